# Optimizing an MI355X kernel written in HIP

```python
import jax, jax.numpy as jnp
from jax import lax
import numpy as np

D_MODEL = 2048
BATCH = 8
SEQ = 2048
DEPTH = 1

CHUNK = 64
D_MIX = D_MODEL
FOX_HEAD_DIM = 128
FOX_WIDTH = D_MIX // 2
FOX_HEADS = FOX_WIDTH // FOX_HEAD_DIM
Q_BLOCK = 128
MLSTM_HEAD_DIM = 256
MLSTM_WIDTH = D_MIX - FOX_WIDTH
MLSTM_HEADS = MLSTM_WIDTH // MLSTM_HEAD_DIM
CONV_K = 4
PEER_HEADS = 8
N_KEYS = 128
N_EXPERTS = N_KEYS * N_KEYS
PEER_TOPK = 16
PEER_QDIM = 256
PEER_TOKEN_BLOCK = 128
RMS_EPS = 1e-6
N_MOD = 6

kernel_name = "hybrid_fox_mlstm_peer_block"


def rms_norm(x, gain):
    xf = x.astype(jnp.float32)
    r = lax.rsqrt(jnp.mean(xf * xf, axis=-1, keepdims=True) + RMS_EPS)
    return (xf * r).astype(x.dtype) * gain


def causal_depthwise_conv(x, w, b):
    C = x.shape[-1]
    y = lax.conv_general_dilated(
        x, w[:, None, :].astype(x.dtype), window_strides=(1,),
        padding=[(CONV_K - 1, 0)], dimension_numbers=('NWC', 'WIO', 'NWC'),
        feature_group_count=C)
    return y + b


def fox_attention(q, k, v, f_pre, q_gain, k_gain):
    B, S, H, Dh = q.shape
    q = rms_norm(q, q_gain).transpose(0, 2, 1, 3)
    k = rms_norm(k, k_gain).transpose(0, 2, 1, 3)
    v = v.transpose(0, 2, 1, 3)
    F = jnp.cumsum(jax.nn.log_sigmoid(f_pre.astype(jnp.float32)), axis=1).transpose(0, 2, 1)
    scale = FOX_HEAD_DIM ** -0.5
    outs = []
    for blk in range(S // Q_BLOCK):
        lo, hi = blk * Q_BLOCK, (blk + 1) * Q_BLOCK
        s = jnp.einsum('bhqd,bhkd->bhqk', q[:, :, lo:hi], k[:, :, :hi]).astype(jnp.float32) * scale
        s = s + F[:, :, lo:hi, None] - F[:, :, None, :hi]
        causal = (lo + jnp.arange(Q_BLOCK))[:, None] >= jnp.arange(hi)[None, :]
        s = jnp.where(causal, s, -jnp.inf)
        p = jax.nn.softmax(s, axis=-1).astype(v.dtype)
        outs.append(jnp.einsum('bhqk,bhkd->bhqd', p, v[:, :, :hi]))
    o = jnp.concatenate(outs, axis=2)
    return o.transpose(0, 2, 1, 3).reshape(B, S, H * Dh)


def mlstm_chunkwise(q, k, v, i_pre, f_pre):
    B, S, H, Dh = q.shape
    NC = S // CHUNK

    def to_chunks(t):
        return t.reshape(B, NC, CHUNK, *t.shape[2:]).swapaxes(0, 1)

    k = k * (Dh ** -0.5)
    xs = (to_chunks(q.astype(jnp.float32)), to_chunks(k.astype(jnp.float32)),
          to_chunks(v.astype(jnp.float32)), to_chunks(i_pre.astype(jnp.float32)),
          to_chunks(jax.nn.log_sigmoid(f_pre.astype(jnp.float32))))
    causal = jnp.tril(jnp.ones((CHUNK, CHUNK), dtype=bool))

    def step(carry, inp):
        C, n, m = carry
        qc, kc, vc, ic, fc = inp
        b = jnp.cumsum(fc, axis=1).transpose(0, 2, 1)
        ic = ic.transpose(0, 2, 1)
        logD = b[:, :, :, None] - b[:, :, None, :] + ic[:, :, None, :]
        logD = jnp.where(causal, logD, -jnp.inf)
        m_inter = b + m[:, :, None]
        m_t = jnp.maximum(m_inter, jnp.max(logD, axis=-1))
        Dm = jnp.exp(logD - m_t[..., None])
        inter = jnp.exp(m_inter - m_t)
        W = jnp.einsum('blhd,bshd->bhls', qc, kc) * Dm
        num = (jnp.einsum('bhls,bshd->bhld', W, vc)
               + inter[..., None] * jnp.einsum('blhd,bhde->bhle', qc, C))
        den = jnp.sum(W, axis=-1) + inter * jnp.einsum('blhd,bhd->bhl', qc, n)
        h = num / jnp.maximum(jnp.abs(den), jnp.exp(-m_t))[..., None]
        bL = b[:, :, -1]
        w_s = bL[..., None] - b + ic
        m_new = jnp.maximum(bL + m, jnp.max(w_s, axis=-1))
        decay = jnp.exp(bL + m - m_new)
        ws = jnp.exp(w_s - m_new[..., None])
        C_new = decay[..., None, None] * C + jnp.einsum('bhs,bshd,bshe->bhde', ws, kc, vc)
        n_new = decay[..., None] * n + jnp.einsum('bhs,bshd->bhd', ws, kc)
        return (C_new, n_new, m_new), h.transpose(0, 2, 1, 3)

    init = (jnp.zeros((B, H, Dh, Dh), jnp.float32), jnp.zeros((B, H, Dh), jnp.float32),
            jnp.zeros((B, H), jnp.float32))
    _, hs = lax.scan(step, init, xs)
    return hs.swapaxes(0, 1).reshape(B, S, H, Dh).astype(q.dtype)


def mixer(h, w_in, fox_f_bias, fox_q_gain, fox_k_gain, mlstm_conv_w, mlstm_conv_b,
          mlstm_i_bias, mlstm_f_bias, mlstm_head_gain, w_out):
    B, S, _ = h.shape
    sizes = [FOX_WIDTH, FOX_WIDTH, FOX_WIDTH, FOX_HEADS,
             MLSTM_WIDTH, MLSTM_WIDTH, MLSTM_WIDTH, MLSTM_WIDTH, MLSTM_HEADS, MLSTM_HEADS]
    split_at = np.cumsum(sizes)[:-1].tolist()
    p = h @ w_in
    fq, fk, fv, ff, mq, mk, mv, mo, mi, mf = jnp.split(p, split_at, axis=-1)
    fox_out = fox_attention(fq.reshape(B, S, FOX_HEADS, FOX_HEAD_DIM),
                            fk.reshape(B, S, FOX_HEADS, FOX_HEAD_DIM),
                            fv.reshape(B, S, FOX_HEADS, FOX_HEAD_DIM),
                            ff + fox_f_bias, fox_q_gain, fox_k_gain)
    mqk = jax.nn.silu(causal_depthwise_conv(jnp.concatenate([mq, mk], axis=-1),
                                            mlstm_conv_w, mlstm_conv_b))
    mq, mk = jnp.split(mqk, 2, axis=-1)
    hm = mlstm_chunkwise(mq.reshape(B, S, MLSTM_HEADS, MLSTM_HEAD_DIM),
                         mk.reshape(B, S, MLSTM_HEADS, MLSTM_HEAD_DIM),
                         mv.reshape(B, S, MLSTM_HEADS, MLSTM_HEAD_DIM),
                         mi + mlstm_i_bias, mf + mlstm_f_bias)
    hm = rms_norm(hm, mlstm_head_gain.reshape(MLSTM_HEADS, MLSTM_HEAD_DIM))
    mlstm_out = hm.reshape(B, S, MLSTM_WIDTH) * jax.nn.sigmoid(mo)
    return jnp.concatenate([fox_out, mlstm_out], axis=-1) @ w_out


def peer(h, w_query, sub_keys_1, sub_keys_2, expert_down, expert_up):
    B, S, D = h.shape
    half = PEER_QDIM // 2
    q = (h @ w_query).reshape(B, S, PEER_HEADS, PEER_QDIM)
    s1 = jnp.einsum('bshd,nd->bshn', q[..., :half], sub_keys_1).astype(jnp.float32)
    s2 = jnp.einsum('bshd,nd->bshn', q[..., half:], sub_keys_2).astype(jnp.float32)
    v1, i1 = lax.top_k(s1, PEER_TOPK)
    v2, i2 = lax.top_k(s2, PEER_TOPK)
    cand = (v1[..., :, None] + v2[..., None, :]).reshape(B, S, PEER_HEADS, PEER_TOPK * PEER_TOPK)
    vs, pos = lax.top_k(cand, PEER_TOPK)
    e1 = jnp.take_along_axis(i1, pos // PEER_TOPK, axis=-1)
    e2 = jnp.take_along_axis(i2, pos % PEER_TOPK, axis=-1)
    idx = e1 * N_KEYS + e2
    g = jax.nn.softmax(vs, axis=-1)
    T = B * S
    nb = T // PEER_TOKEN_BLOCK

    def block(args):
        xb, ib, gb = args
        u = jnp.take(expert_down, ib, axis=0)
        a = jax.nn.gelu(jnp.einsum('td,thkd->thk', xb, u), approximate=False)
        w = (gb * a).astype(xb.dtype)
        vv = jnp.take(expert_up, ib, axis=0)
        return jnp.einsum('thk,thkd->td', w, vv)

    out = lax.map(block, (h.reshape(nb, PEER_TOKEN_BLOCK, D),
                          idx.reshape(nb, PEER_TOKEN_BLOCK, PEER_HEADS, PEER_TOPK),
                          g.reshape(nb, PEER_TOKEN_BLOCK, PEER_HEADS, PEER_TOPK)))
    return out.reshape(B, S, D)


def setup_inputs(seed: int = 0) -> dict:
    key = jax.random.key(seed)
    ks = jax.random.split(key, 24)
    n = jax.random.normal
    L = DEPTH
    in_cols = 3 * FOX_WIDTH + FOX_HEADS + 4 * MLSTM_WIDTH + 2 * MLSTM_HEADS
    return {
        "x": n(ks[0], (BATCH, SEQ, D_MODEL), jnp.float32),
        "c": n(ks[1], (BATCH, D_MODEL), jnp.float32),
        "w_ada": n(ks[2], (L, D_MODEL, N_MOD * D_MODEL), jnp.float32) * (0.5 * D_MODEL ** -0.5),
        "b_ada": n(ks[3], (L, N_MOD * D_MODEL), jnp.float32) * 0.02,
        "norm1_gain": 1.0 + 0.02 * n(ks[4], (L, D_MODEL), jnp.float32),
        "norm2_gain": 1.0 + 0.02 * n(ks[5], (L, D_MODEL), jnp.float32),
        "w_in": n(ks[6], (L, D_MODEL, in_cols), jnp.float32) * D_MODEL ** -0.5,
        "fox_f_bias": 3.0 + 0.1 * n(ks[7], (L, FOX_HEADS), jnp.float32),
        "fox_q_gain": 1.0 + 0.02 * n(ks[8], (L, FOX_HEAD_DIM), jnp.float32),
        "fox_k_gain": 1.0 + 0.02 * n(ks[9], (L, FOX_HEAD_DIM), jnp.float32),
        "mlstm_conv_w": n(ks[10], (L, CONV_K, 2 * MLSTM_WIDTH), jnp.float32) * CONV_K ** -0.5,
        "mlstm_conv_b": 0.02 * n(ks[11], (L, 2 * MLSTM_WIDTH), jnp.float32),
        "mlstm_i_bias": -1.0 + 0.1 * n(ks[12], (L, MLSTM_HEADS), jnp.float32),
        "mlstm_f_bias": 3.0 + 0.1 * n(ks[13], (L, MLSTM_HEADS), jnp.float32),
        "mlstm_head_gain": 1.0 + 0.02 * n(ks[14], (L, MLSTM_WIDTH), jnp.float32),
        "w_out": n(ks[15], (L, D_MIX, D_MODEL), jnp.float32) * D_MIX ** -0.5,
        "peer_w_query": n(ks[16], (L, D_MODEL, PEER_HEADS * PEER_QDIM), jnp.float32) * D_MODEL ** -0.5,
        "peer_sub_keys_1": n(ks[17], (L, N_KEYS, PEER_QDIM // 2), jnp.float32) * (PEER_QDIM // 2) ** -0.5,
        "peer_sub_keys_2": n(ks[18], (L, N_KEYS, PEER_QDIM // 2), jnp.float32) * (PEER_QDIM // 2) ** -0.5,
        "peer_expert_down": n(ks[19], (L, N_EXPERTS, D_MODEL), jnp.float32) * D_MODEL ** -0.5,
        "peer_expert_up": n(ks[20], (L, N_EXPERTS, D_MODEL), jnp.float32) * PEER_HEADS ** -0.5,
    }


def reference(x, c, w_ada, b_ada, norm1_gain, norm2_gain, w_in, fox_f_bias, fox_q_gain,
              fox_k_gain, mlstm_conv_w, mlstm_conv_b, mlstm_i_bias, mlstm_f_bias,
              mlstm_head_gain, w_out, peer_w_query, peer_sub_keys_1, peer_sub_keys_2,
              peer_expert_down, peer_expert_up):
    for l in range(DEPTH):
        mod = jax.nn.silu(c) @ w_ada[l] + b_ada[l]
        shift1, scale1, gate1, shift2, scale2, gate2 = jnp.split(mod[:, None, :], N_MOD, axis=-1)
        h = rms_norm(x, norm1_gain[l]) * (1.0 + scale1) + shift1
        y = mixer(h, w_in[l], fox_f_bias[l], fox_q_gain[l], fox_k_gain[l], mlstm_conv_w[l],
                  mlstm_conv_b[l], mlstm_i_bias[l], mlstm_f_bias[l], mlstm_head_gain[l], w_out[l])
        x = x + gate1 * y
        h = rms_norm(x, norm2_gain[l]) * (1.0 + scale2) + shift2
        y = peer(h, peer_w_query[l], peer_sub_keys_1[l], peer_sub_keys_2[l],
                 peer_expert_down[l], peer_expert_up[l])
        x = x + gate2 * y
    return x
```

```cpp
#include <hip/hip_runtime.h>
#include <cstdio>
#include <cstdint>

#define GAS __attribute__((address_space(1)))
#define LAS __attribute__((address_space(3)))
typedef unsigned short bf16_t;
typedef short bf16x8 __attribute__((ext_vector_type(8)));
typedef float f32x4 __attribute__((ext_vector_type(4)));
typedef float f32x16 __attribute__((ext_vector_type(16)));
typedef unsigned u32x4 __attribute__((ext_vector_type(4)));
typedef unsigned u32x2 __attribute__((ext_vector_type(2)));

constexpr int T_ = 16384, D_ = 2048, B_ = 8, S_ = 2048, NTHR = 512;
constexpr float EPS_ = 1e-6f;
constexpr int NMOD = 6 * D_;
constexpr int INCOLS = 7184;

constexpr size_t WS_BAR   = 0;
constexpr size_t WS_MOD   = 16384;
constexpr size_t WS_WG    = WS_MOD + (size_t)B_ * NMOD * 4;
constexpr size_t WS_GATE  = WS_WG + 16 * 2048 * 4;
constexpr size_t WS_F     = WS_GATE + (size_t)T_ * 16 * 4;
constexpr size_t WS_NST   = WS_F + 64 * 2048 * 4;
constexpr size_t WS_MST   = WS_NST + 1024 * 256 * 4;
constexpr size_t WS_WINT  = WS_MST + 4096;
constexpr size_t WS_WOT   = WS_WINT + (size_t)7168 * 2048 * 2;
constexpr size_t WS_WQT   = WS_WOT + (size_t)2048 * 2048 * 2;
constexpr size_t WS_H     = WS_WQT + (size_t)2048 * 2048 * 2;
constexpr size_t WS_P     = WS_H + (size_t)T_ * 2048 * 2;
constexpr size_t SEG_B    = (size_t)T_ * 1024 * 2;
constexpr size_t WS_CST   = WS_P + 7 * SEG_B;
constexpr size_t WS_END   = WS_CST + (size_t)1024 * 256 * 256 * 2;
constexpr size_t WS_H2    = WS_P;
constexpr size_t WS_Q     = WS_H2 + (size_t)T_ * 2048 * 2;
constexpr size_t WS_IDX   = WS_Q + (size_t)T_ * 2048 * 2;
constexpr size_t WS_GW    = WS_IDX + (size_t)T_ * 128 * 4;
static_assert(WS_GW + (size_t)T_ * 128 * 4 <= WS_CST, "alias overflow");

struct Params {
    const float *x, *c, *w_ada, *b_ada, *g1, *g2, *w_in, *fox_fb, *fox_qg, *fox_kg, *conv_w, *conv_b, *m_ib, *m_fb, *m_hg, *w_out, *w_q, *sk1, *sk2, *e_down, *e_up;
    float* out; unsigned char* ws; int ph_lo, ph_hi;
};

__device__ __forceinline__ unsigned cvt_pk(float lo, float hi) { unsigned r; asm("v_cvt_pk_bf16_f32 %0, %1, %2" : "=v"(r) : "v"(lo), "v"(hi)); return r; }
__device__ __forceinline__ float bf2f(unsigned short h) { return __builtin_bit_cast(float, ((unsigned)h) << 16); }
__device__ __forceinline__ float bflo(unsigned w) { return __builtin_bit_cast(float, w << 16); }
__device__ __forceinline__ float bfhi(unsigned w) { return __builtin_bit_cast(float, w & 0xffff0000u); }
__device__ __forceinline__ float wsum(float v) {
#pragma unroll
    for (int o = 32; o; o >>= 1) v += __shfl_xor(v, o);
    return v; }
__device__ __forceinline__ float wmax(float v) {
#pragma unroll
    for (int o = 32; o; o >>= 1) v = fmaxf(v, __shfl_xor(v, o));
    return v; }
__device__ __forceinline__ float logsig(float x) { return fminf(x, 0.f) - log1pf(expf(-fabsf(x))); }
__device__ __forceinline__ float sigm(float x) { return 1.f / (1.f + expf(-x)); }
__device__ __forceinline__ float silu_f(float x) { return x / (1.f + expf(-x)); }
namespace pg8 {
#define PG8_LAS __attribute__((address_space(3)))
typedef unsigned short bf16_t;
typedef short bf16x8 __attribute__((ext_vector_type(8)));
typedef float f32x4 __attribute__((ext_vector_type(4)));
typedef unsigned u32x4 __attribute__((ext_vector_type(4)));
constexpr int BM = 256, BK = 64, HALF = 128, HTB = HALF * BK * 2  , STAGE_BYTES = 8 * HTB, NXCD = 8, WGM = 8;

__host__ __device__ __forceinline__ int lds_byte(int r, int c) { const int st = (r >> 4) * 2 + (c >> 5), rr = r & 15, cc = c & 31, ob = rr * 64 + cc * 2; return st * 1024 + (ob ^ (((ob >> 9) & 1) << 5)); }
__host__ __device__ __forceinline__ void stage_rc(int b, int& R, int& C) { const int st = b / 1024, sb = b % 1024, swz = sb ^ (((sb >> 9) & 1) << 5); R = (st >> 1) * 16 + swz / 64; C = (st & 1) * 32 + (swz % 64) / 2; }
__host__ __device__ __forceinline__ int perm32(int rho) { const int n = rho >> 4, i = rho & 15; return 8 * (i >> 2) + 4 * n + (i & 3); }

struct Unit { int pm, pn; };
struct Gemm { const bf16_t* A; const bf16_t* Bt; int M, N, K; };

struct StaticOrder {
    int nM, nN, nwg, G, c;
    __host__ __device__ void init(int M, int N, int G_, int c_) { nM = M / BM; nN = N / BM; nwg = nM * nN; G = G_; c = c_; }
    __host__ __device__ bool next(int i, Unit& u) const {
        const long L = (long)i * G + c; if (L >= nwg) return false;
        int wgid = (int)L; { const int q = nwg / NXCD, r = nwg % NXCD, xcd = wgid % NXCD, off = wgid / NXCD; wgid = (xcd < r ? xcd * (q + 1) : r * (q + 1) + (xcd - r) * q) + off; }
        const int nig = WGM * nN, gid = wgid / nig, fm = gid * WGM, gsz = (nM - fm) < WGM ? (nM - fm) : WGM;
        u.pm = fm + ((wgid % nig) % gsz); u.pn = (wgid % nig) / gsz; return true;
    }
    __device__ __forceinline__ void a_ready(const Unit&) const {}
    __device__ __forceinline__ void done(const Unit&) const {}
};
struct EpiSeg {
    static constexpr bool PERM = true, AFTER_DRAIN = false;
    bf16_t* P;
    __device__ __forceinline__ void operator()(const f32x4 (&acc)[2][2][4][2], const Unit& u, int wr, int wc, int fr, int fq) const {
        const int seg = u.pn >> 2; bf16_t* base = P + (size_t)seg * ((size_t)T_ * 1024);
        const int row0 = u.pm * BM + wr * 64 + fr, col0 = (u.pn & 3) * 256 + wc * 32 + 8 * fq;
#pragma unroll
        for (int ai = 0; ai < 2; ++ai)
#pragma unroll
            for (int m = 0; m < 4; ++m) { bf16_t* rowp = base + (size_t)(row0 + ai * HALF + m * 16) * 1024 + col0;
#pragma unroll
                for (int bj = 0; bj < 2; ++bj) { const f32x4 v0 = acc[ai][bj][m][0], v1 = acc[ai][bj][m][1];
                    u32x4 w; w.x = cvt_pk(v0[0], v0[1]); w.y = cvt_pk(v0[2], v0[3]); w.z = cvt_pk(v1[0], v1[1]); w.w = cvt_pk(v1[2], v1[3]);
                    *(u32x4*)(rowp + bj * HALF) = w; } }
    }
};
struct EpiBf {
    static constexpr bool PERM = true, AFTER_DRAIN = false;
    bf16_t* O; int ldc;
    __device__ __forceinline__ void operator()(const f32x4 (&acc)[2][2][4][2], const Unit& u, int wr, int wc, int fr, int fq) const {
        const int row0 = u.pm * BM + wr * 64 + fr, col0 = u.pn * BM + wc * 32 + 8 * fq;
#pragma unroll
        for (int ai = 0; ai < 2; ++ai)
#pragma unroll
            for (int m = 0; m < 4; ++m) { bf16_t* rowp = O + (size_t)(row0 + ai * HALF + m * 16) * ldc + col0;
#pragma unroll
                for (int bj = 0; bj < 2; ++bj) { const f32x4 v0 = acc[ai][bj][m][0], v1 = acc[ai][bj][m][1];
                    u32x4 w; w.x = cvt_pk(v0[0], v0[1]); w.y = cvt_pk(v0[2], v0[3]); w.z = cvt_pk(v1[0], v1[1]); w.w = cvt_pk(v1[2], v1[3]);
                    *(u32x4*)(rowp + bj * HALF) = w; } }
    }
};
struct EpiRes {
    static constexpr bool PERM = false, AFTER_DRAIN = false;
    const float* X; float* O; const float* mod; int goff;
    __device__ __forceinline__ void operator()(const f32x4 (&acc)[2][2][4][2], const Unit& u, int wr, int wc, int fr, int fq) const {
        const int row0 = u.pm * BM + wr * 64 + fr, col0 = u.pn * BM + wc * 32 + 4 * fq;
        const float* gp = mod + (size_t)((u.pm * BM) >> 11) * NMOD + goff + col0;
        f32x4 gv[2][2];
#pragma unroll
        for (int bj = 0; bj < 2; ++bj)
#pragma unroll
            for (int n = 0; n < 2; ++n) gv[bj][n] = *(const f32x4*)(gp + bj * HALF + 16 * n);
#pragma unroll
        for (int ai = 0; ai < 2; ++ai)
#pragma unroll
            for (int m = 0; m < 4; ++m) { const size_t ro = (size_t)(row0 + ai * HALF + m * 16) * D_ + col0;
#pragma unroll
                for (int bj = 0; bj < 2; ++bj)
#pragma unroll
                    for (int n = 0; n < 2; ++n) { const f32x4 xv = *(const f32x4*)(X + ro + bj * HALF + 16 * n);
                        *(f32x4*)(O + ro + bj * HALF + 16 * n) = xv + gv[bj][n] * acc[ai][bj][m][n]; } }
    }
};
template <class Epi, class Sched, bool ALIGN_EPI = false, bool SP2 = false>
__device__ __forceinline__ void gemm_phase(PG8_LAS unsigned char* lds, const Gemm g, const Sched& S, const Epi& E) {
    const int tid = threadIdx.x, wid = __builtin_amdgcn_readfirstlane(tid >> 6), lane = tid & 63, wr = wid >> 2, wc = wid & 3, fr = lane & 15, fq = lane >> 4;
    const int K = g.K, nt = K / BK;
    unsigned voffA[2], voffB[2];
#pragma unroll
    for (int i = 0; i < 2; ++i) { int R, C; stage_rc(tid * 16 + i * 8192, R, C); const int Rb = Epi::PERM ? ((R & ~31) + perm32(R & 31)) : R;
        voffA[i] = (unsigned)(R * K + C) * 2u; voffB[i] = (unsigned)(Rb * K + C) * 2u; }
    const size_t kstep = (size_t)(BK * 2);
    const size_t hstep = (size_t)HALF * K * 2;
    const size_t tstep = 2 * hstep;
    const unsigned ldsw = (unsigned)wid * 1024u;
    const int aoff = lds_byte(wr * 64 + fr, fq * 8), boff = lds_byte(wc * 32 + fr, fq * 8);
#define PG8_SA(b, h) (((b) * 2 + (h)) * HTB)
#define PG8_SB(b, h) ((4 + (b) * 2 + (h)) * HTB)
#define PG8_STAGE(bufoff, gbase, voff) do { _Pragma("unroll") for (int _i = 0; _i < 2; ++_i) \
        __builtin_amdgcn_global_load_lds((const unsigned*)((const char*)(gbase) + (voff)[_i]), (PG8_LAS unsigned*)(lds + (bufoff) + ldsw + _i * 8192), 16, 0, 0); } while (0)
#define PG8_LDA(dst, b, h) do { _Pragma("unroll") for (int m = 0; m < 4; ++m) _Pragma("unroll") for (int k = 0; k < 2; ++k) dst[m][k] = *(const PG8_LAS bf16x8*)(lds + PG8_SA(b, h) + aoff + m * 2048 + k * 1024); } while (0)
#define PG8_LDB(dst, b, h) do { _Pragma("unroll") for (int n = 0; n < 2; ++n) _Pragma("unroll") for (int k = 0; k < 2; ++k) dst[n][k] = *(const PG8_LAS bf16x8*)(lds + PG8_SB(b, h) + boff + n * 2048 + k * 1024); } while (0)
#define PG8_MMA(ai, bj, At, Bt) do { __builtin_amdgcn_s_setprio(1); _Pragma("unroll") for (int m = 0; m < 4; ++m) _Pragma("unroll") for (int n = 0; n < 2; ++n) _Pragma("unroll") for (int k = 0; k < 2; ++k) \
        acc[ai][bj][m][n] = __builtin_amdgcn_mfma_f32_16x16x32_bf16(Bt[n][k], At[m][k], acc[ai][bj][m][n], 0, 0, 0); __builtin_amdgcn_s_setprio(0); } while (0)
#define PG8_WAIT_V(n) asm volatile("s_waitcnt vmcnt(" #n ")" ::: "memory")
#define PG8_WAIT_L(n) asm volatile("s_waitcnt lgkmcnt(" #n ")" ::: "memory")
#define PG8_BAR __builtin_amdgcn_s_barrier()
#define PG8_SCHED __builtin_amdgcn_sched_barrier(0)
    Unit cur, nxt; int ui = 0;
    if (!S.next(0, cur)) return;
    f32x4 acc[2][2][4][2];
#pragma unroll
    for (int a = 0; a < 2; ++a)
#pragma unroll
        for (int b = 0; b < 2; ++b)
#pragma unroll
            for (int m = 0; m < 4; ++m)
#pragma unroll
                for (int n = 0; n < 2; ++n) acc[a][b][m][n] = (f32x4){0.f, 0.f, 0.f, 0.f};
    bf16x8 At[4][2], B0[2][2], B1[2][2];
    const char* cA = (const char*)g.A + (size_t)cur.pm * tstep; const char* cB = (const char*)g.Bt + (size_t)cur.pn * tstep;
    S.a_ready(cur);
    if constexpr (SP2) {
        PG8_STAGE(PG8_SB(0, 0), cB, voffB); PG8_STAGE(PG8_SB(0, 1), cB + hstep, voffB); PG8_STAGE(PG8_SA(0, 0), cA, voffA); PG8_STAGE(PG8_SA(0, 1), cA + hstep, voffA);
        if (wr == 1) PG8_BAR;
        PG8_WAIT_V(2); PG8_BAR;
        PG8_STAGE(PG8_SB(1, 0), cB + kstep, voffB); PG8_STAGE(PG8_SA(1, 0), cA + kstep, voffA); PG8_STAGE(PG8_SB(1, 1), cB + hstep + kstep, voffB);
        PG8_WAIT_V(6); PG8_BAR;
    } else {
        PG8_STAGE(PG8_SB(0, 0), cB, voffB); PG8_STAGE(PG8_SA(0, 0), cA, voffA); PG8_STAGE(PG8_SB(0, 1), cB + hstep, voffB); PG8_STAGE(PG8_SA(0, 1), cA + hstep, voffA);
        if (wr == 1) PG8_BAR;
        PG8_WAIT_V(4); PG8_BAR;
        PG8_STAGE(PG8_SB(1, 0), cB + kstep, voffB); PG8_STAGE(PG8_SA(1, 0), cA + kstep, voffA); PG8_STAGE(PG8_SB(1, 1), cB + hstep + kstep, voffB);
        PG8_WAIT_V(6); PG8_BAR;
    }
    for (;;) {
        const bool has_next = S.next(ui + 1, nxt);
        const char* nA = has_next ? (const char*)g.A + (size_t)nxt.pm * tstep : cA; const char* nB = has_next ? (const char*)g.Bt + (size_t)nxt.pn * tstep : cB;
        for (int t = 0; t < nt; t += 2) {
            const bool last = (t == nt - 2);
            const char* a1 = cA + (size_t)(t + 1) * kstep;
            const char* a2 = last ? nA : cA + (size_t)(t + 2) * kstep; const char* b2 = last ? nB : cB + (size_t)(t + 2) * kstep;
            const char* a3 = a2 + kstep; const char* b3 = b2 + kstep;
            if (last && has_next) S.a_ready(nxt);
            if constexpr (SP2) {
            PG8_LDB(B0, 0, 0); PG8_LDB(B1, 0, 1); PG8_SCHED; PG8_LDA(At, 0, 0); PG8_STAGE(PG8_SA(1, 1), a1 + hstep, voffA);
            PG8_WAIT_V(8); PG8_WAIT_L(0); PG8_BAR; PG8_MMA(0, 0, At, B0); PG8_MMA(0, 1, At, B1); PG8_BAR; PG8_SCHED;
            PG8_LDA(At, 0, 1); PG8_STAGE(PG8_SB(0, 0), b2, voffB); PG8_STAGE(PG8_SB(0, 1), b2 + hstep, voffB); PG8_STAGE(PG8_SA(0, 0), a2, voffA);
            PG8_WAIT_V(8); PG8_WAIT_L(0); PG8_BAR; PG8_MMA(1, 0, At, B0); PG8_MMA(1, 1, At, B1); PG8_BAR; PG8_SCHED;
            PG8_LDB(B0, 1, 0); PG8_LDB(B1, 1, 1); PG8_SCHED; PG8_LDA(At, 1, 0); PG8_STAGE(PG8_SA(0, 1), a2 + hstep, voffA);
            PG8_WAIT_V(8); PG8_WAIT_L(0); PG8_BAR; PG8_MMA(0, 0, At, B0); PG8_MMA(0, 1, At, B1); PG8_BAR; PG8_SCHED;
            PG8_LDA(At, 1, 1); PG8_STAGE(PG8_SB(1, 0), b3, voffB); PG8_STAGE(PG8_SB(1, 1), b3 + hstep, voffB); PG8_STAGE(PG8_SA(1, 0), a3, voffA);
            PG8_WAIT_V(8); PG8_WAIT_L(0); PG8_BAR; PG8_MMA(1, 0, At, B0); PG8_MMA(1, 1, At, B1); PG8_BAR; PG8_SCHED;
            } else {
            PG8_LDB(B0, 0, 0); PG8_SCHED; PG8_LDA(At, 0, 0); PG8_STAGE(PG8_SA(1, 1), a1 + hstep, voffA);
            PG8_WAIT_L(8); PG8_BAR; PG8_WAIT_L(0); PG8_MMA(0, 0, At, B0); PG8_BAR; PG8_SCHED;
            PG8_LDB(B1, 0, 1); PG8_STAGE(PG8_SB(0, 0), b2, voffB);
            PG8_BAR; PG8_WAIT_L(0); PG8_MMA(0, 1, At, B1); PG8_BAR;
            PG8_LDA(At, 0, 1); PG8_STAGE(PG8_SA(0, 0), a2, voffA);
            PG8_BAR; PG8_WAIT_L(0); PG8_MMA(1, 0, At, B0); PG8_BAR; PG8_SCHED;
            PG8_STAGE(PG8_SB(0, 1), b2 + hstep, voffB);
            PG8_WAIT_V(6); PG8_BAR; PG8_MMA(1, 1, At, B1); PG8_BAR;
            PG8_LDB(B0, 1, 0); PG8_SCHED; PG8_LDA(At, 1, 0); PG8_STAGE(PG8_SA(0, 1), a2 + hstep, voffA);
            PG8_WAIT_L(8); PG8_BAR; PG8_WAIT_L(0); PG8_MMA(0, 0, At, B0); PG8_BAR; PG8_SCHED;
            PG8_LDB(B1, 1, 1); PG8_STAGE(PG8_SB(1, 0), b3, voffB);
            PG8_BAR; PG8_WAIT_L(0); PG8_MMA(0, 1, At, B1); PG8_BAR;
            PG8_LDA(At, 1, 1); PG8_STAGE(PG8_SA(1, 0), a3, voffA);
            PG8_BAR; PG8_WAIT_L(0); PG8_MMA(1, 0, At, B0); PG8_BAR; PG8_SCHED;
            PG8_STAGE(PG8_SB(1, 1), b3 + hstep, voffB);
            PG8_WAIT_V(6); PG8_BAR; PG8_MMA(1, 1, At, B1); PG8_BAR;
            }
        }
        if constexpr (ALIGN_EPI) { if (wr == 0) PG8_BAR; }
        if constexpr (!Epi::AFTER_DRAIN) { E(acc, cur, wr, wc, fr, fq); S.done(cur); }
        if (!has_next) break;
#pragma unroll
        for (int a = 0; a < 2; ++a)
#pragma unroll
            for (int b = 0; b < 2; ++b)
#pragma unroll
                for (int m = 0; m < 4; ++m)
#pragma unroll
                    for (int n = 0; n < 2; ++n) acc[a][b][m][n] = (f32x4){0.f, 0.f, 0.f, 0.f};
        cur = nxt; cA = nA; cB = nB; ++ui;
        if constexpr (ALIGN_EPI) { if (wr == 1) PG8_BAR; }
    }
    PG8_WAIT_V(0);
    if constexpr (!ALIGN_EPI) { if (wr == 0) PG8_BAR; }
    PG8_BAR;
    if constexpr (Epi::AFTER_DRAIN) { E.fused(acc, cur, wr, wc, fr, fq, lds, wid, lane); S.done(cur); }
#undef PG8_SA
#undef PG8_SB
#undef PG8_STAGE
#undef PG8_LDA
#undef PG8_LDB
#undef PG8_MMA
#undef PG8_WAIT_V
#undef PG8_WAIT_L
#undef PG8_BAR
#undef PG8_SCHED
}
}
#define XB_TMO      128
#define XB_XCNT(j)  (256  + 64 * (j))
#define XB_XSUB(j)  (1280 + 64 * (j))
#define XB_XGEN(j)  (2304 + 64 * (j))
#define XB_TOP      3328
#define XB_TOPGEN   3392
#define XCD_BAR_WORDS 3456
#define XB_SPIN_CAP (1u << 18)

__device__ __forceinline__ unsigned xb_ld(unsigned* p)              { return __hip_atomic_load(p, __ATOMIC_RELAXED, __HIP_MEMORY_SCOPE_AGENT); }
__device__ __forceinline__ unsigned xb_add(unsigned* p, unsigned v) { return __hip_atomic_fetch_add(p, v, __ATOMIC_RELAXED, __HIP_MEMORY_SCOPE_AGENT); }
__device__ __forceinline__ unsigned xb_xcc_id() { return (unsigned)__builtin_amdgcn_s_getreg((3 << 11) | 20) & 0xFu; }
#define XB_SPIN(cond, bar) do { unsigned _sp = 0; while (cond) { __builtin_amdgcn_s_sleep(1); \
    if ((++_sp & 255u) == 0u) { if (xb_ld(&(bar)[XB_TMO])) break; if (_sp > XB_SPIN_CAP) { atomicAdd(&(bar)[XB_TMO], 1u); break; } } } } while (0)

struct XcdBarrier {
    unsigned* bar; unsigned x;
    volatile LAS unsigned* st;
};

__device__ __forceinline__ XcdBarrier xcd_barrier_post(unsigned* bar, volatile LAS unsigned* st) {
    XcdBarrier b; b.bar = bar; b.x = xb_xcc_id(); b.st = st;
    if (threadIdx.x == 0) (void)xb_add(&bar[XB_XCNT(b.x)], 1u);
    return b;
}
__device__ __forceinline__ void xcd_barrier_complete(unsigned* bar, unsigned x, unsigned& nloc, unsigned& nx) {
    const unsigned G = gridDim.x * gridDim.y * gridDim.z;
    unsigned sum, cnt, mine, sp = 0u;
    for (;;) {
        sum = 0u; cnt = 0u; mine = 0u;
#pragma unroll
        for (unsigned j = 0; j < 16; ++j) { const unsigned c = xb_ld(&bar[XB_XCNT(j)]); sum += c; cnt += (c > 0u) ? 1u : 0u; mine = (j == x) ? c : mine; }
        if (sum == G) break;
        __builtin_amdgcn_s_sleep(1);
        if ((++sp & 255u) == 0u) { if (xb_ld(&bar[XB_TMO])) break; if (sp > XB_SPIN_CAP) { atomicAdd(&bar[XB_TMO], 1u); break; } }
    }
    nloc = mine > 0u ? mine : 1u; nx = cnt > 0u ? cnt : 1u;
}

__device__ __forceinline__ void xcd_barrier(const XcdBarrier& b) {
    asm volatile("s_waitcnt vmcnt(0)" ::: "memory");
    __syncthreads();
    if (threadIdx.x == 0) {
        unsigned* bar = b.bar;
        __builtin_amdgcn_s_waitcnt(0);
        unsigned nloc = b.st[0], nx = b.st[1];
        if (nloc == 0u) { xcd_barrier_complete(bar, b.x, nloc, nx); b.st[0] = nloc; b.st[1] = nx; }
        const unsigned old = xb_add(&bar[XB_XSUB(b.x)], 1u);
        const unsigned gen = old / nloc;
        if (old + 1u == (gen + 1u) * nloc) {
            __builtin_amdgcn_fence(__ATOMIC_RELEASE, "agent");
            asm volatile("s_waitcnt vmcnt(0)" ::: "memory");
            const unsigned og = xb_add(&bar[XB_TOP], 1u);
            const unsigned tg = og / nx;
            if (og + 1u == (tg + 1u) * nx) xb_add(&bar[XB_TOPGEN], 1u);
            else XB_SPIN(xb_ld(&bar[XB_TOPGEN]) == tg, bar);
            __builtin_amdgcn_fence(__ATOMIC_ACQUIRE, "agent");
            xb_add(&bar[XB_XGEN(b.x)], 1u);
            asm volatile("s_waitcnt vmcnt(0)" ::: "memory");
        } else {
            XB_SPIN(xb_ld(&bar[XB_XGEN(b.x)]) == gen, bar);
            __builtin_amdgcn_fence(__ATOMIC_ACQUIRE, "agent");
            asm volatile("s_waitcnt vmcnt(0)" ::: "memory");
        }
    }
    __syncthreads();
}
__device__ __forceinline__ void phase_prep(const Params& p, unsigned char* lds, int bid, int nb) {
    const int tid = threadIdx.x, lane = tid & 63, wave = tid >> 6;
    unsigned char* ws = p.ws;
    float* mod = (float*)(ws + WS_MOD);
    if (bid < 192) {
        float* sc = (float*)lds;
        float* red = sc + 8 * 2048;
        for (int i = tid; i < 8 * 2048; i += NTHR) sc[i] = silu_f(p.c[i]);
        __syncthreads();
        for (int it = bid; it < 192; it += nb) {
            const int col = it * 64 + lane;
            float acc[8];
#pragma unroll
            for (int b = 0; b < 8; ++b) acc[b] = 0.f;
            const float* w = p.w_ada + (size_t)(wave * 256) * NMOD + col;
            const float* s0 = sc + wave * 256;
#pragma unroll 4
            for (int k = 0; k < 256; ++k) {
                const float wv = w[(size_t)k * NMOD];
#pragma unroll
                for (int b = 0; b < 8; ++b) acc[b] += s0[b * 2048 + k] * wv;
            }
#pragma unroll
            for (int b = 0; b < 8; ++b) red[(wave * 8 + b) * 64 + lane] = acc[b];
            __syncthreads();
            {   const int b = wave; float s = p.b_ada[col];
#pragma unroll
                for (int w2 = 0; w2 < 8; ++w2) s += red[(w2 * 8 + b) * 64 + lane];
                mod[b * NMOD + col] = s; }
            __syncthreads();
        }
    }
    __syncthreads();
    {
        float* tile = (float*)lds;
        bf16_t* WinT = (bf16_t*)(ws + WS_WINT); bf16_t* WoT = (bf16_t*)(ws + WS_WOT); bf16_t* WqT = (bf16_t*)(ws + WS_WQT);
        for (int item = bid; item < 5632; item += nb) {
            const float* src; int ld, scol; bf16_t* dst; int kt;
            if (item < 3584) { const int seg = item >> 9, rem = item & 511, ntile = rem >> 5; kt = rem & 31;
                src = p.w_in; ld = INCOLS; scol = (seg < 3 ? seg * 1024 : 3080 + (seg - 3) * 1024) + ntile * 64; dst = WinT + (size_t)(seg * 1024 + ntile * 64) * 2048; }
            else if (item < 4608) { const int rem = item - 3584, ntile = rem >> 5; kt = rem & 31; src = p.w_out; ld = 2048; scol = ntile * 64; dst = WoT + (size_t)(ntile * 64) * 2048; }
            else { const int rem = item - 4608, ntile = rem >> 5; kt = rem & 31; src = p.w_q; ld = 2048; scol = ntile * 64; dst = WqT + (size_t)(ntile * 64) * 2048; }
            const int k0 = kt * 64;
#pragma unroll
            for (int ii = 0; ii < 8; ++ii) { const int k = wave + 8 * ii; tile[k * 65 + lane] = src[(size_t)(k0 + k) * ld + scol + lane]; }
            __syncthreads();
#pragma unroll
            for (int ii = 0; ii < 8; ++ii) { const int n = wave + 8 * ii; dst[(size_t)n * 2048 + k0 + lane] = (bf16_t)(cvt_pk(tile[lane * 65 + n], 0.f) & 0xffffu); }
            __syncthreads();
        }
    }
    {
        float* Wg = (float*)(ws + WS_WG);
        for (int i = bid * NTHR + tid; i < 16 * 2048; i += nb * NTHR) { const int g = i >> 11, k = i & 2047; const int col = g < 8 ? 3072 + g : 7176 + (g - 8);
            Wg[i] = p.w_in[(size_t)k * INCOLS + col]; }
    }
}

template <bool GATES>
__device__ __forceinline__ void phase_norm(const float* xin, const float* gain, const float* mod, int shift_off, int scale_off, bf16_t* hout, const float* Wg, float* gate_out, int bid, int nb) {
    const int tid = threadIdx.x, lane = tid & 63, wave = tid >> 6;
    for (int row = bid * 8 + wave; row < T_; row += nb * 8) {
        const f32x4* xr = (const f32x4*)(xin + (size_t)row * D_);
        f32x4 v[8]; float ss = 0.f;
#pragma unroll
        for (int j = 0; j < 8; ++j) { v[j] = xr[lane + 64 * j]; ss += v[j][0] * v[j][0] + v[j][1] * v[j][1] + v[j][2] * v[j][2] + v[j][3] * v[j][3]; }
        ss = wsum(ss);
        const float r = rsqrtf(ss * (1.f / D_) + EPS_);
        const float* mb = mod + (size_t)(row >> 11) * NMOD;
        f32x4 hv[8];
#pragma unroll
        for (int j = 0; j < 8; ++j) {
            const int k = 4 * (lane + 64 * j);
            const f32x4 gn = *(const f32x4*)(gain + k), sh = *(const f32x4*)(mb + shift_off + k), scl = *(const f32x4*)(mb + scale_off + k);
#pragma unroll
            for (int e = 0; e < 4; ++e) hv[j][e] = (v[j][e] * r) * gn[e] * (1.f + scl[e]) + sh[e];
            u32x2 w; w.x = cvt_pk(hv[j][0], hv[j][1]); w.y = cvt_pk(hv[j][2], hv[j][3]);
            *(u32x2*)(hout + (size_t)row * D_ + k) = w;
        }
        if (GATES) {
            float outv = 0.f;
#pragma unroll 1
            for (int g = 0; g < 16; ++g) {
                float ga = 0.f;
#pragma unroll
                for (int j = 0; j < 8; ++j) { const f32x4 wv = *(const f32x4*)(Wg + g * 2048 + 4 * (lane + 64 * j)); ga += hv[j][0] * wv[0] + hv[j][1] * wv[1] + hv[j][2] * wv[2] + hv[j][3] * wv[3]; }
                const float s = wsum(ga); if (lane == g) outv = s;
            }
            if (lane < 16) gate_out[(size_t)row * 16 + lane] = outv;
        }
    }
}

__device__ __forceinline__ void phase_post(const Params& p, int bid, int nb) {
    const int tid = threadIdx.x, lane = tid & 63, wave = tid >> 6;
    unsigned char* ws = p.ws;
    bf16_t* Pq = (bf16_t*)(ws + WS_P); bf16_t* Pk = (bf16_t*)(ws + WS_P + SEG_B);
    const float qscale = 0.08838834764831845f;
    for (int r = bid * 8 + wave; r < 2 * T_; r += nb * 8) {
        const int which = r >= T_ ? 1 : 0; const int t = r - which * T_;
        bf16_t* ptr = (which ? Pk : Pq) + (size_t)t * 1024 + lane * 16;
        const float* gn = (which ? p.fox_kg : p.fox_qg) + (lane & 7) * 16;
        u32x4 a = *(const u32x4*)ptr, b = *(const u32x4*)(ptr + 8);
        float f[16];
        f[0] = bflo(a.x); f[1] = bfhi(a.x); f[2] = bflo(a.y); f[3] = bfhi(a.y); f[4] = bflo(a.z); f[5] = bfhi(a.z); f[6] = bflo(a.w); f[7] = bfhi(a.w);
        f[8] = bflo(b.x); f[9] = bfhi(b.x); f[10] = bflo(b.y); f[11] = bfhi(b.y); f[12] = bflo(b.z); f[13] = bfhi(b.z); f[14] = bflo(b.w); f[15] = bfhi(b.w);
        float ss = 0.f;
#pragma unroll
        for (int i = 0; i < 16; ++i) ss += f[i] * f[i];
        ss += __shfl_xor(ss, 1); ss += __shfl_xor(ss, 2); ss += __shfl_xor(ss, 4);
        const float rr = rsqrtf(ss * (1.f / 128.f) + EPS_) * (which ? 1.f : qscale);
#pragma unroll
        for (int i = 0; i < 16; ++i) f[i] = (f[i] * rr) * gn[i];
        a.x = cvt_pk(f[0], f[1]); a.y = cvt_pk(f[2], f[3]); a.z = cvt_pk(f[4], f[5]); a.w = cvt_pk(f[6], f[7]);
        b.x = cvt_pk(f[8], f[9]); b.y = cvt_pk(f[10], f[11]); b.z = cvt_pk(f[12], f[13]); b.w = cvt_pk(f[14], f[15]);
        *(u32x4*)ptr = a; *(u32x4*)(ptr + 8) = b;
    }
    const float* gate = (const float*)(ws + WS_GATE); float* F = (float*)(ws + WS_F);
    for (int sq = bid * 8 + wave; sq < 64; sq += nb * 8) {
        const int b = sq >> 3, h = sq & 7; const float fb = p.fox_fb[h];
        float v[32]; float run = 0.f;
#pragma unroll
        for (int i = 0; i < 32; ++i) { const int t = lane * 32 + i; run += logsig(gate[(size_t)(b * S_ + t) * 16 + h] + fb); v[i] = run; }
        float inc = run;
#pragma unroll
        for (int o = 1; o < 64; o <<= 1) { const float u = __shfl_up(inc, o); if (lane >= o) inc += u; }
        const float excl = inc - run;
#pragma unroll
        for (int i = 0; i < 32; ++i) F[(size_t)sq * S_ + lane * 32 + i] = v[i] + excl;
    }
}
__device__ __forceinline__ void fox_unit(const Params& p, unsigned char* lds, int b, int h, int qb) {
    const int tid = threadIdx.x, lane = tid & 63, wave = tid >> 6, r = lane & 31, hh = lane >> 5;
    unsigned char* ws = p.ws;
    const bf16_t* Pq = (const bf16_t*)(ws + WS_P); const bf16_t* Pk = (const bf16_t*)(ws + WS_P + SEG_B); const bf16_t* Pv = (const bf16_t*)(ws + WS_P + 2 * SEG_B);
    const float* F = (const float*)(ws + WS_F) + (size_t)(b * 8 + h) * S_;
    bf16_t* Oc = (bf16_t*)(ws + WS_H);
    bf16_t* Ks = (bf16_t*)lds;
    bf16_t* Vs = Ks + 64 * 136;
    float* Fs = (float*)(Vs + 128 * 72);
    const int q0w = qb * 256 + wave * 32, qs = q0w + r;
    const size_t trow = (size_t)(b * S_ + qs);
    bf16x8 qf[8];
#pragma unroll
    for (int ks = 0; ks < 8; ++ks) qf[ks] = *(const bf16x8*)(Pq + trow * 1024 + h * 128 + ks * 16 + hh * 8);
    const float Fq = F[qs];
    f32x16 o[4];
#pragma unroll
    for (int d = 0; d < 4; ++d)
#pragma unroll
        for (int i = 0; i < 16; ++i) o[d][i] = 0.f;
    float m = -INFINITY, l = 0.f;
    const int ntile = (qb * 256 + 256) / 64;
    for (int kt = 0; kt < ntile; ++kt) {
        const int k0 = kt * 64;
        __syncthreads();
#pragma unroll
        for (int i = 0; i < 2; ++i) { const int c = tid + NTHR * i, row = c >> 4, cc = c & 15;
            *(u32x4*)(Ks + row * 136 + cc * 8) = *(const u32x4*)(Pk + (size_t)(b * S_ + k0 + row) * 1024 + h * 128 + cc * 8); }
#pragma unroll
        for (int i = 0; i < 2; ++i) { const int c = tid + NTHR * i, key = c >> 4, cc = c & 15;
            const u32x4 w = *(const u32x4*)(Pv + (size_t)(b * S_ + k0 + key) * 1024 + h * 128 + cc * 8);
            bf16_t* vp = Vs + (cc * 8) * 72 + key;
            vp[0 * 72] = (bf16_t)(w.x & 0xffffu); vp[1 * 72] = (bf16_t)(w.x >> 16); vp[2 * 72] = (bf16_t)(w.y & 0xffffu); vp[3 * 72] = (bf16_t)(w.y >> 16);
            vp[4 * 72] = (bf16_t)(w.z & 0xffffu); vp[5 * 72] = (bf16_t)(w.z >> 16); vp[6 * 72] = (bf16_t)(w.w & 0xffffu); vp[7 * 72] = (bf16_t)(w.w >> 16); }
        if (tid < 64) Fs[tid] = F[k0 + tid];
        __syncthreads();
        if (k0 <= q0w + 31) {
            f32x16 s[2];
#pragma unroll
            for (int kb = 0; kb < 2; ++kb) {
#pragma unroll
                for (int i = 0; i < 16; ++i) s[kb][i] = 0.f;
#pragma unroll
                for (int ks = 0; ks < 8; ++ks) { const bf16x8 a = *(const bf16x8*)(Ks + (kb * 32 + r) * 136 + ks * 16 + hh * 8);
                    s[kb] = __builtin_amdgcn_mfma_f32_32x32x16_bf16(a, qf[ks], s[kb], 0, 0, 0); }
            }
            float mx = m;
#pragma unroll
            for (int kb = 0; kb < 2; ++kb)
#pragma unroll
                for (int i = 0; i < 16; ++i) { const int kl = kb * 32 + (i & 3) + 8 * (i >> 2) + 4 * hh; float val = s[kb][i] + Fq - Fs[kl];
                    if (k0 + kl > qs) val = -INFINITY; s[kb][i] = val; mx = fmaxf(mx, val); }
            mx = fmaxf(mx, __shfl_xor(mx, 32));
            const float alpha = __expf(m - mx);
            float ps = 0.f;
#pragma unroll
            for (int kb = 0; kb < 2; ++kb)
#pragma unroll
                for (int i = 0; i < 16; ++i) { const float pv = __expf(s[kb][i] - mx); s[kb][i] = pv; ps += pv; }
            l = l * alpha + ps; m = mx;
#pragma unroll
            for (int d = 0; d < 4; ++d)
#pragma unroll
                for (int i = 0; i < 16; ++i) o[d][i] *= alpha;
#pragma unroll
            for (int kb = 0; kb < 2; ++kb)
#pragma unroll
                for (int st = 0; st < 2; ++st) {
                    u32x4 pw; pw.x = cvt_pk(s[kb][8 * st + 0], s[kb][8 * st + 1]); pw.y = cvt_pk(s[kb][8 * st + 2], s[kb][8 * st + 3]);
                    pw.z = cvt_pk(s[kb][8 * st + 4], s[kb][8 * st + 5]); pw.w = cvt_pk(s[kb][8 * st + 6], s[kb][8 * st + 7]);
                    const bf16x8 pf = __builtin_bit_cast(bf16x8, pw);
#pragma unroll
                    for (int d = 0; d < 4; ++d) { const bf16_t* vp = Vs + (d * 32 + r) * 72 + kb * 32 + st * 16 + hh * 4;
                        const u32x2 lo = *(const u32x2*)vp, hi = *(const u32x2*)(vp + 8);
                        u32x4 vw; vw.x = lo.x; vw.y = lo.y; vw.z = hi.x; vw.w = hi.y;
                        o[d] = __builtin_amdgcn_mfma_f32_32x32x16_bf16(__builtin_bit_cast(bf16x8, vw), pf, o[d], 0, 0, 0); }
                }
        }
    }
    l += __shfl_xor(l, 32);
    const float inv = 1.f / l;
#pragma unroll
    for (int d = 0; d < 4; ++d)
#pragma unroll
        for (int g = 0; g < 4; ++g) { u32x2 w; w.x = cvt_pk(o[d][4 * g] * inv, o[d][4 * g + 1] * inv); w.y = cvt_pk(o[d][4 * g + 2] * inv, o[d][4 * g + 3] * inv);
            *(u32x2*)(Oc + trow * D_ + h * 128 + d * 32 + 8 * g + 4 * hh) = w; }
}

__device__ __forceinline__ void mlstm_passA(const Params& p, unsigned char* lds, int unit) {
    const int tid = threadIdx.x, lane = tid & 63, wave = tid >> 6;
    const int b = unit >> 5, h = (unit >> 3) & 3, vs = unit & 7;
    unsigned char* ws = p.ws;
    const bf16_t* Mk = (const bf16_t*)(ws + WS_P + 4 * SEG_B); const bf16_t* Mv = (const bf16_t*)(ws + WS_P + 5 * SEG_B);
    const float* gate = (const float*)(ws + WS_GATE);
    bf16_t* Cst = (bf16_t*)(ws + WS_CST); float* nst = (float*)(ws + WS_NST); float* mst = (float*)(ws + WS_MST);
    float* ksm = (float*)lds;
    float* vsm = ksm + 64 * 256;
    float* sc = vsm + 64 * 32;
    const int e = tid & 31, dg = tid >> 5;
    float c[16];
#pragma unroll
    for (int i = 0; i < 16; ++i) c[i] = 0.f;
    float nreg = 0.f, m = 0.f;
    const int ch = tid & 255, half = tid >> 8;
    const float cw0 = p.conv_w[0 * 2048 + 1024 + h * 256 + ch], cw1 = p.conv_w[1 * 2048 + 1024 + h * 256 + ch], cw2 = p.conv_w[2 * 2048 + 1024 + h * 256 + ch], cw3 = p.conv_w[3 * 2048 + 1024 + h * 256 + ch];
    const float cb = p.conv_b[1024 + h * 256 + ch];
    const float ib = p.m_ib[h], fb = p.m_fb[h];
    for (int cc = 0; cc < 32; ++cc) {
        const int bhc = (b * 4 + h) * 32 + cc;
        const int t0 = b * S_ + cc * 64;
#pragma unroll
        for (int i = 0; i < 16; ++i) Cst[((size_t)bhc * 256 + dg * 16 + i) * 256 + vs * 32 + e] = (bf16_t)(cvt_pk(c[i], 0.f) & 0xffffu);
        if (vs == 0 && tid < 256) nst[(size_t)bhc * 256 + tid] = nreg;
        if (vs == 0 && tid == 0) mst[bhc] = m;
        if (cc == 31) break;
        __syncthreads();
        if (wave == 0) {
            const float ipre = gate[(size_t)(t0 + lane) * 16 + 8 + h] + ib, fpre = gate[(size_t)(t0 + lane) * 16 + 12 + h] + fb;
            float bc = logsig(fpre);
#pragma unroll
            for (int o = 1; o < 64; o <<= 1) { const float u = __shfl_up(bc, o); if (lane >= o) bc += u; }
            const float a = ipre - bc; const float amax = wmax(a); const float bL = __shfl(bc, 63);
            const float mnew = bL + fmaxf(m, amax);
            sc[lane] = expf(bL + a - mnew);
            if (lane == 0) { sc[64] = expf(bL + m - mnew); sc[65] = mnew; }
        }
        __syncthreads();
        {
            const int s0 = half * 32; const int sp = cc * 64 + s0;
            const bf16_t* src = Mk + (size_t)(t0 + s0) * 1024 + h * 256 + ch;
            float x0 = sp >= 3 ? bf2f(*(src - 3 * 1024)) : 0.f, x1 = sp >= 2 ? bf2f(*(src - 2 * 1024)) : 0.f, x2 = sp >= 1 ? bf2f(*(src - 1 * 1024)) : 0.f;
            for (int s = 0; s < 32; ++s) { const float x3 = bf2f(src[(size_t)s * 1024]);
                const float y = silu_f(cw0 * x0 + cw1 * x1 + cw2 * x2 + cw3 * x3 + cb);
                ksm[(s0 + s) * 256 + ch] = y * 0.0625f * sc[s0 + s]; x0 = x1; x1 = x2; x2 = x3; }
        }
#pragma unroll
        for (int i = 0; i < 4; ++i) { const int idx = tid + NTHR * i, s = idx >> 5, ee = idx & 31; vsm[idx] = bf2f(Mv[(size_t)(t0 + s) * 1024 + h * 256 + vs * 32 + ee]); }
        __syncthreads();
        const float decay = sc[64]; m = sc[65];
#pragma unroll
        for (int i = 0; i < 16; ++i) c[i] *= decay;
        for (int s = 0; s < 64; ++s) { const float vv = vsm[s * 32 + e]; const f32x4* kp = (const f32x4*)(ksm + s * 256 + dg * 16);
#pragma unroll
            for (int j = 0; j < 4; ++j) { const f32x4 kv = kp[j]; c[4 * j] += kv[0] * vv; c[4 * j + 1] += kv[1] * vv; c[4 * j + 2] += kv[2] * vv; c[4 * j + 3] += kv[3] * vv; } }
        if (tid < 256) { nreg *= decay; for (int s = 0; s < 64; ++s) nreg += ksm[s * 256 + tid]; }
    }
}

__device__ __forceinline__ void mlstm_passB(const Params& p, unsigned char* lds, int unit) {
    const int tid = threadIdx.x, lane = tid & 63, wave = tid >> 6;
    const int b = unit >> 7, h = (unit >> 5) & 3, cc = unit & 31;
    unsigned char* ws = p.ws;
    const bf16_t* Mq = (const bf16_t*)(ws + WS_P + 3 * SEG_B); const bf16_t* Mk = (const bf16_t*)(ws + WS_P + 4 * SEG_B);
    const bf16_t* Mv = (const bf16_t*)(ws + WS_P + 5 * SEG_B); const bf16_t* Mo = (const bf16_t*)(ws + WS_P + 6 * SEG_B);
    const float* gate = (const float*)(ws + WS_GATE);
    const bf16_t* Cst = (const bf16_t*)(ws + WS_CST); const float* nst = (const float*)(ws + WS_NST); const float* mst = (const float*)(ws + WS_MST);
    bf16_t* Oc = (bf16_t*)(ws + WS_H);
    float* qT = (float*)lds;
    float* kR = qT + 256 * 64;
    float* WT = kR + 64 * 257;
    float* sc = WT + 64 * 64;
    float* red = sc + 384;
    const int bhc = (b * 4 + h) * 32 + cc, t0 = b * S_ + cc * 64;
    __syncthreads();
    if (wave == 0) {
        const float ipre = gate[(size_t)(t0 + lane) * 16 + 8 + h] + p.m_ib[h], fpre = gate[(size_t)(t0 + lane) * 16 + 12 + h] + p.m_fb[h];
        float bc = logsig(fpre);
#pragma unroll
        for (int o = 1; o < 64; o <<= 1) { const float u = __shfl_up(bc, o); if (lane >= o) bc += u; }
        const float a = ipre - bc; float pm = a;
#pragma unroll
        for (int o = 1; o < 64; o <<= 1) { const float u = __shfl_up(pm, o); if (lane >= o) pm = fmaxf(pm, u); }
        const float mc = mst[bhc]; const float mt = bc + fmaxf(mc, pm);
        sc[lane] = bc; sc[64 + lane] = a; sc[128 + lane] = mt; sc[192 + lane] = expf(bc + mc - mt);
    }
    {
        const int ch = tid & 255, half = tid >> 8, s0 = half * 32, sp = cc * 64 + s0;
#pragma unroll
        for (int which = 0; which < 2; ++which) {
            const int cidx = which * 1024 + h * 256 + ch;
            const float cw0 = p.conv_w[cidx], cw1 = p.conv_w[2048 + cidx], cw2 = p.conv_w[4096 + cidx], cw3 = p.conv_w[6144 + cidx], cb = p.conv_b[cidx];
            const bf16_t* src = (which ? Mk : Mq) + (size_t)(t0 + s0) * 1024 + h * 256 + ch;
            float x0 = sp >= 3 ? bf2f(*(src - 3 * 1024)) : 0.f, x1 = sp >= 2 ? bf2f(*(src - 2 * 1024)) : 0.f, x2 = sp >= 1 ? bf2f(*(src - 1 * 1024)) : 0.f;
            for (int s = 0; s < 32; ++s) { const float x3 = bf2f(src[(size_t)s * 1024]);
                const float y = silu_f(cw0 * x0 + cw1 * x1 + cw2 * x2 + cw3 * x3 + cb);
                if (which) kR[(s0 + s) * 257 + ch] = y * 0.0625f; else qT[ch * 64 + s0 + s] = y;
                x0 = x1; x1 = x2; x2 = x3; }
        }
    }
    __syncthreads();
    {
        float acc[8];
#pragma unroll
        for (int i = 0; i < 8; ++i) acc[i] = 0.f;
        for (int d = 0; d < 256; ++d) { const float kv = kR[lane * 257 + d]; const f32x4 q0 = *(const f32x4*)(qT + d * 64 + wave * 8), q1 = *(const f32x4*)(qT + d * 64 + wave * 8 + 4);
            acc[0] += q0[0] * kv; acc[1] += q0[1] * kv; acc[2] += q0[2] * kv; acc[3] += q0[3] * kv; acc[4] += q1[0] * kv; acc[5] += q1[1] * kv; acc[6] += q1[2] * kv; acc[7] += q1[3] * kv; }
        const float as = sc[64 + lane];
#pragma unroll
        for (int i = 0; i < 8; ++i) { const int l = wave * 8 + i; const float w = (lane <= l) ? acc[i] * expf(sc[l] + as - sc[128 + l]) : 0.f;
            WT[lane * 64 + l] = w; const float rs = wsum(w); if (lane == 0) sc[256 + l] = rs; }
    }
    __syncthreads();
    if (wave == 0) {
        float qn = 0.f; const float* np = nst + (size_t)bhc * 256;
        for (int d = 0; d < 256; ++d) qn += qT[d * 64 + lane] * np[d];
        const float den = sc[256 + lane] + sc[192 + lane] * qn;
        sc[320 + lane] = fmaxf(fabsf(den), expf(-sc[128 + lane]));
    }
    {
        const int e = tid & 255, lh = tid >> 8;
        float acc[32];
#pragma unroll
        for (int i = 0; i < 32; ++i) acc[i] = 0.f;
        const bf16_t* cp = Cst + (size_t)bhc * 65536 + e;
        for (int d = 0; d < 256; ++d) { const float cv = bf2f(cp[(size_t)d * 256]); const f32x4* qp = (const f32x4*)(qT + d * 64 + lh * 32);
#pragma unroll
            for (int j = 0; j < 8; ++j) { const f32x4 qv = qp[j]; acc[4 * j] += qv[0] * cv; acc[4 * j + 1] += qv[1] * cv; acc[4 * j + 2] += qv[2] * cv; acc[4 * j + 3] += qv[3] * cv; } }
#pragma unroll
        for (int i = 0; i < 32; ++i) acc[i] *= sc[192 + lh * 32 + i];
        for (int s = 0; s < 64; ++s) { const float vv = bf2f(Mv[(size_t)(t0 + s) * 1024 + h * 256 + e]); const f32x4* wp = (const f32x4*)(WT + s * 64 + lh * 32);
#pragma unroll
            for (int j = 0; j < 8; ++j) { const f32x4 wv = wp[j]; acc[4 * j] += wv[0] * vv; acc[4 * j + 1] += wv[1] * vv; acc[4 * j + 2] += wv[2] * vv; acc[4 * j + 3] += wv[3] * vv; } }
        __syncthreads();
#pragma unroll
        for (int i = 0; i < 32; ++i) { acc[i] = acc[i] / sc[320 + lh * 32 + i]; const float ss = wsum(acc[i] * acc[i]); if (lane == 0) red[(lh * 32 + i) * 4 + (wave & 3)] = ss; }
        __syncthreads();
        const float hg = p.m_hg[h * 256 + e];
#pragma unroll
        for (int i = 0; i < 32; ++i) { const int l = lh * 32 + i; const f32x4 rv = *(const f32x4*)(red + l * 4);
            const float rr = rsqrtf((rv[0] + rv[1] + rv[2] + rv[3]) * (1.f / 256.f) + EPS_);
            const float og = sigm(bf2f(Mo[(size_t)(t0 + l) * 1024 + h * 256 + e]));
            Oc[(size_t)(t0 + l) * D_ + 1024 + h * 256 + e] = (bf16_t)(cvt_pk(acc[i] * rr * hg * og, 0.f) & 0xffffu); }
    }
}
__device__ __forceinline__ void argmax_step(float& bv, int& bi) {
#pragma unroll
    for (int o = 32; o; o >>= 1) { const float ov = __shfl_xor(bv, o); const int oi = __shfl_xor(bi, o); if (ov > bv || (ov == bv && oi < bi)) { bv = ov; bi = oi; } }
}
__device__ __forceinline__ void top16_of_128(float va, float vb, int lane, float& outv, int& outi) {
    outv = 0.f; outi = 0;
    for (int r = 0; r < 16; ++r) {
        float bv; int bi; if (va >= vb) { bv = va; bi = lane; } else { bv = vb; bi = lane + 64; }
        argmax_step(bv, bi);
        if (lane == r) { outv = bv; outi = bi; }
        if (bi == lane) va = -INFINITY; else if (bi == lane + 64) vb = -INFINITY;
    }
}
__device__ __forceinline__ void phase_topk(const Params& p, unsigned char* lds, int bid, int nb) {
    const int tid = threadIdx.x, lane = tid & 63, wave = tid >> 6;
    unsigned char* ws = p.ws;
    const bf16_t* Q = (const bf16_t*)(ws + WS_Q); int* IDX = (int*)(ws + WS_IDX); float* GW = (float*)(ws + WS_GW);
    float* K1t = (float*)lds; float* K2t = K1t + 128 * 128;
    for (int i = tid; i < 16384; i += NTHR) { const int n = i >> 7, d = i & 127; K1t[d * 128 + n] = p.sk1[i]; K2t[d * 128 + n] = p.sk2[i]; }
    __syncthreads();
    for (int item = bid * 8 + wave; item < T_ * 8; item += nb * 8) {
        const int t = item >> 3, hh = item & 7;
        const u32x2 qw = *(const u32x2*)(Q + (size_t)t * D_ + hh * 256 + lane * 4);
        float qv[4]; qv[0] = bflo(qw.x); qv[1] = bfhi(qw.x); qv[2] = bflo(qw.y); qv[3] = bfhi(qw.y);
        float s1a = 0.f, s1b = 0.f, s2a = 0.f, s2b = 0.f;
#pragma unroll 2
        for (int L = 0; L < 32; ++L)
#pragma unroll
            for (int c = 0; c < 4; ++c) { const int d = L * 4 + c; const float q1 = __shfl(qv[c], L), q2 = __shfl(qv[c], L + 32);
                s1a += q1 * K1t[d * 128 + lane]; s1b += q1 * K1t[d * 128 + 64 + lane]; s2a += q2 * K2t[d * 128 + lane]; s2b += q2 * K2t[d * 128 + 64 + lane]; }
        float v1, v2; int i1, i2;
        top16_of_128(s1a, s1b, lane, v1, i1);
        top16_of_128(s2a, s2b, lane, v2, i2);
        float cand[4];
        const float a1 = __shfl(v1, lane >> 2);
#pragma unroll
        for (int c = 0; c < 4; ++c) cand[c] = a1 + __shfl(v2, (lane & 3) * 4 + c);
        float vs = 0.f; int ps = 0;
        for (int r = 0; r < 16; ++r) {
            float bv = cand[0]; int bi = lane * 4;
#pragma unroll
            for (int c = 1; c < 4; ++c) if (cand[c] > bv) { bv = cand[c]; bi = lane * 4 + c; }
            argmax_step(bv, bi);
            if (lane == r) { vs = bv; ps = bi; }
#pragma unroll
            for (int c = 0; c < 4; ++c) if (bi == lane * 4 + c) cand[c] = -INFINITY;
        }
        const int e1 = __shfl(i1, ps >> 4), e2 = __shfl(i2, ps & 15);
        const float mx = __shfl(vs, 0);
        const float ex = lane < 16 ? expf(vs - mx) : 0.f;
        const float sum = wsum(ex);
        if (lane < 16) { IDX[(size_t)t * 128 + hh * 16 + lane] = e1 * 128 + e2; GW[(size_t)t * 128 + hh * 16 + lane] = ex / sum; }
    }
}

__device__ __forceinline__ void phase_peer(const Params& p, int bid, int nb) {
    const int tid = threadIdx.x, lane = tid & 63, wave = tid >> 6;
    unsigned char* ws = p.ws;
    const bf16_t* H2 = (const bf16_t*)(ws + WS_H2); const int* IDX = (const int*)(ws + WS_IDX); const float* GW = (const float*)(ws + WS_GW);
    const float* mod = (const float*)(ws + WS_MOD);
    for (int t = bid * 8 + wave; t < T_; t += nb * 8) {
        f32x4 hv[8], acc[8];
#pragma unroll
        for (int j = 0; j < 8; ++j) { const u32x2 w = *(const u32x2*)(H2 + (size_t)t * D_ + 4 * (lane + 64 * j)); hv[j][0] = bflo(w.x); hv[j][1] = bfhi(w.x); hv[j][2] = bflo(w.y); hv[j][3] = bfhi(w.y);
            acc[j] = (f32x4){0.f, 0.f, 0.f, 0.f}; }
        const int myidx0 = IDX[(size_t)t * 128 + lane], myidx1 = IDX[(size_t)t * 128 + 64 + lane];
        const float myg0 = GW[(size_t)t * 128 + lane], myg1 = GW[(size_t)t * 128 + 64 + lane];
        for (int i = 0; i < 128; ++i) {
            const int e = __shfl(i < 64 ? myidx0 : myidx1, i & 63); const float g = __shfl(i < 64 ? myg0 : myg1, i & 63);
            const f32x4* dp = (const f32x4*)(p.e_down + (size_t)e * D_);
            float dot = 0.f;
#pragma unroll
            for (int j = 0; j < 8; ++j) { const f32x4 dv = dp[lane + 64 * j]; dot += dv[0] * hv[j][0] + dv[1] * hv[j][1] + dv[2] * hv[j][2] + dv[3] * hv[j][3]; }
            dot = wsum(dot);
            const float w = g * 0.5f * dot * (1.f + erff(dot * 0.7071067811865476f));
            const f32x4* up = (const f32x4*)(p.e_up + (size_t)e * D_);
#pragma unroll
            for (int j = 0; j < 8; ++j) { const f32x4 uv = up[lane + 64 * j]; acc[j] += uv * w; }
        }
        const float* g2 = mod + (size_t)(t >> 11) * NMOD + 5 * D_;
#pragma unroll
        for (int j = 0; j < 8; ++j) { const int k = 4 * (lane + 64 * j); f32x4* op = (f32x4*)(p.out + (size_t)t * D_ + k); const f32x4 gv = *(const f32x4*)(g2 + k);
            *op = *op + gv * acc[j]; }
    }
}
constexpr int N_PHASES = 11;
constexpr int LDS_BYTES = 152 * 1024;
__global__ void __launch_bounds__(NTHR) fwd_kernel(Params p) {
    extern __shared__ __attribute__((aligned(16))) unsigned char lds[];
    const int bid = blockIdx.x, nb = gridDim.x, tid = threadIdx.x;
    unsigned char* ws = p.ws;
    volatile LAS unsigned* xbst = (volatile LAS unsigned*)((LAS unsigned char*)lds + LDS_BYTES - 16);
    if (tid == 0) { xbst[0] = 0u; xbst[1] = 0u; xbst[2] = 0u; xbst[3] = 0u; }
    __syncthreads();
    XcdBarrier bar; bar.bar = (unsigned*)(ws + WS_BAR); bar.x = 0; bar.st = xbst;
    const bool multi = (p.ph_hi - p.ph_lo) > 1;
    if (multi) bar = xcd_barrier_post((unsigned*)(ws + WS_BAR), xbst);
    const float* mod = (const float*)(ws + WS_MOD);
    const int lo = p.ph_lo, hi = p.ph_hi;
#ifdef ONLY_PHASE
#define IN(k) ((k) == ONLY_PHASE && lo <= (k) && (k) < hi)
#else
#define IN(k) (lo <= (k) && (k) < hi)
#endif
#define SEAM(k) do { if (lo <= (k) && (k) + 1 < hi) xcd_barrier(bar); } while (0)
    if (IN(0)) phase_prep(p, lds, bid, nb);
    SEAM(0);
    if (IN(1)) phase_norm<true>(p.x, p.g1, mod, 0, D_, (bf16_t*)(ws + WS_H), (const float*)(ws + WS_WG), (float*)(ws + WS_GATE), bid, nb);
    SEAM(1);
    if (IN(2)) { pg8::Gemm g{(const bf16_t*)(ws + WS_H), (const bf16_t*)(ws + WS_WINT), T_, 7168, D_}; pg8::StaticOrder S; S.init(T_, 7168, nb, bid);
        pg8::EpiSeg E{(bf16_t*)(ws + WS_P)}; pg8::gemm_phase<pg8::EpiSeg, pg8::StaticOrder, true, true>((LAS unsigned char*)lds, g, S, E); }
    SEAM(2);
    if (IN(3)) phase_post(p, bid, nb);
    SEAM(3);
    if (IN(4)) { for (int u = bid; u < 256; u += nb) mlstm_passA(p, lds, u);
        for (int u = bid; u < 256; u += nb) { fox_unit(p, lds, (u & 63) >> 3, u & 7, u >> 6); const int v = 511 - u; fox_unit(p, lds, (v & 63) >> 3, v & 7, v >> 6); } }
    SEAM(4);
    if (IN(5)) { for (int u = bid; u < 1024; u += nb) mlstm_passB(p, lds, u); }
    SEAM(5);
    if (IN(6)) { pg8::Gemm g{(const bf16_t*)(ws + WS_H), (const bf16_t*)(ws + WS_WOT), T_, D_, D_}; pg8::StaticOrder S; S.init(T_, D_, nb, bid);
        pg8::EpiRes E{p.x, p.out, mod, 2 * D_}; pg8::gemm_phase<pg8::EpiRes, pg8::StaticOrder, true, true>((LAS unsigned char*)lds, g, S, E); }
    SEAM(6);
    if (IN(7)) phase_norm<false>(p.out, p.g2, mod, 3 * D_, 4 * D_, (bf16_t*)(ws + WS_H2), nullptr, nullptr, bid, nb);
    SEAM(7);
    if (IN(8)) { pg8::Gemm g{(const bf16_t*)(ws + WS_H2), (const bf16_t*)(ws + WS_WQT), T_, D_, D_}; pg8::StaticOrder S; S.init(T_, D_, nb, bid);
        pg8::EpiBf E{(bf16_t*)(ws + WS_Q), D_}; pg8::gemm_phase<pg8::EpiBf, pg8::StaticOrder, true, true>((LAS unsigned char*)lds, g, S, E); }
    SEAM(8);
    if (IN(9)) phase_topk(p, lds, bid, nb);
    SEAM(9);
    if (IN(10)) phase_peer(p, bid, nb);
#undef IN
#undef SEAM
}

#ifndef ONE_LAUNCH
#define ONE_LAUNCH 1
#endif
extern "C" void kernel_launch(void* const* d_in, const int* in_sizes, int n_in, void* d_out, int out_size, void* d_ws, size_t ws_size, hipStream_t stream) {
    static int grid = 0;
    if (grid == 0) {
        int dev = 0, cus = 0, per_cu = 0;
        if (n_in != 21 || ws_size < WS_END) { fprintf(stderr, "kernel_launch: unexpected n_in %d / ws_size %zu (need %zu)\n", n_in, ws_size, (size_t)WS_END); grid = -1; return; }
        hipGetDevice(&dev); hipDeviceGetAttribute(&cus, hipDeviceAttributeMultiprocessorCount, dev);
        if (hipFuncSetAttribute((const void*)fwd_kernel, hipFuncAttributeMaxDynamicSharedMemorySize, LDS_BYTES) != hipSuccess) { fprintf(stderr, "kernel_launch: hipFuncSetAttribute failed\n"); grid = -1; return; }
        if (hipOccupancyMaxActiveBlocksPerMultiprocessor(&per_cu, (const void*)fwd_kernel, NTHR, LDS_BYTES) != hipSuccess || per_cu < 1) { fprintf(stderr, "kernel_launch: occupancy query says %d\n", per_cu); (void)hipGetLastError(); }
        grid = cus > 0 ? cus : 256;
    }
    if (grid < 0) return;
    Params p{};
    const float** pp = (const float**)&p;
    for (int i = 0; i < 21; ++i) pp[i] = (const float*)d_in[i];
    p.out = (float*)d_out; p.ws = (unsigned char*)d_ws;
    hipMemsetAsync((char*)d_ws + WS_BAR, 0, 16384, stream);
#if ONE_LAUNCH
    p.ph_lo = 0; p.ph_hi = N_PHASES;
    void* args[] = {&p};
    hipError_t e = hipLaunchCooperativeKernel((const void*)fwd_kernel, dim3(grid), dim3(NTHR), args, LDS_BYTES, stream);
    if (e != hipSuccess) fprintf(stderr, "cooperative launch failed: %s (grid %d)\n", hipGetErrorString(e), grid);
#else
    for (int ph = 0; ph < N_PHASES; ++ph) { p.ph_lo = ph; p.ph_hi = ph + 1; hipLaunchKernelGGL(fwd_kernel, dim3(grid), dim3(NTHR), LDS_BYTES, stream, p); }
#endif
}
```

```cpp
#include <hip/hip_runtime.h>
#include <cstdio>
#include <cstdint>

#define GAS __attribute__((address_space(1)))
#define LAS __attribute__((address_space(3)))
typedef unsigned short bf16_t;
typedef short bf16x8 __attribute__((ext_vector_type(8)));
typedef float f32x4 __attribute__((ext_vector_type(4)));
typedef float f32x16 __attribute__((ext_vector_type(16)));
typedef unsigned u32x4 __attribute__((ext_vector_type(4)));
typedef unsigned u32x2 __attribute__((ext_vector_type(2)));

constexpr int T_ = 16384, D_ = 2048, B_ = 8, S_ = 2048, NTHR = 512;
constexpr float EPS_ = 1e-6f;
constexpr int NMOD = 6 * D_;
constexpr int INCOLS = 7184;

constexpr size_t WS_BAR   = 0;
constexpr size_t WS_MOD   = 16384;
constexpr size_t WS_WG    = WS_MOD + (size_t)B_ * NMOD * 4;
constexpr size_t WS_GATE  = WS_WG + 16 * 2048 * 4;
constexpr size_t WS_F     = WS_GATE + (size_t)T_ * 16 * 4;
constexpr size_t WS_NST   = WS_F + 64 * 2048 * 4;
constexpr size_t WS_MST   = WS_NST + 1024 * 256 * 4;
constexpr size_t WS_WINT  = WS_MST + 4096;
constexpr size_t WS_WOT   = WS_WINT + (size_t)7168 * 2048 * 2;
constexpr size_t WS_WQT   = WS_WOT + (size_t)2048 * 2048 * 2;
constexpr size_t WS_H     = WS_WQT + (size_t)2048 * 2048 * 2;
constexpr size_t WS_P     = WS_H + (size_t)T_ * 2048 * 2;
constexpr size_t SEG_B    = (size_t)T_ * 1024 * 2;
constexpr size_t WS_CST   = WS_P + 7 * SEG_B;
constexpr size_t WS_E8D   = WS_CST + (size_t)1024 * 256 * 256 * 2;
constexpr size_t WS_E8U   = WS_E8D + (size_t)16384 * 2048;
constexpr size_t WS_END   = WS_E8U + (size_t)16384 * 2048;
constexpr size_t WS_H2    = WS_P;
constexpr size_t WS_Q     = WS_H2 + (size_t)T_ * 2048 * 2;
constexpr size_t WS_IDX   = WS_Q + (size_t)T_ * 2048 * 2;
constexpr size_t WS_GW    = WS_IDX + (size_t)T_ * 128 * 4;
static_assert(WS_GW + (size_t)T_ * 128 * 4 <= WS_CST, "alias overflow");

struct Params {
    const float *x, *c, *w_ada, *b_ada, *g1, *g2, *w_in, *fox_fb, *fox_qg, *fox_kg, *conv_w, *conv_b, *m_ib, *m_fb, *m_hg, *w_out, *w_q, *sk1, *sk2, *e_down, *e_up;
    float* out; unsigned char* ws; int ph_lo, ph_hi;
};

__device__ __forceinline__ unsigned cvt_pk(float lo, float hi) { unsigned r; asm("v_cvt_pk_bf16_f32 %0, %1, %2" : "=v"(r) : "v"(lo), "v"(hi)); return r; }
__device__ __forceinline__ float bf2f(unsigned short h) { return __builtin_bit_cast(float, ((unsigned)h) << 16); }
__device__ __forceinline__ float bflo(unsigned w) { return __builtin_bit_cast(float, w << 16); }
__device__ __forceinline__ float bfhi(unsigned w) { return __builtin_bit_cast(float, w & 0xffff0000u); }
__device__ __forceinline__ float wsum(float v) {
#pragma unroll
    for (int o = 32; o; o >>= 1) v += __shfl_xor(v, o);
    return v; }
__device__ __forceinline__ float wmax(float v) {
#pragma unroll
    for (int o = 32; o; o >>= 1) v = fmaxf(v, __shfl_xor(v, o));
    return v; }
__device__ __forceinline__ float logsig(float x) { return fminf(x, 0.f) - log1pf(expf(-fabsf(x))); }
__device__ __forceinline__ float sigm(float x) { return 1.f / (1.f + expf(-x)); }
__device__ __forceinline__ float silu_f(float x) { return x / (1.f + expf(-x)); }
namespace pg8 {
#define PG8_LAS __attribute__((address_space(3)))
typedef unsigned short bf16_t;
typedef short bf16x8 __attribute__((ext_vector_type(8)));
typedef float f32x4 __attribute__((ext_vector_type(4)));
typedef unsigned u32x4 __attribute__((ext_vector_type(4)));
constexpr int BM = 256, BK = 64, HALF = 128, HTB = HALF * BK * 2  , STAGE_BYTES = 8 * HTB, NXCD = 8, WGM = 8;

__host__ __device__ __forceinline__ int lds_byte(int r, int c) { const int st = (r >> 4) * 2 + (c >> 5), rr = r & 15, cc = c & 31, ob = rr * 64 + cc * 2; return st * 1024 + (ob ^ (((ob >> 9) & 1) << 5)); }
__host__ __device__ __forceinline__ void stage_rc(int b, int& R, int& C) { const int st = b / 1024, sb = b % 1024, swz = sb ^ (((sb >> 9) & 1) << 5); R = (st >> 1) * 16 + swz / 64; C = (st & 1) * 32 + (swz % 64) / 2; }
__host__ __device__ __forceinline__ int perm32(int rho) { const int n = rho >> 4, i = rho & 15; return 8 * (i >> 2) + 4 * n + (i & 3); }

struct Unit { int pm, pn; };
struct Gemm { const bf16_t* A; const bf16_t* Bt; int M, N, K; };

struct StaticOrder {
    int nM, nN, nwg, G, c;
    __host__ __device__ void init(int M, int N, int G_, int c_) { nM = M / BM; nN = N / BM; nwg = nM * nN; G = G_; c = c_; }
    __host__ __device__ bool next(int i, Unit& u) const {
        const long L = (long)i * G + c; if (L >= nwg) return false;
        int wgid = (int)L; { const int q = nwg / NXCD, r = nwg % NXCD, xcd = wgid % NXCD, off = wgid / NXCD; wgid = (xcd < r ? xcd * (q + 1) : r * (q + 1) + (xcd - r) * q) + off; }
        const int nig = WGM * nN, gid = wgid / nig, fm = gid * WGM, gsz = (nM - fm) < WGM ? (nM - fm) : WGM;
        u.pm = fm + ((wgid % nig) % gsz); u.pn = (wgid % nig) / gsz; return true;
    }
    __device__ __forceinline__ void a_ready(const Unit&) const {}
    __device__ __forceinline__ void done(const Unit&) const {}
};
struct EpiSeg {
    static constexpr bool PERM = true, AFTER_DRAIN = false;
    bf16_t* P;
    __device__ __forceinline__ void operator()(const f32x4 (&acc)[2][2][4][2], const Unit& u, int wr, int wc, int fr, int fq) const {
        const int seg = u.pn >> 2; bf16_t* base = P + (size_t)seg * ((size_t)T_ * 1024);
        const int row0 = u.pm * BM + wr * 64 + fr, col0 = (u.pn & 3) * 256 + wc * 32 + 8 * fq;
#pragma unroll
        for (int ai = 0; ai < 2; ++ai)
#pragma unroll
            for (int m = 0; m < 4; ++m) { bf16_t* rowp = base + (size_t)(row0 + ai * HALF + m * 16) * 1024 + col0;
#pragma unroll
                for (int bj = 0; bj < 2; ++bj) { const f32x4 v0 = acc[ai][bj][m][0], v1 = acc[ai][bj][m][1];
                    u32x4 w; w.x = cvt_pk(v0[0], v0[1]); w.y = cvt_pk(v0[2], v0[3]); w.z = cvt_pk(v1[0], v1[1]); w.w = cvt_pk(v1[2], v1[3]);
                    *(u32x4*)(rowp + bj * HALF) = w; } }
    }
};
struct EpiBf {
    static constexpr bool PERM = true, AFTER_DRAIN = false;
    bf16_t* O; int ldc;
    __device__ __forceinline__ void operator()(const f32x4 (&acc)[2][2][4][2], const Unit& u, int wr, int wc, int fr, int fq) const {
        const int row0 = u.pm * BM + wr * 64 + fr, col0 = u.pn * BM + wc * 32 + 8 * fq;
#pragma unroll
        for (int ai = 0; ai < 2; ++ai)
#pragma unroll
            for (int m = 0; m < 4; ++m) { bf16_t* rowp = O + (size_t)(row0 + ai * HALF + m * 16) * ldc + col0;
#pragma unroll
                for (int bj = 0; bj < 2; ++bj) { const f32x4 v0 = acc[ai][bj][m][0], v1 = acc[ai][bj][m][1];
                    u32x4 w; w.x = cvt_pk(v0[0], v0[1]); w.y = cvt_pk(v0[2], v0[3]); w.z = cvt_pk(v1[0], v1[1]); w.w = cvt_pk(v1[2], v1[3]);
                    *(u32x4*)(rowp + bj * HALF) = w; } }
    }
};
struct EpiRes {
    static constexpr bool PERM = false, AFTER_DRAIN = false;
    const float* X; float* O; const float* mod; int goff;
    __device__ __forceinline__ void operator()(const f32x4 (&acc)[2][2][4][2], const Unit& u, int wr, int wc, int fr, int fq) const {
        const int row0 = u.pm * BM + wr * 64 + fr, col0 = u.pn * BM + wc * 32 + 4 * fq;
        const float* gp = mod + (size_t)((u.pm * BM) >> 11) * NMOD + goff + col0;
        f32x4 gv[2][2];
#pragma unroll
        for (int bj = 0; bj < 2; ++bj)
#pragma unroll
            for (int n = 0; n < 2; ++n) gv[bj][n] = *(const f32x4*)(gp + bj * HALF + 16 * n);
#pragma unroll
        for (int ai = 0; ai < 2; ++ai)
#pragma unroll
            for (int m = 0; m < 4; ++m) { const size_t ro = (size_t)(row0 + ai * HALF + m * 16) * D_ + col0;
#pragma unroll
                for (int bj = 0; bj < 2; ++bj)
#pragma unroll
                    for (int n = 0; n < 2; ++n) { const f32x4 xv = *(const f32x4*)(X + ro + bj * HALF + 16 * n);
                        *(f32x4*)(O + ro + bj * HALF + 16 * n) = xv + gv[bj][n] * acc[ai][bj][m][n]; } }
    }
};
template <class Epi, class Sched, bool ALIGN_EPI = false, bool SP2 = false>
__device__ __forceinline__ void gemm_phase(PG8_LAS unsigned char* lds, const Gemm g, const Sched& S, const Epi& E) {
    const int tid = threadIdx.x, wid = __builtin_amdgcn_readfirstlane(tid >> 6), lane = tid & 63, wr = wid >> 2, wc = wid & 3, fr = lane & 15, fq = lane >> 4;
    const int K = g.K, nt = K / BK;
    unsigned voffA[2], voffB[2];
#pragma unroll
    for (int i = 0; i < 2; ++i) { int R, C; stage_rc(tid * 16 + i * 8192, R, C); const int Rb = Epi::PERM ? ((R & ~31) + perm32(R & 31)) : R;
        voffA[i] = (unsigned)(R * K + C) * 2u; voffB[i] = (unsigned)(Rb * K + C) * 2u; }
    const size_t kstep = (size_t)(BK * 2);
    const size_t hstep = (size_t)HALF * K * 2;
    const size_t tstep = 2 * hstep;
    const unsigned ldsw = (unsigned)wid * 1024u;
    const int aoff = lds_byte(wr * 64 + fr, fq * 8), boff = lds_byte(wc * 32 + fr, fq * 8);
#define PG8_SA(b, h) (((b) * 2 + (h)) * HTB)
#define PG8_SB(b, h) ((4 + (b) * 2 + (h)) * HTB)
#define PG8_STAGE(bufoff, gbase, voff) do { _Pragma("unroll") for (int _i = 0; _i < 2; ++_i) \
        __builtin_amdgcn_global_load_lds((const unsigned*)((const char*)(gbase) + (voff)[_i]), (PG8_LAS unsigned*)(lds + (bufoff) + ldsw + _i * 8192), 16, 0, 0); } while (0)
#define PG8_LDA(dst, b, h) do { _Pragma("unroll") for (int m = 0; m < 4; ++m) _Pragma("unroll") for (int k = 0; k < 2; ++k) dst[m][k] = *(const PG8_LAS bf16x8*)(lds + PG8_SA(b, h) + aoff + m * 2048 + k * 1024); } while (0)
#define PG8_LDB(dst, b, h) do { _Pragma("unroll") for (int n = 0; n < 2; ++n) _Pragma("unroll") for (int k = 0; k < 2; ++k) dst[n][k] = *(const PG8_LAS bf16x8*)(lds + PG8_SB(b, h) + boff + n * 2048 + k * 1024); } while (0)
#define PG8_MMA(ai, bj, At, Bt) do { __builtin_amdgcn_s_setprio(1); _Pragma("unroll") for (int m = 0; m < 4; ++m) _Pragma("unroll") for (int n = 0; n < 2; ++n) _Pragma("unroll") for (int k = 0; k < 2; ++k) \
        acc[ai][bj][m][n] = __builtin_amdgcn_mfma_f32_16x16x32_bf16(Bt[n][k], At[m][k], acc[ai][bj][m][n], 0, 0, 0); __builtin_amdgcn_s_setprio(0); } while (0)
#define PG8_WAIT_V(n) asm volatile("s_waitcnt vmcnt(" #n ")" ::: "memory")
#define PG8_WAIT_L(n) asm volatile("s_waitcnt lgkmcnt(" #n ")" ::: "memory")
#define PG8_BAR __builtin_amdgcn_s_barrier()
#define PG8_SCHED __builtin_amdgcn_sched_barrier(0)
    Unit cur, nxt; int ui = 0;
    if (!S.next(0, cur)) return;
    f32x4 acc[2][2][4][2];
#pragma unroll
    for (int a = 0; a < 2; ++a)
#pragma unroll
        for (int b = 0; b < 2; ++b)
#pragma unroll
            for (int m = 0; m < 4; ++m)
#pragma unroll
                for (int n = 0; n < 2; ++n) acc[a][b][m][n] = (f32x4){0.f, 0.f, 0.f, 0.f};
    bf16x8 At[4][2], B0[2][2], B1[2][2];
    const char* cA = (const char*)g.A + (size_t)cur.pm * tstep; const char* cB = (const char*)g.Bt + (size_t)cur.pn * tstep;
    S.a_ready(cur);
    if constexpr (SP2) {
        PG8_STAGE(PG8_SB(0, 0), cB, voffB); PG8_STAGE(PG8_SB(0, 1), cB + hstep, voffB); PG8_STAGE(PG8_SA(0, 0), cA, voffA); PG8_STAGE(PG8_SA(0, 1), cA + hstep, voffA);
        if (wr == 1) PG8_BAR;
        PG8_WAIT_V(2); PG8_BAR;
        PG8_STAGE(PG8_SB(1, 0), cB + kstep, voffB); PG8_STAGE(PG8_SA(1, 0), cA + kstep, voffA); PG8_STAGE(PG8_SB(1, 1), cB + hstep + kstep, voffB);
        PG8_WAIT_V(6); PG8_BAR;
    } else {
        PG8_STAGE(PG8_SB(0, 0), cB, voffB); PG8_STAGE(PG8_SA(0, 0), cA, voffA); PG8_STAGE(PG8_SB(0, 1), cB + hstep, voffB); PG8_STAGE(PG8_SA(0, 1), cA + hstep, voffA);
        if (wr == 1) PG8_BAR;
        PG8_WAIT_V(4); PG8_BAR;
        PG8_STAGE(PG8_SB(1, 0), cB + kstep, voffB); PG8_STAGE(PG8_SA(1, 0), cA + kstep, voffA); PG8_STAGE(PG8_SB(1, 1), cB + hstep + kstep, voffB);
        PG8_WAIT_V(6); PG8_BAR;
    }
    for (;;) {
        const bool has_next = S.next(ui + 1, nxt);
        const char* nA = has_next ? (const char*)g.A + (size_t)nxt.pm * tstep : cA; const char* nB = has_next ? (const char*)g.Bt + (size_t)nxt.pn * tstep : cB;
        for (int t = 0; t < nt; t += 2) {
            const bool last = (t == nt - 2);
            const char* a1 = cA + (size_t)(t + 1) * kstep;
            const char* a2 = last ? nA : cA + (size_t)(t + 2) * kstep; const char* b2 = last ? nB : cB + (size_t)(t + 2) * kstep;
            const char* a3 = a2 + kstep; const char* b3 = b2 + kstep;
            if (last && has_next) S.a_ready(nxt);
            if constexpr (SP2) {
            PG8_LDB(B0, 0, 0); PG8_LDB(B1, 0, 1); PG8_SCHED; PG8_LDA(At, 0, 0); PG8_STAGE(PG8_SA(1, 1), a1 + hstep, voffA);
            PG8_WAIT_V(8); PG8_WAIT_L(0); PG8_BAR; PG8_MMA(0, 0, At, B0); PG8_MMA(0, 1, At, B1); PG8_BAR; PG8_SCHED;
            PG8_LDA(At, 0, 1); PG8_STAGE(PG8_SB(0, 0), b2, voffB); PG8_STAGE(PG8_SB(0, 1), b2 + hstep, voffB); PG8_STAGE(PG8_SA(0, 0), a2, voffA);
            PG8_WAIT_V(8); PG8_WAIT_L(0); PG8_BAR; PG8_MMA(1, 0, At, B0); PG8_MMA(1, 1, At, B1); PG8_BAR; PG8_SCHED;
            PG8_LDB(B0, 1, 0); PG8_LDB(B1, 1, 1); PG8_SCHED; PG8_LDA(At, 1, 0); PG8_STAGE(PG8_SA(0, 1), a2 + hstep, voffA);
            PG8_WAIT_V(8); PG8_WAIT_L(0); PG8_BAR; PG8_MMA(0, 0, At, B0); PG8_MMA(0, 1, At, B1); PG8_BAR; PG8_SCHED;
            PG8_LDA(At, 1, 1); PG8_STAGE(PG8_SB(1, 0), b3, voffB); PG8_STAGE(PG8_SB(1, 1), b3 + hstep, voffB); PG8_STAGE(PG8_SA(1, 0), a3, voffA);
            PG8_WAIT_V(8); PG8_WAIT_L(0); PG8_BAR; PG8_MMA(1, 0, At, B0); PG8_MMA(1, 1, At, B1); PG8_BAR; PG8_SCHED;
            } else {
            PG8_LDB(B0, 0, 0); PG8_SCHED; PG8_LDA(At, 0, 0); PG8_STAGE(PG8_SA(1, 1), a1 + hstep, voffA);
            PG8_WAIT_L(8); PG8_BAR; PG8_WAIT_L(0); PG8_MMA(0, 0, At, B0); PG8_BAR; PG8_SCHED;
            PG8_LDB(B1, 0, 1); PG8_STAGE(PG8_SB(0, 0), b2, voffB);
            PG8_BAR; PG8_WAIT_L(0); PG8_MMA(0, 1, At, B1); PG8_BAR;
            PG8_LDA(At, 0, 1); PG8_STAGE(PG8_SA(0, 0), a2, voffA);
            PG8_BAR; PG8_WAIT_L(0); PG8_MMA(1, 0, At, B0); PG8_BAR; PG8_SCHED;
            PG8_STAGE(PG8_SB(0, 1), b2 + hstep, voffB);
            PG8_WAIT_V(6); PG8_BAR; PG8_MMA(1, 1, At, B1); PG8_BAR;
            PG8_LDB(B0, 1, 0); PG8_SCHED; PG8_LDA(At, 1, 0); PG8_STAGE(PG8_SA(0, 1), a2 + hstep, voffA);
            PG8_WAIT_L(8); PG8_BAR; PG8_WAIT_L(0); PG8_MMA(0, 0, At, B0); PG8_BAR; PG8_SCHED;
            PG8_LDB(B1, 1, 1); PG8_STAGE(PG8_SB(1, 0), b3, voffB);
            PG8_BAR; PG8_WAIT_L(0); PG8_MMA(0, 1, At, B1); PG8_BAR;
            PG8_LDA(At, 1, 1); PG8_STAGE(PG8_SA(1, 0), a3, voffA);
            PG8_BAR; PG8_WAIT_L(0); PG8_MMA(1, 0, At, B0); PG8_BAR; PG8_SCHED;
            PG8_STAGE(PG8_SB(1, 1), b3 + hstep, voffB);
            PG8_WAIT_V(6); PG8_BAR; PG8_MMA(1, 1, At, B1); PG8_BAR;
            }
        }
        if constexpr (ALIGN_EPI) { if (wr == 0) PG8_BAR; }
        if constexpr (!Epi::AFTER_DRAIN) { E(acc, cur, wr, wc, fr, fq); S.done(cur); }
        if (!has_next) break;
#pragma unroll
        for (int a = 0; a < 2; ++a)
#pragma unroll
            for (int b = 0; b < 2; ++b)
#pragma unroll
                for (int m = 0; m < 4; ++m)
#pragma unroll
                    for (int n = 0; n < 2; ++n) acc[a][b][m][n] = (f32x4){0.f, 0.f, 0.f, 0.f};
        cur = nxt; cA = nA; cB = nB; ++ui;
        if constexpr (ALIGN_EPI) { if (wr == 1) PG8_BAR; }
    }
    PG8_WAIT_V(0);
    if constexpr (!ALIGN_EPI) { if (wr == 0) PG8_BAR; }
    PG8_BAR;
    if constexpr (Epi::AFTER_DRAIN) { E.fused(acc, cur, wr, wc, fr, fq, lds, wid, lane); S.done(cur); }
#undef PG8_SA
#undef PG8_SB
#undef PG8_STAGE
#undef PG8_LDA
#undef PG8_LDB
#undef PG8_MMA
#undef PG8_WAIT_V
#undef PG8_WAIT_L
#undef PG8_BAR
#undef PG8_SCHED
}
}
#define XB_TMO      128
#define XB_XCNT(j)  (256  + 64 * (j))
#define XB_XSUB(j)  (1280 + 64 * (j))
#define XB_XGEN(j)  (2304 + 64 * (j))
#define XB_TOP      3328
#define XB_TOPGEN   3392
#define XCD_BAR_WORDS 3456
#define XB_SPIN_CAP (1u << 18)

__device__ __forceinline__ unsigned xb_ld(unsigned* p)              { return __hip_atomic_load(p, __ATOMIC_RELAXED, __HIP_MEMORY_SCOPE_AGENT); }
__device__ __forceinline__ unsigned xb_add(unsigned* p, unsigned v) { return __hip_atomic_fetch_add(p, v, __ATOMIC_RELAXED, __HIP_MEMORY_SCOPE_AGENT); }
__device__ __forceinline__ unsigned xb_xcc_id() { return (unsigned)__builtin_amdgcn_s_getreg((3 << 11) | 20) & 0xFu; }
#define XB_SPIN(cond, bar) do { unsigned _sp = 0; while (cond) { __builtin_amdgcn_s_sleep(1); \
    if ((++_sp & 255u) == 0u) { if (xb_ld(&(bar)[XB_TMO])) break; if (_sp > XB_SPIN_CAP) { atomicAdd(&(bar)[XB_TMO], 1u); break; } } } } while (0)

struct XcdBarrier {
    unsigned* bar; unsigned x;
    volatile LAS unsigned* st;
};

__device__ __forceinline__ XcdBarrier xcd_barrier_post(unsigned* bar, volatile LAS unsigned* st) {
    XcdBarrier b; b.bar = bar; b.x = xb_xcc_id(); b.st = st;
    if (threadIdx.x == 0) (void)xb_add(&bar[XB_XCNT(b.x)], 1u);
    return b;
}
__device__ __forceinline__ void xcd_barrier_complete(unsigned* bar, unsigned x, unsigned& nloc, unsigned& nx) {
    const unsigned G = gridDim.x * gridDim.y * gridDim.z;
    unsigned sum, cnt, mine, sp = 0u;
    for (;;) {
        sum = 0u; cnt = 0u; mine = 0u;
#pragma unroll
        for (unsigned j = 0; j < 16; ++j) { const unsigned c = xb_ld(&bar[XB_XCNT(j)]); sum += c; cnt += (c > 0u) ? 1u : 0u; mine = (j == x) ? c : mine; }
        if (sum == G) break;
        __builtin_amdgcn_s_sleep(1);
        if ((++sp & 255u) == 0u) { if (xb_ld(&bar[XB_TMO])) break; if (sp > XB_SPIN_CAP) { atomicAdd(&bar[XB_TMO], 1u); break; } }
    }
    nloc = mine > 0u ? mine : 1u; nx = cnt > 0u ? cnt : 1u;
}

__device__ __forceinline__ void xcd_barrier(const XcdBarrier& b) {
    asm volatile("s_waitcnt vmcnt(0)" ::: "memory");
    __syncthreads();
    if (threadIdx.x == 0) {
        unsigned* bar = b.bar;
        __builtin_amdgcn_s_waitcnt(0);
        unsigned nloc = b.st[0], nx = b.st[1];
        if (nloc == 0u) { xcd_barrier_complete(bar, b.x, nloc, nx); b.st[0] = nloc; b.st[1] = nx; }
        const unsigned old = xb_add(&bar[XB_XSUB(b.x)], 1u);
        const unsigned gen = old / nloc;
        if (old + 1u == (gen + 1u) * nloc) {
            __builtin_amdgcn_fence(__ATOMIC_RELEASE, "agent");
            asm volatile("s_waitcnt vmcnt(0)" ::: "memory");
            const unsigned og = xb_add(&bar[XB_TOP], 1u);
            const unsigned tg = og / nx;
            if (og + 1u == (tg + 1u) * nx) xb_add(&bar[XB_TOPGEN], 1u);
            else XB_SPIN(xb_ld(&bar[XB_TOPGEN]) == tg, bar);
            __builtin_amdgcn_fence(__ATOMIC_ACQUIRE, "agent");
            xb_add(&bar[XB_XGEN(b.x)], 1u);
            asm volatile("s_waitcnt vmcnt(0)" ::: "memory");
        } else {
            XB_SPIN(xb_ld(&bar[XB_XGEN(b.x)]) == gen, bar);
            __builtin_amdgcn_fence(__ATOMIC_ACQUIRE, "agent");
            asm volatile("s_waitcnt vmcnt(0)" ::: "memory");
        }
    }
    __syncthreads();
}
__device__ __forceinline__ void phase_prep(const Params& p, unsigned char* lds, int bid, int nb) {
    const int tid = threadIdx.x, lane = tid & 63, wave = tid >> 6;
    unsigned char* ws = p.ws;
    float* mod = (float*)(ws + WS_MOD);
    if (bid < 192) {
        float* sc = (float*)lds;
        float* red = sc + 8 * 2048;
        for (int i = tid; i < 8 * 2048; i += NTHR) sc[i] = silu_f(p.c[i]);
        __syncthreads();
        for (int it = bid; it < 192; it += nb) {
            const int col = it * 64 + lane;
            float acc[8];
#pragma unroll
            for (int b = 0; b < 8; ++b) acc[b] = 0.f;
            const float* w = p.w_ada + (size_t)(wave * 256) * NMOD + col;
            const float* s0 = sc + wave * 256;
#pragma unroll 4
            for (int k = 0; k < 256; ++k) {
                const float wv = w[(size_t)k * NMOD];
#pragma unroll
                for (int b = 0; b < 8; ++b) acc[b] += s0[b * 2048 + k] * wv;
            }
#pragma unroll
            for (int b = 0; b < 8; ++b) red[(wave * 8 + b) * 64 + lane] = acc[b];
            __syncthreads();
            {   const int b = wave; float s = p.b_ada[col];
#pragma unroll
                for (int w2 = 0; w2 < 8; ++w2) s += red[(w2 * 8 + b) * 64 + lane];
                mod[b * NMOD + col] = s; }
            __syncthreads();
        }
    }
    __syncthreads();
    {
        float* tile = (float*)lds;
        bf16_t* WinT = (bf16_t*)(ws + WS_WINT); bf16_t* WoT = (bf16_t*)(ws + WS_WOT); bf16_t* WqT = (bf16_t*)(ws + WS_WQT);
        for (int item = bid; item < 5632; item += nb) {
            const float* src; int ld, scol; bf16_t* dst; int kt;
            if (item < 3584) { const int seg = item >> 9, rem = item & 511, ntile = rem >> 5; kt = rem & 31;
                src = p.w_in; ld = INCOLS; scol = (seg < 3 ? seg * 1024 : 3080 + (seg - 3) * 1024) + ntile * 64; dst = WinT + (size_t)(seg * 1024 + ntile * 64) * 2048; }
            else if (item < 4608) { const int rem = item - 3584, ntile = rem >> 5; kt = rem & 31; src = p.w_out; ld = 2048; scol = ntile * 64; dst = WoT + (size_t)(ntile * 64) * 2048; }
            else { const int rem = item - 4608, ntile = rem >> 5; kt = rem & 31; src = p.w_q; ld = 2048; scol = ntile * 64; dst = WqT + (size_t)(ntile * 64) * 2048; }
            const int k0 = kt * 64;
#pragma unroll
            for (int ii = 0; ii < 8; ++ii) { const int k = wave + 8 * ii; tile[k * 65 + lane] = src[(size_t)(k0 + k) * ld + scol + lane]; }
            __syncthreads();
#pragma unroll
            for (int ii = 0; ii < 8; ++ii) { const int n = wave + 8 * ii; dst[(size_t)n * 2048 + k0 + lane] = (bf16_t)(cvt_pk(tile[lane * 65 + n], 0.f) & 0xffffu); }
            __syncthreads();
        }
    }
    {
        unsigned char* E8D = ws + WS_E8D; unsigned char* E8U = ws + WS_E8U;
        for (int i = bid * NTHR + tid; i < 4194304; i += nb * NTHR) {
            const int which = i >> 21, r = i & 2097151;
            const f32x4* sp = (const f32x4*)(which ? p.e_up : p.e_down) + (size_t)r * 4;
            const float scl = which ? 32.f : 512.f;
            const f32x4 a = sp[0] * scl, b = sp[1] * scl, c = sp[2] * scl, d = sp[3] * scl;
            u32x4 w; int t;
            t = __builtin_amdgcn_cvt_pk_fp8_f32(a[0], a[1], 0, false); t = __builtin_amdgcn_cvt_pk_fp8_f32(a[2], a[3], t, true); w.x = (unsigned)t;
            t = __builtin_amdgcn_cvt_pk_fp8_f32(b[0], b[1], 0, false); t = __builtin_amdgcn_cvt_pk_fp8_f32(b[2], b[3], t, true); w.y = (unsigned)t;
            t = __builtin_amdgcn_cvt_pk_fp8_f32(c[0], c[1], 0, false); t = __builtin_amdgcn_cvt_pk_fp8_f32(c[2], c[3], t, true); w.z = (unsigned)t;
            t = __builtin_amdgcn_cvt_pk_fp8_f32(d[0], d[1], 0, false); t = __builtin_amdgcn_cvt_pk_fp8_f32(d[2], d[3], t, true); w.w = (unsigned)t;
            *(u32x4*)((which ? E8U : E8D) + (size_t)r * 16) = w;
        }
    }
    {
        float* Wg = (float*)(ws + WS_WG);
        for (int i = bid * NTHR + tid; i < 16 * 2048; i += nb * NTHR) { const int g = i >> 11, k = i & 2047; const int col = g < 8 ? 3072 + g : 7176 + (g - 8);
            Wg[i] = p.w_in[(size_t)k * INCOLS + col]; }
    }
}

template <bool GATES>
__device__ __forceinline__ void phase_norm(const float* xin, const float* gain, const float* mod, int shift_off, int scale_off, bf16_t* hout, const float* Wg, float* gate_out, int bid, int nb) {
    const int tid = threadIdx.x, lane = tid & 63, wave = tid >> 6;
    for (int row = bid * 8 + wave; row < T_; row += nb * 8) {
        const f32x4* xr = (const f32x4*)(xin + (size_t)row * D_);
        f32x4 v[8]; float ss = 0.f;
#pragma unroll
        for (int j = 0; j < 8; ++j) { v[j] = xr[lane + 64 * j]; ss += v[j][0] * v[j][0] + v[j][1] * v[j][1] + v[j][2] * v[j][2] + v[j][3] * v[j][3]; }
        ss = wsum(ss);
        const float r = rsqrtf(ss * (1.f / D_) + EPS_);
        const float* mb = mod + (size_t)(row >> 11) * NMOD;
        f32x4 hv[8];
#pragma unroll
        for (int j = 0; j < 8; ++j) {
            const int k = 4 * (lane + 64 * j);
            const f32x4 gn = *(const f32x4*)(gain + k), sh = *(const f32x4*)(mb + shift_off + k), scl = *(const f32x4*)(mb + scale_off + k);
#pragma unroll
            for (int e = 0; e < 4; ++e) hv[j][e] = (v[j][e] * r) * gn[e] * (1.f + scl[e]) + sh[e];
            u32x2 w; w.x = cvt_pk(hv[j][0], hv[j][1]); w.y = cvt_pk(hv[j][2], hv[j][3]);
            *(u32x2*)(hout + (size_t)row * D_ + k) = w;
        }
        if (GATES) {
            float outv = 0.f;
#pragma unroll 1
            for (int g = 0; g < 16; ++g) {
                float ga = 0.f;
#pragma unroll
                for (int j = 0; j < 8; ++j) { const f32x4 wv = *(const f32x4*)(Wg + g * 2048 + 4 * (lane + 64 * j)); ga += hv[j][0] * wv[0] + hv[j][1] * wv[1] + hv[j][2] * wv[2] + hv[j][3] * wv[3]; }
                const float s = wsum(ga); if (lane == g) outv = s;
            }
            if (lane < 16) gate_out[(size_t)row * 16 + lane] = outv;
        }
    }
}

__device__ __forceinline__ void phase_post(const Params& p, int bid, int nb) {
    const int tid = threadIdx.x, lane = tid & 63, wave = tid >> 6;
    unsigned char* ws = p.ws;
    bf16_t* Pq = (bf16_t*)(ws + WS_P); bf16_t* Pk = (bf16_t*)(ws + WS_P + SEG_B);
    const float qscale = 0.08838834764831845f;
    for (int r = bid * 8 + wave; r < 2 * T_; r += nb * 8) {
        const int which = r >= T_ ? 1 : 0; const int t = r - which * T_;
        bf16_t* ptr = (which ? Pk : Pq) + (size_t)t * 1024 + lane * 16;
        const float* gn = (which ? p.fox_kg : p.fox_qg) + (lane & 7) * 16;
        u32x4 a = *(const u32x4*)ptr, b = *(const u32x4*)(ptr + 8);
        float f[16];
        f[0] = bflo(a.x); f[1] = bfhi(a.x); f[2] = bflo(a.y); f[3] = bfhi(a.y); f[4] = bflo(a.z); f[5] = bfhi(a.z); f[6] = bflo(a.w); f[7] = bfhi(a.w);
        f[8] = bflo(b.x); f[9] = bfhi(b.x); f[10] = bflo(b.y); f[11] = bfhi(b.y); f[12] = bflo(b.z); f[13] = bfhi(b.z); f[14] = bflo(b.w); f[15] = bfhi(b.w);
        float ss = 0.f;
#pragma unroll
        for (int i = 0; i < 16; ++i) ss += f[i] * f[i];
        ss += __shfl_xor(ss, 1); ss += __shfl_xor(ss, 2); ss += __shfl_xor(ss, 4);
        const float rr = rsqrtf(ss * (1.f / 128.f) + EPS_) * (which ? 1.f : qscale);
#pragma unroll
        for (int i = 0; i < 16; ++i) f[i] = (f[i] * rr) * gn[i];
        a.x = cvt_pk(f[0], f[1]); a.y = cvt_pk(f[2], f[3]); a.z = cvt_pk(f[4], f[5]); a.w = cvt_pk(f[6], f[7]);
        b.x = cvt_pk(f[8], f[9]); b.y = cvt_pk(f[10], f[11]); b.z = cvt_pk(f[12], f[13]); b.w = cvt_pk(f[14], f[15]);
        *(u32x4*)ptr = a; *(u32x4*)(ptr + 8) = b;
    }
    const float* gate = (const float*)(ws + WS_GATE); float* F = (float*)(ws + WS_F);
    for (int sq = bid * 8 + wave; sq < 64; sq += nb * 8) {
        const int b = sq >> 3, h = sq & 7; const float fb = p.fox_fb[h];
        float v[32]; float run = 0.f;
#pragma unroll
        for (int i = 0; i < 32; ++i) { const int t = lane * 32 + i; run += logsig(gate[(size_t)(b * S_ + t) * 16 + h] + fb); v[i] = run; }
        float inc = run;
#pragma unroll
        for (int o = 1; o < 64; o <<= 1) { const float u = __shfl_up(inc, o); if (lane >= o) inc += u; }
        const float excl = inc - run;
#pragma unroll
        for (int i = 0; i < 32; ++i) F[(size_t)sq * S_ + lane * 32 + i] = v[i] + excl;
    }
}
__device__ __forceinline__ void fox_unit(const Params& p, unsigned char* lds, int b, int h, int qb) {
    const int tid = threadIdx.x, lane = tid & 63, wave = tid >> 6, r = lane & 31, hh = lane >> 5;
    unsigned char* ws = p.ws;
    const bf16_t* Pq = (const bf16_t*)(ws + WS_P); const bf16_t* Pk = (const bf16_t*)(ws + WS_P + SEG_B); const bf16_t* Pv = (const bf16_t*)(ws + WS_P + 2 * SEG_B);
    const float* F = (const float*)(ws + WS_F) + (size_t)(b * 8 + h) * S_;
    bf16_t* Oc = (bf16_t*)(ws + WS_H);
    bf16_t* Ks = (bf16_t*)lds;
    bf16_t* Vs = Ks + 64 * 136;
    float* Fs = (float*)(Vs + 128 * 72);
    const int q0w = qb * 256 + wave * 32, qs = q0w + r;
    const size_t trow = (size_t)(b * S_ + qs);
    bf16x8 qf[8];
#pragma unroll
    for (int ks = 0; ks < 8; ++ks) qf[ks] = *(const bf16x8*)(Pq + trow * 1024 + h * 128 + ks * 16 + hh * 8);
    const float Fq = F[qs];
    f32x16 o[4];
#pragma unroll
    for (int d = 0; d < 4; ++d)
#pragma unroll
        for (int i = 0; i < 16; ++i) o[d][i] = 0.f;
    float m = -INFINITY, l = 0.f;
    const int ntile = (qb * 256 + 256) / 64;
    for (int kt = 0; kt < ntile; ++kt) {
        const int k0 = kt * 64;
        __syncthreads();
#pragma unroll
        for (int i = 0; i < 2; ++i) { const int c = tid + NTHR * i, row = c >> 4, cc = c & 15;
            *(u32x4*)(Ks + row * 136 + cc * 8) = *(const u32x4*)(Pk + (size_t)(b * S_ + k0 + row) * 1024 + h * 128 + cc * 8); }
#pragma unroll
        for (int i = 0; i < 2; ++i) { const int c = tid + NTHR * i, key = c >> 4, cc = c & 15;
            const u32x4 w = *(const u32x4*)(Pv + (size_t)(b * S_ + k0 + key) * 1024 + h * 128 + cc * 8);
            bf16_t* vp = Vs + (cc * 8) * 72 + key;
            vp[0 * 72] = (bf16_t)(w.x & 0xffffu); vp[1 * 72] = (bf16_t)(w.x >> 16); vp[2 * 72] = (bf16_t)(w.y & 0xffffu); vp[3 * 72] = (bf16_t)(w.y >> 16);
            vp[4 * 72] = (bf16_t)(w.z & 0xffffu); vp[5 * 72] = (bf16_t)(w.z >> 16); vp[6 * 72] = (bf16_t)(w.w & 0xffffu); vp[7 * 72] = (bf16_t)(w.w >> 16); }
        if (tid < 64) Fs[tid] = F[k0 + tid];
        __syncthreads();
        if (k0 <= q0w + 31) {
            f32x16 s[2];
#pragma unroll
            for (int kb = 0; kb < 2; ++kb) {
#pragma unroll
                for (int i = 0; i < 16; ++i) s[kb][i] = 0.f;
#pragma unroll
                for (int ks = 0; ks < 8; ++ks) { const bf16x8 a = *(const bf16x8*)(Ks + (kb * 32 + r) * 136 + ks * 16 + hh * 8);
                    s[kb] = __builtin_amdgcn_mfma_f32_32x32x16_bf16(a, qf[ks], s[kb], 0, 0, 0); }
            }
            float mx = m;
#pragma unroll
            for (int kb = 0; kb < 2; ++kb)
#pragma unroll
                for (int i = 0; i < 16; ++i) { const int kl = kb * 32 + (i & 3) + 8 * (i >> 2) + 4 * hh; float val = s[kb][i] + Fq - Fs[kl];
                    if (k0 + kl > qs) val = -INFINITY; s[kb][i] = val; mx = fmaxf(mx, val); }
            mx = fmaxf(mx, __shfl_xor(mx, 32));
            const float alpha = __expf(m - mx);
            float ps = 0.f;
#pragma unroll
            for (int kb = 0; kb < 2; ++kb)
#pragma unroll
                for (int i = 0; i < 16; ++i) { const float pv = __expf(s[kb][i] - mx); s[kb][i] = pv; ps += pv; }
            l = l * alpha + ps; m = mx;
#pragma unroll
            for (int d = 0; d < 4; ++d)
#pragma unroll
                for (int i = 0; i < 16; ++i) o[d][i] *= alpha;
#pragma unroll
            for (int kb = 0; kb < 2; ++kb)
#pragma unroll
                for (int st = 0; st < 2; ++st) {
                    u32x4 pw; pw.x = cvt_pk(s[kb][8 * st + 0], s[kb][8 * st + 1]); pw.y = cvt_pk(s[kb][8 * st + 2], s[kb][8 * st + 3]);
                    pw.z = cvt_pk(s[kb][8 * st + 4], s[kb][8 * st + 5]); pw.w = cvt_pk(s[kb][8 * st + 6], s[kb][8 * st + 7]);
                    const bf16x8 pf = __builtin_bit_cast(bf16x8, pw);
#pragma unroll
                    for (int d = 0; d < 4; ++d) { const bf16_t* vp = Vs + (d * 32 + r) * 72 + kb * 32 + st * 16 + hh * 4;
                        const u32x2 lo = *(const u32x2*)vp, hi = *(const u32x2*)(vp + 8);
                        u32x4 vw; vw.x = lo.x; vw.y = lo.y; vw.z = hi.x; vw.w = hi.y;
                        o[d] = __builtin_amdgcn_mfma_f32_32x32x16_bf16(__builtin_bit_cast(bf16x8, vw), pf, o[d], 0, 0, 0); }
                }
        }
    }
    l += __shfl_xor(l, 32);
    const float inv = 1.f / l;
#pragma unroll
    for (int d = 0; d < 4; ++d)
#pragma unroll
        for (int g = 0; g < 4; ++g) { u32x2 w; w.x = cvt_pk(o[d][4 * g] * inv, o[d][4 * g + 1] * inv); w.y = cvt_pk(o[d][4 * g + 2] * inv, o[d][4 * g + 3] * inv);
            *(u32x2*)(Oc + trow * D_ + h * 128 + d * 32 + 8 * g + 4 * hh) = w; }
}

__device__ __forceinline__ void mlstm_passA(const Params& p, unsigned char* lds, int unit) {
    const int tid = threadIdx.x, lane = tid & 63, wave = tid >> 6;
    const int b = unit >> 5, h = (unit >> 3) & 3, vs = unit & 7;
    unsigned char* ws = p.ws;
    const bf16_t* Mk = (const bf16_t*)(ws + WS_P + 4 * SEG_B); const bf16_t* Mv = (const bf16_t*)(ws + WS_P + 5 * SEG_B);
    const float* gate = (const float*)(ws + WS_GATE);
    bf16_t* Cst = (bf16_t*)(ws + WS_CST); float* nst = (float*)(ws + WS_NST); float* mst = (float*)(ws + WS_MST);
    float* ksm = (float*)lds;
    float* vsm = ksm + 64 * 256;
    float* sc = vsm + 64 * 32;
    const int e = tid & 31, dg = tid >> 5;
    float c[16];
#pragma unroll
    for (int i = 0; i < 16; ++i) c[i] = 0.f;
    float nreg = 0.f, m = 0.f;
    const int ch = tid & 255, half = tid >> 8;
    const float cw0 = p.conv_w[0 * 2048 + 1024 + h * 256 + ch], cw1 = p.conv_w[1 * 2048 + 1024 + h * 256 + ch], cw2 = p.conv_w[2 * 2048 + 1024 + h * 256 + ch], cw3 = p.conv_w[3 * 2048 + 1024 + h * 256 + ch];
    const float cb = p.conv_b[1024 + h * 256 + ch];
    const float ib = p.m_ib[h], fb = p.m_fb[h];
    for (int cc = 0; cc < 32; ++cc) {
        const int bhc = (b * 4 + h) * 32 + cc;
        const int t0 = b * S_ + cc * 64;
#pragma unroll
        for (int i = 0; i < 16; ++i) Cst[((size_t)bhc * 256 + dg * 16 + i) * 256 + vs * 32 + e] = (bf16_t)(cvt_pk(c[i], 0.f) & 0xffffu);
        if (vs == 0 && tid < 256) nst[(size_t)bhc * 256 + tid] = nreg;
        if (vs == 0 && tid == 0) mst[bhc] = m;
        if (cc == 31) break;
        __syncthreads();
        if (wave == 0) {
            const float ipre = gate[(size_t)(t0 + lane) * 16 + 8 + h] + ib, fpre = gate[(size_t)(t0 + lane) * 16 + 12 + h] + fb;
            float bc = logsig(fpre);
#pragma unroll
            for (int o = 1; o < 64; o <<= 1) { const float u = __shfl_up(bc, o); if (lane >= o) bc += u; }
            const float a = ipre - bc; const float amax = wmax(a); const float bL = __shfl(bc, 63);
            const float mnew = bL + fmaxf(m, amax);
            sc[lane] = expf(bL + a - mnew);
            if (lane == 0) { sc[64] = expf(bL + m - mnew); sc[65] = mnew; }
        }
        __syncthreads();
        {
            const int s0 = half * 32; const int sp = cc * 64 + s0;
            const bf16_t* src = Mk + (size_t)(t0 + s0) * 1024 + h * 256 + ch;
            float x0 = sp >= 3 ? bf2f(*(src - 3 * 1024)) : 0.f, x1 = sp >= 2 ? bf2f(*(src - 2 * 1024)) : 0.f, x2 = sp >= 1 ? bf2f(*(src - 1 * 1024)) : 0.f;
            for (int s = 0; s < 32; ++s) { const float x3 = bf2f(src[(size_t)s * 1024]);
                const float y = silu_f(cw0 * x0 + cw1 * x1 + cw2 * x2 + cw3 * x3 + cb);
                ksm[(s0 + s) * 256 + ch] = y * 0.0625f * sc[s0 + s]; x0 = x1; x1 = x2; x2 = x3; }
        }
#pragma unroll
        for (int i = 0; i < 4; ++i) { const int idx = tid + NTHR * i, s = idx >> 5, ee = idx & 31; vsm[idx] = bf2f(Mv[(size_t)(t0 + s) * 1024 + h * 256 + vs * 32 + ee]); }
        __syncthreads();
        const float decay = sc[64]; m = sc[65];
#pragma unroll
        for (int i = 0; i < 16; ++i) c[i] *= decay;
        for (int s = 0; s < 64; ++s) { const float vv = vsm[s * 32 + e]; const f32x4* kp = (const f32x4*)(ksm + s * 256 + dg * 16);
#pragma unroll
            for (int j = 0; j < 4; ++j) { const f32x4 kv = kp[j]; c[4 * j] += kv[0] * vv; c[4 * j + 1] += kv[1] * vv; c[4 * j + 2] += kv[2] * vv; c[4 * j + 3] += kv[3] * vv; } }
        if (tid < 256) { nreg *= decay; for (int s = 0; s < 64; ++s) nreg += ksm[s * 256 + tid]; }
    }
}

__device__ __forceinline__ void mlstm_passB(const Params& p, unsigned char* lds, int unit) {
    const int tid = threadIdx.x, lane = tid & 63, wave = tid >> 6;
    const int b = unit >> 7, h = (unit >> 5) & 3, cc = unit & 31;
    unsigned char* ws = p.ws;
    const bf16_t* Mq = (const bf16_t*)(ws + WS_P + 3 * SEG_B); const bf16_t* Mk = (const bf16_t*)(ws + WS_P + 4 * SEG_B);
    const bf16_t* Mv = (const bf16_t*)(ws + WS_P + 5 * SEG_B); const bf16_t* Mo = (const bf16_t*)(ws + WS_P + 6 * SEG_B);
    const float* gate = (const float*)(ws + WS_GATE);
    const bf16_t* Cst = (const bf16_t*)(ws + WS_CST); const float* nst = (const float*)(ws + WS_NST); const float* mst = (const float*)(ws + WS_MST);
    bf16_t* Oc = (bf16_t*)(ws + WS_H);
    float* qT = (float*)lds;
    float* kR = qT + 256 * 64;
    float* WT = kR + 64 * 257;
    float* sc = WT + 64 * 64;
    float* red = sc + 384;
    const int bhc = (b * 4 + h) * 32 + cc, t0 = b * S_ + cc * 64;
    __syncthreads();
    if (wave == 0) {
        const float ipre = gate[(size_t)(t0 + lane) * 16 + 8 + h] + p.m_ib[h], fpre = gate[(size_t)(t0 + lane) * 16 + 12 + h] + p.m_fb[h];
        float bc = logsig(fpre);
#pragma unroll
        for (int o = 1; o < 64; o <<= 1) { const float u = __shfl_up(bc, o); if (lane >= o) bc += u; }
        const float a = ipre - bc; float pm = a;
#pragma unroll
        for (int o = 1; o < 64; o <<= 1) { const float u = __shfl_up(pm, o); if (lane >= o) pm = fmaxf(pm, u); }
        const float mc = mst[bhc]; const float mt = bc + fmaxf(mc, pm);
        sc[lane] = bc; sc[64 + lane] = a; sc[128 + lane] = mt; sc[192 + lane] = expf(bc + mc - mt);
    }
    {
        const int ch = tid & 255, half = tid >> 8, s0 = half * 32, sp = cc * 64 + s0;
#pragma unroll
        for (int which = 0; which < 2; ++which) {
            const int cidx = which * 1024 + h * 256 + ch;
            const float cw0 = p.conv_w[cidx], cw1 = p.conv_w[2048 + cidx], cw2 = p.conv_w[4096 + cidx], cw3 = p.conv_w[6144 + cidx], cb = p.conv_b[cidx];
            const bf16_t* src = (which ? Mk : Mq) + (size_t)(t0 + s0) * 1024 + h * 256 + ch;
            float x0 = sp >= 3 ? bf2f(*(src - 3 * 1024)) : 0.f, x1 = sp >= 2 ? bf2f(*(src - 2 * 1024)) : 0.f, x2 = sp >= 1 ? bf2f(*(src - 1 * 1024)) : 0.f;
            for (int s = 0; s < 32; ++s) { const float x3 = bf2f(src[(size_t)s * 1024]);
                const float y = silu_f(cw0 * x0 + cw1 * x1 + cw2 * x2 + cw3 * x3 + cb);
                if (which) kR[(s0 + s) * 257 + ch] = y * 0.0625f; else qT[ch * 64 + s0 + s] = y;
                x0 = x1; x1 = x2; x2 = x3; }
        }
    }
    __syncthreads();
    {
        float acc[8];
#pragma unroll
        for (int i = 0; i < 8; ++i) acc[i] = 0.f;
        for (int d = 0; d < 256; ++d) { const float kv = kR[lane * 257 + d]; const f32x4 q0 = *(const f32x4*)(qT + d * 64 + wave * 8), q1 = *(const f32x4*)(qT + d * 64 + wave * 8 + 4);
            acc[0] += q0[0] * kv; acc[1] += q0[1] * kv; acc[2] += q0[2] * kv; acc[3] += q0[3] * kv; acc[4] += q1[0] * kv; acc[5] += q1[1] * kv; acc[6] += q1[2] * kv; acc[7] += q1[3] * kv; }
        const float as = sc[64 + lane];
#pragma unroll
        for (int i = 0; i < 8; ++i) { const int l = wave * 8 + i; const float w = (lane <= l) ? acc[i] * expf(sc[l] + as - sc[128 + l]) : 0.f;
            WT[lane * 64 + l] = w; const float rs = wsum(w); if (lane == 0) sc[256 + l] = rs; }
    }
    __syncthreads();
    if (wave == 0) {
        float qn = 0.f; const float* np = nst + (size_t)bhc * 256;
        for (int d = 0; d < 256; ++d) qn += qT[d * 64 + lane] * np[d];
        const float den = sc[256 + lane] + sc[192 + lane] * qn;
        sc[320 + lane] = fmaxf(fabsf(den), expf(-sc[128 + lane]));
    }
    {
        const int e = tid & 255, lh = tid >> 8;
        float acc[32];
#pragma unroll
        for (int i = 0; i < 32; ++i) acc[i] = 0.f;
        const bf16_t* cp = Cst + (size_t)bhc * 65536 + e;
        for (int d = 0; d < 256; ++d) { const float cv = bf2f(cp[(size_t)d * 256]); const f32x4* qp = (const f32x4*)(qT + d * 64 + lh * 32);
#pragma unroll
            for (int j = 0; j < 8; ++j) { const f32x4 qv = qp[j]; acc[4 * j] += qv[0] * cv; acc[4 * j + 1] += qv[1] * cv; acc[4 * j + 2] += qv[2] * cv; acc[4 * j + 3] += qv[3] * cv; } }
#pragma unroll
        for (int i = 0; i < 32; ++i) acc[i] *= sc[192 + lh * 32 + i];
        for (int s = 0; s < 64; ++s) { const float vv = bf2f(Mv[(size_t)(t0 + s) * 1024 + h * 256 + e]); const f32x4* wp = (const f32x4*)(WT + s * 64 + lh * 32);
#pragma unroll
            for (int j = 0; j < 8; ++j) { const f32x4 wv = wp[j]; acc[4 * j] += wv[0] * vv; acc[4 * j + 1] += wv[1] * vv; acc[4 * j + 2] += wv[2] * vv; acc[4 * j + 3] += wv[3] * vv; } }
        __syncthreads();
#pragma unroll
        for (int i = 0; i < 32; ++i) { acc[i] = acc[i] / sc[320 + lh * 32 + i]; const float ss = wsum(acc[i] * acc[i]); if (lane == 0) red[(lh * 32 + i) * 4 + (wave & 3)] = ss; }
        __syncthreads();
        const float hg = p.m_hg[h * 256 + e];
#pragma unroll
        for (int i = 0; i < 32; ++i) { const int l = lh * 32 + i; const f32x4 rv = *(const f32x4*)(red + l * 4);
            const float rr = rsqrtf((rv[0] + rv[1] + rv[2] + rv[3]) * (1.f / 256.f) + EPS_);
            const float og = sigm(bf2f(Mo[(size_t)(t0 + l) * 1024 + h * 256 + e]));
            Oc[(size_t)(t0 + l) * D_ + 1024 + h * 256 + e] = (bf16_t)(cvt_pk(acc[i] * rr * hg * og, 0.f) & 0xffffu); }
    }
}
__device__ __forceinline__ void ce_desc(float& a, float& b) { const float hi = fmaxf(a, b), lo = fminf(a, b); a = hi; b = lo; }
__device__ __forceinline__ void sort16_desc(float (&v)[16]) {
#pragma unroll
    for (int k = 2; k <= 16; k <<= 1)
#pragma unroll
        for (int j = k >> 1; j > 0; j >>= 1)
#pragma unroll
            for (int i = 0; i < 16; ++i) { const int l = i ^ j; if (l > i) { if ((i & k) == 0) ce_desc(v[i], v[l]); else ce_desc(v[l], v[i]); } }
}
__device__ __forceinline__ void bmerge16_desc(float (&v)[16]) {
#pragma unroll
    for (int j = 8; j > 0; j >>= 1)
#pragma unroll
        for (int i = 0; i < 16; ++i) { const int l = i ^ j; if (l > i) ce_desc(v[i], v[l]); }
}
__device__ __forceinline__ void merge_top16(float (&a)[16], const float (&b)[16]) {
#pragma unroll
    for (int i = 0; i < 16; ++i) a[i] = fmaxf(a[i], b[15 - i]);
    bmerge16_desc(a);
}
__device__ __forceinline__ float pack_idx(float v, unsigned mask, unsigned idx) { return __builtin_bit_cast(float, (__builtin_bit_cast(unsigned, v) & mask) | idx); }
__device__ __forceinline__ void top16_from_acc(const f32x16 (&acc)[4], int h, float (&out)[16]) {
    float g[4][16];
#pragma unroll
    for (int mt = 0; mt < 4; ++mt) {
#pragma unroll
        for (int i = 0; i < 16; ++i) g[mt][i] = pack_idx(acc[mt][i], 0xffffff80u, (unsigned)(32 * mt + (i & 3) + 8 * (i >> 2)) | ((unsigned)h << 2));
        sort16_desc(g[mt]);
    }
    merge_top16(g[0], g[1]); merge_top16(g[2], g[3]); merge_top16(g[0], g[2]);
    float o[16];
#pragma unroll
    for (int i = 0; i < 16; ++i) o[i] = __shfl_xor(g[0][i], 32);
    merge_top16(g[0], o);
#pragma unroll
    for (int i = 0; i < 16; ++i) out[i] = g[0][i];
}
__device__ __forceinline__ unsigned lut16(const unsigned (&P)[4], unsigned i) {
    const unsigned long long lo = (unsigned long long)P[0] | ((unsigned long long)P[1] << 32), hi = (unsigned long long)P[2] | ((unsigned long long)P[3] << 32);
    const unsigned long long s = (i & 8u) ? hi : lo;
    return (unsigned)(s >> ((i & 7u) * 8u)) & 0xffu;
}
struct CandTab { int i[50]; int j[50]; };
constexpr CandTab make_cand_tab() { CandTab t{}; int n = 0; for (int i = 0; i < 16; ++i) for (int j = 0; j < 16; ++j) if ((i + 1) * (j + 1) <= 16) { t.i[n] = i; t.j[n] = j; ++n; } return t; }
__device__ __forceinline__ void phase_topk(const Params& p, unsigned char* lds, int bid, int nb) {
    const int tid = threadIdx.x, lane = tid & 63, wave = tid >> 6, r = lane & 31, h = lane >> 5;
    unsigned char* ws = p.ws;
    const bf16_t* Q = (const bf16_t*)(ws + WS_Q); int* IDX = (int*)(ws + WS_IDX); float* GW = (float*)(ws + WS_GW);
    constexpr int KP = 136;
    bf16_t* KS = (bf16_t*)lds;
    for (int i = tid; i < 2 * 16384; i += NTHR) { const int which = i >> 14, n = (i >> 7) & 127, d = i & 127; const float v = (which ? p.sk2 : p.sk1)[i & 16383];
        const unsigned hb = cvt_pk(v, 0.f) & 0xffffu; const float lo = v - bf2f((bf16_t)hb);
        KS[((which * 2 + 0) * 128 + n) * KP + d] = (bf16_t)hb; KS[((which * 2 + 1) * 128 + n) * KP + d] = (bf16_t)(cvt_pk(lo, 0.f) & 0xffffu); }
    __syncthreads();
    for (int item = bid * 8 + wave; item < 512 * 8; item += nb * 8) {
        const int tt = item >> 3, hh = item & 7, t = tt * 32 + r;
        float top[2][16];
#pragma unroll
        for (int list = 0; list < 2; ++list) {
            bf16x8 qf[8];
#pragma unroll
            for (int ks = 0; ks < 8; ++ks) qf[ks] = *(const bf16x8*)(Q + (size_t)t * D_ + hh * 256 + list * 128 + ks * 16 + h * 8);
            f32x16 acc[4];
#pragma unroll
            for (int mt = 0; mt < 4; ++mt) {
#pragma unroll
                for (int i = 0; i < 16; ++i) acc[mt][i] = 0.f;
#pragma unroll
                for (int hl = 0; hl < 2; ++hl)
#pragma unroll
                    for (int ks = 0; ks < 8; ++ks) { const bf16x8 a = *(const bf16x8*)(KS + ((list * 2 + hl) * 128 + mt * 32 + r) * KP + ks * 16 + h * 8);
                        acc[mt] = __builtin_amdgcn_mfma_f32_32x32x16_bf16(a, qf[ks], acc[mt], 0, 0, 0); }
                __builtin_amdgcn_sched_barrier(0);
            }
            top16_from_acc(acc, h, top[list]);
        }
        unsigned P1[4], P2[4];
#pragma unroll
        for (int q = 0; q < 4; ++q) { P1[q] = 0u; P2[q] = 0u;
#pragma unroll
            for (int e = 0; e < 4; ++e) { P1[q] |= (__builtin_bit_cast(unsigned, top[0][4 * q + e]) & 127u) << (8 * e); P2[q] |= (__builtin_bit_cast(unsigned, top[1][4 * q + e]) & 127u) << (8 * e); } }
        float c[4][16];
#pragma unroll
        for (int n = 0; n < 64; ++n) {
            if (n < 50) { constexpr CandTab CT = make_cand_tab(); const int i = CT.i[n], j = CT.j[n];
                c[n >> 4][n & 15] = pack_idx(top[0][i] + top[1][j], 0xffffff00u, (unsigned)(i * 16 + j)); }
            else c[n >> 4][n & 15] = -INFINITY;
        }
        sort16_desc(c[0]); sort16_desc(c[1]); sort16_desc(c[2]); sort16_desc(c[3]);
        merge_top16(c[0], c[1]); merge_top16(c[2], c[3]); merge_top16(c[0], c[2]);
        float ex[16], sum = 0.f;
#pragma unroll
        for (int k = 0; k < 16; ++k) { ex[k] = __expf(c[0][k] - c[0][0]); sum += ex[k]; }
        const float inv = 1.f / sum;
        if (h == 0) {
            int* ip = IDX + (size_t)t * 128 + hh * 16; float* gp = GW + (size_t)t * 128 + hh * 16;
#pragma unroll
            for (int q = 0; q < 4; ++q) { u32x4 iv; f32x4 gv;
#pragma unroll
                for (int e = 0; e < 4; ++e) { const unsigned pos = __builtin_bit_cast(unsigned, c[0][4 * q + e]) & 255u;
                    iv[e] = lut16(P1, pos >> 4) * 128u + lut16(P2, pos & 15u); gv[e] = ex[4 * q + e] * inv; }
                *(u32x4*)(ip + 4 * q) = iv; *(f32x4*)(gp + 4 * q) = gv; }
        }
    }
}

typedef float f32x2 __attribute__((ext_vector_type(2)));
__device__ __forceinline__ float dot16_fp8(const u32x4 w, const float (&h)[32], int o) {
    float s = 0.f;
#pragma unroll
    for (int q = 0; q < 4; ++q) { const f32x2 lo = __builtin_amdgcn_cvt_pk_f32_fp8((int)w[q], false), hi = __builtin_amdgcn_cvt_pk_f32_fp8((int)w[q], true);
        s += lo[0] * h[o + 4 * q] + lo[1] * h[o + 4 * q + 1] + hi[0] * h[o + 4 * q + 2] + hi[1] * h[o + 4 * q + 3]; }
    return s;
}
__device__ __forceinline__ void axpy16_fp8(const u32x4 w, float a, float (&acc)[32], int o) {
#pragma unroll
    for (int q = 0; q < 4; ++q) { const f32x2 lo = __builtin_amdgcn_cvt_pk_f32_fp8((int)w[q], false), hi = __builtin_amdgcn_cvt_pk_f32_fp8((int)w[q], true);
        acc[o + 4 * q] += a * lo[0]; acc[o + 4 * q + 1] += a * lo[1]; acc[o + 4 * q + 2] += a * hi[0]; acc[o + 4 * q + 3] += a * hi[1]; }
}
__device__ __forceinline__ void phase_peer(const Params& p, int bid, int nb) {
    const int tid = threadIdx.x, lane = tid & 63, wave = tid >> 6;
    unsigned char* ws = p.ws;
    const bf16_t* H2 = (const bf16_t*)(ws + WS_H2); const int* IDX = (const int*)(ws + WS_IDX); const float* GW = (const float*)(ws + WS_GW);
    const float* mod = (const float*)(ws + WS_MOD);
    const unsigned char* E8D = ws + WS_E8D + 16 * lane; const unsigned char* E8U = ws + WS_E8U + 16 * lane;
    for (int t = bid * 8 + wave; t < T_; t += nb * 8) {
        float hv[32];
#pragma unroll
        for (int hf = 0; hf < 2; ++hf)
#pragma unroll
            for (int q = 0; q < 2; ++q) { const u32x4 w = *(const u32x4*)(H2 + (size_t)t * D_ + hf * 1024 + 16 * lane + 8 * q);
#pragma unroll
                for (int e = 0; e < 4; ++e) { hv[hf * 16 + q * 8 + 2 * e] = bflo(w[e]); hv[hf * 16 + q * 8 + 2 * e + 1] = bfhi(w[e]); } }
        const int idx0 = IDX[(size_t)t * 128 + lane], idx1 = IDX[(size_t)t * 128 + 64 + lane];
        const float g0 = GW[(size_t)t * 128 + lane], g1 = GW[(size_t)t * 128 + 64 + lane];
        float a0 = 0.f, a1 = 0.f;
        for (int i0 = 0; i0 < 128; i0 += 4) {
            u32x4 lo[4], hi[4];
#pragma unroll
            for (int u = 0; u < 4; ++u) { const int e = __shfl(i0 < 64 ? idx0 : idx1, (i0 + u) & 63); lo[u] = *(const u32x4*)(E8D + (size_t)e * 2048); hi[u] = *(const u32x4*)(E8D + (size_t)e * 2048 + 1024); }
#pragma unroll
            for (int u = 0; u < 4; ++u) { float d = dot16_fp8(lo[u], hv, 0) + dot16_fp8(hi[u], hv, 16); d = wsum(d);
                if (lane == ((i0 + u) & 63)) { if (i0 < 64) a0 = d; else a1 = d; } }
        }
        a0 *= (1.f / 512.f); a1 *= (1.f / 512.f);
        const float w0 = g0 * 0.5f * a0 * (1.f + erff(a0 * 0.7071067811865476f)), w1 = g1 * 0.5f * a1 * (1.f + erff(a1 * 0.7071067811865476f));
        float acc[32];
#pragma unroll
        for (int i = 0; i < 32; ++i) acc[i] = 0.f;
        for (int i0 = 0; i0 < 128; i0 += 4) {
            u32x4 lo[4], hi[4];
#pragma unroll
            for (int u = 0; u < 4; ++u) { const int e = __shfl(i0 < 64 ? idx0 : idx1, (i0 + u) & 63); lo[u] = *(const u32x4*)(E8U + (size_t)e * 2048); hi[u] = *(const u32x4*)(E8U + (size_t)e * 2048 + 1024); }
#pragma unroll
            for (int u = 0; u < 4; ++u) { const float w = __shfl(i0 < 64 ? w0 : w1, (i0 + u) & 63); axpy16_fp8(lo[u], w, acc, 0); axpy16_fp8(hi[u], w, acc, 16); }
        }
        const float* g2 = mod + (size_t)(t >> 11) * NMOD + 5 * D_;
#pragma unroll
        for (int hf = 0; hf < 2; ++hf)
#pragma unroll
            for (int q = 0; q < 4; ++q) { const int k = hf * 1024 + 16 * lane + 4 * q; f32x4* op = (f32x4*)(p.out + (size_t)t * D_ + k); const f32x4 gv = *(const f32x4*)(g2 + k);
                f32x4 av; av[0] = acc[hf * 16 + 4 * q]; av[1] = acc[hf * 16 + 4 * q + 1]; av[2] = acc[hf * 16 + 4 * q + 2]; av[3] = acc[hf * 16 + 4 * q + 3];
                *op = *op + gv * av * (1.f / 32.f); }
    }
}

constexpr int N_PHASES = 11;
constexpr int LDS_BYTES = 152 * 1024;
__global__ void __launch_bounds__(NTHR) fwd_kernel(Params p) {
    extern __shared__ __attribute__((aligned(16))) unsigned char lds[];
    const int bid = blockIdx.x, nb = gridDim.x, tid = threadIdx.x;
    unsigned char* ws = p.ws;
    volatile LAS unsigned* xbst = (volatile LAS unsigned*)((LAS unsigned char*)lds + LDS_BYTES - 16);
    if (tid == 0) { xbst[0] = 0u; xbst[1] = 0u; xbst[2] = 0u; xbst[3] = 0u; }
    __syncthreads();
    XcdBarrier bar; bar.bar = (unsigned*)(ws + WS_BAR); bar.x = 0; bar.st = xbst;
    const bool multi = (p.ph_hi - p.ph_lo) > 1;
    if (multi) bar = xcd_barrier_post((unsigned*)(ws + WS_BAR), xbst);
    const float* mod = (const float*)(ws + WS_MOD);
    const int lo = p.ph_lo, hi = p.ph_hi;
#ifdef ONLY_PHASE
#define IN(k) ((k) == ONLY_PHASE && lo <= (k) && (k) < hi)
#else
#define IN(k) (lo <= (k) && (k) < hi)
#endif
#define SEAM(k) do { if (lo <= (k) && (k) + 1 < hi) xcd_barrier(bar); } while (0)
#ifndef REPEAT_MASK
#define REPEAT_MASK 0
#endif
#define REP(k) for (int rep_ = 0; rep_ < (((REPEAT_MASK) >> (k)) & 1) + 1; ++rep_)
    REP(0) if (IN(0)) phase_prep(p, lds, bid, nb);
    SEAM(0);
    REP(1) if (IN(1)) phase_norm<true>(p.x, p.g1, mod, 0, D_, (bf16_t*)(ws + WS_H), (const float*)(ws + WS_WG), (float*)(ws + WS_GATE), bid, nb);
    SEAM(1);
    REP(2) if (IN(2)) { pg8::Gemm g{(const bf16_t*)(ws + WS_H), (const bf16_t*)(ws + WS_WINT), T_, 7168, D_}; pg8::StaticOrder S; S.init(T_, 7168, nb, bid);
        pg8::EpiSeg E{(bf16_t*)(ws + WS_P)}; pg8::gemm_phase<pg8::EpiSeg, pg8::StaticOrder, true, true>((LAS unsigned char*)lds, g, S, E); }
    SEAM(2);
    REP(3) if (IN(3)) phase_post(p, bid, nb);
    SEAM(3);
    REP(4) if (IN(4)) { for (int u = bid; u < 256; u += nb) mlstm_passA(p, lds, u);
        for (int u = bid; u < 256; u += nb) { fox_unit(p, lds, (u & 63) >> 3, u & 7, u >> 6); const int v = 511 - u; fox_unit(p, lds, (v & 63) >> 3, v & 7, v >> 6); } }
    SEAM(4);
    REP(5) if (IN(5)) { for (int u = bid; u < 1024; u += nb) mlstm_passB(p, lds, u); }
    SEAM(5);
    REP(6) if (IN(6)) { pg8::Gemm g{(const bf16_t*)(ws + WS_H), (const bf16_t*)(ws + WS_WOT), T_, D_, D_}; pg8::StaticOrder S; S.init(T_, D_, nb, bid);
        pg8::EpiRes E{p.x, p.out, mod, 2 * D_}; pg8::gemm_phase<pg8::EpiRes, pg8::StaticOrder, true, true>((LAS unsigned char*)lds, g, S, E); }
    SEAM(6);
    REP(7) if (IN(7)) phase_norm<false>(p.out, p.g2, mod, 3 * D_, 4 * D_, (bf16_t*)(ws + WS_H2), nullptr, nullptr, bid, nb);
    SEAM(7);
    REP(8) if (IN(8)) { pg8::Gemm g{(const bf16_t*)(ws + WS_H2), (const bf16_t*)(ws + WS_WQT), T_, D_, D_}; pg8::StaticOrder S; S.init(T_, D_, nb, bid);
        pg8::EpiBf E{(bf16_t*)(ws + WS_Q), D_}; pg8::gemm_phase<pg8::EpiBf, pg8::StaticOrder, true, true>((LAS unsigned char*)lds, g, S, E); }
    SEAM(8);
    REP(9) if (IN(9)) phase_topk(p, lds, bid, nb);
    SEAM(9);
    REP(10) if (IN(10)) phase_peer(p, bid, nb);
#undef IN
#undef SEAM
}

#ifndef ONE_LAUNCH
#define ONE_LAUNCH 1
#endif
extern "C" void kernel_launch(void* const* d_in, const int* in_sizes, int n_in, void* d_out, int out_size, void* d_ws, size_t ws_size, hipStream_t stream) {
    static int grid = 0;
    if (grid == 0) {
        int dev = 0, cus = 0, per_cu = 0;
        if (n_in != 21 || ws_size < WS_END) { fprintf(stderr, "kernel_launch: unexpected n_in %d / ws_size %zu (need %zu)\n", n_in, ws_size, (size_t)WS_END); grid = -1; return; }
        hipGetDevice(&dev); hipDeviceGetAttribute(&cus, hipDeviceAttributeMultiprocessorCount, dev);
        if (hipFuncSetAttribute((const void*)fwd_kernel, hipFuncAttributeMaxDynamicSharedMemorySize, LDS_BYTES) != hipSuccess) { fprintf(stderr, "kernel_launch: hipFuncSetAttribute failed\n"); grid = -1; return; }
        if (hipOccupancyMaxActiveBlocksPerMultiprocessor(&per_cu, (const void*)fwd_kernel, NTHR, LDS_BYTES) != hipSuccess || per_cu < 1) { fprintf(stderr, "kernel_launch: occupancy query says %d\n", per_cu); (void)hipGetLastError(); }
        grid = cus > 0 ? cus : 256;
    }
    if (grid < 0) return;
    Params p{};
    const float** pp = (const float**)&p;
    for (int i = 0; i < 21; ++i) pp[i] = (const float*)d_in[i];
    p.out = (float*)d_out; p.ws = (unsigned char*)d_ws;
    hipMemsetAsync((char*)d_ws + WS_BAR, 0, 16384, stream);
#if ONE_LAUNCH
    p.ph_lo = 0; p.ph_hi = N_PHASES;
    void* args[] = {&p};
    hipError_t e = hipLaunchCooperativeKernel((const void*)fwd_kernel, dim3(grid), dim3(NTHR), args, LDS_BYTES, stream);
    if (e != hipSuccess) fprintf(stderr, "cooperative launch failed: %s (grid %d)\n", hipGetErrorString(e), grid);
#else
    for (int ph = 0; ph < N_PHASES; ++ph) { p.ph_lo = ph; p.ph_hi = ph + 1; hipLaunchKernelGGL(fwd_kernel, dim3(grid), dim3(NTHR), LDS_BYTES, stream, p); }
#endif
}
```

```cpp
#include <hip/hip_runtime.h>
#include <cstdio>
#include <cstdint>

#define GAS __attribute__((address_space(1)))
#define LAS __attribute__((address_space(3)))
typedef unsigned short bf16_t;
typedef short bf16x8 __attribute__((ext_vector_type(8)));
typedef float f32x4 __attribute__((ext_vector_type(4)));
typedef float f32x16 __attribute__((ext_vector_type(16)));
typedef unsigned u32x4 __attribute__((ext_vector_type(4)));
typedef unsigned u32x2 __attribute__((ext_vector_type(2)));

constexpr int T_ = 16384, D_ = 2048, B_ = 8, S_ = 2048, NTHR = 512;
constexpr float EPS_ = 1e-6f;
constexpr int NMOD = 6 * D_;
constexpr int INCOLS = 7184;

constexpr size_t WS_BAR   = 0;
constexpr size_t WS_MOD   = 16384;
constexpr size_t WS_WG    = WS_MOD + (size_t)B_ * NMOD * 4;
constexpr size_t WS_GATE  = WS_WG + 16 * 2048 * 4;
constexpr size_t WS_F     = WS_GATE + (size_t)T_ * 16 * 4;
constexpr size_t WS_NST   = WS_F + 64 * 2048 * 4;
constexpr size_t WS_MST   = WS_NST + 1024 * 256 * 4;
constexpr size_t WS_WINT  = WS_MST + 4096;
constexpr size_t WS_WOT   = WS_WINT + (size_t)7168 * 2048 * 2;
constexpr size_t WS_WQT   = WS_WOT + (size_t)2048 * 2048 * 2;
constexpr size_t WS_H     = WS_WQT + (size_t)2048 * 2048 * 2;
constexpr size_t WS_P     = WS_H + (size_t)T_ * 2048 * 2;
constexpr size_t SEG_B    = (size_t)T_ * 1024 * 2;
constexpr size_t WS_CST   = WS_P + 7 * SEG_B;
constexpr size_t WS_E8D   = WS_CST + (size_t)1024 * 256 * 256 * 2;
constexpr size_t WS_E8U   = WS_E8D + (size_t)16384 * 2048;
constexpr size_t WS_END   = WS_E8U + (size_t)16384 * 2048;
constexpr size_t WS_QC    = WS_E8D;
constexpr size_t WS_KC    = WS_E8U;
constexpr size_t WS_QCTR  = 15360;
constexpr size_t WS_H2    = WS_P;
constexpr size_t WS_Q     = WS_H2 + (size_t)T_ * 2048 * 2;
constexpr size_t WS_IDX   = WS_Q + (size_t)T_ * 2048 * 2;
constexpr size_t WS_GW    = WS_IDX + (size_t)T_ * 128 * 4;
static_assert(WS_GW + (size_t)T_ * 128 * 4 <= WS_CST, "alias overflow");

struct Params {
    const float *x, *c, *w_ada, *b_ada, *g1, *g2, *w_in, *fox_fb, *fox_qg, *fox_kg, *conv_w, *conv_b, *m_ib, *m_fb, *m_hg, *w_out, *w_q, *sk1, *sk2, *e_down, *e_up;
    float* out; unsigned char* ws; int ph_lo, ph_hi;
};

__device__ __forceinline__ int get_tid() { int t = threadIdx.x; asm volatile("" : "+v"(t)); return t; }
__device__ __forceinline__ unsigned cvt_pk(float lo, float hi) { unsigned r; asm("v_cvt_pk_bf16_f32 %0, %1, %2" : "=v"(r) : "v"(lo), "v"(hi)); return r; }
__device__ __forceinline__ float bf2f(unsigned short h) { return __builtin_bit_cast(float, ((unsigned)h) << 16); }
__device__ __forceinline__ float bflo(unsigned w) { return __builtin_bit_cast(float, w << 16); }
__device__ __forceinline__ float bfhi(unsigned w) { return __builtin_bit_cast(float, w & 0xffff0000u); }
__device__ __forceinline__ float wsum(float v) {
#pragma unroll
    for (int o = 32; o; o >>= 1) v += __shfl_xor(v, o);
    return v; }
__device__ __forceinline__ float wmax(float v) {
#pragma unroll
    for (int o = 32; o; o >>= 1) v = fmaxf(v, __shfl_xor(v, o));
    return v; }
__device__ __forceinline__ float logsig(float x) { return fminf(x, 0.f) - log1pf(expf(-fabsf(x))); }
__device__ __forceinline__ float sigm(float x) { return 1.f / (1.f + expf(-x)); }
__device__ __forceinline__ float silu_f(float x) { return x / (1.f + expf(-x)); }
namespace pg8 {
#define PG8_LAS __attribute__((address_space(3)))
typedef unsigned short bf16_t;
typedef short bf16x8 __attribute__((ext_vector_type(8)));
typedef float f32x4 __attribute__((ext_vector_type(4)));
typedef unsigned u32x4 __attribute__((ext_vector_type(4)));
constexpr int BM = 256, BK = 64, HALF = 128, HTB = HALF * BK * 2  , STAGE_BYTES = 8 * HTB, NXCD = 8, WGM = 8;

__host__ __device__ __forceinline__ int lds_byte(int r, int c) { const int st = (r >> 4) * 2 + (c >> 5), rr = r & 15, cc = c & 31, ob = rr * 64 + cc * 2; return st * 1024 + (ob ^ (((ob >> 9) & 1) << 5)); }
__host__ __device__ __forceinline__ void stage_rc(int b, int& R, int& C) { const int st = b / 1024, sb = b % 1024, swz = sb ^ (((sb >> 9) & 1) << 5); R = (st >> 1) * 16 + swz / 64; C = (st & 1) * 32 + (swz % 64) / 2; }
__host__ __device__ __forceinline__ int perm32(int rho) { const int n = rho >> 4, i = rho & 15; return 8 * (i >> 2) + 4 * n + (i & 3); }

struct Unit { int pm, pn; };
struct Gemm { const bf16_t* A; const bf16_t* Bt; int M, N, K; };

struct StaticOrder {
    int nM, nN, nwg, G, c;
    __host__ __device__ void init(int M, int N, int G_, int c_) { nM = M / BM; nN = N / BM; nwg = nM * nN; G = G_; c = c_; }
    __host__ __device__ bool next(int i, Unit& u) const {
        const long L = (long)i * G + c; if (L >= nwg) return false;
        int wgid = (int)L; { const int q = nwg / NXCD, r = nwg % NXCD, xcd = wgid % NXCD, off = wgid / NXCD; wgid = (xcd < r ? xcd * (q + 1) : r * (q + 1) + (xcd - r) * q) + off; }
        const int nig = WGM * nN, gid = wgid / nig, fm = gid * WGM, gsz = (nM - fm) < WGM ? (nM - fm) : WGM;
        u.pm = fm + ((wgid % nig) % gsz); u.pn = (wgid % nig) / gsz; return true;
    }
    __device__ __forceinline__ void a_ready(const Unit&) const {}
    __device__ __forceinline__ void done(const Unit&) const {}
};
struct EpiSeg {
    static constexpr bool PERM = true, AFTER_DRAIN = false;
    bf16_t* P;
    __device__ __forceinline__ void operator()(const f32x4 (&acc)[2][2][4][2], const Unit& u, int wr, int wc, int fr, int fq) const {
        const int seg = u.pn >> 2; bf16_t* base = P + (size_t)seg * ((size_t)T_ * 1024);
        const int row0 = u.pm * BM + wr * 64 + fr, col0 = (u.pn & 3) * 256 + wc * 32 + 8 * fq;
#pragma unroll
        for (int ai = 0; ai < 2; ++ai)
#pragma unroll
            for (int m = 0; m < 4; ++m) { bf16_t* rowp = base + (size_t)(row0 + ai * HALF + m * 16) * 1024 + col0;
#pragma unroll
                for (int bj = 0; bj < 2; ++bj) { const f32x4 v0 = acc[ai][bj][m][0], v1 = acc[ai][bj][m][1];
                    u32x4 w; w.x = cvt_pk(v0[0], v0[1]); w.y = cvt_pk(v0[2], v0[3]); w.z = cvt_pk(v1[0], v1[1]); w.w = cvt_pk(v1[2], v1[3]);
                    *(u32x4*)(rowp + bj * HALF) = w; } }
    }
};
struct EpiBf {
    static constexpr bool PERM = true, AFTER_DRAIN = false;
    bf16_t* O; int ldc;
    __device__ __forceinline__ void operator()(const f32x4 (&acc)[2][2][4][2], const Unit& u, int wr, int wc, int fr, int fq) const {
        const int row0 = u.pm * BM + wr * 64 + fr, col0 = u.pn * BM + wc * 32 + 8 * fq;
#pragma unroll
        for (int ai = 0; ai < 2; ++ai)
#pragma unroll
            for (int m = 0; m < 4; ++m) { bf16_t* rowp = O + (size_t)(row0 + ai * HALF + m * 16) * ldc + col0;
#pragma unroll
                for (int bj = 0; bj < 2; ++bj) { const f32x4 v0 = acc[ai][bj][m][0], v1 = acc[ai][bj][m][1];
                    u32x4 w; w.x = cvt_pk(v0[0], v0[1]); w.y = cvt_pk(v0[2], v0[3]); w.z = cvt_pk(v1[0], v1[1]); w.w = cvt_pk(v1[2], v1[3]);
                    *(u32x4*)(rowp + bj * HALF) = w; } }
    }
};
struct EpiRes {
    static constexpr bool PERM = false, AFTER_DRAIN = false;
    const float* X; float* O; const float* mod; int goff;
    __device__ __forceinline__ void operator()(const f32x4 (&acc)[2][2][4][2], const Unit& u, int wr, int wc, int fr, int fq) const {
        const int row0 = u.pm * BM + wr * 64 + fr, col0 = u.pn * BM + wc * 32 + 4 * fq;
        const float* gp = mod + (size_t)((u.pm * BM) >> 11) * NMOD + goff + col0;
        f32x4 gv[2][2];
#pragma unroll
        for (int bj = 0; bj < 2; ++bj)
#pragma unroll
            for (int n = 0; n < 2; ++n) gv[bj][n] = *(const f32x4*)(gp + bj * HALF + 16 * n);
#pragma unroll
        for (int ai = 0; ai < 2; ++ai)
#pragma unroll
            for (int m = 0; m < 4; ++m) { const size_t ro = (size_t)(row0 + ai * HALF + m * 16) * D_ + col0;
#pragma unroll
                for (int bj = 0; bj < 2; ++bj)
#pragma unroll
                    for (int n = 0; n < 2; ++n) { const f32x4 xv = *(const f32x4*)(X + ro + bj * HALF + 16 * n);
                        *(f32x4*)(O + ro + bj * HALF + 16 * n) = xv + gv[bj][n] * acc[ai][bj][m][n]; } }
    }
};
template <class Epi, class Sched, bool ALIGN_EPI = false, bool SP2 = false>
__device__ __forceinline__ void gemm_phase(PG8_LAS unsigned char* lds, const Gemm g, const Sched& S, const Epi& E) {
    const int tid = get_tid(), wid = __builtin_amdgcn_readfirstlane(tid >> 6), lane = tid & 63, wr = wid >> 2, wc = wid & 3, fr = lane & 15, fq = lane >> 4;
    const int K = g.K, nt = K / BK;
    unsigned voffA[2], voffB[2];
#pragma unroll
    for (int i = 0; i < 2; ++i) { int R, C; stage_rc(tid * 16 + i * 8192, R, C); const int Rb = Epi::PERM ? ((R & ~31) + perm32(R & 31)) : R;
        voffA[i] = (unsigned)(R * K + C) * 2u; voffB[i] = (unsigned)(Rb * K + C) * 2u; }
    const size_t kstep = (size_t)(BK * 2);
    const size_t hstep = (size_t)HALF * K * 2;
    const size_t tstep = 2 * hstep;
    const unsigned ldsw = (unsigned)wid * 1024u;
    const int aoff = lds_byte(wr * 64 + fr, fq * 8), boff = lds_byte(wc * 32 + fr, fq * 8);
#define PG8_SA(b, h) (((b) * 2 + (h)) * HTB)
#define PG8_SB(b, h) ((4 + (b) * 2 + (h)) * HTB)
#define PG8_STAGE(bufoff, gbase, voff) do { _Pragma("unroll") for (int _i = 0; _i < 2; ++_i) \
        __builtin_amdgcn_global_load_lds((const unsigned*)((const char*)(gbase) + (voff)[_i]), (PG8_LAS unsigned*)(lds + (bufoff) + ldsw + _i * 8192), 16, 0, 0); } while (0)
#define PG8_LDA(dst, b, h) do { _Pragma("unroll") for (int m = 0; m < 4; ++m) _Pragma("unroll") for (int k = 0; k < 2; ++k) dst[m][k] = *(const PG8_LAS bf16x8*)(lds + PG8_SA(b, h) + aoff + m * 2048 + k * 1024); } while (0)
#define PG8_LDB(dst, b, h) do { _Pragma("unroll") for (int n = 0; n < 2; ++n) _Pragma("unroll") for (int k = 0; k < 2; ++k) dst[n][k] = *(const PG8_LAS bf16x8*)(lds + PG8_SB(b, h) + boff + n * 2048 + k * 1024); } while (0)
#define PG8_MMA(ai, bj, At, Bt) do { __builtin_amdgcn_s_setprio(1); _Pragma("unroll") for (int m = 0; m < 4; ++m) _Pragma("unroll") for (int n = 0; n < 2; ++n) _Pragma("unroll") for (int k = 0; k < 2; ++k) \
        acc[ai][bj][m][n] = __builtin_amdgcn_mfma_f32_16x16x32_bf16(Bt[n][k], At[m][k], acc[ai][bj][m][n], 0, 0, 0); __builtin_amdgcn_s_setprio(0); } while (0)
#define PG8_WAIT_V(n) asm volatile("s_waitcnt vmcnt(" #n ")" ::: "memory")
#define PG8_WAIT_L(n) asm volatile("s_waitcnt lgkmcnt(" #n ")" ::: "memory")
#define PG8_BAR __builtin_amdgcn_s_barrier()
#define PG8_SCHED __builtin_amdgcn_sched_barrier(0)
    Unit cur, nxt; int ui = 0;
    if (!S.next(0, cur)) return;
    f32x4 acc[2][2][4][2];
#pragma unroll
    for (int a = 0; a < 2; ++a)
#pragma unroll
        for (int b = 0; b < 2; ++b)
#pragma unroll
            for (int m = 0; m < 4; ++m)
#pragma unroll
                for (int n = 0; n < 2; ++n) acc[a][b][m][n] = (f32x4){0.f, 0.f, 0.f, 0.f};
    bf16x8 At[4][2], B0[2][2], B1[2][2];
    const char* cA = (const char*)g.A + (size_t)cur.pm * tstep; const char* cB = (const char*)g.Bt + (size_t)cur.pn * tstep;
    S.a_ready(cur);
    if constexpr (SP2) {
        PG8_STAGE(PG8_SB(0, 0), cB, voffB); PG8_STAGE(PG8_SB(0, 1), cB + hstep, voffB); PG8_STAGE(PG8_SA(0, 0), cA, voffA); PG8_STAGE(PG8_SA(0, 1), cA + hstep, voffA);
        if (wr == 1) PG8_BAR;
        PG8_WAIT_V(2); PG8_BAR;
        PG8_STAGE(PG8_SB(1, 0), cB + kstep, voffB); PG8_STAGE(PG8_SA(1, 0), cA + kstep, voffA); PG8_STAGE(PG8_SB(1, 1), cB + hstep + kstep, voffB);
        PG8_WAIT_V(6); PG8_BAR;
    } else {
        PG8_STAGE(PG8_SB(0, 0), cB, voffB); PG8_STAGE(PG8_SA(0, 0), cA, voffA); PG8_STAGE(PG8_SB(0, 1), cB + hstep, voffB); PG8_STAGE(PG8_SA(0, 1), cA + hstep, voffA);
        if (wr == 1) PG8_BAR;
        PG8_WAIT_V(4); PG8_BAR;
        PG8_STAGE(PG8_SB(1, 0), cB + kstep, voffB); PG8_STAGE(PG8_SA(1, 0), cA + kstep, voffA); PG8_STAGE(PG8_SB(1, 1), cB + hstep + kstep, voffB);
        PG8_WAIT_V(6); PG8_BAR;
    }
    for (;;) {
        const bool has_next = S.next(ui + 1, nxt);
        const char* nA = has_next ? (const char*)g.A + (size_t)nxt.pm * tstep : cA; const char* nB = has_next ? (const char*)g.Bt + (size_t)nxt.pn * tstep : cB;
        for (int t = 0; t < nt; t += 2) {
            const bool last = (t == nt - 2);
            const char* a1 = cA + (size_t)(t + 1) * kstep;
            const char* a2 = last ? nA : cA + (size_t)(t + 2) * kstep; const char* b2 = last ? nB : cB + (size_t)(t + 2) * kstep;
            const char* a3 = a2 + kstep; const char* b3 = b2 + kstep;
            if (last && has_next) S.a_ready(nxt);
            if constexpr (SP2) {
            PG8_LDB(B0, 0, 0); PG8_LDB(B1, 0, 1); PG8_SCHED; PG8_LDA(At, 0, 0); PG8_STAGE(PG8_SA(1, 1), a1 + hstep, voffA);
            PG8_WAIT_V(8); PG8_WAIT_L(0); PG8_BAR; PG8_MMA(0, 0, At, B0); PG8_MMA(0, 1, At, B1); PG8_BAR; PG8_SCHED;
            PG8_LDA(At, 0, 1); PG8_STAGE(PG8_SB(0, 0), b2, voffB); PG8_STAGE(PG8_SB(0, 1), b2 + hstep, voffB); PG8_STAGE(PG8_SA(0, 0), a2, voffA);
            PG8_WAIT_V(8); PG8_WAIT_L(0); PG8_BAR; PG8_MMA(1, 0, At, B0); PG8_MMA(1, 1, At, B1); PG8_BAR; PG8_SCHED;
            PG8_LDB(B0, 1, 0); PG8_LDB(B1, 1, 1); PG8_SCHED; PG8_LDA(At, 1, 0); PG8_STAGE(PG8_SA(0, 1), a2 + hstep, voffA);
            PG8_WAIT_V(8); PG8_WAIT_L(0); PG8_BAR; PG8_MMA(0, 0, At, B0); PG8_MMA(0, 1, At, B1); PG8_BAR; PG8_SCHED;
            PG8_LDA(At, 1, 1); PG8_STAGE(PG8_SB(1, 0), b3, voffB); PG8_STAGE(PG8_SB(1, 1), b3 + hstep, voffB); PG8_STAGE(PG8_SA(1, 0), a3, voffA);
            PG8_WAIT_V(8); PG8_WAIT_L(0); PG8_BAR; PG8_MMA(1, 0, At, B0); PG8_MMA(1, 1, At, B1); PG8_BAR; PG8_SCHED;
            } else {
            PG8_LDB(B0, 0, 0); PG8_SCHED; PG8_LDA(At, 0, 0); PG8_STAGE(PG8_SA(1, 1), a1 + hstep, voffA);
            PG8_WAIT_L(8); PG8_BAR; PG8_WAIT_L(0); PG8_MMA(0, 0, At, B0); PG8_BAR; PG8_SCHED;
            PG8_LDB(B1, 0, 1); PG8_STAGE(PG8_SB(0, 0), b2, voffB);
            PG8_BAR; PG8_WAIT_L(0); PG8_MMA(0, 1, At, B1); PG8_BAR;
            PG8_LDA(At, 0, 1); PG8_STAGE(PG8_SA(0, 0), a2, voffA);
            PG8_BAR; PG8_WAIT_L(0); PG8_MMA(1, 0, At, B0); PG8_BAR; PG8_SCHED;
            PG8_STAGE(PG8_SB(0, 1), b2 + hstep, voffB);
            PG8_WAIT_V(6); PG8_BAR; PG8_MMA(1, 1, At, B1); PG8_BAR;
            PG8_LDB(B0, 1, 0); PG8_SCHED; PG8_LDA(At, 1, 0); PG8_STAGE(PG8_SA(0, 1), a2 + hstep, voffA);
            PG8_WAIT_L(8); PG8_BAR; PG8_WAIT_L(0); PG8_MMA(0, 0, At, B0); PG8_BAR; PG8_SCHED;
            PG8_LDB(B1, 1, 1); PG8_STAGE(PG8_SB(1, 0), b3, voffB);
            PG8_BAR; PG8_WAIT_L(0); PG8_MMA(0, 1, At, B1); PG8_BAR;
            PG8_LDA(At, 1, 1); PG8_STAGE(PG8_SA(1, 0), a3, voffA);
            PG8_BAR; PG8_WAIT_L(0); PG8_MMA(1, 0, At, B0); PG8_BAR; PG8_SCHED;
            PG8_STAGE(PG8_SB(1, 1), b3 + hstep, voffB);
            PG8_WAIT_V(6); PG8_BAR; PG8_MMA(1, 1, At, B1); PG8_BAR;
            }
        }
        if constexpr (ALIGN_EPI) { if (wr == 0) PG8_BAR; }
        if constexpr (!Epi::AFTER_DRAIN) { E(acc, cur, wr, wc, fr, fq); S.done(cur); }
        if (!has_next) break;
#pragma unroll
        for (int a = 0; a < 2; ++a)
#pragma unroll
            for (int b = 0; b < 2; ++b)
#pragma unroll
                for (int m = 0; m < 4; ++m)
#pragma unroll
                    for (int n = 0; n < 2; ++n) acc[a][b][m][n] = (f32x4){0.f, 0.f, 0.f, 0.f};
        cur = nxt; cA = nA; cB = nB; ++ui;
        if constexpr (ALIGN_EPI) { if (wr == 1) PG8_BAR; }
    }
    PG8_WAIT_V(0);
    if constexpr (!ALIGN_EPI) { if (wr == 0) PG8_BAR; }
    PG8_BAR;
    if constexpr (Epi::AFTER_DRAIN) { E.fused(acc, cur, wr, wc, fr, fq, lds, wid, lane); S.done(cur); }
#undef PG8_SA
#undef PG8_SB
#undef PG8_STAGE
#undef PG8_LDA
#undef PG8_LDB
#undef PG8_MMA
#undef PG8_WAIT_V
#undef PG8_WAIT_L
#undef PG8_BAR
#undef PG8_SCHED
}
}
#define XB_TMO      128
#define XB_XCNT(j)  (256  + 64 * (j))
#define XB_XSUB(j)  (1280 + 64 * (j))
#define XB_XGEN(j)  (2304 + 64 * (j))
#define XB_TOP      3328
#define XB_TOPGEN   3392
#define XCD_BAR_WORDS 3456
#define XB_SPIN_CAP (1u << 18)

__device__ __forceinline__ unsigned xb_ld(unsigned* p)              { return __hip_atomic_load(p, __ATOMIC_RELAXED, __HIP_MEMORY_SCOPE_AGENT); }
__device__ __forceinline__ unsigned xb_add(unsigned* p, unsigned v) { return __hip_atomic_fetch_add(p, v, __ATOMIC_RELAXED, __HIP_MEMORY_SCOPE_AGENT); }
__device__ __forceinline__ unsigned xb_xcc_id() { return (unsigned)__builtin_amdgcn_s_getreg((3 << 11) | 20) & 0xFu; }
#define XB_SPIN(cond, bar) do { unsigned _sp = 0; while (cond) { __builtin_amdgcn_s_sleep(1); \
    if ((++_sp & 255u) == 0u) { if (xb_ld(&(bar)[XB_TMO])) break; if (_sp > XB_SPIN_CAP) { atomicAdd(&(bar)[XB_TMO], 1u); break; } } } } while (0)

struct XcdBarrier {
    unsigned* bar; unsigned x;
    volatile LAS unsigned* st;
};

__device__ __forceinline__ XcdBarrier xcd_barrier_post(unsigned* bar, volatile LAS unsigned* st) {
    XcdBarrier b; b.bar = bar; b.x = xb_xcc_id(); b.st = st;
    if (threadIdx.x == 0) (void)xb_add(&bar[XB_XCNT(b.x)], 1u);
    return b;
}
__device__ __forceinline__ void xcd_barrier_complete(unsigned* bar, unsigned x, unsigned& nloc, unsigned& nx) {
    const unsigned G = gridDim.x * gridDim.y * gridDim.z;
    unsigned sum, cnt, mine, sp = 0u;
    for (;;) {
        sum = 0u; cnt = 0u; mine = 0u;
#pragma unroll
        for (unsigned j = 0; j < 16; ++j) { const unsigned c = xb_ld(&bar[XB_XCNT(j)]); sum += c; cnt += (c > 0u) ? 1u : 0u; mine = (j == x) ? c : mine; }
        if (sum == G) break;
        __builtin_amdgcn_s_sleep(1);
        if ((++sp & 255u) == 0u) { if (xb_ld(&bar[XB_TMO])) break; if (sp > XB_SPIN_CAP) { atomicAdd(&bar[XB_TMO], 1u); break; } }
    }
    nloc = mine > 0u ? mine : 1u; nx = cnt > 0u ? cnt : 1u;
}

__device__ __forceinline__ void xcd_barrier(const XcdBarrier& b) {
    asm volatile("s_waitcnt vmcnt(0)" ::: "memory");
    __syncthreads();
    if (threadIdx.x == 0) {
        unsigned* bar = b.bar;
        __builtin_amdgcn_s_waitcnt(0);
        unsigned nloc = b.st[0], nx = b.st[1];
        if (nloc == 0u) { xcd_barrier_complete(bar, b.x, nloc, nx); b.st[0] = nloc; b.st[1] = nx; }
        const unsigned old = xb_add(&bar[XB_XSUB(b.x)], 1u);
        const unsigned gen = old / nloc;
        if (old + 1u == (gen + 1u) * nloc) {
            __builtin_amdgcn_fence(__ATOMIC_RELEASE, "agent");
            asm volatile("s_waitcnt vmcnt(0)" ::: "memory");
            const unsigned og = xb_add(&bar[XB_TOP], 1u);
            const unsigned tg = og / nx;
            if (og + 1u == (tg + 1u) * nx) xb_add(&bar[XB_TOPGEN], 1u);
            else XB_SPIN(xb_ld(&bar[XB_TOPGEN]) == tg, bar);
            __builtin_amdgcn_fence(__ATOMIC_ACQUIRE, "agent");
            xb_add(&bar[XB_XGEN(b.x)], 1u);
            asm volatile("s_waitcnt vmcnt(0)" ::: "memory");
        } else {
            XB_SPIN(xb_ld(&bar[XB_XGEN(b.x)]) == gen, bar);
            __builtin_amdgcn_fence(__ATOMIC_ACQUIRE, "agent");
            asm volatile("s_waitcnt vmcnt(0)" ::: "memory");
        }
    }
    __syncthreads();
}
__device__ __forceinline__ void phase_prep(const Params& p, unsigned char* lds, int bid, int nb) {
    const int tid = get_tid(), lane = tid & 63, wave = tid >> 6;
    unsigned char* ws = p.ws;
    float* mod = (float*)(ws + WS_MOD);
    if (bid < 192) {
        float* sc = (float*)lds;
        float* red = sc + 8 * 2048;
        for (int i = tid; i < 8 * 2048; i += NTHR) sc[i] = silu_f(p.c[i]);
        __syncthreads();
        for (int it = bid; it < 192; it += nb) {
            const int col = it * 64 + lane;
            float acc[8];
#pragma unroll
            for (int b = 0; b < 8; ++b) acc[b] = 0.f;
            const float* w = p.w_ada + (size_t)(wave * 256) * NMOD + col;
            const float* s0 = sc + wave * 256;
#pragma unroll 4
            for (int k = 0; k < 256; ++k) {
                const float wv = w[(size_t)k * NMOD];
#pragma unroll
                for (int b = 0; b < 8; ++b) acc[b] += s0[b * 2048 + k] * wv;
            }
#pragma unroll
            for (int b = 0; b < 8; ++b) red[(wave * 8 + b) * 64 + lane] = acc[b];
            __syncthreads();
            {   const int b = wave; float s = p.b_ada[col];
#pragma unroll
                for (int w2 = 0; w2 < 8; ++w2) s += red[(w2 * 8 + b) * 64 + lane];
                mod[b * NMOD + col] = s; }
            __syncthreads();
        }
    }
    __syncthreads();
    {
        float* tile = (float*)lds;
        bf16_t* WinT = (bf16_t*)(ws + WS_WINT); bf16_t* WoT = (bf16_t*)(ws + WS_WOT); bf16_t* WqT = (bf16_t*)(ws + WS_WQT);
        for (int item = bid; item < 5632; item += nb) {
            const float* src; int ld, scol; bf16_t* dst; int kt;
            if (item < 3584) { const int seg = item >> 9, rem = item & 511, ntile = rem >> 5; kt = rem & 31;
                src = p.w_in; ld = INCOLS; scol = (seg < 3 ? seg * 1024 : 3080 + (seg - 3) * 1024) + ntile * 64; dst = WinT + (size_t)(seg * 1024 + ntile * 64) * 2048; }
            else if (item < 4608) { const int rem = item - 3584, ntile = rem >> 5; kt = rem & 31; src = p.w_out; ld = 2048; scol = ntile * 64; dst = WoT + (size_t)(ntile * 64) * 2048; }
            else { const int rem = item - 4608, ntile = rem >> 5; kt = rem & 31; src = p.w_q; ld = 2048; scol = ntile * 64; dst = WqT + (size_t)(ntile * 64) * 2048; }
            const int k0 = kt * 64;
#pragma unroll
            for (int ii = 0; ii < 8; ++ii) { const int k = wave + 8 * ii; tile[k * 65 + lane] = src[(size_t)(k0 + k) * ld + scol + lane]; }
            __syncthreads();
#pragma unroll
            for (int ii = 0; ii < 8; ++ii) { const int n = wave + 8 * ii; dst[(size_t)n * 2048 + k0 + lane] = (bf16_t)(cvt_pk(tile[lane * 65 + n], 0.f) & 0xffffu); }
            __syncthreads();
        }
    }
    {
        float* Wg = (float*)(ws + WS_WG);
        for (int i = bid * NTHR + tid; i < 16 * 2048; i += nb * NTHR) { const int g = i >> 11, k = i & 2047; const int col = g < 8 ? 3072 + g : 7176 + (g - 8);
            Wg[i] = p.w_in[(size_t)k * INCOLS + col]; }
    }
}

__device__ __forceinline__ void convert_experts(const Params& p, int bid, int nb) {
    const int tid = get_tid(); unsigned char* ws = p.ws;
    {
        unsigned char* E8D = ws + WS_E8D; unsigned char* E8U = ws + WS_E8U;
        for (int i = bid * NTHR + tid; i < 4194304; i += nb * NTHR) {
            const int which = i >> 21, r = i & 2097151;
            const f32x4* sp = (const f32x4*)(which ? p.e_up : p.e_down) + (size_t)r * 4;
            const float scl = which ? 32.f : 512.f;
            const f32x4 a = sp[0] * scl, b = sp[1] * scl, c = sp[2] * scl, d = sp[3] * scl;
            u32x4 w; int t;
            t = __builtin_amdgcn_cvt_pk_fp8_f32(a[0], a[1], 0, false); t = __builtin_amdgcn_cvt_pk_fp8_f32(a[2], a[3], t, true); w.x = (unsigned)t;
            t = __builtin_amdgcn_cvt_pk_fp8_f32(b[0], b[1], 0, false); t = __builtin_amdgcn_cvt_pk_fp8_f32(b[2], b[3], t, true); w.y = (unsigned)t;
            t = __builtin_amdgcn_cvt_pk_fp8_f32(c[0], c[1], 0, false); t = __builtin_amdgcn_cvt_pk_fp8_f32(c[2], c[3], t, true); w.z = (unsigned)t;
            t = __builtin_amdgcn_cvt_pk_fp8_f32(d[0], d[1], 0, false); t = __builtin_amdgcn_cvt_pk_fp8_f32(d[2], d[3], t, true); w.w = (unsigned)t;
            *(u32x4*)((which ? E8U : E8D) + (size_t)r * 16) = w;
        }
    }
}

template <bool GATES>
__device__ __forceinline__ void phase_norm(const float* xin, const float* gain, const float* mod, int shift_off, int scale_off, bf16_t* hout, const float* Wg, float* gate_out, int bid, int nb) {
    const int tid = get_tid(), lane = tid & 63, wave = tid >> 6;
    for (int row = bid * 8 + wave; row < T_; row += nb * 8) {
        const f32x4* xr = (const f32x4*)(xin + (size_t)row * D_);
        f32x4 v[8]; float ss = 0.f;
#pragma unroll
        for (int j = 0; j < 8; ++j) { v[j] = xr[lane + 64 * j]; ss += v[j][0] * v[j][0] + v[j][1] * v[j][1] + v[j][2] * v[j][2] + v[j][3] * v[j][3]; }
        ss = wsum(ss);
        const float r = rsqrtf(ss * (1.f / D_) + EPS_);
        const float* mb = mod + (size_t)(row >> 11) * NMOD;
        f32x4 hv[8];
#pragma unroll
        for (int j = 0; j < 8; ++j) {
            const int k = 4 * (lane + 64 * j);
            const f32x4 gn = *(const f32x4*)(gain + k), sh = *(const f32x4*)(mb + shift_off + k), scl = *(const f32x4*)(mb + scale_off + k);
#pragma unroll
            for (int e = 0; e < 4; ++e) hv[j][e] = (v[j][e] * r) * gn[e] * (1.f + scl[e]) + sh[e];
            u32x2 w; w.x = cvt_pk(hv[j][0], hv[j][1]); w.y = cvt_pk(hv[j][2], hv[j][3]);
            *(u32x2*)(hout + (size_t)row * D_ + k) = w;
        }
        if (GATES) {
            float outv = 0.f;
#pragma unroll 1
            for (int g = 0; g < 16; ++g) {
                float ga = 0.f;
#pragma unroll
                for (int j = 0; j < 8; ++j) { const f32x4 wv = *(const f32x4*)(Wg + g * 2048 + 4 * (lane + 64 * j)); ga += hv[j][0] * wv[0] + hv[j][1] * wv[1] + hv[j][2] * wv[2] + hv[j][3] * wv[3]; }
                const float s = wsum(ga); if (lane == g) outv = s;
            }
            if (lane < 16) gate_out[(size_t)row * 16 + lane] = outv;
        }
    }
}

__device__ __forceinline__ void phase_post(const Params& p, int bid, int nb) {
    const int tid = get_tid(), lane = tid & 63, wave = tid >> 6;
    unsigned char* ws = p.ws;
    bf16_t* Pq = (bf16_t*)(ws + WS_P); bf16_t* Pk = (bf16_t*)(ws + WS_P + SEG_B);
    const float qscale = 0.08838834764831845f;
    for (int r = bid * 8 + wave; r < 2 * T_; r += nb * 8) {
        const int which = r >= T_ ? 1 : 0; const int t = r - which * T_;
        bf16_t* ptr = (which ? Pk : Pq) + (size_t)t * 1024 + lane * 16;
        const float* gn = (which ? p.fox_kg : p.fox_qg) + (lane & 7) * 16;
        u32x4 a = *(const u32x4*)ptr, b = *(const u32x4*)(ptr + 8);
        float f[16];
        f[0] = bflo(a.x); f[1] = bfhi(a.x); f[2] = bflo(a.y); f[3] = bfhi(a.y); f[4] = bflo(a.z); f[5] = bfhi(a.z); f[6] = bflo(a.w); f[7] = bfhi(a.w);
        f[8] = bflo(b.x); f[9] = bfhi(b.x); f[10] = bflo(b.y); f[11] = bfhi(b.y); f[12] = bflo(b.z); f[13] = bfhi(b.z); f[14] = bflo(b.w); f[15] = bfhi(b.w);
        float ss = 0.f;
#pragma unroll
        for (int i = 0; i < 16; ++i) ss += f[i] * f[i];
        ss += __shfl_xor(ss, 1); ss += __shfl_xor(ss, 2); ss += __shfl_xor(ss, 4);
        const float rr = rsqrtf(ss * (1.f / 128.f) + EPS_) * (which ? 1.f : qscale);
#pragma unroll
        for (int i = 0; i < 16; ++i) f[i] = (f[i] * rr) * gn[i];
        a.x = cvt_pk(f[0], f[1]); a.y = cvt_pk(f[2], f[3]); a.z = cvt_pk(f[4], f[5]); a.w = cvt_pk(f[6], f[7]);
        b.x = cvt_pk(f[8], f[9]); b.y = cvt_pk(f[10], f[11]); b.z = cvt_pk(f[12], f[13]); b.w = cvt_pk(f[14], f[15]);
        *(u32x4*)ptr = a; *(u32x4*)(ptr + 8) = b;
    }
    {
        const bf16_t* Mq = (const bf16_t*)(ws + WS_P + 3 * SEG_B); const bf16_t* Mk = (const bf16_t*)(ws + WS_P + 4 * SEG_B);
        bf16_t* QC = (bf16_t*)(ws + WS_QC); bf16_t* KC = (bf16_t*)(ws + WS_KC);
        for (int item = bid; item < 256; item += nb) {
            const int which = item >> 7, tb = item & 127, cg = tid & 127, run = tid >> 7, ch0 = cg * 8, ts = tb * 128 + run * 32, sp = ts & 2047;
            const bf16_t* src = (which ? Mk : Mq) + (size_t)ts * 1024 + ch0; bf16_t* dst = (which ? KC : QC) + (size_t)ts * 1024 + ch0;
            float w0[8], w1[8], w2[8], w3[8], cb[8], x0[8], x1[8], x2[8];
#pragma unroll
            for (int e = 0; e < 8; ++e) { const int ci = which * 1024 + ch0 + e; w0[e] = p.conv_w[ci]; w1[e] = p.conv_w[2048 + ci]; w2[e] = p.conv_w[4096 + ci]; w3[e] = p.conv_w[6144 + ci]; cb[e] = p.conv_b[ci]; }
            {   u32x4 a = {0u, 0u, 0u, 0u}, b = a, c = a;
                if (sp != 0) { a = *(const u32x4*)(src - 3 * 1024); b = *(const u32x4*)(src - 2 * 1024); c = *(const u32x4*)(src - 1024); }
#pragma unroll
                for (int e = 0; e < 4; ++e) { x0[2 * e] = bflo(a[e]); x0[2 * e + 1] = bfhi(a[e]); x1[2 * e] = bflo(b[e]); x1[2 * e + 1] = bfhi(b[e]); x2[2 * e] = bflo(c[e]); x2[2 * e + 1] = bfhi(c[e]); } }
            const float osc = which ? 0.0625f : 1.f;
            for (int s = 0; s < 32; ++s) {
                const u32x4 d = *(const u32x4*)(src + (size_t)s * 1024); float x3[8], y[8];
#pragma unroll
                for (int e = 0; e < 4; ++e) { x3[2 * e] = bflo(d[e]); x3[2 * e + 1] = bfhi(d[e]); }
#pragma unroll
                for (int e = 0; e < 8; ++e) { y[e] = silu_f(w0[e] * x0[e] + w1[e] * x1[e] + w2[e] * x2[e] + w3[e] * x3[e] + cb[e]) * osc; x0[e] = x1[e]; x1[e] = x2[e]; x2[e] = x3[e]; }
                u32x4 o; o.x = cvt_pk(y[0], y[1]); o.y = cvt_pk(y[2], y[3]); o.z = cvt_pk(y[4], y[5]); o.w = cvt_pk(y[6], y[7]);
                *(u32x4*)(dst + (size_t)s * 1024) = o;
            }
        }
    }
    const float* gate = (const float*)(ws + WS_GATE); float* F = (float*)(ws + WS_F);
    for (int sq = bid * 8 + wave; sq < 64; sq += nb * 8) {
        const int b = sq >> 3, h = sq & 7; const float fb = p.fox_fb[h];
        float v[32]; float run = 0.f;
#pragma unroll
        for (int i = 0; i < 32; ++i) { const int t = lane * 32 + i; run += logsig(gate[(size_t)(b * S_ + t) * 16 + h] + fb); v[i] = run; }
        float inc = run;
#pragma unroll
        for (int o = 1; o < 64; o <<= 1) { const float u = __shfl_up(inc, o); if (lane >= o) inc += u; }
        const float excl = inc - run;
#pragma unroll
        for (int i = 0; i < 32; ++i) F[(size_t)sq * S_ + lane * 32 + i] = v[i] + excl;
    }
}
__device__ __forceinline__ void fox_unit(const Params& p, unsigned char* lds, int b, int h, int qb) {
    const int tid = get_tid(), lane = tid & 63, wave = tid >> 6, r = lane & 31, hh = lane >> 5;
    unsigned char* ws = p.ws;
    const bf16_t* Pq = (const bf16_t*)(ws + WS_P); const bf16_t* Pk = (const bf16_t*)(ws + WS_P + SEG_B); const bf16_t* Pv = (const bf16_t*)(ws + WS_P + 2 * SEG_B);
    const float* F = (const float*)(ws + WS_F) + (size_t)(b * 8 + h) * S_;
    bf16_t* Oc = (bf16_t*)(ws + WS_H);
    bf16_t* Ks = (bf16_t*)lds;
    bf16_t* Vs = Ks + 64 * 136;
    float* Fs = (float*)(Vs + 128 * 72);
    const int q0w = qb * 256 + wave * 32, qs = q0w + r;
    const size_t trow = (size_t)(b * S_ + qs);
    bf16x8 qf[8];
#pragma unroll
    for (int ks = 0; ks < 8; ++ks) qf[ks] = *(const bf16x8*)(Pq + trow * 1024 + h * 128 + ks * 16 + hh * 8);
    const float Fq = F[qs];
    f32x16 o[4];
#pragma unroll
    for (int d = 0; d < 4; ++d)
#pragma unroll
        for (int i = 0; i < 16; ++i) o[d][i] = 0.f;
    float m = -INFINITY, l = 0.f;
    const int ntile = (qb * 256 + 256) / 64;
    for (int kt = 0; kt < ntile; ++kt) {
        const int k0 = kt * 64;
        __syncthreads();
#pragma unroll
        for (int i = 0; i < 2; ++i) { const int c = tid + NTHR * i, row = c >> 4, cc = c & 15;
            *(u32x4*)(Ks + row * 136 + cc * 8) = *(const u32x4*)(Pk + (size_t)(b * S_ + k0 + row) * 1024 + h * 128 + cc * 8); }
#pragma unroll
        for (int i = 0; i < 2; ++i) { const int c = tid + NTHR * i, key = c >> 4, cc = c & 15;
            const u32x4 w = *(const u32x4*)(Pv + (size_t)(b * S_ + k0 + key) * 1024 + h * 128 + cc * 8);
            bf16_t* vp = Vs + (cc * 8) * 72 + key;
            vp[0 * 72] = (bf16_t)(w.x & 0xffffu); vp[1 * 72] = (bf16_t)(w.x >> 16); vp[2 * 72] = (bf16_t)(w.y & 0xffffu); vp[3 * 72] = (bf16_t)(w.y >> 16);
            vp[4 * 72] = (bf16_t)(w.z & 0xffffu); vp[5 * 72] = (bf16_t)(w.z >> 16); vp[6 * 72] = (bf16_t)(w.w & 0xffffu); vp[7 * 72] = (bf16_t)(w.w >> 16); }
        if (tid < 64) Fs[tid] = F[k0 + tid];
        __syncthreads();
        if (k0 <= q0w + 31) {
            f32x16 s[2];
#pragma unroll
            for (int kb = 0; kb < 2; ++kb) {
#pragma unroll
                for (int i = 0; i < 16; ++i) s[kb][i] = 0.f;
#pragma unroll
                for (int ks = 0; ks < 8; ++ks) { const bf16x8 a = *(const bf16x8*)(Ks + (kb * 32 + r) * 136 + ks * 16 + hh * 8);
                    s[kb] = __builtin_amdgcn_mfma_f32_32x32x16_bf16(a, qf[ks], s[kb], 0, 0, 0); }
            }
            float mx = m;
#pragma unroll
            for (int kb = 0; kb < 2; ++kb)
#pragma unroll
                for (int i = 0; i < 16; ++i) { const int kl = kb * 32 + (i & 3) + 8 * (i >> 2) + 4 * hh; float val = s[kb][i] + Fq - Fs[kl];
                    if (k0 + kl > qs) val = -INFINITY; s[kb][i] = val; mx = fmaxf(mx, val); }
            mx = fmaxf(mx, __shfl_xor(mx, 32));
            const float alpha = __expf(m - mx);
            float ps = 0.f;
#pragma unroll
            for (int kb = 0; kb < 2; ++kb)
#pragma unroll
                for (int i = 0; i < 16; ++i) { const float pv = __expf(s[kb][i] - mx); s[kb][i] = pv; ps += pv; }
            l = l * alpha + ps; m = mx;
#pragma unroll
            for (int d = 0; d < 4; ++d)
#pragma unroll
                for (int i = 0; i < 16; ++i) o[d][i] *= alpha;
#pragma unroll
            for (int kb = 0; kb < 2; ++kb)
#pragma unroll
                for (int st = 0; st < 2; ++st) {
                    u32x4 pw; pw.x = cvt_pk(s[kb][8 * st + 0], s[kb][8 * st + 1]); pw.y = cvt_pk(s[kb][8 * st + 2], s[kb][8 * st + 3]);
                    pw.z = cvt_pk(s[kb][8 * st + 4], s[kb][8 * st + 5]); pw.w = cvt_pk(s[kb][8 * st + 6], s[kb][8 * st + 7]);
                    const bf16x8 pf = __builtin_bit_cast(bf16x8, pw);
#pragma unroll
                    for (int d = 0; d < 4; ++d) { const bf16_t* vp = Vs + (d * 32 + r) * 72 + kb * 32 + st * 16 + hh * 4;
                        const u32x2 lo = *(const u32x2*)vp, hi = *(const u32x2*)(vp + 8);
                        u32x4 vw; vw.x = lo.x; vw.y = lo.y; vw.z = hi.x; vw.w = hi.y;
                        o[d] = __builtin_amdgcn_mfma_f32_32x32x16_bf16(__builtin_bit_cast(bf16x8, vw), pf, o[d], 0, 0, 0); }
                }
        }
    }
    l += __shfl_xor(l, 32);
    const float inv = 1.f / l;
#pragma unroll
    for (int d = 0; d < 4; ++d)
#pragma unroll
        for (int g = 0; g < 4; ++g) { u32x2 w; w.x = cvt_pk(o[d][4 * g] * inv, o[d][4 * g + 1] * inv); w.y = cvt_pk(o[d][4 * g + 2] * inv, o[d][4 * g + 3] * inv);
            *(u32x2*)(Oc + trow * D_ + h * 128 + d * 32 + 8 * g + 4 * hh) = w; }
}

typedef short s16x4 __attribute__((ext_vector_type(4)));
__device__ __forceinline__ s16x4 lds_tr16(const unsigned char* p) { return __builtin_amdgcn_ds_read_tr16_b64_v4i16((LAS s16x4*)p); }
__device__ __forceinline__ bf16x8 tr_frag(const unsigned char* p0, int row4_bytes) {
    const s16x4 a = lds_tr16(p0), b = lds_tr16(p0 + row4_bytes);
    bf16x8 f; f[0] = a[0]; f[1] = a[1]; f[2] = a[2]; f[3] = a[3]; f[4] = b[0]; f[5] = b[1]; f[6] = b[2]; f[7] = b[3]; return f;
}
__device__ __forceinline__ void mlstm_passA(const Params& p, unsigned char* lds, int unit) {
    const int tid = get_tid(), lane = tid & 63, wave = tid >> 6, r = lane & 31, hh = lane >> 5, li = lane & 15;
    const int b = unit >> 3, h = (unit >> 1) & 3, eh = unit & 1;
    unsigned char* ws = p.ws;
    const bf16_t* KC = (const bf16_t*)(ws + WS_KC); const bf16_t* Mv = (const bf16_t*)(ws + WS_P + 5 * SEG_B);
    const float* gate = (const float*)(ws + WS_GATE);
    bf16_t* Cst = (bf16_t*)(ws + WS_CST); float* nst = (float*)(ws + WS_NST); float* mst = (float*)(ws + WS_MST);
    constexpr int KST = 528, VST = 272;
    unsigned char* ksm = lds;
    unsigned char* vsm = ksm + 64 * KST;
    float* WSV = (float*)(vsm + 64 * VST);
    float* SCL = WSV + 2048;
    __syncthreads();
    for (int cc = wave; cc < 32; cc += 8) {
        const int t = b * S_ + cc * 64 + lane;
        const float ipre = gate[(size_t)t * 16 + 8 + h] + p.m_ib[h], fpre = gate[(size_t)t * 16 + 12 + h] + p.m_fb[h];
        float bc = logsig(fpre);
#pragma unroll
        for (int o = 1; o < 64; o <<= 1) { const float u = __shfl_up(bc, o); if (lane >= o) bc += u; }
        const float a = ipre - bc; const float amax = wmax(a); const float bL = __shfl(bc, 63);
        WSV[cc * 64 + lane] = a; if (lane == 0) { SCL[cc] = bL; SCL[32 + cc] = amax; }
    }
    __syncthreads();
    if (tid == 0) { float m = 0.f; for (int cc = 0; cc < 32; ++cc) { const float mn = SCL[cc] + fmaxf(m, SCL[32 + cc]); SCL[64 + cc] = expf(SCL[cc] + m - mn); SCL[96 + cc] = mn; if (eh == 0) mst[(b * 4 + h) * 32 + cc] = m; m = mn; } }
    __syncthreads();
    for (int i = tid; i < 2048; i += NTHR) { const int cc = i >> 6; WSV[i] = expf(SCL[cc] + WSV[i] - SCL[96 + cc]); }
    f32x16 acc[4];
#pragma unroll
    for (int et = 0; et < 4; ++et)
#pragma unroll
        for (int i = 0; i < 16; ++i) acc[et][i] = 0.f;
    float nreg = 0.f;
    const int kb_off = (8 * hh + (li >> 2)) * KST + (wave * 32 + 16 * (r >> 4) + 4 * (li & 3)) * 2;
    const int vb_off = (8 * hh + (li >> 2)) * VST + (16 * (r >> 4) + 4 * (li & 3)) * 2;
    for (int cc = 0; cc < 32; ++cc) {
        const int bhc = (b * 4 + h) * 32 + cc, t0 = b * S_ + cc * 64;
#pragma unroll
        for (int et = 0; et < 4; ++et)
#pragma unroll
            for (int i = 0; i < 16; ++i) Cst[((size_t)bhc * 256 + eh * 128 + et * 32 + (i & 3) + 8 * (i >> 2) + 4 * hh) * 256 + wave * 32 + r] = (bf16_t)(cvt_pk(acc[et][i], 0.f) & 0xffffu);
        if (eh == 0 && tid < 256) nst[(size_t)bhc * 256 + tid] = nreg;
        if (cc == 31) break;
        __syncthreads();
#pragma unroll
        for (int i = 0; i < 4; ++i) { const int c = tid + NTHR * i, row = c >> 5, c16 = c & 31;
            *(u32x4*)(ksm + row * KST + c16 * 16) = *(const u32x4*)(KC + (size_t)(t0 + row) * 1024 + h * 256 + c16 * 8); }
#pragma unroll
        for (int i = 0; i < 2; ++i) { const int c = tid + NTHR * i, row = c >> 4, c16 = c & 15; const float wv = WSV[cc * 64 + row];
            const u32x4 w = *(const u32x4*)(Mv + (size_t)(t0 + row) * 1024 + h * 256 + eh * 128 + c16 * 8);
            u32x4 o; o.x = cvt_pk(bflo(w.x) * wv, bfhi(w.x) * wv); o.y = cvt_pk(bflo(w.y) * wv, bfhi(w.y) * wv); o.z = cvt_pk(bflo(w.z) * wv, bfhi(w.z) * wv); o.w = cvt_pk(bflo(w.w) * wv, bfhi(w.w) * wv);
            *(u32x4*)(vsm + row * VST + c16 * 16) = o; }
        __syncthreads();
        const float decay = SCL[64 + cc];
        if (tid < 256) { float s = 0.f; for (int q = 0; q < 64; ++q) s += WSV[cc * 64 + q] * bf2f(*(const bf16_t*)(ksm + q * KST + tid * 2)); nreg = nreg * decay + s; }
#pragma unroll
        for (int et = 0; et < 4; ++et)
#pragma unroll
            for (int i = 0; i < 16; ++i) acc[et][i] *= decay;
#pragma unroll
        for (int ks = 0; ks < 4; ++ks) {
            const bf16x8 bfr = tr_frag(ksm + kb_off + ks * 16 * KST, 4 * KST);
#pragma unroll
            for (int et = 0; et < 4; ++et) { const bf16x8 afr = tr_frag(vsm + vb_off + ks * 16 * VST + et * 64, 4 * VST);
                acc[et] = __builtin_amdgcn_mfma_f32_32x32x16_bf16(afr, bfr, acc[et], 0, 0, 0); }
        }
    }
}

__device__ __forceinline__ void mlstm_passB(const Params& p, unsigned char* lds, int unit) {
    const int tid = get_tid(), lane = tid & 63, wave = tid >> 6, r = lane & 31, hh = lane >> 5, li = lane & 15;
    const int b = unit >> 7, h = (unit >> 5) & 3, cc = unit & 31;
    unsigned char* ws = p.ws;
    const bf16_t* QC = (const bf16_t*)(ws + WS_QC); const bf16_t* KC = (const bf16_t*)(ws + WS_KC);
    const bf16_t* Mv = (const bf16_t*)(ws + WS_P + 5 * SEG_B); const bf16_t* Mo = (const bf16_t*)(ws + WS_P + 6 * SEG_B);
    const float* gate = (const float*)(ws + WS_GATE);
    const bf16_t* Cst = (const bf16_t*)(ws + WS_CST); const float* nst = (const float*)(ws + WS_NST); const float* mst = (const float*)(ws + WS_MST);
    bf16_t* Oc = (bf16_t*)(ws + WS_H);
    constexpr int QST = 528, VST = 544, WST = 144, HST = 1040;
    unsigned char* qsm = lds;
    unsigned char* ksm = qsm + 64 * QST;
    unsigned char* vsm = ksm + 64 * QST;
    unsigned char* wsm = vsm + 64 * VST;
    float* sc = (float*)(wsm + 64 * WST);
    float* hsm = (float*)lds;
    const int bhc = (b * 4 + h) * 32 + cc, t0 = b * S_ + cc * 64;
    __syncthreads();
    if (wave == 0) {
        const float ipre = gate[(size_t)(t0 + lane) * 16 + 8 + h] + p.m_ib[h], fpre = gate[(size_t)(t0 + lane) * 16 + 12 + h] + p.m_fb[h];
        float bc = logsig(fpre);
#pragma unroll
        for (int o = 1; o < 64; o <<= 1) { const float u = __shfl_up(bc, o); if (lane >= o) bc += u; }
        const float a = ipre - bc; float pm = a;
#pragma unroll
        for (int o = 1; o < 64; o <<= 1) { const float u = __shfl_up(pm, o); if (lane >= o) pm = fmaxf(pm, u); }
        const float mc = mst[bhc]; const float mt = bc + fmaxf(mc, pm);
        sc[lane] = bc - mt; sc[64 + lane] = a; sc[128 + lane] = mt; sc[192 + lane] = expf(bc + mc - mt);
    }
    bf16x8 cfr[16];
#pragma unroll
    for (int ks = 0; ks < 16; ++ks) cfr[ks] = *(const bf16x8*)(Cst + ((size_t)bhc * 256 + wave * 32 + r) * 256 + ks * 16 + hh * 8);
#pragma unroll
    for (int i = 0; i < 4; ++i) { const int c = tid + NTHR * i, row = c >> 5, c16 = c & 31;
        *(u32x4*)(qsm + row * QST + c16 * 16) = *(const u32x4*)(QC + (size_t)(t0 + row) * 1024 + h * 256 + c16 * 8);
        *(u32x4*)(ksm + row * QST + c16 * 16) = *(const u32x4*)(KC + (size_t)(t0 + row) * 1024 + h * 256 + c16 * 8);
        *(u32x4*)(vsm + row * VST + c16 * 16) = *(const u32x4*)(Mv + (size_t)(t0 + row) * 1024 + h * 256 + c16 * 8); }
    __syncthreads();
    if (wave < 3) {
        const int sb = wave >> 1, lb = wave ? 1 : 0;
        f32x16 s;
#pragma unroll
        for (int i = 0; i < 16; ++i) s[i] = 0.f;
#pragma unroll
        for (int ks = 0; ks < 16; ++ks) { const bf16x8 a = *(const bf16x8*)(ksm + (sb * 32 + r) * QST + ks * 32 + hh * 16), q = *(const bf16x8*)(qsm + (lb * 32 + r) * QST + ks * 32 + hh * 16);
            s = __builtin_amdgcn_mfma_f32_32x32x16_bf16(a, q, s, 0, 0, 0); }
        const int l = lb * 32 + r; const float bl = sc[l]; float rs = 0.f;
#pragma unroll
        for (int g = 0; g < 4; ++g) { float w[4];
#pragma unroll
            for (int e = 0; e < 4; ++e) { const int sI = sb * 32 + 8 * g + 4 * hh + e; w[e] = (sI <= l) ? s[4 * g + e] * __expf(bl + sc[64 + sI]) : 0.f; rs += w[e]; }
            u32x2 o; o.x = cvt_pk(w[0], w[1]); o.y = cvt_pk(w[2], w[3]);
            *(u32x2*)(wsm + l * WST + (sb * 32 + 8 * g + 4 * hh) * 2) = o; }
        sc[256 + l * 4 + sb * 2 + hh] = rs;
    } else if (wave == 3) {
        const int l = r;
#pragma unroll
        for (int g = 0; g < 4; ++g) { u32x2 o; o.x = 0u; o.y = 0u; *(u32x2*)(wsm + l * WST + (32 + 8 * g + 4 * hh) * 2) = o; }
        sc[256 + l * 4 + 2 + hh] = 0.f;
    }
    {
        const int l = tid & 63, part = tid >> 6; const float* np = nst + (size_t)bhc * 256 + part * 32; float s = 0.f;
#pragma unroll
        for (int q = 0; q < 4; ++q) { const u32x4 w = *(const u32x4*)(qsm + l * QST + part * 64 + q * 16);
            s += bflo(w.x) * np[8 * q] + bfhi(w.x) * np[8 * q + 1] + bflo(w.y) * np[8 * q + 2] + bfhi(w.y) * np[8 * q + 3] + bflo(w.z) * np[8 * q + 4] + bfhi(w.z) * np[8 * q + 5] + bflo(w.w) * np[8 * q + 6] + bfhi(w.w) * np[8 * q + 7]; }
        sc[512 + l * 8 + part] = s;
    }
    f32x16 acc[2];
#pragma unroll
    for (int lb = 0; lb < 2; ++lb)
#pragma unroll
        for (int i = 0; i < 16; ++i) acc[lb][i] = 0.f;
#pragma unroll
    for (int ks = 0; ks < 16; ++ks)
#pragma unroll
        for (int lb = 0; lb < 2; ++lb) { const bf16x8 q = *(const bf16x8*)(qsm + (lb * 32 + r) * QST + ks * 32 + hh * 16);
            acc[lb] = __builtin_amdgcn_mfma_f32_32x32x16_bf16(cfr[ks], q, acc[lb], 0, 0, 0); }
    __syncthreads();
#pragma unroll
    for (int lb = 0; lb < 2; ++lb) { const float it = sc[192 + lb * 32 + r];
#pragma unroll
        for (int i = 0; i < 16; ++i) acc[lb][i] *= it; }
    const int vb_off = (8 * hh + (li >> 2)) * VST + (wave * 32 + 16 * (r >> 4) + 4 * (li & 3)) * 2;
#pragma unroll
    for (int ks = 0; ks < 4; ++ks) { const bf16x8 afr = tr_frag(vsm + vb_off + ks * 16 * VST, 4 * VST);
#pragma unroll
        for (int lb = 0; lb < 2; ++lb) { if (lb == 0 && ks >= 2) continue;
            const bf16x8 wf = *(const bf16x8*)(wsm + (lb * 32 + r) * WST + ks * 32 + hh * 16);
            acc[lb] = __builtin_amdgcn_mfma_f32_32x32x16_bf16(afr, wf, acc[lb], 0, 0, 0); } }
    float ssq[2];
#pragma unroll
    for (int lb = 0; lb < 2; ++lb) { const int l = lb * 32 + r;
        const f32x4 rsv = *(const f32x4*)(sc + 256 + l * 4); const f32x4 q0 = *(const f32x4*)(sc + 512 + l * 8), q1 = *(const f32x4*)(sc + 512 + l * 8 + 4);
        const float den = (rsv[0] + rsv[1] + rsv[2] + rsv[3]) + sc[192 + l] * ((q0[0] + q0[1] + q0[2] + q0[3]) + (q1[0] + q1[1] + q1[2] + q1[3]));
        const float inv = 1.f / fmaxf(fabsf(den), __expf(-sc[128 + l]));
        float s2 = 0.f;
#pragma unroll
        for (int i = 0; i < 16; ++i) { acc[lb][i] *= inv; s2 += acc[lb][i] * acc[lb][i]; }
        s2 += __shfl_xor(s2, 32); ssq[lb] = s2; }
    __syncthreads();
    if (hh == 0) { sc[1024 + r * 8 + wave] = ssq[0]; sc[1024 + (32 + r) * 8 + wave] = ssq[1]; }
#pragma unroll
    for (int lb = 0; lb < 2; ++lb)
#pragma unroll
        for (int g = 0; g < 4; ++g) { f32x4 v; v[0] = acc[lb][4 * g]; v[1] = acc[lb][4 * g + 1]; v[2] = acc[lb][4 * g + 2]; v[3] = acc[lb][4 * g + 3];
            *(f32x4*)((unsigned char*)hsm + (lb * 32 + r) * HST + (wave * 32 + 8 * g + 4 * hh) * 4) = v; }
    __syncthreads();
#pragma unroll
    for (int i = 0; i < 4; ++i) { const int c = tid + NTHR * i, l = c >> 5, e0 = (c & 31) * 8;
        const f32x4 s0 = *(const f32x4*)(sc + 1024 + l * 8), s1 = *(const f32x4*)(sc + 1024 + l * 8 + 4);
        const float rr = rsqrtf(((s0[0] + s0[1] + s0[2] + s0[3]) + (s1[0] + s1[1] + s1[2] + s1[3])) * (1.f / 256.f) + EPS_);
        const f32x4 h0 = *(const f32x4*)((unsigned char*)hsm + l * HST + e0 * 4), h1 = *(const f32x4*)((unsigned char*)hsm + l * HST + e0 * 4 + 16);
        const f32x4 g0 = *(const f32x4*)(p.m_hg + h * 256 + e0), g1 = *(const f32x4*)(p.m_hg + h * 256 + e0 + 4);
        const u32x4 mo = *(const u32x4*)(Mo + (size_t)(t0 + l) * 1024 + h * 256 + e0);
        u32x4 o;
        o.x = cvt_pk(h0[0] * rr * g0[0] * sigm(bflo(mo.x)), h0[1] * rr * g0[1] * sigm(bfhi(mo.x))); o.y = cvt_pk(h0[2] * rr * g0[2] * sigm(bflo(mo.y)), h0[3] * rr * g0[3] * sigm(bfhi(mo.y)));
        o.z = cvt_pk(h1[0] * rr * g1[0] * sigm(bflo(mo.z)), h1[1] * rr * g1[1] * sigm(bfhi(mo.z))); o.w = cvt_pk(h1[2] * rr * g1[2] * sigm(bflo(mo.w)), h1[3] * rr * g1[3] * sigm(bfhi(mo.w)));
        *(u32x4*)(Oc + (size_t)(t0 + l) * D_ + 1024 + h * 256 + e0) = o; }
}

__device__ __forceinline__ void ce_desc(float& a, float& b) { const float hi = fmaxf(a, b), lo = fminf(a, b); a = hi; b = lo; }
__device__ __forceinline__ void sort16_desc(float (&v)[16]) {
#pragma unroll
    for (int k = 2; k <= 16; k <<= 1)
#pragma unroll
        for (int j = k >> 1; j > 0; j >>= 1)
#pragma unroll
            for (int i = 0; i < 16; ++i) { const int l = i ^ j; if (l > i) { if ((i & k) == 0) ce_desc(v[i], v[l]); else ce_desc(v[l], v[i]); } }
}
__device__ __forceinline__ void bmerge16_desc(float (&v)[16]) {
#pragma unroll
    for (int j = 8; j > 0; j >>= 1)
#pragma unroll
        for (int i = 0; i < 16; ++i) { const int l = i ^ j; if (l > i) ce_desc(v[i], v[l]); }
}
__device__ __forceinline__ void merge_top16(float (&a)[16], const float (&b)[16]) {
#pragma unroll
    for (int i = 0; i < 16; ++i) a[i] = fmaxf(a[i], b[15 - i]);
    bmerge16_desc(a);
}
__device__ __forceinline__ float pack_idx(float v, unsigned mask, unsigned idx) { return __builtin_bit_cast(float, (__builtin_bit_cast(unsigned, v) & mask) | idx); }
__device__ __forceinline__ void top16_from_acc(const f32x16 (&acc)[4], int h, float (&out)[16]) {
    float g[4][16];
#pragma unroll
    for (int mt = 0; mt < 4; ++mt) {
#pragma unroll
        for (int i = 0; i < 16; ++i) g[mt][i] = pack_idx(acc[mt][i], 0xffffff80u, (unsigned)(32 * mt + (i & 3) + 8 * (i >> 2)) | ((unsigned)h << 2));
        sort16_desc(g[mt]);
    }
    merge_top16(g[0], g[1]); merge_top16(g[2], g[3]); merge_top16(g[0], g[2]);
    float o[16];
#pragma unroll
    for (int i = 0; i < 16; ++i) o[i] = __shfl_xor(g[0][i], 32);
    merge_top16(g[0], o);
#pragma unroll
    for (int i = 0; i < 16; ++i) out[i] = g[0][i];
}
__device__ __forceinline__ unsigned lut16(const unsigned (&P)[4], unsigned i) {
    const unsigned long long lo = (unsigned long long)P[0] | ((unsigned long long)P[1] << 32), hi = (unsigned long long)P[2] | ((unsigned long long)P[3] << 32);
    const unsigned long long s = (i & 8u) ? hi : lo;
    return (unsigned)(s >> ((i & 7u) * 8u)) & 0xffu;
}
struct CandTab { int i[50]; int j[50]; };
constexpr CandTab make_cand_tab() { CandTab t{}; int n = 0; for (int i = 0; i < 16; ++i) for (int j = 0; j < 16; ++j) if ((i + 1) * (j + 1) <= 16) { t.i[n] = i; t.j[n] = j; ++n; } return t; }
__device__ __forceinline__ void phase_topk(const Params& p, unsigned char* lds, int bid, int nb) {
    const int tid = get_tid(), lane = tid & 63, wave = tid >> 6, r = lane & 31, h = lane >> 5;
    unsigned char* ws = p.ws;
    const bf16_t* Q = (const bf16_t*)(ws + WS_Q); int* IDX = (int*)(ws + WS_IDX); float* GW = (float*)(ws + WS_GW);
    constexpr int KP = 136;
    bf16_t* KS = (bf16_t*)lds;
    for (int i = tid; i < 2 * 16384; i += NTHR) { const int which = i >> 14, n = (i >> 7) & 127, d = i & 127; const float v = (which ? p.sk2 : p.sk1)[i & 16383];
        const unsigned hb = cvt_pk(v, 0.f) & 0xffffu; const float lo = v - bf2f((bf16_t)hb);
        KS[((which * 2 + 0) * 128 + n) * KP + d] = (bf16_t)hb; KS[((which * 2 + 1) * 128 + n) * KP + d] = (bf16_t)(cvt_pk(lo, 0.f) & 0xffffu); }
    __syncthreads();
    for (int item = bid * 8 + wave; item < 512 * 8; item += nb * 8) {
        const int tt = item >> 3, hh = item & 7, t = tt * 32 + r;
        float top[2][16];
#pragma unroll
        for (int list = 0; list < 2; ++list) {
            bf16x8 qf[8];
#pragma unroll
            for (int ks = 0; ks < 8; ++ks) qf[ks] = *(const bf16x8*)(Q + (size_t)t * D_ + hh * 256 + list * 128 + ks * 16 + h * 8);
            float g[4][16];
#pragma unroll
            for (int mt = 0; mt < 4; ++mt) {
                f32x16 acc;
#pragma unroll
                for (int i = 0; i < 16; ++i) acc[i] = 0.f;
#pragma unroll
                for (int hl = 0; hl < 2; ++hl)
#pragma unroll
                    for (int ks = 0; ks < 8; ++ks) { const bf16x8 a = *(const bf16x8*)(KS + ((list * 2 + hl) * 128 + mt * 32 + r) * KP + ks * 16 + h * 8);
                        acc = __builtin_amdgcn_mfma_f32_32x32x16_bf16(a, qf[ks], acc, 0, 0, 0); }
#pragma unroll
                for (int i = 0; i < 16; ++i) g[mt][i] = pack_idx(acc[i], 0xffffff80u, (unsigned)(32 * mt + (i & 3) + 8 * (i >> 2)) | ((unsigned)h << 2));
                sort16_desc(g[mt]);
                __builtin_amdgcn_sched_barrier(0);
            }
            merge_top16(g[0], g[1]); merge_top16(g[2], g[3]); merge_top16(g[0], g[2]);
            {   float o[16];
#pragma unroll
                for (int i = 0; i < 16; ++i) o[i] = __shfl_xor(g[0][i], 32);
                merge_top16(g[0], o); }
#pragma unroll
            for (int i = 0; i < 16; ++i) top[list][i] = g[0][i];
            __builtin_amdgcn_sched_barrier(0);
        }
        unsigned P1[4], P2[4];
#pragma unroll
        for (int q = 0; q < 4; ++q) { P1[q] = 0u; P2[q] = 0u;
#pragma unroll
            for (int e = 0; e < 4; ++e) { P1[q] |= (__builtin_bit_cast(unsigned, top[0][4 * q + e]) & 127u) << (8 * e); P2[q] |= (__builtin_bit_cast(unsigned, top[1][4 * q + e]) & 127u) << (8 * e); } }
        float c[4][16];
#pragma unroll
        for (int n = 0; n < 64; ++n) {
            if (n < 50) { constexpr CandTab CT = make_cand_tab(); const int i = CT.i[n], j = CT.j[n];
                c[n >> 4][n & 15] = pack_idx(top[0][i] + top[1][j], 0xffffff00u, (unsigned)(i * 16 + j)); }
            else c[n >> 4][n & 15] = -INFINITY;
        }
        sort16_desc(c[0]); __builtin_amdgcn_sched_barrier(0); sort16_desc(c[1]); __builtin_amdgcn_sched_barrier(0); merge_top16(c[0], c[1]); __builtin_amdgcn_sched_barrier(0);
        sort16_desc(c[2]); __builtin_amdgcn_sched_barrier(0); sort16_desc(c[3]); __builtin_amdgcn_sched_barrier(0); merge_top16(c[2], c[3]); __builtin_amdgcn_sched_barrier(0); merge_top16(c[0], c[2]);
        float ex[16], sum = 0.f;
#pragma unroll
        for (int k = 0; k < 16; ++k) { ex[k] = __expf(c[0][k] - c[0][0]); sum += ex[k]; }
        const float inv = 1.f / sum;
        if (h == 0) {
            int* ip = IDX + (size_t)t * 128 + hh * 16; float* gp = GW + (size_t)t * 128 + hh * 16;
#pragma unroll
            for (int q = 0; q < 4; ++q) { u32x4 iv; f32x4 gv;
#pragma unroll
                for (int e = 0; e < 4; ++e) { const unsigned pos = __builtin_bit_cast(unsigned, c[0][4 * q + e]) & 255u;
                    iv[e] = lut16(P1, pos >> 4) * 128u + lut16(P2, pos & 15u); gv[e] = ex[4 * q + e] * inv; }
                *(u32x4*)(ip + 4 * q) = iv; *(f32x4*)(gp + 4 * q) = gv; }
        }
    }
}

typedef float f32x2 __attribute__((ext_vector_type(2)));
__device__ __forceinline__ float dot16_fp8(const u32x4 w, const float (&h)[32], int o) {
    float s = 0.f;
#pragma unroll
    for (int q = 0; q < 4; ++q) { const f32x2 lo = __builtin_amdgcn_cvt_pk_f32_fp8((int)w[q], false), hi = __builtin_amdgcn_cvt_pk_f32_fp8((int)w[q], true);
        s += lo[0] * h[o + 4 * q] + lo[1] * h[o + 4 * q + 1] + hi[0] * h[o + 4 * q + 2] + hi[1] * h[o + 4 * q + 3]; }
    return s;
}
__device__ __forceinline__ void axpy16_fp8(const u32x4 w, float a, float (&acc)[32], int o) {
#pragma unroll
    for (int q = 0; q < 4; ++q) { const f32x2 lo = __builtin_amdgcn_cvt_pk_f32_fp8((int)w[q], false), hi = __builtin_amdgcn_cvt_pk_f32_fp8((int)w[q], true);
        acc[o + 4 * q] += a * lo[0]; acc[o + 4 * q + 1] += a * lo[1]; acc[o + 4 * q + 2] += a * hi[0]; acc[o + 4 * q + 3] += a * hi[1]; }
}
__device__ __forceinline__ void phase_peer(const Params& p, int bid, int nb) {
    const int tid = get_tid(), lane = tid & 63, wave = tid >> 6;
    unsigned char* ws = p.ws;
    const bf16_t* H2 = (const bf16_t*)(ws + WS_H2); const int* IDX = (const int*)(ws + WS_IDX); const float* GW = (const float*)(ws + WS_GW);
    const float* mod = (const float*)(ws + WS_MOD);
    const unsigned char* E8D = ws + WS_E8D + 16 * lane; const unsigned char* E8U = ws + WS_E8U + 16 * lane;
    for (int t = bid * 8 + wave; t < T_; t += nb * 8) {
        float hv[32];
#pragma unroll
        for (int hf = 0; hf < 2; ++hf)
#pragma unroll
            for (int q = 0; q < 2; ++q) { const u32x4 w = *(const u32x4*)(H2 + (size_t)t * D_ + hf * 1024 + 16 * lane + 8 * q);
#pragma unroll
                for (int e = 0; e < 4; ++e) { hv[hf * 16 + q * 8 + 2 * e] = bflo(w[e]); hv[hf * 16 + q * 8 + 2 * e + 1] = bfhi(w[e]); } }
        const int idx0 = IDX[(size_t)t * 128 + lane], idx1 = IDX[(size_t)t * 128 + 64 + lane];
        const float g0 = GW[(size_t)t * 128 + lane], g1 = GW[(size_t)t * 128 + 64 + lane];
        float a0 = 0.f, a1 = 0.f;
        for (int i0 = 0; i0 < 128; i0 += 4) {
            u32x4 lo[4], hi[4];
#pragma unroll
            for (int u = 0; u < 4; ++u) { const int e = __shfl(i0 < 64 ? idx0 : idx1, (i0 + u) & 63); lo[u] = *(const u32x4*)(E8D + (size_t)e * 2048); hi[u] = *(const u32x4*)(E8D + (size_t)e * 2048 + 1024); }
#pragma unroll
            for (int u = 0; u < 4; ++u) { float d = dot16_fp8(lo[u], hv, 0) + dot16_fp8(hi[u], hv, 16); d = wsum(d);
                if (lane == ((i0 + u) & 63)) { if (i0 < 64) a0 = d; else a1 = d; } }
        }
        a0 *= (1.f / 512.f); a1 *= (1.f / 512.f);
        const float w0 = g0 * 0.5f * a0 * (1.f + erff(a0 * 0.7071067811865476f)), w1 = g1 * 0.5f * a1 * (1.f + erff(a1 * 0.7071067811865476f));
        float acc[32];
#pragma unroll
        for (int i = 0; i < 32; ++i) acc[i] = 0.f;
        for (int i0 = 0; i0 < 128; i0 += 4) {
            u32x4 lo[4], hi[4];
#pragma unroll
            for (int u = 0; u < 4; ++u) { const int e = __shfl(i0 < 64 ? idx0 : idx1, (i0 + u) & 63); lo[u] = *(const u32x4*)(E8U + (size_t)e * 2048); hi[u] = *(const u32x4*)(E8U + (size_t)e * 2048 + 1024); }
#pragma unroll
            for (int u = 0; u < 4; ++u) { const float w = __shfl(i0 < 64 ? w0 : w1, (i0 + u) & 63); axpy16_fp8(lo[u], w, acc, 0); axpy16_fp8(hi[u], w, acc, 16); }
        }
        const float* g2 = mod + (size_t)(t >> 11) * NMOD + 5 * D_;
#pragma unroll
        for (int hf = 0; hf < 2; ++hf)
#pragma unroll
            for (int q = 0; q < 4; ++q) { const int k = hf * 1024 + 16 * lane + 4 * q; f32x4* op = (f32x4*)(p.out + (size_t)t * D_ + k); const f32x4 gv = *(const f32x4*)(g2 + k);
                f32x4 av; av[0] = acc[hf * 16 + 4 * q]; av[1] = acc[hf * 16 + 4 * q + 1]; av[2] = acc[hf * 16 + 4 * q + 2]; av[3] = acc[hf * 16 + 4 * q + 3];
                *op = *op + gv * av * (1.f / 32.f); }
    }
}

typedef const __attribute__((address_space(4))) Params* KargPtr;
__device__ __forceinline__ Params load_params() {
#if defined(__HIP_DEVICE_COMPILE__)
    KargPtr kp = (KargPtr)__builtin_amdgcn_kernarg_segment_ptr(); asm volatile("" : "+s"(kp)); Params r; __builtin_memcpy(&r, kp, sizeof(Params)); return r;
#else
    return Params{};
#endif
}
constexpr int N_PHASES = 11;
constexpr int LDS_BYTES = 152 * 1024;
__global__ void __launch_bounds__(NTHR) fwd_kernel(Params p_arg) {
    extern __shared__ __attribute__((aligned(16))) unsigned char lds[];
    const int bid = blockIdx.x, nb = gridDim.x, tid = get_tid();
    unsigned char* ws = p_arg.ws;
    volatile LAS unsigned* xbst = (volatile LAS unsigned*)((LAS unsigned char*)lds + LDS_BYTES - 16);
    if (tid == 0) { xbst[0] = 0u; xbst[1] = 0u; xbst[2] = 0u; xbst[3] = 0u; }
    __syncthreads();
    if ((p_arg.ph_hi - p_arg.ph_lo) > 1) (void)xcd_barrier_post((unsigned*)(ws + WS_BAR), xbst);
#ifdef ONLY_PHASE
#define IN(k) ((k) == ONLY_PHASE && p.ph_lo <= (k) && (k) < p.ph_hi)
#else
#define IN(k) (p.ph_lo <= (k) && (k) < p.ph_hi)
#endif
#define SEAM(k) do { const Params p = load_params(); if (p.ph_lo <= (k) && (k) + 1 < p.ph_hi) { XcdBarrier bar; bar.bar = (unsigned*)(p.ws + WS_BAR); bar.x = xb_xcc_id(); bar.st = xbst; xcd_barrier(bar); } } while (0)
#ifndef REPEAT_MASK
#define REPEAT_MASK 0
#endif
#define REP(k) for (int rep_ = 0; rep_ < (((REPEAT_MASK) >> (k)) & 1) + 1; ++rep_)
    REP(0) { const Params p = load_params(); if (IN(0)) { unsigned char* ws = p.ws; const float* mod = (const float*)(ws + WS_MOD); (void)mod;
        phase_prep(p, lds, bid, nb);
    } }
    SEAM(0);
    REP(1) { const Params p = load_params(); if (IN(1)) { unsigned char* ws = p.ws; const float* mod = (const float*)(ws + WS_MOD); (void)mod;
        phase_norm<true>(p.x, p.g1, mod, 0, D_, (bf16_t*)(ws + WS_H), (const float*)(ws + WS_WG), (float*)(ws + WS_GATE), bid, nb);
    } }
    SEAM(1);
    REP(2) { const Params p = load_params(); if (IN(2)) { unsigned char* ws = p.ws; const float* mod = (const float*)(ws + WS_MOD); (void)mod;
        { pg8::Gemm g{(const bf16_t*)(ws + WS_H), (const bf16_t*)(ws + WS_WINT), T_, 7168, D_}; pg8::StaticOrder S; S.init(T_, 7168, nb, bid);
        pg8::EpiSeg E{(bf16_t*)(ws + WS_P)}; pg8::gemm_phase<pg8::EpiSeg, pg8::StaticOrder, true, true>((LAS unsigned char*)lds, g, S, E); }
    } }
    SEAM(2);
    REP(3) { const Params p = load_params(); if (IN(3)) { unsigned char* ws = p.ws; const float* mod = (const float*)(ws + WS_MOD); (void)mod;
        phase_post(p, bid, nb);
    } }
    SEAM(3);
    REP(4) { const Params p = load_params(); if (IN(4)) { unsigned char* ws = p.ws; const float* mod = (const float*)(ws + WS_MOD); (void)mod;
        { for (int u = bid; u < 64; u += nb) mlstm_passA(p, lds, u);
        unsigned* qctr = (unsigned*)(ws + WS_QCTR); volatile int* slot = (volatile int*)(lds + LDS_BYTES - 32);
        for (;;) { __syncthreads(); if (tid == 0) *slot = (int)atomicAdd(qctr, 1u); __syncthreads(); const int u = *slot; if (u >= 512) break;
            const int bh = u & 63; fox_unit(p, lds, bh >> 3, bh & 7, 7 - (u >> 6)); } }
    } }
    SEAM(4);
    REP(5) { const Params p = load_params(); if (IN(5)) { unsigned char* ws = p.ws; const float* mod = (const float*)(ws + WS_MOD); (void)mod;
        { for (int u = bid; u < 1024; u += nb) mlstm_passB(p, lds, u); }
    } }
    SEAM(5);
    REP(6) { const Params p = load_params(); if (IN(6)) { unsigned char* ws = p.ws; const float* mod = (const float*)(ws + WS_MOD); (void)mod;
        { pg8::Gemm g{(const bf16_t*)(ws + WS_H), (const bf16_t*)(ws + WS_WOT), T_, D_, D_}; pg8::StaticOrder S; S.init(T_, D_, nb, bid);
        pg8::EpiRes E{p.x, p.out, mod, 2 * D_}; pg8::gemm_phase<pg8::EpiRes, pg8::StaticOrder, true, true>((LAS unsigned char*)lds, g, S, E); }
    } }
    SEAM(6);
    REP(7) { const Params p = load_params(); if (IN(7)) { unsigned char* ws = p.ws; const float* mod = (const float*)(ws + WS_MOD); (void)mod;
        convert_experts(p, bid, nb);
    } }
    REP(7) { const Params p = load_params(); if (IN(7)) { unsigned char* ws = p.ws; const float* mod = (const float*)(ws + WS_MOD); (void)mod;
        phase_norm<false>(p.out, p.g2, mod, 3 * D_, 4 * D_, (bf16_t*)(ws + WS_H2), nullptr, nullptr, bid, nb);
    } }
    SEAM(7);
    REP(8) { const Params p = load_params(); if (IN(8)) { unsigned char* ws = p.ws; const float* mod = (const float*)(ws + WS_MOD); (void)mod;
        { pg8::Gemm g{(const bf16_t*)(ws + WS_H2), (const bf16_t*)(ws + WS_WQT), T_, D_, D_}; pg8::StaticOrder S; S.init(T_, D_, nb, bid);
        pg8::EpiBf E{(bf16_t*)(ws + WS_Q), D_}; pg8::gemm_phase<pg8::EpiBf, pg8::StaticOrder, true, true>((LAS unsigned char*)lds, g, S, E); }
    } }
    SEAM(8);
    REP(9) { const Params p = load_params(); if (IN(9)) { unsigned char* ws = p.ws; const float* mod = (const float*)(ws + WS_MOD); (void)mod;
        phase_topk(p, lds, bid, nb);
    } }
    SEAM(9);
    REP(10) { const Params p = load_params(); if (IN(10)) { unsigned char* ws = p.ws; const float* mod = (const float*)(ws + WS_MOD); (void)mod;
        phase_peer(p, bid, nb);
    } }
#undef IN
#undef SEAM
}

#ifndef ONE_LAUNCH
#define ONE_LAUNCH 1
#endif
extern "C" void kernel_launch(void* const* d_in, const int* in_sizes, int n_in, void* d_out, int out_size, void* d_ws, size_t ws_size, hipStream_t stream) {
    static int grid = 0;
    if (grid == 0) {
        int dev = 0, cus = 0, per_cu = 0;
        if (n_in != 21 || ws_size < WS_END) { fprintf(stderr, "kernel_launch: unexpected n_in %d / ws_size %zu (need %zu)\n", n_in, ws_size, (size_t)WS_END); grid = -1; return; }
        hipGetDevice(&dev); hipDeviceGetAttribute(&cus, hipDeviceAttributeMultiprocessorCount, dev);
        if (hipFuncSetAttribute((const void*)fwd_kernel, hipFuncAttributeMaxDynamicSharedMemorySize, LDS_BYTES) != hipSuccess) { fprintf(stderr, "kernel_launch: hipFuncSetAttribute failed\n"); grid = -1; return; }
        if (hipOccupancyMaxActiveBlocksPerMultiprocessor(&per_cu, (const void*)fwd_kernel, NTHR, LDS_BYTES) != hipSuccess || per_cu < 1) { fprintf(stderr, "kernel_launch: occupancy query says %d\n", per_cu); (void)hipGetLastError(); }
        grid = cus > 0 ? cus : 256;
    }
    if (grid < 0) return;
    Params p{};
    const float** pp = (const float**)&p;
    for (int i = 0; i < 21; ++i) pp[i] = (const float*)d_in[i];
    p.out = (float*)d_out; p.ws = (unsigned char*)d_ws;
    hipMemsetAsync((char*)d_ws + WS_BAR, 0, 16384, stream);
#if ONE_LAUNCH
    p.ph_lo = 0; p.ph_hi = N_PHASES;
    void* args[] = {&p};
    hipError_t e = hipLaunchCooperativeKernel((const void*)fwd_kernel, dim3(grid), dim3(NTHR), args, LDS_BYTES, stream);
    if (e != hipSuccess) fprintf(stderr, "cooperative launch failed: %s (grid %d)\n", hipGetErrorString(e), grid);
#else
    for (int ph = 0; ph < N_PHASES; ++ph) { p.ph_lo = ph; p.ph_hi = ph + 1; hipLaunchKernelGGL(fwd_kernel, dim3(grid), dim3(NTHR), LDS_BYTES, stream, p); }
#endif
}
```

```cpp
#include <hip/hip_runtime.h>
#include <cstdio>
#include <cstdint>

#define GAS __attribute__((address_space(1)))
#define LAS __attribute__((address_space(3)))
typedef unsigned short bf16_t;
typedef short bf16x8 __attribute__((ext_vector_type(8)));
typedef float f32x4 __attribute__((ext_vector_type(4)));
typedef float f32x16 __attribute__((ext_vector_type(16)));
typedef unsigned u32x4 __attribute__((ext_vector_type(4)));
typedef unsigned u32x2 __attribute__((ext_vector_type(2)));

constexpr int T_ = 16384, D_ = 2048, B_ = 8, S_ = 2048, NTHR = 512;
constexpr float EPS_ = 1e-6f;
constexpr int NMOD = 6 * D_;
constexpr int INCOLS = 7184;

constexpr size_t WS_BAR   = 0;
constexpr size_t WS_MOD   = 16384;
constexpr size_t WS_WG    = WS_MOD + (size_t)B_ * NMOD * 4;
constexpr size_t WS_GATE  = WS_WG + 16 * 2048 * 4;
constexpr size_t WS_F     = WS_GATE + (size_t)T_ * 16 * 4;
constexpr size_t WS_NST   = WS_F + 64 * 2048 * 4;
constexpr size_t WS_MST   = WS_NST + 1024 * 256 * 4;
constexpr size_t WS_WINT  = WS_MST + 4096;
constexpr size_t WS_WOT   = WS_WINT + (size_t)7168 * 2048 * 2;
constexpr size_t WS_WQT   = WS_WOT + (size_t)2048 * 2048 * 2;
constexpr size_t WS_H     = WS_WQT + (size_t)2048 * 2048 * 2;
constexpr size_t WS_P     = WS_H + (size_t)T_ * 2048 * 2;
constexpr size_t SEG_B    = (size_t)T_ * 1024 * 2;
constexpr size_t WS_CST   = WS_P + 7 * SEG_B;
constexpr size_t WS_E8D   = WS_CST + (size_t)1024 * 256 * 256 * 2;
constexpr size_t WS_E8U   = WS_E8D + (size_t)16384 * 2048;
constexpr size_t WS_END   = WS_E8U + (size_t)16384 * 2048;
constexpr size_t WS_QC    = WS_E8D;
constexpr size_t WS_KC    = WS_E8U;
constexpr size_t WS_QCTR  = 15360;
constexpr size_t WS_H2    = WS_P;
constexpr size_t WS_Q     = WS_H2 + (size_t)T_ * 2048 * 2;
constexpr size_t WS_IDX   = WS_Q + (size_t)T_ * 2048 * 2;
constexpr size_t WS_GW    = WS_IDX + (size_t)T_ * 128 * 4;
static_assert(WS_GW + (size_t)T_ * 128 * 4 <= WS_CST, "alias overflow");
constexpr size_t WS_X1    = WS_CST;
constexpr size_t WS_EWT   = WS_GW + (size_t)T_ * 128 * 4;
static_assert(WS_EWT + (size_t)T_ * 128 * 4 <= WS_CST, "alias overflow 2");

struct Params {
    const float *x, *c, *w_ada, *b_ada, *g1, *g2, *w_in, *fox_fb, *fox_qg, *fox_kg, *conv_w, *conv_b, *m_ib, *m_fb, *m_hg, *w_out, *w_q, *sk1, *sk2, *e_down, *e_up;
    float* out; unsigned char* ws; int ph_lo, ph_hi;
};

__device__ __forceinline__ int get_tid() { int t = threadIdx.x; asm volatile("" : "+v"(t)); return t; }
__device__ __forceinline__ unsigned cvt_pk(float lo, float hi) { unsigned r; asm("v_cvt_pk_bf16_f32 %0, %1, %2" : "=v"(r) : "v"(lo), "v"(hi)); return r; }
__device__ __forceinline__ void fmac(float& acc, float a, float b) { asm("v_fmac_f32 %0, %1, %2" : "+v"(acc) : "v"(a), "v"(b)); }
__device__ __forceinline__ float bf2f(unsigned short h) { return __builtin_bit_cast(float, ((unsigned)h) << 16); }
__device__ __forceinline__ float bflo(unsigned w) { return __builtin_bit_cast(float, w << 16); }
__device__ __forceinline__ float bfhi(unsigned w) { return __builtin_bit_cast(float, w & 0xffff0000u); }
__device__ __forceinline__ float wsum(float v) {
#pragma unroll
    for (int o = 32; o; o >>= 1) v += __shfl_xor(v, o);
    return v; }
__device__ __forceinline__ float wmax(float v) {
#pragma unroll
    for (int o = 32; o; o >>= 1) v = fmaxf(v, __shfl_xor(v, o));
    return v; }
__device__ __forceinline__ float logsig(float x) { return fminf(x, 0.f) - log1pf(expf(-fabsf(x))); }
__device__ __forceinline__ float sigm(float x) { return 1.f / (1.f + expf(-x)); }
__device__ __forceinline__ float silu_f(float x) { return x / (1.f + expf(-x)); }
namespace pg8 {
#define PG8_LAS __attribute__((address_space(3)))
typedef unsigned short bf16_t;
typedef short bf16x8 __attribute__((ext_vector_type(8)));
typedef float f32x4 __attribute__((ext_vector_type(4)));
typedef unsigned u32x4 __attribute__((ext_vector_type(4)));
constexpr int BM = 256, BK = 64, HALF = 128, HTB = HALF * BK * 2  , STAGE_BYTES = 8 * HTB, NXCD = 8, WGM = 8;

__host__ __device__ __forceinline__ int lds_byte(int r, int c) { const int st = (r >> 4) * 2 + (c >> 5), rr = r & 15, cc = c & 31, ob = rr * 64 + cc * 2; return st * 1024 + (ob ^ (((ob >> 9) & 1) << 5)); }
__host__ __device__ __forceinline__ void stage_rc(int b, int& R, int& C) { const int st = b / 1024, sb = b % 1024, swz = sb ^ (((sb >> 9) & 1) << 5); R = (st >> 1) * 16 + swz / 64; C = (st & 1) * 32 + (swz % 64) / 2; }
__host__ __device__ __forceinline__ int perm32(int rho) { const int n = rho >> 4, i = rho & 15; return 8 * (i >> 2) + 4 * n + (i & 3); }

struct Unit { int pm, pn; };
struct Gemm { const bf16_t* A; const bf16_t* Bt; int M, N, K; };

struct StaticOrder {
    int nM, nN, nwg, G, c;
    __host__ __device__ void init(int M, int N, int G_, int c_) { nM = M / BM; nN = N / BM; nwg = nM * nN; G = G_; c = c_; }
    __host__ __device__ bool next(int i, Unit& u) const {
        const long L = (long)i * G + c; if (L >= nwg) return false;
        int wgid = (int)L; { const int q = nwg / NXCD, r = nwg % NXCD, xcd = wgid % NXCD, off = wgid / NXCD; wgid = (xcd < r ? xcd * (q + 1) : r * (q + 1) + (xcd - r) * q) + off; }
        const int nig = WGM * nN, gid = wgid / nig, fm = gid * WGM, gsz = (nM - fm) < WGM ? (nM - fm) : WGM;
        u.pm = fm + ((wgid % nig) % gsz); u.pn = (wgid % nig) / gsz; return true;
    }
    __device__ __forceinline__ void a_ready(const Unit&) const {}
    __device__ __forceinline__ void done(const Unit&) const {}
};
struct EpiSeg {
    static constexpr bool PERM = true, AFTER_DRAIN = false;
    bf16_t* P;
    __device__ __forceinline__ void operator()(const f32x4 (&acc)[2][2][4][2], const Unit& u, int wr, int wc, int fr, int fq) const {
        const int seg = u.pn >> 2; bf16_t* base = P + (size_t)seg * ((size_t)T_ * 1024);
        const int row0 = u.pm * BM + wr * 64 + fr, col0 = (u.pn & 3) * 256 + wc * 32 + 8 * fq;
#pragma unroll
        for (int ai = 0; ai < 2; ++ai)
#pragma unroll
            for (int m = 0; m < 4; ++m) { bf16_t* rowp = base + (size_t)(row0 + ai * HALF + m * 16) * 1024 + col0;
#pragma unroll
                for (int bj = 0; bj < 2; ++bj) { const f32x4 v0 = acc[ai][bj][m][0], v1 = acc[ai][bj][m][1];
                    u32x4 w; w.x = cvt_pk(v0[0], v0[1]); w.y = cvt_pk(v0[2], v0[3]); w.z = cvt_pk(v1[0], v1[1]); w.w = cvt_pk(v1[2], v1[3]);
                    *(u32x4*)(rowp + bj * HALF) = w; } }
    }
};
struct EpiBf {
    static constexpr bool PERM = true, AFTER_DRAIN = false;
    bf16_t* O; int ldc;
    __device__ __forceinline__ void operator()(const f32x4 (&acc)[2][2][4][2], const Unit& u, int wr, int wc, int fr, int fq) const {
        const int row0 = u.pm * BM + wr * 64 + fr, col0 = u.pn * BM + wc * 32 + 8 * fq;
#pragma unroll
        for (int ai = 0; ai < 2; ++ai)
#pragma unroll
            for (int m = 0; m < 4; ++m) { bf16_t* rowp = O + (size_t)(row0 + ai * HALF + m * 16) * ldc + col0;
#pragma unroll
                for (int bj = 0; bj < 2; ++bj) { const f32x4 v0 = acc[ai][bj][m][0], v1 = acc[ai][bj][m][1];
                    u32x4 w; w.x = cvt_pk(v0[0], v0[1]); w.y = cvt_pk(v0[2], v0[3]); w.z = cvt_pk(v1[0], v1[1]); w.w = cvt_pk(v1[2], v1[3]);
                    *(u32x4*)(rowp + bj * HALF) = w; } }
    }
};
struct EpiRes {
    static constexpr bool PERM = false, AFTER_DRAIN = false;
    const float* X; float* O; const float* mod; int goff;
    __device__ __forceinline__ void operator()(const f32x4 (&acc)[2][2][4][2], const Unit& u, int wr, int wc, int fr, int fq) const {
        const int row0 = u.pm * BM + wr * 64 + fr, col0 = u.pn * BM + wc * 32 + 4 * fq;
        const float* gp = mod + (size_t)((u.pm * BM) >> 11) * NMOD + goff + col0;
        f32x4 gv[2][2];
#pragma unroll
        for (int bj = 0; bj < 2; ++bj)
#pragma unroll
            for (int n = 0; n < 2; ++n) gv[bj][n] = *(const f32x4*)(gp + bj * HALF + 16 * n);
#pragma unroll
        for (int ai = 0; ai < 2; ++ai)
#pragma unroll
            for (int m = 0; m < 4; ++m) { const size_t ro = (size_t)(row0 + ai * HALF + m * 16) * D_ + col0;
#pragma unroll
                for (int bj = 0; bj < 2; ++bj)
#pragma unroll
                    for (int n = 0; n < 2; ++n) { const f32x4 xv = *(const f32x4*)(X + ro + bj * HALF + 16 * n);
                        *(f32x4*)(O + ro + bj * HALF + 16 * n) = xv + gv[bj][n] * acc[ai][bj][m][n]; } }
    }
};
template <class Epi, class Sched, bool ALIGN_EPI = false, bool SP2 = false>
__device__ __forceinline__ void gemm_phase(PG8_LAS unsigned char* lds, const Gemm g, const Sched& S, const Epi& E) {
    const int tid = get_tid(), wid = __builtin_amdgcn_readfirstlane(tid >> 6), lane = tid & 63, wr = wid >> 2, wc = wid & 3, fr = lane & 15, fq = lane >> 4;
    const int K = g.K, nt = K / BK;
    unsigned voffA[2], voffB[2];
#pragma unroll
    for (int i = 0; i < 2; ++i) { int R, C; stage_rc(tid * 16 + i * 8192, R, C); const int Rb = Epi::PERM ? ((R & ~31) + perm32(R & 31)) : R;
        voffA[i] = (unsigned)(R * K + C) * 2u; voffB[i] = (unsigned)(Rb * K + C) * 2u; }
    const size_t kstep = (size_t)(BK * 2);
    const size_t hstep = (size_t)HALF * K * 2;
    const size_t tstep = 2 * hstep;
    const unsigned ldsw = (unsigned)wid * 1024u;
    const int aoff = lds_byte(wr * 64 + fr, fq * 8), boff = lds_byte(wc * 32 + fr, fq * 8);
#define PG8_SA(b, h) (((b) * 2 + (h)) * HTB)
#define PG8_SB(b, h) ((4 + (b) * 2 + (h)) * HTB)
#define PG8_STAGE(bufoff, gbase, voff) do { _Pragma("unroll") for (int _i = 0; _i < 2; ++_i) \
        __builtin_amdgcn_global_load_lds((const unsigned*)((const char*)(gbase) + (voff)[_i]), (PG8_LAS unsigned*)(lds + (bufoff) + ldsw + _i * 8192), 16, 0, 0); } while (0)
#define PG8_LDA(dst, b, h) do { _Pragma("unroll") for (int m = 0; m < 4; ++m) _Pragma("unroll") for (int k = 0; k < 2; ++k) dst[m][k] = *(const PG8_LAS bf16x8*)(lds + PG8_SA(b, h) + aoff + m * 2048 + k * 1024); } while (0)
#define PG8_LDB(dst, b, h) do { _Pragma("unroll") for (int n = 0; n < 2; ++n) _Pragma("unroll") for (int k = 0; k < 2; ++k) dst[n][k] = *(const PG8_LAS bf16x8*)(lds + PG8_SB(b, h) + boff + n * 2048 + k * 1024); } while (0)
#define PG8_MMA(ai, bj, At, Bt) do { __builtin_amdgcn_s_setprio(1); _Pragma("unroll") for (int m = 0; m < 4; ++m) _Pragma("unroll") for (int n = 0; n < 2; ++n) _Pragma("unroll") for (int k = 0; k < 2; ++k) \
        acc[ai][bj][m][n] = __builtin_amdgcn_mfma_f32_16x16x32_bf16(Bt[n][k], At[m][k], acc[ai][bj][m][n], 0, 0, 0); __builtin_amdgcn_s_setprio(0); } while (0)
#define PG8_WAIT_V(n) asm volatile("s_waitcnt vmcnt(" #n ")" ::: "memory")
#define PG8_WAIT_L(n) asm volatile("s_waitcnt lgkmcnt(" #n ")" ::: "memory")
#define PG8_BAR __builtin_amdgcn_s_barrier()
#define PG8_SCHED __builtin_amdgcn_sched_barrier(0)
    Unit cur, nxt; int ui = 0;
    if (!S.next(0, cur)) return;
    f32x4 acc[2][2][4][2];
#pragma unroll
    for (int a = 0; a < 2; ++a)
#pragma unroll
        for (int b = 0; b < 2; ++b)
#pragma unroll
            for (int m = 0; m < 4; ++m)
#pragma unroll
                for (int n = 0; n < 2; ++n) acc[a][b][m][n] = (f32x4){0.f, 0.f, 0.f, 0.f};
    bf16x8 At[4][2], B0[2][2], B1[2][2];
    const char* cA = (const char*)g.A + (size_t)cur.pm * tstep; const char* cB = (const char*)g.Bt + (size_t)cur.pn * tstep;
    S.a_ready(cur);
    if constexpr (SP2) {
        PG8_STAGE(PG8_SB(0, 0), cB, voffB); PG8_STAGE(PG8_SB(0, 1), cB + hstep, voffB); PG8_STAGE(PG8_SA(0, 0), cA, voffA); PG8_STAGE(PG8_SA(0, 1), cA + hstep, voffA);
        if (wr == 1) PG8_BAR;
        PG8_WAIT_V(2); PG8_BAR;
        PG8_STAGE(PG8_SB(1, 0), cB + kstep, voffB); PG8_STAGE(PG8_SA(1, 0), cA + kstep, voffA); PG8_STAGE(PG8_SB(1, 1), cB + hstep + kstep, voffB);
        PG8_WAIT_V(6); PG8_BAR;
    } else {
        PG8_STAGE(PG8_SB(0, 0), cB, voffB); PG8_STAGE(PG8_SA(0, 0), cA, voffA); PG8_STAGE(PG8_SB(0, 1), cB + hstep, voffB); PG8_STAGE(PG8_SA(0, 1), cA + hstep, voffA);
        if (wr == 1) PG8_BAR;
        PG8_WAIT_V(4); PG8_BAR;
        PG8_STAGE(PG8_SB(1, 0), cB + kstep, voffB); PG8_STAGE(PG8_SA(1, 0), cA + kstep, voffA); PG8_STAGE(PG8_SB(1, 1), cB + hstep + kstep, voffB);
        PG8_WAIT_V(6); PG8_BAR;
    }
    for (;;) {
        const bool has_next = S.next(ui + 1, nxt);
        const char* nA = has_next ? (const char*)g.A + (size_t)nxt.pm * tstep : cA; const char* nB = has_next ? (const char*)g.Bt + (size_t)nxt.pn * tstep : cB;
        for (int t = 0; t < nt; t += 2) {
            const bool last = (t == nt - 2);
            const char* a1 = cA + (size_t)(t + 1) * kstep;
            const char* a2 = last ? nA : cA + (size_t)(t + 2) * kstep; const char* b2 = last ? nB : cB + (size_t)(t + 2) * kstep;
            const char* a3 = a2 + kstep; const char* b3 = b2 + kstep;
            if (last && has_next) S.a_ready(nxt);
            if constexpr (SP2) {
            PG8_LDB(B0, 0, 0); PG8_LDB(B1, 0, 1); PG8_SCHED; PG8_LDA(At, 0, 0); PG8_STAGE(PG8_SA(1, 1), a1 + hstep, voffA);
            PG8_WAIT_V(8); PG8_WAIT_L(0); PG8_BAR; PG8_MMA(0, 0, At, B0); PG8_MMA(0, 1, At, B1); PG8_BAR; PG8_SCHED;
            PG8_LDA(At, 0, 1); PG8_STAGE(PG8_SB(0, 0), b2, voffB); PG8_STAGE(PG8_SB(0, 1), b2 + hstep, voffB); PG8_STAGE(PG8_SA(0, 0), a2, voffA);
            PG8_WAIT_V(8); PG8_WAIT_L(0); PG8_BAR; PG8_MMA(1, 0, At, B0); PG8_MMA(1, 1, At, B1); PG8_BAR; PG8_SCHED;
            PG8_LDB(B0, 1, 0); PG8_LDB(B1, 1, 1); PG8_SCHED; PG8_LDA(At, 1, 0); PG8_STAGE(PG8_SA(0, 1), a2 + hstep, voffA);
            PG8_WAIT_V(8); PG8_WAIT_L(0); PG8_BAR; PG8_MMA(0, 0, At, B0); PG8_MMA(0, 1, At, B1); PG8_BAR; PG8_SCHED;
            PG8_LDA(At, 1, 1); PG8_STAGE(PG8_SB(1, 0), b3, voffB); PG8_STAGE(PG8_SB(1, 1), b3 + hstep, voffB); PG8_STAGE(PG8_SA(1, 0), a3, voffA);
            PG8_WAIT_V(8); PG8_WAIT_L(0); PG8_BAR; PG8_MMA(1, 0, At, B0); PG8_MMA(1, 1, At, B1); PG8_BAR; PG8_SCHED;
            } else {
            PG8_LDB(B0, 0, 0); PG8_SCHED; PG8_LDA(At, 0, 0); PG8_STAGE(PG8_SA(1, 1), a1 + hstep, voffA);
            PG8_WAIT_L(8); PG8_BAR; PG8_WAIT_L(0); PG8_MMA(0, 0, At, B0); PG8_BAR; PG8_SCHED;
            PG8_LDB(B1, 0, 1); PG8_STAGE(PG8_SB(0, 0), b2, voffB);
            PG8_BAR; PG8_WAIT_L(0); PG8_MMA(0, 1, At, B1); PG8_BAR;
            PG8_LDA(At, 0, 1); PG8_STAGE(PG8_SA(0, 0), a2, voffA);
            PG8_BAR; PG8_WAIT_L(0); PG8_MMA(1, 0, At, B0); PG8_BAR; PG8_SCHED;
            PG8_STAGE(PG8_SB(0, 1), b2 + hstep, voffB);
            PG8_WAIT_V(6); PG8_BAR; PG8_MMA(1, 1, At, B1); PG8_BAR;
            PG8_LDB(B0, 1, 0); PG8_SCHED; PG8_LDA(At, 1, 0); PG8_STAGE(PG8_SA(0, 1), a2 + hstep, voffA);
            PG8_WAIT_L(8); PG8_BAR; PG8_WAIT_L(0); PG8_MMA(0, 0, At, B0); PG8_BAR; PG8_SCHED;
            PG8_LDB(B1, 1, 1); PG8_STAGE(PG8_SB(1, 0), b3, voffB);
            PG8_BAR; PG8_WAIT_L(0); PG8_MMA(0, 1, At, B1); PG8_BAR;
            PG8_LDA(At, 1, 1); PG8_STAGE(PG8_SA(1, 0), a3, voffA);
            PG8_BAR; PG8_WAIT_L(0); PG8_MMA(1, 0, At, B0); PG8_BAR; PG8_SCHED;
            PG8_STAGE(PG8_SB(1, 1), b3 + hstep, voffB);
            PG8_WAIT_V(6); PG8_BAR; PG8_MMA(1, 1, At, B1); PG8_BAR;
            }
        }
        if constexpr (ALIGN_EPI) { if (wr == 0) PG8_BAR; }
        if constexpr (!Epi::AFTER_DRAIN) { E(acc, cur, wr, wc, fr, fq); S.done(cur); }
        if (!has_next) break;
#pragma unroll
        for (int a = 0; a < 2; ++a)
#pragma unroll
            for (int b = 0; b < 2; ++b)
#pragma unroll
                for (int m = 0; m < 4; ++m)
#pragma unroll
                    for (int n = 0; n < 2; ++n) acc[a][b][m][n] = (f32x4){0.f, 0.f, 0.f, 0.f};
        cur = nxt; cA = nA; cB = nB; ++ui;
        if constexpr (ALIGN_EPI) { if (wr == 1) PG8_BAR; }
    }
    PG8_WAIT_V(0);
    if constexpr (!ALIGN_EPI) { if (wr == 0) PG8_BAR; }
    PG8_BAR;
    if constexpr (Epi::AFTER_DRAIN) { E.fused(acc, cur, wr, wc, fr, fq, lds, wid, lane); S.done(cur); }
#undef PG8_SA
#undef PG8_SB
#undef PG8_STAGE
#undef PG8_LDA
#undef PG8_LDB
#undef PG8_MMA
#undef PG8_WAIT_V
#undef PG8_WAIT_L
#undef PG8_BAR
#undef PG8_SCHED
}
}
#define XB_TMO      128
#define XB_XCNT(j)  (256  + 64 * (j))
#define XB_XSUB(j)  (1280 + 64 * (j))
#define XB_XGEN(j)  (2304 + 64 * (j))
#define XB_TOP      3328
#define XB_TOPGEN   3392
#define XCD_BAR_WORDS 3456
#define XB_SPIN_CAP (1u << 18)

__device__ __forceinline__ unsigned xb_ld(unsigned* p)              { return __hip_atomic_load(p, __ATOMIC_RELAXED, __HIP_MEMORY_SCOPE_AGENT); }
__device__ __forceinline__ unsigned xb_add(unsigned* p, unsigned v) { return __hip_atomic_fetch_add(p, v, __ATOMIC_RELAXED, __HIP_MEMORY_SCOPE_AGENT); }
__device__ __forceinline__ unsigned xb_xcc_id() { return (unsigned)__builtin_amdgcn_s_getreg((3 << 11) | 20) & 0xFu; }
#define XB_SPIN(cond, bar) do { unsigned _sp = 0; while (cond) { __builtin_amdgcn_s_sleep(1); \
    if ((++_sp & 255u) == 0u) { if (xb_ld(&(bar)[XB_TMO])) break; if (_sp > XB_SPIN_CAP) { atomicAdd(&(bar)[XB_TMO], 1u); break; } } } } while (0)

struct XcdBarrier {
    unsigned* bar; unsigned x;
    volatile LAS unsigned* st;
};

__device__ __forceinline__ XcdBarrier xcd_barrier_post(unsigned* bar, volatile LAS unsigned* st) {
    XcdBarrier b; b.bar = bar; b.x = xb_xcc_id(); b.st = st;
    if (threadIdx.x == 0) (void)xb_add(&bar[XB_XCNT(b.x)], 1u);
    return b;
}
__device__ __forceinline__ void xcd_barrier_complete(unsigned* bar, unsigned x, unsigned& nloc, unsigned& nx) {
    const unsigned G = gridDim.x * gridDim.y * gridDim.z;
    unsigned sum, cnt, mine, sp = 0u;
    for (;;) {
        sum = 0u; cnt = 0u; mine = 0u;
#pragma unroll
        for (unsigned j = 0; j < 16; ++j) { const unsigned c = xb_ld(&bar[XB_XCNT(j)]); sum += c; cnt += (c > 0u) ? 1u : 0u; mine = (j == x) ? c : mine; }
        if (sum == G) break;
        __builtin_amdgcn_s_sleep(1);
        if ((++sp & 255u) == 0u) { if (xb_ld(&bar[XB_TMO])) break; if (sp > XB_SPIN_CAP) { atomicAdd(&bar[XB_TMO], 1u); break; } }
    }
    nloc = mine > 0u ? mine : 1u; nx = cnt > 0u ? cnt : 1u;
}

__device__ __forceinline__ void xcd_barrier(const XcdBarrier& b) {
    asm volatile("s_waitcnt vmcnt(0)" ::: "memory");
    __syncthreads();
    if (threadIdx.x == 0) {
        unsigned* bar = b.bar;
        __builtin_amdgcn_s_waitcnt(0);
        unsigned nloc = b.st[0], nx = b.st[1];
        if (nloc == 0u) { xcd_barrier_complete(bar, b.x, nloc, nx); b.st[0] = nloc; b.st[1] = nx; }
        const unsigned old = xb_add(&bar[XB_XSUB(b.x)], 1u);
        const unsigned gen = old / nloc;
        if (old + 1u == (gen + 1u) * nloc) {
            __builtin_amdgcn_fence(__ATOMIC_RELEASE, "agent");
            asm volatile("s_waitcnt vmcnt(0)" ::: "memory");
            const unsigned og = xb_add(&bar[XB_TOP], 1u);
            const unsigned tg = og / nx;
            if (og + 1u == (tg + 1u) * nx) xb_add(&bar[XB_TOPGEN], 1u);
            else XB_SPIN(xb_ld(&bar[XB_TOPGEN]) == tg, bar);
            __builtin_amdgcn_fence(__ATOMIC_ACQUIRE, "agent");
            xb_add(&bar[XB_XGEN(b.x)], 1u);
            asm volatile("s_waitcnt vmcnt(0)" ::: "memory");
        } else {
            XB_SPIN(xb_ld(&bar[XB_XGEN(b.x)]) == gen, bar);
            __builtin_amdgcn_fence(__ATOMIC_ACQUIRE, "agent");
            asm volatile("s_waitcnt vmcnt(0)" ::: "memory");
        }
    }
    __syncthreads();
}
__device__ __forceinline__ void phase_prep(const Params& p, unsigned char* lds, int bid, int nb) {
    const int tid = get_tid(), lane = tid & 63, wave = tid >> 6;
    unsigned char* ws = p.ws;
    float* mod = (float*)(ws + WS_MOD);
    if (bid < 192) {
        float* sc = (float*)lds;
        float* red = sc + 8 * 2048;
        for (int i = tid; i < 8 * 2048; i += NTHR) sc[i] = silu_f(p.c[i]);
        __syncthreads();
        for (int it = bid; it < 192; it += nb) {
            const int col = it * 64 + lane;
            float acc[8];
#pragma unroll
            for (int b = 0; b < 8; ++b) acc[b] = 0.f;
            const float* w = p.w_ada + (size_t)(wave * 256) * NMOD + col;
            const float* s0 = sc + wave * 256;
#pragma unroll 4
            for (int k = 0; k < 256; ++k) {
                const float wv = w[(size_t)k * NMOD];
#pragma unroll
                for (int b = 0; b < 8; ++b) acc[b] += s0[b * 2048 + k] * wv;
            }
#pragma unroll
            for (int b = 0; b < 8; ++b) red[(wave * 8 + b) * 64 + lane] = acc[b];
            __syncthreads();
            {   const int b = wave; float s = p.b_ada[col];
#pragma unroll
                for (int w2 = 0; w2 < 8; ++w2) s += red[(w2 * 8 + b) * 64 + lane];
                mod[b * NMOD + col] = s; }
            __syncthreads();
        }
    }
    __syncthreads();
    {
        float* tile = (float*)lds;
        bf16_t* WinT = (bf16_t*)(ws + WS_WINT); bf16_t* WoT = (bf16_t*)(ws + WS_WOT); bf16_t* WqT = (bf16_t*)(ws + WS_WQT);
        for (int item = bid; item < 5632; item += nb) {
            const float* src; int ld, scol; bf16_t* dst; int kt;
            if (item < 3584) { const int seg = item >> 9, rem = item & 511, ntile = rem >> 5; kt = rem & 31;
                src = p.w_in; ld = INCOLS; scol = (seg < 3 ? seg * 1024 : 3080 + (seg - 3) * 1024) + ntile * 64; dst = WinT + (size_t)(seg * 1024 + ntile * 64) * 2048; }
            else if (item < 4608) { const int rem = item - 3584, ntile = rem >> 5; kt = rem & 31; src = p.w_out; ld = 2048; scol = ntile * 64; dst = WoT + (size_t)(ntile * 64) * 2048; }
            else { const int rem = item - 4608, ntile = rem >> 5; kt = rem & 31; src = p.w_q; ld = 2048; scol = ntile * 64; dst = WqT + (size_t)(ntile * 64) * 2048; }
            const int k0 = kt * 64;
#pragma unroll
            for (int ii = 0; ii < 8; ++ii) { const int k = wave + 8 * ii; tile[k * 65 + lane] = src[(size_t)(k0 + k) * ld + scol + lane]; }
            __syncthreads();
#pragma unroll
            for (int ii = 0; ii < 8; ++ii) { const int n = wave + 8 * ii; dst[(size_t)n * 2048 + k0 + lane] = (bf16_t)(cvt_pk(tile[lane * 65 + n], 0.f) & 0xffffu); }
            __syncthreads();
        }
    }
    {
        float* Wg = (float*)(ws + WS_WG);
        for (int i = bid * NTHR + tid; i < 16 * 2048; i += nb * NTHR) { const int g = i >> 11, k = i & 2047; const int col = g < 8 ? 3072 + g : 7176 + (g - 8);
            Wg[i] = p.w_in[(size_t)k * INCOLS + col]; }
    }
}

__device__ __forceinline__ unsigned pack4_fp8(const f32x4 a) { int t = __builtin_amdgcn_cvt_pk_fp8_f32(a[0], a[1], 0, false); t = __builtin_amdgcn_cvt_pk_fp8_f32(a[2], a[3], t, true); return (unsigned)t; }
__device__ __forceinline__ void convert_experts(const Params& p, int bid, int nb) {
    const int tid = get_tid(); unsigned char* ws = p.ws;
    unsigned char* E8D = ws + WS_E8D; unsigned char* E8US = ws + WS_E8U;
    for (int i = bid * NTHR + tid; i < 2097152; i += nb * NTHR) {
        const f32x4* sp = (const f32x4*)p.e_down + (size_t)i * 4;
        u32x4 w; w.x = pack4_fp8(sp[0] * 512.f); w.y = pack4_fp8(sp[1] * 512.f); w.z = pack4_fp8(sp[2] * 512.f); w.w = pack4_fp8(sp[3] * 512.f);
        *(u32x4*)(E8D + (size_t)i * 16) = w;
    }
    for (int i = bid * NTHR + tid; i < 524288; i += nb * NTHR) {
        const int s = i & 255, eg = i >> 8;
        const float* sp = p.e_up + (size_t)(eg * 8) * 2048 + 8 * s;
        unsigned w[16];
#pragma unroll
        for (int q = 0; q < 8; ++q) { const f32x4 a = *(const f32x4*)(sp + (size_t)q * 2048), b = *(const f32x4*)(sp + (size_t)q * 2048 + 4); w[2 * q] = pack4_fp8(a * 32.f); w[2 * q + 1] = pack4_fp8(b * 32.f); }
        u32x4* dp = (u32x4*)(E8US + ((size_t)s * 16384 + eg * 8) * 8);
#pragma unroll
        for (int q = 0; q < 4; ++q) { u32x4 o; o.x = w[4 * q]; o.y = w[4 * q + 1]; o.z = w[4 * q + 2]; o.w = w[4 * q + 3]; dp[q] = o; }
    }
}

template <bool GATES>
__device__ __forceinline__ void phase_norm(const float* xin, const float* gain, const float* mod, int shift_off, int scale_off, bf16_t* hout, const float* Wg, float* gate_out, int bid, int nb) {
    const int tid = get_tid(), lane = tid & 63, wave = tid >> 6;
    for (int row = bid * 8 + wave; row < T_; row += nb * 8) {
        const f32x4* xr = (const f32x4*)(xin + (size_t)row * D_);
        f32x4 v[8]; float ss = 0.f;
#pragma unroll
        for (int j = 0; j < 8; ++j) { v[j] = xr[lane + 64 * j]; ss += v[j][0] * v[j][0] + v[j][1] * v[j][1] + v[j][2] * v[j][2] + v[j][3] * v[j][3]; }
        ss = wsum(ss);
        const float r = rsqrtf(ss * (1.f / D_) + EPS_);
        const float* mb = mod + (size_t)(row >> 11) * NMOD;
        f32x4 hv[8];
#pragma unroll
        for (int j = 0; j < 8; ++j) {
            const int k = 4 * (lane + 64 * j);
            const f32x4 gn = *(const f32x4*)(gain + k), sh = *(const f32x4*)(mb + shift_off + k), scl = *(const f32x4*)(mb + scale_off + k);
#pragma unroll
            for (int e = 0; e < 4; ++e) hv[j][e] = (v[j][e] * r) * gn[e] * (1.f + scl[e]) + sh[e];
            u32x2 w; w.x = cvt_pk(hv[j][0], hv[j][1]); w.y = cvt_pk(hv[j][2], hv[j][3]);
            *(u32x2*)(hout + (size_t)row * D_ + k) = w;
        }
        if (GATES) {
            float outv = 0.f;
#pragma unroll 1
            for (int g = 0; g < 16; ++g) {
                float ga = 0.f;
#pragma unroll
                for (int j = 0; j < 8; ++j) { const f32x4 wv = *(const f32x4*)(Wg + g * 2048 + 4 * (lane + 64 * j)); ga += hv[j][0] * wv[0] + hv[j][1] * wv[1] + hv[j][2] * wv[2] + hv[j][3] * wv[3]; }
                const float s = wsum(ga); if (lane == g) outv = s;
            }
            if (lane < 16) gate_out[(size_t)row * 16 + lane] = outv;
        }
    }
}

__device__ __forceinline__ void phase_post(const Params& p, int bid, int nb) {
    const int tid = get_tid(), lane = tid & 63, wave = tid >> 6;
    unsigned char* ws = p.ws;
    bf16_t* Pq = (bf16_t*)(ws + WS_P); bf16_t* Pk = (bf16_t*)(ws + WS_P + SEG_B);
    const float qscale = 0.08838834764831845f;
    for (int r = bid * 8 + wave; r < 2 * T_; r += nb * 8) {
        const int which = r >= T_ ? 1 : 0; const int t = r - which * T_;
        bf16_t* ptr = (which ? Pk : Pq) + (size_t)t * 1024 + lane * 16;
        const float* gn = (which ? p.fox_kg : p.fox_qg) + (lane & 7) * 16;
        u32x4 a = *(const u32x4*)ptr, b = *(const u32x4*)(ptr + 8);
        float f[16];
        f[0] = bflo(a.x); f[1] = bfhi(a.x); f[2] = bflo(a.y); f[3] = bfhi(a.y); f[4] = bflo(a.z); f[5] = bfhi(a.z); f[6] = bflo(a.w); f[7] = bfhi(a.w);
        f[8] = bflo(b.x); f[9] = bfhi(b.x); f[10] = bflo(b.y); f[11] = bfhi(b.y); f[12] = bflo(b.z); f[13] = bfhi(b.z); f[14] = bflo(b.w); f[15] = bfhi(b.w);
        float ss = 0.f;
#pragma unroll
        for (int i = 0; i < 16; ++i) ss += f[i] * f[i];
        ss += __shfl_xor(ss, 1); ss += __shfl_xor(ss, 2); ss += __shfl_xor(ss, 4);
        const float rr = rsqrtf(ss * (1.f / 128.f) + EPS_) * (which ? 1.f : qscale);
#pragma unroll
        for (int i = 0; i < 16; ++i) f[i] = (f[i] * rr) * gn[i];
        a.x = cvt_pk(f[0], f[1]); a.y = cvt_pk(f[2], f[3]); a.z = cvt_pk(f[4], f[5]); a.w = cvt_pk(f[6], f[7]);
        b.x = cvt_pk(f[8], f[9]); b.y = cvt_pk(f[10], f[11]); b.z = cvt_pk(f[12], f[13]); b.w = cvt_pk(f[14], f[15]);
        *(u32x4*)ptr = a; *(u32x4*)(ptr + 8) = b;
    }
    {
        const bf16_t* Mq = (const bf16_t*)(ws + WS_P + 3 * SEG_B); const bf16_t* Mk = (const bf16_t*)(ws + WS_P + 4 * SEG_B);
        bf16_t* QC = (bf16_t*)(ws + WS_QC); bf16_t* KC = (bf16_t*)(ws + WS_KC);
        for (int item = bid; item < 256; item += nb) {
            const int which = item >> 7, tb = item & 127, cg = tid & 127, run = tid >> 7, ch0 = cg * 8, ts = tb * 128 + run * 32, sp = ts & 2047;
            const bf16_t* src = (which ? Mk : Mq) + (size_t)ts * 1024 + ch0; bf16_t* dst = (which ? KC : QC) + (size_t)ts * 1024 + ch0;
            float w0[8], w1[8], w2[8], w3[8], cb[8], x0[8], x1[8], x2[8];
#pragma unroll
            for (int e = 0; e < 8; ++e) { const int ci = which * 1024 + ch0 + e; w0[e] = p.conv_w[ci]; w1[e] = p.conv_w[2048 + ci]; w2[e] = p.conv_w[4096 + ci]; w3[e] = p.conv_w[6144 + ci]; cb[e] = p.conv_b[ci]; }
            {   u32x4 a = {0u, 0u, 0u, 0u}, b = a, c = a;
                if (sp != 0) { a = *(const u32x4*)(src - 3 * 1024); b = *(const u32x4*)(src - 2 * 1024); c = *(const u32x4*)(src - 1024); }
#pragma unroll
                for (int e = 0; e < 4; ++e) { x0[2 * e] = bflo(a[e]); x0[2 * e + 1] = bfhi(a[e]); x1[2 * e] = bflo(b[e]); x1[2 * e + 1] = bfhi(b[e]); x2[2 * e] = bflo(c[e]); x2[2 * e + 1] = bfhi(c[e]); } }
            const float osc = which ? 0.0625f : 1.f;
            for (int s = 0; s < 32; ++s) {
                const u32x4 d = *(const u32x4*)(src + (size_t)s * 1024); float x3[8], y[8];
#pragma unroll
                for (int e = 0; e < 4; ++e) { x3[2 * e] = bflo(d[e]); x3[2 * e + 1] = bfhi(d[e]); }
#pragma unroll
                for (int e = 0; e < 8; ++e) { y[e] = silu_f(w0[e] * x0[e] + w1[e] * x1[e] + w2[e] * x2[e] + w3[e] * x3[e] + cb[e]) * osc; x0[e] = x1[e]; x1[e] = x2[e]; x2[e] = x3[e]; }
                u32x4 o; o.x = cvt_pk(y[0], y[1]); o.y = cvt_pk(y[2], y[3]); o.z = cvt_pk(y[4], y[5]); o.w = cvt_pk(y[6], y[7]);
                *(u32x4*)(dst + (size_t)s * 1024) = o;
            }
        }
    }
    const float* gate = (const float*)(ws + WS_GATE); float* F = (float*)(ws + WS_F);
    for (int sq = bid * 8 + wave; sq < 64; sq += nb * 8) {
        const int b = sq >> 3, h = sq & 7; const float fb = p.fox_fb[h];
        float v[32]; float run = 0.f;
#pragma unroll
        for (int i = 0; i < 32; ++i) { const int t = lane * 32 + i; run += logsig(gate[(size_t)(b * S_ + t) * 16 + h] + fb); v[i] = run; }
        float inc = run;
#pragma unroll
        for (int o = 1; o < 64; o <<= 1) { const float u = __shfl_up(inc, o); if (lane >= o) inc += u; }
        const float excl = inc - run;
#pragma unroll
        for (int i = 0; i < 32; ++i) F[(size_t)sq * S_ + lane * 32 + i] = v[i] + excl;
    }
}
__device__ __forceinline__ void fox_unit(const Params& p, unsigned char* lds, int b, int h, int qb) {
    const int tid = get_tid(), lane = tid & 63, wave = tid >> 6, r = lane & 31, hh = lane >> 5;
    unsigned char* ws = p.ws;
    const bf16_t* Pq = (const bf16_t*)(ws + WS_P); const bf16_t* Pk = (const bf16_t*)(ws + WS_P + SEG_B); const bf16_t* Pv = (const bf16_t*)(ws + WS_P + 2 * SEG_B);
    const float* F = (const float*)(ws + WS_F) + (size_t)(b * 8 + h) * S_;
    bf16_t* Oc = (bf16_t*)(ws + WS_H);
    bf16_t* Ks = (bf16_t*)lds;
    bf16_t* Vs = Ks + 64 * 136;
    float* Fs = (float*)(Vs + 128 * 72);
    const int q0w = qb * 256 + wave * 32, qs = q0w + r;
    const size_t trow = (size_t)(b * S_ + qs);
    bf16x8 qf[8];
#pragma unroll
    for (int ks = 0; ks < 8; ++ks) qf[ks] = *(const bf16x8*)(Pq + trow * 1024 + h * 128 + ks * 16 + hh * 8);
    const float Fq = F[qs];
    f32x16 o[4];
#pragma unroll
    for (int d = 0; d < 4; ++d)
#pragma unroll
        for (int i = 0; i < 16; ++i) o[d][i] = 0.f;
    float m = -INFINITY, l = 0.f;
    const int ntile = (qb * 256 + 256) / 64;
    for (int kt = 0; kt < ntile; ++kt) {
        const int k0 = kt * 64;
        __syncthreads();
#pragma unroll
        for (int i = 0; i < 2; ++i) { const int c = tid + NTHR * i, row = c >> 4, cc = c & 15;
            *(u32x4*)(Ks + row * 136 + cc * 8) = *(const u32x4*)(Pk + (size_t)(b * S_ + k0 + row) * 1024 + h * 128 + cc * 8); }
#pragma unroll
        for (int i = 0; i < 2; ++i) { const int c = tid + NTHR * i, key = c >> 4, cc = c & 15;
            const u32x4 w = *(const u32x4*)(Pv + (size_t)(b * S_ + k0 + key) * 1024 + h * 128 + cc * 8);
            bf16_t* vp = Vs + (cc * 8) * 72 + key;
            vp[0 * 72] = (bf16_t)(w.x & 0xffffu); vp[1 * 72] = (bf16_t)(w.x >> 16); vp[2 * 72] = (bf16_t)(w.y & 0xffffu); vp[3 * 72] = (bf16_t)(w.y >> 16);
            vp[4 * 72] = (bf16_t)(w.z & 0xffffu); vp[5 * 72] = (bf16_t)(w.z >> 16); vp[6 * 72] = (bf16_t)(w.w & 0xffffu); vp[7 * 72] = (bf16_t)(w.w >> 16); }
        if (tid < 64) Fs[tid] = F[k0 + tid];
        __syncthreads();
        if (k0 <= q0w + 31) {
            f32x16 s[2];
#pragma unroll
            for (int kb = 0; kb < 2; ++kb) {
#pragma unroll
                for (int i = 0; i < 16; ++i) s[kb][i] = 0.f;
#pragma unroll
                for (int ks = 0; ks < 8; ++ks) { const bf16x8 a = *(const bf16x8*)(Ks + (kb * 32 + r) * 136 + ks * 16 + hh * 8);
                    s[kb] = __builtin_amdgcn_mfma_f32_32x32x16_bf16(a, qf[ks], s[kb], 0, 0, 0); }
            }
            float mx = m;
#pragma unroll
            for (int kb = 0; kb < 2; ++kb)
#pragma unroll
                for (int i = 0; i < 16; ++i) { const int kl = kb * 32 + (i & 3) + 8 * (i >> 2) + 4 * hh; float val = s[kb][i] + Fq - Fs[kl];
                    if (k0 + kl > qs) val = -INFINITY; s[kb][i] = val; mx = fmaxf(mx, val); }
            mx = fmaxf(mx, __shfl_xor(mx, 32));
            const float alpha = __expf(m - mx);
            float ps = 0.f;
#pragma unroll
            for (int kb = 0; kb < 2; ++kb)
#pragma unroll
                for (int i = 0; i < 16; ++i) { const float pv = __expf(s[kb][i] - mx); s[kb][i] = pv; ps += pv; }
            l = l * alpha + ps; m = mx;
#pragma unroll
            for (int d = 0; d < 4; ++d)
#pragma unroll
                for (int i = 0; i < 16; ++i) o[d][i] *= alpha;
#pragma unroll
            for (int kb = 0; kb < 2; ++kb)
#pragma unroll
                for (int st = 0; st < 2; ++st) {
                    u32x4 pw; pw.x = cvt_pk(s[kb][8 * st + 0], s[kb][8 * st + 1]); pw.y = cvt_pk(s[kb][8 * st + 2], s[kb][8 * st + 3]);
                    pw.z = cvt_pk(s[kb][8 * st + 4], s[kb][8 * st + 5]); pw.w = cvt_pk(s[kb][8 * st + 6], s[kb][8 * st + 7]);
                    const bf16x8 pf = __builtin_bit_cast(bf16x8, pw);
#pragma unroll
                    for (int d = 0; d < 4; ++d) { const bf16_t* vp = Vs + (d * 32 + r) * 72 + kb * 32 + st * 16 + hh * 4;
                        const u32x2 lo = *(const u32x2*)vp, hi = *(const u32x2*)(vp + 8);
                        u32x4 vw; vw.x = lo.x; vw.y = lo.y; vw.z = hi.x; vw.w = hi.y;
                        o[d] = __builtin_amdgcn_mfma_f32_32x32x16_bf16(__builtin_bit_cast(bf16x8, vw), pf, o[d], 0, 0, 0); }
                }
        }
    }
    l += __shfl_xor(l, 32);
    const float inv = 1.f / l;
#pragma unroll
    for (int d = 0; d < 4; ++d)
#pragma unroll
        for (int g = 0; g < 4; ++g) { u32x2 w; w.x = cvt_pk(o[d][4 * g] * inv, o[d][4 * g + 1] * inv); w.y = cvt_pk(o[d][4 * g + 2] * inv, o[d][4 * g + 3] * inv);
            *(u32x2*)(Oc + trow * D_ + h * 128 + d * 32 + 8 * g + 4 * hh) = w; }
}

typedef short s16x4 __attribute__((ext_vector_type(4)));
__device__ __forceinline__ s16x4 lds_tr16(const unsigned char* p) { return __builtin_amdgcn_ds_read_tr16_b64_v4i16((LAS s16x4*)p); }
__device__ __forceinline__ bf16x8 tr_frag(const unsigned char* p0, int row4_bytes) {
    const s16x4 a = lds_tr16(p0), b = lds_tr16(p0 + row4_bytes);
    bf16x8 f; f[0] = a[0]; f[1] = a[1]; f[2] = a[2]; f[3] = a[3]; f[4] = b[0]; f[5] = b[1]; f[6] = b[2]; f[7] = b[3]; return f;
}
__device__ __forceinline__ void mlstm_passA(const Params& p, unsigned char* lds, int unit) {
    const int tid = get_tid(), lane = tid & 63, wave = tid >> 6, r = lane & 31, hh = lane >> 5, li = lane & 15;
    const int b = unit >> 3, h = (unit >> 1) & 3, eh = unit & 1;
    unsigned char* ws = p.ws;
    const bf16_t* KC = (const bf16_t*)(ws + WS_KC); const bf16_t* Mv = (const bf16_t*)(ws + WS_P + 5 * SEG_B);
    const float* gate = (const float*)(ws + WS_GATE);
    bf16_t* Cst = (bf16_t*)(ws + WS_CST); float* nst = (float*)(ws + WS_NST); float* mst = (float*)(ws + WS_MST);
    constexpr int KST = 528, VST = 272;
    unsigned char* ksm = lds;
    unsigned char* vsm = ksm + 64 * KST;
    float* WSV = (float*)(vsm + 64 * VST);
    float* SCL = WSV + 2048;
    __syncthreads();
    for (int cc = wave; cc < 32; cc += 8) {
        const int t = b * S_ + cc * 64 + lane;
        const float ipre = gate[(size_t)t * 16 + 8 + h] + p.m_ib[h], fpre = gate[(size_t)t * 16 + 12 + h] + p.m_fb[h];
        float bc = logsig(fpre);
#pragma unroll
        for (int o = 1; o < 64; o <<= 1) { const float u = __shfl_up(bc, o); if (lane >= o) bc += u; }
        const float a = ipre - bc; const float amax = wmax(a); const float bL = __shfl(bc, 63);
        WSV[cc * 64 + lane] = a; if (lane == 0) { SCL[cc] = bL; SCL[32 + cc] = amax; }
    }
    __syncthreads();
    if (tid == 0) { float m = 0.f; for (int cc = 0; cc < 32; ++cc) { const float mn = SCL[cc] + fmaxf(m, SCL[32 + cc]); SCL[64 + cc] = expf(SCL[cc] + m - mn); SCL[96 + cc] = mn; if (eh == 0) mst[(b * 4 + h) * 32 + cc] = m; m = mn; } }
    __syncthreads();
    for (int i = tid; i < 2048; i += NTHR) { const int cc = i >> 6; WSV[i] = expf(SCL[cc] + WSV[i] - SCL[96 + cc]); }
    f32x16 acc[4];
#pragma unroll
    for (int et = 0; et < 4; ++et)
#pragma unroll
        for (int i = 0; i < 16; ++i) acc[et][i] = 0.f;
    float nreg = 0.f;
    const int kb_off = (8 * hh + (li >> 2)) * KST + (wave * 32 + 16 * (r >> 4) + 4 * (li & 3)) * 2;
    const int vb_off = (8 * hh + (li >> 2)) * VST + (16 * (r >> 4) + 4 * (li & 3)) * 2;
    for (int cc = 0; cc < 32; ++cc) {
        const int bhc = (b * 4 + h) * 32 + cc, t0 = b * S_ + cc * 64;
#pragma unroll
        for (int et = 0; et < 4; ++et)
#pragma unroll
            for (int i = 0; i < 16; ++i) Cst[((size_t)bhc * 256 + eh * 128 + et * 32 + (i & 3) + 8 * (i >> 2) + 4 * hh) * 256 + wave * 32 + r] = (bf16_t)(cvt_pk(acc[et][i], 0.f) & 0xffffu);
        if (eh == 0 && tid < 256) nst[(size_t)bhc * 256 + tid] = nreg;
        if (cc == 31) break;
        __syncthreads();
#pragma unroll
        for (int i = 0; i < 4; ++i) { const int c = tid + NTHR * i, row = c >> 5, c16 = c & 31;
            *(u32x4*)(ksm + row * KST + c16 * 16) = *(const u32x4*)(KC + (size_t)(t0 + row) * 1024 + h * 256 + c16 * 8); }
#pragma unroll
        for (int i = 0; i < 2; ++i) { const int c = tid + NTHR * i, row = c >> 4, c16 = c & 15; const float wv = WSV[cc * 64 + row];
            const u32x4 w = *(const u32x4*)(Mv + (size_t)(t0 + row) * 1024 + h * 256 + eh * 128 + c16 * 8);
            u32x4 o; o.x = cvt_pk(bflo(w.x) * wv, bfhi(w.x) * wv); o.y = cvt_pk(bflo(w.y) * wv, bfhi(w.y) * wv); o.z = cvt_pk(bflo(w.z) * wv, bfhi(w.z) * wv); o.w = cvt_pk(bflo(w.w) * wv, bfhi(w.w) * wv);
            *(u32x4*)(vsm + row * VST + c16 * 16) = o; }
        __syncthreads();
        const float decay = SCL[64 + cc];
        if (tid < 256) { float s = 0.f; for (int q = 0; q < 64; ++q) s += WSV[cc * 64 + q] * bf2f(*(const bf16_t*)(ksm + q * KST + tid * 2)); nreg = nreg * decay + s; }
#pragma unroll
        for (int et = 0; et < 4; ++et)
#pragma unroll
            for (int i = 0; i < 16; ++i) acc[et][i] *= decay;
#pragma unroll
        for (int ks = 0; ks < 4; ++ks) {
            const bf16x8 bfr = tr_frag(ksm + kb_off + ks * 16 * KST, 4 * KST);
#pragma unroll
            for (int et = 0; et < 4; ++et) { const bf16x8 afr = tr_frag(vsm + vb_off + ks * 16 * VST + et * 64, 4 * VST);
                acc[et] = __builtin_amdgcn_mfma_f32_32x32x16_bf16(afr, bfr, acc[et], 0, 0, 0); }
        }
    }
}

__device__ __forceinline__ void mlstm_passB(const Params& p, unsigned char* lds, int unit) {
    const int tid = get_tid(), lane = tid & 63, wave = tid >> 6, r = lane & 31, hh = lane >> 5, li = lane & 15;
    const int b = unit >> 7, h = (unit >> 5) & 3, cc = unit & 31;
    unsigned char* ws = p.ws;
    const bf16_t* QC = (const bf16_t*)(ws + WS_QC); const bf16_t* KC = (const bf16_t*)(ws + WS_KC);
    const bf16_t* Mv = (const bf16_t*)(ws + WS_P + 5 * SEG_B); const bf16_t* Mo = (const bf16_t*)(ws + WS_P + 6 * SEG_B);
    const float* gate = (const float*)(ws + WS_GATE);
    const bf16_t* Cst = (const bf16_t*)(ws + WS_CST); const float* nst = (const float*)(ws + WS_NST); const float* mst = (const float*)(ws + WS_MST);
    bf16_t* Oc = (bf16_t*)(ws + WS_H);
    constexpr int QST = 528, VST = 544, WST = 144, HST = 1040;
    unsigned char* qsm = lds;
    unsigned char* ksm = qsm + 64 * QST;
    unsigned char* vsm = ksm + 64 * QST;
    unsigned char* wsm = vsm + 64 * VST;
    float* sc = (float*)(wsm + 64 * WST);
    float* hsm = (float*)lds;
    const int bhc = (b * 4 + h) * 32 + cc, t0 = b * S_ + cc * 64;
    __syncthreads();
    if (wave == 0) {
        const float ipre = gate[(size_t)(t0 + lane) * 16 + 8 + h] + p.m_ib[h], fpre = gate[(size_t)(t0 + lane) * 16 + 12 + h] + p.m_fb[h];
        float bc = logsig(fpre);
#pragma unroll
        for (int o = 1; o < 64; o <<= 1) { const float u = __shfl_up(bc, o); if (lane >= o) bc += u; }
        const float a = ipre - bc; float pm = a;
#pragma unroll
        for (int o = 1; o < 64; o <<= 1) { const float u = __shfl_up(pm, o); if (lane >= o) pm = fmaxf(pm, u); }
        const float mc = mst[bhc]; const float mt = bc + fmaxf(mc, pm);
        sc[lane] = bc - mt; sc[64 + lane] = a; sc[128 + lane] = mt; sc[192 + lane] = expf(bc + mc - mt);
    }
    bf16x8 cfr[16];
#pragma unroll
    for (int ks = 0; ks < 16; ++ks) cfr[ks] = *(const bf16x8*)(Cst + ((size_t)bhc * 256 + wave * 32 + r) * 256 + ks * 16 + hh * 8);
#pragma unroll
    for (int i = 0; i < 4; ++i) { const int c = tid + NTHR * i, row = c >> 5, c16 = c & 31;
        *(u32x4*)(qsm + row * QST + c16 * 16) = *(const u32x4*)(QC + (size_t)(t0 + row) * 1024 + h * 256 + c16 * 8);
        *(u32x4*)(ksm + row * QST + c16 * 16) = *(const u32x4*)(KC + (size_t)(t0 + row) * 1024 + h * 256 + c16 * 8);
        *(u32x4*)(vsm + row * VST + c16 * 16) = *(const u32x4*)(Mv + (size_t)(t0 + row) * 1024 + h * 256 + c16 * 8); }
    __syncthreads();
    if (wave < 3) {
        const int sb = wave >> 1, lb = wave ? 1 : 0;
        f32x16 s;
#pragma unroll
        for (int i = 0; i < 16; ++i) s[i] = 0.f;
#pragma unroll
        for (int ks = 0; ks < 16; ++ks) { const bf16x8 a = *(const bf16x8*)(ksm + (sb * 32 + r) * QST + ks * 32 + hh * 16), q = *(const bf16x8*)(qsm + (lb * 32 + r) * QST + ks * 32 + hh * 16);
            s = __builtin_amdgcn_mfma_f32_32x32x16_bf16(a, q, s, 0, 0, 0); }
        const int l = lb * 32 + r; const float bl = sc[l]; float rs = 0.f;
#pragma unroll
        for (int g = 0; g < 4; ++g) { float w[4];
#pragma unroll
            for (int e = 0; e < 4; ++e) { const int sI = sb * 32 + 8 * g + 4 * hh + e; w[e] = (sI <= l) ? s[4 * g + e] * __expf(bl + sc[64 + sI]) : 0.f; rs += w[e]; }
            u32x2 o; o.x = cvt_pk(w[0], w[1]); o.y = cvt_pk(w[2], w[3]);
            *(u32x2*)(wsm + l * WST + (sb * 32 + 8 * g + 4 * hh) * 2) = o; }
        sc[256 + l * 4 + sb * 2 + hh] = rs;
    } else if (wave == 3) {
        const int l = r;
#pragma unroll
        for (int g = 0; g < 4; ++g) { u32x2 o; o.x = 0u; o.y = 0u; *(u32x2*)(wsm + l * WST + (32 + 8 * g + 4 * hh) * 2) = o; }
        sc[256 + l * 4 + 2 + hh] = 0.f;
    }
    {
        const int l = tid & 63, part = tid >> 6; const float* np = nst + (size_t)bhc * 256 + part * 32; float s = 0.f;
#pragma unroll
        for (int q = 0; q < 4; ++q) { const u32x4 w = *(const u32x4*)(qsm + l * QST + part * 64 + q * 16);
            s += bflo(w.x) * np[8 * q] + bfhi(w.x) * np[8 * q + 1] + bflo(w.y) * np[8 * q + 2] + bfhi(w.y) * np[8 * q + 3] + bflo(w.z) * np[8 * q + 4] + bfhi(w.z) * np[8 * q + 5] + bflo(w.w) * np[8 * q + 6] + bfhi(w.w) * np[8 * q + 7]; }
        sc[512 + l * 8 + part] = s;
    }
    f32x16 acc[2];
#pragma unroll
    for (int lb = 0; lb < 2; ++lb)
#pragma unroll
        for (int i = 0; i < 16; ++i) acc[lb][i] = 0.f;
#pragma unroll
    for (int ks = 0; ks < 16; ++ks)
#pragma unroll
        for (int lb = 0; lb < 2; ++lb) { const bf16x8 q = *(const bf16x8*)(qsm + (lb * 32 + r) * QST + ks * 32 + hh * 16);
            acc[lb] = __builtin_amdgcn_mfma_f32_32x32x16_bf16(cfr[ks], q, acc[lb], 0, 0, 0); }
    __syncthreads();
#pragma unroll
    for (int lb = 0; lb < 2; ++lb) { const float it = sc[192 + lb * 32 + r];
#pragma unroll
        for (int i = 0; i < 16; ++i) acc[lb][i] *= it; }
    const int vb_off = (8 * hh + (li >> 2)) * VST + (wave * 32 + 16 * (r >> 4) + 4 * (li & 3)) * 2;
#pragma unroll
    for (int ks = 0; ks < 4; ++ks) { const bf16x8 afr = tr_frag(vsm + vb_off + ks * 16 * VST, 4 * VST);
#pragma unroll
        for (int lb = 0; lb < 2; ++lb) { if (lb == 0 && ks >= 2) continue;
            const bf16x8 wf = *(const bf16x8*)(wsm + (lb * 32 + r) * WST + ks * 32 + hh * 16);
            acc[lb] = __builtin_amdgcn_mfma_f32_32x32x16_bf16(afr, wf, acc[lb], 0, 0, 0); } }
    float ssq[2];
#pragma unroll
    for (int lb = 0; lb < 2; ++lb) { const int l = lb * 32 + r;
        const f32x4 rsv = *(const f32x4*)(sc + 256 + l * 4); const f32x4 q0 = *(const f32x4*)(sc + 512 + l * 8), q1 = *(const f32x4*)(sc + 512 + l * 8 + 4);
        const float den = (rsv[0] + rsv[1] + rsv[2] + rsv[3]) + sc[192 + l] * ((q0[0] + q0[1] + q0[2] + q0[3]) + (q1[0] + q1[1] + q1[2] + q1[3]));
        const float inv = 1.f / fmaxf(fabsf(den), __expf(-sc[128 + l]));
        float s2 = 0.f;
#pragma unroll
        for (int i = 0; i < 16; ++i) { acc[lb][i] *= inv; s2 += acc[lb][i] * acc[lb][i]; }
        s2 += __shfl_xor(s2, 32); ssq[lb] = s2; }
    __syncthreads();
    if (hh == 0) { sc[1024 + r * 8 + wave] = ssq[0]; sc[1024 + (32 + r) * 8 + wave] = ssq[1]; }
#pragma unroll
    for (int lb = 0; lb < 2; ++lb)
#pragma unroll
        for (int g = 0; g < 4; ++g) { f32x4 v; v[0] = acc[lb][4 * g]; v[1] = acc[lb][4 * g + 1]; v[2] = acc[lb][4 * g + 2]; v[3] = acc[lb][4 * g + 3];
            *(f32x4*)((unsigned char*)hsm + (lb * 32 + r) * HST + (wave * 32 + 8 * g + 4 * hh) * 4) = v; }
    __syncthreads();
#pragma unroll
    for (int i = 0; i < 4; ++i) { const int c = tid + NTHR * i, l = c >> 5, e0 = (c & 31) * 8;
        const f32x4 s0 = *(const f32x4*)(sc + 1024 + l * 8), s1 = *(const f32x4*)(sc + 1024 + l * 8 + 4);
        const float rr = rsqrtf(((s0[0] + s0[1] + s0[2] + s0[3]) + (s1[0] + s1[1] + s1[2] + s1[3])) * (1.f / 256.f) + EPS_);
        const f32x4 h0 = *(const f32x4*)((unsigned char*)hsm + l * HST + e0 * 4), h1 = *(const f32x4*)((unsigned char*)hsm + l * HST + e0 * 4 + 16);
        const f32x4 g0 = *(const f32x4*)(p.m_hg + h * 256 + e0), g1 = *(const f32x4*)(p.m_hg + h * 256 + e0 + 4);
        const u32x4 mo = *(const u32x4*)(Mo + (size_t)(t0 + l) * 1024 + h * 256 + e0);
        u32x4 o;
        o.x = cvt_pk(h0[0] * rr * g0[0] * sigm(bflo(mo.x)), h0[1] * rr * g0[1] * sigm(bfhi(mo.x))); o.y = cvt_pk(h0[2] * rr * g0[2] * sigm(bflo(mo.y)), h0[3] * rr * g0[3] * sigm(bfhi(mo.y)));
        o.z = cvt_pk(h1[0] * rr * g1[0] * sigm(bflo(mo.z)), h1[1] * rr * g1[1] * sigm(bfhi(mo.z))); o.w = cvt_pk(h1[2] * rr * g1[2] * sigm(bflo(mo.w)), h1[3] * rr * g1[3] * sigm(bfhi(mo.w)));
        *(u32x4*)(Oc + (size_t)(t0 + l) * D_ + 1024 + h * 256 + e0) = o; }
}

__device__ __forceinline__ void ce_desc(float& a, float& b) { const float hi = fmaxf(a, b), lo = fminf(a, b); a = hi; b = lo; }
__device__ __forceinline__ void sort16_desc(float (&v)[16]) {
#pragma unroll
    for (int k = 2; k <= 16; k <<= 1)
#pragma unroll
        for (int j = k >> 1; j > 0; j >>= 1)
#pragma unroll
            for (int i = 0; i < 16; ++i) { const int l = i ^ j; if (l > i) { if ((i & k) == 0) ce_desc(v[i], v[l]); else ce_desc(v[l], v[i]); } }
}
__device__ __forceinline__ void bmerge16_desc(float (&v)[16]) {
#pragma unroll
    for (int j = 8; j > 0; j >>= 1)
#pragma unroll
        for (int i = 0; i < 16; ++i) { const int l = i ^ j; if (l > i) ce_desc(v[i], v[l]); }
}
__device__ __forceinline__ void merge_top16(float (&a)[16], const float (&b)[16]) {
#pragma unroll
    for (int i = 0; i < 16; ++i) a[i] = fmaxf(a[i], b[15 - i]);
    bmerge16_desc(a);
}
__device__ __forceinline__ float pack_idx(float v, unsigned mask, unsigned idx) { return __builtin_bit_cast(float, (__builtin_bit_cast(unsigned, v) & mask) | idx); }
__device__ __forceinline__ void top16_from_acc(const f32x16 (&acc)[4], int h, float (&out)[16]) {
    float g[4][16];
#pragma unroll
    for (int mt = 0; mt < 4; ++mt) {
#pragma unroll
        for (int i = 0; i < 16; ++i) g[mt][i] = pack_idx(acc[mt][i], 0xffffff80u, (unsigned)(32 * mt + (i & 3) + 8 * (i >> 2)) | ((unsigned)h << 2));
        sort16_desc(g[mt]);
    }
    merge_top16(g[0], g[1]); merge_top16(g[2], g[3]); merge_top16(g[0], g[2]);
    float o[16];
#pragma unroll
    for (int i = 0; i < 16; ++i) o[i] = __shfl_xor(g[0][i], 32);
    merge_top16(g[0], o);
#pragma unroll
    for (int i = 0; i < 16; ++i) out[i] = g[0][i];
}
__device__ __forceinline__ unsigned lut16(const unsigned (&P)[4], unsigned i) {
    const unsigned long long lo = (unsigned long long)P[0] | ((unsigned long long)P[1] << 32), hi = (unsigned long long)P[2] | ((unsigned long long)P[3] << 32);
    const unsigned long long s = (i & 8u) ? hi : lo;
    return (unsigned)(s >> ((i & 7u) * 8u)) & 0xffu;
}
struct CandTab { int i[50]; int j[50]; };
constexpr CandTab make_cand_tab() { CandTab t{}; int n = 0; for (int i = 0; i < 16; ++i) for (int j = 0; j < 16; ++j) if ((i + 1) * (j + 1) <= 16) { t.i[n] = i; t.j[n] = j; ++n; } return t; }
__device__ __forceinline__ void phase_topk(const Params& p, unsigned char* lds, int bid, int nb) {
    const int tid = get_tid(), lane = tid & 63, wave = tid >> 6, r = lane & 31, h = lane >> 5;
    unsigned char* ws = p.ws;
    const bf16_t* Q = (const bf16_t*)(ws + WS_Q); int* IDX = (int*)(ws + WS_IDX); float* GW = (float*)(ws + WS_GW);
    constexpr int KP = 136;
    bf16_t* KS = (bf16_t*)lds;
    for (int i = tid; i < 2 * 16384; i += NTHR) { const int which = i >> 14, n = (i >> 7) & 127, d = i & 127; const float v = (which ? p.sk2 : p.sk1)[i & 16383];
        const unsigned hb = cvt_pk(v, 0.f) & 0xffffu; const float lo = v - bf2f((bf16_t)hb);
        KS[((which * 2 + 0) * 128 + n) * KP + d] = (bf16_t)hb; KS[((which * 2 + 1) * 128 + n) * KP + d] = (bf16_t)(cvt_pk(lo, 0.f) & 0xffffu); }
    __syncthreads();
    for (int item = bid * 8 + wave; item < 512 * 8; item += nb * 8) {
        const int tt = item >> 3, hh = item & 7, t = tt * 32 + r;
        float top[2][16];
#pragma unroll
        for (int list = 0; list < 2; ++list) {
            bf16x8 qf[8];
#pragma unroll
            for (int ks = 0; ks < 8; ++ks) qf[ks] = *(const bf16x8*)(Q + (size_t)t * D_ + hh * 256 + list * 128 + ks * 16 + h * 8);
            float g[4][16];
#pragma unroll
            for (int mt = 0; mt < 4; ++mt) {
                f32x16 acc;
#pragma unroll
                for (int i = 0; i < 16; ++i) acc[i] = 0.f;
#pragma unroll
                for (int hl = 0; hl < 2; ++hl)
#pragma unroll
                    for (int ks = 0; ks < 8; ++ks) { const bf16x8 a = *(const bf16x8*)(KS + ((list * 2 + hl) * 128 + mt * 32 + r) * KP + ks * 16 + h * 8);
                        acc = __builtin_amdgcn_mfma_f32_32x32x16_bf16(a, qf[ks], acc, 0, 0, 0); }
#pragma unroll
                for (int i = 0; i < 16; ++i) g[mt][i] = pack_idx(acc[i], 0xffffff80u, (unsigned)(32 * mt + (i & 3) + 8 * (i >> 2)) | ((unsigned)h << 2));
                sort16_desc(g[mt]);
                __builtin_amdgcn_sched_barrier(0);
            }
            merge_top16(g[0], g[1]); merge_top16(g[2], g[3]); merge_top16(g[0], g[2]);
            {   float o[16];
#pragma unroll
                for (int i = 0; i < 16; ++i) o[i] = __shfl_xor(g[0][i], 32);
                merge_top16(g[0], o); }
#pragma unroll
            for (int i = 0; i < 16; ++i) top[list][i] = g[0][i];
            __builtin_amdgcn_sched_barrier(0);
        }
        unsigned P1[4], P2[4];
#pragma unroll
        for (int q = 0; q < 4; ++q) { P1[q] = 0u; P2[q] = 0u;
#pragma unroll
            for (int e = 0; e < 4; ++e) { P1[q] |= (__builtin_bit_cast(unsigned, top[0][4 * q + e]) & 127u) << (8 * e); P2[q] |= (__builtin_bit_cast(unsigned, top[1][4 * q + e]) & 127u) << (8 * e); } }
        float c[4][16];
#pragma unroll
        for (int n = 0; n < 64; ++n) {
            if (n < 50) { constexpr CandTab CT = make_cand_tab(); const int i = CT.i[n], j = CT.j[n];
                c[n >> 4][n & 15] = pack_idx(top[0][i] + top[1][j], 0xffffff00u, (unsigned)(i * 16 + j)); }
            else c[n >> 4][n & 15] = -INFINITY;
        }
        sort16_desc(c[0]); __builtin_amdgcn_sched_barrier(0); sort16_desc(c[1]); __builtin_amdgcn_sched_barrier(0); merge_top16(c[0], c[1]); __builtin_amdgcn_sched_barrier(0);
        sort16_desc(c[2]); __builtin_amdgcn_sched_barrier(0); sort16_desc(c[3]); __builtin_amdgcn_sched_barrier(0); merge_top16(c[2], c[3]); __builtin_amdgcn_sched_barrier(0); merge_top16(c[0], c[2]);
        float ex[16], sum = 0.f;
#pragma unroll
        for (int k = 0; k < 16; ++k) { ex[k] = __expf(c[0][k] - c[0][0]); sum += ex[k]; }
        const float inv = 1.f / sum;
        if (h == 0) {
            int* ip = IDX + (size_t)t * 128 + hh * 16; float* gp = GW + (size_t)t * 128 + hh * 16;
#pragma unroll
            for (int q = 0; q < 4; ++q) { u32x4 iv; f32x4 gv;
#pragma unroll
                for (int e = 0; e < 4; ++e) { const unsigned pos = __builtin_bit_cast(unsigned, c[0][4 * q + e]) & 255u;
                    iv[e] = lut16(P1, pos >> 4) * 128u + lut16(P2, pos & 15u); gv[e] = ex[4 * q + e] * inv; }
                *(u32x4*)(ip + 4 * q) = iv; *(f32x4*)(gp + 4 * q) = gv; }
        }
    }
}

typedef float f32x2 __attribute__((ext_vector_type(2)));
__device__ __forceinline__ float dot16_fp8(const u32x4 w, const float (&h)[32], int o) {
    float s = 0.f;
#pragma unroll
    for (int q = 0; q < 4; ++q) { const f32x2 lo = __builtin_amdgcn_cvt_pk_f32_fp8((int)w[q], false), hi = __builtin_amdgcn_cvt_pk_f32_fp8((int)w[q], true);
        fmac(s, lo[0], h[o + 4 * q]); fmac(s, lo[1], h[o + 4 * q + 1]); fmac(s, hi[0], h[o + 4 * q + 2]); fmac(s, hi[1], h[o + 4 * q + 3]); }
    return s;
}
__device__ __forceinline__ void phase_peer1(const Params& p, int bid, int nb) {
    const int tid = get_tid(), lane = tid & 63, wave = tid >> 6;
    unsigned char* ws = p.ws;
    const bf16_t* H2 = (const bf16_t*)(ws + WS_H2); const int* IDX = (const int*)(ws + WS_IDX); const float* GW = (const float*)(ws + WS_GW);
    unsigned* EWT = (unsigned*)(ws + WS_EWT);
    const unsigned char* E8D = ws + WS_E8D + 16 * lane;
    for (int t = bid * 8 + wave; t < T_; t += nb * 8) {
        float hv[32];
#pragma unroll
        for (int hf = 0; hf < 2; ++hf)
#pragma unroll
            for (int q = 0; q < 2; ++q) { const u32x4 w = *(const u32x4*)(H2 + (size_t)t * D_ + hf * 1024 + 16 * lane + 8 * q);
#pragma unroll
                for (int e = 0; e < 4; ++e) { hv[hf * 16 + q * 8 + 2 * e] = bflo(w[e]); hv[hf * 16 + q * 8 + 2 * e + 1] = bfhi(w[e]); } }
        const int idx0 = IDX[(size_t)t * 128 + lane], idx1 = IDX[(size_t)t * 128 + 64 + lane];
        const float g0 = GW[(size_t)t * 128 + lane], g1 = GW[(size_t)t * 128 + 64 + lane];
        float a0 = 0.f, a1 = 0.f;
        for (int i0 = 0; i0 < 128; i0 += 8) {
            u32x4 lo[8], hi[8];
#pragma unroll
            for (int u = 0; u < 8; ++u) { const int e = __shfl(i0 < 64 ? idx0 : idx1, (i0 + u) & 63); lo[u] = *(const u32x4*)(E8D + (size_t)e * 2048); hi[u] = *(const u32x4*)(E8D + (size_t)e * 2048 + 1024); }
#pragma unroll
            for (int u = 0; u < 8; ++u) { float d = dot16_fp8(lo[u], hv, 0) + dot16_fp8(hi[u], hv, 16); d = wsum(d);
                if (lane == ((i0 + u) & 63)) { if (i0 < 64) a0 = d; else a1 = d; } }
        }
        a0 *= (1.f / 512.f); a1 *= (1.f / 512.f);
        const float w0 = g0 * 0.5f * a0 * (1.f + erff(a0 * 0.7071067811865476f)), w1 = g1 * 0.5f * a1 * (1.f + erff(a1 * 0.7071067811865476f));
        unsigned* ep = EWT + (size_t)(t >> 6) * 8192 + (t & 63) * 4;
        ep[(lane >> 2) * 256 + (lane & 3)] = (cvt_pk(0.f, w0) & 0xffff0000u) | (unsigned)idx0;
        ep[((lane + 64) >> 2) * 256 + (lane & 3)] = (cvt_pk(0.f, w1) & 0xffff0000u) | (unsigned)idx1;
    }
}
__device__ __forceinline__ void phase_peer2(const Params& p, unsigned char* lds, int bid, int nb) {
    const int tid = get_tid(), lane = tid & 63, wave = tid >> 6;
    unsigned char* ws = p.ws;
    const unsigned* EWT = (const unsigned*)(ws + WS_EWT); const float* X1 = (const float*)(ws + WS_X1); const float* mod = (const float*)(ws + WS_MOD);
    for (int si = bid; si < 256; si += nb) {
        const int s = (si & 7) * 32 + (si >> 3);
        __syncthreads();
        {   const u32x4* sp = (const u32x4*)(ws + WS_E8U + (size_t)s * 131072);
#pragma unroll
            for (int i = 0; i < 16; ++i) ((u32x4*)lds)[tid + NTHR * i] = sp[tid + NTHR * i]; }
        __syncthreads();
        const int tb0 = ((si >> 5) * 32 + wave) & 255;
        unsigned cur[16], nxt[16];
        {   const u32x4* wp = (const u32x4*)(EWT + (size_t)tb0 * 8192) + lane;
#pragma unroll
            for (int u = 0; u < 4; ++u) { const u32x4 v = wp[u * 64]; cur[4 * u] = v.x; cur[4 * u + 1] = v.y; cur[4 * u + 2] = v.z; cur[4 * u + 3] = v.w; } }
        float acc[8];
#pragma unroll
        for (int c = 0; c < 8; ++c) acc[c] = 0.f;
        f32x4 xa = {0.f, 0.f, 0.f, 0.f}, xb = xa;
        for (int q = 0; q < 256; ++q) {
            const int tb = (tb0 + 8 * (q >> 3)) & 255, g = q & 7;
            if (q + 1 < 256) { const int tbn = (tb0 + 8 * ((q + 1) >> 3)) & 255; const u32x4* wp = (const u32x4*)(EWT + (size_t)tbn * 8192 + ((q + 1) & 7) * 1024) + lane;
#pragma unroll
                for (int u = 0; u < 4; ++u) { const u32x4 v = wp[u * 64]; nxt[4 * u] = v.x; nxt[4 * u + 1] = v.y; nxt[4 * u + 2] = v.z; nxt[4 * u + 3] = v.w; } }
            const int t = tb * 64 + lane;
            if (g == 0) { xa = *(const f32x4*)(X1 + (size_t)t * D_ + 8 * s); xb = *(const f32x4*)(X1 + (size_t)t * D_ + 8 * s + 4); }
            u32x2 row[16];
#pragma unroll
            for (int u = 0; u < 16; ++u) row[u] = *(const u32x2*)(lds + ((cur[u] << 3) & 0x1fff8u));
#pragma unroll
            for (int u = 0; u < 16; ++u) {
                const float w = __builtin_bit_cast(float, cur[u]);
                const f32x2 v0 = __builtin_amdgcn_cvt_pk_f32_fp8((int)row[u].x, false), v1 = __builtin_amdgcn_cvt_pk_f32_fp8((int)row[u].x, true), v2 = __builtin_amdgcn_cvt_pk_f32_fp8((int)row[u].y, false), v3 = __builtin_amdgcn_cvt_pk_f32_fp8((int)row[u].y, true);
                fmac(acc[0], w, v0[0]); fmac(acc[1], w, v0[1]); fmac(acc[2], w, v1[0]); fmac(acc[3], w, v1[1]); fmac(acc[4], w, v2[0]); fmac(acc[5], w, v2[1]); fmac(acc[6], w, v3[0]); fmac(acc[7], w, v3[1]);
            }
            if (g == 7) {
                const float* g2 = mod + (size_t)(t >> 11) * NMOD + 5 * D_ + 8 * s;
                const f32x4 ga = *(const f32x4*)g2, gb = *(const f32x4*)(g2 + 4);
                f32x4 oa, ob;
#pragma unroll
                for (int c = 0; c < 4; ++c) { oa[c] = xa[c] + ga[c] * acc[c] * (1.f / 32.f); ob[c] = xb[c] + gb[c] * acc[4 + c] * (1.f / 32.f); }
                *(f32x4*)(p.out + (size_t)t * D_ + 8 * s) = oa; *(f32x4*)(p.out + (size_t)t * D_ + 8 * s + 4) = ob;
#pragma unroll
                for (int c = 0; c < 8; ++c) acc[c] = 0.f;
            }
#pragma unroll
            for (int u = 0; u < 16; ++u) cur[u] = nxt[u];
        }
    }
}

typedef const __attribute__((address_space(4))) Params* KargPtr;
__device__ __forceinline__ Params load_params() {
#if defined(__HIP_DEVICE_COMPILE__)
    KargPtr kp = (KargPtr)__builtin_amdgcn_kernarg_segment_ptr(); asm volatile("" : "+s"(kp)); Params r; __builtin_memcpy(&r, kp, sizeof(Params)); return r;
#else
    return Params{};
#endif
}
constexpr int N_PHASES = 12;
constexpr int LDS_BYTES = 152 * 1024;
__global__ void __launch_bounds__(NTHR) fwd_kernel(Params p_arg) {
    extern __shared__ __attribute__((aligned(16))) unsigned char lds[];
    const int bid = blockIdx.x, nb = gridDim.x, tid = get_tid();
    unsigned char* ws = p_arg.ws;
    volatile LAS unsigned* xbst = (volatile LAS unsigned*)((LAS unsigned char*)lds + LDS_BYTES - 16);
    if (tid == 0) { xbst[0] = 0u; xbst[1] = 0u; xbst[2] = 0u; xbst[3] = 0u; }
    __syncthreads();
    if ((p_arg.ph_hi - p_arg.ph_lo) > 1) (void)xcd_barrier_post((unsigned*)(ws + WS_BAR), xbst);
#ifdef ONLY_PHASE
#define IN(k) ((k) == ONLY_PHASE && p.ph_lo <= (k) && (k) < p.ph_hi)
#else
#define IN(k) (p.ph_lo <= (k) && (k) < p.ph_hi)
#endif
#define SEAM(k) do { const Params p = load_params(); if (p.ph_lo <= (k) && (k) + 1 < p.ph_hi) { XcdBarrier bar; bar.bar = (unsigned*)(p.ws + WS_BAR); bar.x = xb_xcc_id(); bar.st = xbst; xcd_barrier(bar); } } while (0)
#ifndef REPEAT_MASK
#define REPEAT_MASK 0
#endif
#define REP(k) for (int rep_ = 0; rep_ < (((REPEAT_MASK) >> (k)) & 1) + 1; ++rep_)
    REP(0) { const Params p = load_params(); if (IN(0)) { unsigned char* ws = p.ws; const float* mod = (const float*)(ws + WS_MOD); (void)mod;
        phase_prep(p, lds, bid, nb);
    } }
    SEAM(0);
    REP(1) { const Params p = load_params(); if (IN(1)) { unsigned char* ws = p.ws; const float* mod = (const float*)(ws + WS_MOD); (void)mod;
        phase_norm<true>(p.x, p.g1, mod, 0, D_, (bf16_t*)(ws + WS_H), (const float*)(ws + WS_WG), (float*)(ws + WS_GATE), bid, nb);
    } }
    SEAM(1);
    REP(2) { const Params p = load_params(); if (IN(2)) { unsigned char* ws = p.ws; const float* mod = (const float*)(ws + WS_MOD); (void)mod;
        { pg8::Gemm g{(const bf16_t*)(ws + WS_H), (const bf16_t*)(ws + WS_WINT), T_, 7168, D_}; pg8::StaticOrder S; S.init(T_, 7168, nb, bid);
        pg8::EpiSeg E{(bf16_t*)(ws + WS_P)}; pg8::gemm_phase<pg8::EpiSeg, pg8::StaticOrder, true, true>((LAS unsigned char*)lds, g, S, E); }
    } }
    SEAM(2);
    REP(3) { const Params p = load_params(); if (IN(3)) { unsigned char* ws = p.ws; const float* mod = (const float*)(ws + WS_MOD); (void)mod;
        phase_post(p, bid, nb);
    } }
    SEAM(3);
    REP(4) { const Params p = load_params(); if (IN(4)) { unsigned char* ws = p.ws; const float* mod = (const float*)(ws + WS_MOD); (void)mod;
        { for (int u = bid; u < 64; u += nb) mlstm_passA(p, lds, u);
        unsigned* qctr = (unsigned*)(ws + WS_QCTR); volatile int* slot = (volatile int*)(lds + LDS_BYTES - 32);
        for (;;) { __syncthreads(); if (tid == 0) *slot = (int)atomicAdd(qctr, 1u); __syncthreads(); const int u = *slot; if (u >= 512) break;
            const int bh = u & 63; fox_unit(p, lds, bh >> 3, bh & 7, 7 - (u >> 6)); } }
    } }
    SEAM(4);
    REP(5) { const Params p = load_params(); if (IN(5)) { unsigned char* ws = p.ws; const float* mod = (const float*)(ws + WS_MOD); (void)mod;
        { for (int u = bid; u < 1024; u += nb) mlstm_passB(p, lds, u); }
    } }
    SEAM(5);
    REP(6) { const Params p = load_params(); if (IN(6)) { unsigned char* ws = p.ws; const float* mod = (const float*)(ws + WS_MOD); (void)mod;
        { pg8::Gemm g{(const bf16_t*)(ws + WS_H), (const bf16_t*)(ws + WS_WOT), T_, D_, D_}; pg8::StaticOrder S; S.init(T_, D_, nb, bid);
        pg8::EpiRes E{p.x, (float*)(ws + WS_X1), mod, 2 * D_}; pg8::gemm_phase<pg8::EpiRes, pg8::StaticOrder, true, true>((LAS unsigned char*)lds, g, S, E); }
    } }
    SEAM(6);
    REP(7) { const Params p = load_params(); if (IN(7)) { unsigned char* ws = p.ws; const float* mod = (const float*)(ws + WS_MOD); (void)mod;
        convert_experts(p, bid, nb);
    } }
    REP(7) { const Params p = load_params(); if (IN(7)) { unsigned char* ws = p.ws; const float* mod = (const float*)(ws + WS_MOD); (void)mod;
        phase_norm<false>((const float*)(ws + WS_X1), p.g2, mod, 3 * D_, 4 * D_, (bf16_t*)(ws + WS_H2), nullptr, nullptr, bid, nb);
    } }
    SEAM(7);
    REP(8) { const Params p = load_params(); if (IN(8)) { unsigned char* ws = p.ws; const float* mod = (const float*)(ws + WS_MOD); (void)mod;
        { pg8::Gemm g{(const bf16_t*)(ws + WS_H2), (const bf16_t*)(ws + WS_WQT), T_, D_, D_}; pg8::StaticOrder S; S.init(T_, D_, nb, bid);
        pg8::EpiBf E{(bf16_t*)(ws + WS_Q), D_}; pg8::gemm_phase<pg8::EpiBf, pg8::StaticOrder, true, true>((LAS unsigned char*)lds, g, S, E); }
    } }
    SEAM(8);
    REP(9) { const Params p = load_params(); if (IN(9)) { unsigned char* ws = p.ws; const float* mod = (const float*)(ws + WS_MOD); (void)mod;
        phase_topk(p, lds, bid, nb);
    } }
    SEAM(9);
    REP(10) { const Params p = load_params(); if (IN(10)) { unsigned char* ws = p.ws; const float* mod = (const float*)(ws + WS_MOD); (void)mod;
        phase_peer1(p, bid, nb);
    } }
    SEAM(10);
    REP(11) { const Params p = load_params(); if (IN(11)) { unsigned char* ws = p.ws; const float* mod = (const float*)(ws + WS_MOD); (void)mod;
        phase_peer2(p, lds, bid, nb);
    } }
#undef IN
#undef SEAM
}

#ifndef ONE_LAUNCH
#define ONE_LAUNCH 1
#endif
extern "C" void kernel_launch(void* const* d_in, const int* in_sizes, int n_in, void* d_out, int out_size, void* d_ws, size_t ws_size, hipStream_t stream) {
    static int grid = 0;
    if (grid == 0) {
        int dev = 0, cus = 0, per_cu = 0;
        if (n_in != 21 || ws_size < WS_END) { fprintf(stderr, "kernel_launch: unexpected n_in %d / ws_size %zu (need %zu)\n", n_in, ws_size, (size_t)WS_END); grid = -1; return; }
        hipGetDevice(&dev); hipDeviceGetAttribute(&cus, hipDeviceAttributeMultiprocessorCount, dev);
        if (hipFuncSetAttribute((const void*)fwd_kernel, hipFuncAttributeMaxDynamicSharedMemorySize, LDS_BYTES) != hipSuccess) { fprintf(stderr, "kernel_launch: hipFuncSetAttribute failed\n"); grid = -1; return; }
        if (hipOccupancyMaxActiveBlocksPerMultiprocessor(&per_cu, (const void*)fwd_kernel, NTHR, LDS_BYTES) != hipSuccess || per_cu < 1) { fprintf(stderr, "kernel_launch: occupancy query says %d\n", per_cu); (void)hipGetLastError(); }
        grid = cus > 0 ? cus : 256;
    }
    if (grid < 0) return;
    Params p{};
    const float** pp = (const float**)&p;
    for (int i = 0; i < 21; ++i) pp[i] = (const float*)d_in[i];
    p.out = (float*)d_out; p.ws = (unsigned char*)d_ws;
    hipMemsetAsync((char*)d_ws + WS_BAR, 0, 16384, stream);
#if ONE_LAUNCH
    p.ph_lo = 0; p.ph_hi = N_PHASES;
    void* args[] = {&p};
    hipError_t e = hipLaunchCooperativeKernel((const void*)fwd_kernel, dim3(grid), dim3(NTHR), args, LDS_BYTES, stream);
    if (e != hipSuccess) fprintf(stderr, "cooperative launch failed: %s (grid %d)\n", hipGetErrorString(e), grid);
#else
    for (int ph = 0; ph < N_PHASES; ++ph) { p.ph_lo = ph; p.ph_hi = ph + 1; hipLaunchKernelGGL(fwd_kernel, dim3(grid), dim3(NTHR), LDS_BYTES, stream, p); }
#endif
}
```

```cpp
#include <hip/hip_runtime.h>
#include <cstdio>
#include <cstdint>

#define GAS __attribute__((address_space(1)))
#define LAS __attribute__((address_space(3)))
typedef unsigned short bf16_t;
typedef short bf16x8 __attribute__((ext_vector_type(8)));
typedef float f32x4 __attribute__((ext_vector_type(4)));
typedef float f32x16 __attribute__((ext_vector_type(16)));
typedef unsigned u32x4 __attribute__((ext_vector_type(4)));
typedef unsigned u32x2 __attribute__((ext_vector_type(2)));

constexpr int T_ = 16384, D_ = 2048, B_ = 8, S_ = 2048, NTHR = 512;
constexpr float EPS_ = 1e-6f;
constexpr int NMOD = 6 * D_;
constexpr int INCOLS = 7184;

constexpr size_t WS_BAR   = 0;
constexpr size_t WS_MOD   = 16384;
constexpr size_t WS_WG    = WS_MOD + (size_t)B_ * NMOD * 4;
constexpr size_t WS_GATE  = WS_WG + 16 * 2048 * 4;
constexpr size_t WS_F     = WS_GATE + (size_t)T_ * 16 * 4;
constexpr size_t WS_NST   = WS_F + 64 * 2048 * 4;
constexpr size_t WS_MST   = WS_NST + 1024 * 256 * 4;
constexpr size_t WS_WINT  = WS_MST + 4096;
constexpr size_t WS_WOT   = WS_WINT + (size_t)7168 * 2048 * 2;
constexpr size_t WS_WQT   = WS_WOT + (size_t)2048 * 2048 * 2;
constexpr size_t WS_H     = WS_WQT + (size_t)2048 * 2048 * 2;
constexpr size_t WS_P     = WS_H + (size_t)T_ * 2048 * 2;
constexpr size_t SEG_B    = (size_t)T_ * 1024 * 2;
constexpr size_t WS_CST   = WS_P + 7 * SEG_B;
constexpr size_t WS_E8D   = WS_CST + (size_t)1024 * 256 * 256 * 2;
constexpr size_t WS_E8U   = WS_E8D + (size_t)16384 * 2048;
constexpr size_t WS_END   = WS_E8U + (size_t)16384 * 2048;
constexpr size_t WS_QC    = WS_E8D;
constexpr size_t WS_KC    = WS_E8U;
constexpr size_t WS_QCTR  = 15360;
constexpr size_t WS_H2    = WS_P;
constexpr size_t WS_Q     = WS_H2 + (size_t)T_ * 2048 * 2;
constexpr size_t WS_IDX   = WS_Q + (size_t)T_ * 2048 * 2;
constexpr size_t WS_GW    = WS_IDX + (size_t)T_ * 128 * 4;
static_assert(WS_GW + (size_t)T_ * 128 * 4 <= WS_CST, "alias overflow");
constexpr size_t WS_X1    = WS_CST;
constexpr size_t WS_EWT   = WS_GW + (size_t)T_ * 128 * 4;
static_assert(WS_EWT + (size_t)T_ * 128 * 4 <= WS_CST, "alias overflow 2");

struct Params {
    const float *x, *c, *w_ada, *b_ada, *g1, *g2, *w_in, *fox_fb, *fox_qg, *fox_kg, *conv_w, *conv_b, *m_ib, *m_fb, *m_hg, *w_out, *w_q, *sk1, *sk2, *e_down, *e_up;
    float* out; unsigned char* ws; int ph_lo, ph_hi;
};

__device__ __forceinline__ int get_tid() { int t = threadIdx.x; asm volatile("" : "+v"(t)); return t; }
__device__ __forceinline__ unsigned cvt_pk(float lo, float hi) { unsigned r; asm("v_cvt_pk_bf16_f32 %0, %1, %2" : "=v"(r) : "v"(lo), "v"(hi)); return r; }
__device__ __forceinline__ void fmac(float& acc, float a, float b) { asm("v_fmac_f32 %0, %1, %2" : "+v"(acc) : "v"(a), "v"(b)); }
__device__ __forceinline__ float bf2f(unsigned short h) { return __builtin_bit_cast(float, ((unsigned)h) << 16); }
__device__ __forceinline__ float bflo(unsigned w) { return __builtin_bit_cast(float, w << 16); }
__device__ __forceinline__ float bfhi(unsigned w) { return __builtin_bit_cast(float, w & 0xffff0000u); }
__device__ __forceinline__ float wsum(float v) {
#pragma unroll
    for (int o = 32; o; o >>= 1) v += __shfl_xor(v, o);
    return v; }
__device__ __forceinline__ float wmax(float v) {
#pragma unroll
    for (int o = 32; o; o >>= 1) v = fmaxf(v, __shfl_xor(v, o));
    return v; }
__device__ __forceinline__ float logsig(float x) { return fminf(x, 0.f) - log1pf(expf(-fabsf(x))); }
__device__ __forceinline__ float sigm(float x) { return 1.f / (1.f + expf(-x)); }
__device__ __forceinline__ float silu_f(float x) { return x / (1.f + expf(-x)); }
namespace pg8 {
#define PG8_LAS __attribute__((address_space(3)))
typedef unsigned short bf16_t;
typedef short bf16x8 __attribute__((ext_vector_type(8)));
typedef float f32x4 __attribute__((ext_vector_type(4)));
typedef unsigned u32x4 __attribute__((ext_vector_type(4)));
constexpr int BM = 256, BK = 64, HALF = 128, HTB = HALF * BK * 2  , STAGE_BYTES = 8 * HTB, NXCD = 8, WGM = 8;

__host__ __device__ __forceinline__ int lds_byte(int r, int c) { const int st = (r >> 4) * 2 + (c >> 5), rr = r & 15, cc = c & 31, ob = rr * 64 + cc * 2; return st * 1024 + (ob ^ (((ob >> 9) & 1) << 5)); }
__host__ __device__ __forceinline__ void stage_rc(int b, int& R, int& C) { const int st = b / 1024, sb = b % 1024, swz = sb ^ (((sb >> 9) & 1) << 5); R = (st >> 1) * 16 + swz / 64; C = (st & 1) * 32 + (swz % 64) / 2; }
__host__ __device__ __forceinline__ int perm32(int rho) { const int n = rho >> 4, i = rho & 15; return 8 * (i >> 2) + 4 * n + (i & 3); }

struct Unit { int pm, pn; };
struct Gemm { const bf16_t* A; const bf16_t* Bt; int M, N, K; };

struct StaticOrder {
    int nM, nN, nwg, G, c;
    __host__ __device__ void init(int M, int N, int G_, int c_) { nM = M / BM; nN = N / BM; nwg = nM * nN; G = G_; c = c_; }
    __host__ __device__ bool next(int i, Unit& u) const {
        const long L = (long)i * G + c; if (L >= nwg) return false;
        int wgid = (int)L; { const int q = nwg / NXCD, r = nwg % NXCD, xcd = wgid % NXCD, off = wgid / NXCD; wgid = (xcd < r ? xcd * (q + 1) : r * (q + 1) + (xcd - r) * q) + off; }
        const int nig = WGM * nN, gid = wgid / nig, fm = gid * WGM, gsz = (nM - fm) < WGM ? (nM - fm) : WGM;
        u.pm = fm + ((wgid % nig) % gsz); u.pn = (wgid % nig) / gsz; return true;
    }
    __device__ __forceinline__ void a_ready(const Unit&) const {}
    __device__ __forceinline__ void done(const Unit&) const {}
};
struct EpiSeg {
    static constexpr bool PERM = true, AFTER_DRAIN = false;
    bf16_t* P;
    __device__ __forceinline__ void operator()(const f32x4 (&acc)[2][2][4][2], const Unit& u, int wr, int wc, int fr, int fq) const {
        const int seg = u.pn >> 2; bf16_t* base = P + (size_t)seg * ((size_t)T_ * 1024);
        const int row0 = u.pm * BM + wr * 64 + fr, col0 = (u.pn & 3) * 256 + wc * 32 + 8 * fq;
#pragma unroll
        for (int ai = 0; ai < 2; ++ai)
#pragma unroll
            for (int m = 0; m < 4; ++m) { bf16_t* rowp = base + (size_t)(row0 + ai * HALF + m * 16) * 1024 + col0;
#pragma unroll
                for (int bj = 0; bj < 2; ++bj) { const f32x4 v0 = acc[ai][bj][m][0], v1 = acc[ai][bj][m][1];
                    u32x4 w; w.x = cvt_pk(v0[0], v0[1]); w.y = cvt_pk(v0[2], v0[3]); w.z = cvt_pk(v1[0], v1[1]); w.w = cvt_pk(v1[2], v1[3]);
                    *(u32x4*)(rowp + bj * HALF) = w; } }
    }
};
struct EpiBf {
    static constexpr bool PERM = true, AFTER_DRAIN = false;
    bf16_t* O; int ldc;
    __device__ __forceinline__ void operator()(const f32x4 (&acc)[2][2][4][2], const Unit& u, int wr, int wc, int fr, int fq) const {
        const int row0 = u.pm * BM + wr * 64 + fr, col0 = u.pn * BM + wc * 32 + 8 * fq;
#pragma unroll
        for (int ai = 0; ai < 2; ++ai)
#pragma unroll
            for (int m = 0; m < 4; ++m) { bf16_t* rowp = O + (size_t)(row0 + ai * HALF + m * 16) * ldc + col0;
#pragma unroll
                for (int bj = 0; bj < 2; ++bj) { const f32x4 v0 = acc[ai][bj][m][0], v1 = acc[ai][bj][m][1];
                    u32x4 w; w.x = cvt_pk(v0[0], v0[1]); w.y = cvt_pk(v0[2], v0[3]); w.z = cvt_pk(v1[0], v1[1]); w.w = cvt_pk(v1[2], v1[3]);
                    *(u32x4*)(rowp + bj * HALF) = w; } }
    }
};
struct EpiRes {
    static constexpr bool PERM = false, AFTER_DRAIN = false;
    const float* X; float* O; const float* mod; int goff;
    __device__ __forceinline__ void operator()(const f32x4 (&acc)[2][2][4][2], const Unit& u, int wr, int wc, int fr, int fq) const {
        const int row0 = u.pm * BM + wr * 64 + fr, col0 = u.pn * BM + wc * 32 + 4 * fq;
        const float* gp = mod + (size_t)((u.pm * BM) >> 11) * NMOD + goff + col0;
        f32x4 gv[2][2];
#pragma unroll
        for (int bj = 0; bj < 2; ++bj)
#pragma unroll
            for (int n = 0; n < 2; ++n) gv[bj][n] = *(const f32x4*)(gp + bj * HALF + 16 * n);
#pragma unroll
        for (int ai = 0; ai < 2; ++ai)
#pragma unroll
            for (int m = 0; m < 4; ++m) { const size_t ro = (size_t)(row0 + ai * HALF + m * 16) * D_ + col0;
#pragma unroll
                for (int bj = 0; bj < 2; ++bj)
#pragma unroll
                    for (int n = 0; n < 2; ++n) { const f32x4 xv = *(const f32x4*)(X + ro + bj * HALF + 16 * n);
                        *(f32x4*)(O + ro + bj * HALF + 16 * n) = xv + gv[bj][n] * acc[ai][bj][m][n]; } }
    }
};
template <class Epi, class Sched, bool ALIGN_EPI = false, bool SP2 = false>
__device__ __forceinline__ void gemm_phase(PG8_LAS unsigned char* lds, const Gemm g, const Sched& S, const Epi& E) {
    const int tid = get_tid(), wid = __builtin_amdgcn_readfirstlane(tid >> 6), lane = tid & 63, wr = wid >> 2, wc = wid & 3, fr = lane & 15, fq = lane >> 4;
    const int K = g.K, nt = K / BK;
    unsigned voffA[2], voffB[2];
#pragma unroll
    for (int i = 0; i < 2; ++i) { int R, C; stage_rc(tid * 16 + i * 8192, R, C); const int Rb = Epi::PERM ? ((R & ~31) + perm32(R & 31)) : R;
        voffA[i] = (unsigned)(R * K + C) * 2u; voffB[i] = (unsigned)(Rb * K + C) * 2u; }
    const size_t kstep = (size_t)(BK * 2);
    const size_t hstep = (size_t)HALF * K * 2;
    const size_t tstep = 2 * hstep;
    const unsigned ldsw = (unsigned)wid * 1024u;
    const int aoff = lds_byte(wr * 64 + fr, fq * 8), boff = lds_byte(wc * 32 + fr, fq * 8);
#define PG8_SA(b, h) (((b) * 2 + (h)) * HTB)
#define PG8_SB(b, h) ((4 + (b) * 2 + (h)) * HTB)
#define PG8_STAGE(bufoff, gbase, voff) do { _Pragma("unroll") for (int _i = 0; _i < 2; ++_i) \
        __builtin_amdgcn_global_load_lds((const unsigned*)((const char*)(gbase) + (voff)[_i]), (PG8_LAS unsigned*)(lds + (bufoff) + ldsw + _i * 8192), 16, 0, 0); } while (0)
#define PG8_LDA(dst, b, h) do { _Pragma("unroll") for (int m = 0; m < 4; ++m) _Pragma("unroll") for (int k = 0; k < 2; ++k) dst[m][k] = *(const PG8_LAS bf16x8*)(lds + PG8_SA(b, h) + aoff + m * 2048 + k * 1024); } while (0)
#define PG8_LDB(dst, b, h) do { _Pragma("unroll") for (int n = 0; n < 2; ++n) _Pragma("unroll") for (int k = 0; k < 2; ++k) dst[n][k] = *(const PG8_LAS bf16x8*)(lds + PG8_SB(b, h) + boff + n * 2048 + k * 1024); } while (0)
#define PG8_MMA(ai, bj, At, Bt) do { __builtin_amdgcn_s_setprio(1); _Pragma("unroll") for (int m = 0; m < 4; ++m) _Pragma("unroll") for (int n = 0; n < 2; ++n) _Pragma("unroll") for (int k = 0; k < 2; ++k) \
        acc[ai][bj][m][n] = __builtin_amdgcn_mfma_f32_16x16x32_bf16(Bt[n][k], At[m][k], acc[ai][bj][m][n], 0, 0, 0); __builtin_amdgcn_s_setprio(0); } while (0)
#define PG8_WAIT_V(n) asm volatile("s_waitcnt vmcnt(" #n ")" ::: "memory")
#define PG8_WAIT_L(n) asm volatile("s_waitcnt lgkmcnt(" #n ")" ::: "memory")
#define PG8_BAR __builtin_amdgcn_s_barrier()
#define PG8_SCHED __builtin_amdgcn_sched_barrier(0)
    Unit cur, nxt; int ui = 0;
    if (!S.next(0, cur)) return;
    f32x4 acc[2][2][4][2];
#pragma unroll
    for (int a = 0; a < 2; ++a)
#pragma unroll
        for (int b = 0; b < 2; ++b)
#pragma unroll
            for (int m = 0; m < 4; ++m)
#pragma unroll
                for (int n = 0; n < 2; ++n) acc[a][b][m][n] = (f32x4){0.f, 0.f, 0.f, 0.f};
    bf16x8 At[4][2], B0[2][2], B1[2][2];
    const char* cA = (const char*)g.A + (size_t)cur.pm * tstep; const char* cB = (const char*)g.Bt + (size_t)cur.pn * tstep;
    S.a_ready(cur);
    if constexpr (SP2) {
        PG8_STAGE(PG8_SB(0, 0), cB, voffB); PG8_STAGE(PG8_SB(0, 1), cB + hstep, voffB); PG8_STAGE(PG8_SA(0, 0), cA, voffA); PG8_STAGE(PG8_SA(0, 1), cA + hstep, voffA);
        if (wr == 1) PG8_BAR;
        PG8_WAIT_V(2); PG8_BAR;
        PG8_STAGE(PG8_SB(1, 0), cB + kstep, voffB); PG8_STAGE(PG8_SA(1, 0), cA + kstep, voffA); PG8_STAGE(PG8_SB(1, 1), cB + hstep + kstep, voffB);
        PG8_WAIT_V(6); PG8_BAR;
    } else {
        PG8_STAGE(PG8_SB(0, 0), cB, voffB); PG8_STAGE(PG8_SA(0, 0), cA, voffA); PG8_STAGE(PG8_SB(0, 1), cB + hstep, voffB); PG8_STAGE(PG8_SA(0, 1), cA + hstep, voffA);
        if (wr == 1) PG8_BAR;
        PG8_WAIT_V(4); PG8_BAR;
        PG8_STAGE(PG8_SB(1, 0), cB + kstep, voffB); PG8_STAGE(PG8_SA(1, 0), cA + kstep, voffA); PG8_STAGE(PG8_SB(1, 1), cB + hstep + kstep, voffB);
        PG8_WAIT_V(6); PG8_BAR;
    }
    for (;;) {
        const bool has_next = S.next(ui + 1, nxt);
        const char* nA = has_next ? (const char*)g.A + (size_t)nxt.pm * tstep : cA; const char* nB = has_next ? (const char*)g.Bt + (size_t)nxt.pn * tstep : cB;
        for (int t = 0; t < nt; t += 2) {
            const bool last = (t == nt - 2);
            const char* a1 = cA + (size_t)(t + 1) * kstep;
            const char* a2 = last ? nA : cA + (size_t)(t + 2) * kstep; const char* b2 = last ? nB : cB + (size_t)(t + 2) * kstep;
            const char* a3 = a2 + kstep; const char* b3 = b2 + kstep;
            if (last && has_next) S.a_ready(nxt);
            if constexpr (SP2) {
            PG8_LDB(B0, 0, 0); PG8_LDB(B1, 0, 1); PG8_SCHED; PG8_LDA(At, 0, 0); PG8_STAGE(PG8_SA(1, 1), a1 + hstep, voffA);
            PG8_WAIT_V(8); PG8_WAIT_L(0); PG8_BAR; PG8_MMA(0, 0, At, B0); PG8_MMA(0, 1, At, B1); PG8_BAR; PG8_SCHED;
            PG8_LDA(At, 0, 1); PG8_STAGE(PG8_SB(0, 0), b2, voffB); PG8_STAGE(PG8_SB(0, 1), b2 + hstep, voffB); PG8_STAGE(PG8_SA(0, 0), a2, voffA);
            PG8_WAIT_V(8); PG8_WAIT_L(0); PG8_BAR; PG8_MMA(1, 0, At, B0); PG8_MMA(1, 1, At, B1); PG8_BAR; PG8_SCHED;
            PG8_LDB(B0, 1, 0); PG8_LDB(B1, 1, 1); PG8_SCHED; PG8_LDA(At, 1, 0); PG8_STAGE(PG8_SA(0, 1), a2 + hstep, voffA);
            PG8_WAIT_V(8); PG8_WAIT_L(0); PG8_BAR; PG8_MMA(0, 0, At, B0); PG8_MMA(0, 1, At, B1); PG8_BAR; PG8_SCHED;
            PG8_LDA(At, 1, 1); PG8_STAGE(PG8_SB(1, 0), b3, voffB); PG8_STAGE(PG8_SB(1, 1), b3 + hstep, voffB); PG8_STAGE(PG8_SA(1, 0), a3, voffA);
            PG8_WAIT_V(8); PG8_WAIT_L(0); PG8_BAR; PG8_MMA(1, 0, At, B0); PG8_MMA(1, 1, At, B1); PG8_BAR; PG8_SCHED;
            } else {
            PG8_LDB(B0, 0, 0); PG8_SCHED; PG8_LDA(At, 0, 0); PG8_STAGE(PG8_SA(1, 1), a1 + hstep, voffA);
            PG8_WAIT_L(8); PG8_BAR; PG8_WAIT_L(0); PG8_MMA(0, 0, At, B0); PG8_BAR; PG8_SCHED;
            PG8_LDB(B1, 0, 1); PG8_STAGE(PG8_SB(0, 0), b2, voffB);
            PG8_BAR; PG8_WAIT_L(0); PG8_MMA(0, 1, At, B1); PG8_BAR;
            PG8_LDA(At, 0, 1); PG8_STAGE(PG8_SA(0, 0), a2, voffA);
            PG8_BAR; PG8_WAIT_L(0); PG8_MMA(1, 0, At, B0); PG8_BAR; PG8_SCHED;
            PG8_STAGE(PG8_SB(0, 1), b2 + hstep, voffB);
            PG8_WAIT_V(6); PG8_BAR; PG8_MMA(1, 1, At, B1); PG8_BAR;
            PG8_LDB(B0, 1, 0); PG8_SCHED; PG8_LDA(At, 1, 0); PG8_STAGE(PG8_SA(0, 1), a2 + hstep, voffA);
            PG8_WAIT_L(8); PG8_BAR; PG8_WAIT_L(0); PG8_MMA(0, 0, At, B0); PG8_BAR; PG8_SCHED;
            PG8_LDB(B1, 1, 1); PG8_STAGE(PG8_SB(1, 0), b3, voffB);
            PG8_BAR; PG8_WAIT_L(0); PG8_MMA(0, 1, At, B1); PG8_BAR;
            PG8_LDA(At, 1, 1); PG8_STAGE(PG8_SA(1, 0), a3, voffA);
            PG8_BAR; PG8_WAIT_L(0); PG8_MMA(1, 0, At, B0); PG8_BAR; PG8_SCHED;
            PG8_STAGE(PG8_SB(1, 1), b3 + hstep, voffB);
            PG8_WAIT_V(6); PG8_BAR; PG8_MMA(1, 1, At, B1); PG8_BAR;
            }
        }
        if constexpr (ALIGN_EPI) { if (wr == 0) PG8_BAR; }
        if constexpr (!Epi::AFTER_DRAIN) { E(acc, cur, wr, wc, fr, fq); S.done(cur); }
        if (!has_next) break;
#pragma unroll
        for (int a = 0; a < 2; ++a)
#pragma unroll
            for (int b = 0; b < 2; ++b)
#pragma unroll
                for (int m = 0; m < 4; ++m)
#pragma unroll
                    for (int n = 0; n < 2; ++n) acc[a][b][m][n] = (f32x4){0.f, 0.f, 0.f, 0.f};
        cur = nxt; cA = nA; cB = nB; ++ui;
        if constexpr (ALIGN_EPI) { if (wr == 1) PG8_BAR; }
    }
    PG8_WAIT_V(0);
    if constexpr (!ALIGN_EPI) { if (wr == 0) PG8_BAR; }
    PG8_BAR;
    if constexpr (Epi::AFTER_DRAIN) { E.fused(acc, cur, wr, wc, fr, fq, lds, wid, lane); S.done(cur); }
#undef PG8_SA
#undef PG8_SB
#undef PG8_STAGE
#undef PG8_LDA
#undef PG8_LDB
#undef PG8_MMA
#undef PG8_WAIT_V
#undef PG8_WAIT_L
#undef PG8_BAR
#undef PG8_SCHED
}
}
#define XB_TMO      128
#define XB_XCNT(j)  (256  + 64 * (j))
#define XB_XSUB(j)  (1280 + 64 * (j))
#define XB_XGEN(j)  (2304 + 64 * (j))
#define XB_TOP      3328
#define XB_TOPGEN   3392
#define XCD_BAR_WORDS 3456
#define XB_SPIN_CAP (1u << 18)

__device__ __forceinline__ unsigned xb_ld(unsigned* p)              { return __hip_atomic_load(p, __ATOMIC_RELAXED, __HIP_MEMORY_SCOPE_AGENT); }
__device__ __forceinline__ unsigned xb_add(unsigned* p, unsigned v) { return __hip_atomic_fetch_add(p, v, __ATOMIC_RELAXED, __HIP_MEMORY_SCOPE_AGENT); }
__device__ __forceinline__ unsigned xb_xcc_id() { return (unsigned)__builtin_amdgcn_s_getreg((3 << 11) | 20) & 0xFu; }
#define XB_SPIN(cond, bar) do { unsigned _sp = 0; while (cond) { __builtin_amdgcn_s_sleep(1); \
    if ((++_sp & 255u) == 0u) { if (xb_ld(&(bar)[XB_TMO])) break; if (_sp > XB_SPIN_CAP) { atomicAdd(&(bar)[XB_TMO], 1u); break; } } } } while (0)

struct XcdBarrier {
    unsigned* bar; unsigned x;
    volatile LAS unsigned* st;
};

__device__ __forceinline__ XcdBarrier xcd_barrier_post(unsigned* bar, volatile LAS unsigned* st) {
    XcdBarrier b; b.bar = bar; b.x = xb_xcc_id(); b.st = st;
    if (threadIdx.x == 0) (void)xb_add(&bar[XB_XCNT(b.x)], 1u);
    return b;
}
__device__ __forceinline__ void xcd_barrier_complete(unsigned* bar, unsigned x, unsigned& nloc, unsigned& nx) {
    const unsigned G = gridDim.x * gridDim.y * gridDim.z;
    unsigned sum, cnt, mine, sp = 0u;
    for (;;) {
        sum = 0u; cnt = 0u; mine = 0u;
#pragma unroll
        for (unsigned j = 0; j < 16; ++j) { const unsigned c = xb_ld(&bar[XB_XCNT(j)]); sum += c; cnt += (c > 0u) ? 1u : 0u; mine = (j == x) ? c : mine; }
        if (sum == G) break;
        __builtin_amdgcn_s_sleep(1);
        if ((++sp & 255u) == 0u) { if (xb_ld(&bar[XB_TMO])) break; if (sp > XB_SPIN_CAP) { atomicAdd(&bar[XB_TMO], 1u); break; } }
    }
    nloc = mine > 0u ? mine : 1u; nx = cnt > 0u ? cnt : 1u;
}

__device__ __forceinline__ void xcd_barrier(const XcdBarrier& b) {
    asm volatile("s_waitcnt vmcnt(0)" ::: "memory");
    __syncthreads();
    if (threadIdx.x == 0) {
        unsigned* bar = b.bar;
        __builtin_amdgcn_s_waitcnt(0);
        unsigned nloc = b.st[0], nx = b.st[1];
        if (nloc == 0u) { xcd_barrier_complete(bar, b.x, nloc, nx); b.st[0] = nloc; b.st[1] = nx; }
        const unsigned old = xb_add(&bar[XB_XSUB(b.x)], 1u);
        const unsigned gen = old / nloc;
        if (old + 1u == (gen + 1u) * nloc) {
            __builtin_amdgcn_fence(__ATOMIC_RELEASE, "agent");
            asm volatile("s_waitcnt vmcnt(0)" ::: "memory");
            const unsigned og = xb_add(&bar[XB_TOP], 1u);
            const unsigned tg = og / nx;
            if (og + 1u == (tg + 1u) * nx) xb_add(&bar[XB_TOPGEN], 1u);
            else XB_SPIN(xb_ld(&bar[XB_TOPGEN]) == tg, bar);
            __builtin_amdgcn_fence(__ATOMIC_ACQUIRE, "agent");
            xb_add(&bar[XB_XGEN(b.x)], 1u);
            asm volatile("s_waitcnt vmcnt(0)" ::: "memory");
        } else {
            XB_SPIN(xb_ld(&bar[XB_XGEN(b.x)]) == gen, bar);
            __builtin_amdgcn_fence(__ATOMIC_ACQUIRE, "agent");
            asm volatile("s_waitcnt vmcnt(0)" ::: "memory");
        }
    }
    __syncthreads();
}
__device__ __forceinline__ void phase_prep(const Params& p, unsigned char* lds, int bid, int nb) {
    const int tid = get_tid(), lane = tid & 63, wave = tid >> 6;
    unsigned char* ws = p.ws;
    float* mod = (float*)(ws + WS_MOD);
    if (bid < 192) {
        float* sc = (float*)lds;
        float* red = sc + 8 * 2048;
        for (int i = tid; i < 8 * 2048; i += NTHR) sc[i] = silu_f(p.c[i]);
        __syncthreads();
        for (int it = bid; it < 192; it += nb) {
            const int col = it * 64 + lane;
            float acc[8];
#pragma unroll
            for (int b = 0; b < 8; ++b) acc[b] = 0.f;
            const float* w = p.w_ada + (size_t)(wave * 256) * NMOD + col;
            const float* s0 = sc + wave * 256;
#pragma unroll 4
            for (int k = 0; k < 256; ++k) {
                const float wv = w[(size_t)k * NMOD];
#pragma unroll
                for (int b = 0; b < 8; ++b) acc[b] += s0[b * 2048 + k] * wv;
            }
#pragma unroll
            for (int b = 0; b < 8; ++b) red[(wave * 8 + b) * 64 + lane] = acc[b];
            __syncthreads();
            {   const int b = wave; float s = p.b_ada[col];
#pragma unroll
                for (int w2 = 0; w2 < 8; ++w2) s += red[(w2 * 8 + b) * 64 + lane];
                mod[b * NMOD + col] = s; }
            __syncthreads();
        }
    }
    __syncthreads();
    {
        float* tile = (float*)lds;
        bf16_t* WinT = (bf16_t*)(ws + WS_WINT); bf16_t* WoT = (bf16_t*)(ws + WS_WOT); bf16_t* WqT = (bf16_t*)(ws + WS_WQT);
        for (int item = bid; item < 5632; item += nb) {
            const float* src; int ld, scol; bf16_t* dst; int kt;
            if (item < 3584) { const int seg = item >> 9, rem = item & 511, ntile = rem >> 5; kt = rem & 31;
                src = p.w_in; ld = INCOLS; scol = (seg < 3 ? seg * 1024 : 3080 + (seg - 3) * 1024) + ntile * 64; dst = WinT + (size_t)(seg * 1024 + ntile * 64) * 2048; }
            else if (item < 4608) { const int rem = item - 3584, ntile = rem >> 5; kt = rem & 31; src = p.w_out; ld = 2048; scol = ntile * 64; dst = WoT + (size_t)(ntile * 64) * 2048; }
            else { const int rem = item - 4608, ntile = rem >> 5; kt = rem & 31; src = p.w_q; ld = 2048; scol = ntile * 64; dst = WqT + (size_t)(ntile * 64) * 2048; }
            const int k0 = kt * 64;
#pragma unroll
            for (int ii = 0; ii < 8; ++ii) { const int k = wave + 8 * ii; tile[k * 65 + lane] = src[(size_t)(k0 + k) * ld + scol + lane]; }
            __syncthreads();
#pragma unroll
            for (int ii = 0; ii < 8; ++ii) { const int n = wave + 8 * ii; dst[(size_t)n * 2048 + k0 + lane] = (bf16_t)(cvt_pk(tile[lane * 65 + n], 0.f) & 0xffffu); }
            __syncthreads();
        }
    }
    {
        float* Wg = (float*)(ws + WS_WG);
        for (int i = bid * NTHR + tid; i < 16 * 2048; i += nb * NTHR) { const int g = i >> 11, k = i & 2047; const int col = g < 8 ? 3072 + g : 7176 + (g - 8);
            Wg[i] = p.w_in[(size_t)k * INCOLS + col]; }
    }
}

__device__ __forceinline__ unsigned pack4_fp8(const f32x4 a) { int t = __builtin_amdgcn_cvt_pk_fp8_f32(a[0], a[1], 0, false); t = __builtin_amdgcn_cvt_pk_fp8_f32(a[2], a[3], t, true); return (unsigned)t; }
__device__ __forceinline__ void convert_experts(const Params& p, int bid, int nb) {
    const int tid = get_tid(); unsigned char* ws = p.ws;
    unsigned char* E8D = ws + WS_E8D; unsigned char* E8US = ws + WS_E8U;
    for (int i = bid * NTHR + tid; i < 2097152; i += nb * NTHR) {
        const f32x4* sp = (const f32x4*)p.e_down + (size_t)i * 4;
        u32x4 w; w.x = pack4_fp8(sp[0] * 512.f); w.y = pack4_fp8(sp[1] * 512.f); w.z = pack4_fp8(sp[2] * 512.f); w.w = pack4_fp8(sp[3] * 512.f);
        *(u32x4*)(E8D + (size_t)i * 16) = w;
    }
    for (int i = bid * NTHR + tid; i < 524288; i += nb * NTHR) {
        const int s = i & 255, eg = i >> 8;
        const float* sp = p.e_up + (size_t)(eg * 8) * 2048 + 8 * s;
        unsigned w[16];
#pragma unroll
        for (int q = 0; q < 8; ++q) { const f32x4 a = *(const f32x4*)(sp + (size_t)q * 2048), b = *(const f32x4*)(sp + (size_t)q * 2048 + 4); w[2 * q] = pack4_fp8(a * 32.f); w[2 * q + 1] = pack4_fp8(b * 32.f); }
        u32x4* dp = (u32x4*)(E8US + ((size_t)s * 16384 + eg * 8) * 8);
#pragma unroll
        for (int q = 0; q < 4; ++q) { u32x4 o; o.x = w[4 * q]; o.y = w[4 * q + 1]; o.z = w[4 * q + 2]; o.w = w[4 * q + 3]; dp[q] = o; }
    }
}

template <bool GATES>
__device__ __forceinline__ void phase_norm(const float* xin, const float* gain, const float* mod, int shift_off, int scale_off, bf16_t* hout, const float* Wg, float* gate_out, int bid, int nb) {
    const int tid = get_tid(), lane = tid & 63, wave = tid >> 6;
    for (int row = bid * 8 + wave; row < T_; row += nb * 8) {
        const f32x4* xr = (const f32x4*)(xin + (size_t)row * D_);
        f32x4 v[8]; float ss = 0.f;
#pragma unroll
        for (int j = 0; j < 8; ++j) { v[j] = xr[lane + 64 * j]; ss += v[j][0] * v[j][0] + v[j][1] * v[j][1] + v[j][2] * v[j][2] + v[j][3] * v[j][3]; }
        ss = wsum(ss);
        const float r = rsqrtf(ss * (1.f / D_) + EPS_);
        const float* mb = mod + (size_t)(row >> 11) * NMOD;
        f32x4 hv[8];
#pragma unroll
        for (int j = 0; j < 8; ++j) {
            const int k = 4 * (lane + 64 * j);
            const f32x4 gn = *(const f32x4*)(gain + k), sh = *(const f32x4*)(mb + shift_off + k), scl = *(const f32x4*)(mb + scale_off + k);
#pragma unroll
            for (int e = 0; e < 4; ++e) hv[j][e] = (v[j][e] * r) * gn[e] * (1.f + scl[e]) + sh[e];
            u32x2 w; w.x = cvt_pk(hv[j][0], hv[j][1]); w.y = cvt_pk(hv[j][2], hv[j][3]);
            *(u32x2*)(hout + (size_t)row * D_ + k) = w;
        }
        if (GATES) {
            float outv = 0.f;
#pragma unroll 1
            for (int g = 0; g < 16; ++g) {
                float ga = 0.f;
#pragma unroll
                for (int j = 0; j < 8; ++j) { const f32x4 wv = *(const f32x4*)(Wg + g * 2048 + 4 * (lane + 64 * j)); ga += hv[j][0] * wv[0] + hv[j][1] * wv[1] + hv[j][2] * wv[2] + hv[j][3] * wv[3]; }
                const float s = wsum(ga); if (lane == g) outv = s;
            }
            if (lane < 16) gate_out[(size_t)row * 16 + lane] = outv;
        }
    }
}

__device__ __forceinline__ void phase_post(const Params& p, int bid, int nb) {
    const int tid = get_tid(), lane = tid & 63, wave = tid >> 6;
    unsigned char* ws = p.ws;
    bf16_t* Pq = (bf16_t*)(ws + WS_P); bf16_t* Pk = (bf16_t*)(ws + WS_P + SEG_B);
    const float qscale = 0.08838834764831845f * 1.4426950408889634f;
    for (int r = bid * 8 + wave; r < 2 * T_; r += nb * 8) {
        const int which = r >= T_ ? 1 : 0; const int t = r - which * T_;
        bf16_t* ptr = (which ? Pk : Pq) + (size_t)t * 1024 + lane * 16;
        const float* gn = (which ? p.fox_kg : p.fox_qg) + (lane & 7) * 16;
        u32x4 a = *(const u32x4*)ptr, b = *(const u32x4*)(ptr + 8);
        float f[16];
        f[0] = bflo(a.x); f[1] = bfhi(a.x); f[2] = bflo(a.y); f[3] = bfhi(a.y); f[4] = bflo(a.z); f[5] = bfhi(a.z); f[6] = bflo(a.w); f[7] = bfhi(a.w);
        f[8] = bflo(b.x); f[9] = bfhi(b.x); f[10] = bflo(b.y); f[11] = bfhi(b.y); f[12] = bflo(b.z); f[13] = bfhi(b.z); f[14] = bflo(b.w); f[15] = bfhi(b.w);
        float ss = 0.f;
#pragma unroll
        for (int i = 0; i < 16; ++i) ss += f[i] * f[i];
        ss += __shfl_xor(ss, 1); ss += __shfl_xor(ss, 2); ss += __shfl_xor(ss, 4);
        const float rr = rsqrtf(ss * (1.f / 128.f) + EPS_) * (which ? 1.f : qscale);
#pragma unroll
        for (int i = 0; i < 16; ++i) f[i] = (f[i] * rr) * gn[i];
        a.x = cvt_pk(f[0], f[1]); a.y = cvt_pk(f[2], f[3]); a.z = cvt_pk(f[4], f[5]); a.w = cvt_pk(f[6], f[7]);
        b.x = cvt_pk(f[8], f[9]); b.y = cvt_pk(f[10], f[11]); b.z = cvt_pk(f[12], f[13]); b.w = cvt_pk(f[14], f[15]);
        *(u32x4*)ptr = a; *(u32x4*)(ptr + 8) = b;
    }
    {
        const bf16_t* Mq = (const bf16_t*)(ws + WS_P + 3 * SEG_B); const bf16_t* Mk = (const bf16_t*)(ws + WS_P + 4 * SEG_B);
        bf16_t* QC = (bf16_t*)(ws + WS_QC); bf16_t* KC = (bf16_t*)(ws + WS_KC);
        for (int item = bid; item < 256; item += nb) {
            const int which = item >> 7, tb = item & 127, cg = tid & 127, run = tid >> 7, ch0 = cg * 8, ts = tb * 128 + run * 32, sp = ts & 2047;
            const bf16_t* src = (which ? Mk : Mq) + (size_t)ts * 1024 + ch0; bf16_t* dst = (which ? KC : QC) + (size_t)ts * 1024 + ch0;
            float w0[8], w1[8], w2[8], w3[8], cb[8], x0[8], x1[8], x2[8];
#pragma unroll
            for (int e = 0; e < 8; ++e) { const int ci = which * 1024 + ch0 + e; w0[e] = p.conv_w[ci]; w1[e] = p.conv_w[2048 + ci]; w2[e] = p.conv_w[4096 + ci]; w3[e] = p.conv_w[6144 + ci]; cb[e] = p.conv_b[ci]; }
            {   u32x4 a = {0u, 0u, 0u, 0u}, b = a, c = a;
                if (sp != 0) { a = *(const u32x4*)(src - 3 * 1024); b = *(const u32x4*)(src - 2 * 1024); c = *(const u32x4*)(src - 1024); }
#pragma unroll
                for (int e = 0; e < 4; ++e) { x0[2 * e] = bflo(a[e]); x0[2 * e + 1] = bfhi(a[e]); x1[2 * e] = bflo(b[e]); x1[2 * e + 1] = bfhi(b[e]); x2[2 * e] = bflo(c[e]); x2[2 * e + 1] = bfhi(c[e]); } }
            const float osc = which ? 0.0625f : 1.f;
            for (int s = 0; s < 32; ++s) {
                const u32x4 d = *(const u32x4*)(src + (size_t)s * 1024); float x3[8], y[8];
#pragma unroll
                for (int e = 0; e < 4; ++e) { x3[2 * e] = bflo(d[e]); x3[2 * e + 1] = bfhi(d[e]); }
#pragma unroll
                for (int e = 0; e < 8; ++e) { y[e] = silu_f(w0[e] * x0[e] + w1[e] * x1[e] + w2[e] * x2[e] + w3[e] * x3[e] + cb[e]) * osc; x0[e] = x1[e]; x1[e] = x2[e]; x2[e] = x3[e]; }
                u32x4 o; o.x = cvt_pk(y[0], y[1]); o.y = cvt_pk(y[2], y[3]); o.z = cvt_pk(y[4], y[5]); o.w = cvt_pk(y[6], y[7]);
                *(u32x4*)(dst + (size_t)s * 1024) = o;
            }
        }
    }
    const float* gate = (const float*)(ws + WS_GATE); float* F = (float*)(ws + WS_F);
    for (int sq = bid * 8 + wave; sq < 64; sq += nb * 8) {
        const int b = sq >> 3, h = sq & 7; const float fb = p.fox_fb[h];
        float v[32]; float run = 0.f;
#pragma unroll
        for (int i = 0; i < 32; ++i) { const int t = lane * 32 + i; run += logsig(gate[(size_t)(b * S_ + t) * 16 + h] + fb); v[i] = run; }
        float inc = run;
#pragma unroll
        for (int o = 1; o < 64; o <<= 1) { const float u = __shfl_up(inc, o); if (lane >= o) inc += u; }
        const float excl = inc - run;
#pragma unroll
        for (int i = 0; i < 32; ++i) F[(size_t)sq * S_ + lane * 32 + i] = (v[i] + excl) * 1.4426950408889634f;
    }
}
typedef short s16x4 __attribute__((ext_vector_type(4)));
__device__ __forceinline__ s16x4 lds_tr16(const unsigned char* p) { return __builtin_amdgcn_ds_read_tr16_b64_v4i16((LAS s16x4*)p); }
__device__ __forceinline__ bf16x8 tr_frag(const unsigned char* p0, int second_bytes) {
    const s16x4 a = lds_tr16(p0), b = lds_tr16(p0 + second_bytes);
    bf16x8 f; f[0] = a[0]; f[1] = a[1]; f[2] = a[2]; f[3] = a[3]; f[4] = b[0]; f[5] = b[1]; f[6] = b[2]; f[7] = b[3]; return f;
}
__device__ __forceinline__ void fox_unit(const Params& p, unsigned char* lds, int b, int h, int qb) {
    const int tid = get_tid(), lane = tid & 63, wave = tid >> 6, r = lane & 31, hh = lane >> 5, li = lane & 15;
    unsigned char* ws = p.ws;
    const bf16_t* Pq = (const bf16_t*)(ws + WS_P); const bf16_t* Pk = (const bf16_t*)(ws + WS_P + SEG_B); const bf16_t* Pv = (const bf16_t*)(ws + WS_P + 2 * SEG_B);
    const float* F = (const float*)(ws + WS_F) + (size_t)(b * 8 + h) * S_;
    bf16_t* Oc = (bf16_t*)(ws + WS_H);
    constexpr int KST = 272, VST = 544, BUF = 64 * KST + 64 * VST + 256;
    const int q0w = qb * 256 + wave * 32, qs = q0w + r; const int q0s = __builtin_amdgcn_readfirstlane(q0w);
    const size_t trow = (size_t)(b * S_ + qs);
    bf16x8 qf[8];
#pragma unroll
    for (int ks = 0; ks < 8; ++ks) qf[ks] = *(const bf16x8*)(Pq + trow * 1024 + h * 128 + ks * 16 + hh * 8);
    const float Fq = F[qs];
    f32x16 o[4];
#pragma unroll
    for (int d = 0; d < 4; ++d)
#pragma unroll
        for (int i = 0; i < 16; ++i) o[d][i] = 0.f;
    float m = -INFINITY, l = 0.f;
    const int ntile = (qb * 256 + 256) / 64;
    const int srow0 = tid >> 4, scc = tid & 15;
    const bf16_t* kg = Pk + (size_t)(b * S_ + srow0) * 1024 + h * 128 + scc * 8; const bf16_t* vg = Pv + (size_t)(b * S_ + srow0) * 1024 + h * 128 + scc * 8;
    u32x4 kr[2], vr[2]; float fr = 0.f;
    const int vb_off = 64 * KST + (4 * hh + (li >> 2)) * VST + (16 * (r >> 4) + 4 * (li & 3)) * 2;
    __syncthreads();
#pragma unroll
    for (int i = 0; i < 2; ++i) { kr[i] = *(const u32x4*)(kg + (size_t)(32 * i) * 1024); vr[i] = *(const u32x4*)(vg + (size_t)(32 * i) * 1024); }
    if (tid < 64) fr = F[tid];
#pragma unroll
    for (int i = 0; i < 2; ++i) { *(u32x4*)(lds + (srow0 + 32 * i) * KST + scc * 16) = kr[i]; *(u32x4*)(lds + 64 * KST + (srow0 + 32 * i) * VST + scc * 16) = vr[i]; }
    if (tid < 64) *(float*)(lds + 64 * KST + 64 * VST + tid * 4) = fr;
    __syncthreads();
    for (int kt = 0; kt < ntile; ++kt) {
        const int k0 = kt * 64; unsigned char* cur = lds + (kt & 1) * BUF; unsigned char* nxt = lds + ((kt & 1) ^ 1) * BUF;
        const bool more = kt + 1 < ntile;
        if (more) {
#pragma unroll
            for (int i = 0; i < 2; ++i) { kr[i] = *(const u32x4*)(kg + (size_t)(k0 + 64 + 32 * i) * 1024); vr[i] = *(const u32x4*)(vg + (size_t)(k0 + 64 + 32 * i) * 1024); }
            if (tid < 64) fr = F[k0 + 64 + tid];
        }
        if (k0 <= q0s + 31) {
            f32x16 s[2];
#pragma unroll
            for (int kb = 0; kb < 2; ++kb) {
#pragma unroll
                for (int i = 0; i < 16; ++i) s[kb][i] = 0.f;
#pragma unroll
                for (int ks = 0; ks < 8; ++ks) { const bf16x8 a = *(const bf16x8*)(cur + (kb * 32 + r) * KST + ks * 32 + hh * 16);
                    s[kb] = __builtin_amdgcn_mfma_f32_32x32x16_bf16(a, qf[ks], s[kb], 0, 0, 0); }
            }
            const float* Fs = (const float*)(cur + 64 * KST + 64 * VST);
            const bool need_mask = k0 + 63 > q0s;
            float mx = m;
#pragma unroll
            for (int kb = 0; kb < 2; ++kb)
#pragma unroll
                for (int g = 0; g < 4; ++g) { const f32x4 f4 = *(const f32x4*)(Fs + kb * 32 + 8 * g + 4 * hh);
#pragma unroll
                    for (int e = 0; e < 4; ++e) { float val = s[kb][4 * g + e] + (Fq - f4[e]);
                        if (need_mask && (k0 + kb * 32 + 8 * g + 4 * hh + e > qs)) val = -INFINITY;
                        s[kb][4 * g + e] = val; mx = fmaxf(mx, val); } }
            mx = fmaxf(mx, __shfl_xor(mx, 32));
            const float alpha = __builtin_amdgcn_exp2f(m - mx);
            float ps = 0.f;
#pragma unroll
            for (int kb = 0; kb < 2; ++kb)
#pragma unroll
                for (int i = 0; i < 16; ++i) { const float pv = __builtin_amdgcn_exp2f(s[kb][i] - mx); s[kb][i] = pv; ps += pv; }
            l = l * alpha + ps; m = mx;
#pragma unroll
            for (int d = 0; d < 4; ++d)
#pragma unroll
                for (int i = 0; i < 16; ++i) o[d][i] *= alpha;
#pragma unroll
            for (int kb = 0; kb < 2; ++kb)
#pragma unroll
                for (int st = 0; st < 2; ++st) {
                    u32x4 pw; pw.x = cvt_pk(s[kb][8 * st + 0], s[kb][8 * st + 1]); pw.y = cvt_pk(s[kb][8 * st + 2], s[kb][8 * st + 3]);
                    pw.z = cvt_pk(s[kb][8 * st + 4], s[kb][8 * st + 5]); pw.w = cvt_pk(s[kb][8 * st + 6], s[kb][8 * st + 7]);
                    const bf16x8 pf = __builtin_bit_cast(bf16x8, pw);
#pragma unroll
                    for (int d = 0; d < 4; ++d) { const bf16x8 vf = tr_frag(cur + vb_off + (kb * 32 + st * 16) * VST + d * 64, 8 * VST);
                        o[d] = __builtin_amdgcn_mfma_f32_32x32x16_bf16(vf, pf, o[d], 0, 0, 0); }
                }
        }
        if (more) {
#pragma unroll
            for (int i = 0; i < 2; ++i) { *(u32x4*)(nxt + (srow0 + 32 * i) * KST + scc * 16) = kr[i]; *(u32x4*)(nxt + 64 * KST + (srow0 + 32 * i) * VST + scc * 16) = vr[i]; }
            if (tid < 64) *(float*)(nxt + 64 * KST + 64 * VST + tid * 4) = fr;
        }
        __syncthreads();
    }
    l += __shfl_xor(l, 32);
    const float inv = 1.f / l;
#pragma unroll
    for (int d = 0; d < 4; ++d)
#pragma unroll
        for (int g = 0; g < 4; ++g) { u32x2 w; w.x = cvt_pk(o[d][4 * g] * inv, o[d][4 * g + 1] * inv); w.y = cvt_pk(o[d][4 * g + 2] * inv, o[d][4 * g + 3] * inv);
            *(u32x2*)(Oc + trow * D_ + h * 128 + d * 32 + 8 * g + 4 * hh) = w; }
}

__device__ __forceinline__ void mlstm_passA(const Params& p, unsigned char* lds, int unit) {
    const int tid = get_tid(), lane = tid & 63, wave = tid >> 6, r = lane & 31, hh = lane >> 5, li = lane & 15;
    const int b = unit >> 3, h = (unit >> 1) & 3, eh = unit & 1;
    unsigned char* ws = p.ws;
    const bf16_t* KC = (const bf16_t*)(ws + WS_KC); const bf16_t* Mv = (const bf16_t*)(ws + WS_P + 5 * SEG_B);
    const float* gate = (const float*)(ws + WS_GATE);
    bf16_t* Cst = (bf16_t*)(ws + WS_CST); float* nst = (float*)(ws + WS_NST); float* mst = (float*)(ws + WS_MST);
    constexpr int KST = 528, VST = 272;
    unsigned char* ksm = lds;
    unsigned char* vsm = ksm + 64 * KST;
    float* WSV = (float*)(vsm + 64 * VST);
    float* SCL = WSV + 2048;
    __syncthreads();
    for (int cc = wave; cc < 32; cc += 8) {
        const int t = b * S_ + cc * 64 + lane;
        const float ipre = gate[(size_t)t * 16 + 8 + h] + p.m_ib[h], fpre = gate[(size_t)t * 16 + 12 + h] + p.m_fb[h];
        float bc = logsig(fpre);
#pragma unroll
        for (int o = 1; o < 64; o <<= 1) { const float u = __shfl_up(bc, o); if (lane >= o) bc += u; }
        const float a = ipre - bc; const float amax = wmax(a); const float bL = __shfl(bc, 63);
        WSV[cc * 64 + lane] = a; if (lane == 0) { SCL[cc] = bL; SCL[32 + cc] = amax; }
    }
    __syncthreads();
    if (tid == 0) { float m = 0.f; for (int cc = 0; cc < 32; ++cc) { const float mn = SCL[cc] + fmaxf(m, SCL[32 + cc]); SCL[64 + cc] = expf(SCL[cc] + m - mn); SCL[96 + cc] = mn; if (eh == 0) mst[(b * 4 + h) * 32 + cc] = m; m = mn; } }
    __syncthreads();
    for (int i = tid; i < 2048; i += NTHR) { const int cc = i >> 6; WSV[i] = expf(SCL[cc] + WSV[i] - SCL[96 + cc]); }
    f32x16 acc[4];
#pragma unroll
    for (int et = 0; et < 4; ++et)
#pragma unroll
        for (int i = 0; i < 16; ++i) acc[et][i] = 0.f;
    float nreg = 0.f;
    const int kb_off = (8 * hh + (li >> 2)) * KST + (wave * 32 + 16 * (r >> 4) + 4 * (li & 3)) * 2;
    const int vb_off = (8 * hh + (li >> 2)) * VST + (16 * (r >> 4) + 4 * (li & 3)) * 2;
    for (int cc = 0; cc < 32; ++cc) {
        const int bhc = (b * 4 + h) * 32 + cc, t0 = b * S_ + cc * 64;
#pragma unroll
        for (int et = 0; et < 4; ++et)
#pragma unroll
            for (int i = 0; i < 16; ++i) Cst[((size_t)bhc * 256 + eh * 128 + et * 32 + (i & 3) + 8 * (i >> 2) + 4 * hh) * 256 + wave * 32 + r] = (bf16_t)(cvt_pk(acc[et][i], 0.f) & 0xffffu);
        if (eh == 0 && tid < 256) nst[(size_t)bhc * 256 + tid] = nreg;
        if (cc == 31) break;
        __syncthreads();
#pragma unroll
        for (int i = 0; i < 4; ++i) { const int c = tid + NTHR * i, row = c >> 5, c16 = c & 31;
            *(u32x4*)(ksm + row * KST + c16 * 16) = *(const u32x4*)(KC + (size_t)(t0 + row) * 1024 + h * 256 + c16 * 8); }
#pragma unroll
        for (int i = 0; i < 2; ++i) { const int c = tid + NTHR * i, row = c >> 4, c16 = c & 15; const float wv = WSV[cc * 64 + row];
            const u32x4 w = *(const u32x4*)(Mv + (size_t)(t0 + row) * 1024 + h * 256 + eh * 128 + c16 * 8);
            u32x4 o; o.x = cvt_pk(bflo(w.x) * wv, bfhi(w.x) * wv); o.y = cvt_pk(bflo(w.y) * wv, bfhi(w.y) * wv); o.z = cvt_pk(bflo(w.z) * wv, bfhi(w.z) * wv); o.w = cvt_pk(bflo(w.w) * wv, bfhi(w.w) * wv);
            *(u32x4*)(vsm + row * VST + c16 * 16) = o; }
        __syncthreads();
        const float decay = SCL[64 + cc];
        if (tid < 256) { float s = 0.f; for (int q = 0; q < 64; ++q) s += WSV[cc * 64 + q] * bf2f(*(const bf16_t*)(ksm + q * KST + tid * 2)); nreg = nreg * decay + s; }
#pragma unroll
        for (int et = 0; et < 4; ++et)
#pragma unroll
            for (int i = 0; i < 16; ++i) acc[et][i] *= decay;
#pragma unroll
        for (int ks = 0; ks < 4; ++ks) {
            const bf16x8 bfr = tr_frag(ksm + kb_off + ks * 16 * KST, 4 * KST);
#pragma unroll
            for (int et = 0; et < 4; ++et) { const bf16x8 afr = tr_frag(vsm + vb_off + ks * 16 * VST + et * 64, 4 * VST);
                acc[et] = __builtin_amdgcn_mfma_f32_32x32x16_bf16(afr, bfr, acc[et], 0, 0, 0); }
        }
    }
}

__device__ __forceinline__ void mlstm_passB(const Params& p, unsigned char* lds, int unit) {
    const int tid = get_tid(), lane = tid & 63, wave = tid >> 6, r = lane & 31, hh = lane >> 5, li = lane & 15;
    const int b = unit >> 7, h = (unit >> 5) & 3, cc = unit & 31;
    unsigned char* ws = p.ws;
    const bf16_t* QC = (const bf16_t*)(ws + WS_QC); const bf16_t* KC = (const bf16_t*)(ws + WS_KC);
    const bf16_t* Mv = (const bf16_t*)(ws + WS_P + 5 * SEG_B); const bf16_t* Mo = (const bf16_t*)(ws + WS_P + 6 * SEG_B);
    const float* gate = (const float*)(ws + WS_GATE);
    const bf16_t* Cst = (const bf16_t*)(ws + WS_CST); const float* nst = (const float*)(ws + WS_NST); const float* mst = (const float*)(ws + WS_MST);
    bf16_t* Oc = (bf16_t*)(ws + WS_H);
    constexpr int QST = 528, VST = 544, WST = 144, HST = 1040;
    unsigned char* qsm = lds;
    unsigned char* ksm = qsm + 64 * QST;
    unsigned char* vsm = ksm + 64 * QST;
    unsigned char* wsm = vsm + 64 * VST;
    float* sc = (float*)(wsm + 64 * WST);
    float* hsm = (float*)lds;
    const int bhc = (b * 4 + h) * 32 + cc, t0 = b * S_ + cc * 64;
    __syncthreads();
    if (wave == 0) {
        const float ipre = gate[(size_t)(t0 + lane) * 16 + 8 + h] + p.m_ib[h], fpre = gate[(size_t)(t0 + lane) * 16 + 12 + h] + p.m_fb[h];
        float bc = logsig(fpre);
#pragma unroll
        for (int o = 1; o < 64; o <<= 1) { const float u = __shfl_up(bc, o); if (lane >= o) bc += u; }
        const float a = ipre - bc; float pm = a;
#pragma unroll
        for (int o = 1; o < 64; o <<= 1) { const float u = __shfl_up(pm, o); if (lane >= o) pm = fmaxf(pm, u); }
        const float mc = mst[bhc]; const float mt = bc + fmaxf(mc, pm);
        sc[lane] = bc - mt; sc[64 + lane] = a; sc[128 + lane] = mt; sc[192 + lane] = expf(bc + mc - mt);
    }
    bf16x8 cfr[16];
#pragma unroll
    for (int ks = 0; ks < 16; ++ks) cfr[ks] = *(const bf16x8*)(Cst + ((size_t)bhc * 256 + wave * 32 + r) * 256 + ks * 16 + hh * 8);
#pragma unroll
    for (int i = 0; i < 4; ++i) { const int c = tid + NTHR * i, row = c >> 5, c16 = c & 31;
        *(u32x4*)(qsm + row * QST + c16 * 16) = *(const u32x4*)(QC + (size_t)(t0 + row) * 1024 + h * 256 + c16 * 8);
        *(u32x4*)(ksm + row * QST + c16 * 16) = *(const u32x4*)(KC + (size_t)(t0 + row) * 1024 + h * 256 + c16 * 8);
        *(u32x4*)(vsm + row * VST + c16 * 16) = *(const u32x4*)(Mv + (size_t)(t0 + row) * 1024 + h * 256 + c16 * 8); }
    __syncthreads();
    if (wave < 3) {
        const int sb = wave >> 1, lb = wave ? 1 : 0;
        f32x16 s;
#pragma unroll
        for (int i = 0; i < 16; ++i) s[i] = 0.f;
#pragma unroll
        for (int ks = 0; ks < 16; ++ks) { const bf16x8 a = *(const bf16x8*)(ksm + (sb * 32 + r) * QST + ks * 32 + hh * 16), q = *(const bf16x8*)(qsm + (lb * 32 + r) * QST + ks * 32 + hh * 16);
            s = __builtin_amdgcn_mfma_f32_32x32x16_bf16(a, q, s, 0, 0, 0); }
        const int l = lb * 32 + r; const float bl = sc[l]; float rs = 0.f;
#pragma unroll
        for (int g = 0; g < 4; ++g) { float w[4];
#pragma unroll
            for (int e = 0; e < 4; ++e) { const int sI = sb * 32 + 8 * g + 4 * hh + e; w[e] = (sI <= l) ? s[4 * g + e] * __expf(bl + sc[64 + sI]) : 0.f; rs += w[e]; }
            u32x2 o; o.x = cvt_pk(w[0], w[1]); o.y = cvt_pk(w[2], w[3]);
            *(u32x2*)(wsm + l * WST + (sb * 32 + 8 * g + 4 * hh) * 2) = o; }
        sc[256 + l * 4 + sb * 2 + hh] = rs;
    } else if (wave == 3) {
        const int l = r;
#pragma unroll
        for (int g = 0; g < 4; ++g) { u32x2 o; o.x = 0u; o.y = 0u; *(u32x2*)(wsm + l * WST + (32 + 8 * g + 4 * hh) * 2) = o; }
        sc[256 + l * 4 + 2 + hh] = 0.f;
    }
    {
        const int l = tid & 63, part = tid >> 6; const float* np = nst + (size_t)bhc * 256 + part * 32; float s = 0.f;
#pragma unroll
        for (int q = 0; q < 4; ++q) { const u32x4 w = *(const u32x4*)(qsm + l * QST + part * 64 + q * 16);
            s += bflo(w.x) * np[8 * q] + bfhi(w.x) * np[8 * q + 1] + bflo(w.y) * np[8 * q + 2] + bfhi(w.y) * np[8 * q + 3] + bflo(w.z) * np[8 * q + 4] + bfhi(w.z) * np[8 * q + 5] + bflo(w.w) * np[8 * q + 6] + bfhi(w.w) * np[8 * q + 7]; }
        sc[512 + l * 8 + part] = s;
    }
    f32x16 acc[2];
#pragma unroll
    for (int lb = 0; lb < 2; ++lb)
#pragma unroll
        for (int i = 0; i < 16; ++i) acc[lb][i] = 0.f;
#pragma unroll
    for (int ks = 0; ks < 16; ++ks)
#pragma unroll
        for (int lb = 0; lb < 2; ++lb) { const bf16x8 q = *(const bf16x8*)(qsm + (lb * 32 + r) * QST + ks * 32 + hh * 16);
            acc[lb] = __builtin_amdgcn_mfma_f32_32x32x16_bf16(cfr[ks], q, acc[lb], 0, 0, 0); }
    __syncthreads();
#pragma unroll
    for (int lb = 0; lb < 2; ++lb) { const float it = sc[192 + lb * 32 + r];
#pragma unroll
        for (int i = 0; i < 16; ++i) acc[lb][i] *= it; }
    const int vb_off = (8 * hh + (li >> 2)) * VST + (wave * 32 + 16 * (r >> 4) + 4 * (li & 3)) * 2;
#pragma unroll
    for (int ks = 0; ks < 4; ++ks) { const bf16x8 afr = tr_frag(vsm + vb_off + ks * 16 * VST, 4 * VST);
#pragma unroll
        for (int lb = 0; lb < 2; ++lb) { if (lb == 0 && ks >= 2) continue;
            const bf16x8 wf = *(const bf16x8*)(wsm + (lb * 32 + r) * WST + ks * 32 + hh * 16);
            acc[lb] = __builtin_amdgcn_mfma_f32_32x32x16_bf16(afr, wf, acc[lb], 0, 0, 0); } }
    float ssq[2];
#pragma unroll
    for (int lb = 0; lb < 2; ++lb) { const int l = lb * 32 + r;
        const f32x4 rsv = *(const f32x4*)(sc + 256 + l * 4); const f32x4 q0 = *(const f32x4*)(sc + 512 + l * 8), q1 = *(const f32x4*)(sc + 512 + l * 8 + 4);
        const float den = (rsv[0] + rsv[1] + rsv[2] + rsv[3]) + sc[192 + l] * ((q0[0] + q0[1] + q0[2] + q0[3]) + (q1[0] + q1[1] + q1[2] + q1[3]));
        const float inv = 1.f / fmaxf(fabsf(den), __expf(-sc[128 + l]));
        float s2 = 0.f;
#pragma unroll
        for (int i = 0; i < 16; ++i) { acc[lb][i] *= inv; s2 += acc[lb][i] * acc[lb][i]; }
        s2 += __shfl_xor(s2, 32); ssq[lb] = s2; }
    __syncthreads();
    if (hh == 0) { sc[1024 + r * 8 + wave] = ssq[0]; sc[1024 + (32 + r) * 8 + wave] = ssq[1]; }
#pragma unroll
    for (int lb = 0; lb < 2; ++lb)
#pragma unroll
        for (int g = 0; g < 4; ++g) { f32x4 v; v[0] = acc[lb][4 * g]; v[1] = acc[lb][4 * g + 1]; v[2] = acc[lb][4 * g + 2]; v[3] = acc[lb][4 * g + 3];
            *(f32x4*)((unsigned char*)hsm + (lb * 32 + r) * HST + (wave * 32 + 8 * g + 4 * hh) * 4) = v; }
    __syncthreads();
#pragma unroll
    for (int i = 0; i < 4; ++i) { const int c = tid + NTHR * i, l = c >> 5, e0 = (c & 31) * 8;
        const f32x4 s0 = *(const f32x4*)(sc + 1024 + l * 8), s1 = *(const f32x4*)(sc + 1024 + l * 8 + 4);
        const float rr = rsqrtf(((s0[0] + s0[1] + s0[2] + s0[3]) + (s1[0] + s1[1] + s1[2] + s1[3])) * (1.f / 256.f) + EPS_);
        const f32x4 h0 = *(const f32x4*)((unsigned char*)hsm + l * HST + e0 * 4), h1 = *(const f32x4*)((unsigned char*)hsm + l * HST + e0 * 4 + 16);
        const f32x4 g0 = *(const f32x4*)(p.m_hg + h * 256 + e0), g1 = *(const f32x4*)(p.m_hg + h * 256 + e0 + 4);
        const u32x4 mo = *(const u32x4*)(Mo + (size_t)(t0 + l) * 1024 + h * 256 + e0);
        u32x4 o;
        o.x = cvt_pk(h0[0] * rr * g0[0] * sigm(bflo(mo.x)), h0[1] * rr * g0[1] * sigm(bfhi(mo.x))); o.y = cvt_pk(h0[2] * rr * g0[2] * sigm(bflo(mo.y)), h0[3] * rr * g0[3] * sigm(bfhi(mo.y)));
        o.z = cvt_pk(h1[0] * rr * g1[0] * sigm(bflo(mo.z)), h1[1] * rr * g1[1] * sigm(bfhi(mo.z))); o.w = cvt_pk(h1[2] * rr * g1[2] * sigm(bflo(mo.w)), h1[3] * rr * g1[3] * sigm(bfhi(mo.w)));
        *(u32x4*)(Oc + (size_t)(t0 + l) * D_ + 1024 + h * 256 + e0) = o; }
}

__device__ __forceinline__ void ce_desc(float& a, float& b) { const float hi = fmaxf(a, b), lo = fminf(a, b); a = hi; b = lo; }
__device__ __forceinline__ void sort16_desc(float (&v)[16]) {
#pragma unroll
    for (int k = 2; k <= 16; k <<= 1)
#pragma unroll
        for (int j = k >> 1; j > 0; j >>= 1)
#pragma unroll
            for (int i = 0; i < 16; ++i) { const int l = i ^ j; if (l > i) { if ((i & k) == 0) ce_desc(v[i], v[l]); else ce_desc(v[l], v[i]); } }
}
__device__ __forceinline__ void bmerge16_desc(float (&v)[16]) {
#pragma unroll
    for (int j = 8; j > 0; j >>= 1)
#pragma unroll
        for (int i = 0; i < 16; ++i) { const int l = i ^ j; if (l > i) ce_desc(v[i], v[l]); }
}
__device__ __forceinline__ void merge_top16(float (&a)[16], const float (&b)[16]) {
#pragma unroll
    for (int i = 0; i < 16; ++i) a[i] = fmaxf(a[i], b[15 - i]);
    bmerge16_desc(a);
}
__device__ __forceinline__ float pack_idx(float v, unsigned mask, unsigned idx) { return __builtin_bit_cast(float, (__builtin_bit_cast(unsigned, v) & mask) | idx); }
__device__ __forceinline__ void top16_from_acc(const f32x16 (&acc)[4], int h, float (&out)[16]) {
    float g[4][16];
#pragma unroll
    for (int mt = 0; mt < 4; ++mt) {
#pragma unroll
        for (int i = 0; i < 16; ++i) g[mt][i] = pack_idx(acc[mt][i], 0xffffff80u, (unsigned)(32 * mt + (i & 3) + 8 * (i >> 2)) | ((unsigned)h << 2));
        sort16_desc(g[mt]);
    }
    merge_top16(g[0], g[1]); merge_top16(g[2], g[3]); merge_top16(g[0], g[2]);
    float o[16];
#pragma unroll
    for (int i = 0; i < 16; ++i) o[i] = __shfl_xor(g[0][i], 32);
    merge_top16(g[0], o);
#pragma unroll
    for (int i = 0; i < 16; ++i) out[i] = g[0][i];
}
__device__ __forceinline__ unsigned lut16(const unsigned (&P)[4], unsigned i) {
    const unsigned long long lo = (unsigned long long)P[0] | ((unsigned long long)P[1] << 32), hi = (unsigned long long)P[2] | ((unsigned long long)P[3] << 32);
    const unsigned long long s = (i & 8u) ? hi : lo;
    return (unsigned)(s >> ((i & 7u) * 8u)) & 0xffu;
}
struct CandTab { int i[50]; int j[50]; };
constexpr CandTab make_cand_tab() { CandTab t{}; int n = 0; for (int i = 0; i < 16; ++i) for (int j = 0; j < 16; ++j) if ((i + 1) * (j + 1) <= 16) { t.i[n] = i; t.j[n] = j; ++n; } return t; }
__device__ __forceinline__ void phase_topk(const Params& p, unsigned char* lds, int bid, int nb) {
    const int tid = get_tid(), lane = tid & 63, wave = tid >> 6, r = lane & 31, h = lane >> 5;
    unsigned char* ws = p.ws;
    const bf16_t* Q = (const bf16_t*)(ws + WS_Q); int* IDX = (int*)(ws + WS_IDX); float* GW = (float*)(ws + WS_GW);
    constexpr int KP = 136;
    bf16_t* KS = (bf16_t*)lds;
    for (int i = tid; i < 2 * 16384; i += NTHR) { const int which = i >> 14, n = (i >> 7) & 127, d = i & 127; const float v = (which ? p.sk2 : p.sk1)[i & 16383];
        const unsigned hb = cvt_pk(v, 0.f) & 0xffffu; const float lo = v - bf2f((bf16_t)hb);
        KS[((which * 2 + 0) * 128 + n) * KP + d] = (bf16_t)hb; KS[((which * 2 + 1) * 128 + n) * KP + d] = (bf16_t)(cvt_pk(lo, 0.f) & 0xffffu); }
    __syncthreads();
    for (int item = bid * 8 + wave; item < 512 * 8; item += nb * 8) {
        const int tt = item >> 3, hh = item & 7, t = tt * 32 + r;
        float top[2][16];
#pragma unroll
        for (int list = 0; list < 2; ++list) {
            bf16x8 qf[8];
#pragma unroll
            for (int ks = 0; ks < 8; ++ks) qf[ks] = *(const bf16x8*)(Q + (size_t)t * D_ + hh * 256 + list * 128 + ks * 16 + h * 8);
            float g[4][16];
#pragma unroll
            for (int mt = 0; mt < 4; ++mt) {
                f32x16 acc;
#pragma unroll
                for (int i = 0; i < 16; ++i) acc[i] = 0.f;
#pragma unroll
                for (int hl = 0; hl < 2; ++hl)
#pragma unroll
                    for (int ks = 0; ks < 8; ++ks) { const bf16x8 a = *(const bf16x8*)(KS + ((list * 2 + hl) * 128 + mt * 32 + r) * KP + ks * 16 + h * 8);
                        acc = __builtin_amdgcn_mfma_f32_32x32x16_bf16(a, qf[ks], acc, 0, 0, 0); }
#pragma unroll
                for (int i = 0; i < 16; ++i) g[mt][i] = pack_idx(acc[i], 0xffffff80u, (unsigned)(32 * mt + (i & 3) + 8 * (i >> 2)) | ((unsigned)h << 2));
                sort16_desc(g[mt]);
                __builtin_amdgcn_sched_barrier(0);
            }
            merge_top16(g[0], g[1]); merge_top16(g[2], g[3]); merge_top16(g[0], g[2]);
            {   float o[16];
#pragma unroll
                for (int i = 0; i < 16; ++i) o[i] = __shfl_xor(g[0][i], 32);
                merge_top16(g[0], o); }
#pragma unroll
            for (int i = 0; i < 16; ++i) top[list][i] = g[0][i];
            __builtin_amdgcn_sched_barrier(0);
        }
        unsigned P1[4], P2[4];
#pragma unroll
        for (int q = 0; q < 4; ++q) { P1[q] = 0u; P2[q] = 0u;
#pragma unroll
            for (int e = 0; e < 4; ++e) { P1[q] |= (__builtin_bit_cast(unsigned, top[0][4 * q + e]) & 127u) << (8 * e); P2[q] |= (__builtin_bit_cast(unsigned, top[1][4 * q + e]) & 127u) << (8 * e); } }
        float c[4][16];
#pragma unroll
        for (int n = 0; n < 64; ++n) {
            if (n < 50) { constexpr CandTab CT = make_cand_tab(); const int i = CT.i[n], j = CT.j[n];
                c[n >> 4][n & 15] = pack_idx(top[0][i] + top[1][j], 0xffffff00u, (unsigned)(i * 16 + j)); }
            else c[n >> 4][n & 15] = -INFINITY;
        }
        sort16_desc(c[0]); __builtin_amdgcn_sched_barrier(0); sort16_desc(c[1]); __builtin_amdgcn_sched_barrier(0); merge_top16(c[0], c[1]); __builtin_amdgcn_sched_barrier(0);
        sort16_desc(c[2]); __builtin_amdgcn_sched_barrier(0); sort16_desc(c[3]); __builtin_amdgcn_sched_barrier(0); merge_top16(c[2], c[3]); __builtin_amdgcn_sched_barrier(0); merge_top16(c[0], c[2]);
        float ex[16], sum = 0.f;
#pragma unroll
        for (int k = 0; k < 16; ++k) { ex[k] = __expf(c[0][k] - c[0][0]); sum += ex[k]; }
        const float inv = 1.f / sum;
        if (h == 0) {
            int* ip = IDX + (size_t)t * 128 + hh * 16; float* gp = GW + (size_t)t * 128 + hh * 16;
#pragma unroll
            for (int q = 0; q < 4; ++q) { u32x4 iv; f32x4 gv;
#pragma unroll
                for (int e = 0; e < 4; ++e) { const unsigned pos = __builtin_bit_cast(unsigned, c[0][4 * q + e]) & 255u;
                    iv[e] = lut16(P1, pos >> 4) * 128u + lut16(P2, pos & 15u); gv[e] = ex[4 * q + e] * inv; }
                *(u32x4*)(ip + 4 * q) = iv; *(f32x4*)(gp + 4 * q) = gv; }
        }
    }
}

typedef float f32x2 __attribute__((ext_vector_type(2)));
__device__ __forceinline__ float dot16_fp8(const u32x4 w, const float (&h)[32], int o) {
    float s = 0.f;
#pragma unroll
    for (int q = 0; q < 4; ++q) { const f32x2 lo = __builtin_amdgcn_cvt_pk_f32_fp8((int)w[q], false), hi = __builtin_amdgcn_cvt_pk_f32_fp8((int)w[q], true);
        fmac(s, lo[0], h[o + 4 * q]); fmac(s, lo[1], h[o + 4 * q + 1]); fmac(s, hi[0], h[o + 4 * q + 2]); fmac(s, hi[1], h[o + 4 * q + 3]); }
    return s;
}
__device__ __forceinline__ void phase_peer1(const Params& p, int bid, int nb) {
    const int tid = get_tid(), lane = tid & 63, wave = tid >> 6;
    unsigned char* ws = p.ws;
    const bf16_t* H2 = (const bf16_t*)(ws + WS_H2); const int* IDX = (const int*)(ws + WS_IDX); const float* GW = (const float*)(ws + WS_GW);
    unsigned* EWT = (unsigned*)(ws + WS_EWT);
    const unsigned char* E8D = ws + WS_E8D + 16 * lane;
    for (int t = bid * 8 + wave; t < T_; t += nb * 8) {
        float hv[32];
#pragma unroll
        for (int hf = 0; hf < 2; ++hf)
#pragma unroll
            for (int q = 0; q < 2; ++q) { const u32x4 w = *(const u32x4*)(H2 + (size_t)t * D_ + hf * 1024 + 16 * lane + 8 * q);
#pragma unroll
                for (int e = 0; e < 4; ++e) { hv[hf * 16 + q * 8 + 2 * e] = bflo(w[e]); hv[hf * 16 + q * 8 + 2 * e + 1] = bfhi(w[e]); } }
        const int idx0 = IDX[(size_t)t * 128 + lane], idx1 = IDX[(size_t)t * 128 + 64 + lane];
        const float g0 = GW[(size_t)t * 128 + lane], g1 = GW[(size_t)t * 128 + 64 + lane];
        float a0 = 0.f, a1 = 0.f;
        for (int i0 = 0; i0 < 128; i0 += 8) {
            u32x4 lo[8], hi[8];
#pragma unroll
            for (int u = 0; u < 8; ++u) { const int e = __shfl(i0 < 64 ? idx0 : idx1, (i0 + u) & 63); lo[u] = *(const u32x4*)(E8D + (size_t)e * 2048); hi[u] = *(const u32x4*)(E8D + (size_t)e * 2048 + 1024); }
#pragma unroll
            for (int u = 0; u < 8; ++u) { float d = dot16_fp8(lo[u], hv, 0) + dot16_fp8(hi[u], hv, 16); d = wsum(d);
                if (lane == ((i0 + u) & 63)) { if (i0 < 64) a0 = d; else a1 = d; } }
        }
        a0 *= (1.f / 512.f); a1 *= (1.f / 512.f);
        const float w0 = g0 * 0.5f * a0 * (1.f + erff(a0 * 0.7071067811865476f)), w1 = g1 * 0.5f * a1 * (1.f + erff(a1 * 0.7071067811865476f));
        unsigned* ep = EWT + (size_t)(t >> 6) * 8192 + (t & 63) * 4;
        ep[(lane >> 2) * 256 + (lane & 3)] = (cvt_pk(0.f, w0) & 0xffff0000u) | (unsigned)idx0;
        ep[((lane + 64) >> 2) * 256 + (lane & 3)] = (cvt_pk(0.f, w1) & 0xffff0000u) | (unsigned)idx1;
    }
}
__device__ __forceinline__ void phase_peer2(const Params& p, unsigned char* lds, int bid, int nb) {
    const int tid = get_tid(), lane = tid & 63, wave = tid >> 6;
    unsigned char* ws = p.ws;
    const unsigned* EWT = (const unsigned*)(ws + WS_EWT); const float* X1 = (const float*)(ws + WS_X1); const float* mod = (const float*)(ws + WS_MOD);
    for (int si = bid; si < 256; si += nb) {
        const int s = (si & 7) * 32 + (si >> 3);
        __syncthreads();
        {   const u32x4* sp = (const u32x4*)(ws + WS_E8U + (size_t)s * 131072);
#pragma unroll
            for (int i = 0; i < 16; ++i) ((u32x4*)lds)[tid + NTHR * i] = sp[tid + NTHR * i]; }
        __syncthreads();
        const int tb0 = ((si >> 5) * 32 + wave) & 255;
        unsigned cur[16], nxt[16];
        {   const u32x4* wp = (const u32x4*)(EWT + (size_t)tb0 * 8192) + lane;
#pragma unroll
            for (int u = 0; u < 4; ++u) { const u32x4 v = wp[u * 64]; cur[4 * u] = v.x; cur[4 * u + 1] = v.y; cur[4 * u + 2] = v.z; cur[4 * u + 3] = v.w; } }
        float acc[8];
#pragma unroll
        for (int c = 0; c < 8; ++c) acc[c] = 0.f;
        f32x4 xa = {0.f, 0.f, 0.f, 0.f}, xb = xa;
        for (int q = 0; q < 256; ++q) {
            const int tb = (tb0 + 8 * (q >> 3)) & 255, g = q & 7;
            if (q + 1 < 256) { const int tbn = (tb0 + 8 * ((q + 1) >> 3)) & 255; const u32x4* wp = (const u32x4*)(EWT + (size_t)tbn * 8192 + ((q + 1) & 7) * 1024) + lane;
#pragma unroll
                for (int u = 0; u < 4; ++u) { const u32x4 v = wp[u * 64]; nxt[4 * u] = v.x; nxt[4 * u + 1] = v.y; nxt[4 * u + 2] = v.z; nxt[4 * u + 3] = v.w; } }
            const int t = tb * 64 + lane;
            if (g == 0) { xa = *(const f32x4*)(X1 + (size_t)t * D_ + 8 * s); xb = *(const f32x4*)(X1 + (size_t)t * D_ + 8 * s + 4); }
            u32x2 row[16];
#pragma unroll
            for (int u = 0; u < 16; ++u) row[u] = *(const u32x2*)(lds + ((cur[u] << 3) & 0x1fff8u));
#pragma unroll
            for (int u = 0; u < 16; ++u) {
                const float w = __builtin_bit_cast(float, cur[u]);
                const f32x2 v0 = __builtin_amdgcn_cvt_pk_f32_fp8((int)row[u].x, false), v1 = __builtin_amdgcn_cvt_pk_f32_fp8((int)row[u].x, true), v2 = __builtin_amdgcn_cvt_pk_f32_fp8((int)row[u].y, false), v3 = __builtin_amdgcn_cvt_pk_f32_fp8((int)row[u].y, true);
                fmac(acc[0], w, v0[0]); fmac(acc[1], w, v0[1]); fmac(acc[2], w, v1[0]); fmac(acc[3], w, v1[1]); fmac(acc[4], w, v2[0]); fmac(acc[5], w, v2[1]); fmac(acc[6], w, v3[0]); fmac(acc[7], w, v3[1]);
            }
            if (g == 7) {
                const float* g2 = mod + (size_t)(t >> 11) * NMOD + 5 * D_ + 8 * s;
                const f32x4 ga = *(const f32x4*)g2, gb = *(const f32x4*)(g2 + 4);
                f32x4 oa, ob;
#pragma unroll
                for (int c = 0; c < 4; ++c) { oa[c] = xa[c] + ga[c] * acc[c] * (1.f / 32.f); ob[c] = xb[c] + gb[c] * acc[4 + c] * (1.f / 32.f); }
                *(f32x4*)(p.out + (size_t)t * D_ + 8 * s) = oa; *(f32x4*)(p.out + (size_t)t * D_ + 8 * s + 4) = ob;
#pragma unroll
                for (int c = 0; c < 8; ++c) acc[c] = 0.f;
            }
#pragma unroll
            for (int u = 0; u < 16; ++u) cur[u] = nxt[u];
        }
    }
}

typedef const __attribute__((address_space(4))) Params* KargPtr;
__device__ __forceinline__ Params load_params() {
#if defined(__HIP_DEVICE_COMPILE__)
    KargPtr kp = (KargPtr)__builtin_amdgcn_kernarg_segment_ptr(); asm volatile("" : "+s"(kp)); Params r; __builtin_memcpy(&r, kp, sizeof(Params)); return r;
#else
    return Params{};
#endif
}
constexpr int N_PHASES = 12;
constexpr int LDS_BYTES = 152 * 1024;
__global__ void __launch_bounds__(NTHR) fwd_kernel(Params p_arg) {
    extern __shared__ __attribute__((aligned(16))) unsigned char lds[];
    const int bid = blockIdx.x, nb = gridDim.x, tid = get_tid();
    unsigned char* ws = p_arg.ws;
    volatile LAS unsigned* xbst = (volatile LAS unsigned*)((LAS unsigned char*)lds + LDS_BYTES - 16);
    if (tid == 0) { xbst[0] = 0u; xbst[1] = 0u; xbst[2] = 0u; xbst[3] = 0u; }
    __syncthreads();
    if ((p_arg.ph_hi - p_arg.ph_lo) > 1) (void)xcd_barrier_post((unsigned*)(ws + WS_BAR), xbst);
#ifdef ONLY_PHASE
#define IN(k) ((k) == ONLY_PHASE && p.ph_lo <= (k) && (k) < p.ph_hi)
#else
#define IN(k) (p.ph_lo <= (k) && (k) < p.ph_hi)
#endif
#define SEAM(k) do { const Params p = load_params(); if (p.ph_lo <= (k) && (k) + 1 < p.ph_hi) { XcdBarrier bar; bar.bar = (unsigned*)(p.ws + WS_BAR); bar.x = xb_xcc_id(); bar.st = xbst; xcd_barrier(bar); } } while (0)
#ifndef REPEAT_MASK
#define REPEAT_MASK 0
#endif
#define REP(k) for (int rep_ = 0; rep_ < (((REPEAT_MASK) >> (k)) & 1) + 1; ++rep_)
    REP(0) { const Params p = load_params(); if (IN(0)) { unsigned char* ws = p.ws; const float* mod = (const float*)(ws + WS_MOD); (void)mod;
        phase_prep(p, lds, bid, nb);
    } }
    SEAM(0);
    REP(1) { const Params p = load_params(); if (IN(1)) { unsigned char* ws = p.ws; const float* mod = (const float*)(ws + WS_MOD); (void)mod;
        phase_norm<true>(p.x, p.g1, mod, 0, D_, (bf16_t*)(ws + WS_H), (const float*)(ws + WS_WG), (float*)(ws + WS_GATE), bid, nb);
    } }
    SEAM(1);
    REP(2) { const Params p = load_params(); if (IN(2)) { unsigned char* ws = p.ws; const float* mod = (const float*)(ws + WS_MOD); (void)mod;
        { pg8::Gemm g{(const bf16_t*)(ws + WS_H), (const bf16_t*)(ws + WS_WINT), T_, 7168, D_}; pg8::StaticOrder S; S.init(T_, 7168, nb, bid);
        pg8::EpiSeg E{(bf16_t*)(ws + WS_P)}; pg8::gemm_phase<pg8::EpiSeg, pg8::StaticOrder, true, true>((LAS unsigned char*)lds, g, S, E); }
    } }
    SEAM(2);
    REP(3) { const Params p = load_params(); if (IN(3)) { unsigned char* ws = p.ws; const float* mod = (const float*)(ws + WS_MOD); (void)mod;
        phase_post(p, bid, nb);
    } }
    SEAM(3);
    REP(4) { const Params p = load_params(); if (IN(4)) { unsigned char* ws = p.ws; const float* mod = (const float*)(ws + WS_MOD); (void)mod;
        { for (int u = bid; u < 64; u += nb) mlstm_passA(p, lds, u);
        unsigned* qctr = (unsigned*)(ws + WS_QCTR); LAS int* slot = (LAS int*)((LAS unsigned char*)lds + LDS_BYTES - 32);
        for (;;) { __syncthreads(); if (tid == 0) *slot = (int)atomicAdd(qctr, 1u); __syncthreads(); const int u = *slot; if (u >= 512) break;
            const int bh = u & 63; fox_unit(p, lds, bh >> 3, bh & 7, 7 - (u >> 6)); } }
    } }
    SEAM(4);
    REP(5) { const Params p = load_params(); if (IN(5)) { unsigned char* ws = p.ws; const float* mod = (const float*)(ws + WS_MOD); (void)mod;
        { for (int u = bid; u < 1024; u += nb) mlstm_passB(p, lds, u); }
    } }
    SEAM(5);
    REP(6) { const Params p = load_params(); if (IN(6)) { unsigned char* ws = p.ws; const float* mod = (const float*)(ws + WS_MOD); (void)mod;
        { pg8::Gemm g{(const bf16_t*)(ws + WS_H), (const bf16_t*)(ws + WS_WOT), T_, D_, D_}; pg8::StaticOrder S; S.init(T_, D_, nb, bid);
        pg8::EpiRes E{p.x, (float*)(ws + WS_X1), mod, 2 * D_}; pg8::gemm_phase<pg8::EpiRes, pg8::StaticOrder, true, true>((LAS unsigned char*)lds, g, S, E); }
    } }
    SEAM(6);
    REP(7) { const Params p = load_params(); if (IN(7)) { unsigned char* ws = p.ws; const float* mod = (const float*)(ws + WS_MOD); (void)mod;
        convert_experts(p, bid, nb);
    } }
    REP(7) { const Params p = load_params(); if (IN(7)) { unsigned char* ws = p.ws; const float* mod = (const float*)(ws + WS_MOD); (void)mod;
        phase_norm<false>((const float*)(ws + WS_X1), p.g2, mod, 3 * D_, 4 * D_, (bf16_t*)(ws + WS_H2), nullptr, nullptr, bid, nb);
    } }
    SEAM(7);
    REP(8) { const Params p = load_params(); if (IN(8)) { unsigned char* ws = p.ws; const float* mod = (const float*)(ws + WS_MOD); (void)mod;
        { pg8::Gemm g{(const bf16_t*)(ws + WS_H2), (const bf16_t*)(ws + WS_WQT), T_, D_, D_}; pg8::StaticOrder S; S.init(T_, D_, nb, bid);
        pg8::EpiBf E{(bf16_t*)(ws + WS_Q), D_}; pg8::gemm_phase<pg8::EpiBf, pg8::StaticOrder, true, true>((LAS unsigned char*)lds, g, S, E); }
    } }
    SEAM(8);
    REP(9) { const Params p = load_params(); if (IN(9)) { unsigned char* ws = p.ws; const float* mod = (const float*)(ws + WS_MOD); (void)mod;
        phase_topk(p, lds, bid, nb);
    } }
    SEAM(9);
    REP(10) { const Params p = load_params(); if (IN(10)) { unsigned char* ws = p.ws; const float* mod = (const float*)(ws + WS_MOD); (void)mod;
        phase_peer1(p, bid, nb);
    } }
    SEAM(10);
    REP(11) { const Params p = load_params(); if (IN(11)) { unsigned char* ws = p.ws; const float* mod = (const float*)(ws + WS_MOD); (void)mod;
        phase_peer2(p, lds, bid, nb);
    } }
#undef IN
#undef SEAM
}

#ifndef ONE_LAUNCH
#define ONE_LAUNCH 1
#endif
extern "C" void kernel_launch(void* const* d_in, const int* in_sizes, int n_in, void* d_out, int out_size, void* d_ws, size_t ws_size, hipStream_t stream) {
    static int grid = 0;
    if (grid == 0) {
        int dev = 0, cus = 0, per_cu = 0;
        if (n_in != 21 || ws_size < WS_END) { fprintf(stderr, "kernel_launch: unexpected n_in %d / ws_size %zu (need %zu)\n", n_in, ws_size, (size_t)WS_END); grid = -1; return; }
        hipGetDevice(&dev); hipDeviceGetAttribute(&cus, hipDeviceAttributeMultiprocessorCount, dev);
        if (hipFuncSetAttribute((const void*)fwd_kernel, hipFuncAttributeMaxDynamicSharedMemorySize, LDS_BYTES) != hipSuccess) { fprintf(stderr, "kernel_launch: hipFuncSetAttribute failed\n"); grid = -1; return; }
        if (hipOccupancyMaxActiveBlocksPerMultiprocessor(&per_cu, (const void*)fwd_kernel, NTHR, LDS_BYTES) != hipSuccess || per_cu < 1) { fprintf(stderr, "kernel_launch: occupancy query says %d\n", per_cu); (void)hipGetLastError(); }
        grid = cus > 0 ? cus : 256;
    }
    if (grid < 0) return;
    Params p{};
    const float** pp = (const float**)&p;
    for (int i = 0; i < 21; ++i) pp[i] = (const float*)d_in[i];
    p.out = (float*)d_out; p.ws = (unsigned char*)d_ws;
    hipMemsetAsync((char*)d_ws + WS_BAR, 0, 16384, stream);
#if ONE_LAUNCH
    p.ph_lo = 0; p.ph_hi = N_PHASES;
    void* args[] = {&p};
    hipError_t e = hipLaunchCooperativeKernel((const void*)fwd_kernel, dim3(grid), dim3(NTHR), args, LDS_BYTES, stream);
    if (e != hipSuccess) fprintf(stderr, "cooperative launch failed: %s (grid %d)\n", hipGetErrorString(e), grid);
#else
    for (int ph = 0; ph < N_PHASES; ++ph) { p.ph_lo = ph; p.ph_hi = ph + 1; hipLaunchKernelGGL(fwd_kernel, dim3(grid), dim3(NTHR), LDS_BYTES, stream, p); }
#endif
}
```

```cpp
#include <hip/hip_runtime.h>
#include <cstdio>
#include <cstdint>

#define GAS __attribute__((address_space(1)))
#define LAS __attribute__((address_space(3)))
typedef unsigned short bf16_t;
typedef short bf16x8 __attribute__((ext_vector_type(8)));
typedef float f32x4 __attribute__((ext_vector_type(4)));
typedef float f32x16 __attribute__((ext_vector_type(16)));
typedef unsigned u32x4 __attribute__((ext_vector_type(4)));
typedef unsigned u32x2 __attribute__((ext_vector_type(2)));

constexpr int T_ = 16384, D_ = 2048, B_ = 8, S_ = 2048, NTHR = 512;
constexpr float EPS_ = 1e-6f;
constexpr int NMOD = 6 * D_;
constexpr int INCOLS = 7184;

constexpr size_t WS_BAR   = 0;
constexpr size_t WS_MOD   = 16384;
constexpr size_t WS_WG    = WS_MOD + (size_t)B_ * NMOD * 4;
constexpr size_t WS_GATE  = WS_WG + 16 * 2048 * 4;
constexpr size_t WS_F     = WS_GATE + (size_t)T_ * 16 * 4;
constexpr size_t WS_NST   = WS_F + 64 * 2048 * 4;
constexpr size_t WS_MST   = WS_NST + 1024 * 256 * 4;
constexpr size_t WS_DSC   = WS_MST + 4096;
constexpr size_t WS_WINT  = WS_DSC + 16384 * 4;
constexpr size_t WS_WOT   = WS_WINT + (size_t)7168 * 2048 * 2;
constexpr size_t WS_WQT   = WS_WOT + (size_t)2048 * 2048 * 2;
constexpr size_t WS_H     = WS_WQT + (size_t)2048 * 2048 * 2;
constexpr size_t WS_P     = WS_H + (size_t)T_ * 2048 * 2;
constexpr size_t SEG_B    = (size_t)T_ * 1024 * 2;
constexpr size_t WS_CST   = WS_P + 7 * SEG_B;
constexpr size_t WS_E8D   = WS_CST + (size_t)1024 * 256 * 256 * 2;
constexpr size_t WS_E8U   = WS_E8D + (size_t)16384 * 2048;
constexpr size_t WS_END   = WS_E8U + (size_t)16384 * 2048;
constexpr size_t WS_QC    = WS_E8D;
constexpr size_t WS_KC    = WS_E8U;
constexpr size_t WS_QCTR  = 15360;
constexpr size_t WS_H2    = WS_P;
constexpr size_t WS_Q     = WS_H2 + (size_t)T_ * 2048 * 2;
constexpr size_t WS_IDX   = WS_Q + (size_t)T_ * 2048 * 2;
constexpr size_t WS_GW    = WS_IDX + (size_t)T_ * 128 * 4;
static_assert(WS_GW + (size_t)T_ * 128 * 4 <= WS_CST, "alias overflow");
constexpr size_t WS_X1    = WS_CST;
constexpr size_t WS_EWT   = WS_GW + (size_t)T_ * 128 * 4;
static_assert(WS_EWT + (size_t)T_ * 128 * 4 <= WS_CST, "alias overflow 2");

struct Params {
    const float *x, *c, *w_ada, *b_ada, *g1, *g2, *w_in, *fox_fb, *fox_qg, *fox_kg, *conv_w, *conv_b, *m_ib, *m_fb, *m_hg, *w_out, *w_q, *sk1, *sk2, *e_down, *e_up;
    float* out; unsigned char* ws; int ph_lo, ph_hi;
};

__device__ __forceinline__ int get_tid() { int t = threadIdx.x; asm volatile("" : "+v"(t)); return t; }
__device__ __forceinline__ unsigned cvt_pk(float lo, float hi) { unsigned r; asm("v_cvt_pk_bf16_f32 %0, %1, %2" : "=v"(r) : "v"(lo), "v"(hi)); return r; }
__device__ __forceinline__ void fmac(float& acc, float a, float b) { asm("v_fmac_f32 %0, %1, %2" : "+v"(acc) : "v"(a), "v"(b)); }
__device__ __forceinline__ float bf2f(unsigned short h) { return __builtin_bit_cast(float, ((unsigned)h) << 16); }
__device__ __forceinline__ float bflo(unsigned w) { return __builtin_bit_cast(float, w << 16); }
__device__ __forceinline__ float bfhi(unsigned w) { return __builtin_bit_cast(float, w & 0xffff0000u); }
__device__ __forceinline__ float wsum(float v) {
#pragma unroll
    for (int o = 32; o; o >>= 1) v += __shfl_xor(v, o);
    return v; }
__device__ __forceinline__ float wmax(float v) {
#pragma unroll
    for (int o = 32; o; o >>= 1) v = fmaxf(v, __shfl_xor(v, o));
    return v; }
__device__ __forceinline__ float logsig(float x) { return fminf(x, 0.f) - log1pf(expf(-fabsf(x))); }
__device__ __forceinline__ float sigm(float x) { return 1.f / (1.f + expf(-x)); }
__device__ __forceinline__ float silu_f(float x) { return x / (1.f + expf(-x)); }
namespace pg8 {
#define PG8_LAS __attribute__((address_space(3)))
typedef unsigned short bf16_t;
typedef short bf16x8 __attribute__((ext_vector_type(8)));
typedef float f32x4 __attribute__((ext_vector_type(4)));
typedef unsigned u32x4 __attribute__((ext_vector_type(4)));
constexpr int BM = 256, BK = 64, HALF = 128, HTB = HALF * BK * 2  , STAGE_BYTES = 8 * HTB, NXCD = 8, WGM = 8;

__host__ __device__ __forceinline__ int lds_byte(int r, int c) { const int st = (r >> 4) * 2 + (c >> 5), rr = r & 15, cc = c & 31, ob = rr * 64 + cc * 2; return st * 1024 + (ob ^ (((ob >> 9) & 1) << 5)); }
__host__ __device__ __forceinline__ void stage_rc(int b, int& R, int& C) { const int st = b / 1024, sb = b % 1024, swz = sb ^ (((sb >> 9) & 1) << 5); R = (st >> 1) * 16 + swz / 64; C = (st & 1) * 32 + (swz % 64) / 2; }
__host__ __device__ __forceinline__ int perm32(int rho) { const int n = rho >> 4, i = rho & 15; return 8 * (i >> 2) + 4 * n + (i & 3); }

struct Unit { int pm, pn; };
struct Gemm { const bf16_t* A; const bf16_t* Bt; int M, N, K; };

struct StaticOrder {
    int nM, nN, nwg, G, c;
    __host__ __device__ void init(int M, int N, int G_, int c_) { nM = M / BM; nN = N / BM; nwg = nM * nN; G = G_; c = c_; }
    __host__ __device__ bool next(int i, Unit& u) const {
        const long L = (long)i * G + c; if (L >= nwg) return false;
        int wgid = (int)L; { const int q = nwg / NXCD, r = nwg % NXCD, xcd = wgid % NXCD, off = wgid / NXCD; wgid = (xcd < r ? xcd * (q + 1) : r * (q + 1) + (xcd - r) * q) + off; }
        const int nig = WGM * nN, gid = wgid / nig, fm = gid * WGM, gsz = (nM - fm) < WGM ? (nM - fm) : WGM;
        u.pm = fm + ((wgid % nig) % gsz); u.pn = (wgid % nig) / gsz; return true;
    }
    __device__ __forceinline__ void a_ready(const Unit&) const {}
    __device__ __forceinline__ void done(const Unit&) const {}
};
struct EpiSeg {
    static constexpr bool PERM = true, AFTER_DRAIN = false;
    bf16_t* P;
    __device__ __forceinline__ void operator()(const f32x4 (&acc)[2][2][4][2], const Unit& u, int wr, int wc, int fr, int fq) const {
        const int seg = u.pn >> 2; bf16_t* base = P + (size_t)seg * ((size_t)T_ * 1024);
        const int row0 = u.pm * BM + wr * 64 + fr, col0 = (u.pn & 3) * 256 + wc * 32 + 8 * fq;
#pragma unroll
        for (int ai = 0; ai < 2; ++ai)
#pragma unroll
            for (int m = 0; m < 4; ++m) { bf16_t* rowp = base + (size_t)(row0 + ai * HALF + m * 16) * 1024 + col0;
#pragma unroll
                for (int bj = 0; bj < 2; ++bj) { const f32x4 v0 = acc[ai][bj][m][0], v1 = acc[ai][bj][m][1];
                    u32x4 w; w.x = cvt_pk(v0[0], v0[1]); w.y = cvt_pk(v0[2], v0[3]); w.z = cvt_pk(v1[0], v1[1]); w.w = cvt_pk(v1[2], v1[3]);
                    *(u32x4*)(rowp + bj * HALF) = w; } }
    }
};
struct EpiBf {
    static constexpr bool PERM = true, AFTER_DRAIN = false;
    bf16_t* O; int ldc;
    __device__ __forceinline__ void operator()(const f32x4 (&acc)[2][2][4][2], const Unit& u, int wr, int wc, int fr, int fq) const {
        const int row0 = u.pm * BM + wr * 64 + fr, col0 = u.pn * BM + wc * 32 + 8 * fq;
#pragma unroll
        for (int ai = 0; ai < 2; ++ai)
#pragma unroll
            for (int m = 0; m < 4; ++m) { bf16_t* rowp = O + (size_t)(row0 + ai * HALF + m * 16) * ldc + col0;
#pragma unroll
                for (int bj = 0; bj < 2; ++bj) { const f32x4 v0 = acc[ai][bj][m][0], v1 = acc[ai][bj][m][1];
                    u32x4 w; w.x = cvt_pk(v0[0], v0[1]); w.y = cvt_pk(v0[2], v0[3]); w.z = cvt_pk(v1[0], v1[1]); w.w = cvt_pk(v1[2], v1[3]);
                    *(u32x4*)(rowp + bj * HALF) = w; } }
    }
};
struct EpiRes {
    static constexpr bool PERM = false, AFTER_DRAIN = false;
    const float* X; float* O; const float* mod; int goff;
    __device__ __forceinline__ void operator()(const f32x4 (&acc)[2][2][4][2], const Unit& u, int wr, int wc, int fr, int fq) const {
        const int row0 = u.pm * BM + wr * 64 + fr, col0 = u.pn * BM + wc * 32 + 4 * fq;
        const float* gp = mod + (size_t)((u.pm * BM) >> 11) * NMOD + goff + col0;
        f32x4 gv[2][2];
#pragma unroll
        for (int bj = 0; bj < 2; ++bj)
#pragma unroll
            for (int n = 0; n < 2; ++n) gv[bj][n] = *(const f32x4*)(gp + bj * HALF + 16 * n);
#pragma unroll
        for (int ai = 0; ai < 2; ++ai)
#pragma unroll
            for (int m = 0; m < 4; ++m) { const size_t ro = (size_t)(row0 + ai * HALF + m * 16) * D_ + col0;
#pragma unroll
                for (int bj = 0; bj < 2; ++bj)
#pragma unroll
                    for (int n = 0; n < 2; ++n) { const f32x4 xv = *(const f32x4*)(X + ro + bj * HALF + 16 * n);
                        *(f32x4*)(O + ro + bj * HALF + 16 * n) = xv + gv[bj][n] * acc[ai][bj][m][n]; } }
    }
};
template <class Epi, class Sched, bool ALIGN_EPI = false, bool SP2 = false>
__device__ __forceinline__ void gemm_phase(PG8_LAS unsigned char* lds, const Gemm g, const Sched& S, const Epi& E) {
    const int tid = get_tid(), wid = __builtin_amdgcn_readfirstlane(tid >> 6), lane = tid & 63, wr = wid >> 2, wc = wid & 3, fr = lane & 15, fq = lane >> 4;
    const int K = g.K, nt = K / BK;
    unsigned voffA[2], voffB[2];
#pragma unroll
    for (int i = 0; i < 2; ++i) { int R, C; stage_rc(tid * 16 + i * 8192, R, C); const int Rb = Epi::PERM ? ((R & ~31) + perm32(R & 31)) : R;
        voffA[i] = (unsigned)(R * K + C) * 2u; voffB[i] = (unsigned)(Rb * K + C) * 2u; }
    const size_t kstep = (size_t)(BK * 2);
    const size_t hstep = (size_t)HALF * K * 2;
    const size_t tstep = 2 * hstep;
    const unsigned ldsw = (unsigned)wid * 1024u;
    const int aoff = lds_byte(wr * 64 + fr, fq * 8), boff = lds_byte(wc * 32 + fr, fq * 8);
#define PG8_SA(b, h) (((b) * 2 + (h)) * HTB)
#define PG8_SB(b, h) ((4 + (b) * 2 + (h)) * HTB)
#define PG8_STAGE(bufoff, gbase, voff) do { _Pragma("unroll") for (int _i = 0; _i < 2; ++_i) \
        __builtin_amdgcn_global_load_lds((const unsigned*)((const char*)(gbase) + (voff)[_i]), (PG8_LAS unsigned*)(lds + (bufoff) + ldsw + _i * 8192), 16, 0, 0); } while (0)
#define PG8_LDA(dst, b, h) do { _Pragma("unroll") for (int m = 0; m < 4; ++m) _Pragma("unroll") for (int k = 0; k < 2; ++k) dst[m][k] = *(const PG8_LAS bf16x8*)(lds + PG8_SA(b, h) + aoff + m * 2048 + k * 1024); } while (0)
#define PG8_LDB(dst, b, h) do { _Pragma("unroll") for (int n = 0; n < 2; ++n) _Pragma("unroll") for (int k = 0; k < 2; ++k) dst[n][k] = *(const PG8_LAS bf16x8*)(lds + PG8_SB(b, h) + boff + n * 2048 + k * 1024); } while (0)
#define PG8_MMA(ai, bj, At, Bt) do { __builtin_amdgcn_s_setprio(1); _Pragma("unroll") for (int m = 0; m < 4; ++m) _Pragma("unroll") for (int n = 0; n < 2; ++n) _Pragma("unroll") for (int k = 0; k < 2; ++k) \
        acc[ai][bj][m][n] = __builtin_amdgcn_mfma_f32_16x16x32_bf16(Bt[n][k], At[m][k], acc[ai][bj][m][n], 0, 0, 0); __builtin_amdgcn_s_setprio(0); } while (0)
#define PG8_WAIT_V(n) asm volatile("s_waitcnt vmcnt(" #n ")" ::: "memory")
#define PG8_WAIT_L(n) asm volatile("s_waitcnt lgkmcnt(" #n ")" ::: "memory")
#define PG8_BAR __builtin_amdgcn_s_barrier()
#define PG8_SCHED __builtin_amdgcn_sched_barrier(0)
    Unit cur, nxt; int ui = 0;
    if (!S.next(0, cur)) return;
    f32x4 acc[2][2][4][2];
#pragma unroll
    for (int a = 0; a < 2; ++a)
#pragma unroll
        for (int b = 0; b < 2; ++b)
#pragma unroll
            for (int m = 0; m < 4; ++m)
#pragma unroll
                for (int n = 0; n < 2; ++n) acc[a][b][m][n] = (f32x4){0.f, 0.f, 0.f, 0.f};
    bf16x8 At[4][2], B0[2][2], B1[2][2];
    const char* cA = (const char*)g.A + (size_t)cur.pm * tstep; const char* cB = (const char*)g.Bt + (size_t)cur.pn * tstep;
    S.a_ready(cur);
    if constexpr (SP2) {
        PG8_STAGE(PG8_SB(0, 0), cB, voffB); PG8_STAGE(PG8_SB(0, 1), cB + hstep, voffB); PG8_STAGE(PG8_SA(0, 0), cA, voffA); PG8_STAGE(PG8_SA(0, 1), cA + hstep, voffA);
        if (wr == 1) PG8_BAR;
        PG8_WAIT_V(2); PG8_BAR;
        PG8_STAGE(PG8_SB(1, 0), cB + kstep, voffB); PG8_STAGE(PG8_SA(1, 0), cA + kstep, voffA); PG8_STAGE(PG8_SB(1, 1), cB + hstep + kstep, voffB);
        PG8_WAIT_V(6); PG8_BAR;
    } else {
        PG8_STAGE(PG8_SB(0, 0), cB, voffB); PG8_STAGE(PG8_SA(0, 0), cA, voffA); PG8_STAGE(PG8_SB(0, 1), cB + hstep, voffB); PG8_STAGE(PG8_SA(0, 1), cA + hstep, voffA);
        if (wr == 1) PG8_BAR;
        PG8_WAIT_V(4); PG8_BAR;
        PG8_STAGE(PG8_SB(1, 0), cB + kstep, voffB); PG8_STAGE(PG8_SA(1, 0), cA + kstep, voffA); PG8_STAGE(PG8_SB(1, 1), cB + hstep + kstep, voffB);
        PG8_WAIT_V(6); PG8_BAR;
    }
    for (;;) {
        const bool has_next = S.next(ui + 1, nxt);
        const char* nA = has_next ? (const char*)g.A + (size_t)nxt.pm * tstep : cA; const char* nB = has_next ? (const char*)g.Bt + (size_t)nxt.pn * tstep : cB;
        for (int t = 0; t < nt; t += 2) {
            const bool last = (t == nt - 2);
            const char* a1 = cA + (size_t)(t + 1) * kstep;
            const char* a2 = last ? nA : cA + (size_t)(t + 2) * kstep; const char* b2 = last ? nB : cB + (size_t)(t + 2) * kstep;
            const char* a3 = a2 + kstep; const char* b3 = b2 + kstep;
            if (last && has_next) S.a_ready(nxt);
            if constexpr (SP2) {
            PG8_LDB(B0, 0, 0); PG8_LDB(B1, 0, 1); PG8_SCHED; PG8_LDA(At, 0, 0); PG8_STAGE(PG8_SA(1, 1), a1 + hstep, voffA);
            PG8_WAIT_V(8); PG8_WAIT_L(0); PG8_BAR; PG8_MMA(0, 0, At, B0); PG8_MMA(0, 1, At, B1); PG8_BAR; PG8_SCHED;
            PG8_LDA(At, 0, 1); PG8_STAGE(PG8_SB(0, 0), b2, voffB); PG8_STAGE(PG8_SB(0, 1), b2 + hstep, voffB); PG8_STAGE(PG8_SA(0, 0), a2, voffA);
            PG8_WAIT_V(8); PG8_WAIT_L(0); PG8_BAR; PG8_MMA(1, 0, At, B0); PG8_MMA(1, 1, At, B1); PG8_BAR; PG8_SCHED;
            PG8_LDB(B0, 1, 0); PG8_LDB(B1, 1, 1); PG8_SCHED; PG8_LDA(At, 1, 0); PG8_STAGE(PG8_SA(0, 1), a2 + hstep, voffA);
            PG8_WAIT_V(8); PG8_WAIT_L(0); PG8_BAR; PG8_MMA(0, 0, At, B0); PG8_MMA(0, 1, At, B1); PG8_BAR; PG8_SCHED;
            PG8_LDA(At, 1, 1); PG8_STAGE(PG8_SB(1, 0), b3, voffB); PG8_STAGE(PG8_SB(1, 1), b3 + hstep, voffB); PG8_STAGE(PG8_SA(1, 0), a3, voffA);
            PG8_WAIT_V(8); PG8_WAIT_L(0); PG8_BAR; PG8_MMA(1, 0, At, B0); PG8_MMA(1, 1, At, B1); PG8_BAR; PG8_SCHED;
            } else {
            PG8_LDB(B0, 0, 0); PG8_SCHED; PG8_LDA(At, 0, 0); PG8_STAGE(PG8_SA(1, 1), a1 + hstep, voffA);
            PG8_WAIT_L(8); PG8_BAR; PG8_WAIT_L(0); PG8_MMA(0, 0, At, B0); PG8_BAR; PG8_SCHED;
            PG8_LDB(B1, 0, 1); PG8_STAGE(PG8_SB(0, 0), b2, voffB);
            PG8_BAR; PG8_WAIT_L(0); PG8_MMA(0, 1, At, B1); PG8_BAR;
            PG8_LDA(At, 0, 1); PG8_STAGE(PG8_SA(0, 0), a2, voffA);
            PG8_BAR; PG8_WAIT_L(0); PG8_MMA(1, 0, At, B0); PG8_BAR; PG8_SCHED;
            PG8_STAGE(PG8_SB(0, 1), b2 + hstep, voffB);
            PG8_WAIT_V(6); PG8_BAR; PG8_MMA(1, 1, At, B1); PG8_BAR;
            PG8_LDB(B0, 1, 0); PG8_SCHED; PG8_LDA(At, 1, 0); PG8_STAGE(PG8_SA(0, 1), a2 + hstep, voffA);
            PG8_WAIT_L(8); PG8_BAR; PG8_WAIT_L(0); PG8_MMA(0, 0, At, B0); PG8_BAR; PG8_SCHED;
            PG8_LDB(B1, 1, 1); PG8_STAGE(PG8_SB(1, 0), b3, voffB);
            PG8_BAR; PG8_WAIT_L(0); PG8_MMA(0, 1, At, B1); PG8_BAR;
            PG8_LDA(At, 1, 1); PG8_STAGE(PG8_SA(1, 0), a3, voffA);
            PG8_BAR; PG8_WAIT_L(0); PG8_MMA(1, 0, At, B0); PG8_BAR; PG8_SCHED;
            PG8_STAGE(PG8_SB(1, 1), b3 + hstep, voffB);
            PG8_WAIT_V(6); PG8_BAR; PG8_MMA(1, 1, At, B1); PG8_BAR;
            }
        }
        if constexpr (ALIGN_EPI) { if (wr == 0) PG8_BAR; }
        if constexpr (!Epi::AFTER_DRAIN) { E(acc, cur, wr, wc, fr, fq); S.done(cur); }
        if (!has_next) break;
#pragma unroll
        for (int a = 0; a < 2; ++a)
#pragma unroll
            for (int b = 0; b < 2; ++b)
#pragma unroll
                for (int m = 0; m < 4; ++m)
#pragma unroll
                    for (int n = 0; n < 2; ++n) acc[a][b][m][n] = (f32x4){0.f, 0.f, 0.f, 0.f};
        cur = nxt; cA = nA; cB = nB; ++ui;
        if constexpr (ALIGN_EPI) { if (wr == 1) PG8_BAR; }
    }
    PG8_WAIT_V(0);
    if constexpr (!ALIGN_EPI) { if (wr == 0) PG8_BAR; }
    PG8_BAR;
    if constexpr (Epi::AFTER_DRAIN) { E.fused(acc, cur, wr, wc, fr, fq, lds, wid, lane); S.done(cur); }
#undef PG8_SA
#undef PG8_SB
#undef PG8_STAGE
#undef PG8_LDA
#undef PG8_LDB
#undef PG8_MMA
#undef PG8_WAIT_V
#undef PG8_WAIT_L
#undef PG8_BAR
#undef PG8_SCHED
}
}
#define XB_TMO      128
#define XB_XCNT(j)  (256  + 64 * (j))
#define XB_XSUB(j)  (1280 + 64 * (j))
#define XB_XGEN(j)  (2304 + 64 * (j))
#define XB_TOP      3328
#define XB_TOPGEN   3392
#define XCD_BAR_WORDS 3456
#define XB_SPIN_CAP (1u << 18)

__device__ __forceinline__ unsigned xb_ld(unsigned* p)              { return __hip_atomic_load(p, __ATOMIC_RELAXED, __HIP_MEMORY_SCOPE_AGENT); }
__device__ __forceinline__ unsigned xb_add(unsigned* p, unsigned v) { return __hip_atomic_fetch_add(p, v, __ATOMIC_RELAXED, __HIP_MEMORY_SCOPE_AGENT); }
__device__ __forceinline__ unsigned xb_xcc_id() { return (unsigned)__builtin_amdgcn_s_getreg((3 << 11) | 20) & 0xFu; }
#define XB_SPIN(cond, bar) do { unsigned _sp = 0; while (cond) { __builtin_amdgcn_s_sleep(1); \
    if ((++_sp & 255u) == 0u) { if (xb_ld(&(bar)[XB_TMO])) break; if (_sp > XB_SPIN_CAP) { atomicAdd(&(bar)[XB_TMO], 1u); break; } } } } while (0)

struct XcdBarrier {
    unsigned* bar; unsigned x;
    volatile LAS unsigned* st;
};

__device__ __forceinline__ XcdBarrier xcd_barrier_post(unsigned* bar, volatile LAS unsigned* st) {
    XcdBarrier b; b.bar = bar; b.x = xb_xcc_id(); b.st = st;
    if (threadIdx.x == 0) (void)xb_add(&bar[XB_XCNT(b.x)], 1u);
    return b;
}
__device__ __forceinline__ void xcd_barrier_complete(unsigned* bar, unsigned x, unsigned& nloc, unsigned& nx) {
    const unsigned G = gridDim.x * gridDim.y * gridDim.z;
    unsigned sum, cnt, mine, sp = 0u;
    for (;;) {
        sum = 0u; cnt = 0u; mine = 0u;
#pragma unroll
        for (unsigned j = 0; j < 16; ++j) { const unsigned c = xb_ld(&bar[XB_XCNT(j)]); sum += c; cnt += (c > 0u) ? 1u : 0u; mine = (j == x) ? c : mine; }
        if (sum == G) break;
        __builtin_amdgcn_s_sleep(1);
        if ((++sp & 255u) == 0u) { if (xb_ld(&bar[XB_TMO])) break; if (sp > XB_SPIN_CAP) { atomicAdd(&bar[XB_TMO], 1u); break; } }
    }
    nloc = mine > 0u ? mine : 1u; nx = cnt > 0u ? cnt : 1u;
}

__device__ __forceinline__ void xcd_barrier(const XcdBarrier& b) {
    asm volatile("s_waitcnt vmcnt(0)" ::: "memory");
    __syncthreads();
    if (threadIdx.x == 0) {
        unsigned* bar = b.bar;
        __builtin_amdgcn_s_waitcnt(0);
        unsigned nloc = b.st[0], nx = b.st[1];
        if (nloc == 0u) { xcd_barrier_complete(bar, b.x, nloc, nx); b.st[0] = nloc; b.st[1] = nx; }
        const unsigned old = xb_add(&bar[XB_XSUB(b.x)], 1u);
        const unsigned gen = old / nloc;
        if (old + 1u == (gen + 1u) * nloc) {
            __builtin_amdgcn_fence(__ATOMIC_RELEASE, "agent");
            asm volatile("s_waitcnt vmcnt(0)" ::: "memory");
            const unsigned og = xb_add(&bar[XB_TOP], 1u);
            const unsigned tg = og / nx;
            if (og + 1u == (tg + 1u) * nx) xb_add(&bar[XB_TOPGEN], 1u);
            else XB_SPIN(xb_ld(&bar[XB_TOPGEN]) == tg, bar);
            __builtin_amdgcn_fence(__ATOMIC_ACQUIRE, "agent");
            xb_add(&bar[XB_XGEN(b.x)], 1u);
            asm volatile("s_waitcnt vmcnt(0)" ::: "memory");
        } else {
            XB_SPIN(xb_ld(&bar[XB_XGEN(b.x)]) == gen, bar);
            __builtin_amdgcn_fence(__ATOMIC_ACQUIRE, "agent");
            asm volatile("s_waitcnt vmcnt(0)" ::: "memory");
        }
    }
    __syncthreads();
}
__device__ __forceinline__ void phase_prep(const Params& p, unsigned char* lds, int bid, int nb) {
    const int tid = get_tid(), lane = tid & 63, wave = tid >> 6;
    unsigned char* ws = p.ws;
    float* mod = (float*)(ws + WS_MOD);
    if (bid < 192) {
        float* sc = (float*)lds;
        float* red = sc + 8 * 2048;
        for (int i = tid; i < 8 * 2048; i += NTHR) sc[i] = silu_f(p.c[i]);
        __syncthreads();
        for (int it = bid; it < 192; it += nb) {
            const int col = it * 64 + lane;
            float acc[8];
#pragma unroll
            for (int b = 0; b < 8; ++b) acc[b] = 0.f;
            const float* w = p.w_ada + (size_t)(wave * 256) * NMOD + col;
            const float* s0 = sc + wave * 256;
#pragma unroll 4
            for (int k = 0; k < 256; ++k) {
                const float wv = w[(size_t)k * NMOD];
#pragma unroll
                for (int b = 0; b < 8; ++b) acc[b] += s0[b * 2048 + k] * wv;
            }
#pragma unroll
            for (int b = 0; b < 8; ++b) red[(wave * 8 + b) * 64 + lane] = acc[b];
            __syncthreads();
            {   const int b = wave; float s = p.b_ada[col];
#pragma unroll
                for (int w2 = 0; w2 < 8; ++w2) s += red[(w2 * 8 + b) * 64 + lane];
                mod[b * NMOD + col] = s; }
            __syncthreads();
        }
    }
    __syncthreads();
    {
        float* tile = (float*)lds;
        bf16_t* WinT = (bf16_t*)(ws + WS_WINT); bf16_t* WoT = (bf16_t*)(ws + WS_WOT); bf16_t* WqT = (bf16_t*)(ws + WS_WQT);
        for (int item = bid; item < 5632; item += nb) {
            const float* src; int ld, scol; bf16_t* dst; int kt;
            if (item < 3584) { const int seg = item >> 9, rem = item & 511, ntile = rem >> 5; kt = rem & 31;
                src = p.w_in; ld = INCOLS; scol = (seg < 3 ? seg * 1024 : 3080 + (seg - 3) * 1024) + ntile * 64; dst = WinT + (size_t)(seg * 1024 + ntile * 64) * 2048; }
            else if (item < 4608) { const int rem = item - 3584, ntile = rem >> 5; kt = rem & 31; src = p.w_out; ld = 2048; scol = ntile * 64; dst = WoT + (size_t)(ntile * 64) * 2048; }
            else { const int rem = item - 4608, ntile = rem >> 5; kt = rem & 31; src = p.w_q; ld = 2048; scol = ntile * 64; dst = WqT + (size_t)(ntile * 64) * 2048; }
            const int k0 = kt * 64;
#pragma unroll
            for (int ii = 0; ii < 8; ++ii) { const int k = wave + 8 * ii; tile[k * 65 + lane] = src[(size_t)(k0 + k) * ld + scol + lane]; }
            __syncthreads();
#pragma unroll
            for (int ii = 0; ii < 8; ++ii) { const int n = wave + 8 * ii; dst[(size_t)n * 2048 + k0 + lane] = (bf16_t)(cvt_pk(tile[lane * 65 + n], 0.f) & 0xffffu); }
            __syncthreads();
        }
    }
    {
        bf16_t* Wg = (bf16_t*)(ws + WS_WG);
        for (int i = bid * NTHR + tid; i < 16 * 2048; i += nb * NTHR) { const int g = i >> 11, k = i & 2047; const int col = g < 8 ? 3072 + g : 7176 + (g - 8);
            Wg[i] = (bf16_t)(cvt_pk(p.w_in[(size_t)k * INCOLS + col], 0.f) & 0xffffu); }
    }
}

__device__ __forceinline__ unsigned pack4_fp8(const f32x4 a) { int t = __builtin_amdgcn_cvt_pk_fp8_f32(a[0], a[1], 0, false); t = __builtin_amdgcn_cvt_pk_fp8_f32(a[2], a[3], t, true); return (unsigned)t; }
__device__ __forceinline__ void convert_experts(const Params& p, int bid, int nb) {
    const int tid = get_tid(); unsigned char* ws = p.ws;
    unsigned char* E8D = ws + WS_E8D; unsigned char* E8US = ws + WS_E8U;
    {
        const int lane = tid & 63, wave = tid >> 6; float* DSC = (float*)(ws + WS_DSC);
        for (int e = bid * 8 + wave; e < 16384; e += nb * 8) {
            const float* rp = p.e_down + (size_t)e * 2048;
            f32x4 v[8]; float mx = 0.f;
#pragma unroll
            for (int hf = 0; hf < 2; ++hf)
#pragma unroll
                for (int q = 0; q < 4; ++q) { v[hf * 4 + q] = *(const f32x4*)(rp + hf * 1024 + 16 * lane + 4 * q);
#pragma unroll
                    for (int c = 0; c < 4; ++c) mx = fmaxf(mx, fabsf(v[hf * 4 + q][c])); }
            mx = fmaxf(wmax(mx), 1e-30f);
            const float inv = 127.f / mx;
            if (lane == 0) DSC[e] = mx * (1.f / 127.f);
#pragma unroll
            for (int hf = 0; hf < 2; ++hf) { u32x4 o;
#pragma unroll
                for (int q = 0; q < 4; ++q) { unsigned w = 0u;
#pragma unroll
                    for (int c = 0; c < 4; ++c) w |= ((unsigned)__float2int_rn(v[hf * 4 + q][c] * inv) & 0xffu) << (8 * c);
                    o[q] = w; }
                *(u32x4*)(E8D + (size_t)e * 2048 + hf * 1024 + 16 * lane) = o; }
        }
    }
    for (int i = bid * NTHR + tid; i < 524288; i += nb * NTHR) {
        const int s = i & 255, eg = i >> 8;
        const float* sp = p.e_up + (size_t)(eg * 8) * 2048 + 8 * s;
        unsigned w[16];
#pragma unroll
        for (int q = 0; q < 8; ++q) { const f32x4 a = *(const f32x4*)(sp + (size_t)q * 2048), b = *(const f32x4*)(sp + (size_t)q * 2048 + 4); w[2 * q] = pack4_fp8(a * 32.f); w[2 * q + 1] = pack4_fp8(b * 32.f); }
        u32x4* dp = (u32x4*)(E8US + ((size_t)s * 16384 + eg * 8) * 8);
#pragma unroll
        for (int q = 0; q < 4; ++q) { u32x4 o; o.x = w[4 * q]; o.y = w[4 * q + 1]; o.z = w[4 * q + 2]; o.w = w[4 * q + 3]; dp[q] = o; }
    }
}

template <bool GATES>
__device__ __forceinline__ void phase_norm(const float* xin, const float* gain, const float* mod, int shift_off, int scale_off, bf16_t* hout, const float* Wg, float* gate_out, int bid, int nb) {
    const int tid = get_tid(), lane = tid & 63, wave = tid >> 6;
    for (int row = bid * 8 + wave; row < T_; row += nb * 8) {
        const f32x4* xr = (const f32x4*)(xin + (size_t)row * D_);
        f32x4 v[8]; float ss = 0.f;
#pragma unroll
        for (int j = 0; j < 8; ++j) { v[j] = xr[lane + 64 * j]; ss += v[j][0] * v[j][0] + v[j][1] * v[j][1] + v[j][2] * v[j][2] + v[j][3] * v[j][3]; }
        ss = wsum(ss);
        const float r = rsqrtf(ss * (1.f / D_) + EPS_);
        const float* mb = mod + (size_t)(row >> 11) * NMOD;
        f32x4 hv[8];
#pragma unroll
        for (int j = 0; j < 8; ++j) {
            const int k = 4 * (lane + 64 * j);
            const f32x4 gn = *(const f32x4*)(gain + k), sh = *(const f32x4*)(mb + shift_off + k), scl = *(const f32x4*)(mb + scale_off + k);
#pragma unroll
            for (int e = 0; e < 4; ++e) hv[j][e] = (v[j][e] * r) * gn[e] * (1.f + scl[e]) + sh[e];
            u32x2 w; w.x = cvt_pk(hv[j][0], hv[j][1]); w.y = cvt_pk(hv[j][2], hv[j][3]);
            *(u32x2*)(hout + (size_t)row * D_ + k) = w;
        }
    }
}

__device__ __forceinline__ void phase_gates(const Params& p, unsigned char* lds, int bid, int nb) {
    const int tid = get_tid(), lane = tid & 63, wave = tid >> 6, r = lane & 31, hh = lane >> 5;
    unsigned char* ws = p.ws;
    const bf16_t* H = (const bf16_t*)(ws + WS_H); const bf16_t* Wg = (const bf16_t*)(ws + WS_WG); float* gate = (float*)(ws + WS_GATE);
    constexpr int WST = 4096 + 16;
    for (int i = tid; i < 16 * 256; i += NTHR) { const int g = i >> 8, c = i & 255; *(u32x4*)(lds + g * WST + c * 16) = *(const u32x4*)(Wg + (size_t)g * 2048 + c * 8); }
    __syncthreads();
    float* part = (float*)(lds + 16 * WST);
    for (int pr = bid; pr < T_ / 64; pr += nb) {
        const int t = pr * 64 + (wave >> 2) * 32 + r, kq = wave & 3;
        f32x16 acc;
#pragma unroll
        for (int i = 0; i < 16; ++i) acc[i] = 0.f;
        const bf16_t* hp = H + (size_t)t * D_ + kq * 512 + hh * 8; const unsigned char* wp = lds + (r & 15) * WST + kq * 1024 + hh * 16;
#pragma unroll 1
        for (int k0 = 0; k0 < 32; k0 += 16) {
            bf16x8 bfr[16];
#pragma unroll
            for (int j = 0; j < 16; ++j) bfr[j] = *(const bf16x8*)(hp + (k0 + j) * 16);
#pragma unroll
            for (int j = 0; j < 16; ++j) { bf16x8 a = *(const bf16x8*)(wp + (k0 + j) * 32); if (r >= 16) a = (bf16x8){0, 0, 0, 0, 0, 0, 0, 0};
                acc = __builtin_amdgcn_mfma_f32_32x32x16_bf16(a, bfr[j], acc, 0, 0, 0); }
        }
        __syncthreads();
#pragma unroll
        for (int i = 0; i < 8; ++i) part[(wave * 8 + i) * 64 + lane] = acc[i];
        __syncthreads();
        if (kq == 0) {
            float s[8];
#pragma unroll
            for (int i = 0; i < 8; ++i) s[i] = part[(wave * 8 + i) * 64 + lane] + part[((wave + 1) * 8 + i) * 64 + lane] + part[((wave + 2) * 8 + i) * 64 + lane] + part[((wave + 3) * 8 + i) * 64 + lane];
            f32x4 g0, g1; g0[0] = s[0]; g0[1] = s[1]; g0[2] = s[2]; g0[3] = s[3]; g1[0] = s[4]; g1[1] = s[5]; g1[2] = s[6]; g1[3] = s[7];
            *(f32x4*)(gate + (size_t)t * 16 + 4 * hh) = g0; *(f32x4*)(gate + (size_t)t * 16 + 8 + 4 * hh) = g1;
        }
    }
    __syncthreads();
}

__device__ __forceinline__ void phase_post(const Params& p, int bid, int nb) {
    const int tid = get_tid(), lane = tid & 63, wave = tid >> 6;
    unsigned char* ws = p.ws;
    bf16_t* Pq = (bf16_t*)(ws + WS_P); bf16_t* Pk = (bf16_t*)(ws + WS_P + SEG_B);
    const float qscale = 0.08838834764831845f * 1.4426950408889634f;
    for (int r = bid * 8 + wave; r < 2 * T_; r += nb * 8) {
        const int which = r >= T_ ? 1 : 0; const int t = r - which * T_;
        bf16_t* ptr = (which ? Pk : Pq) + (size_t)t * 1024 + lane * 16;
        const float* gn = (which ? p.fox_kg : p.fox_qg) + (lane & 7) * 16;
        u32x4 a = *(const u32x4*)ptr, b = *(const u32x4*)(ptr + 8);
        float f[16];
        f[0] = bflo(a.x); f[1] = bfhi(a.x); f[2] = bflo(a.y); f[3] = bfhi(a.y); f[4] = bflo(a.z); f[5] = bfhi(a.z); f[6] = bflo(a.w); f[7] = bfhi(a.w);
        f[8] = bflo(b.x); f[9] = bfhi(b.x); f[10] = bflo(b.y); f[11] = bfhi(b.y); f[12] = bflo(b.z); f[13] = bfhi(b.z); f[14] = bflo(b.w); f[15] = bfhi(b.w);
        float ss = 0.f;
#pragma unroll
        for (int i = 0; i < 16; ++i) ss += f[i] * f[i];
        ss += __shfl_xor(ss, 1); ss += __shfl_xor(ss, 2); ss += __shfl_xor(ss, 4);
        const float rr = rsqrtf(ss * (1.f / 128.f) + EPS_) * (which ? 1.f : qscale);
#pragma unroll
        for (int i = 0; i < 16; ++i) f[i] = (f[i] * rr) * gn[i];
        a.x = cvt_pk(f[0], f[1]); a.y = cvt_pk(f[2], f[3]); a.z = cvt_pk(f[4], f[5]); a.w = cvt_pk(f[6], f[7]);
        b.x = cvt_pk(f[8], f[9]); b.y = cvt_pk(f[10], f[11]); b.z = cvt_pk(f[12], f[13]); b.w = cvt_pk(f[14], f[15]);
        *(u32x4*)ptr = a; *(u32x4*)(ptr + 8) = b;
    }
    {
        const bf16_t* Mq = (const bf16_t*)(ws + WS_P + 3 * SEG_B); const bf16_t* Mk = (const bf16_t*)(ws + WS_P + 4 * SEG_B);
        bf16_t* QC = (bf16_t*)(ws + WS_QC); bf16_t* KC = (bf16_t*)(ws + WS_KC);
        for (int item = bid; item < 256; item += nb) {
            const int which = item >> 7, tb = item & 127, cg = tid & 127, run = tid >> 7, ch0 = cg * 8, ts = tb * 128 + run * 32, sp = ts & 2047;
            const bf16_t* src = (which ? Mk : Mq) + (size_t)ts * 1024 + ch0; bf16_t* dst = (which ? KC : QC) + (size_t)ts * 1024 + ch0;
            float w0[8], w1[8], w2[8], w3[8], cb[8], x0[8], x1[8], x2[8];
#pragma unroll
            for (int e = 0; e < 8; ++e) { const int ci = which * 1024 + ch0 + e; w0[e] = p.conv_w[ci]; w1[e] = p.conv_w[2048 + ci]; w2[e] = p.conv_w[4096 + ci]; w3[e] = p.conv_w[6144 + ci]; cb[e] = p.conv_b[ci]; }
            {   u32x4 a = {0u, 0u, 0u, 0u}, b = a, c = a;
                if (sp != 0) { a = *(const u32x4*)(src - 3 * 1024); b = *(const u32x4*)(src - 2 * 1024); c = *(const u32x4*)(src - 1024); }
#pragma unroll
                for (int e = 0; e < 4; ++e) { x0[2 * e] = bflo(a[e]); x0[2 * e + 1] = bfhi(a[e]); x1[2 * e] = bflo(b[e]); x1[2 * e + 1] = bfhi(b[e]); x2[2 * e] = bflo(c[e]); x2[2 * e + 1] = bfhi(c[e]); } }
            const float osc = which ? 0.0625f : 1.f;
            for (int s = 0; s < 32; ++s) {
                const u32x4 d = *(const u32x4*)(src + (size_t)s * 1024); float x3[8], y[8];
#pragma unroll
                for (int e = 0; e < 4; ++e) { x3[2 * e] = bflo(d[e]); x3[2 * e + 1] = bfhi(d[e]); }
#pragma unroll
                for (int e = 0; e < 8; ++e) { y[e] = silu_f(w0[e] * x0[e] + w1[e] * x1[e] + w2[e] * x2[e] + w3[e] * x3[e] + cb[e]) * osc; x0[e] = x1[e]; x1[e] = x2[e]; x2[e] = x3[e]; }
                u32x4 o; o.x = cvt_pk(y[0], y[1]); o.y = cvt_pk(y[2], y[3]); o.z = cvt_pk(y[4], y[5]); o.w = cvt_pk(y[6], y[7]);
                *(u32x4*)(dst + (size_t)s * 1024) = o;
            }
        }
    }
    const float* gate = (const float*)(ws + WS_GATE); float* F = (float*)(ws + WS_F);
    for (int sq = bid * 8 + wave; sq < 64; sq += nb * 8) {
        const int b = sq >> 3, h = sq & 7; const float fb = p.fox_fb[h];
        float v[32]; float run = 0.f;
#pragma unroll
        for (int i = 0; i < 32; ++i) { const int t = lane * 32 + i; run += logsig(gate[(size_t)(b * S_ + t) * 16 + h] + fb); v[i] = run; }
        float inc = run;
#pragma unroll
        for (int o = 1; o < 64; o <<= 1) { const float u = __shfl_up(inc, o); if (lane >= o) inc += u; }
        const float excl = inc - run;
#pragma unroll
        for (int i = 0; i < 32; ++i) F[(size_t)sq * S_ + lane * 32 + i] = (v[i] + excl) * 1.4426950408889634f;
    }
}
typedef short s16x4 __attribute__((ext_vector_type(4)));
__device__ __forceinline__ s16x4 lds_tr16(const unsigned char* p) { return __builtin_amdgcn_ds_read_tr16_b64_v4i16((LAS s16x4*)p); }
__device__ __forceinline__ bf16x8 tr_frag(const unsigned char* p0, int second_bytes) {
    const s16x4 a = lds_tr16(p0), b = lds_tr16(p0 + second_bytes);
    bf16x8 f; f[0] = a[0]; f[1] = a[1]; f[2] = a[2]; f[3] = a[3]; f[4] = b[0]; f[5] = b[1]; f[6] = b[2]; f[7] = b[3]; return f;
}
__device__ __forceinline__ void fox_unit(const Params& p, unsigned char* lds, int b, int h, int qb) {
    const int tid = get_tid(), lane = tid & 63, wave = tid >> 6, r = lane & 31, hh = lane >> 5, li = lane & 15;
    unsigned char* ws = p.ws;
    const bf16_t* Pq = (const bf16_t*)(ws + WS_P); const bf16_t* Pk = (const bf16_t*)(ws + WS_P + SEG_B); const bf16_t* Pv = (const bf16_t*)(ws + WS_P + 2 * SEG_B);
    const float* F = (const float*)(ws + WS_F) + (size_t)(b * 8 + h) * S_;
    bf16_t* Oc = (bf16_t*)(ws + WS_H);
    constexpr int KST = 272, VST = 544, BUF = 64 * KST + 64 * VST + 256;
    const int q0w = qb * 256 + wave * 32, qs = q0w + r; const int q0s = __builtin_amdgcn_readfirstlane(q0w);
    const size_t trow = (size_t)(b * S_ + qs);
    bf16x8 qf[8];
#pragma unroll
    for (int ks = 0; ks < 8; ++ks) qf[ks] = *(const bf16x8*)(Pq + trow * 1024 + h * 128 + ks * 16 + hh * 8);
    const float Fq = F[qs];
    f32x16 o[4];
#pragma unroll
    for (int d = 0; d < 4; ++d)
#pragma unroll
        for (int i = 0; i < 16; ++i) o[d][i] = 0.f;
    float m = -INFINITY, l = 0.f;
    const int ntile = (qb * 256 + 256) / 64;
    const int srow0 = tid >> 4, scc = tid & 15;
    const bf16_t* kg = Pk + (size_t)(b * S_ + srow0) * 1024 + h * 128 + scc * 8; const bf16_t* vg = Pv + (size_t)(b * S_ + srow0) * 1024 + h * 128 + scc * 8;
    u32x4 kr[2], vr[2]; float fr = 0.f;
    const int vb_off = 64 * KST + (4 * hh + (li >> 2)) * VST + (16 * (r >> 4) + 4 * (li & 3)) * 2;
    __syncthreads();
#pragma unroll
    for (int i = 0; i < 2; ++i) { kr[i] = *(const u32x4*)(kg + (size_t)(32 * i) * 1024); vr[i] = *(const u32x4*)(vg + (size_t)(32 * i) * 1024); }
    if (tid < 64) fr = F[tid];
#pragma unroll
    for (int i = 0; i < 2; ++i) { *(u32x4*)(lds + (srow0 + 32 * i) * KST + scc * 16) = kr[i]; *(u32x4*)(lds + 64 * KST + (srow0 + 32 * i) * VST + scc * 16) = vr[i]; }
    if (tid < 64) *(float*)(lds + 64 * KST + 64 * VST + tid * 4) = fr;
    __syncthreads();
    for (int kt = 0; kt < ntile; ++kt) {
        const int k0 = kt * 64; unsigned char* cur = lds + (kt & 1) * BUF; unsigned char* nxt = lds + ((kt & 1) ^ 1) * BUF;
        const bool more = kt + 1 < ntile;
        if (more) {
#pragma unroll
            for (int i = 0; i < 2; ++i) { kr[i] = *(const u32x4*)(kg + (size_t)(k0 + 64 + 32 * i) * 1024); vr[i] = *(const u32x4*)(vg + (size_t)(k0 + 64 + 32 * i) * 1024); }
            if (tid < 64) fr = F[k0 + 64 + tid];
        }
        if (k0 <= q0s + 31) {
            f32x16 s[2];
#pragma unroll
            for (int kb = 0; kb < 2; ++kb) {
#pragma unroll
                for (int i = 0; i < 16; ++i) s[kb][i] = 0.f;
#pragma unroll
                for (int ks = 0; ks < 8; ++ks) { const bf16x8 a = *(const bf16x8*)(cur + (kb * 32 + r) * KST + ks * 32 + hh * 16);
                    s[kb] = __builtin_amdgcn_mfma_f32_32x32x16_bf16(a, qf[ks], s[kb], 0, 0, 0); }
            }
            const float* Fs = (const float*)(cur + 64 * KST + 64 * VST);
            const bool need_mask = k0 + 63 > q0s;
            float mx = m;
#pragma unroll
            for (int kb = 0; kb < 2; ++kb)
#pragma unroll
                for (int g = 0; g < 4; ++g) { const f32x4 f4 = *(const f32x4*)(Fs + kb * 32 + 8 * g + 4 * hh);
#pragma unroll
                    for (int e = 0; e < 4; ++e) { float val = s[kb][4 * g + e] + (Fq - f4[e]);
                        if (need_mask && (k0 + kb * 32 + 8 * g + 4 * hh + e > qs)) val = -INFINITY;
                        s[kb][4 * g + e] = val; mx = fmaxf(mx, val); } }
            mx = fmaxf(mx, __shfl_xor(mx, 32));
            const float alpha = __builtin_amdgcn_exp2f(m - mx);
            float ps = 0.f;
#pragma unroll
            for (int kb = 0; kb < 2; ++kb)
#pragma unroll
                for (int i = 0; i < 16; ++i) { const float pv = __builtin_amdgcn_exp2f(s[kb][i] - mx); s[kb][i] = pv; ps += pv; }
            l = l * alpha + ps; m = mx;
#pragma unroll
            for (int d = 0; d < 4; ++d)
#pragma unroll
                for (int i = 0; i < 16; ++i) o[d][i] *= alpha;
#pragma unroll
            for (int kb = 0; kb < 2; ++kb)
#pragma unroll
                for (int st = 0; st < 2; ++st) {
                    u32x4 pw; pw.x = cvt_pk(s[kb][8 * st + 0], s[kb][8 * st + 1]); pw.y = cvt_pk(s[kb][8 * st + 2], s[kb][8 * st + 3]);
                    pw.z = cvt_pk(s[kb][8 * st + 4], s[kb][8 * st + 5]); pw.w = cvt_pk(s[kb][8 * st + 6], s[kb][8 * st + 7]);
                    const bf16x8 pf = __builtin_bit_cast(bf16x8, pw);
#pragma unroll
                    for (int d = 0; d < 4; ++d) { const bf16x8 vf = tr_frag(cur + vb_off + (kb * 32 + st * 16) * VST + d * 64, 8 * VST);
                        o[d] = __builtin_amdgcn_mfma_f32_32x32x16_bf16(vf, pf, o[d], 0, 0, 0); }
                }
        }
        if (more) {
#pragma unroll
            for (int i = 0; i < 2; ++i) { *(u32x4*)(nxt + (srow0 + 32 * i) * KST + scc * 16) = kr[i]; *(u32x4*)(nxt + 64 * KST + (srow0 + 32 * i) * VST + scc * 16) = vr[i]; }
            if (tid < 64) *(float*)(nxt + 64 * KST + 64 * VST + tid * 4) = fr;
        }
        __syncthreads();
    }
    l += __shfl_xor(l, 32);
    const float inv = 1.f / l;
#pragma unroll
    for (int d = 0; d < 4; ++d)
#pragma unroll
        for (int g = 0; g < 4; ++g) { u32x2 w; w.x = cvt_pk(o[d][4 * g] * inv, o[d][4 * g + 1] * inv); w.y = cvt_pk(o[d][4 * g + 2] * inv, o[d][4 * g + 3] * inv);
            *(u32x2*)(Oc + trow * D_ + h * 128 + d * 32 + 8 * g + 4 * hh) = w; }
}

__device__ __forceinline__ void mlstm_passA(const Params& p, unsigned char* lds, int unit) {
    const int tid = get_tid(), lane = tid & 63, wave = tid >> 6, r = lane & 31, hh = lane >> 5, li = lane & 15;
    const int b = unit >> 3, h = (unit >> 1) & 3, eh = unit & 1;
    unsigned char* ws = p.ws;
    const bf16_t* KC = (const bf16_t*)(ws + WS_KC); const bf16_t* Mv = (const bf16_t*)(ws + WS_P + 5 * SEG_B);
    const float* gate = (const float*)(ws + WS_GATE);
    bf16_t* Cst = (bf16_t*)(ws + WS_CST); float* nst = (float*)(ws + WS_NST); float* mst = (float*)(ws + WS_MST);
    constexpr int KST = 528, VST = 272;
    unsigned char* ksm = lds;
    unsigned char* vsm = ksm + 64 * KST;
    float* WSV = (float*)(vsm + 64 * VST);
    float* SCL = WSV + 2048;
    __syncthreads();
    for (int cc = wave; cc < 32; cc += 8) {
        const int t = b * S_ + cc * 64 + lane;
        const float ipre = gate[(size_t)t * 16 + 8 + h] + p.m_ib[h], fpre = gate[(size_t)t * 16 + 12 + h] + p.m_fb[h];
        float bc = logsig(fpre);
#pragma unroll
        for (int o = 1; o < 64; o <<= 1) { const float u = __shfl_up(bc, o); if (lane >= o) bc += u; }
        const float a = ipre - bc; const float amax = wmax(a); const float bL = __shfl(bc, 63);
        WSV[cc * 64 + lane] = a; if (lane == 0) { SCL[cc] = bL; SCL[32 + cc] = amax; }
    }
    __syncthreads();
    if (tid == 0) { float m = 0.f; for (int cc = 0; cc < 32; ++cc) { const float mn = SCL[cc] + fmaxf(m, SCL[32 + cc]); SCL[64 + cc] = expf(SCL[cc] + m - mn); SCL[96 + cc] = mn; if (eh == 0) mst[(b * 4 + h) * 32 + cc] = m; m = mn; } }
    __syncthreads();
    for (int i = tid; i < 2048; i += NTHR) { const int cc = i >> 6; WSV[i] = expf(SCL[cc] + WSV[i] - SCL[96 + cc]); }
    f32x16 acc[4];
#pragma unroll
    for (int et = 0; et < 4; ++et)
#pragma unroll
        for (int i = 0; i < 16; ++i) acc[et][i] = 0.f;
    float nreg = 0.f;
    const int kb_off = (8 * hh + (li >> 2)) * KST + (wave * 32 + 16 * (r >> 4) + 4 * (li & 3)) * 2;
    const int vb_off = (8 * hh + (li >> 2)) * VST + (16 * (r >> 4) + 4 * (li & 3)) * 2;
    for (int cc = 0; cc < 32; ++cc) {
        const int bhc = (b * 4 + h) * 32 + cc, t0 = b * S_ + cc * 64;
#pragma unroll
        for (int et = 0; et < 4; ++et)
#pragma unroll
            for (int i = 0; i < 16; ++i) Cst[((size_t)bhc * 256 + eh * 128 + et * 32 + (i & 3) + 8 * (i >> 2) + 4 * hh) * 256 + wave * 32 + r] = (bf16_t)(cvt_pk(acc[et][i], 0.f) & 0xffffu);
        if (eh == 0 && tid < 256) nst[(size_t)bhc * 256 + tid] = nreg;
        if (cc == 31) break;
        __syncthreads();
#pragma unroll
        for (int i = 0; i < 4; ++i) { const int c = tid + NTHR * i, row = c >> 5, c16 = c & 31;
            *(u32x4*)(ksm + row * KST + c16 * 16) = *(const u32x4*)(KC + (size_t)(t0 + row) * 1024 + h * 256 + c16 * 8); }
#pragma unroll
        for (int i = 0; i < 2; ++i) { const int c = tid + NTHR * i, row = c >> 4, c16 = c & 15; const float wv = WSV[cc * 64 + row];
            const u32x4 w = *(const u32x4*)(Mv + (size_t)(t0 + row) * 1024 + h * 256 + eh * 128 + c16 * 8);
            u32x4 o; o.x = cvt_pk(bflo(w.x) * wv, bfhi(w.x) * wv); o.y = cvt_pk(bflo(w.y) * wv, bfhi(w.y) * wv); o.z = cvt_pk(bflo(w.z) * wv, bfhi(w.z) * wv); o.w = cvt_pk(bflo(w.w) * wv, bfhi(w.w) * wv);
            *(u32x4*)(vsm + row * VST + c16 * 16) = o; }
        __syncthreads();
        const float decay = SCL[64 + cc];
        if (tid < 256) { float s = 0.f; for (int q = 0; q < 64; ++q) s += WSV[cc * 64 + q] * bf2f(*(const bf16_t*)(ksm + q * KST + tid * 2)); nreg = nreg * decay + s; }
#pragma unroll
        for (int et = 0; et < 4; ++et)
#pragma unroll
            for (int i = 0; i < 16; ++i) acc[et][i] *= decay;
#pragma unroll
        for (int ks = 0; ks < 4; ++ks) {
            const bf16x8 bfr = tr_frag(ksm + kb_off + ks * 16 * KST, 4 * KST);
#pragma unroll
            for (int et = 0; et < 4; ++et) { const bf16x8 afr = tr_frag(vsm + vb_off + ks * 16 * VST + et * 64, 4 * VST);
                acc[et] = __builtin_amdgcn_mfma_f32_32x32x16_bf16(afr, bfr, acc[et], 0, 0, 0); }
        }
    }
}

__device__ __forceinline__ void mlstm_passB(const Params& p, unsigned char* lds, int unit) {
    const int tid = get_tid(), lane = tid & 63, wave = tid >> 6, r = lane & 31, hh = lane >> 5, li = lane & 15;
    const int b = unit >> 7, h = (unit >> 5) & 3, cc = unit & 31;
    unsigned char* ws = p.ws;
    const bf16_t* QC = (const bf16_t*)(ws + WS_QC); const bf16_t* KC = (const bf16_t*)(ws + WS_KC);
    const bf16_t* Mv = (const bf16_t*)(ws + WS_P + 5 * SEG_B); const bf16_t* Mo = (const bf16_t*)(ws + WS_P + 6 * SEG_B);
    const float* gate = (const float*)(ws + WS_GATE);
    const bf16_t* Cst = (const bf16_t*)(ws + WS_CST); const float* nst = (const float*)(ws + WS_NST); const float* mst = (const float*)(ws + WS_MST);
    bf16_t* Oc = (bf16_t*)(ws + WS_H);
    constexpr int QST = 528, VST = 544, WST = 144, HST = 1040;
    unsigned char* qsm = lds;
    unsigned char* ksm = qsm + 64 * QST;
    unsigned char* vsm = ksm + 64 * QST;
    unsigned char* wsm = vsm + 64 * VST;
    float* sc = (float*)(wsm + 64 * WST);
    float* hsm = (float*)lds;
    const int bhc = (b * 4 + h) * 32 + cc, t0 = b * S_ + cc * 64;
    __syncthreads();
    if (wave == 0) {
        const float ipre = gate[(size_t)(t0 + lane) * 16 + 8 + h] + p.m_ib[h], fpre = gate[(size_t)(t0 + lane) * 16 + 12 + h] + p.m_fb[h];
        float bc = logsig(fpre);
#pragma unroll
        for (int o = 1; o < 64; o <<= 1) { const float u = __shfl_up(bc, o); if (lane >= o) bc += u; }
        const float a = ipre - bc; float pm = a;
#pragma unroll
        for (int o = 1; o < 64; o <<= 1) { const float u = __shfl_up(pm, o); if (lane >= o) pm = fmaxf(pm, u); }
        const float mc = mst[bhc]; const float mt = bc + fmaxf(mc, pm);
        sc[lane] = bc - mt; sc[64 + lane] = a; sc[128 + lane] = mt; sc[192 + lane] = expf(bc + mc - mt);
    }
    bf16x8 cfr[16];
#pragma unroll
    for (int ks = 0; ks < 16; ++ks) cfr[ks] = *(const bf16x8*)(Cst + ((size_t)bhc * 256 + wave * 32 + r) * 256 + ks * 16 + hh * 8);
#pragma unroll
    for (int i = 0; i < 4; ++i) { const int c = tid + NTHR * i, row = c >> 5, c16 = c & 31;
        *(u32x4*)(qsm + row * QST + c16 * 16) = *(const u32x4*)(QC + (size_t)(t0 + row) * 1024 + h * 256 + c16 * 8);
        *(u32x4*)(ksm + row * QST + c16 * 16) = *(const u32x4*)(KC + (size_t)(t0 + row) * 1024 + h * 256 + c16 * 8);
        *(u32x4*)(vsm + row * VST + c16 * 16) = *(const u32x4*)(Mv + (size_t)(t0 + row) * 1024 + h * 256 + c16 * 8); }
    __syncthreads();
    if (wave < 3) {
        const int sb = wave >> 1, lb = wave ? 1 : 0;
        f32x16 s;
#pragma unroll
        for (int i = 0; i < 16; ++i) s[i] = 0.f;
#pragma unroll
        for (int ks = 0; ks < 16; ++ks) { const bf16x8 a = *(const bf16x8*)(ksm + (sb * 32 + r) * QST + ks * 32 + hh * 16), q = *(const bf16x8*)(qsm + (lb * 32 + r) * QST + ks * 32 + hh * 16);
            s = __builtin_amdgcn_mfma_f32_32x32x16_bf16(a, q, s, 0, 0, 0); }
        const int l = lb * 32 + r; const float bl = sc[l]; float rs = 0.f;
#pragma unroll
        for (int g = 0; g < 4; ++g) { float w[4];
#pragma unroll
            for (int e = 0; e < 4; ++e) { const int sI = sb * 32 + 8 * g + 4 * hh + e; w[e] = (sI <= l) ? s[4 * g + e] * __expf(bl + sc[64 + sI]) : 0.f; rs += w[e]; }
            u32x2 o; o.x = cvt_pk(w[0], w[1]); o.y = cvt_pk(w[2], w[3]);
            *(u32x2*)(wsm + l * WST + (sb * 32 + 8 * g + 4 * hh) * 2) = o; }
        sc[256 + l * 4 + sb * 2 + hh] = rs;
    } else if (wave == 3) {
        const int l = r;
#pragma unroll
        for (int g = 0; g < 4; ++g) { u32x2 o; o.x = 0u; o.y = 0u; *(u32x2*)(wsm + l * WST + (32 + 8 * g + 4 * hh) * 2) = o; }
        sc[256 + l * 4 + 2 + hh] = 0.f;
    }
    {
        const int l = tid & 63, part = tid >> 6; const float* np = nst + (size_t)bhc * 256 + part * 32; float s = 0.f;
#pragma unroll
        for (int q = 0; q < 4; ++q) { const u32x4 w = *(const u32x4*)(qsm + l * QST + part * 64 + q * 16);
            s += bflo(w.x) * np[8 * q] + bfhi(w.x) * np[8 * q + 1] + bflo(w.y) * np[8 * q + 2] + bfhi(w.y) * np[8 * q + 3] + bflo(w.z) * np[8 * q + 4] + bfhi(w.z) * np[8 * q + 5] + bflo(w.w) * np[8 * q + 6] + bfhi(w.w) * np[8 * q + 7]; }
        sc[512 + l * 8 + part] = s;
    }
    f32x16 acc[2];
#pragma unroll
    for (int lb = 0; lb < 2; ++lb)
#pragma unroll
        for (int i = 0; i < 16; ++i) acc[lb][i] = 0.f;
#pragma unroll
    for (int ks = 0; ks < 16; ++ks)
#pragma unroll
        for (int lb = 0; lb < 2; ++lb) { const bf16x8 q = *(const bf16x8*)(qsm + (lb * 32 + r) * QST + ks * 32 + hh * 16);
            acc[lb] = __builtin_amdgcn_mfma_f32_32x32x16_bf16(cfr[ks], q, acc[lb], 0, 0, 0); }
    __syncthreads();
#pragma unroll
    for (int lb = 0; lb < 2; ++lb) { const float it = sc[192 + lb * 32 + r];
#pragma unroll
        for (int i = 0; i < 16; ++i) acc[lb][i] *= it; }
    const int vb_off = (8 * hh + (li >> 2)) * VST + (wave * 32 + 16 * (r >> 4) + 4 * (li & 3)) * 2;
#pragma unroll
    for (int ks = 0; ks < 4; ++ks) { const bf16x8 afr = tr_frag(vsm + vb_off + ks * 16 * VST, 4 * VST);
#pragma unroll
        for (int lb = 0; lb < 2; ++lb) { if (lb == 0 && ks >= 2) continue;
            const bf16x8 wf = *(const bf16x8*)(wsm + (lb * 32 + r) * WST + ks * 32 + hh * 16);
            acc[lb] = __builtin_amdgcn_mfma_f32_32x32x16_bf16(afr, wf, acc[lb], 0, 0, 0); } }
    float ssq[2];
#pragma unroll
    for (int lb = 0; lb < 2; ++lb) { const int l = lb * 32 + r;
        const f32x4 rsv = *(const f32x4*)(sc + 256 + l * 4); const f32x4 q0 = *(const f32x4*)(sc + 512 + l * 8), q1 = *(const f32x4*)(sc + 512 + l * 8 + 4);
        const float den = (rsv[0] + rsv[1] + rsv[2] + rsv[3]) + sc[192 + l] * ((q0[0] + q0[1] + q0[2] + q0[3]) + (q1[0] + q1[1] + q1[2] + q1[3]));
        const float inv = 1.f / fmaxf(fabsf(den), __expf(-sc[128 + l]));
        float s2 = 0.f;
#pragma unroll
        for (int i = 0; i < 16; ++i) { acc[lb][i] *= inv; s2 += acc[lb][i] * acc[lb][i]; }
        s2 += __shfl_xor(s2, 32); ssq[lb] = s2; }
    __syncthreads();
    if (hh == 0) { sc[1024 + r * 8 + wave] = ssq[0]; sc[1024 + (32 + r) * 8 + wave] = ssq[1]; }
#pragma unroll
    for (int lb = 0; lb < 2; ++lb)
#pragma unroll
        for (int g = 0; g < 4; ++g) { f32x4 v; v[0] = acc[lb][4 * g]; v[1] = acc[lb][4 * g + 1]; v[2] = acc[lb][4 * g + 2]; v[3] = acc[lb][4 * g + 3];
            *(f32x4*)((unsigned char*)hsm + (lb * 32 + r) * HST + (wave * 32 + 8 * g + 4 * hh) * 4) = v; }
    __syncthreads();
#pragma unroll
    for (int i = 0; i < 4; ++i) { const int c = tid + NTHR * i, l = c >> 5, e0 = (c & 31) * 8;
        const f32x4 s0 = *(const f32x4*)(sc + 1024 + l * 8), s1 = *(const f32x4*)(sc + 1024 + l * 8 + 4);
        const float rr = rsqrtf(((s0[0] + s0[1] + s0[2] + s0[3]) + (s1[0] + s1[1] + s1[2] + s1[3])) * (1.f / 256.f) + EPS_);
        const f32x4 h0 = *(const f32x4*)((unsigned char*)hsm + l * HST + e0 * 4), h1 = *(const f32x4*)((unsigned char*)hsm + l * HST + e0 * 4 + 16);
        const f32x4 g0 = *(const f32x4*)(p.m_hg + h * 256 + e0), g1 = *(const f32x4*)(p.m_hg + h * 256 + e0 + 4);
        const u32x4 mo = *(const u32x4*)(Mo + (size_t)(t0 + l) * 1024 + h * 256 + e0);
        u32x4 o;
        o.x = cvt_pk(h0[0] * rr * g0[0] * sigm(bflo(mo.x)), h0[1] * rr * g0[1] * sigm(bfhi(mo.x))); o.y = cvt_pk(h0[2] * rr * g0[2] * sigm(bflo(mo.y)), h0[3] * rr * g0[3] * sigm(bfhi(mo.y)));
        o.z = cvt_pk(h1[0] * rr * g1[0] * sigm(bflo(mo.z)), h1[1] * rr * g1[1] * sigm(bfhi(mo.z))); o.w = cvt_pk(h1[2] * rr * g1[2] * sigm(bflo(mo.w)), h1[3] * rr * g1[3] * sigm(bfhi(mo.w)));
        *(u32x4*)(Oc + (size_t)(t0 + l) * D_ + 1024 + h * 256 + e0) = o; }
}

__device__ __forceinline__ void ce_desc(float& a, float& b) { const float hi = fmaxf(a, b), lo = fminf(a, b); a = hi; b = lo; }
__device__ __forceinline__ void sort16_desc(float (&v)[16]) {
#pragma unroll
    for (int k = 2; k <= 16; k <<= 1)
#pragma unroll
        for (int j = k >> 1; j > 0; j >>= 1)
#pragma unroll
            for (int i = 0; i < 16; ++i) { const int l = i ^ j; if (l > i) { if ((i & k) == 0) ce_desc(v[i], v[l]); else ce_desc(v[l], v[i]); } }
}
__device__ __forceinline__ void bmerge16_desc(float (&v)[16]) {
#pragma unroll
    for (int j = 8; j > 0; j >>= 1)
#pragma unroll
        for (int i = 0; i < 16; ++i) { const int l = i ^ j; if (l > i) ce_desc(v[i], v[l]); }
}
__device__ __forceinline__ void merge_top16(float (&a)[16], const float (&b)[16]) {
#pragma unroll
    for (int i = 0; i < 16; ++i) a[i] = fmaxf(a[i], b[15 - i]);
    bmerge16_desc(a);
}
__device__ __forceinline__ float pack_idx(float v, unsigned mask, unsigned idx) { return __builtin_bit_cast(float, (__builtin_bit_cast(unsigned, v) & mask) | idx); }
__device__ __forceinline__ void top16_from_acc(const f32x16 (&acc)[4], int h, float (&out)[16]) {
    float g[4][16];
#pragma unroll
    for (int mt = 0; mt < 4; ++mt) {
#pragma unroll
        for (int i = 0; i < 16; ++i) g[mt][i] = pack_idx(acc[mt][i], 0xffffff80u, (unsigned)(32 * mt + (i & 3) + 8 * (i >> 2)) | ((unsigned)h << 2));
        sort16_desc(g[mt]);
    }
    merge_top16(g[0], g[1]); merge_top16(g[2], g[3]); merge_top16(g[0], g[2]);
    float o[16];
#pragma unroll
    for (int i = 0; i < 16; ++i) o[i] = __shfl_xor(g[0][i], 32);
    merge_top16(g[0], o);
#pragma unroll
    for (int i = 0; i < 16; ++i) out[i] = g[0][i];
}
__device__ __forceinline__ unsigned lut16(const unsigned (&P)[4], unsigned i) {
    const unsigned long long lo = (unsigned long long)P[0] | ((unsigned long long)P[1] << 32), hi = (unsigned long long)P[2] | ((unsigned long long)P[3] << 32);
    const unsigned long long s = (i & 8u) ? hi : lo;
    return (unsigned)(s >> ((i & 7u) * 8u)) & 0xffu;
}
struct CandTab { int i[50]; int j[50]; };
constexpr CandTab make_cand_tab() { CandTab t{}; int n = 0; for (int i = 0; i < 16; ++i) for (int j = 0; j < 16; ++j) if ((i + 1) * (j + 1) <= 16) { t.i[n] = i; t.j[n] = j; ++n; } return t; }
__device__ __forceinline__ void phase_topk(const Params& p, unsigned char* lds, int bid, int nb) {
    const int tid = get_tid(), lane = tid & 63, wave = tid >> 6, r = lane & 31, h = lane >> 5;
    unsigned char* ws = p.ws;
    const bf16_t* Q = (const bf16_t*)(ws + WS_Q); int* IDX = (int*)(ws + WS_IDX); float* GW = (float*)(ws + WS_GW);
    constexpr int KP = 136;
    bf16_t* KS = (bf16_t*)lds;
    for (int i = tid; i < 2 * 16384; i += NTHR) { const int which = i >> 14, n = (i >> 7) & 127, d = i & 127; const float v = (which ? p.sk2 : p.sk1)[i & 16383];
        const unsigned hb = cvt_pk(v, 0.f) & 0xffffu; const float lo = v - bf2f((bf16_t)hb);
        KS[((which * 2 + 0) * 128 + n) * KP + d] = (bf16_t)hb; KS[((which * 2 + 1) * 128 + n) * KP + d] = (bf16_t)(cvt_pk(lo, 0.f) & 0xffffu); }
    __syncthreads();
    for (int item = bid * 8 + wave; item < 512 * 8; item += nb * 8) {
        const int tt = item >> 3, hh = item & 7, t = tt * 32 + r;
        float top[2][16];
#pragma unroll
        for (int list = 0; list < 2; ++list) {
            bf16x8 qf[8];
#pragma unroll
            for (int ks = 0; ks < 8; ++ks) qf[ks] = *(const bf16x8*)(Q + (size_t)t * D_ + hh * 256 + list * 128 + ks * 16 + h * 8);
            float g[4][16];
#pragma unroll
            for (int mt = 0; mt < 4; ++mt) {
                f32x16 acc;
#pragma unroll
                for (int i = 0; i < 16; ++i) acc[i] = 0.f;
#pragma unroll
                for (int hl = 0; hl < 2; ++hl)
#pragma unroll
                    for (int ks = 0; ks < 8; ++ks) { const bf16x8 a = *(const bf16x8*)(KS + ((list * 2 + hl) * 128 + mt * 32 + r) * KP + ks * 16 + h * 8);
                        acc = __builtin_amdgcn_mfma_f32_32x32x16_bf16(a, qf[ks], acc, 0, 0, 0); }
#pragma unroll
                for (int i = 0; i < 16; ++i) g[mt][i] = pack_idx(acc[i], 0xffffff80u, (unsigned)(32 * mt + (i & 3) + 8 * (i >> 2)) | ((unsigned)h << 2));
                sort16_desc(g[mt]);
                __builtin_amdgcn_sched_barrier(0);
            }
            merge_top16(g[0], g[1]); merge_top16(g[2], g[3]); merge_top16(g[0], g[2]);
            {   float o[16];
#pragma unroll
                for (int i = 0; i < 16; ++i) o[i] = __shfl_xor(g[0][i], 32);
                merge_top16(g[0], o); }
#pragma unroll
            for (int i = 0; i < 16; ++i) top[list][i] = g[0][i];
            __builtin_amdgcn_sched_barrier(0);
        }
        unsigned P1[4], P2[4];
#pragma unroll
        for (int q = 0; q < 4; ++q) { P1[q] = 0u; P2[q] = 0u;
#pragma unroll
            for (int e = 0; e < 4; ++e) { P1[q] |= (__builtin_bit_cast(unsigned, top[0][4 * q + e]) & 127u) << (8 * e); P2[q] |= (__builtin_bit_cast(unsigned, top[1][4 * q + e]) & 127u) << (8 * e); } }
        float c[4][16];
#pragma unroll
        for (int n = 0; n < 64; ++n) {
            if (n < 50) { constexpr CandTab CT = make_cand_tab(); const int i = CT.i[n], j = CT.j[n];
                c[n >> 4][n & 15] = pack_idx(top[0][i] + top[1][j], 0xffffff00u, (unsigned)(i * 16 + j)); }
            else c[n >> 4][n & 15] = -INFINITY;
        }
        sort16_desc(c[0]); __builtin_amdgcn_sched_barrier(0); sort16_desc(c[1]); __builtin_amdgcn_sched_barrier(0); merge_top16(c[0], c[1]); __builtin_amdgcn_sched_barrier(0);
        sort16_desc(c[2]); __builtin_amdgcn_sched_barrier(0); sort16_desc(c[3]); __builtin_amdgcn_sched_barrier(0); merge_top16(c[2], c[3]); __builtin_amdgcn_sched_barrier(0); merge_top16(c[0], c[2]);
        float ex[16], sum = 0.f;
#pragma unroll
        for (int k = 0; k < 16; ++k) { ex[k] = __expf(c[0][k] - c[0][0]); sum += ex[k]; }
        const float inv = 1.f / sum;
        if (h == 0) {
            int* ip = IDX + (size_t)t * 128 + hh * 16; float* gp = GW + (size_t)t * 128 + hh * 16;
#pragma unroll
            for (int q = 0; q < 4; ++q) { u32x4 iv; f32x4 gv;
#pragma unroll
                for (int e = 0; e < 4; ++e) { const unsigned pos = __builtin_bit_cast(unsigned, c[0][4 * q + e]) & 255u;
                    iv[e] = lut16(P1, pos >> 4) * 128u + lut16(P2, pos & 15u); gv[e] = ex[4 * q + e] * inv; }
                *(u32x4*)(ip + 4 * q) = iv; *(f32x4*)(gp + 4 * q) = gv; }
        }
    }
}

typedef float f32x2 __attribute__((ext_vector_type(2)));
__device__ __forceinline__ float dot16_fp8(const u32x4 w, const float (&h)[32], int o) {
    float s = 0.f;
#pragma unroll
    for (int q = 0; q < 4; ++q) { const f32x2 lo = __builtin_amdgcn_cvt_pk_f32_fp8((int)w[q], false), hi = __builtin_amdgcn_cvt_pk_f32_fp8((int)w[q], true);
        fmac(s, lo[0], h[o + 4 * q]); fmac(s, lo[1], h[o + 4 * q + 1]); fmac(s, hi[0], h[o + 4 * q + 2]); fmac(s, hi[1], h[o + 4 * q + 3]); }
    return s;
}
template <int CTRL, int ROW_MASK, int BANK_MASK>
__device__ __forceinline__ int dpp_mov0i(int v) { return __builtin_amdgcn_update_dpp(0, v, CTRL, ROW_MASK, BANK_MASK, true); }
__device__ __forceinline__ void phase_peer1(const Params& p, unsigned char* lds, int bid, int nb, int probe) {
    const int tid = get_tid(), lane = tid & 63, wave = tid >> 6, r = lane >> 4, c16 = lane & 15;
    unsigned char* ws = p.ws;
    const bf16_t* H2 = (const bf16_t*)(ws + WS_H2); const int* IDX = (const int*)(ws + WS_IDX); const float* GW = (const float*)(ws + WS_GW);
    unsigned* EWT = (unsigned*)(ws + WS_EWT); const float* DSC = (const float*)(ws + WS_DSC);
    const unsigned char* E8D = ws + WS_E8D + 16 * c16; const unsigned emask = probe ? 0x3ffu : 0x3fffu;
    LAS unsigned* seq = (LAS unsigned*)((LAS unsigned char*)lds + wave * 2048 + r * 512);
    LAS unsigned* hist = (LAS unsigned*)((LAS unsigned char*)lds + 16384 + wave * 256 + r * 64);
    for (int tile = bid; tile < 256; tile += nb)
        for (int ps = 0; ps < 2; ++ps) {
            const int t = tile * 64 + ps * 32 + wave * 4 + r;
            unsigned hq[32]; float hsc;
            {   float mx = 0.f; u32x4 raw[16];
#pragma unroll
                for (int q = 0; q < 8; ++q) { raw[2 * q] = *(const u32x4*)(H2 + (size_t)t * D_ + 256 * q + 16 * c16); raw[2 * q + 1] = *(const u32x4*)(H2 + (size_t)t * D_ + 256 * q + 16 * c16 + 8); }
#pragma unroll
                for (int i = 0; i < 16; ++i)
#pragma unroll
                    for (int e = 0; e < 4; ++e) mx = fmaxf(mx, fmaxf(fabsf(bflo(raw[i][e])), fabsf(bfhi(raw[i][e]))));
                mx = fmaxf(mx, __shfl_xor(mx, 1)); mx = fmaxf(mx, __shfl_xor(mx, 2)); mx = fmaxf(mx, __shfl_xor(mx, 4)); mx = fmaxf(mx, __shfl_xor(mx, 8));
                mx = fmaxf(mx, 1e-30f); const float inv = 127.f / mx; hsc = mx * (1.f / 127.f);
#pragma unroll
                for (int i = 0; i < 16; ++i)
#pragma unroll
                    for (int hh = 0; hh < 2; ++hh) {
                        const unsigned w0 = raw[i][2 * hh], w1 = raw[i][2 * hh + 1];
                        hq[2 * i + hh] = ((unsigned)__float2int_rn(bflo(w0) * inv) & 0xffu) | (((unsigned)__float2int_rn(bfhi(w0) * inv) & 0xffu) << 8) | (((unsigned)__float2int_rn(bflo(w1) * inv) & 0xffu) << 16) | (((unsigned)__float2int_rn(bfhi(w1) * inv) & 0xffu) << 24); }
            }
            int idx[8]; unsigned pos[8];
#pragma unroll
            for (int m = 0; m < 8; ++m) idx[m] = IDX[(size_t)t * 128 + c16 + 16 * m];
            hist[c16] = 0u;
#pragma unroll
            for (int m = 0; m < 8; ++m) pos[m] = __hip_atomic_fetch_add(&hist[idx[m] >> 10], 1u, __ATOMIC_RELAXED, __HIP_MEMORY_SCOPE_WORKGROUP);
            {   const unsigned c = hist[c16]; unsigned inc = c;
#pragma unroll
                for (int o = 1; o < 16; o <<= 1) { const unsigned u = __shfl_up(inc, o, 16); if (c16 >= o) inc += u; }
                hist[c16] = inc - c; }
#pragma unroll
            for (int m = 0; m < 8; ++m) { pos[m] += hist[idx[m] >> 10]; seq[pos[m]] = (unsigned)idx[m] | ((unsigned)(c16 + 16 * m) << 14); }
            u32x4 cur[8], nxt[8];
            {   const unsigned char* rp = E8D + (size_t)(seq[0] & emask) * 2048;
#pragma unroll
                for (int q = 0; q < 8; ++q) cur[q] = *(const u32x4*)(rp + 256 * q); }
            for (int s = 0; s < 128; ++s) {
                if (s + 1 < 128) { const unsigned char* rp = E8D + (size_t)(seq[s + 1] & emask) * 2048;
#pragma unroll
                    for (int q = 0; q < 8; ++q) nxt[q] = *(const u32x4*)(rp + 256 * q); }
                int d0 = 0, d1 = 0;
#pragma unroll
                for (int q = 0; q < 8; ++q) { d0 = __builtin_amdgcn_sdot4((int)cur[q][0], (int)hq[4 * q], d0, false); d1 = __builtin_amdgcn_sdot4((int)cur[q][1], (int)hq[4 * q + 1], d1, false);
                    d0 = __builtin_amdgcn_sdot4((int)cur[q][2], (int)hq[4 * q + 2], d0, false); d1 = __builtin_amdgcn_sdot4((int)cur[q][3], (int)hq[4 * q + 3], d1, false); }
                int d = d0 + d1;
                d += dpp_mov0i<0x111, 0xf, 0xf>(d); d += dpp_mov0i<0x112, 0xf, 0xf>(d); d += dpp_mov0i<0x114, 0xf, 0xe>(d); d += dpp_mov0i<0x118, 0xf, 0xc>(d);
                if (c16 == 15) seq[s] = (unsigned)d;
#pragma unroll
                for (int q = 0; q < 8; ++q) cur[q] = nxt[q];
            }
            if (probe) continue;
            unsigned* ep = EWT + (size_t)(t >> 6) * 8192 + (t & 63) * 4;
#pragma unroll
            for (int m = 0; m < 8; ++m) { const int j = c16 + 16 * m;
                const float a = (float)(int)seq[pos[m]] * hsc * DSC[idx[m]];
                const float w = GW[(size_t)t * 128 + j] * 0.5f * a * (1.f + erff(a * 0.7071067811865476f));
                ep[(j >> 2) * 256 + (j & 3)] = (cvt_pk(0.f, w) & 0xffff0000u) | (unsigned)idx[m]; }
        }
}
__device__ __forceinline__ void phase_peer2(const Params& p, unsigned char* lds, int bid, int nb) {
    const int tid = get_tid(), lane = tid & 63, wave = tid >> 6;
    unsigned char* ws = p.ws;
    const unsigned* EWT = (const unsigned*)(ws + WS_EWT); const float* X1 = (const float*)(ws + WS_X1); const float* mod = (const float*)(ws + WS_MOD);
    for (int si = bid; si < 256; si += nb) {
        const int s = (si & 7) * 32 + (si >> 3);
        __syncthreads();
        {   const u32x4* sp = (const u32x4*)(ws + WS_E8U + (size_t)s * 131072);
#pragma unroll
            for (int i = 0; i < 16; ++i) ((u32x4*)lds)[tid + NTHR * i] = sp[tid + NTHR * i]; }
        __syncthreads();
        const int tb0 = ((si >> 5) * 32 + wave) & 255;
        unsigned cur[16], nxt[16];
        {   const u32x4* wp = (const u32x4*)(EWT + (size_t)tb0 * 8192) + lane;
#pragma unroll
            for (int u = 0; u < 4; ++u) { const u32x4 v = wp[u * 64]; cur[4 * u] = v.x; cur[4 * u + 1] = v.y; cur[4 * u + 2] = v.z; cur[4 * u + 3] = v.w; } }
        float acc[8];
#pragma unroll
        for (int c = 0; c < 8; ++c) acc[c] = 0.f;
        f32x4 xa = {0.f, 0.f, 0.f, 0.f}, xb = xa;
        for (int q = 0; q < 256; ++q) {
            const int tb = (tb0 + 8 * (q >> 3)) & 255, g = q & 7;
            if (q + 1 < 256) { const int tbn = (tb0 + 8 * ((q + 1) >> 3)) & 255; const u32x4* wp = (const u32x4*)(EWT + (size_t)tbn * 8192 + ((q + 1) & 7) * 1024) + lane;
#pragma unroll
                for (int u = 0; u < 4; ++u) { const u32x4 v = wp[u * 64]; nxt[4 * u] = v.x; nxt[4 * u + 1] = v.y; nxt[4 * u + 2] = v.z; nxt[4 * u + 3] = v.w; } }
            const int t = tb * 64 + lane;
            if (g == 0) { xa = *(const f32x4*)(X1 + (size_t)t * D_ + 8 * s); xb = *(const f32x4*)(X1 + (size_t)t * D_ + 8 * s + 4); }
            u32x2 row[16];
#pragma unroll
            for (int u = 0; u < 16; ++u) row[u] = *(const LAS u32x2*)(unsigned)((cur[u] << 3) & 0x1fff8u);
#pragma unroll
            for (int u = 0; u < 16; ++u) {
                const float w = __builtin_bit_cast(float, cur[u]);
                const f32x2 v0 = __builtin_amdgcn_cvt_pk_f32_fp8((int)row[u].x, false), v1 = __builtin_amdgcn_cvt_pk_f32_fp8((int)row[u].x, true), v2 = __builtin_amdgcn_cvt_pk_f32_fp8((int)row[u].y, false), v3 = __builtin_amdgcn_cvt_pk_f32_fp8((int)row[u].y, true);
                fmac(acc[0], w, v0[0]); fmac(acc[1], w, v0[1]); fmac(acc[2], w, v1[0]); fmac(acc[3], w, v1[1]); fmac(acc[4], w, v2[0]); fmac(acc[5], w, v2[1]); fmac(acc[6], w, v3[0]); fmac(acc[7], w, v3[1]);
            }
            if (g == 7) {
                const float* g2 = mod + (size_t)(t >> 11) * NMOD + 5 * D_ + 8 * s;
                const f32x4 ga = *(const f32x4*)g2, gb = *(const f32x4*)(g2 + 4);
                f32x4 oa, ob;
#pragma unroll
                for (int c = 0; c < 4; ++c) { oa[c] = xa[c] + ga[c] * acc[c] * (1.f / 32.f); ob[c] = xb[c] + gb[c] * acc[4 + c] * (1.f / 32.f); }
                *(f32x4*)(p.out + (size_t)t * D_ + 8 * s) = oa; *(f32x4*)(p.out + (size_t)t * D_ + 8 * s + 4) = ob;
#pragma unroll
                for (int c = 0; c < 8; ++c) acc[c] = 0.f;
            }
#pragma unroll
            for (int u = 0; u < 16; ++u) cur[u] = nxt[u];
        }
    }
}

typedef const __attribute__((address_space(4))) Params* KargPtr;
__device__ __forceinline__ Params load_params() {
#if defined(__HIP_DEVICE_COMPILE__)
    KargPtr kp = (KargPtr)__builtin_amdgcn_kernarg_segment_ptr(); asm volatile("" : "+s"(kp)); Params r; __builtin_memcpy(&r, kp, sizeof(Params)); return r;
#else
    return Params{};
#endif
}
constexpr int N_PHASES = 12;
constexpr int LDS_BYTES = 152 * 1024;
__global__ void __launch_bounds__(NTHR) fwd_kernel(Params p_arg) {
    extern __shared__ __attribute__((aligned(16))) unsigned char lds[];
    const int bid = blockIdx.x, nb = gridDim.x, tid = get_tid();
    unsigned char* ws = p_arg.ws;
    volatile LAS unsigned* xbst = (volatile LAS unsigned*)((LAS unsigned char*)lds + LDS_BYTES - 16);
    if (tid == 0) { xbst[0] = 0u; xbst[1] = 0u; xbst[2] = 0u; xbst[3] = 0u; }
    __syncthreads();
    if ((p_arg.ph_hi - p_arg.ph_lo) > 1) (void)xcd_barrier_post((unsigned*)(ws + WS_BAR), xbst);
#ifdef ONLY_PHASE
#define IN(k) ((k) == ONLY_PHASE && p.ph_lo <= (k) && (k) < p.ph_hi)
#else
#define IN(k) (p.ph_lo <= (k) && (k) < p.ph_hi)
#endif
#define SEAM(k) do { const Params p = load_params(); if (p.ph_lo <= (k) && (k) + 1 < p.ph_hi) { XcdBarrier bar; bar.bar = (unsigned*)(p.ws + WS_BAR); bar.x = xb_xcc_id(); bar.st = xbst; xcd_barrier(bar); } } while (0)
#ifndef REPEAT_MASK
#define REPEAT_MASK 0
#endif
#define REP(k) for (int rep_ = 0; rep_ < (((REPEAT_MASK) >> (k)) & 1) + 1; ++rep_)
    REP(0) { const Params p = load_params(); if (IN(0)) { unsigned char* ws = p.ws; const float* mod = (const float*)(ws + WS_MOD); (void)mod;
        phase_prep(p, lds, bid, nb);
    } }
    SEAM(0);
    REP(1) { const Params p = load_params(); if (IN(1)) { unsigned char* ws = p.ws; const float* mod = (const float*)(ws + WS_MOD); (void)mod;
        phase_norm<true>(p.x, p.g1, mod, 0, D_, (bf16_t*)(ws + WS_H), (const float*)(ws + WS_WG), (float*)(ws + WS_GATE), bid, nb);
    } }
    SEAM(1);
    REP(2) { const Params p = load_params(); if (IN(2)) { unsigned char* ws = p.ws; const float* mod = (const float*)(ws + WS_MOD); (void)mod;
        phase_gates(p, lds, bid, nb);
        { pg8::Gemm g{(const bf16_t*)(ws + WS_H), (const bf16_t*)(ws + WS_WINT), T_, 7168, D_}; pg8::StaticOrder S; S.init(T_, 7168, nb, bid);
        pg8::EpiSeg E{(bf16_t*)(ws + WS_P)}; pg8::gemm_phase<pg8::EpiSeg, pg8::StaticOrder, true, true>((LAS unsigned char*)lds, g, S, E); }
    } }
    SEAM(2);
    REP(3) { const Params p = load_params(); if (IN(3)) { unsigned char* ws = p.ws; const float* mod = (const float*)(ws + WS_MOD); (void)mod;
        phase_post(p, bid, nb);
    } }
    SEAM(3);
    REP(4) { const Params p = load_params(); if (IN(4)) { unsigned char* ws = p.ws; const float* mod = (const float*)(ws + WS_MOD); (void)mod;
        { for (int u = bid; u < 64; u += nb) mlstm_passA(p, lds, u);
        unsigned* qctr = (unsigned*)(ws + WS_QCTR) + rep_; LAS int* slot = (LAS int*)((LAS unsigned char*)lds + LDS_BYTES - 32);
        for (;;) { __syncthreads(); if (tid == 0) *slot = (int)atomicAdd(qctr, 1u); __syncthreads(); const int u = *slot; if (u >= 512) break;
            const int bh = u & 63; fox_unit(p, lds, bh >> 3, bh & 7, 7 - (u >> 6)); } }
    } }
    SEAM(4);
    REP(5) { const Params p = load_params(); if (IN(5)) { unsigned char* ws = p.ws; const float* mod = (const float*)(ws + WS_MOD); (void)mod;
        { for (int u = bid; u < 1024; u += nb) mlstm_passB(p, lds, u); }
    } }
    SEAM(5);
    REP(6) { const Params p = load_params(); if (IN(6)) { unsigned char* ws = p.ws; const float* mod = (const float*)(ws + WS_MOD); (void)mod;
        { pg8::Gemm g{(const bf16_t*)(ws + WS_H), (const bf16_t*)(ws + WS_WOT), T_, D_, D_}; pg8::StaticOrder S; S.init(T_, D_, nb, bid);
        pg8::EpiRes E{p.x, (float*)(ws + WS_X1), mod, 2 * D_}; pg8::gemm_phase<pg8::EpiRes, pg8::StaticOrder, true, true>((LAS unsigned char*)lds, g, S, E); }
    } }
    SEAM(6);
    REP(7) { const Params p = load_params(); if (IN(7)) { unsigned char* ws = p.ws; const float* mod = (const float*)(ws + WS_MOD); (void)mod;
        convert_experts(p, bid, nb);
    } }
    REP(7) { const Params p = load_params(); if (IN(7)) { unsigned char* ws = p.ws; const float* mod = (const float*)(ws + WS_MOD); (void)mod;
        phase_norm<false>((const float*)(ws + WS_X1), p.g2, mod, 3 * D_, 4 * D_, (bf16_t*)(ws + WS_H2), nullptr, nullptr, bid, nb);
    } }
    SEAM(7);
    REP(8) { const Params p = load_params(); if (IN(8)) { unsigned char* ws = p.ws; const float* mod = (const float*)(ws + WS_MOD); (void)mod;
        { pg8::Gemm g{(const bf16_t*)(ws + WS_H2), (const bf16_t*)(ws + WS_WQT), T_, D_, D_}; pg8::StaticOrder S; S.init(T_, D_, nb, bid);
        pg8::EpiBf E{(bf16_t*)(ws + WS_Q), D_}; pg8::gemm_phase<pg8::EpiBf, pg8::StaticOrder, true, true>((LAS unsigned char*)lds, g, S, E); }
    } }
    SEAM(8);
    REP(9) { const Params p = load_params(); if (IN(9)) { unsigned char* ws = p.ws; const float* mod = (const float*)(ws + WS_MOD); (void)mod;
        phase_topk(p, lds, bid, nb);
    } }
    SEAM(9);
    REP(10) { const Params p = load_params(); if (IN(10)) { unsigned char* ws = p.ws; const float* mod = (const float*)(ws + WS_MOD); (void)mod;
#ifdef PROBE_L2
        phase_peer1(p, lds, bid, nb, rep_);
#else
        phase_peer1(p, lds, bid, nb, 0);
#endif
    } }
    SEAM(10);
    REP(11) { const Params p = load_params(); if (IN(11)) { unsigned char* ws = p.ws; const float* mod = (const float*)(ws + WS_MOD); (void)mod;
        phase_peer2(p, lds, bid, nb);
    } }
#undef IN
#undef SEAM
}

#ifndef ONE_LAUNCH
#define ONE_LAUNCH 1
#endif
extern "C" void kernel_launch(void* const* d_in, const int* in_sizes, int n_in, void* d_out, int out_size, void* d_ws, size_t ws_size, hipStream_t stream) {
    static int grid = 0;
    if (grid == 0) {
        int dev = 0, cus = 0, per_cu = 0;
        if (n_in != 21 || ws_size < WS_END) { fprintf(stderr, "kernel_launch: unexpected n_in %d / ws_size %zu (need %zu)\n", n_in, ws_size, (size_t)WS_END); grid = -1; return; }
        hipGetDevice(&dev); hipDeviceGetAttribute(&cus, hipDeviceAttributeMultiprocessorCount, dev);
        if (hipFuncSetAttribute((const void*)fwd_kernel, hipFuncAttributeMaxDynamicSharedMemorySize, LDS_BYTES) != hipSuccess) { fprintf(stderr, "kernel_launch: hipFuncSetAttribute failed\n"); grid = -1; return; }
        if (hipOccupancyMaxActiveBlocksPerMultiprocessor(&per_cu, (const void*)fwd_kernel, NTHR, LDS_BYTES) != hipSuccess || per_cu < 1) { fprintf(stderr, "kernel_launch: occupancy query says %d\n", per_cu); (void)hipGetLastError(); }
        grid = cus > 0 ? cus : 256;
    }
    if (grid < 0) return;
    Params p{};
    const float** pp = (const float**)&p;
    for (int i = 0; i < 21; ++i) pp[i] = (const float*)d_in[i];
    p.out = (float*)d_out; p.ws = (unsigned char*)d_ws;
    hipMemsetAsync((char*)d_ws + WS_BAR, 0, 16384, stream);
#if ONE_LAUNCH
    p.ph_lo = 0; p.ph_hi = N_PHASES;
    void* args[] = {&p};
    hipError_t e = hipLaunchCooperativeKernel((const void*)fwd_kernel, dim3(grid), dim3(NTHR), args, LDS_BYTES, stream);
    if (e != hipSuccess) fprintf(stderr, "cooperative launch failed: %s (grid %d)\n", hipGetErrorString(e), grid);
#else
    for (int ph = 0; ph < N_PHASES; ++ph) { p.ph_lo = ph; p.ph_hi = ph + 1; hipLaunchKernelGGL(fwd_kernel, dim3(grid), dim3(NTHR), LDS_BYTES, stream, p); }
#endif
}
```

```cpp
#include <hip/hip_runtime.h>
#include <cstdio>
#include <cstdint>

#define GAS __attribute__((address_space(1)))
#define LAS __attribute__((address_space(3)))
typedef unsigned short bf16_t;
typedef short bf16x8 __attribute__((ext_vector_type(8)));
typedef float f32x4 __attribute__((ext_vector_type(4)));
typedef float f32x16 __attribute__((ext_vector_type(16)));
typedef unsigned u32x4 __attribute__((ext_vector_type(4)));
typedef unsigned u32x2 __attribute__((ext_vector_type(2)));

constexpr int T_ = 16384, D_ = 2048, B_ = 8, S_ = 2048, NTHR = 512;
constexpr float EPS_ = 1e-6f;
constexpr int NMOD = 6 * D_;
constexpr int INCOLS = 7184;

constexpr size_t WS_BAR   = 0;
constexpr size_t WS_MOD   = 16384;
constexpr size_t WS_WG    = WS_MOD + (size_t)B_ * NMOD * 4;
constexpr size_t WS_GATE  = WS_WG + 16 * 2048 * 4;
constexpr size_t WS_F     = WS_GATE + (size_t)T_ * 16 * 4;
constexpr size_t WS_NST   = WS_F + 64 * 2048 * 4;
constexpr size_t WS_MST   = WS_NST + 1024 * 256 * 4;
constexpr size_t WS_DSC   = WS_MST + 4096;
constexpr size_t WS_WINT  = WS_DSC + 16384 * 4;
constexpr size_t WS_WOT   = WS_WINT + (size_t)7168 * 2048 * 2;
constexpr size_t WS_WQT   = WS_WOT + (size_t)2048 * 2048 * 2;
constexpr size_t WS_H     = WS_WQT + (size_t)2048 * 2048 * 2;
constexpr size_t WS_P     = WS_H + (size_t)T_ * 2048 * 2;
constexpr size_t SEG_B    = (size_t)T_ * 1024 * 2;
constexpr size_t WS_CST   = WS_P + 7 * SEG_B;
constexpr size_t WS_E8D   = WS_CST + (size_t)1024 * 256 * 256 * 2;
constexpr size_t WS_E8U   = WS_E8D + (size_t)16384 * 2048;
constexpr size_t WS_END   = WS_E8U + (size_t)16384 * 2048;
constexpr size_t WS_QC    = WS_E8D;
constexpr size_t WS_KC    = WS_E8U;
constexpr size_t WS_QCTR  = 15360;
constexpr size_t WS_H2    = WS_P;
constexpr size_t WS_Q     = WS_H2 + (size_t)T_ * 2048 * 2;
constexpr size_t WS_IDX   = WS_Q + (size_t)T_ * 2048 * 2;
constexpr size_t WS_GW    = WS_IDX + (size_t)T_ * 128 * 4;
static_assert(WS_GW + (size_t)T_ * 128 * 4 <= WS_CST, "alias overflow");
constexpr size_t WS_X1    = WS_CST;
constexpr size_t WS_EWT   = WS_GW + (size_t)T_ * 128 * 4;
static_assert(WS_EWT + (size_t)T_ * 128 * 4 <= WS_CST, "alias overflow 2");

struct Params {
    const float *x, *c, *w_ada, *b_ada, *g1, *g2, *w_in, *fox_fb, *fox_qg, *fox_kg, *conv_w, *conv_b, *m_ib, *m_fb, *m_hg, *w_out, *w_q, *sk1, *sk2, *e_down, *e_up;
    float* out; unsigned char* ws; int ph_lo, ph_hi;
};

__device__ __forceinline__ int get_tid() { int t = threadIdx.x; asm volatile("" : "+v"(t)); return t; }
__device__ __forceinline__ unsigned cvt_pk(float lo, float hi) { unsigned r; asm("v_cvt_pk_bf16_f32 %0, %1, %2" : "=v"(r) : "v"(lo), "v"(hi)); return r; }
__device__ __forceinline__ void fmac(float& acc, float a, float b) { asm("v_fmac_f32 %0, %1, %2" : "+v"(acc) : "v"(a), "v"(b)); }
__device__ __forceinline__ float bf2f(unsigned short h) { return __builtin_bit_cast(float, ((unsigned)h) << 16); }
__device__ __forceinline__ float bflo(unsigned w) { return __builtin_bit_cast(float, w << 16); }
__device__ __forceinline__ float bfhi(unsigned w) { return __builtin_bit_cast(float, w & 0xffff0000u); }
__device__ __forceinline__ float wsum(float v) {
#pragma unroll
    for (int o = 32; o; o >>= 1) v += __shfl_xor(v, o);
    return v; }
__device__ __forceinline__ float wmax(float v) {
#pragma unroll
    for (int o = 32; o; o >>= 1) v = fmaxf(v, __shfl_xor(v, o));
    return v; }
__device__ __forceinline__ float logsig(float x) { return fminf(x, 0.f) - log1pf(expf(-fabsf(x))); }
__device__ __forceinline__ float sigm(float x) { return 1.f / (1.f + expf(-x)); }
__device__ __forceinline__ float silu_f(float x) { return x / (1.f + expf(-x)); }
namespace pg8 {
#define PG8_LAS __attribute__((address_space(3)))
typedef unsigned short bf16_t;
typedef short bf16x8 __attribute__((ext_vector_type(8)));
typedef float f32x4 __attribute__((ext_vector_type(4)));
typedef unsigned u32x4 __attribute__((ext_vector_type(4)));
constexpr int BM = 256, BK = 64, HALF = 128, HTB = HALF * BK * 2  , STAGE_BYTES = 8 * HTB, NXCD = 8, WGM = 8;

__host__ __device__ __forceinline__ int lds_byte(int r, int c) { const int st = (r >> 4) * 2 + (c >> 5), rr = r & 15, cc = c & 31, ob = rr * 64 + cc * 2; return st * 1024 + (ob ^ (((ob >> 9) & 1) << 5)); }
__host__ __device__ __forceinline__ void stage_rc(int b, int& R, int& C) { const int st = b / 1024, sb = b % 1024, swz = sb ^ (((sb >> 9) & 1) << 5); R = (st >> 1) * 16 + swz / 64; C = (st & 1) * 32 + (swz % 64) / 2; }
__host__ __device__ __forceinline__ int perm32(int rho) { const int n = rho >> 4, i = rho & 15; return 8 * (i >> 2) + 4 * n + (i & 3); }

struct Unit { int pm, pn; };
struct Gemm { const bf16_t* A; const bf16_t* Bt; int M, N, K; };

struct StaticOrder {
    int nM, nN, nwg, G, c;
    __host__ __device__ void init(int M, int N, int G_, int c_) { nM = M / BM; nN = N / BM; nwg = nM * nN; G = G_; c = c_; }
    __host__ __device__ bool next(int i, Unit& u) const {
        const long L = (long)i * G + c; if (L >= nwg) return false;
        int wgid = (int)L; { const int q = nwg / NXCD, r = nwg % NXCD, xcd = wgid % NXCD, off = wgid / NXCD; wgid = (xcd < r ? xcd * (q + 1) : r * (q + 1) + (xcd - r) * q) + off; }
        const int nig = WGM * nN, gid = wgid / nig, fm = gid * WGM, gsz = (nM - fm) < WGM ? (nM - fm) : WGM;
        u.pm = fm + ((wgid % nig) % gsz); u.pn = (wgid % nig) / gsz; return true;
    }
    __device__ __forceinline__ void a_ready(const Unit&) const {}
    __device__ __forceinline__ void done(const Unit&) const {}
};
struct EpiSeg {
    static constexpr bool PERM = true, AFTER_DRAIN = false;
    bf16_t* P;
    __device__ __forceinline__ void operator()(const f32x4 (&acc)[2][2][4][2], const Unit& u, int wr, int wc, int fr, int fq) const {
        const int seg = u.pn >> 2; bf16_t* base = P + (size_t)seg * ((size_t)T_ * 1024);
        const int row0 = u.pm * BM + wr * 64 + fr, col0 = (u.pn & 3) * 256 + wc * 32 + 8 * fq;
#pragma unroll
        for (int ai = 0; ai < 2; ++ai)
#pragma unroll
            for (int m = 0; m < 4; ++m) { bf16_t* rowp = base + (size_t)(row0 + ai * HALF + m * 16) * 1024 + col0;
#pragma unroll
                for (int bj = 0; bj < 2; ++bj) { const f32x4 v0 = acc[ai][bj][m][0], v1 = acc[ai][bj][m][1];
                    u32x4 w; w.x = cvt_pk(v0[0], v0[1]); w.y = cvt_pk(v0[2], v0[3]); w.z = cvt_pk(v1[0], v1[1]); w.w = cvt_pk(v1[2], v1[3]);
                    *(u32x4*)(rowp + bj * HALF) = w; } }
    }
};
struct EpiBf {
    static constexpr bool PERM = true, AFTER_DRAIN = false;
    bf16_t* O; int ldc;
    __device__ __forceinline__ void operator()(const f32x4 (&acc)[2][2][4][2], const Unit& u, int wr, int wc, int fr, int fq) const {
        const int row0 = u.pm * BM + wr * 64 + fr, col0 = u.pn * BM + wc * 32 + 8 * fq;
#pragma unroll
        for (int ai = 0; ai < 2; ++ai)
#pragma unroll
            for (int m = 0; m < 4; ++m) { bf16_t* rowp = O + (size_t)(row0 + ai * HALF + m * 16) * ldc + col0;
#pragma unroll
                for (int bj = 0; bj < 2; ++bj) { const f32x4 v0 = acc[ai][bj][m][0], v1 = acc[ai][bj][m][1];
                    u32x4 w; w.x = cvt_pk(v0[0], v0[1]); w.y = cvt_pk(v0[2], v0[3]); w.z = cvt_pk(v1[0], v1[1]); w.w = cvt_pk(v1[2], v1[3]);
                    *(u32x4*)(rowp + bj * HALF) = w; } }
    }
};
struct EpiRes {
    static constexpr bool PERM = false, AFTER_DRAIN = false;
    const float* X; float* O; const float* mod; int goff;
    __device__ __forceinline__ void operator()(const f32x4 (&acc)[2][2][4][2], const Unit& u, int wr, int wc, int fr, int fq) const {
        const int row0 = u.pm * BM + wr * 64 + fr, col0 = u.pn * BM + wc * 32 + 4 * fq;
        const float* gp = mod + (size_t)((u.pm * BM) >> 11) * NMOD + goff + col0;
        f32x4 gv[2][2];
#pragma unroll
        for (int bj = 0; bj < 2; ++bj)
#pragma unroll
            for (int n = 0; n < 2; ++n) gv[bj][n] = *(const f32x4*)(gp + bj * HALF + 16 * n);
#pragma unroll
        for (int ai = 0; ai < 2; ++ai)
#pragma unroll
            for (int m = 0; m < 4; ++m) { const size_t ro = (size_t)(row0 + ai * HALF + m * 16) * D_ + col0;
#pragma unroll
                for (int bj = 0; bj < 2; ++bj)
#pragma unroll
                    for (int n = 0; n < 2; ++n) { const f32x4 xv = *(const f32x4*)(X + ro + bj * HALF + 16 * n);
                        *(f32x4*)(O + ro + bj * HALF + 16 * n) = xv + gv[bj][n] * acc[ai][bj][m][n]; } }
    }
};
template <class Epi, class Sched, bool ALIGN_EPI = false, bool SP2 = false>
__device__ __forceinline__ void gemm_phase(PG8_LAS unsigned char* lds, const Gemm g, const Sched& S, const Epi& E) {
    const int tid = get_tid(), wid = __builtin_amdgcn_readfirstlane(tid >> 6), lane = tid & 63, wr = wid >> 2, wc = wid & 3, fr = lane & 15, fq = lane >> 4;
    const int K = g.K, nt = K / BK;
    unsigned voffA[2], voffB[2];
#pragma unroll
    for (int i = 0; i < 2; ++i) { int R, C; stage_rc(tid * 16 + i * 8192, R, C); const int Rb = Epi::PERM ? ((R & ~31) + perm32(R & 31)) : R;
        voffA[i] = (unsigned)(R * K + C) * 2u; voffB[i] = (unsigned)(Rb * K + C) * 2u; }
    const size_t kstep = (size_t)(BK * 2);
    const size_t hstep = (size_t)HALF * K * 2;
    const size_t tstep = 2 * hstep;
    const unsigned ldsw = (unsigned)wid * 1024u;
    const int aoff = lds_byte(wr * 64 + fr, fq * 8), boff = lds_byte(wc * 32 + fr, fq * 8);
#define PG8_SA(b, h) (((b) * 2 + (h)) * HTB)
#define PG8_SB(b, h) ((4 + (b) * 2 + (h)) * HTB)
#define PG8_STAGE(bufoff, gbase, voff) do { _Pragma("unroll") for (int _i = 0; _i < 2; ++_i) \
        __builtin_amdgcn_global_load_lds((const unsigned*)((const char*)(gbase) + (voff)[_i]), (PG8_LAS unsigned*)(lds + (bufoff) + ldsw + _i * 8192), 16, 0, 0); } while (0)
#define PG8_LDA(dst, b, h) do { _Pragma("unroll") for (int m = 0; m < 4; ++m) _Pragma("unroll") for (int k = 0; k < 2; ++k) dst[m][k] = *(const PG8_LAS bf16x8*)(lds + PG8_SA(b, h) + aoff + m * 2048 + k * 1024); } while (0)
#define PG8_LDB(dst, b, h) do { _Pragma("unroll") for (int n = 0; n < 2; ++n) _Pragma("unroll") for (int k = 0; k < 2; ++k) dst[n][k] = *(const PG8_LAS bf16x8*)(lds + PG8_SB(b, h) + boff + n * 2048 + k * 1024); } while (0)
#define PG8_MMA(ai, bj, At, Bt) do { __builtin_amdgcn_s_setprio(1); _Pragma("unroll") for (int m = 0; m < 4; ++m) _Pragma("unroll") for (int n = 0; n < 2; ++n) _Pragma("unroll") for (int k = 0; k < 2; ++k) \
        acc[ai][bj][m][n] = __builtin_amdgcn_mfma_f32_16x16x32_bf16(Bt[n][k], At[m][k], acc[ai][bj][m][n], 0, 0, 0); __builtin_amdgcn_s_setprio(0); } while (0)
#define PG8_WAIT_V(n) asm volatile("s_waitcnt vmcnt(" #n ")" ::: "memory")
#define PG8_WAIT_L(n) asm volatile("s_waitcnt lgkmcnt(" #n ")" ::: "memory")
#define PG8_BAR __builtin_amdgcn_s_barrier()
#define PG8_SCHED __builtin_amdgcn_sched_barrier(0)
    Unit cur, nxt; int ui = 0;
    if (!S.next(0, cur)) return;
    f32x4 acc[2][2][4][2];
#pragma unroll
    for (int a = 0; a < 2; ++a)
#pragma unroll
        for (int b = 0; b < 2; ++b)
#pragma unroll
            for (int m = 0; m < 4; ++m)
#pragma unroll
                for (int n = 0; n < 2; ++n) acc[a][b][m][n] = (f32x4){0.f, 0.f, 0.f, 0.f};
    bf16x8 At[4][2], B0[2][2], B1[2][2];
    const char* cA = (const char*)g.A + (size_t)cur.pm * tstep; const char* cB = (const char*)g.Bt + (size_t)cur.pn * tstep;
    S.a_ready(cur);
    if constexpr (SP2) {
        PG8_STAGE(PG8_SB(0, 0), cB, voffB); PG8_STAGE(PG8_SB(0, 1), cB + hstep, voffB); PG8_STAGE(PG8_SA(0, 0), cA, voffA); PG8_STAGE(PG8_SA(0, 1), cA + hstep, voffA);
        if (wr == 1) PG8_BAR;
        PG8_WAIT_V(2); PG8_BAR;
        PG8_STAGE(PG8_SB(1, 0), cB + kstep, voffB); PG8_STAGE(PG8_SA(1, 0), cA + kstep, voffA); PG8_STAGE(PG8_SB(1, 1), cB + hstep + kstep, voffB);
        PG8_WAIT_V(6); PG8_BAR;
    } else {
        PG8_STAGE(PG8_SB(0, 0), cB, voffB); PG8_STAGE(PG8_SA(0, 0), cA, voffA); PG8_STAGE(PG8_SB(0, 1), cB + hstep, voffB); PG8_STAGE(PG8_SA(0, 1), cA + hstep, voffA);
        if (wr == 1) PG8_BAR;
        PG8_WAIT_V(4); PG8_BAR;
        PG8_STAGE(PG8_SB(1, 0), cB + kstep, voffB); PG8_STAGE(PG8_SA(1, 0), cA + kstep, voffA); PG8_STAGE(PG8_SB(1, 1), cB + hstep + kstep, voffB);
        PG8_WAIT_V(6); PG8_BAR;
    }
    for (;;) {
        const bool has_next = S.next(ui + 1, nxt);
        const char* nA = has_next ? (const char*)g.A + (size_t)nxt.pm * tstep : cA; const char* nB = has_next ? (const char*)g.Bt + (size_t)nxt.pn * tstep : cB;
        for (int t = 0; t < nt; t += 2) {
            const bool last = (t == nt - 2);
            const char* a1 = cA + (size_t)(t + 1) * kstep;
            const char* a2 = last ? nA : cA + (size_t)(t + 2) * kstep; const char* b2 = last ? nB : cB + (size_t)(t + 2) * kstep;
            const char* a3 = a2 + kstep; const char* b3 = b2 + kstep;
            if (last && has_next) S.a_ready(nxt);
            if constexpr (SP2) {
            PG8_LDB(B0, 0, 0); PG8_LDB(B1, 0, 1); PG8_SCHED; PG8_LDA(At, 0, 0); PG8_STAGE(PG8_SA(1, 1), a1 + hstep, voffA);
            PG8_WAIT_V(8); PG8_WAIT_L(0); PG8_BAR; PG8_MMA(0, 0, At, B0); PG8_MMA(0, 1, At, B1); PG8_BAR; PG8_SCHED;
            PG8_LDA(At, 0, 1); PG8_STAGE(PG8_SB(0, 0), b2, voffB); PG8_STAGE(PG8_SB(0, 1), b2 + hstep, voffB); PG8_STAGE(PG8_SA(0, 0), a2, voffA);
            PG8_WAIT_V(8); PG8_WAIT_L(0); PG8_BAR; PG8_MMA(1, 0, At, B0); PG8_MMA(1, 1, At, B1); PG8_BAR; PG8_SCHED;
            PG8_LDB(B0, 1, 0); PG8_LDB(B1, 1, 1); PG8_SCHED; PG8_LDA(At, 1, 0); PG8_STAGE(PG8_SA(0, 1), a2 + hstep, voffA);
            PG8_WAIT_V(8); PG8_WAIT_L(0); PG8_BAR; PG8_MMA(0, 0, At, B0); PG8_MMA(0, 1, At, B1); PG8_BAR; PG8_SCHED;
            PG8_LDA(At, 1, 1); PG8_STAGE(PG8_SB(1, 0), b3, voffB); PG8_STAGE(PG8_SB(1, 1), b3 + hstep, voffB); PG8_STAGE(PG8_SA(1, 0), a3, voffA);
            PG8_WAIT_V(8); PG8_WAIT_L(0); PG8_BAR; PG8_MMA(1, 0, At, B0); PG8_MMA(1, 1, At, B1); PG8_BAR; PG8_SCHED;
            } else {
            PG8_LDB(B0, 0, 0); PG8_SCHED; PG8_LDA(At, 0, 0); PG8_STAGE(PG8_SA(1, 1), a1 + hstep, voffA);
            PG8_WAIT_L(8); PG8_BAR; PG8_WAIT_L(0); PG8_MMA(0, 0, At, B0); PG8_BAR; PG8_SCHED;
            PG8_LDB(B1, 0, 1); PG8_STAGE(PG8_SB(0, 0), b2, voffB);
            PG8_BAR; PG8_WAIT_L(0); PG8_MMA(0, 1, At, B1); PG8_BAR;
            PG8_LDA(At, 0, 1); PG8_STAGE(PG8_SA(0, 0), a2, voffA);
            PG8_BAR; PG8_WAIT_L(0); PG8_MMA(1, 0, At, B0); PG8_BAR; PG8_SCHED;
            PG8_STAGE(PG8_SB(0, 1), b2 + hstep, voffB);
            PG8_WAIT_V(6); PG8_BAR; PG8_MMA(1, 1, At, B1); PG8_BAR;
            PG8_LDB(B0, 1, 0); PG8_SCHED; PG8_LDA(At, 1, 0); PG8_STAGE(PG8_SA(0, 1), a2 + hstep, voffA);
            PG8_WAIT_L(8); PG8_BAR; PG8_WAIT_L(0); PG8_MMA(0, 0, At, B0); PG8_BAR; PG8_SCHED;
            PG8_LDB(B1, 1, 1); PG8_STAGE(PG8_SB(1, 0), b3, voffB);
            PG8_BAR; PG8_WAIT_L(0); PG8_MMA(0, 1, At, B1); PG8_BAR;
            PG8_LDA(At, 1, 1); PG8_STAGE(PG8_SA(1, 0), a3, voffA);
            PG8_BAR; PG8_WAIT_L(0); PG8_MMA(1, 0, At, B0); PG8_BAR; PG8_SCHED;
            PG8_STAGE(PG8_SB(1, 1), b3 + hstep, voffB);
            PG8_WAIT_V(6); PG8_BAR; PG8_MMA(1, 1, At, B1); PG8_BAR;
            }
        }
        if constexpr (ALIGN_EPI) { if (wr == 0) PG8_BAR; }
        if constexpr (!Epi::AFTER_DRAIN) { E(acc, cur, wr, wc, fr, fq); S.done(cur); }
        if (!has_next) break;
#pragma unroll
        for (int a = 0; a < 2; ++a)
#pragma unroll
            for (int b = 0; b < 2; ++b)
#pragma unroll
                for (int m = 0; m < 4; ++m)
#pragma unroll
                    for (int n = 0; n < 2; ++n) acc[a][b][m][n] = (f32x4){0.f, 0.f, 0.f, 0.f};
        cur = nxt; cA = nA; cB = nB; ++ui;
        if constexpr (ALIGN_EPI) { if (wr == 1) PG8_BAR; }
    }
    PG8_WAIT_V(0);
    if constexpr (!ALIGN_EPI) { if (wr == 0) PG8_BAR; }
    PG8_BAR;
    if constexpr (Epi::AFTER_DRAIN) { E.fused(acc, cur, wr, wc, fr, fq, lds, wid, lane); S.done(cur); }
#undef PG8_SA
#undef PG8_SB
#undef PG8_STAGE
#undef PG8_LDA
#undef PG8_LDB
#undef PG8_MMA
#undef PG8_WAIT_V
#undef PG8_WAIT_L
#undef PG8_BAR
#undef PG8_SCHED
}
}
#define XB_TMO      128
#define XB_XCNT(j)  (256  + 64 * (j))
#define XB_XSUB(j)  (1280 + 64 * (j))
#define XB_XGEN(j)  (2304 + 64 * (j))
#define XB_TOP      3328
#define XB_TOPGEN   3392
#define XCD_BAR_WORDS 3456
#define XB_SPIN_CAP (1u << 18)

__device__ __forceinline__ unsigned xb_ld(unsigned* p)              { return __hip_atomic_load(p, __ATOMIC_RELAXED, __HIP_MEMORY_SCOPE_AGENT); }
__device__ __forceinline__ unsigned xb_add(unsigned* p, unsigned v) { return __hip_atomic_fetch_add(p, v, __ATOMIC_RELAXED, __HIP_MEMORY_SCOPE_AGENT); }
__device__ __forceinline__ unsigned xb_xcc_id() { return (unsigned)__builtin_amdgcn_s_getreg((3 << 11) | 20) & 0xFu; }
#define XB_SPIN(cond, bar) do { unsigned _sp = 0; while (cond) { __builtin_amdgcn_s_sleep(1); \
    if ((++_sp & 255u) == 0u) { if (xb_ld(&(bar)[XB_TMO])) break; if (_sp > XB_SPIN_CAP) { atomicAdd(&(bar)[XB_TMO], 1u); break; } } } } while (0)

struct XcdBarrier {
    unsigned* bar; unsigned x;
    volatile LAS unsigned* st;
};

__device__ __forceinline__ XcdBarrier xcd_barrier_post(unsigned* bar, volatile LAS unsigned* st) {
    XcdBarrier b; b.bar = bar; b.x = xb_xcc_id(); b.st = st;
    if (threadIdx.x == 0) (void)xb_add(&bar[XB_XCNT(b.x)], 1u);
    return b;
}
__device__ __forceinline__ void xcd_barrier_complete(unsigned* bar, unsigned x, unsigned& nloc, unsigned& nx) {
    const unsigned G = gridDim.x * gridDim.y * gridDim.z;
    unsigned sum, cnt, mine, sp = 0u;
    for (;;) {
        sum = 0u; cnt = 0u; mine = 0u;
#pragma unroll
        for (unsigned j = 0; j < 16; ++j) { const unsigned c = xb_ld(&bar[XB_XCNT(j)]); sum += c; cnt += (c > 0u) ? 1u : 0u; mine = (j == x) ? c : mine; }
        if (sum == G) break;
        __builtin_amdgcn_s_sleep(1);
        if ((++sp & 255u) == 0u) { if (xb_ld(&bar[XB_TMO])) break; if (sp > XB_SPIN_CAP) { atomicAdd(&bar[XB_TMO], 1u); break; } }
    }
    nloc = mine > 0u ? mine : 1u; nx = cnt > 0u ? cnt : 1u;
}

__device__ __forceinline__ void xcd_barrier(const XcdBarrier& b) {
    asm volatile("s_waitcnt vmcnt(0)" ::: "memory");
    __syncthreads();
    if (threadIdx.x == 0) {
        unsigned* bar = b.bar;
        __builtin_amdgcn_s_waitcnt(0);
        unsigned nloc = b.st[0], nx = b.st[1];
        if (nloc == 0u) { xcd_barrier_complete(bar, b.x, nloc, nx); b.st[0] = nloc; b.st[1] = nx; }
        const unsigned old = xb_add(&bar[XB_XSUB(b.x)], 1u);
        const unsigned gen = old / nloc;
        if (old + 1u == (gen + 1u) * nloc) {
            __builtin_amdgcn_fence(__ATOMIC_RELEASE, "agent");
            asm volatile("s_waitcnt vmcnt(0)" ::: "memory");
            const unsigned og = xb_add(&bar[XB_TOP], 1u);
            const unsigned tg = og / nx;
            if (og + 1u == (tg + 1u) * nx) xb_add(&bar[XB_TOPGEN], 1u);
            else XB_SPIN(xb_ld(&bar[XB_TOPGEN]) == tg, bar);
            __builtin_amdgcn_fence(__ATOMIC_ACQUIRE, "agent");
            xb_add(&bar[XB_XGEN(b.x)], 1u);
            asm volatile("s_waitcnt vmcnt(0)" ::: "memory");
        } else {
            XB_SPIN(xb_ld(&bar[XB_XGEN(b.x)]) == gen, bar);
            __builtin_amdgcn_fence(__ATOMIC_ACQUIRE, "agent");
            asm volatile("s_waitcnt vmcnt(0)" ::: "memory");
        }
    }
    __syncthreads();
}
__device__ __forceinline__ void phase_prep(const Params& p, unsigned char* lds, int bid, int nb) {
    const int tid = get_tid(), lane = tid & 63, wave = tid >> 6;
    unsigned char* ws = p.ws;
    float* mod = (float*)(ws + WS_MOD);
    if (bid < 192) {
        float* sc = (float*)lds;
        float* red = sc + 8 * 2048;
        for (int i = tid; i < 8 * 2048; i += NTHR) sc[i] = silu_f(p.c[i]);
        __syncthreads();
        for (int it = bid; it < 192; it += nb) {
            const int col = it * 64 + lane;
            float acc[8];
#pragma unroll
            for (int b = 0; b < 8; ++b) acc[b] = 0.f;
            const float* w = p.w_ada + (size_t)(wave * 256) * NMOD + col;
            const float* s0 = sc + wave * 256;
#pragma unroll 4
            for (int k = 0; k < 256; ++k) {
                const float wv = w[(size_t)k * NMOD];
#pragma unroll
                for (int b = 0; b < 8; ++b) acc[b] += s0[b * 2048 + k] * wv;
            }
#pragma unroll
            for (int b = 0; b < 8; ++b) red[(wave * 8 + b) * 64 + lane] = acc[b];
            __syncthreads();
            {   const int b = wave; float s = p.b_ada[col];
#pragma unroll
                for (int w2 = 0; w2 < 8; ++w2) s += red[(w2 * 8 + b) * 64 + lane];
                mod[b * NMOD + col] = s; }
            __syncthreads();
        }
    }
    __syncthreads();
    {
        float* tile = (float*)lds;
        bf16_t* WinT = (bf16_t*)(ws + WS_WINT); bf16_t* WoT = (bf16_t*)(ws + WS_WOT); bf16_t* WqT = (bf16_t*)(ws + WS_WQT);
        for (int item = bid; item < 5632; item += nb) {
            const float* src; int ld, scol; bf16_t* dst; int kt;
            if (item < 3584) { const int seg = item >> 9, rem = item & 511, ntile = rem >> 5; kt = rem & 31;
                src = p.w_in; ld = INCOLS; scol = (seg < 3 ? seg * 1024 : 3080 + (seg - 3) * 1024) + ntile * 64; dst = WinT + (size_t)(seg * 1024 + ntile * 64) * 2048; }
            else if (item < 4608) { const int rem = item - 3584, ntile = rem >> 5; kt = rem & 31; src = p.w_out; ld = 2048; scol = ntile * 64; dst = WoT + (size_t)(ntile * 64) * 2048; }
            else { const int rem = item - 4608, ntile = rem >> 5; kt = rem & 31; src = p.w_q; ld = 2048; scol = ntile * 64; dst = WqT + (size_t)(ntile * 64) * 2048; }
            const int k0 = kt * 64;
#pragma unroll
            for (int ii = 0; ii < 8; ++ii) { const int k = wave + 8 * ii; tile[k * 65 + lane] = src[(size_t)(k0 + k) * ld + scol + lane]; }
            __syncthreads();
#pragma unroll
            for (int ii = 0; ii < 8; ++ii) { const int n = wave + 8 * ii; dst[(size_t)n * 2048 + k0 + lane] = (bf16_t)(cvt_pk(tile[lane * 65 + n], 0.f) & 0xffffu); }
            __syncthreads();
        }
    }
    {
        bf16_t* Wg = (bf16_t*)(ws + WS_WG);
        for (int i = bid * NTHR + tid; i < 16 * 2048; i += nb * NTHR) { const int g = i >> 11, k = i & 2047; const int col = g < 8 ? 3072 + g : 7176 + (g - 8);
            Wg[i] = (bf16_t)(cvt_pk(p.w_in[(size_t)k * INCOLS + col], 0.f) & 0xffffu); }
    }
}

__device__ __forceinline__ unsigned pack4_fp8(const f32x4 a) { int t = __builtin_amdgcn_cvt_pk_fp8_f32(a[0], a[1], 0, false); t = __builtin_amdgcn_cvt_pk_fp8_f32(a[2], a[3], t, true); return (unsigned)t; }
__device__ __forceinline__ void convert_experts(const Params& p, int bid, int nb) {
    const int tid = get_tid(); unsigned char* ws = p.ws;
    unsigned char* E8D = ws + WS_E8D; unsigned char* E8US = ws + WS_E8U;
    {
        const int lane = tid & 63, wave = tid >> 6; float* DSC = (float*)(ws + WS_DSC);
        for (int e = bid * 8 + wave; e < 16384; e += nb * 8) {
            const float* rp = p.e_down + (size_t)e * 2048;
            f32x4 v[8]; float mx = 0.f;
#pragma unroll
            for (int hf = 0; hf < 2; ++hf)
#pragma unroll
                for (int q = 0; q < 4; ++q) { v[hf * 4 + q] = *(const f32x4*)(rp + hf * 1024 + 16 * lane + 4 * q);
#pragma unroll
                    for (int c = 0; c < 4; ++c) mx = fmaxf(mx, fabsf(v[hf * 4 + q][c])); }
            mx = fmaxf(wmax(mx), 1e-30f);
            const float inv = 127.f / mx;
            if (lane == 0) DSC[e] = mx * (1.f / 127.f);
#pragma unroll
            for (int hf = 0; hf < 2; ++hf) { u32x4 o;
#pragma unroll
                for (int q = 0; q < 4; ++q) { unsigned w = 0u;
#pragma unroll
                    for (int c = 0; c < 4; ++c) w |= ((unsigned)__float2int_rn(v[hf * 4 + q][c] * inv) & 0xffu) << (8 * c);
                    o[q] = w; }
                *(u32x4*)(E8D + (size_t)e * 2048 + hf * 1024 + 16 * lane) = o; }
        }
    }
    for (int i = bid * NTHR + tid; i < 524288; i += nb * NTHR) {
        const int s = i & 255, eg = i >> 8;
        const float* sp = p.e_up + (size_t)(eg * 8) * 2048 + 8 * s;
        unsigned w[16];
#pragma unroll
        for (int q = 0; q < 8; ++q) { const f32x4 a = *(const f32x4*)(sp + (size_t)q * 2048), b = *(const f32x4*)(sp + (size_t)q * 2048 + 4); w[2 * q] = pack4_fp8(a * 32.f); w[2 * q + 1] = pack4_fp8(b * 32.f); }
        u32x4* dp = (u32x4*)(E8US + ((size_t)s * 16384 + eg * 8) * 8);
#pragma unroll
        for (int q = 0; q < 4; ++q) { u32x4 o; o.x = w[4 * q]; o.y = w[4 * q + 1]; o.z = w[4 * q + 2]; o.w = w[4 * q + 3]; dp[q] = o; }
    }
}

template <bool RES>
__device__ __forceinline__ void phase_norm(const float* xin, const bf16_t* yin, int gate_off, const float* gain, const float* mod, int shift_off, int scale_off, bf16_t* hout, int bid, int nb) {
    const int tid = get_tid(), lane = tid & 63, wave = tid >> 6;
    for (int row = bid * 8 + wave; row < T_; row += nb * 8) {
        const f32x4* xr = (const f32x4*)(xin + (size_t)row * D_);
        f32x4 v[8]; float ss = 0.f;
        const float* mb = mod + (size_t)(row >> 11) * NMOD;
#pragma unroll
        for (int j = 0; j < 8; ++j) { v[j] = xr[lane + 64 * j];
            if (RES) { const int k = 4 * (lane + 64 * j); const u32x2 yw = *(const u32x2*)(yin + (size_t)row * D_ + k); const f32x4 gv = *(const f32x4*)(mb + gate_off + k);
                v[j][0] += gv[0] * bflo(yw.x); v[j][1] += gv[1] * bfhi(yw.x); v[j][2] += gv[2] * bflo(yw.y); v[j][3] += gv[3] * bfhi(yw.y); }
            ss += v[j][0] * v[j][0] + v[j][1] * v[j][1] + v[j][2] * v[j][2] + v[j][3] * v[j][3]; }
        ss = wsum(ss);
        const float r = rsqrtf(ss * (1.f / D_) + EPS_);
        f32x4 hv[8];
#pragma unroll
        for (int j = 0; j < 8; ++j) {
            const int k = 4 * (lane + 64 * j);
            const f32x4 gn = *(const f32x4*)(gain + k), sh = *(const f32x4*)(mb + shift_off + k), scl = *(const f32x4*)(mb + scale_off + k);
#pragma unroll
            for (int e = 0; e < 4; ++e) hv[j][e] = (v[j][e] * r) * gn[e] * (1.f + scl[e]) + sh[e];
            u32x2 w; w.x = cvt_pk(hv[j][0], hv[j][1]); w.y = cvt_pk(hv[j][2], hv[j][3]);
            *(u32x2*)(hout + (size_t)row * D_ + k) = w;
        }
    }
}

__device__ __forceinline__ void phase_gates(const Params& p, unsigned char* lds, int bid, int nb) {
    const int tid = get_tid(), lane = tid & 63, wave = tid >> 6, r = lane & 31, hh = lane >> 5;
    unsigned char* ws = p.ws;
    const bf16_t* H = (const bf16_t*)(ws + WS_H); const bf16_t* Wg = (const bf16_t*)(ws + WS_WG); float* gate = (float*)(ws + WS_GATE);
    constexpr int WST = 4096 + 16;
    for (int i = tid; i < 16 * 256; i += NTHR) { const int g = i >> 8, c = i & 255; *(u32x4*)(lds + g * WST + c * 16) = *(const u32x4*)(Wg + (size_t)g * 2048 + c * 8); }
    __syncthreads();
    float* part = (float*)(lds + 16 * WST);
    for (int pr = bid; pr < T_ / 64; pr += nb) {
        const int t = pr * 64 + (wave >> 2) * 32 + r, kq = wave & 3;
        f32x16 acc;
#pragma unroll
        for (int i = 0; i < 16; ++i) acc[i] = 0.f;
        const bf16_t* hp = H + (size_t)t * D_ + kq * 512 + hh * 8; const unsigned char* wp = lds + (r & 15) * WST + kq * 1024 + hh * 16;
#pragma unroll 1
        for (int k0 = 0; k0 < 32; k0 += 16) {
            bf16x8 bfr[16];
#pragma unroll
            for (int j = 0; j < 16; ++j) bfr[j] = *(const bf16x8*)(hp + (k0 + j) * 16);
#pragma unroll
            for (int j = 0; j < 16; ++j) { bf16x8 a = *(const bf16x8*)(wp + (k0 + j) * 32); if (r >= 16) a = (bf16x8){0, 0, 0, 0, 0, 0, 0, 0};
                acc = __builtin_amdgcn_mfma_f32_32x32x16_bf16(a, bfr[j], acc, 0, 0, 0); }
        }
        __syncthreads();
#pragma unroll
        for (int i = 0; i < 8; ++i) part[(wave * 8 + i) * 64 + lane] = acc[i];
        __syncthreads();
        if (kq == 0) {
            float s[8];
#pragma unroll
            for (int i = 0; i < 8; ++i) s[i] = part[(wave * 8 + i) * 64 + lane] + part[((wave + 1) * 8 + i) * 64 + lane] + part[((wave + 2) * 8 + i) * 64 + lane] + part[((wave + 3) * 8 + i) * 64 + lane];
            f32x4 g0, g1; g0[0] = s[0]; g0[1] = s[1]; g0[2] = s[2]; g0[3] = s[3]; g1[0] = s[4]; g1[1] = s[5]; g1[2] = s[6]; g1[3] = s[7];
            *(f32x4*)(gate + (size_t)t * 16 + 4 * hh) = g0; *(f32x4*)(gate + (size_t)t * 16 + 8 + 4 * hh) = g1;
        }
    }
    __syncthreads();
}

__device__ __forceinline__ void phase_post(const Params& p, int bid, int nb) {
    const int tid = get_tid(), lane = tid & 63, wave = tid >> 6;
    unsigned char* ws = p.ws;
    bf16_t* Pq = (bf16_t*)(ws + WS_P); bf16_t* Pk = (bf16_t*)(ws + WS_P + SEG_B);
    const float qscale = 0.08838834764831845f * 1.4426950408889634f;
    for (int r = bid * 8 + wave; r < 2 * T_; r += nb * 8) {
        const int which = r >= T_ ? 1 : 0; const int t = r - which * T_;
        bf16_t* ptr = (which ? Pk : Pq) + (size_t)t * 1024 + lane * 16;
        const float* gn = (which ? p.fox_kg : p.fox_qg) + (lane & 7) * 16;
        u32x4 a = *(const u32x4*)ptr, b = *(const u32x4*)(ptr + 8);
        float f[16];
        f[0] = bflo(a.x); f[1] = bfhi(a.x); f[2] = bflo(a.y); f[3] = bfhi(a.y); f[4] = bflo(a.z); f[5] = bfhi(a.z); f[6] = bflo(a.w); f[7] = bfhi(a.w);
        f[8] = bflo(b.x); f[9] = bfhi(b.x); f[10] = bflo(b.y); f[11] = bfhi(b.y); f[12] = bflo(b.z); f[13] = bfhi(b.z); f[14] = bflo(b.w); f[15] = bfhi(b.w);
        float ss = 0.f;
#pragma unroll
        for (int i = 0; i < 16; ++i) ss += f[i] * f[i];
        ss += __shfl_xor(ss, 1); ss += __shfl_xor(ss, 2); ss += __shfl_xor(ss, 4);
        const float rr = rsqrtf(ss * (1.f / 128.f) + EPS_) * (which ? 1.f : qscale);
#pragma unroll
        for (int i = 0; i < 16; ++i) f[i] = (f[i] * rr) * gn[i];
        a.x = cvt_pk(f[0], f[1]); a.y = cvt_pk(f[2], f[3]); a.z = cvt_pk(f[4], f[5]); a.w = cvt_pk(f[6], f[7]);
        b.x = cvt_pk(f[8], f[9]); b.y = cvt_pk(f[10], f[11]); b.z = cvt_pk(f[12], f[13]); b.w = cvt_pk(f[14], f[15]);
        *(u32x4*)ptr = a; *(u32x4*)(ptr + 8) = b;
    }
    {
        const bf16_t* Mq = (const bf16_t*)(ws + WS_P + 3 * SEG_B); const bf16_t* Mk = (const bf16_t*)(ws + WS_P + 4 * SEG_B);
        bf16_t* QC = (bf16_t*)(ws + WS_QC); bf16_t* KC = (bf16_t*)(ws + WS_KC);
        for (int item = bid; item < 256; item += nb) {
            const int which = item >> 7, tb = item & 127, cg = tid & 127, run = tid >> 7, ch0 = cg * 8, ts = tb * 128 + run * 32, sp = ts & 2047;
            const bf16_t* src = (which ? Mk : Mq) + (size_t)ts * 1024 + ch0; bf16_t* dst = (which ? KC : QC) + (size_t)ts * 1024 + ch0;
            float w0[8], w1[8], w2[8], w3[8], cb[8], x0[8], x1[8], x2[8];
#pragma unroll
            for (int e = 0; e < 8; ++e) { const int ci = which * 1024 + ch0 + e; w0[e] = p.conv_w[ci]; w1[e] = p.conv_w[2048 + ci]; w2[e] = p.conv_w[4096 + ci]; w3[e] = p.conv_w[6144 + ci]; cb[e] = p.conv_b[ci]; }
            {   u32x4 a = {0u, 0u, 0u, 0u}, b = a, c = a;
                if (sp != 0) { a = *(const u32x4*)(src - 3 * 1024); b = *(const u32x4*)(src - 2 * 1024); c = *(const u32x4*)(src - 1024); }
#pragma unroll
                for (int e = 0; e < 4; ++e) { x0[2 * e] = bflo(a[e]); x0[2 * e + 1] = bfhi(a[e]); x1[2 * e] = bflo(b[e]); x1[2 * e + 1] = bfhi(b[e]); x2[2 * e] = bflo(c[e]); x2[2 * e + 1] = bfhi(c[e]); } }
            const float osc = which ? 0.0625f : 1.f;
            for (int s = 0; s < 32; ++s) {
                const u32x4 d = *(const u32x4*)(src + (size_t)s * 1024); float x3[8], y[8];
#pragma unroll
                for (int e = 0; e < 4; ++e) { x3[2 * e] = bflo(d[e]); x3[2 * e + 1] = bfhi(d[e]); }
#pragma unroll
                for (int e = 0; e < 8; ++e) { y[e] = silu_f(w0[e] * x0[e] + w1[e] * x1[e] + w2[e] * x2[e] + w3[e] * x3[e] + cb[e]) * osc; x0[e] = x1[e]; x1[e] = x2[e]; x2[e] = x3[e]; }
                u32x4 o; o.x = cvt_pk(y[0], y[1]); o.y = cvt_pk(y[2], y[3]); o.z = cvt_pk(y[4], y[5]); o.w = cvt_pk(y[6], y[7]);
                *(u32x4*)(dst + (size_t)s * 1024) = o;
            }
        }
    }
    const float* gate = (const float*)(ws + WS_GATE); float* F = (float*)(ws + WS_F);
    for (int sq = bid * 8 + wave; sq < 64; sq += nb * 8) {
        const int b = sq >> 3, h = sq & 7; const float fb = p.fox_fb[h];
        float v[32]; float run = 0.f;
#pragma unroll
        for (int i = 0; i < 32; ++i) { const int t = lane * 32 + i; run += logsig(gate[(size_t)(b * S_ + t) * 16 + h] + fb); v[i] = run; }
        float inc = run;
#pragma unroll
        for (int o = 1; o < 64; o <<= 1) { const float u = __shfl_up(inc, o); if (lane >= o) inc += u; }
        const float excl = inc - run;
#pragma unroll
        for (int i = 0; i < 32; ++i) F[(size_t)sq * S_ + lane * 32 + i] = (v[i] + excl) * 1.4426950408889634f;
    }
}
typedef short s16x4 __attribute__((ext_vector_type(4)));
__device__ __forceinline__ s16x4 lds_tr16(const unsigned char* p) { return __builtin_amdgcn_ds_read_tr16_b64_v4i16((LAS s16x4*)p); }
__device__ __forceinline__ bf16x8 tr_frag(const unsigned char* p0, int second_bytes) {
    const s16x4 a = lds_tr16(p0), b = lds_tr16(p0 + second_bytes);
    bf16x8 f; f[0] = a[0]; f[1] = a[1]; f[2] = a[2]; f[3] = a[3]; f[4] = b[0]; f[5] = b[1]; f[6] = b[2]; f[7] = b[3]; return f;
}
__device__ __forceinline__ void fox_unit(const Params& p, unsigned char* lds, int b, int h, int qb) {
    const int tid = get_tid(), lane = tid & 63, wave = tid >> 6, r = lane & 31, hh = lane >> 5, li = lane & 15;
    unsigned char* ws = p.ws;
    const bf16_t* Pq = (const bf16_t*)(ws + WS_P); const bf16_t* Pk = (const bf16_t*)(ws + WS_P + SEG_B); const bf16_t* Pv = (const bf16_t*)(ws + WS_P + 2 * SEG_B);
    const float* F = (const float*)(ws + WS_F) + (size_t)(b * 8 + h) * S_;
    bf16_t* Oc = (bf16_t*)(ws + WS_H);
    constexpr int KST = 272, VST = 544, BUF = 64 * KST + 64 * VST + 256;
    const int q0w = qb * 256 + wave * 32, qs = q0w + r; const int q0s = __builtin_amdgcn_readfirstlane(q0w);
    const size_t trow = (size_t)(b * S_ + qs);
    bf16x8 qf[8];
#pragma unroll
    for (int ks = 0; ks < 8; ++ks) qf[ks] = *(const bf16x8*)(Pq + trow * 1024 + h * 128 + ks * 16 + hh * 8);
    const float Fq = F[qs];
    f32x16 o[4];
#pragma unroll
    for (int d = 0; d < 4; ++d)
#pragma unroll
        for (int i = 0; i < 16; ++i) o[d][i] = 0.f;
    float m = -INFINITY, l = 0.f;
    const int ntile = (qb * 256 + 256) / 64;
    const int srow0 = tid >> 4, scc = tid & 15;
    const bf16_t* kg = Pk + (size_t)(b * S_ + srow0) * 1024 + h * 128 + scc * 8; const bf16_t* vg = Pv + (size_t)(b * S_ + srow0) * 1024 + h * 128 + scc * 8;
    u32x4 kr[2], vr[2]; float fr = 0.f;
    const int vb_off = 64 * KST + (4 * hh + (li >> 2)) * VST + (16 * (r >> 4) + 4 * (li & 3)) * 2;
    __syncthreads();
#pragma unroll
    for (int i = 0; i < 2; ++i) { kr[i] = *(const u32x4*)(kg + (size_t)(32 * i) * 1024); vr[i] = *(const u32x4*)(vg + (size_t)(32 * i) * 1024); }
    if (tid < 64) fr = F[tid];
#pragma unroll
    for (int i = 0; i < 2; ++i) { *(u32x4*)(lds + (srow0 + 32 * i) * KST + scc * 16) = kr[i]; *(u32x4*)(lds + 64 * KST + (srow0 + 32 * i) * VST + scc * 16) = vr[i]; }
    if (tid < 64) *(float*)(lds + 64 * KST + 64 * VST + tid * 4) = fr;
    __syncthreads();
    for (int kt = 0; kt < ntile; ++kt) {
        const int k0 = kt * 64; unsigned char* cur = lds + (kt & 1) * BUF; unsigned char* nxt = lds + ((kt & 1) ^ 1) * BUF;
        const bool more = kt + 1 < ntile;
        if (more) {
#pragma unroll
            for (int i = 0; i < 2; ++i) { kr[i] = *(const u32x4*)(kg + (size_t)(k0 + 64 + 32 * i) * 1024); vr[i] = *(const u32x4*)(vg + (size_t)(k0 + 64 + 32 * i) * 1024); }
            if (tid < 64) fr = F[k0 + 64 + tid];
        }
        if (k0 <= q0s + 31) {
            f32x16 s[2];
#pragma unroll
            for (int kb = 0; kb < 2; ++kb) {
#pragma unroll
                for (int i = 0; i < 16; ++i) s[kb][i] = 0.f;
#pragma unroll
                for (int ks = 0; ks < 8; ++ks) { const bf16x8 a = *(const bf16x8*)(cur + (kb * 32 + r) * KST + ks * 32 + hh * 16);
                    s[kb] = __builtin_amdgcn_mfma_f32_32x32x16_bf16(a, qf[ks], s[kb], 0, 0, 0); }
            }
            const float* Fs = (const float*)(cur + 64 * KST + 64 * VST);
            const int lim = (k0 + 63 > q0s) ? qs - k0 : 0x7fffffff;
            float mx = m;
#pragma unroll
            for (int kb = 0; kb < 2; ++kb)
#pragma unroll
                for (int g = 0; g < 4; ++g) { const f32x4 f4 = *(const f32x4*)(Fs + kb * 32 + 8 * g + 4 * hh);
#pragma unroll
                    for (int e = 0; e < 4; ++e) { float val = s[kb][4 * g + e] + (Fq - f4[e]);
                        val = (kb * 32 + 8 * g + 4 * hh + e > lim) ? -INFINITY : val;
                        s[kb][4 * g + e] = val; mx = fmaxf(mx, val); } }
            mx = fmaxf(mx, __shfl_xor(mx, 32));
            const float alpha = __builtin_amdgcn_exp2f(m - mx);
            float ps = 0.f;
#pragma unroll
            for (int kb = 0; kb < 2; ++kb)
#pragma unroll
                for (int i = 0; i < 16; ++i) { const float pv = __builtin_amdgcn_exp2f(s[kb][i] - mx); s[kb][i] = pv; ps += pv; }
            l = l * alpha + ps; m = mx;
#pragma unroll
            for (int d = 0; d < 4; ++d)
#pragma unroll
                for (int i = 0; i < 16; ++i) o[d][i] *= alpha;
#pragma unroll
            for (int kb = 0; kb < 2; ++kb)
#pragma unroll
                for (int st = 0; st < 2; ++st) {
                    u32x4 pw; pw.x = cvt_pk(s[kb][8 * st + 0], s[kb][8 * st + 1]); pw.y = cvt_pk(s[kb][8 * st + 2], s[kb][8 * st + 3]);
                    pw.z = cvt_pk(s[kb][8 * st + 4], s[kb][8 * st + 5]); pw.w = cvt_pk(s[kb][8 * st + 6], s[kb][8 * st + 7]);
                    const bf16x8 pf = __builtin_bit_cast(bf16x8, pw);
#pragma unroll
                    for (int d = 0; d < 4; ++d) { const bf16x8 vf = tr_frag(cur + vb_off + (kb * 32 + st * 16) * VST + d * 64, 8 * VST);
                        o[d] = __builtin_amdgcn_mfma_f32_32x32x16_bf16(vf, pf, o[d], 0, 0, 0); }
                }
        }
        if (more) {
#pragma unroll
            for (int i = 0; i < 2; ++i) { *(u32x4*)(nxt + (srow0 + 32 * i) * KST + scc * 16) = kr[i]; *(u32x4*)(nxt + 64 * KST + (srow0 + 32 * i) * VST + scc * 16) = vr[i]; }
            if (tid < 64) *(float*)(nxt + 64 * KST + 64 * VST + tid * 4) = fr;
        }
        __syncthreads();
    }
    l += __shfl_xor(l, 32);
    const float inv = 1.f / l;
#pragma unroll
    for (int d = 0; d < 4; ++d)
#pragma unroll
        for (int g = 0; g < 4; ++g) { u32x2 w; w.x = cvt_pk(o[d][4 * g] * inv, o[d][4 * g + 1] * inv); w.y = cvt_pk(o[d][4 * g + 2] * inv, o[d][4 * g + 3] * inv);
            *(u32x2*)(Oc + trow * D_ + h * 128 + d * 32 + 8 * g + 4 * hh) = w; }
}

__device__ __forceinline__ void mlstm_passA(const Params& p, unsigned char* lds, int unit) {
    const int tid = get_tid(), lane = tid & 63, wave = tid >> 6, r = lane & 31, hh = lane >> 5, li = lane & 15;
    const int b = unit >> 3, h = (unit >> 1) & 3, eh = unit & 1;
    unsigned char* ws = p.ws;
    const bf16_t* KC = (const bf16_t*)(ws + WS_KC); const bf16_t* Mv = (const bf16_t*)(ws + WS_P + 5 * SEG_B);
    const float* gate = (const float*)(ws + WS_GATE);
    bf16_t* Cst = (bf16_t*)(ws + WS_CST); float* nst = (float*)(ws + WS_NST); float* mst = (float*)(ws + WS_MST);
    constexpr int KST = 528, VST = 272;
    unsigned char* ksm = lds;
    unsigned char* vsm = ksm + 64 * KST;
    float* WSV = (float*)(vsm + 64 * VST);
    float* SCL = WSV + 2048;
    constexpr int STGS = 528;
    unsigned char* stg = (unsigned char*)(SCL + 128);
    __syncthreads();
    for (int cc = wave; cc < 32; cc += 8) {
        const int t = b * S_ + cc * 64 + lane;
        const float ipre = gate[(size_t)t * 16 + 8 + h] + p.m_ib[h], fpre = gate[(size_t)t * 16 + 12 + h] + p.m_fb[h];
        float bc = logsig(fpre);
#pragma unroll
        for (int o = 1; o < 64; o <<= 1) { const float u = __shfl_up(bc, o); if (lane >= o) bc += u; }
        const float a = ipre - bc; const float amax = wmax(a); const float bL = __shfl(bc, 63);
        WSV[cc * 64 + lane] = a; if (lane == 0) { SCL[cc] = bL; SCL[32 + cc] = amax; }
    }
    __syncthreads();
    if (tid == 0) { float m = 0.f; for (int cc = 0; cc < 32; ++cc) { const float mn = SCL[cc] + fmaxf(m, SCL[32 + cc]); SCL[64 + cc] = expf(SCL[cc] + m - mn); SCL[96 + cc] = mn; if (eh == 0) mst[(b * 4 + h) * 32 + cc] = m; m = mn; } }
    __syncthreads();
    for (int i = tid; i < 2048; i += NTHR) { const int cc = i >> 6; WSV[i] = expf(SCL[cc] + WSV[i] - SCL[96 + cc]); }
    f32x16 acc[4];
#pragma unroll
    for (int et = 0; et < 4; ++et)
#pragma unroll
        for (int i = 0; i < 16; ++i) acc[et][i] = 0.f;
    f32x16 accn;
#pragma unroll
    for (int i = 0; i < 16; ++i) accn[i] = 0.f;
    const int kb_off = (8 * hh + (li >> 2)) * KST + (wave * 32 + 16 * (r >> 4) + 4 * (li & 3)) * 2;
    const int vb_off = (8 * hh + (li >> 2)) * VST + (16 * (r >> 4) + 4 * (li & 3)) * 2;
    u32x4 pk[4], pv[2];
#pragma unroll
    for (int i = 0; i < 4; ++i) { const int c = tid + NTHR * i, row = c >> 5, c16 = c & 31; pk[i] = *(const u32x4*)(KC + (size_t)(b * S_ + row) * 1024 + h * 256 + c16 * 8); }
#pragma unroll
    for (int i = 0; i < 2; ++i) { const int c = tid + NTHR * i, row = c >> 4, c16 = c & 15; pv[i] = *(const u32x4*)(Mv + (size_t)(b * S_ + row) * 1024 + h * 256 + eh * 128 + c16 * 8); }
    for (int cc = 0; cc < 32; ++cc) {
        const int bhc = (b * 4 + h) * 32 + cc, t0 = b * S_ + cc * 64;
#pragma unroll
        for (int et = 0; et < 4; ++et)
#pragma unroll
            for (int g = 0; g < 4; ++g) { u32x2 o; o.x = cvt_pk(acc[et][4 * g], acc[et][4 * g + 1]); o.y = cvt_pk(acc[et][4 * g + 2], acc[et][4 * g + 3]);
                *(u32x2*)(stg + (et * 32 + r) * STGS + (wave * 32 + 8 * g + 4 * hh) * 2) = o; }
        if (eh == 0 && r == 0) {
#pragma unroll
            for (int g = 0; g < 4; ++g) { f32x4 o; o[0] = accn[4 * g]; o[1] = accn[4 * g + 1]; o[2] = accn[4 * g + 2]; o[3] = accn[4 * g + 3]; *(f32x4*)(nst + (size_t)bhc * 256 + wave * 32 + 8 * g + 4 * hh) = o; } }
        __syncthreads();
#pragma unroll
        for (int i = 0; i < 8; ++i) { const int c = tid + NTHR * i, row = c >> 5, c16 = c & 31;
            *(u32x4*)(Cst + ((size_t)bhc * 256 + eh * 128 + row) * 256 + c16 * 8) = *(const u32x4*)(stg + row * STGS + c16 * 16); }
        if (cc == 31) break;
#pragma unroll
        for (int i = 0; i < 4; ++i) { const int c = tid + NTHR * i, row = c >> 5, c16 = c & 31; *(u32x4*)(ksm + row * KST + c16 * 16) = pk[i]; }
#pragma unroll
        for (int i = 0; i < 2; ++i) { const int c = tid + NTHR * i, row = c >> 4, c16 = c & 15; const float wv = WSV[cc * 64 + row]; const u32x4 w = pv[i];
            u32x4 o; o.x = cvt_pk(bflo(w.x) * wv, bfhi(w.x) * wv); o.y = cvt_pk(bflo(w.y) * wv, bfhi(w.y) * wv); o.z = cvt_pk(bflo(w.z) * wv, bfhi(w.z) * wv); o.w = cvt_pk(bflo(w.w) * wv, bfhi(w.w) * wv);
            *(u32x4*)(vsm + row * VST + c16 * 16) = o; }
        if (cc + 1 < 31) { const int t1 = t0 + 64;
#pragma unroll
            for (int i = 0; i < 4; ++i) { const int c = tid + NTHR * i, row = c >> 5, c16 = c & 31; pk[i] = *(const u32x4*)(KC + (size_t)(t1 + row) * 1024 + h * 256 + c16 * 8); }
#pragma unroll
            for (int i = 0; i < 2; ++i) { const int c = tid + NTHR * i, row = c >> 4, c16 = c & 15; pv[i] = *(const u32x4*)(Mv + (size_t)(t1 + row) * 1024 + h * 256 + eh * 128 + c16 * 8); } }
        __syncthreads();
        const float decay = SCL[64 + cc];
#pragma unroll
        for (int et = 0; et < 4; ++et)
#pragma unroll
            for (int i = 0; i < 16; ++i) acc[et][i] *= decay;
#pragma unroll
        for (int i = 0; i < 16; ++i) accn[i] *= decay;
#pragma unroll
        for (int ks = 0; ks < 4; ++ks) {
            const bf16x8 bfr = tr_frag(ksm + kb_off + ks * 16 * KST, 4 * KST);
            {
                const f32x4 w0 = *(const f32x4*)(WSV + cc * 64 + ks * 16 + hh * 8), w1 = *(const f32x4*)(WSV + cc * 64 + ks * 16 + hh * 8 + 4);
                u32x4 wb; wb.x = cvt_pk(w0[0], w0[1]); wb.y = cvt_pk(w0[2], w0[3]); wb.z = cvt_pk(w1[0], w1[1]); wb.w = cvt_pk(w1[2], w1[3]);
                if (r != 0) wb = (u32x4){0u, 0u, 0u, 0u};
                accn = __builtin_amdgcn_mfma_f32_32x32x16_bf16(bfr, __builtin_bit_cast(bf16x8, wb), accn, 0, 0, 0); }
#pragma unroll
            for (int et = 0; et < 4; ++et) { const bf16x8 afr = tr_frag(vsm + vb_off + ks * 16 * VST + et * 64, 4 * VST);
                acc[et] = __builtin_amdgcn_mfma_f32_32x32x16_bf16(bfr, afr, acc[et], 0, 0, 0); }
        }
    }
}

__device__ __forceinline__ void mlstm_passB(const Params& p, unsigned char* lds, int unit) {
    const int tid = get_tid(), lane = tid & 63, wave = tid >> 6, r = lane & 31, hh = lane >> 5, li = lane & 15;
    const int b = unit >> 7, h = (unit >> 5) & 3, cc = unit & 31;
    unsigned char* ws = p.ws;
    const bf16_t* QC = (const bf16_t*)(ws + WS_QC); const bf16_t* KC = (const bf16_t*)(ws + WS_KC);
    const bf16_t* Mv = (const bf16_t*)(ws + WS_P + 5 * SEG_B); const bf16_t* Mo = (const bf16_t*)(ws + WS_P + 6 * SEG_B);
    const float* gate = (const float*)(ws + WS_GATE);
    const bf16_t* Cst = (const bf16_t*)(ws + WS_CST); const float* nst = (const float*)(ws + WS_NST); const float* mst = (const float*)(ws + WS_MST);
    bf16_t* Oc = (bf16_t*)(ws + WS_H);
    constexpr int QST = 528, VST = 544, WST = 144, HST = 1040;
    unsigned char* qsm = lds;
    unsigned char* ksm = qsm + 64 * QST;
    unsigned char* vsm = ksm + 64 * QST;
    unsigned char* wsm = vsm + 64 * VST;
    float* sc = (float*)(wsm + 64 * WST);
    float* hsm = (float*)lds;
    const int bhc = (b * 4 + h) * 32 + cc, t0 = b * S_ + cc * 64;
    __syncthreads();
    if (wave == 0) {
        const float ipre = gate[(size_t)(t0 + lane) * 16 + 8 + h] + p.m_ib[h], fpre = gate[(size_t)(t0 + lane) * 16 + 12 + h] + p.m_fb[h];
        float bc = logsig(fpre);
#pragma unroll
        for (int o = 1; o < 64; o <<= 1) { const float u = __shfl_up(bc, o); if (lane >= o) bc += u; }
        const float a = ipre - bc; float pm = a;
#pragma unroll
        for (int o = 1; o < 64; o <<= 1) { const float u = __shfl_up(pm, o); if (lane >= o) pm = fmaxf(pm, u); }
        const float mc = mst[bhc]; const float mt = bc + fmaxf(mc, pm);
        sc[lane] = bc - mt; sc[64 + lane] = a; sc[128 + lane] = mt; sc[192 + lane] = expf(bc + mc - mt);
    }
    bf16x8 cfr[16];
#pragma unroll
    for (int ks = 0; ks < 16; ++ks) cfr[ks] = *(const bf16x8*)(Cst + ((size_t)bhc * 256 + wave * 32 + r) * 256 + ks * 16 + hh * 8);
#pragma unroll
    for (int i = 0; i < 4; ++i) { const int c = tid + NTHR * i, row = c >> 5, c16 = c & 31;
        *(u32x4*)(qsm + row * QST + c16 * 16) = *(const u32x4*)(QC + (size_t)(t0 + row) * 1024 + h * 256 + c16 * 8);
        *(u32x4*)(ksm + row * QST + c16 * 16) = *(const u32x4*)(KC + (size_t)(t0 + row) * 1024 + h * 256 + c16 * 8);
        *(u32x4*)(vsm + row * VST + c16 * 16) = *(const u32x4*)(Mv + (size_t)(t0 + row) * 1024 + h * 256 + c16 * 8); }
    __syncthreads();
    if (wave < 3) {
        const int sb = wave >> 1, lb = wave ? 1 : 0;
        f32x16 s;
#pragma unroll
        for (int i = 0; i < 16; ++i) s[i] = 0.f;
#pragma unroll
        for (int ks = 0; ks < 16; ++ks) { const bf16x8 a = *(const bf16x8*)(ksm + (sb * 32 + r) * QST + ks * 32 + hh * 16), q = *(const bf16x8*)(qsm + (lb * 32 + r) * QST + ks * 32 + hh * 16);
            s = __builtin_amdgcn_mfma_f32_32x32x16_bf16(a, q, s, 0, 0, 0); }
        const int l = lb * 32 + r; const float bl = sc[l]; float rs = 0.f;
#pragma unroll
        for (int g = 0; g < 4; ++g) { float w[4];
#pragma unroll
            for (int e = 0; e < 4; ++e) { const int sI = sb * 32 + 8 * g + 4 * hh + e; w[e] = (sI <= l) ? s[4 * g + e] * __expf(bl + sc[64 + sI]) : 0.f; rs += w[e]; }
            u32x2 o; o.x = cvt_pk(w[0], w[1]); o.y = cvt_pk(w[2], w[3]);
            *(u32x2*)(wsm + l * WST + (sb * 32 + 8 * g + 4 * hh) * 2) = o; }
        sc[256 + l * 4 + sb * 2 + hh] = rs;
    } else if (wave == 3) {
        const int l = r;
#pragma unroll
        for (int g = 0; g < 4; ++g) { u32x2 o; o.x = 0u; o.y = 0u; *(u32x2*)(wsm + l * WST + (32 + 8 * g + 4 * hh) * 2) = o; }
        sc[256 + l * 4 + 2 + hh] = 0.f;
    }
    {
        const int l = tid & 63, part = tid >> 6; const float* np = nst + (size_t)bhc * 256 + part * 32; float s = 0.f;
#pragma unroll
        for (int q = 0; q < 4; ++q) { const u32x4 w = *(const u32x4*)(qsm + l * QST + part * 64 + q * 16);
            s += bflo(w.x) * np[8 * q] + bfhi(w.x) * np[8 * q + 1] + bflo(w.y) * np[8 * q + 2] + bfhi(w.y) * np[8 * q + 3] + bflo(w.z) * np[8 * q + 4] + bfhi(w.z) * np[8 * q + 5] + bflo(w.w) * np[8 * q + 6] + bfhi(w.w) * np[8 * q + 7]; }
        sc[512 + l * 8 + part] = s;
    }
    f32x16 acc[2];
#pragma unroll
    for (int lb = 0; lb < 2; ++lb)
#pragma unroll
        for (int i = 0; i < 16; ++i) acc[lb][i] = 0.f;
#pragma unroll
    for (int ks = 0; ks < 16; ++ks)
#pragma unroll
        for (int lb = 0; lb < 2; ++lb) { const bf16x8 q = *(const bf16x8*)(qsm + (lb * 32 + r) * QST + ks * 32 + hh * 16);
            acc[lb] = __builtin_amdgcn_mfma_f32_32x32x16_bf16(cfr[ks], q, acc[lb], 0, 0, 0); }
    __syncthreads();
#pragma unroll
    for (int lb = 0; lb < 2; ++lb) { const float it = sc[192 + lb * 32 + r];
#pragma unroll
        for (int i = 0; i < 16; ++i) acc[lb][i] *= it; }
    const int vb_off = (8 * hh + (li >> 2)) * VST + (wave * 32 + 16 * (r >> 4) + 4 * (li & 3)) * 2;
#pragma unroll
    for (int ks = 0; ks < 4; ++ks) { const bf16x8 afr = tr_frag(vsm + vb_off + ks * 16 * VST, 4 * VST);
#pragma unroll
        for (int lb = 0; lb < 2; ++lb) { if (lb == 0 && ks >= 2) continue;
            const bf16x8 wf = *(const bf16x8*)(wsm + (lb * 32 + r) * WST + ks * 32 + hh * 16);
            acc[lb] = __builtin_amdgcn_mfma_f32_32x32x16_bf16(afr, wf, acc[lb], 0, 0, 0); } }
    float ssq[2];
#pragma unroll
    for (int lb = 0; lb < 2; ++lb) { const int l = lb * 32 + r;
        const f32x4 rsv = *(const f32x4*)(sc + 256 + l * 4); const f32x4 q0 = *(const f32x4*)(sc + 512 + l * 8), q1 = *(const f32x4*)(sc + 512 + l * 8 + 4);
        const float den = (rsv[0] + rsv[1] + rsv[2] + rsv[3]) + sc[192 + l] * ((q0[0] + q0[1] + q0[2] + q0[3]) + (q1[0] + q1[1] + q1[2] + q1[3]));
        const float inv = 1.f / fmaxf(fabsf(den), __expf(-sc[128 + l]));
        float s2 = 0.f;
#pragma unroll
        for (int i = 0; i < 16; ++i) { acc[lb][i] *= inv; s2 += acc[lb][i] * acc[lb][i]; }
        s2 += __shfl_xor(s2, 32); ssq[lb] = s2; }
    __syncthreads();
    if (hh == 0) { sc[1024 + r * 8 + wave] = ssq[0]; sc[1024 + (32 + r) * 8 + wave] = ssq[1]; }
#pragma unroll
    for (int lb = 0; lb < 2; ++lb)
#pragma unroll
        for (int g = 0; g < 4; ++g) { f32x4 v; v[0] = acc[lb][4 * g]; v[1] = acc[lb][4 * g + 1]; v[2] = acc[lb][4 * g + 2]; v[3] = acc[lb][4 * g + 3];
            *(f32x4*)((unsigned char*)hsm + (lb * 32 + r) * HST + (wave * 32 + 8 * g + 4 * hh) * 4) = v; }
    __syncthreads();
#pragma unroll
    for (int i = 0; i < 4; ++i) { const int c = tid + NTHR * i, l = c >> 5, e0 = (c & 31) * 8;
        const f32x4 s0 = *(const f32x4*)(sc + 1024 + l * 8), s1 = *(const f32x4*)(sc + 1024 + l * 8 + 4);
        const float rr = rsqrtf(((s0[0] + s0[1] + s0[2] + s0[3]) + (s1[0] + s1[1] + s1[2] + s1[3])) * (1.f / 256.f) + EPS_);
        const f32x4 h0 = *(const f32x4*)((unsigned char*)hsm + l * HST + e0 * 4), h1 = *(const f32x4*)((unsigned char*)hsm + l * HST + e0 * 4 + 16);
        const f32x4 g0 = *(const f32x4*)(p.m_hg + h * 256 + e0), g1 = *(const f32x4*)(p.m_hg + h * 256 + e0 + 4);
        const u32x4 mo = *(const u32x4*)(Mo + (size_t)(t0 + l) * 1024 + h * 256 + e0);
        u32x4 o;
        o.x = cvt_pk(h0[0] * rr * g0[0] * sigm(bflo(mo.x)), h0[1] * rr * g0[1] * sigm(bfhi(mo.x))); o.y = cvt_pk(h0[2] * rr * g0[2] * sigm(bflo(mo.y)), h0[3] * rr * g0[3] * sigm(bfhi(mo.y)));
        o.z = cvt_pk(h1[0] * rr * g1[0] * sigm(bflo(mo.z)), h1[1] * rr * g1[1] * sigm(bfhi(mo.z))); o.w = cvt_pk(h1[2] * rr * g1[2] * sigm(bflo(mo.w)), h1[3] * rr * g1[3] * sigm(bfhi(mo.w)));
        *(u32x4*)(Oc + (size_t)(t0 + l) * D_ + 1024 + h * 256 + e0) = o; }
}

__device__ __forceinline__ void ce_desc(float& a, float& b) { const float hi = fmaxf(a, b), lo = fminf(a, b); a = hi; b = lo; }
__device__ __forceinline__ void sort16_desc(float (&v)[16]) {
#pragma unroll
    for (int k = 2; k <= 16; k <<= 1)
#pragma unroll
        for (int j = k >> 1; j > 0; j >>= 1)
#pragma unroll
            for (int i = 0; i < 16; ++i) { const int l = i ^ j; if (l > i) { if ((i & k) == 0) ce_desc(v[i], v[l]); else ce_desc(v[l], v[i]); } }
}
__device__ __forceinline__ void bmerge16_desc(float (&v)[16]) {
#pragma unroll
    for (int j = 8; j > 0; j >>= 1)
#pragma unroll
        for (int i = 0; i < 16; ++i) { const int l = i ^ j; if (l > i) ce_desc(v[i], v[l]); }
}
__device__ __forceinline__ void merge_top16(float (&a)[16], const float (&b)[16]) {
#pragma unroll
    for (int i = 0; i < 16; ++i) a[i] = fmaxf(a[i], b[15 - i]);
    bmerge16_desc(a);
}
__device__ __forceinline__ float pack_idx(float v, unsigned mask, unsigned idx) { return __builtin_bit_cast(float, (__builtin_bit_cast(unsigned, v) & mask) | idx); }
__device__ __forceinline__ void top16_from_acc(const f32x16 (&acc)[4], int h, float (&out)[16]) {
    float g[4][16];
#pragma unroll
    for (int mt = 0; mt < 4; ++mt) {
#pragma unroll
        for (int i = 0; i < 16; ++i) g[mt][i] = pack_idx(acc[mt][i], 0xffffff80u, (unsigned)(32 * mt + (i & 3) + 8 * (i >> 2)) | ((unsigned)h << 2));
        sort16_desc(g[mt]);
    }
    merge_top16(g[0], g[1]); merge_top16(g[2], g[3]); merge_top16(g[0], g[2]);
    float o[16];
#pragma unroll
    for (int i = 0; i < 16; ++i) o[i] = __shfl_xor(g[0][i], 32);
    merge_top16(g[0], o);
#pragma unroll
    for (int i = 0; i < 16; ++i) out[i] = g[0][i];
}
__device__ __forceinline__ unsigned lut16(const unsigned (&P)[4], unsigned i) {
    const unsigned long long lo = (unsigned long long)P[0] | ((unsigned long long)P[1] << 32), hi = (unsigned long long)P[2] | ((unsigned long long)P[3] << 32);
    const unsigned long long s = (i & 8u) ? hi : lo;
    return (unsigned)(s >> ((i & 7u) * 8u)) & 0xffu;
}
struct CandTab { int i[50]; int j[50]; };
constexpr CandTab make_cand_tab() { CandTab t{}; int n = 0; for (int i = 0; i < 16; ++i) for (int j = 0; j < 16; ++j) if ((i + 1) * (j + 1) <= 16) { t.i[n] = i; t.j[n] = j; ++n; } return t; }
__device__ __forceinline__ void phase_topk(const Params& p, unsigned char* lds, int bid, int nb) {
    const int tid = get_tid(), lane = tid & 63, wave = tid >> 6, r = lane & 31, h = lane >> 5;
    unsigned char* ws = p.ws;
    const bf16_t* Q = (const bf16_t*)(ws + WS_Q); int* IDX = (int*)(ws + WS_IDX); float* GW = (float*)(ws + WS_GW);
    constexpr int KP = 136;
    bf16_t* KS = (bf16_t*)lds;
    for (int i = tid; i < 2 * 16384; i += NTHR) { const int which = i >> 14, n = (i >> 7) & 127, d = i & 127; const float v = (which ? p.sk2 : p.sk1)[i & 16383];
        const unsigned hb = cvt_pk(v, 0.f) & 0xffffu; const float lo = v - bf2f((bf16_t)hb);
        KS[((which * 2 + 0) * 128 + n) * KP + d] = (bf16_t)hb; KS[((which * 2 + 1) * 128 + n) * KP + d] = (bf16_t)(cvt_pk(lo, 0.f) & 0xffffu); }
    __syncthreads();
    for (int item = bid * 8 + wave; item < 512 * 8; item += nb * 8) {
        const int tt = item >> 3, hh = item & 7, t = tt * 32 + r;
        float top[2][16];
#pragma unroll
        for (int list = 0; list < 2; ++list) {
            bf16x8 qf[8];
#pragma unroll
            for (int ks = 0; ks < 8; ++ks) qf[ks] = *(const bf16x8*)(Q + (size_t)t * D_ + hh * 256 + list * 128 + ks * 16 + h * 8);
            float g[4][16];
#pragma unroll
            for (int mt = 0; mt < 4; ++mt) {
                f32x16 acc;
#pragma unroll
                for (int i = 0; i < 16; ++i) acc[i] = 0.f;
#pragma unroll
                for (int hl = 0; hl < 2; ++hl)
#pragma unroll
                    for (int ks = 0; ks < 8; ++ks) { const bf16x8 a = *(const bf16x8*)(KS + ((list * 2 + hl) * 128 + mt * 32 + r) * KP + ks * 16 + h * 8);
                        acc = __builtin_amdgcn_mfma_f32_32x32x16_bf16(a, qf[ks], acc, 0, 0, 0); }
#pragma unroll
                for (int i = 0; i < 16; ++i) g[mt][i] = pack_idx(acc[i], 0xffffff80u, (unsigned)(32 * mt + (i & 3) + 8 * (i >> 2)) | ((unsigned)h << 2));
                sort16_desc(g[mt]);
                __builtin_amdgcn_sched_barrier(0);
            }
            merge_top16(g[0], g[1]); merge_top16(g[2], g[3]); merge_top16(g[0], g[2]);
            {   float o[16];
#pragma unroll
                for (int i = 0; i < 16; ++i) o[i] = __shfl_xor(g[0][i], 32);
                merge_top16(g[0], o); }
#pragma unroll
            for (int i = 0; i < 16; ++i) top[list][i] = g[0][i];
            __builtin_amdgcn_sched_barrier(0);
        }
        unsigned P1[4], P2[4];
#pragma unroll
        for (int q = 0; q < 4; ++q) { P1[q] = 0u; P2[q] = 0u;
#pragma unroll
            for (int e = 0; e < 4; ++e) { P1[q] |= (__builtin_bit_cast(unsigned, top[0][4 * q + e]) & 127u) << (8 * e); P2[q] |= (__builtin_bit_cast(unsigned, top[1][4 * q + e]) & 127u) << (8 * e); } }
        float c[4][16];
#pragma unroll
        for (int n = 0; n < 64; ++n) {
            if (n < 50) { constexpr CandTab CT = make_cand_tab(); const int i = CT.i[n], j = CT.j[n];
                c[n >> 4][n & 15] = pack_idx(top[0][i] + top[1][j], 0xffffff00u, (unsigned)(i * 16 + j)); }
            else c[n >> 4][n & 15] = -INFINITY;
        }
        sort16_desc(c[0]); __builtin_amdgcn_sched_barrier(0); sort16_desc(c[1]); __builtin_amdgcn_sched_barrier(0); merge_top16(c[0], c[1]); __builtin_amdgcn_sched_barrier(0);
        sort16_desc(c[2]); __builtin_amdgcn_sched_barrier(0); sort16_desc(c[3]); __builtin_amdgcn_sched_barrier(0); merge_top16(c[2], c[3]); __builtin_amdgcn_sched_barrier(0); merge_top16(c[0], c[2]);
        float ex[16], sum = 0.f;
#pragma unroll
        for (int k = 0; k < 16; ++k) { ex[k] = __expf(c[0][k] - c[0][0]); sum += ex[k]; }
        const float inv = 1.f / sum;
        if (h == 0) {
            int* ip = IDX + (size_t)t * 128 + hh * 16; float* gp = GW + (size_t)t * 128 + hh * 16;
#pragma unroll
            for (int q = 0; q < 4; ++q) { u32x4 iv; f32x4 gv;
#pragma unroll
                for (int e = 0; e < 4; ++e) { const unsigned pos = __builtin_bit_cast(unsigned, c[0][4 * q + e]) & 255u;
                    iv[e] = lut16(P1, pos >> 4) * 128u + lut16(P2, pos & 15u); gv[e] = ex[4 * q + e] * inv; }
                *(u32x4*)(ip + 4 * q) = iv; *(f32x4*)(gp + 4 * q) = gv; }
        }
    }
}

typedef float f32x2 __attribute__((ext_vector_type(2)));
__device__ __forceinline__ float dot16_fp8(const u32x4 w, const float (&h)[32], int o) {
    float s = 0.f;
#pragma unroll
    for (int q = 0; q < 4; ++q) { const f32x2 lo = __builtin_amdgcn_cvt_pk_f32_fp8((int)w[q], false), hi = __builtin_amdgcn_cvt_pk_f32_fp8((int)w[q], true);
        fmac(s, lo[0], h[o + 4 * q]); fmac(s, lo[1], h[o + 4 * q + 1]); fmac(s, hi[0], h[o + 4 * q + 2]); fmac(s, hi[1], h[o + 4 * q + 3]); }
    return s;
}
template <int CTRL, int ROW_MASK, int BANK_MASK>
__device__ __forceinline__ int dpp_mov0i(int v) { return __builtin_amdgcn_update_dpp(0, v, CTRL, ROW_MASK, BANK_MASK, true); }
__device__ __forceinline__ void phase_peer1(const Params& p, unsigned char* lds, int bid, int nb, int probe) {
    const int tid = get_tid(), lane = tid & 63, wave = tid >> 6, r = lane >> 4, c16 = lane & 15;
    unsigned char* ws = p.ws;
    const bf16_t* H2 = (const bf16_t*)(ws + WS_H2); const int* IDX = (const int*)(ws + WS_IDX); const float* GW = (const float*)(ws + WS_GW);
    unsigned* EWT = (unsigned*)(ws + WS_EWT); const float* DSC = (const float*)(ws + WS_DSC);
    const unsigned char* E8D = ws + WS_E8D + 16 * c16; const unsigned emask = probe ? 0x3ffu : 0x3fffu;
    LAS unsigned* seq = (LAS unsigned*)((LAS unsigned char*)lds + wave * 2048 + r * 512);
    LAS unsigned* hist = (LAS unsigned*)((LAS unsigned char*)lds + 16384 + wave * 256 + r * 64);
    for (int tile = bid; tile < 256; tile += nb)
        for (int ps = 0; ps < 2; ++ps) {
            const int t = tile * 64 + ps * 32 + wave * 4 + r;
            unsigned hq[32]; float hsc;
            {   float mx = 0.f; u32x4 raw[16];
#pragma unroll
                for (int q = 0; q < 8; ++q) { raw[2 * q] = *(const u32x4*)(H2 + (size_t)t * D_ + 256 * q + 16 * c16); raw[2 * q + 1] = *(const u32x4*)(H2 + (size_t)t * D_ + 256 * q + 16 * c16 + 8); }
#pragma unroll
                for (int i = 0; i < 16; ++i)
#pragma unroll
                    for (int e = 0; e < 4; ++e) mx = fmaxf(mx, fmaxf(fabsf(bflo(raw[i][e])), fabsf(bfhi(raw[i][e]))));
                mx = fmaxf(mx, __shfl_xor(mx, 1)); mx = fmaxf(mx, __shfl_xor(mx, 2)); mx = fmaxf(mx, __shfl_xor(mx, 4)); mx = fmaxf(mx, __shfl_xor(mx, 8));
                mx = fmaxf(mx, 1e-30f); const float inv = 127.f / mx; hsc = mx * (1.f / 127.f);
#pragma unroll
                for (int i = 0; i < 16; ++i)
#pragma unroll
                    for (int hh = 0; hh < 2; ++hh) {
                        const unsigned w0 = raw[i][2 * hh], w1 = raw[i][2 * hh + 1];
                        hq[2 * i + hh] = ((unsigned)__float2int_rn(bflo(w0) * inv) & 0xffu) | (((unsigned)__float2int_rn(bfhi(w0) * inv) & 0xffu) << 8) | (((unsigned)__float2int_rn(bflo(w1) * inv) & 0xffu) << 16) | (((unsigned)__float2int_rn(bfhi(w1) * inv) & 0xffu) << 24); }
            }
            int idx[8]; unsigned pos[8];
#pragma unroll
            for (int m = 0; m < 8; ++m) idx[m] = IDX[(size_t)t * 128 + c16 + 16 * m];
            hist[c16] = 0u;
#pragma unroll
            for (int m = 0; m < 8; ++m) pos[m] = __hip_atomic_fetch_add(&hist[idx[m] >> 10], 1u, __ATOMIC_RELAXED, __HIP_MEMORY_SCOPE_WORKGROUP);
            {   const unsigned c = hist[c16]; unsigned inc = c;
#pragma unroll
                for (int o = 1; o < 16; o <<= 1) { const unsigned u = __shfl_up(inc, o, 16); if (c16 >= o) inc += u; }
                hist[c16] = inc - c; }
#pragma unroll
            for (int m = 0; m < 8; ++m) { pos[m] += hist[idx[m] >> 10]; seq[pos[m]] = (unsigned)idx[m] | ((unsigned)(c16 + 16 * m) << 14); }
            u32x4 cur[8], nxt[8];
            {   const unsigned char* rp = E8D + (size_t)(seq[0] & emask) * 2048;
#pragma unroll
                for (int q = 0; q < 8; ++q) cur[q] = *(const u32x4*)(rp + 256 * q); }
            for (int s = 0; s < 128; ++s) {
                if (s + 1 < 128) { const unsigned char* rp = E8D + (size_t)(seq[s + 1] & emask) * 2048;
#pragma unroll
                    for (int q = 0; q < 8; ++q) nxt[q] = *(const u32x4*)(rp + 256 * q); }
                int d0 = 0, d1 = 0;
#pragma unroll
                for (int q = 0; q < 8; ++q) { d0 = __builtin_amdgcn_sdot4((int)cur[q][0], (int)hq[4 * q], d0, false); d1 = __builtin_amdgcn_sdot4((int)cur[q][1], (int)hq[4 * q + 1], d1, false);
                    d0 = __builtin_amdgcn_sdot4((int)cur[q][2], (int)hq[4 * q + 2], d0, false); d1 = __builtin_amdgcn_sdot4((int)cur[q][3], (int)hq[4 * q + 3], d1, false); }
                int d = d0 + d1;
                d += dpp_mov0i<0x111, 0xf, 0xf>(d); d += dpp_mov0i<0x112, 0xf, 0xf>(d); d += dpp_mov0i<0x114, 0xf, 0xe>(d); d += dpp_mov0i<0x118, 0xf, 0xc>(d);
                if (c16 == 15) seq[s] = (unsigned)d;
#pragma unroll
                for (int q = 0; q < 8; ++q) cur[q] = nxt[q];
            }
            if (probe) continue;
            unsigned* ep = EWT + (size_t)(t >> 6) * 8192 + (t & 63) * 4;
#pragma unroll
            for (int m = 0; m < 8; ++m) { const int j = c16 + 16 * m;
                const float a = (float)(int)seq[pos[m]] * hsc * DSC[idx[m]];
                const float w = GW[(size_t)t * 128 + j] * 0.5f * a * (1.f + erff(a * 0.7071067811865476f));
                ep[(j >> 2) * 256 + (j & 3)] = (cvt_pk(0.f, w) & 0xffff0000u) | (unsigned)idx[m]; }
        }
}
__device__ __forceinline__ void phase_peer2(const Params& p, unsigned char* lds, int bid, int nb) {
    const int tid = get_tid(), lane = tid & 63, wave = tid >> 6;
    unsigned char* ws = p.ws;
    const unsigned* EWT = (const unsigned*)(ws + WS_EWT); const bf16_t* Y = (const bf16_t*)(ws + WS_X1); const float* mod = (const float*)(ws + WS_MOD);
    for (int si = bid; si < 256; si += nb) {
        const int s = (si & 7) * 32 + (si >> 3);
        __syncthreads();
        {   const u32x4* sp = (const u32x4*)(ws + WS_E8U + (size_t)s * 131072);
#pragma unroll
            for (int i = 0; i < 16; ++i) ((u32x4*)lds)[tid + NTHR * i] = sp[tid + NTHR * i]; }
        __syncthreads();
        const int tb0 = ((si >> 5) * 32 + wave) & 255;
        unsigned cur[16], nxt[16];
        {   const u32x4* wp = (const u32x4*)(EWT + (size_t)tb0 * 8192) + lane;
#pragma unroll
            for (int u = 0; u < 4; ++u) { const u32x4 v = wp[u * 64]; cur[4 * u] = v.x; cur[4 * u + 1] = v.y; cur[4 * u + 2] = v.z; cur[4 * u + 3] = v.w; } }
        float acc[8];
#pragma unroll
        for (int c = 0; c < 8; ++c) acc[c] = 0.f;
        f32x4 xa = {0.f, 0.f, 0.f, 0.f}, xb = xa;
        for (int q = 0; q < 256; ++q) {
            const int tb = (tb0 + 8 * (q >> 3)) & 255, g = q & 7;
            if (q + 1 < 256) { const int tbn = (tb0 + 8 * ((q + 1) >> 3)) & 255; const u32x4* wp = (const u32x4*)(EWT + (size_t)tbn * 8192 + ((q + 1) & 7) * 1024) + lane;
#pragma unroll
                for (int u = 0; u < 4; ++u) { const u32x4 v = wp[u * 64]; nxt[4 * u] = v.x; nxt[4 * u + 1] = v.y; nxt[4 * u + 2] = v.z; nxt[4 * u + 3] = v.w; } }
            const int t = tb * 64 + lane;
            if (g == 0) { xa = *(const f32x4*)(p.x + (size_t)t * D_ + 8 * s); xb = *(const f32x4*)(p.x + (size_t)t * D_ + 8 * s + 4);
                const u32x4 yw = *(const u32x4*)(Y + (size_t)t * D_ + 8 * s); const float* g1 = mod + (size_t)(t >> 11) * NMOD + 2 * D_ + 8 * s; const f32x4 ha = *(const f32x4*)g1, hb = *(const f32x4*)(g1 + 4);
                xa[0] += ha[0] * bflo(yw.x); xa[1] += ha[1] * bfhi(yw.x); xa[2] += ha[2] * bflo(yw.y); xa[3] += ha[3] * bfhi(yw.y); xb[0] += hb[0] * bflo(yw.z); xb[1] += hb[1] * bfhi(yw.z); xb[2] += hb[2] * bflo(yw.w); xb[3] += hb[3] * bfhi(yw.w); }
            u32x2 row[16];
#pragma unroll
            for (int u = 0; u < 16; ++u) row[u] = *(const LAS u32x2*)(unsigned)((cur[u] << 3) & 0x1fff8u);
#pragma unroll
            for (int u = 0; u < 16; ++u) {
                const float w = __builtin_bit_cast(float, cur[u]);
                const f32x2 v0 = __builtin_amdgcn_cvt_pk_f32_fp8((int)row[u].x, false), v1 = __builtin_amdgcn_cvt_pk_f32_fp8((int)row[u].x, true), v2 = __builtin_amdgcn_cvt_pk_f32_fp8((int)row[u].y, false), v3 = __builtin_amdgcn_cvt_pk_f32_fp8((int)row[u].y, true);
                fmac(acc[0], w, v0[0]); fmac(acc[1], w, v0[1]); fmac(acc[2], w, v1[0]); fmac(acc[3], w, v1[1]); fmac(acc[4], w, v2[0]); fmac(acc[5], w, v2[1]); fmac(acc[6], w, v3[0]); fmac(acc[7], w, v3[1]);
            }
            if (g == 7) {
                const float* g2 = mod + (size_t)(t >> 11) * NMOD + 5 * D_ + 8 * s;
                const f32x4 ga = *(const f32x4*)g2, gb = *(const f32x4*)(g2 + 4);
                f32x4 oa, ob;
#pragma unroll
                for (int c = 0; c < 4; ++c) { oa[c] = xa[c] + ga[c] * acc[c] * (1.f / 32.f); ob[c] = xb[c] + gb[c] * acc[4 + c] * (1.f / 32.f); }
                *(f32x4*)(p.out + (size_t)t * D_ + 8 * s) = oa; *(f32x4*)(p.out + (size_t)t * D_ + 8 * s + 4) = ob;
#pragma unroll
                for (int c = 0; c < 8; ++c) acc[c] = 0.f;
            }
#pragma unroll
            for (int u = 0; u < 16; ++u) cur[u] = nxt[u];
        }
    }
}

typedef const __attribute__((address_space(4))) Params* KargPtr;
__device__ __forceinline__ Params load_params() {
#if defined(__HIP_DEVICE_COMPILE__)
    KargPtr kp = (KargPtr)__builtin_amdgcn_kernarg_segment_ptr(); asm volatile("" : "+s"(kp)); Params r; __builtin_memcpy(&r, kp, sizeof(Params)); return r;
#else
    return Params{};
#endif
}
constexpr int N_PHASES = 12;
constexpr int LDS_BYTES = 152 * 1024;
__global__ void __launch_bounds__(NTHR) fwd_kernel(Params p_arg) {
    extern __shared__ __attribute__((aligned(16))) unsigned char lds[];
    const int bid = blockIdx.x, nb = gridDim.x, tid = get_tid();
    unsigned char* ws = p_arg.ws;
    volatile LAS unsigned* xbst = (volatile LAS unsigned*)((LAS unsigned char*)lds + LDS_BYTES - 16);
    if (tid == 0) { xbst[0] = 0u; xbst[1] = 0u; xbst[2] = 0u; xbst[3] = 0u; }
    __syncthreads();
    if ((p_arg.ph_hi - p_arg.ph_lo) > 1) (void)xcd_barrier_post((unsigned*)(ws + WS_BAR), xbst);
#ifdef ONLY_PHASE
#define IN(k) ((k) == ONLY_PHASE && p.ph_lo <= (k) && (k) < p.ph_hi)
#else
#define IN(k) (p.ph_lo <= (k) && (k) < p.ph_hi)
#endif
#define SEAM(k) do { const Params p = load_params(); if (p.ph_lo <= (k) && (k) + 1 < p.ph_hi) { XcdBarrier bar; bar.bar = (unsigned*)(p.ws + WS_BAR); bar.x = xb_xcc_id(); bar.st = xbst; xcd_barrier(bar); } } while (0)
#ifndef REPEAT_MASK
#define REPEAT_MASK 0
#endif
#define REP(k) for (int rep_ = 0; rep_ < (((REPEAT_MASK) >> (k)) & 1) + 1; ++rep_)
    REP(0) { const Params p = load_params(); if (IN(0)) { unsigned char* ws = p.ws; const float* mod = (const float*)(ws + WS_MOD); (void)mod;
        phase_prep(p, lds, bid, nb);
    } }
    SEAM(0);
    REP(1) { const Params p = load_params(); if (IN(1)) { unsigned char* ws = p.ws; const float* mod = (const float*)(ws + WS_MOD); (void)mod;
        phase_norm<false>(p.x, nullptr, 0, p.g1, mod, 0, D_, (bf16_t*)(ws + WS_H), bid, nb);
    } }
    SEAM(1);
    REP(2) { const Params p = load_params(); if (IN(2)) { unsigned char* ws = p.ws; const float* mod = (const float*)(ws + WS_MOD); (void)mod;
        phase_gates(p, lds, bid, nb);
        { pg8::Gemm g{(const bf16_t*)(ws + WS_H), (const bf16_t*)(ws + WS_WINT), T_, 7168, D_}; pg8::StaticOrder S; S.init(T_, 7168, nb, bid);
        pg8::EpiSeg E{(bf16_t*)(ws + WS_P)}; pg8::gemm_phase<pg8::EpiSeg, pg8::StaticOrder, true, true>((LAS unsigned char*)lds, g, S, E); }
    } }
    SEAM(2);
    REP(3) { const Params p = load_params(); if (IN(3)) { unsigned char* ws = p.ws; const float* mod = (const float*)(ws + WS_MOD); (void)mod;
        phase_post(p, bid, nb);
    } }
    SEAM(3);
    REP(4) { const Params p = load_params(); if (IN(4)) { unsigned char* ws = p.ws; const float* mod = (const float*)(ws + WS_MOD); (void)mod;
        { for (int u = bid; u < 64; u += nb) mlstm_passA(p, lds, u);
        unsigned* qctr = (unsigned*)(ws + WS_QCTR) + rep_; LAS int* slot = (LAS int*)((LAS unsigned char*)lds + LDS_BYTES - 32);
        for (;;) { __syncthreads(); if (tid == 0) *slot = (int)atomicAdd(qctr, 1u); __syncthreads(); const int u = *slot; if (u >= 512) break;
            const int bh = u & 63; fox_unit(p, lds, bh >> 3, bh & 7, 7 - (u >> 6)); } }
    } }
    SEAM(4);
    REP(5) { const Params p = load_params(); if (IN(5)) { unsigned char* ws = p.ws; const float* mod = (const float*)(ws + WS_MOD); (void)mod;
        { for (int u = bid; u < 1024; u += nb) mlstm_passB(p, lds, u); }
    } }
    SEAM(5);
    REP(6) { const Params p = load_params(); if (IN(6)) { unsigned char* ws = p.ws; const float* mod = (const float*)(ws + WS_MOD); (void)mod;
        { pg8::Gemm g{(const bf16_t*)(ws + WS_H), (const bf16_t*)(ws + WS_WOT), T_, D_, D_}; pg8::StaticOrder S; S.init(T_, D_, nb, bid);
        pg8::EpiBf E{(bf16_t*)(ws + WS_X1), D_}; pg8::gemm_phase<pg8::EpiBf, pg8::StaticOrder, true, true>((LAS unsigned char*)lds, g, S, E); }
    } }
    SEAM(6);
    REP(7) { const Params p = load_params(); if (IN(7)) { unsigned char* ws = p.ws; const float* mod = (const float*)(ws + WS_MOD); (void)mod;
        convert_experts(p, bid, nb);
    } }
    REP(7) { const Params p = load_params(); if (IN(7)) { unsigned char* ws = p.ws; const float* mod = (const float*)(ws + WS_MOD); (void)mod;
        phase_norm<true>(p.x, (const bf16_t*)(ws + WS_X1), 2 * D_, p.g2, mod, 3 * D_, 4 * D_, (bf16_t*)(ws + WS_H2), bid, nb);
    } }
    SEAM(7);
    REP(8) { const Params p = load_params(); if (IN(8)) { unsigned char* ws = p.ws; const float* mod = (const float*)(ws + WS_MOD); (void)mod;
        { pg8::Gemm g{(const bf16_t*)(ws + WS_H2), (const bf16_t*)(ws + WS_WQT), T_, D_, D_}; pg8::StaticOrder S; S.init(T_, D_, nb, bid);
        pg8::EpiBf E{(bf16_t*)(ws + WS_Q), D_}; pg8::gemm_phase<pg8::EpiBf, pg8::StaticOrder, true, true>((LAS unsigned char*)lds, g, S, E); }
    } }
    SEAM(8);
    REP(9) { const Params p = load_params(); if (IN(9)) { unsigned char* ws = p.ws; const float* mod = (const float*)(ws + WS_MOD); (void)mod;
        phase_topk(p, lds, bid, nb);
    } }
    SEAM(9);
    REP(10) { const Params p = load_params(); if (IN(10)) { unsigned char* ws = p.ws; const float* mod = (const float*)(ws + WS_MOD); (void)mod;
#ifdef PROBE_L2
        phase_peer1(p, lds, bid, nb, rep_);
#else
        phase_peer1(p, lds, bid, nb, 0);
#endif
    } }
    SEAM(10);
    REP(11) { const Params p = load_params(); if (IN(11)) { unsigned char* ws = p.ws; const float* mod = (const float*)(ws + WS_MOD); (void)mod;
        phase_peer2(p, lds, bid, nb);
    } }
#undef IN
#undef SEAM
}

#ifndef ONE_LAUNCH
#define ONE_LAUNCH 1
#endif
extern "C" void kernel_launch(void* const* d_in, const int* in_sizes, int n_in, void* d_out, int out_size, void* d_ws, size_t ws_size, hipStream_t stream) {
    static int grid = 0;
    if (grid == 0) {
        int dev = 0, cus = 0, per_cu = 0;
        if (n_in != 21 || ws_size < WS_END) { fprintf(stderr, "kernel_launch: unexpected n_in %d / ws_size %zu (need %zu)\n", n_in, ws_size, (size_t)WS_END); grid = -1; return; }
        hipGetDevice(&dev); hipDeviceGetAttribute(&cus, hipDeviceAttributeMultiprocessorCount, dev);
        if (hipFuncSetAttribute((const void*)fwd_kernel, hipFuncAttributeMaxDynamicSharedMemorySize, LDS_BYTES) != hipSuccess) { fprintf(stderr, "kernel_launch: hipFuncSetAttribute failed\n"); grid = -1; return; }
        if (hipOccupancyMaxActiveBlocksPerMultiprocessor(&per_cu, (const void*)fwd_kernel, NTHR, LDS_BYTES) != hipSuccess || per_cu < 1) { fprintf(stderr, "kernel_launch: occupancy query says %d\n", per_cu); (void)hipGetLastError(); }
        grid = cus > 0 ? cus : 256;
    }
    if (grid < 0) return;
    Params p{};
    const float** pp = (const float**)&p;
    for (int i = 0; i < 21; ++i) pp[i] = (const float*)d_in[i];
    p.out = (float*)d_out; p.ws = (unsigned char*)d_ws;
    hipMemsetAsync((char*)d_ws + WS_BAR, 0, 16384, stream);
#if ONE_LAUNCH
    p.ph_lo = 0; p.ph_hi = N_PHASES;
    void* args[] = {&p};
    hipError_t e = hipLaunchCooperativeKernel((const void*)fwd_kernel, dim3(grid), dim3(NTHR), args, LDS_BYTES, stream);
    if (e != hipSuccess) fprintf(stderr, "cooperative launch failed: %s (grid %d)\n", hipGetErrorString(e), grid);
#else
    for (int ph = 0; ph < N_PHASES; ++ph) { p.ph_lo = ph; p.ph_hi = ph + 1; hipLaunchKernelGGL(fwd_kernel, dim3(grid), dim3(NTHR), LDS_BYTES, stream, p); }
#endif
}
```

```cpp
#include <hip/hip_runtime.h>
#include <cstdio>
#include <cstdint>

#define GAS __attribute__((address_space(1)))
#define LAS __attribute__((address_space(3)))
typedef unsigned short bf16_t;
typedef short bf16x8 __attribute__((ext_vector_type(8)));
typedef float f32x4 __attribute__((ext_vector_type(4)));
typedef float f32x16 __attribute__((ext_vector_type(16)));
typedef unsigned u32x4 __attribute__((ext_vector_type(4)));
typedef unsigned u32x2 __attribute__((ext_vector_type(2)));

constexpr int T_ = 16384, D_ = 2048, B_ = 8, S_ = 2048, NTHR = 512;
constexpr float EPS_ = 1e-6f;
constexpr int NMOD = 6 * D_;
constexpr int INCOLS = 7184;

constexpr size_t WS_BAR   = 0;
constexpr size_t WS_MOD   = 16384;
constexpr size_t WS_WG    = WS_MOD + (size_t)B_ * NMOD * 4;
constexpr size_t WS_GATE  = WS_WG + 16 * 2048 * 4;
constexpr size_t WS_F     = WS_GATE + (size_t)T_ * 16 * 4;
constexpr size_t WS_NST   = WS_F + 64 * 2048 * 4;
constexpr size_t WS_MST   = WS_NST + 1024 * 256 * 4;
constexpr size_t WS_DSC   = WS_MST + 4096;
constexpr size_t WS_WINT  = WS_DSC + 16384 * 4;
constexpr size_t WS_WOT   = WS_WINT + (size_t)7168 * 2048 * 2;
constexpr size_t WS_WQT   = WS_WOT + (size_t)2048 * 2048 * 2;
constexpr size_t WS_H     = WS_WQT + (size_t)2048 * 2048 * 2;
constexpr size_t WS_P     = WS_H + (size_t)T_ * 2048 * 2;
constexpr size_t SEG_B    = (size_t)T_ * 1024 * 2;
constexpr size_t WS_CST   = WS_P + 7 * SEG_B;
constexpr size_t WS_E8D   = WS_CST + (size_t)1024 * 256 * 256 * 2;
constexpr size_t WS_E8U   = WS_E8D + (size_t)16384 * 2048;
constexpr size_t WS_END   = WS_E8U + (size_t)16384 * 2048;
constexpr size_t WS_QC    = WS_E8D;
constexpr size_t WS_KC    = WS_E8U;
constexpr size_t WS_QCTR  = 15360;
constexpr size_t WS_H2    = WS_P;
constexpr size_t WS_Q     = WS_H2 + (size_t)T_ * 2048 * 2;
constexpr size_t WS_IDX   = WS_Q + (size_t)T_ * 2048 * 2;
constexpr size_t WS_GW    = WS_IDX + (size_t)T_ * 128 * 4;
static_assert(WS_GW + (size_t)T_ * 128 * 4 <= WS_CST, "alias overflow");
constexpr size_t WS_X1    = WS_CST;
constexpr size_t WS_EWT   = WS_GW + (size_t)T_ * 128 * 4;
static_assert(WS_EWT + (size_t)T_ * 128 * 4 <= WS_CST, "alias overflow 2");

struct Params {
    const float *x, *c, *w_ada, *b_ada, *g1, *g2, *w_in, *fox_fb, *fox_qg, *fox_kg, *conv_w, *conv_b, *m_ib, *m_fb, *m_hg, *w_out, *w_q, *sk1, *sk2, *e_down, *e_up;
    float* out; unsigned char* ws; int ph_lo, ph_hi;
};

__device__ __forceinline__ int get_tid() { int t = threadIdx.x; asm volatile("" : "+v"(t)); return t; }
__device__ __forceinline__ void lds_barrier() { asm volatile("s_waitcnt lgkmcnt(0)\n\ts_barrier" ::: "memory"); }
__device__ __forceinline__ unsigned cvt_pk(float lo, float hi) { unsigned r; asm("v_cvt_pk_bf16_f32 %0, %1, %2" : "=v"(r) : "v"(lo), "v"(hi)); return r; }
__device__ __forceinline__ void fmac(float& acc, float a, float b) { asm("v_fmac_f32 %0, %1, %2" : "+v"(acc) : "v"(a), "v"(b)); }
__device__ __forceinline__ float bf2f(unsigned short h) { return __builtin_bit_cast(float, ((unsigned)h) << 16); }
__device__ __forceinline__ float bflo(unsigned w) { return __builtin_bit_cast(float, w << 16); }
__device__ __forceinline__ float bfhi(unsigned w) { return __builtin_bit_cast(float, w & 0xffff0000u); }
__device__ __forceinline__ float wsum(float v) {
#pragma unroll
    for (int o = 32; o; o >>= 1) v += __shfl_xor(v, o);
    return v; }
__device__ __forceinline__ float wmax(float v) {
#pragma unroll
    for (int o = 32; o; o >>= 1) v = fmaxf(v, __shfl_xor(v, o));
    return v; }
__device__ __forceinline__ float logsig(float x) { return fminf(x, 0.f) - log1pf(expf(-fabsf(x))); }
__device__ __forceinline__ float sigm(float x) { return 1.f / (1.f + expf(-x)); }
__device__ __forceinline__ float silu_f(float x) { return x / (1.f + expf(-x)); }
namespace pg8 {
#define PG8_LAS __attribute__((address_space(3)))
typedef unsigned short bf16_t;
typedef short bf16x8 __attribute__((ext_vector_type(8)));
typedef float f32x4 __attribute__((ext_vector_type(4)));
typedef unsigned u32x4 __attribute__((ext_vector_type(4)));
constexpr int BM = 256, BK = 64, HALF = 128, HTB = HALF * BK * 2  , STAGE_BYTES = 8 * HTB, NXCD = 8, WGM = 8;

__host__ __device__ __forceinline__ int lds_byte(int r, int c) { const int st = (r >> 4) * 2 + (c >> 5), rr = r & 15, cc = c & 31, ob = rr * 64 + cc * 2; return st * 1024 + (ob ^ (((ob >> 9) & 1) << 5)); }
__host__ __device__ __forceinline__ void stage_rc(int b, int& R, int& C) { const int st = b / 1024, sb = b % 1024, swz = sb ^ (((sb >> 9) & 1) << 5); R = (st >> 1) * 16 + swz / 64; C = (st & 1) * 32 + (swz % 64) / 2; }
__host__ __device__ __forceinline__ int perm32(int rho) { const int n = rho >> 4, i = rho & 15; return 8 * (i >> 2) + 4 * n + (i & 3); }

struct Unit { int pm, pn; };
struct Gemm { const bf16_t* A; const bf16_t* Bt; int M, N, K; };

struct StaticOrder {
    int nM, nN, nwg, G, c;
    __host__ __device__ void init(int M, int N, int G_, int c_) { nM = M / BM; nN = N / BM; nwg = nM * nN; G = G_; c = c_; }
    __host__ __device__ bool next(int i, Unit& u) const {
        const long L = (long)i * G + c; if (L >= nwg) return false;
        int wgid = (int)L; { const int q = nwg / NXCD, r = nwg % NXCD, xcd = wgid % NXCD, off = wgid / NXCD; wgid = (xcd < r ? xcd * (q + 1) : r * (q + 1) + (xcd - r) * q) + off; }
        const int nig = WGM * nN, gid = wgid / nig, fm = gid * WGM, gsz = (nM - fm) < WGM ? (nM - fm) : WGM;
        u.pm = fm + ((wgid % nig) % gsz); u.pn = (wgid % nig) / gsz; return true;
    }
    __device__ __forceinline__ void a_ready(const Unit&) const {}
    __device__ __forceinline__ void done(const Unit&) const {}
};
struct EpiSeg {
    static constexpr bool PERM = true, AFTER_DRAIN = false;
    bf16_t* P;
    __device__ __forceinline__ void operator()(const f32x4 (&acc)[2][2][4][2], const Unit& u, int wr, int wc, int fr, int fq) const {
        const int seg = u.pn >> 2; bf16_t* base = P + (size_t)seg * ((size_t)T_ * 1024);
        const int row0 = u.pm * BM + wr * 64 + fr, col0 = (u.pn & 3) * 256 + wc * 32 + 8 * fq;
#pragma unroll
        for (int ai = 0; ai < 2; ++ai)
#pragma unroll
            for (int m = 0; m < 4; ++m) { bf16_t* rowp = base + (size_t)(row0 + ai * HALF + m * 16) * 1024 + col0;
#pragma unroll
                for (int bj = 0; bj < 2; ++bj) { const f32x4 v0 = acc[ai][bj][m][0], v1 = acc[ai][bj][m][1];
                    u32x4 w; w.x = cvt_pk(v0[0], v0[1]); w.y = cvt_pk(v0[2], v0[3]); w.z = cvt_pk(v1[0], v1[1]); w.w = cvt_pk(v1[2], v1[3]);
                    *(u32x4*)(rowp + bj * HALF) = w; } }
    }
};
struct EpiBf {
    static constexpr bool PERM = true, AFTER_DRAIN = false;
    bf16_t* O; int ldc;
    __device__ __forceinline__ void operator()(const f32x4 (&acc)[2][2][4][2], const Unit& u, int wr, int wc, int fr, int fq) const {
        const int row0 = u.pm * BM + wr * 64 + fr, col0 = u.pn * BM + wc * 32 + 8 * fq;
#pragma unroll
        for (int ai = 0; ai < 2; ++ai)
#pragma unroll
            for (int m = 0; m < 4; ++m) { bf16_t* rowp = O + (size_t)(row0 + ai * HALF + m * 16) * ldc + col0;
#pragma unroll
                for (int bj = 0; bj < 2; ++bj) { const f32x4 v0 = acc[ai][bj][m][0], v1 = acc[ai][bj][m][1];
                    u32x4 w; w.x = cvt_pk(v0[0], v0[1]); w.y = cvt_pk(v0[2], v0[3]); w.z = cvt_pk(v1[0], v1[1]); w.w = cvt_pk(v1[2], v1[3]);
                    *(u32x4*)(rowp + bj * HALF) = w; } }
    }
};
struct EpiRes {
    static constexpr bool PERM = false, AFTER_DRAIN = false;
    const float* X; float* O; const float* mod; int goff;
    __device__ __forceinline__ void operator()(const f32x4 (&acc)[2][2][4][2], const Unit& u, int wr, int wc, int fr, int fq) const {
        const int row0 = u.pm * BM + wr * 64 + fr, col0 = u.pn * BM + wc * 32 + 4 * fq;
        const float* gp = mod + (size_t)((u.pm * BM) >> 11) * NMOD + goff + col0;
        f32x4 gv[2][2];
#pragma unroll
        for (int bj = 0; bj < 2; ++bj)
#pragma unroll
            for (int n = 0; n < 2; ++n) gv[bj][n] = *(const f32x4*)(gp + bj * HALF + 16 * n);
#pragma unroll
        for (int ai = 0; ai < 2; ++ai)
#pragma unroll
            for (int m = 0; m < 4; ++m) { const size_t ro = (size_t)(row0 + ai * HALF + m * 16) * D_ + col0;
#pragma unroll
                for (int bj = 0; bj < 2; ++bj)
#pragma unroll
                    for (int n = 0; n < 2; ++n) { const f32x4 xv = *(const f32x4*)(X + ro + bj * HALF + 16 * n);
                        *(f32x4*)(O + ro + bj * HALF + 16 * n) = xv + gv[bj][n] * acc[ai][bj][m][n]; } }
    }
};
template <class Epi, class Sched, bool ALIGN_EPI = false, bool SP2 = false>
__device__ __forceinline__ void gemm_phase(PG8_LAS unsigned char* lds, const Gemm g, const Sched& S, const Epi& E) {
    const int tid = get_tid(), wid = __builtin_amdgcn_readfirstlane(tid >> 6), lane = tid & 63, wr = wid >> 2, wc = wid & 3, fr = lane & 15, fq = lane >> 4;
    const int K = g.K, nt = K / BK;
    unsigned voffA[2], voffB[2];
#pragma unroll
    for (int i = 0; i < 2; ++i) { int R, C; stage_rc(tid * 16 + i * 8192, R, C); const int Rb = Epi::PERM ? ((R & ~31) + perm32(R & 31)) : R;
        voffA[i] = (unsigned)(R * K + C) * 2u; voffB[i] = (unsigned)(Rb * K + C) * 2u; }
    const size_t kstep = (size_t)(BK * 2);
    const size_t hstep = (size_t)HALF * K * 2;
    const size_t tstep = 2 * hstep;
    const unsigned ldsw = (unsigned)wid * 1024u;
    const int aoff = lds_byte(wr * 64 + fr, fq * 8), boff = lds_byte(wc * 32 + fr, fq * 8);
#define PG8_SA(b, h) (((b) * 2 + (h)) * HTB)
#define PG8_SB(b, h) ((4 + (b) * 2 + (h)) * HTB)
#define PG8_STAGE(bufoff, gbase, voff) do { _Pragma("unroll") for (int _i = 0; _i < 2; ++_i) \
        __builtin_amdgcn_global_load_lds((const unsigned*)((const char*)(gbase) + (voff)[_i]), (PG8_LAS unsigned*)(lds + (bufoff) + ldsw + _i * 8192), 16, 0, 0); } while (0)
#define PG8_LDA(dst, b, h) do { _Pragma("unroll") for (int m = 0; m < 4; ++m) _Pragma("unroll") for (int k = 0; k < 2; ++k) dst[m][k] = *(const PG8_LAS bf16x8*)(lds + PG8_SA(b, h) + aoff + m * 2048 + k * 1024); } while (0)
#define PG8_LDB(dst, b, h) do { _Pragma("unroll") for (int n = 0; n < 2; ++n) _Pragma("unroll") for (int k = 0; k < 2; ++k) dst[n][k] = *(const PG8_LAS bf16x8*)(lds + PG8_SB(b, h) + boff + n * 2048 + k * 1024); } while (0)
#define PG8_MMA(ai, bj, At, Bt) do { __builtin_amdgcn_s_setprio(1); _Pragma("unroll") for (int m = 0; m < 4; ++m) _Pragma("unroll") for (int n = 0; n < 2; ++n) _Pragma("unroll") for (int k = 0; k < 2; ++k) \
        acc[ai][bj][m][n] = __builtin_amdgcn_mfma_f32_16x16x32_bf16(Bt[n][k], At[m][k], acc[ai][bj][m][n], 0, 0, 0); __builtin_amdgcn_s_setprio(0); } while (0)
#define PG8_WAIT_V(n) asm volatile("s_waitcnt vmcnt(" #n ")" ::: "memory")
#define PG8_WAIT_L(n) asm volatile("s_waitcnt lgkmcnt(" #n ")" ::: "memory")
#define PG8_BAR __builtin_amdgcn_s_barrier()
#define PG8_SCHED __builtin_amdgcn_sched_barrier(0)
    Unit cur, nxt; int ui = 0;
    if (!S.next(0, cur)) return;
    f32x4 acc[2][2][4][2];
#pragma unroll
    for (int a = 0; a < 2; ++a)
#pragma unroll
        for (int b = 0; b < 2; ++b)
#pragma unroll
            for (int m = 0; m < 4; ++m)
#pragma unroll
                for (int n = 0; n < 2; ++n) acc[a][b][m][n] = (f32x4){0.f, 0.f, 0.f, 0.f};
    bf16x8 At[4][2], B0[2][2], B1[2][2];
    const char* cA = (const char*)g.A + (size_t)cur.pm * tstep; const char* cB = (const char*)g.Bt + (size_t)cur.pn * tstep;
    S.a_ready(cur);
    if constexpr (SP2) {
        PG8_STAGE(PG8_SB(0, 0), cB, voffB); PG8_STAGE(PG8_SB(0, 1), cB + hstep, voffB); PG8_STAGE(PG8_SA(0, 0), cA, voffA); PG8_STAGE(PG8_SA(0, 1), cA + hstep, voffA);
        if (wr == 1) PG8_BAR;
        PG8_WAIT_V(2); PG8_BAR;
        PG8_STAGE(PG8_SB(1, 0), cB + kstep, voffB); PG8_STAGE(PG8_SA(1, 0), cA + kstep, voffA); PG8_STAGE(PG8_SB(1, 1), cB + hstep + kstep, voffB);
        PG8_WAIT_V(6); PG8_BAR;
    } else {
        PG8_STAGE(PG8_SB(0, 0), cB, voffB); PG8_STAGE(PG8_SA(0, 0), cA, voffA); PG8_STAGE(PG8_SB(0, 1), cB + hstep, voffB); PG8_STAGE(PG8_SA(0, 1), cA + hstep, voffA);
        if (wr == 1) PG8_BAR;
        PG8_WAIT_V(4); PG8_BAR;
        PG8_STAGE(PG8_SB(1, 0), cB + kstep, voffB); PG8_STAGE(PG8_SA(1, 0), cA + kstep, voffA); PG8_STAGE(PG8_SB(1, 1), cB + hstep + kstep, voffB);
        PG8_WAIT_V(6); PG8_BAR;
    }
    for (;;) {
        const bool has_next = S.next(ui + 1, nxt);
        const char* nA = has_next ? (const char*)g.A + (size_t)nxt.pm * tstep : cA; const char* nB = has_next ? (const char*)g.Bt + (size_t)nxt.pn * tstep : cB;
        for (int t = 0; t < nt; t += 2) {
            const bool last = (t == nt - 2);
            const char* a1 = cA + (size_t)(t + 1) * kstep;
            const char* a2 = last ? nA : cA + (size_t)(t + 2) * kstep; const char* b2 = last ? nB : cB + (size_t)(t + 2) * kstep;
            const char* a3 = a2 + kstep; const char* b3 = b2 + kstep;
            if (last && has_next) S.a_ready(nxt);
            if constexpr (SP2) {
            PG8_LDB(B0, 0, 0); PG8_LDB(B1, 0, 1); PG8_SCHED; PG8_LDA(At, 0, 0); PG8_STAGE(PG8_SA(1, 1), a1 + hstep, voffA);
            PG8_WAIT_V(8); PG8_WAIT_L(0); PG8_BAR; PG8_MMA(0, 0, At, B0); PG8_MMA(0, 1, At, B1); PG8_BAR; PG8_SCHED;
            PG8_LDA(At, 0, 1); PG8_STAGE(PG8_SB(0, 0), b2, voffB); PG8_STAGE(PG8_SB(0, 1), b2 + hstep, voffB); PG8_STAGE(PG8_SA(0, 0), a2, voffA);
            PG8_WAIT_V(8); PG8_WAIT_L(0); PG8_BAR; PG8_MMA(1, 0, At, B0); PG8_MMA(1, 1, At, B1); PG8_BAR; PG8_SCHED;
            PG8_LDB(B0, 1, 0); PG8_LDB(B1, 1, 1); PG8_SCHED; PG8_LDA(At, 1, 0); PG8_STAGE(PG8_SA(0, 1), a2 + hstep, voffA);
            PG8_WAIT_V(8); PG8_WAIT_L(0); PG8_BAR; PG8_MMA(0, 0, At, B0); PG8_MMA(0, 1, At, B1); PG8_BAR; PG8_SCHED;
            PG8_LDA(At, 1, 1); PG8_STAGE(PG8_SB(1, 0), b3, voffB); PG8_STAGE(PG8_SB(1, 1), b3 + hstep, voffB); PG8_STAGE(PG8_SA(1, 0), a3, voffA);
            PG8_WAIT_V(8); PG8_WAIT_L(0); PG8_BAR; PG8_MMA(1, 0, At, B0); PG8_MMA(1, 1, At, B1); PG8_BAR; PG8_SCHED;
            } else {
            PG8_LDB(B0, 0, 0); PG8_SCHED; PG8_LDA(At, 0, 0); PG8_STAGE(PG8_SA(1, 1), a1 + hstep, voffA);
            PG8_WAIT_L(8); PG8_BAR; PG8_WAIT_L(0); PG8_MMA(0, 0, At, B0); PG8_BAR; PG8_SCHED;
            PG8_LDB(B1, 0, 1); PG8_STAGE(PG8_SB(0, 0), b2, voffB);
            PG8_BAR; PG8_WAIT_L(0); PG8_MMA(0, 1, At, B1); PG8_BAR;
            PG8_LDA(At, 0, 1); PG8_STAGE(PG8_SA(0, 0), a2, voffA);
            PG8_BAR; PG8_WAIT_L(0); PG8_MMA(1, 0, At, B0); PG8_BAR; PG8_SCHED;
            PG8_STAGE(PG8_SB(0, 1), b2 + hstep, voffB);
            PG8_WAIT_V(6); PG8_BAR; PG8_MMA(1, 1, At, B1); PG8_BAR;
            PG8_LDB(B0, 1, 0); PG8_SCHED; PG8_LDA(At, 1, 0); PG8_STAGE(PG8_SA(0, 1), a2 + hstep, voffA);
            PG8_WAIT_L(8); PG8_BAR; PG8_WAIT_L(0); PG8_MMA(0, 0, At, B0); PG8_BAR; PG8_SCHED;
            PG8_LDB(B1, 1, 1); PG8_STAGE(PG8_SB(1, 0), b3, voffB);
            PG8_BAR; PG8_WAIT_L(0); PG8_MMA(0, 1, At, B1); PG8_BAR;
            PG8_LDA(At, 1, 1); PG8_STAGE(PG8_SA(1, 0), a3, voffA);
            PG8_BAR; PG8_WAIT_L(0); PG8_MMA(1, 0, At, B0); PG8_BAR; PG8_SCHED;
            PG8_STAGE(PG8_SB(1, 1), b3 + hstep, voffB);
            PG8_WAIT_V(6); PG8_BAR; PG8_MMA(1, 1, At, B1); PG8_BAR;
            }
        }
        if constexpr (ALIGN_EPI) { if (wr == 0) PG8_BAR; }
        if constexpr (!Epi::AFTER_DRAIN) { E(acc, cur, wr, wc, fr, fq); S.done(cur); }
        if (!has_next) break;
#pragma unroll
        for (int a = 0; a < 2; ++a)
#pragma unroll
            for (int b = 0; b < 2; ++b)
#pragma unroll
                for (int m = 0; m < 4; ++m)
#pragma unroll
                    for (int n = 0; n < 2; ++n) acc[a][b][m][n] = (f32x4){0.f, 0.f, 0.f, 0.f};
        cur = nxt; cA = nA; cB = nB; ++ui;
        if constexpr (ALIGN_EPI) { if (wr == 1) PG8_BAR; }
    }
    PG8_WAIT_V(0);
    if constexpr (!ALIGN_EPI) { if (wr == 0) PG8_BAR; }
    PG8_BAR;
    if constexpr (Epi::AFTER_DRAIN) { E.fused(acc, cur, wr, wc, fr, fq, lds, wid, lane); S.done(cur); }
#undef PG8_SA
#undef PG8_SB
#undef PG8_STAGE
#undef PG8_LDA
#undef PG8_LDB
#undef PG8_MMA
#undef PG8_WAIT_V
#undef PG8_WAIT_L
#undef PG8_BAR
#undef PG8_SCHED
}
}
#define XB_TMO      128
#define XB_XCNT(j)  (256  + 64 * (j))
#define XB_XSUB(j)  (1280 + 64 * (j))
#define XB_XGEN(j)  (2304 + 64 * (j))
#define XB_TOP      3328
#define XB_TOPGEN   3392
#define XCD_BAR_WORDS 3456
#define XB_SPIN_CAP (1u << 18)

__device__ __forceinline__ unsigned xb_ld(unsigned* p)              { return __hip_atomic_load(p, __ATOMIC_RELAXED, __HIP_MEMORY_SCOPE_AGENT); }
__device__ __forceinline__ unsigned xb_add(unsigned* p, unsigned v) { return __hip_atomic_fetch_add(p, v, __ATOMIC_RELAXED, __HIP_MEMORY_SCOPE_AGENT); }
__device__ __forceinline__ unsigned xb_xcc_id() { return (unsigned)__builtin_amdgcn_s_getreg((3 << 11) | 20) & 0xFu; }
#define XB_SPIN(cond, bar) do { unsigned _sp = 0; while (cond) { __builtin_amdgcn_s_sleep(1); \
    if ((++_sp & 255u) == 0u) { if (xb_ld(&(bar)[XB_TMO])) break; if (_sp > XB_SPIN_CAP) { atomicAdd(&(bar)[XB_TMO], 1u); break; } } } } while (0)

struct XcdBarrier {
    unsigned* bar; unsigned x;
    volatile LAS unsigned* st;
};

__device__ __forceinline__ XcdBarrier xcd_barrier_post(unsigned* bar, volatile LAS unsigned* st) {
    XcdBarrier b; b.bar = bar; b.x = xb_xcc_id(); b.st = st;
    if (threadIdx.x == 0) (void)xb_add(&bar[XB_XCNT(b.x)], 1u);
    return b;
}
__device__ __forceinline__ void xcd_barrier_complete(unsigned* bar, unsigned x, unsigned& nloc, unsigned& nx) {
    const unsigned G = gridDim.x * gridDim.y * gridDim.z;
    unsigned sum, cnt, mine, sp = 0u;
    for (;;) {
        sum = 0u; cnt = 0u; mine = 0u;
#pragma unroll
        for (unsigned j = 0; j < 16; ++j) { const unsigned c = xb_ld(&bar[XB_XCNT(j)]); sum += c; cnt += (c > 0u) ? 1u : 0u; mine = (j == x) ? c : mine; }
        if (sum == G) break;
        __builtin_amdgcn_s_sleep(1);
        if ((++sp & 255u) == 0u) { if (xb_ld(&bar[XB_TMO])) break; if (sp > XB_SPIN_CAP) { atomicAdd(&bar[XB_TMO], 1u); break; } }
    }
    nloc = mine > 0u ? mine : 1u; nx = cnt > 0u ? cnt : 1u;
}

__device__ __forceinline__ void xcd_barrier(const XcdBarrier& b) {
    asm volatile("s_waitcnt vmcnt(0)" ::: "memory");
    __syncthreads();
    if (threadIdx.x == 0) {
        unsigned* bar = b.bar;
        __builtin_amdgcn_s_waitcnt(0);
        unsigned nloc = b.st[0], nx = b.st[1];
        if (nloc == 0u) { xcd_barrier_complete(bar, b.x, nloc, nx); b.st[0] = nloc; b.st[1] = nx; }
        const unsigned old = xb_add(&bar[XB_XSUB(b.x)], 1u);
        const unsigned gen = old / nloc;
        if (old + 1u == (gen + 1u) * nloc) {
            __builtin_amdgcn_fence(__ATOMIC_RELEASE, "agent");
            asm volatile("s_waitcnt vmcnt(0)" ::: "memory");
            const unsigned og = xb_add(&bar[XB_TOP], 1u);
            const unsigned tg = og / nx;
            if (og + 1u == (tg + 1u) * nx) xb_add(&bar[XB_TOPGEN], 1u);
            else XB_SPIN(xb_ld(&bar[XB_TOPGEN]) == tg, bar);
            __builtin_amdgcn_fence(__ATOMIC_ACQUIRE, "agent");
            xb_add(&bar[XB_XGEN(b.x)], 1u);
            asm volatile("s_waitcnt vmcnt(0)" ::: "memory");
        } else {
            XB_SPIN(xb_ld(&bar[XB_XGEN(b.x)]) == gen, bar);
            __builtin_amdgcn_fence(__ATOMIC_ACQUIRE, "agent");
            asm volatile("s_waitcnt vmcnt(0)" ::: "memory");
        }
    }
    __syncthreads();
}
__device__ __forceinline__ void phase_prep(const Params& p, unsigned char* lds, int bid, int nb) {
    const int tid = get_tid(), lane = tid & 63, wave = tid >> 6;
    unsigned char* ws = p.ws;
    float* mod = (float*)(ws + WS_MOD);
    if (bid < 192) {
        float* sc = (float*)lds;
        float* red = sc + 8 * 2048;
        for (int i = tid; i < 8 * 2048; i += NTHR) sc[i] = silu_f(p.c[i]);
        __syncthreads();
        for (int it = bid; it < 192; it += nb) {
            const int col = it * 64 + lane;
            float acc[8];
#pragma unroll
            for (int b = 0; b < 8; ++b) acc[b] = 0.f;
            const float* w = p.w_ada + (size_t)(wave * 256) * NMOD + col;
            const float* s0 = sc + wave * 256;
#pragma unroll 4
            for (int k = 0; k < 256; ++k) {
                const float wv = w[(size_t)k * NMOD];
#pragma unroll
                for (int b = 0; b < 8; ++b) acc[b] += s0[b * 2048 + k] * wv;
            }
#pragma unroll
            for (int b = 0; b < 8; ++b) red[(wave * 8 + b) * 64 + lane] = acc[b];
            __syncthreads();
            {   const int b = wave; float s = p.b_ada[col];
#pragma unroll
                for (int w2 = 0; w2 < 8; ++w2) s += red[(w2 * 8 + b) * 64 + lane];
                mod[b * NMOD + col] = s; }
            __syncthreads();
        }
    }
    __syncthreads();
    {
        float* tile = (float*)lds;
        bf16_t* WinT = (bf16_t*)(ws + WS_WINT); bf16_t* WoT = (bf16_t*)(ws + WS_WOT); bf16_t* WqT = (bf16_t*)(ws + WS_WQT);
        for (int item = bid; item < 5632; item += nb) {
            const float* src; int ld, scol; bf16_t* dst; int kt;
            if (item < 3584) { const int seg = item >> 9, rem = item & 511, ntile = rem >> 5; kt = rem & 31;
                src = p.w_in; ld = INCOLS; scol = (seg < 3 ? seg * 1024 : 3080 + (seg - 3) * 1024) + ntile * 64; dst = WinT + (size_t)(seg * 1024 + ntile * 64) * 2048; }
            else if (item < 4608) { const int rem = item - 3584, ntile = rem >> 5; kt = rem & 31; src = p.w_out; ld = 2048; scol = ntile * 64; dst = WoT + (size_t)(ntile * 64) * 2048; }
            else { const int rem = item - 4608, ntile = rem >> 5; kt = rem & 31; src = p.w_q; ld = 2048; scol = ntile * 64; dst = WqT + (size_t)(ntile * 64) * 2048; }
            const int k0 = kt * 64;
#pragma unroll
            for (int ii = 0; ii < 8; ++ii) { const int k = wave + 8 * ii; tile[k * 65 + lane] = src[(size_t)(k0 + k) * ld + scol + lane]; }
            __syncthreads();
#pragma unroll
            for (int ii = 0; ii < 8; ++ii) { const int n = wave + 8 * ii; dst[(size_t)n * 2048 + k0 + lane] = (bf16_t)(cvt_pk(tile[lane * 65 + n], 0.f) & 0xffffu); }
            __syncthreads();
        }
    }
    {
        bf16_t* Wg = (bf16_t*)(ws + WS_WG);
        for (int i = bid * NTHR + tid; i < 16 * 2048; i += nb * NTHR) { const int g = i >> 11, k = i & 2047; const int col = g < 8 ? 3072 + g : 7176 + (g - 8);
            Wg[i] = (bf16_t)(cvt_pk(p.w_in[(size_t)k * INCOLS + col], 0.f) & 0xffffu); }
    }
}

__device__ __forceinline__ unsigned pack4_fp8(const f32x4 a) { int t = __builtin_amdgcn_cvt_pk_fp8_f32(a[0], a[1], 0, false); t = __builtin_amdgcn_cvt_pk_fp8_f32(a[2], a[3], t, true); return (unsigned)t; }
__device__ __forceinline__ void convert_experts(const Params& p, int bid, int nb) {
    const int tid = get_tid(); unsigned char* ws = p.ws;
    unsigned char* E8D = ws + WS_E8D; unsigned char* E8US = ws + WS_E8U;
    {
        const int lane = tid & 63, wave = tid >> 6; float* DSC = (float*)(ws + WS_DSC);
        for (int e = bid * 8 + wave; e < 16384; e += nb * 8) {
            const float* rp = p.e_down + (size_t)e * 2048;
            f32x4 v[8]; float mx = 0.f;
#pragma unroll
            for (int hf = 0; hf < 2; ++hf)
#pragma unroll
                for (int q = 0; q < 4; ++q) { v[hf * 4 + q] = *(const f32x4*)(rp + hf * 1024 + 16 * lane + 4 * q);
#pragma unroll
                    for (int c = 0; c < 4; ++c) mx = fmaxf(mx, fabsf(v[hf * 4 + q][c])); }
            mx = fmaxf(wmax(mx), 1e-30f);
            const float inv = 127.f / mx;
            if (lane == 0) DSC[e] = mx * (1.f / 127.f);
#pragma unroll
            for (int hf = 0; hf < 2; ++hf) { u32x4 o;
#pragma unroll
                for (int q = 0; q < 4; ++q) { unsigned w = 0u;
#pragma unroll
                    for (int c = 0; c < 4; ++c) w |= ((unsigned)__float2int_rn(v[hf * 4 + q][c] * inv) & 0xffu) << (8 * c);
                    o[q] = w; }
                *(u32x4*)(E8D + (size_t)e * 2048 + hf * 1024 + 16 * lane) = o; }
        }
    }
    for (int i = bid * NTHR + tid; i < 524288; i += nb * NTHR) {
        const int s = i & 255, eg = i >> 8;
        const float* sp = p.e_up + (size_t)(eg * 8) * 2048 + 8 * s;
        unsigned w[16];
#pragma unroll
        for (int q = 0; q < 8; ++q) { const f32x4 a = *(const f32x4*)(sp + (size_t)q * 2048), b = *(const f32x4*)(sp + (size_t)q * 2048 + 4); w[2 * q] = pack4_fp8(a * 32.f); w[2 * q + 1] = pack4_fp8(b * 32.f); }
        u32x4* dp = (u32x4*)(E8US + ((size_t)s * 16384 + eg * 8) * 8);
#pragma unroll
        for (int q = 0; q < 4; ++q) { u32x4 o; o.x = w[4 * q]; o.y = w[4 * q + 1]; o.z = w[4 * q + 2]; o.w = w[4 * q + 3]; dp[q] = o; }
    }
}

template <bool RES>
__device__ __forceinline__ void phase_norm(const float* xin, const bf16_t* yin, int gate_off, const float* gain, const float* mod, int shift_off, int scale_off, bf16_t* hout, int bid, int nb) {
    const int tid = get_tid(), lane = tid & 63, wave = tid >> 6;
    for (int row = bid * 8 + wave; row < T_; row += nb * 8) {
        const f32x4* xr = (const f32x4*)(xin + (size_t)row * D_);
        f32x4 v[8]; float ss = 0.f;
        const float* mb = mod + (size_t)(row >> 11) * NMOD;
#pragma unroll
        for (int j = 0; j < 8; ++j) { v[j] = xr[lane + 64 * j];
            if (RES) { const int k = 4 * (lane + 64 * j); const u32x2 yw = *(const u32x2*)(yin + (size_t)row * D_ + k); const f32x4 gv = *(const f32x4*)(mb + gate_off + k);
                v[j][0] += gv[0] * bflo(yw.x); v[j][1] += gv[1] * bfhi(yw.x); v[j][2] += gv[2] * bflo(yw.y); v[j][3] += gv[3] * bfhi(yw.y); }
            ss += v[j][0] * v[j][0] + v[j][1] * v[j][1] + v[j][2] * v[j][2] + v[j][3] * v[j][3]; }
        ss = wsum(ss);
        const float r = rsqrtf(ss * (1.f / D_) + EPS_);
        f32x4 hv[8];
#pragma unroll
        for (int j = 0; j < 8; ++j) {
            const int k = 4 * (lane + 64 * j);
            const f32x4 gn = *(const f32x4*)(gain + k), sh = *(const f32x4*)(mb + shift_off + k), scl = *(const f32x4*)(mb + scale_off + k);
#pragma unroll
            for (int e = 0; e < 4; ++e) hv[j][e] = (v[j][e] * r) * gn[e] * (1.f + scl[e]) + sh[e];
            u32x2 w; w.x = cvt_pk(hv[j][0], hv[j][1]); w.y = cvt_pk(hv[j][2], hv[j][3]);
            *(u32x2*)(hout + (size_t)row * D_ + k) = w;
        }
    }
}

__device__ __forceinline__ void phase_gates(const Params& p, unsigned char* lds, int bid, int nb) {
    const int tid = get_tid(), lane = tid & 63, wave = tid >> 6, r = lane & 31, hh = lane >> 5;
    unsigned char* ws = p.ws;
    const bf16_t* H = (const bf16_t*)(ws + WS_H); const bf16_t* Wg = (const bf16_t*)(ws + WS_WG); float* gate = (float*)(ws + WS_GATE);
    constexpr int WST = 4096 + 16;
    for (int i = tid; i < 16 * 256; i += NTHR) { const int g = i >> 8, c = i & 255; *(u32x4*)(lds + g * WST + c * 16) = *(const u32x4*)(Wg + (size_t)g * 2048 + c * 8); }
    __syncthreads();
    float* part = (float*)(lds + 16 * WST);
    for (int pr = bid; pr < T_ / 64; pr += nb) {
        const int t = pr * 64 + (wave >> 2) * 32 + r, kq = wave & 3;
        f32x16 acc;
#pragma unroll
        for (int i = 0; i < 16; ++i) acc[i] = 0.f;
        const bf16_t* hp = H + (size_t)t * D_ + kq * 512 + hh * 8; const unsigned char* wp = lds + (r & 15) * WST + kq * 1024 + hh * 16;
#pragma unroll 1
        for (int k0 = 0; k0 < 32; k0 += 16) {
            bf16x8 bfr[16];
#pragma unroll
            for (int j = 0; j < 16; ++j) bfr[j] = *(const bf16x8*)(hp + (k0 + j) * 16);
#pragma unroll
            for (int j = 0; j < 16; ++j) { bf16x8 a = *(const bf16x8*)(wp + (k0 + j) * 32); if (r >= 16) a = (bf16x8){0, 0, 0, 0, 0, 0, 0, 0};
                acc = __builtin_amdgcn_mfma_f32_32x32x16_bf16(a, bfr[j], acc, 0, 0, 0); }
        }
        __syncthreads();
#pragma unroll
        for (int i = 0; i < 8; ++i) part[(wave * 8 + i) * 64 + lane] = acc[i];
        __syncthreads();
        if (kq == 0) {
            float s[8];
#pragma unroll
            for (int i = 0; i < 8; ++i) s[i] = part[(wave * 8 + i) * 64 + lane] + part[((wave + 1) * 8 + i) * 64 + lane] + part[((wave + 2) * 8 + i) * 64 + lane] + part[((wave + 3) * 8 + i) * 64 + lane];
            f32x4 g0, g1; g0[0] = s[0]; g0[1] = s[1]; g0[2] = s[2]; g0[3] = s[3]; g1[0] = s[4]; g1[1] = s[5]; g1[2] = s[6]; g1[3] = s[7];
            *(f32x4*)(gate + (size_t)t * 16 + 4 * hh) = g0; *(f32x4*)(gate + (size_t)t * 16 + 8 + 4 * hh) = g1;
        }
    }
    __syncthreads();
}

__device__ __forceinline__ void phase_post(const Params& p, int bid, int nb) {
    const int tid = get_tid(), lane = tid & 63, wave = tid >> 6;
    unsigned char* ws = p.ws;
    bf16_t* Pq = (bf16_t*)(ws + WS_P); bf16_t* Pk = (bf16_t*)(ws + WS_P + SEG_B);
    const float qscale = 0.08838834764831845f * 1.4426950408889634f;
    for (int r = bid * 8 + wave; r < 2 * T_; r += nb * 8) {
        const int which = r >= T_ ? 1 : 0; const int t = r - which * T_;
        bf16_t* ptr = (which ? Pk : Pq) + (size_t)t * 1024 + lane * 16;
        const float* gn = (which ? p.fox_kg : p.fox_qg) + (lane & 7) * 16;
        u32x4 a = *(const u32x4*)ptr, b = *(const u32x4*)(ptr + 8);
        float f[16];
        f[0] = bflo(a.x); f[1] = bfhi(a.x); f[2] = bflo(a.y); f[3] = bfhi(a.y); f[4] = bflo(a.z); f[5] = bfhi(a.z); f[6] = bflo(a.w); f[7] = bfhi(a.w);
        f[8] = bflo(b.x); f[9] = bfhi(b.x); f[10] = bflo(b.y); f[11] = bfhi(b.y); f[12] = bflo(b.z); f[13] = bfhi(b.z); f[14] = bflo(b.w); f[15] = bfhi(b.w);
        float ss = 0.f;
#pragma unroll
        for (int i = 0; i < 16; ++i) ss += f[i] * f[i];
        ss += __shfl_xor(ss, 1); ss += __shfl_xor(ss, 2); ss += __shfl_xor(ss, 4);
        const float rr = rsqrtf(ss * (1.f / 128.f) + EPS_) * (which ? 1.f : qscale);
#pragma unroll
        for (int i = 0; i < 16; ++i) f[i] = (f[i] * rr) * gn[i];
        a.x = cvt_pk(f[0], f[1]); a.y = cvt_pk(f[2], f[3]); a.z = cvt_pk(f[4], f[5]); a.w = cvt_pk(f[6], f[7]);
        b.x = cvt_pk(f[8], f[9]); b.y = cvt_pk(f[10], f[11]); b.z = cvt_pk(f[12], f[13]); b.w = cvt_pk(f[14], f[15]);
        *(u32x4*)ptr = a; *(u32x4*)(ptr + 8) = b;
    }
    {
        const bf16_t* Mq = (const bf16_t*)(ws + WS_P + 3 * SEG_B); const bf16_t* Mk = (const bf16_t*)(ws + WS_P + 4 * SEG_B);
        bf16_t* QC = (bf16_t*)(ws + WS_QC); bf16_t* KC = (bf16_t*)(ws + WS_KC);
        for (int item = bid; item < 256; item += nb) {
            const int which = item >> 7, tb = item & 127, cg = tid & 127, run = tid >> 7, ch0 = cg * 8, ts = tb * 128 + run * 32, sp = ts & 2047;
            const bf16_t* src = (which ? Mk : Mq) + (size_t)ts * 1024 + ch0; bf16_t* dst = (which ? KC : QC) + (size_t)ts * 1024 + ch0;
            float w0[8], w1[8], w2[8], w3[8], cb[8], x0[8], x1[8], x2[8];
#pragma unroll
            for (int e = 0; e < 8; ++e) { const int ci = which * 1024 + ch0 + e; w0[e] = p.conv_w[ci]; w1[e] = p.conv_w[2048 + ci]; w2[e] = p.conv_w[4096 + ci]; w3[e] = p.conv_w[6144 + ci]; cb[e] = p.conv_b[ci]; }
            {   u32x4 a = {0u, 0u, 0u, 0u}, b = a, c = a;
                if (sp != 0) { a = *(const u32x4*)(src - 3 * 1024); b = *(const u32x4*)(src - 2 * 1024); c = *(const u32x4*)(src - 1024); }
#pragma unroll
                for (int e = 0; e < 4; ++e) { x0[2 * e] = bflo(a[e]); x0[2 * e + 1] = bfhi(a[e]); x1[2 * e] = bflo(b[e]); x1[2 * e + 1] = bfhi(b[e]); x2[2 * e] = bflo(c[e]); x2[2 * e + 1] = bfhi(c[e]); } }
            const float osc = which ? 0.0625f : 1.f;
            for (int s = 0; s < 32; ++s) {
                const u32x4 d = *(const u32x4*)(src + (size_t)s * 1024); float x3[8], y[8];
#pragma unroll
                for (int e = 0; e < 4; ++e) { x3[2 * e] = bflo(d[e]); x3[2 * e + 1] = bfhi(d[e]); }
#pragma unroll
                for (int e = 0; e < 8; ++e) { y[e] = silu_f(w0[e] * x0[e] + w1[e] * x1[e] + w2[e] * x2[e] + w3[e] * x3[e] + cb[e]) * osc; x0[e] = x1[e]; x1[e] = x2[e]; x2[e] = x3[e]; }
                u32x4 o; o.x = cvt_pk(y[0], y[1]); o.y = cvt_pk(y[2], y[3]); o.z = cvt_pk(y[4], y[5]); o.w = cvt_pk(y[6], y[7]);
                *(u32x4*)(dst + (size_t)s * 1024) = o;
            }
        }
    }
    const float* gate = (const float*)(ws + WS_GATE); float* F = (float*)(ws + WS_F);
    for (int sq = bid * 8 + wave; sq < 64; sq += nb * 8) {
        const int b = sq >> 3, h = sq & 7; const float fb = p.fox_fb[h];
        float v[32]; float run = 0.f;
#pragma unroll
        for (int i = 0; i < 32; ++i) { const int t = lane * 32 + i; run += logsig(gate[(size_t)(b * S_ + t) * 16 + h] + fb); v[i] = run; }
        float inc = run;
#pragma unroll
        for (int o = 1; o < 64; o <<= 1) { const float u = __shfl_up(inc, o); if (lane >= o) inc += u; }
        const float excl = inc - run;
#pragma unroll
        for (int i = 0; i < 32; ++i) F[(size_t)sq * S_ + lane * 32 + i] = (v[i] + excl) * 1.4426950408889634f;
    }
}
typedef short s16x4 __attribute__((ext_vector_type(4)));
__device__ __forceinline__ s16x4 lds_tr16(const unsigned char* p) { return __builtin_amdgcn_ds_read_tr16_b64_v4i16((LAS s16x4*)p); }
__device__ __forceinline__ bf16x8 tr_frag(const unsigned char* p0, int second_bytes) {
    const s16x4 a = lds_tr16(p0), b = lds_tr16(p0 + second_bytes);
    bf16x8 f; f[0] = a[0]; f[1] = a[1]; f[2] = a[2]; f[3] = a[3]; f[4] = b[0]; f[5] = b[1]; f[6] = b[2]; f[7] = b[3]; return f;
}
__device__ __forceinline__ unsigned split_bf16(float v, float& eff) { const unsigned hi = cvt_pk(v, 0.f) & 0xffffu; const float hf = bf2f((bf16_t)hi); const unsigned lo = cvt_pk(v - hf, 0.f) & 0xffffu; eff = hf + bf2f((bf16_t)lo); return hi | (lo << 16); }
__device__ __forceinline__ void fox_unit(const Params& p, unsigned char* lds, int b, int h, int qb) {
    const int tid = get_tid(), lane = tid & 63, wave = tid >> 6, r = lane & 31, hh = lane >> 5, li = lane & 15;
    unsigned char* ws = p.ws;
    const bf16_t* Pq = (const bf16_t*)(ws + WS_P); const bf16_t* Pk = (const bf16_t*)(ws + WS_P + SEG_B); const bf16_t* Pv = (const bf16_t*)(ws + WS_P + 2 * SEG_B);
    const float* F = (const float*)(ws + WS_F) + (size_t)(b * 8 + h) * S_;
    bf16_t* Oc = (bf16_t*)(ws + WS_H);
    constexpr int KST = 272, VST = 544, BUF = 64 * KST + 64 * VST;
    constexpr float THR = 8.f;
    const int q0w = qb * 256 + wave * 32, qs = q0w + r; const int q0s = __builtin_amdgcn_readfirstlane(q0w);
    const size_t trow = (size_t)(b * S_ + qs);
    bf16x8 qf[8];
#pragma unroll
    for (int ks = 0; ks < 8; ++ks) qf[ks] = *(const bf16x8*)(Pq + trow * 1024 + h * 128 + ks * 16 + hh * 8);
    float feff; const unsigned fq2 = split_bf16(F[qs], feff);
    float m = 0.f;
    u32x4 qa; qa.x = hh ? 0u : fq2; qa.y = 0u; qa.z = hh ? 0u : 0x3f803f80u; qa.w = 0u;
    f32x16 o[4];
#pragma unroll
    for (int d = 0; d < 4; ++d)
#pragma unroll
        for (int i = 0; i < 16; ++i) o[d][i] = 0.f;
    float l = 0.f;
    const int ntile = (qb * 256 + 256) / 64;
    const int srow0 = tid >> 4, scc = tid & 15;
    const bf16_t* kg = Pk + (size_t)(b * S_ + srow0) * 1024 + h * 128 + scc * 8; const bf16_t* vg = Pv + (size_t)(b * S_ + srow0) * 1024 + h * 128 + scc * 8;
    u32x4 kr[2], vr[2]; float fr = 0.f;
    const int vb_off = 64 * KST + (4 * hh + (li >> 2)) * VST + (16 * (r >> 4) + 4 * (li & 3)) * 2;
#define FOX_AUG(dst, fval) do { float e_; const unsigned s2_ = split_bf16(-(fval), e_); u32x4 w_; w_.x = 0x3f803f80u; w_.y = 0x3f803f80u; w_.z = s2_; w_.w = 0u; *(u32x4*)(dst) = w_; } while (0)
    __syncthreads();
#pragma unroll
    for (int i = 0; i < 2; ++i) { kr[i] = *(const u32x4*)(kg + (size_t)(32 * i) * 1024); vr[i] = *(const u32x4*)(vg + (size_t)(32 * i) * 1024); }
    if (tid < 64) fr = F[tid];
#pragma unroll
    for (int i = 0; i < 2; ++i) { *(u32x4*)(lds + (srow0 + 32 * i) * KST + scc * 16) = kr[i]; *(u32x4*)(lds + 64 * KST + (srow0 + 32 * i) * VST + scc * 16) = vr[i]; }
    if (tid < 64) FOX_AUG(lds + tid * KST + 256, fr);
    __syncthreads();
    for (int kt = 0; kt < ntile; ++kt) {
        const int k0 = kt * 64; unsigned char* cur = lds + (kt & 1) * BUF; unsigned char* nxt = lds + ((kt & 1) ^ 1) * BUF;
        const bool more = kt + 1 < ntile;
        if (more) {
#pragma unroll
            for (int i = 0; i < 2; ++i) { kr[i] = *(const u32x4*)(kg + (size_t)(k0 + 64 + 32 * i) * 1024); vr[i] = *(const u32x4*)(vg + (size_t)(k0 + 64 + 32 * i) * 1024); }
            if (tid < 64) fr = F[k0 + 64 + tid];
        }
        if (k0 <= q0s + 31) {
            f32x16 s[2];
            const bf16x8 qaf = __builtin_bit_cast(bf16x8, qa);
#pragma unroll
            for (int kb = 0; kb < 2; ++kb) {
#pragma unroll
                for (int i = 0; i < 16; ++i) s[kb][i] = 0.f;
#pragma unroll
                for (int ks = 0; ks < 8; ++ks) { const bf16x8 a = *(const bf16x8*)(cur + (kb * 32 + r) * KST + ks * 32 + hh * 16);
                    s[kb] = __builtin_amdgcn_mfma_f32_32x32x16_bf16(a, qf[ks], s[kb], 0, 0, 0); }
                {   const bf16x8 a = *(const bf16x8*)(cur + (kb * 32 + r) * KST + 256);
                    s[kb] = __builtin_amdgcn_mfma_f32_32x32x16_bf16(a, qaf, s[kb], 0, 0, 0); }
            }
            if (k0 + 63 > q0s) {
                const int lim = qs - k0;
#pragma unroll
                for (int kb = 0; kb < 2; ++kb)
#pragma unroll
                    for (int i = 0; i < 16; ++i) s[kb][i] = (kb * 32 + (i & 3) + 8 * (i >> 2) + 4 * hh > lim) ? -INFINITY : s[kb][i];
            }
            float mx = fmaxf(s[0][0], s[1][0]);
#pragma unroll
            for (int i = 1; i < 16; ++i) mx = fmaxf(mx, fmaxf(s[0][i], s[1][i]));
            mx = fmaxf(mx, __shfl_xor(mx, 32));
            if (__builtin_amdgcn_ballot_w64(mx > THR) != 0ull) {
                const float mnew_f = m + fmaxf(mx, 0.f); float meff; const unsigned m2 = split_bf16(-mnew_f, meff); meff = -meff;
                const float delta = meff - m, alpha = __builtin_amdgcn_exp2f(-delta);
                m = meff; if (!hh) qa.y = m2;
                l *= alpha;
#pragma unroll
                for (int d = 0; d < 4; ++d)
#pragma unroll
                    for (int i = 0; i < 16; ++i) o[d][i] *= alpha;
#pragma unroll
                for (int kb = 0; kb < 2; ++kb)
#pragma unroll
                    for (int i = 0; i < 16; ++i) s[kb][i] -= delta;
            }
            float ps = 0.f;
#pragma unroll
            for (int kb = 0; kb < 2; ++kb)
#pragma unroll
                for (int i = 0; i < 16; ++i) { const float pv = __builtin_amdgcn_exp2f(s[kb][i]); s[kb][i] = pv; ps += pv; }
            l += ps;
#pragma unroll
            for (int kb = 0; kb < 2; ++kb)
#pragma unroll
                for (int st = 0; st < 2; ++st) {
                    u32x4 pw; pw.x = cvt_pk(s[kb][8 * st + 0], s[kb][8 * st + 1]); pw.y = cvt_pk(s[kb][8 * st + 2], s[kb][8 * st + 3]);
                    pw.z = cvt_pk(s[kb][8 * st + 4], s[kb][8 * st + 5]); pw.w = cvt_pk(s[kb][8 * st + 6], s[kb][8 * st + 7]);
                    const bf16x8 pf = __builtin_bit_cast(bf16x8, pw);
#pragma unroll
                    for (int d = 0; d < 4; ++d) { const bf16x8 vf = tr_frag(cur + vb_off + (kb * 32 + st * 16) * VST + d * 64, 8 * VST);
                        o[d] = __builtin_amdgcn_mfma_f32_32x32x16_bf16(vf, pf, o[d], 0, 0, 0); }
                }
        }
        if (more) {
#pragma unroll
            for (int i = 0; i < 2; ++i) { *(u32x4*)(nxt + (srow0 + 32 * i) * KST + scc * 16) = kr[i]; *(u32x4*)(nxt + 64 * KST + (srow0 + 32 * i) * VST + scc * 16) = vr[i]; }
            if (tid < 64) FOX_AUG(nxt + tid * KST + 256, fr);
        }
        lds_barrier();
    }
#undef FOX_AUG
    l += __shfl_xor(l, 32);
    const float inv = 1.f / l;
#pragma unroll
    for (int d = 0; d < 4; ++d)
#pragma unroll
        for (int g = 0; g < 4; ++g) { u32x2 w; w.x = cvt_pk(o[d][4 * g] * inv, o[d][4 * g + 1] * inv); w.y = cvt_pk(o[d][4 * g + 2] * inv, o[d][4 * g + 3] * inv);
            *(u32x2*)(Oc + trow * D_ + h * 128 + d * 32 + 8 * g + 4 * hh) = w; }
}

__device__ __forceinline__ void mlstm_passA(const Params& p, unsigned char* lds, int unit) {
    const int tid = get_tid(), lane = tid & 63, wave = tid >> 6, r = lane & 31, hh = lane >> 5, li = lane & 15;
    const int b = unit >> 3, h = (unit >> 1) & 3, eh = unit & 1;
    unsigned char* ws = p.ws;
    const bf16_t* KC = (const bf16_t*)(ws + WS_KC); const bf16_t* Mv = (const bf16_t*)(ws + WS_P + 5 * SEG_B);
    const float* gate = (const float*)(ws + WS_GATE);
    bf16_t* Cst = (bf16_t*)(ws + WS_CST); float* nst = (float*)(ws + WS_NST); float* mst = (float*)(ws + WS_MST);
    constexpr int KST = 528, VST = 272;
    unsigned char* ksm = lds;
    unsigned char* vsm = ksm + 64 * KST;
    float* WSV = (float*)(vsm + 64 * VST);
    float* SCL = WSV + 2048;
    constexpr int STGS = 528;
    unsigned char* stg = (unsigned char*)(SCL + 128);
    __syncthreads();
    for (int cc = wave; cc < 32; cc += 8) {
        const int t = b * S_ + cc * 64 + lane;
        const float ipre = gate[(size_t)t * 16 + 8 + h] + p.m_ib[h], fpre = gate[(size_t)t * 16 + 12 + h] + p.m_fb[h];
        float bc = logsig(fpre);
#pragma unroll
        for (int o = 1; o < 64; o <<= 1) { const float u = __shfl_up(bc, o); if (lane >= o) bc += u; }
        const float a = ipre - bc; const float amax = wmax(a); const float bL = __shfl(bc, 63);
        WSV[cc * 64 + lane] = a; if (lane == 0) { SCL[cc] = bL; SCL[32 + cc] = amax; }
    }
    __syncthreads();
    if (tid == 0) { float m = 0.f; for (int cc = 0; cc < 32; ++cc) { const float mn = SCL[cc] + fmaxf(m, SCL[32 + cc]); SCL[64 + cc] = expf(SCL[cc] + m - mn); SCL[96 + cc] = mn; if (eh == 0) mst[(b * 4 + h) * 32 + cc] = m; m = mn; } }
    __syncthreads();
    for (int i = tid; i < 2048; i += NTHR) { const int cc = i >> 6; WSV[i] = expf(SCL[cc] + WSV[i] - SCL[96 + cc]); }
    f32x16 acc[4];
#pragma unroll
    for (int et = 0; et < 4; ++et)
#pragma unroll
        for (int i = 0; i < 16; ++i) acc[et][i] = 0.f;
    f32x16 accn;
#pragma unroll
    for (int i = 0; i < 16; ++i) accn[i] = 0.f;
    const int kb_off = (8 * hh + (li >> 2)) * KST + (wave * 32 + 16 * (r >> 4) + 4 * (li & 3)) * 2;
    const int vb_off = (8 * hh + (li >> 2)) * VST + (16 * (r >> 4) + 4 * (li & 3)) * 2;
    u32x4 pk[4], pv[2];
#pragma unroll
    for (int i = 0; i < 4; ++i) { const int c = tid + NTHR * i, row = c >> 5, c16 = c & 31; pk[i] = *(const u32x4*)(KC + (size_t)(b * S_ + row) * 1024 + h * 256 + c16 * 8); }
#pragma unroll
    for (int i = 0; i < 2; ++i) { const int c = tid + NTHR * i, row = c >> 4, c16 = c & 15; pv[i] = *(const u32x4*)(Mv + (size_t)(b * S_ + row) * 1024 + h * 256 + eh * 128 + c16 * 8); }
    for (int cc = 0; cc < 32; ++cc) {
        const int bhc = (b * 4 + h) * 32 + cc, t0 = b * S_ + cc * 64;
#pragma unroll
        for (int et = 0; et < 4; ++et)
#pragma unroll
            for (int g = 0; g < 4; ++g) { u32x2 o; o.x = cvt_pk(acc[et][4 * g], acc[et][4 * g + 1]); o.y = cvt_pk(acc[et][4 * g + 2], acc[et][4 * g + 3]);
                *(u32x2*)(stg + (et * 32 + r) * STGS + (wave * 32 + 8 * g + 4 * hh) * 2) = o; }
        if (eh == 0 && r == 0) {
#pragma unroll
            for (int g = 0; g < 4; ++g) { f32x4 o; o[0] = accn[4 * g]; o[1] = accn[4 * g + 1]; o[2] = accn[4 * g + 2]; o[3] = accn[4 * g + 3]; *(f32x4*)(nst + (size_t)bhc * 256 + wave * 32 + 8 * g + 4 * hh) = o; } }
        lds_barrier();
#pragma unroll
        for (int i = 0; i < 8; ++i) { const int c = tid + NTHR * i, row = c >> 5, c16 = c & 31;
            *(u32x4*)(Cst + ((size_t)bhc * 256 + eh * 128 + row) * 256 + c16 * 8) = *(const u32x4*)(stg + row * STGS + c16 * 16); }
        if (cc == 31) break;
#pragma unroll
        for (int i = 0; i < 4; ++i) { const int c = tid + NTHR * i, row = c >> 5, c16 = c & 31; *(u32x4*)(ksm + row * KST + c16 * 16) = pk[i]; }
#pragma unroll
        for (int i = 0; i < 2; ++i) { const int c = tid + NTHR * i, row = c >> 4, c16 = c & 15; const float wv = WSV[cc * 64 + row]; const u32x4 w = pv[i];
            u32x4 o; o.x = cvt_pk(bflo(w.x) * wv, bfhi(w.x) * wv); o.y = cvt_pk(bflo(w.y) * wv, bfhi(w.y) * wv); o.z = cvt_pk(bflo(w.z) * wv, bfhi(w.z) * wv); o.w = cvt_pk(bflo(w.w) * wv, bfhi(w.w) * wv);
            *(u32x4*)(vsm + row * VST + c16 * 16) = o; }
        if (cc + 1 < 31) { const int t1 = t0 + 64;
#pragma unroll
            for (int i = 0; i < 4; ++i) { const int c = tid + NTHR * i, row = c >> 5, c16 = c & 31; pk[i] = *(const u32x4*)(KC + (size_t)(t1 + row) * 1024 + h * 256 + c16 * 8); }
#pragma unroll
            for (int i = 0; i < 2; ++i) { const int c = tid + NTHR * i, row = c >> 4, c16 = c & 15; pv[i] = *(const u32x4*)(Mv + (size_t)(t1 + row) * 1024 + h * 256 + eh * 128 + c16 * 8); } }
        lds_barrier();
        const float decay = SCL[64 + cc];
#pragma unroll
        for (int et = 0; et < 4; ++et)
#pragma unroll
            for (int i = 0; i < 16; ++i) acc[et][i] *= decay;
#pragma unroll
        for (int i = 0; i < 16; ++i) accn[i] *= decay;
#pragma unroll
        for (int ks = 0; ks < 4; ++ks) {
            const bf16x8 bfr = tr_frag(ksm + kb_off + ks * 16 * KST, 4 * KST);
            {
                const f32x4 w0 = *(const f32x4*)(WSV + cc * 64 + ks * 16 + hh * 8), w1 = *(const f32x4*)(WSV + cc * 64 + ks * 16 + hh * 8 + 4);
                u32x4 wb; wb.x = cvt_pk(w0[0], w0[1]); wb.y = cvt_pk(w0[2], w0[3]); wb.z = cvt_pk(w1[0], w1[1]); wb.w = cvt_pk(w1[2], w1[3]);
                if (r != 0) wb = (u32x4){0u, 0u, 0u, 0u};
                accn = __builtin_amdgcn_mfma_f32_32x32x16_bf16(bfr, __builtin_bit_cast(bf16x8, wb), accn, 0, 0, 0); }
#pragma unroll
            for (int et = 0; et < 4; ++et) { const bf16x8 afr = tr_frag(vsm + vb_off + ks * 16 * VST + et * 64, 4 * VST);
                acc[et] = __builtin_amdgcn_mfma_f32_32x32x16_bf16(bfr, afr, acc[et], 0, 0, 0); }
        }
    }
}

__device__ __forceinline__ void mlstm_passB(const Params& p, unsigned char* lds, int unit) {
    const int tid = get_tid(), lane = tid & 63, wave = tid >> 6, r = lane & 31, hh = lane >> 5, li = lane & 15;
    const int b = unit >> 7, h = (unit >> 5) & 3, cc = unit & 31;
    unsigned char* ws = p.ws;
    const bf16_t* QC = (const bf16_t*)(ws + WS_QC); const bf16_t* KC = (const bf16_t*)(ws + WS_KC);
    const bf16_t* Mv = (const bf16_t*)(ws + WS_P + 5 * SEG_B); const bf16_t* Mo = (const bf16_t*)(ws + WS_P + 6 * SEG_B);
    const float* gate = (const float*)(ws + WS_GATE);
    const bf16_t* Cst = (const bf16_t*)(ws + WS_CST); const float* nst = (const float*)(ws + WS_NST); const float* mst = (const float*)(ws + WS_MST);
    bf16_t* Oc = (bf16_t*)(ws + WS_H);
    constexpr int QST = 528, VST = 544, WST = 144, HST = 1040;
    unsigned char* qsm = lds;
    unsigned char* ksm = qsm + 64 * QST;
    unsigned char* vsm = ksm + 64 * QST;
    unsigned char* wsm = vsm + 64 * VST;
    float* sc = (float*)(wsm + 64 * WST);
    float* hsm = (float*)lds;
    const int bhc = (b * 4 + h) * 32 + cc, t0 = b * S_ + cc * 64;
    __syncthreads();
    if (wave == 0) {
        const float ipre = gate[(size_t)(t0 + lane) * 16 + 8 + h] + p.m_ib[h], fpre = gate[(size_t)(t0 + lane) * 16 + 12 + h] + p.m_fb[h];
        float bc = logsig(fpre);
#pragma unroll
        for (int o = 1; o < 64; o <<= 1) { const float u = __shfl_up(bc, o); if (lane >= o) bc += u; }
        const float a = ipre - bc; float pm = a;
#pragma unroll
        for (int o = 1; o < 64; o <<= 1) { const float u = __shfl_up(pm, o); if (lane >= o) pm = fmaxf(pm, u); }
        const float mc = mst[bhc]; const float mt = bc + fmaxf(mc, pm);
        sc[lane] = bc - mt; sc[64 + lane] = a; sc[128 + lane] = mt; sc[192 + lane] = expf(bc + mc - mt);
    }
    bf16x8 cfr[16];
#pragma unroll
    for (int ks = 0; ks < 16; ++ks) cfr[ks] = *(const bf16x8*)(Cst + ((size_t)bhc * 256 + wave * 32 + r) * 256 + ks * 16 + hh * 8);
#pragma unroll
    for (int i = 0; i < 4; ++i) { const int c = tid + NTHR * i, row = c >> 5, c16 = c & 31;
        *(u32x4*)(qsm + row * QST + c16 * 16) = *(const u32x4*)(QC + (size_t)(t0 + row) * 1024 + h * 256 + c16 * 8);
        *(u32x4*)(ksm + row * QST + c16 * 16) = *(const u32x4*)(KC + (size_t)(t0 + row) * 1024 + h * 256 + c16 * 8);
        *(u32x4*)(vsm + row * VST + c16 * 16) = *(const u32x4*)(Mv + (size_t)(t0 + row) * 1024 + h * 256 + c16 * 8); }
    __syncthreads();
    if (wave < 3) {
        const int sb = wave >> 1, lb = wave ? 1 : 0;
        f32x16 s;
#pragma unroll
        for (int i = 0; i < 16; ++i) s[i] = 0.f;
#pragma unroll
        for (int ks = 0; ks < 16; ++ks) { const bf16x8 a = *(const bf16x8*)(ksm + (sb * 32 + r) * QST + ks * 32 + hh * 16), q = *(const bf16x8*)(qsm + (lb * 32 + r) * QST + ks * 32 + hh * 16);
            s = __builtin_amdgcn_mfma_f32_32x32x16_bf16(a, q, s, 0, 0, 0); }
        const int l = lb * 32 + r; const float bl = sc[l]; float rs = 0.f;
#pragma unroll
        for (int g = 0; g < 4; ++g) { float w[4];
#pragma unroll
            for (int e = 0; e < 4; ++e) { const int sI = sb * 32 + 8 * g + 4 * hh + e; w[e] = (sI <= l) ? s[4 * g + e] * __expf(bl + sc[64 + sI]) : 0.f; rs += w[e]; }
            u32x2 o; o.x = cvt_pk(w[0], w[1]); o.y = cvt_pk(w[2], w[3]);
            *(u32x2*)(wsm + l * WST + (sb * 32 + 8 * g + 4 * hh) * 2) = o; }
        sc[256 + l * 4 + sb * 2 + hh] = rs;
    } else if (wave == 3) {
        const int l = r;
#pragma unroll
        for (int g = 0; g < 4; ++g) { u32x2 o; o.x = 0u; o.y = 0u; *(u32x2*)(wsm + l * WST + (32 + 8 * g + 4 * hh) * 2) = o; }
        sc[256 + l * 4 + 2 + hh] = 0.f;
    }
    {
        const int l = tid & 63, part = tid >> 6; const float* np = nst + (size_t)bhc * 256 + part * 32; float s = 0.f;
#pragma unroll
        for (int q = 0; q < 4; ++q) { const u32x4 w = *(const u32x4*)(qsm + l * QST + part * 64 + q * 16);
            s += bflo(w.x) * np[8 * q] + bfhi(w.x) * np[8 * q + 1] + bflo(w.y) * np[8 * q + 2] + bfhi(w.y) * np[8 * q + 3] + bflo(w.z) * np[8 * q + 4] + bfhi(w.z) * np[8 * q + 5] + bflo(w.w) * np[8 * q + 6] + bfhi(w.w) * np[8 * q + 7]; }
        sc[512 + l * 8 + part] = s;
    }
    f32x16 acc[2];
#pragma unroll
    for (int lb = 0; lb < 2; ++lb)
#pragma unroll
        for (int i = 0; i < 16; ++i) acc[lb][i] = 0.f;
#pragma unroll
    for (int ks = 0; ks < 16; ++ks)
#pragma unroll
        for (int lb = 0; lb < 2; ++lb) { const bf16x8 q = *(const bf16x8*)(qsm + (lb * 32 + r) * QST + ks * 32 + hh * 16);
            acc[lb] = __builtin_amdgcn_mfma_f32_32x32x16_bf16(cfr[ks], q, acc[lb], 0, 0, 0); }
    __syncthreads();
#pragma unroll
    for (int lb = 0; lb < 2; ++lb) { const float it = sc[192 + lb * 32 + r];
#pragma unroll
        for (int i = 0; i < 16; ++i) acc[lb][i] *= it; }
    const int vb_off = (8 * hh + (li >> 2)) * VST + (wave * 32 + 16 * (r >> 4) + 4 * (li & 3)) * 2;
#pragma unroll
    for (int ks = 0; ks < 4; ++ks) { const bf16x8 afr = tr_frag(vsm + vb_off + ks * 16 * VST, 4 * VST);
#pragma unroll
        for (int lb = 0; lb < 2; ++lb) { if (lb == 0 && ks >= 2) continue;
            const bf16x8 wf = *(const bf16x8*)(wsm + (lb * 32 + r) * WST + ks * 32 + hh * 16);
            acc[lb] = __builtin_amdgcn_mfma_f32_32x32x16_bf16(afr, wf, acc[lb], 0, 0, 0); } }
    float ssq[2];
#pragma unroll
    for (int lb = 0; lb < 2; ++lb) { const int l = lb * 32 + r;
        const f32x4 rsv = *(const f32x4*)(sc + 256 + l * 4); const f32x4 q0 = *(const f32x4*)(sc + 512 + l * 8), q1 = *(const f32x4*)(sc + 512 + l * 8 + 4);
        const float den = (rsv[0] + rsv[1] + rsv[2] + rsv[3]) + sc[192 + l] * ((q0[0] + q0[1] + q0[2] + q0[3]) + (q1[0] + q1[1] + q1[2] + q1[3]));
        const float inv = 1.f / fmaxf(fabsf(den), __expf(-sc[128 + l]));
        float s2 = 0.f;
#pragma unroll
        for (int i = 0; i < 16; ++i) { acc[lb][i] *= inv; s2 += acc[lb][i] * acc[lb][i]; }
        s2 += __shfl_xor(s2, 32); ssq[lb] = s2; }
    __syncthreads();
    if (hh == 0) { sc[1024 + r * 8 + wave] = ssq[0]; sc[1024 + (32 + r) * 8 + wave] = ssq[1]; }
#pragma unroll
    for (int lb = 0; lb < 2; ++lb)
#pragma unroll
        for (int g = 0; g < 4; ++g) { f32x4 v; v[0] = acc[lb][4 * g]; v[1] = acc[lb][4 * g + 1]; v[2] = acc[lb][4 * g + 2]; v[3] = acc[lb][4 * g + 3];
            *(f32x4*)((unsigned char*)hsm + (lb * 32 + r) * HST + (wave * 32 + 8 * g + 4 * hh) * 4) = v; }
    __syncthreads();
#pragma unroll
    for (int i = 0; i < 4; ++i) { const int c = tid + NTHR * i, l = c >> 5, e0 = (c & 31) * 8;
        const f32x4 s0 = *(const f32x4*)(sc + 1024 + l * 8), s1 = *(const f32x4*)(sc + 1024 + l * 8 + 4);
        const float rr = rsqrtf(((s0[0] + s0[1] + s0[2] + s0[3]) + (s1[0] + s1[1] + s1[2] + s1[3])) * (1.f / 256.f) + EPS_);
        const f32x4 h0 = *(const f32x4*)((unsigned char*)hsm + l * HST + e0 * 4), h1 = *(const f32x4*)((unsigned char*)hsm + l * HST + e0 * 4 + 16);
        const f32x4 g0 = *(const f32x4*)(p.m_hg + h * 256 + e0), g1 = *(const f32x4*)(p.m_hg + h * 256 + e0 + 4);
        const u32x4 mo = *(const u32x4*)(Mo + (size_t)(t0 + l) * 1024 + h * 256 + e0);
        u32x4 o;
        o.x = cvt_pk(h0[0] * rr * g0[0] * sigm(bflo(mo.x)), h0[1] * rr * g0[1] * sigm(bfhi(mo.x))); o.y = cvt_pk(h0[2] * rr * g0[2] * sigm(bflo(mo.y)), h0[3] * rr * g0[3] * sigm(bfhi(mo.y)));
        o.z = cvt_pk(h1[0] * rr * g1[0] * sigm(bflo(mo.z)), h1[1] * rr * g1[1] * sigm(bfhi(mo.z))); o.w = cvt_pk(h1[2] * rr * g1[2] * sigm(bflo(mo.w)), h1[3] * rr * g1[3] * sigm(bfhi(mo.w)));
        *(u32x4*)(Oc + (size_t)(t0 + l) * D_ + 1024 + h * 256 + e0) = o; }
}

__device__ __forceinline__ void ce_desc(float& a, float& b) { const float hi = fmaxf(a, b), lo = fminf(a, b); a = hi; b = lo; }
__device__ __forceinline__ void sort16_desc(float (&v)[16]) {
#pragma unroll
    for (int k = 2; k <= 16; k <<= 1)
#pragma unroll
        for (int j = k >> 1; j > 0; j >>= 1)
#pragma unroll
            for (int i = 0; i < 16; ++i) { const int l = i ^ j; if (l > i) { if ((i & k) == 0) ce_desc(v[i], v[l]); else ce_desc(v[l], v[i]); } }
}
__device__ __forceinline__ void bmerge16_desc(float (&v)[16]) {
#pragma unroll
    for (int j = 8; j > 0; j >>= 1)
#pragma unroll
        for (int i = 0; i < 16; ++i) { const int l = i ^ j; if (l > i) ce_desc(v[i], v[l]); }
}
__device__ __forceinline__ void merge_top16(float (&a)[16], const float (&b)[16]) {
#pragma unroll
    for (int i = 0; i < 16; ++i) a[i] = fmaxf(a[i], b[15 - i]);
    bmerge16_desc(a);
}
__device__ __forceinline__ float pack_idx(float v, unsigned mask, unsigned idx) { return __builtin_bit_cast(float, (__builtin_bit_cast(unsigned, v) & mask) | idx); }
__device__ __forceinline__ void top16_from_acc(const f32x16 (&acc)[4], int h, float (&out)[16]) {
    float g[4][16];
#pragma unroll
    for (int mt = 0; mt < 4; ++mt) {
#pragma unroll
        for (int i = 0; i < 16; ++i) g[mt][i] = pack_idx(acc[mt][i], 0xffffff80u, (unsigned)(32 * mt + (i & 3) + 8 * (i >> 2)) | ((unsigned)h << 2));
        sort16_desc(g[mt]);
    }
    merge_top16(g[0], g[1]); merge_top16(g[2], g[3]); merge_top16(g[0], g[2]);
    float o[16];
#pragma unroll
    for (int i = 0; i < 16; ++i) o[i] = __shfl_xor(g[0][i], 32);
    merge_top16(g[0], o);
#pragma unroll
    for (int i = 0; i < 16; ++i) out[i] = g[0][i];
}
__device__ __forceinline__ unsigned lut16(const unsigned (&P)[4], unsigned i) {
    const unsigned long long lo = (unsigned long long)P[0] | ((unsigned long long)P[1] << 32), hi = (unsigned long long)P[2] | ((unsigned long long)P[3] << 32);
    const unsigned long long s = (i & 8u) ? hi : lo;
    return (unsigned)(s >> ((i & 7u) * 8u)) & 0xffu;
}
struct CandTab { int i[50]; int j[50]; };
constexpr CandTab make_cand_tab() { CandTab t{}; int n = 0; for (int i = 0; i < 16; ++i) for (int j = 0; j < 16; ++j) if ((i + 1) * (j + 1) <= 16) { t.i[n] = i; t.j[n] = j; ++n; } return t; }
__device__ __forceinline__ void phase_topk(const Params& p, unsigned char* lds, int bid, int nb) {
    const int tid = get_tid(), lane = tid & 63, wave = tid >> 6, r = lane & 31, h = lane >> 5;
    unsigned char* ws = p.ws;
    const bf16_t* Q = (const bf16_t*)(ws + WS_Q); int* IDX = (int*)(ws + WS_IDX); float* GW = (float*)(ws + WS_GW);
    constexpr int KP = 136;
    bf16_t* KS = (bf16_t*)lds;
    for (int i = tid; i < 2 * 16384; i += NTHR) { const int which = i >> 14, n = (i >> 7) & 127, d = i & 127; const float v = (which ? p.sk2 : p.sk1)[i & 16383];
        const unsigned hb = cvt_pk(v, 0.f) & 0xffffu; const float lo = v - bf2f((bf16_t)hb);
        KS[((which * 2 + 0) * 128 + n) * KP + d] = (bf16_t)hb; KS[((which * 2 + 1) * 128 + n) * KP + d] = (bf16_t)(cvt_pk(lo, 0.f) & 0xffffu); }
    __syncthreads();
    for (int item = bid * 8 + wave; item < 512 * 8; item += nb * 8) {
        const int tt = item >> 3, hh = item & 7, t = tt * 32 + r;
        float top[2][16];
#pragma unroll
        for (int list = 0; list < 2; ++list) {
            bf16x8 qf[8];
#pragma unroll
            for (int ks = 0; ks < 8; ++ks) qf[ks] = *(const bf16x8*)(Q + (size_t)t * D_ + hh * 256 + list * 128 + ks * 16 + h * 8);
            float g[4][16];
#pragma unroll
            for (int mt = 0; mt < 4; ++mt) {
                f32x16 acc;
#pragma unroll
                for (int i = 0; i < 16; ++i) acc[i] = 0.f;
#pragma unroll
                for (int hl = 0; hl < 2; ++hl)
#pragma unroll
                    for (int ks = 0; ks < 8; ++ks) { const bf16x8 a = *(const bf16x8*)(KS + ((list * 2 + hl) * 128 + mt * 32 + r) * KP + ks * 16 + h * 8);
                        acc = __builtin_amdgcn_mfma_f32_32x32x16_bf16(a, qf[ks], acc, 0, 0, 0); }
#pragma unroll
                for (int i = 0; i < 16; ++i) g[mt][i] = pack_idx(acc[i], 0xffffff80u, (unsigned)(32 * mt + (i & 3) + 8 * (i >> 2)) | ((unsigned)h << 2));
                sort16_desc(g[mt]);
                __builtin_amdgcn_sched_barrier(0);
            }
            merge_top16(g[0], g[1]); merge_top16(g[2], g[3]); merge_top16(g[0], g[2]);
            {   float o[16];
#pragma unroll
                for (int i = 0; i < 16; ++i) o[i] = __shfl_xor(g[0][i], 32);
                merge_top16(g[0], o); }
#pragma unroll
            for (int i = 0; i < 16; ++i) top[list][i] = g[0][i];
            __builtin_amdgcn_sched_barrier(0);
        }
        unsigned P1[4], P2[4];
#pragma unroll
        for (int q = 0; q < 4; ++q) { P1[q] = 0u; P2[q] = 0u;
#pragma unroll
            for (int e = 0; e < 4; ++e) { P1[q] |= (__builtin_bit_cast(unsigned, top[0][4 * q + e]) & 127u) << (8 * e); P2[q] |= (__builtin_bit_cast(unsigned, top[1][4 * q + e]) & 127u) << (8 * e); } }
        float c[4][16];
#pragma unroll
        for (int n = 0; n < 64; ++n) {
            if (n < 50) { constexpr CandTab CT = make_cand_tab(); const int i = CT.i[n], j = CT.j[n];
                c[n >> 4][n & 15] = pack_idx(top[0][i] + top[1][j], 0xffffff00u, (unsigned)(i * 16 + j)); }
            else c[n >> 4][n & 15] = -INFINITY;
        }
        sort16_desc(c[0]); __builtin_amdgcn_sched_barrier(0); sort16_desc(c[1]); __builtin_amdgcn_sched_barrier(0); merge_top16(c[0], c[1]); __builtin_amdgcn_sched_barrier(0);
        sort16_desc(c[2]); __builtin_amdgcn_sched_barrier(0); sort16_desc(c[3]); __builtin_amdgcn_sched_barrier(0); merge_top16(c[2], c[3]); __builtin_amdgcn_sched_barrier(0); merge_top16(c[0], c[2]);
        float ex[16], sum = 0.f;
#pragma unroll
        for (int k = 0; k < 16; ++k) { ex[k] = __expf(c[0][k] - c[0][0]); sum += ex[k]; }
        const float inv = 1.f / sum;
        if (h == 0) {
            int* ip = IDX + (size_t)t * 128 + hh * 16; float* gp = GW + (size_t)t * 128 + hh * 16;
#pragma unroll
            for (int q = 0; q < 4; ++q) { u32x4 iv; f32x4 gv;
#pragma unroll
                for (int e = 0; e < 4; ++e) { const unsigned pos = __builtin_bit_cast(unsigned, c[0][4 * q + e]) & 255u;
                    iv[e] = lut16(P1, pos >> 4) * 128u + lut16(P2, pos & 15u); gv[e] = ex[4 * q + e] * inv; }
                *(u32x4*)(ip + 4 * q) = iv; *(f32x4*)(gp + 4 * q) = gv; }
        }
    }
}

typedef float f32x2 __attribute__((ext_vector_type(2)));
__device__ __forceinline__ float dot16_fp8(const u32x4 w, const float (&h)[32], int o) {
    float s = 0.f;
#pragma unroll
    for (int q = 0; q < 4; ++q) { const f32x2 lo = __builtin_amdgcn_cvt_pk_f32_fp8((int)w[q], false), hi = __builtin_amdgcn_cvt_pk_f32_fp8((int)w[q], true);
        fmac(s, lo[0], h[o + 4 * q]); fmac(s, lo[1], h[o + 4 * q + 1]); fmac(s, hi[0], h[o + 4 * q + 2]); fmac(s, hi[1], h[o + 4 * q + 3]); }
    return s;
}
template <int CTRL, int ROW_MASK, int BANK_MASK>
__device__ __forceinline__ int dpp_mov0i(int v) { return __builtin_amdgcn_update_dpp(0, v, CTRL, ROW_MASK, BANK_MASK, true); }
__device__ __forceinline__ void phase_peer1(const Params& p, unsigned char* lds, int bid, int nb, int probe) {
    const int tid = get_tid(), lane = tid & 63, wave = tid >> 6, r = lane >> 4, c16 = lane & 15;
    unsigned char* ws = p.ws;
    const bf16_t* H2 = (const bf16_t*)(ws + WS_H2); const int* IDX = (const int*)(ws + WS_IDX); const float* GW = (const float*)(ws + WS_GW);
    unsigned* EWT = (unsigned*)(ws + WS_EWT); const float* DSC = (const float*)(ws + WS_DSC);
    const unsigned char* E8D = ws + WS_E8D + 16 * c16; const unsigned emask = probe ? 0x3ffu : 0x3fffu;
    LAS unsigned* seq = (LAS unsigned*)((LAS unsigned char*)lds + wave * 2048 + r * 512);
    LAS unsigned* hist = (LAS unsigned*)((LAS unsigned char*)lds + 16384 + wave * 512 + r * 128);
    for (int tile = bid; tile < 256; tile += nb)
        for (int ps = 0; ps < 2; ++ps) {
            const int t = tile * 64 + ps * 32 + wave * 4 + r;
            unsigned hq[32]; float hsc;
            {   float mx = 0.f; u32x4 raw[16];
#pragma unroll
                for (int q = 0; q < 8; ++q) { raw[2 * q] = *(const u32x4*)(H2 + (size_t)t * D_ + 256 * q + 16 * c16); raw[2 * q + 1] = *(const u32x4*)(H2 + (size_t)t * D_ + 256 * q + 16 * c16 + 8); }
#pragma unroll
                for (int i = 0; i < 16; ++i)
#pragma unroll
                    for (int e = 0; e < 4; ++e) mx = fmaxf(mx, fmaxf(fabsf(bflo(raw[i][e])), fabsf(bfhi(raw[i][e]))));
                mx = fmaxf(mx, __shfl_xor(mx, 1)); mx = fmaxf(mx, __shfl_xor(mx, 2)); mx = fmaxf(mx, __shfl_xor(mx, 4)); mx = fmaxf(mx, __shfl_xor(mx, 8));
                mx = fmaxf(mx, 1e-30f); const float inv = 127.f / mx; hsc = mx * (1.f / 127.f);
#pragma unroll
                for (int i = 0; i < 16; ++i)
#pragma unroll
                    for (int hh = 0; hh < 2; ++hh) {
                        const unsigned w0 = raw[i][2 * hh], w1 = raw[i][2 * hh + 1];
                        hq[2 * i + hh] = ((unsigned)__float2int_rn(bflo(w0) * inv) & 0xffu) | (((unsigned)__float2int_rn(bfhi(w0) * inv) & 0xffu) << 8) | (((unsigned)__float2int_rn(bflo(w1) * inv) & 0xffu) << 16) | (((unsigned)__float2int_rn(bfhi(w1) * inv) & 0xffu) << 24); }
            }
            int idx[8]; unsigned pos[8];
#pragma unroll
            for (int m = 0; m < 8; ++m) idx[m] = IDX[(size_t)t * 128 + c16 + 16 * m];
            hist[c16] = 0u; hist[16 + c16] = 0u;
#pragma unroll
            for (int m = 0; m < 8; ++m) pos[m] = __hip_atomic_fetch_add(&hist[idx[m] >> 9], 1u, __ATOMIC_RELAXED, __HIP_MEMORY_SCOPE_WORKGROUP);
            {   const unsigned c0 = hist[2 * c16], c1 = hist[2 * c16 + 1]; unsigned inc = c0 + c1;
#pragma unroll
                for (int o = 1; o < 16; o <<= 1) { const unsigned u = __shfl_up(inc, o, 16); if (c16 >= o) inc += u; }
                const unsigned base = inc - (c0 + c1);
                hist[2 * c16] = base; hist[2 * c16 + 1] = base + c0; }
#pragma unroll
            for (int m = 0; m < 8; ++m) { pos[m] += hist[idx[m] >> 9]; seq[pos[m]] = (unsigned)idx[m] | ((unsigned)(c16 + 16 * m) << 14); }
            u32x4 cur[8], nxt[8];
            {   const unsigned char* rp = E8D + (size_t)(seq[0] & emask) * 2048;
#pragma unroll
                for (int q = 0; q < 8; ++q) cur[q] = *(const u32x4*)(rp + 256 * q); }
            for (int s = 0; s < 128; ++s) {
                if (s + 1 < 128) { const unsigned char* rp = E8D + (size_t)(seq[s + 1] & emask) * 2048;
#pragma unroll
                    for (int q = 0; q < 8; ++q) nxt[q] = *(const u32x4*)(rp + 256 * q); }
                int d0 = 0, d1 = 0;
#pragma unroll
                for (int q = 0; q < 8; ++q) { d0 = __builtin_amdgcn_sdot4((int)cur[q][0], (int)hq[4 * q], d0, false); d1 = __builtin_amdgcn_sdot4((int)cur[q][1], (int)hq[4 * q + 1], d1, false);
                    d0 = __builtin_amdgcn_sdot4((int)cur[q][2], (int)hq[4 * q + 2], d0, false); d1 = __builtin_amdgcn_sdot4((int)cur[q][3], (int)hq[4 * q + 3], d1, false); }
                int d = d0 + d1;
                d += dpp_mov0i<0x111, 0xf, 0xf>(d); d += dpp_mov0i<0x112, 0xf, 0xf>(d); d += dpp_mov0i<0x114, 0xf, 0xe>(d); d += dpp_mov0i<0x118, 0xf, 0xc>(d);
                if (c16 == 15) seq[s] = (unsigned)d;
#pragma unroll
                for (int q = 0; q < 8; ++q) cur[q] = nxt[q];
            }
            if (probe) continue;
            unsigned* ep = EWT + (size_t)(t >> 6) * 8192 + (t & 63) * 4;
#pragma unroll
            for (int m = 0; m < 8; ++m) { const int j = c16 + 16 * m;
                const float a = (float)(int)seq[pos[m]] * hsc * DSC[idx[m]];
                const float w = GW[(size_t)t * 128 + j] * 0.5f * a * (1.f + erff(a * 0.7071067811865476f));
                ep[(j >> 2) * 256 + (j & 3)] = (cvt_pk(0.f, w) & 0xffff0000u) | (unsigned)idx[m]; }
        }
}
__device__ __forceinline__ void phase_peer2(const Params& p, unsigned char* lds, int bid, int nb) {
    const int tid = get_tid(), lane = tid & 63, wave = tid >> 6;
    unsigned char* ws = p.ws;
    const unsigned* EWT = (const unsigned*)(ws + WS_EWT); const bf16_t* Y = (const bf16_t*)(ws + WS_X1); const float* mod = (const float*)(ws + WS_MOD);
    for (int si = bid; si < 256; si += nb) {
        const int s = (si & 7) * 32 + (si >> 3);
        __syncthreads();
        {   const u32x4* sp = (const u32x4*)(ws + WS_E8U + (size_t)s * 131072);
#pragma unroll
            for (int i = 0; i < 16; ++i) ((u32x4*)lds)[tid + NTHR * i] = sp[tid + NTHR * i]; }
        __syncthreads();
        const int tb0 = ((si >> 5) * 32 + wave) & 255;
        unsigned cur[16], nxt[16];
        {   const u32x4* wp = (const u32x4*)(EWT + (size_t)tb0 * 8192) + lane;
#pragma unroll
            for (int u = 0; u < 4; ++u) { const u32x4 v = wp[u * 64]; cur[4 * u] = v.x; cur[4 * u + 1] = v.y; cur[4 * u + 2] = v.z; cur[4 * u + 3] = v.w; } }
        float acc[8];
#pragma unroll
        for (int c = 0; c < 8; ++c) acc[c] = 0.f;
        f32x4 xa = {0.f, 0.f, 0.f, 0.f}, xb = xa;
        for (int q = 0; q < 256; ++q) {
            const int tb = (tb0 + 8 * (q >> 3)) & 255, g = q & 7;
            if (q + 1 < 256) { const int tbn = (tb0 + 8 * ((q + 1) >> 3)) & 255; const u32x4* wp = (const u32x4*)(EWT + (size_t)tbn * 8192 + ((q + 1) & 7) * 1024) + lane;
#pragma unroll
                for (int u = 0; u < 4; ++u) { const u32x4 v = wp[u * 64]; nxt[4 * u] = v.x; nxt[4 * u + 1] = v.y; nxt[4 * u + 2] = v.z; nxt[4 * u + 3] = v.w; } }
            const int t = tb * 64 + lane;
            if (g == 0) { xa = *(const f32x4*)(p.x + (size_t)t * D_ + 8 * s); xb = *(const f32x4*)(p.x + (size_t)t * D_ + 8 * s + 4);
                const u32x4 yw = *(const u32x4*)(Y + (size_t)t * D_ + 8 * s); const float* g1 = mod + (size_t)(t >> 11) * NMOD + 2 * D_ + 8 * s; const f32x4 ha = *(const f32x4*)g1, hb = *(const f32x4*)(g1 + 4);
                xa[0] += ha[0] * bflo(yw.x); xa[1] += ha[1] * bfhi(yw.x); xa[2] += ha[2] * bflo(yw.y); xa[3] += ha[3] * bfhi(yw.y); xb[0] += hb[0] * bflo(yw.z); xb[1] += hb[1] * bfhi(yw.z); xb[2] += hb[2] * bflo(yw.w); xb[3] += hb[3] * bfhi(yw.w); }
            u32x2 row[16];
#pragma unroll
            for (int u = 0; u < 16; ++u) row[u] = *(const LAS u32x2*)(unsigned)((cur[u] << 3) & 0x1fff8u);
#pragma unroll
            for (int u = 0; u < 16; ++u) {
                const float w = __builtin_bit_cast(float, cur[u]);
                const f32x2 v0 = __builtin_amdgcn_cvt_pk_f32_fp8((int)row[u].x, false), v1 = __builtin_amdgcn_cvt_pk_f32_fp8((int)row[u].x, true), v2 = __builtin_amdgcn_cvt_pk_f32_fp8((int)row[u].y, false), v3 = __builtin_amdgcn_cvt_pk_f32_fp8((int)row[u].y, true);
                fmac(acc[0], w, v0[0]); fmac(acc[1], w, v0[1]); fmac(acc[2], w, v1[0]); fmac(acc[3], w, v1[1]); fmac(acc[4], w, v2[0]); fmac(acc[5], w, v2[1]); fmac(acc[6], w, v3[0]); fmac(acc[7], w, v3[1]);
            }
            if (g == 7) {
                const float* g2 = mod + (size_t)(t >> 11) * NMOD + 5 * D_ + 8 * s;
                const f32x4 ga = *(const f32x4*)g2, gb = *(const f32x4*)(g2 + 4);
                f32x4 oa, ob;
#pragma unroll
                for (int c = 0; c < 4; ++c) { oa[c] = xa[c] + ga[c] * acc[c] * (1.f / 32.f); ob[c] = xb[c] + gb[c] * acc[4 + c] * (1.f / 32.f); }
                *(f32x4*)(p.out + (size_t)t * D_ + 8 * s) = oa; *(f32x4*)(p.out + (size_t)t * D_ + 8 * s + 4) = ob;
#pragma unroll
                for (int c = 0; c < 8; ++c) acc[c] = 0.f;
            }
#pragma unroll
            for (int u = 0; u < 16; ++u) cur[u] = nxt[u];
        }
    }
}

typedef const __attribute__((address_space(4))) Params* KargPtr;
__device__ __forceinline__ Params load_params() {
#if defined(__HIP_DEVICE_COMPILE__)
    KargPtr kp = (KargPtr)__builtin_amdgcn_kernarg_segment_ptr(); asm volatile("" : "+s"(kp)); Params r; __builtin_memcpy(&r, kp, sizeof(Params)); return r;
#else
    return Params{};
#endif
}
constexpr int N_PHASES = 12;
constexpr int LDS_BYTES = 152 * 1024;
__global__ void __launch_bounds__(NTHR) fwd_kernel(Params p_arg) {
    extern __shared__ __attribute__((aligned(16))) unsigned char lds[];
    const int bid = blockIdx.x, nb = gridDim.x, tid = get_tid();
    unsigned char* ws = p_arg.ws;
    volatile LAS unsigned* xbst = (volatile LAS unsigned*)((LAS unsigned char*)lds + LDS_BYTES - 16);
    if (tid == 0) { xbst[0] = 0u; xbst[1] = 0u; xbst[2] = 0u; xbst[3] = 0u; }
    __syncthreads();
    if ((p_arg.ph_hi - p_arg.ph_lo) > 1) (void)xcd_barrier_post((unsigned*)(ws + WS_BAR), xbst);
#ifdef ONLY_PHASE
#define IN(k) ((k) == ONLY_PHASE && p.ph_lo <= (k) && (k) < p.ph_hi)
#else
#define IN(k) (p.ph_lo <= (k) && (k) < p.ph_hi)
#endif
#define SEAM(k) do { const Params p = load_params(); if (p.ph_lo <= (k) && (k) + 1 < p.ph_hi) { XcdBarrier bar; bar.bar = (unsigned*)(p.ws + WS_BAR); bar.x = xb_xcc_id(); bar.st = xbst; xcd_barrier(bar); } } while (0)
#ifndef REPEAT_MASK
#define REPEAT_MASK 0
#endif
#define REP(k) for (int rep_ = 0; rep_ < (((REPEAT_MASK) >> (k)) & 1) + 1; ++rep_)
    REP(0) { const Params p = load_params(); if (IN(0)) { unsigned char* ws = p.ws; const float* mod = (const float*)(ws + WS_MOD); (void)mod;
        phase_prep(p, lds, bid, nb);
    } }
    SEAM(0);
    REP(1) { const Params p = load_params(); if (IN(1)) { unsigned char* ws = p.ws; const float* mod = (const float*)(ws + WS_MOD); (void)mod;
        phase_norm<false>(p.x, nullptr, 0, p.g1, mod, 0, D_, (bf16_t*)(ws + WS_H), bid, nb);
    } }
    SEAM(1);
    REP(2) { const Params p = load_params(); if (IN(2)) { unsigned char* ws = p.ws; const float* mod = (const float*)(ws + WS_MOD); (void)mod;
        phase_gates(p, lds, bid, nb);
        { pg8::Gemm g{(const bf16_t*)(ws + WS_H), (const bf16_t*)(ws + WS_WINT), T_, 7168, D_}; pg8::StaticOrder S; S.init(T_, 7168, nb, bid);
        pg8::EpiSeg E{(bf16_t*)(ws + WS_P)}; pg8::gemm_phase<pg8::EpiSeg, pg8::StaticOrder, true, true>((LAS unsigned char*)lds, g, S, E); }
    } }
    SEAM(2);
    REP(3) { const Params p = load_params(); if (IN(3)) { unsigned char* ws = p.ws; const float* mod = (const float*)(ws + WS_MOD); (void)mod;
        phase_post(p, bid, nb);
    } }
    SEAM(3);
    REP(4) { const Params p = load_params(); if (IN(4)) { unsigned char* ws = p.ws; const float* mod = (const float*)(ws + WS_MOD); (void)mod;
        { for (int u = bid; u < 64; u += nb) mlstm_passA(p, lds, u);
        unsigned* qctr = (unsigned*)(ws + WS_QCTR) + rep_; LAS int* slot = (LAS int*)((LAS unsigned char*)lds + LDS_BYTES - 32);
        for (;;) { __syncthreads(); if (tid == 0) *slot = (int)atomicAdd(qctr, 1u); __syncthreads(); const int u = *slot; if (u >= 512) break;
            const int bh = u & 63; fox_unit(p, lds, bh >> 3, bh & 7, 7 - (u >> 6)); } }
    } }
    SEAM(4);
    REP(5) { const Params p = load_params(); if (IN(5)) { unsigned char* ws = p.ws; const float* mod = (const float*)(ws + WS_MOD); (void)mod;
        { for (int u = bid; u < 1024; u += nb) mlstm_passB(p, lds, u); }
    } }
    SEAM(5);
    REP(6) { const Params p = load_params(); if (IN(6)) { unsigned char* ws = p.ws; const float* mod = (const float*)(ws + WS_MOD); (void)mod;
        { pg8::Gemm g{(const bf16_t*)(ws + WS_H), (const bf16_t*)(ws + WS_WOT), T_, D_, D_}; pg8::StaticOrder S; S.init(T_, D_, nb, bid);
        pg8::EpiBf E{(bf16_t*)(ws + WS_X1), D_}; pg8::gemm_phase<pg8::EpiBf, pg8::StaticOrder, true, true>((LAS unsigned char*)lds, g, S, E); }
    } }
    SEAM(6);
    REP(7) { const Params p = load_params(); if (IN(7)) { unsigned char* ws = p.ws; const float* mod = (const float*)(ws + WS_MOD); (void)mod;
        convert_experts(p, bid, nb);
    } }
    REP(7) { const Params p = load_params(); if (IN(7)) { unsigned char* ws = p.ws; const float* mod = (const float*)(ws + WS_MOD); (void)mod;
        phase_norm<true>(p.x, (const bf16_t*)(ws + WS_X1), 2 * D_, p.g2, mod, 3 * D_, 4 * D_, (bf16_t*)(ws + WS_H2), bid, nb);
    } }
    SEAM(7);
    REP(8) { const Params p = load_params(); if (IN(8)) { unsigned char* ws = p.ws; const float* mod = (const float*)(ws + WS_MOD); (void)mod;
        { pg8::Gemm g{(const bf16_t*)(ws + WS_H2), (const bf16_t*)(ws + WS_WQT), T_, D_, D_}; pg8::StaticOrder S; S.init(T_, D_, nb, bid);
        pg8::EpiBf E{(bf16_t*)(ws + WS_Q), D_}; pg8::gemm_phase<pg8::EpiBf, pg8::StaticOrder, true, true>((LAS unsigned char*)lds, g, S, E); }
    } }
    SEAM(8);
    REP(9) { const Params p = load_params(); if (IN(9)) { unsigned char* ws = p.ws; const float* mod = (const float*)(ws + WS_MOD); (void)mod;
        phase_topk(p, lds, bid, nb);
    } }
    SEAM(9);
    REP(10) { const Params p = load_params(); if (IN(10)) { unsigned char* ws = p.ws; const float* mod = (const float*)(ws + WS_MOD); (void)mod;
#ifdef PROBE_L2
        phase_peer1(p, lds, bid, nb, rep_);
#else
        phase_peer1(p, lds, bid, nb, 0);
#endif
    } }
    SEAM(10);
    REP(11) { const Params p = load_params(); if (IN(11)) { unsigned char* ws = p.ws; const float* mod = (const float*)(ws + WS_MOD); (void)mod;
        phase_peer2(p, lds, bid, nb);
    } }
#undef IN
#undef SEAM
}

#ifndef ONE_LAUNCH
#define ONE_LAUNCH 1
#endif
extern "C" void kernel_launch(void* const* d_in, const int* in_sizes, int n_in, void* d_out, int out_size, void* d_ws, size_t ws_size, hipStream_t stream) {
    static int grid = 0;
    if (grid == 0) {
        int dev = 0, cus = 0, per_cu = 0;
        if (n_in != 21 || ws_size < WS_END) { fprintf(stderr, "kernel_launch: unexpected n_in %d / ws_size %zu (need %zu)\n", n_in, ws_size, (size_t)WS_END); grid = -1; return; }
        hipGetDevice(&dev); hipDeviceGetAttribute(&cus, hipDeviceAttributeMultiprocessorCount, dev);
        if (hipFuncSetAttribute((const void*)fwd_kernel, hipFuncAttributeMaxDynamicSharedMemorySize, LDS_BYTES) != hipSuccess) { fprintf(stderr, "kernel_launch: hipFuncSetAttribute failed\n"); grid = -1; return; }
        if (hipOccupancyMaxActiveBlocksPerMultiprocessor(&per_cu, (const void*)fwd_kernel, NTHR, LDS_BYTES) != hipSuccess || per_cu < 1) { fprintf(stderr, "kernel_launch: occupancy query says %d\n", per_cu); (void)hipGetLastError(); }
        grid = cus > 0 ? cus : 256;
    }
    if (grid < 0) return;
    Params p{};
    const float** pp = (const float**)&p;
    for (int i = 0; i < 21; ++i) pp[i] = (const float*)d_in[i];
    p.out = (float*)d_out; p.ws = (unsigned char*)d_ws;
    hipMemsetAsync((char*)d_ws + WS_BAR, 0, 16384, stream);
#if ONE_LAUNCH
    p.ph_lo = 0; p.ph_hi = N_PHASES;
    void* args[] = {&p};
    hipError_t e = hipLaunchCooperativeKernel((const void*)fwd_kernel, dim3(grid), dim3(NTHR), args, LDS_BYTES, stream);
    if (e != hipSuccess) fprintf(stderr, "cooperative launch failed: %s (grid %d)\n", hipGetErrorString(e), grid);
#else
    for (int ph = 0; ph < N_PHASES; ++ph) { p.ph_lo = ph; p.ph_hi = ph + 1; hipLaunchKernelGGL(fwd_kernel, dim3(grid), dim3(NTHR), LDS_BYTES, stream, p); }
#endif
}
```

```cpp
#include <hip/hip_runtime.h>
#include <cstdio>
#include <cstdint>

#define GAS __attribute__((address_space(1)))
#define LAS __attribute__((address_space(3)))
typedef unsigned short bf16_t;
typedef short bf16x8 __attribute__((ext_vector_type(8)));
typedef float f32x4 __attribute__((ext_vector_type(4)));
typedef float f32x16 __attribute__((ext_vector_type(16)));
typedef unsigned u32x4 __attribute__((ext_vector_type(4)));
typedef unsigned u32x2 __attribute__((ext_vector_type(2)));

constexpr int T_ = 16384, D_ = 2048, B_ = 8, S_ = 2048, NTHR = 512;
constexpr float EPS_ = 1e-6f;
constexpr int NMOD = 6 * D_;
constexpr int INCOLS = 7184;

constexpr size_t WS_BAR   = 0;
constexpr size_t WS_MOD   = 16384;
constexpr size_t WS_WG    = WS_MOD + (size_t)B_ * NMOD * 4;
constexpr size_t WS_GATE  = WS_WG + 16 * 2048 * 4;
constexpr size_t WS_F     = WS_GATE + (size_t)T_ * 16 * 4;
constexpr size_t WS_NST   = WS_F + 64 * 2048 * 4;
constexpr size_t WS_MST   = WS_NST + 1024 * 256 * 4;
constexpr size_t WS_DSC   = WS_MST + 4096;
constexpr size_t WS_WINT  = WS_DSC + 16384 * 4;
constexpr size_t WS_WOT   = WS_WINT + (size_t)7168 * 2048 * 2;
constexpr size_t WS_WQT   = WS_WOT + (size_t)2048 * 2048 * 2;
constexpr size_t WS_H     = WS_WQT + (size_t)2048 * 2048 * 2;
constexpr size_t WS_P     = WS_H + (size_t)T_ * 2048 * 2;
constexpr size_t SEG_B    = (size_t)T_ * 1024 * 2;
constexpr size_t WS_CST   = WS_P + 7 * SEG_B;
constexpr size_t WS_E8D   = WS_CST + (size_t)1024 * 256 * 256 * 2;
constexpr size_t WS_E8U   = WS_E8D + (size_t)16384 * 2048;
constexpr size_t WS_END   = WS_E8U + (size_t)16384 * 2048;
constexpr size_t WS_QC    = WS_E8D;
constexpr size_t WS_KC    = WS_E8U;
constexpr size_t WS_QCTR  = 15360;
constexpr size_t WS_H2    = WS_P;
constexpr size_t WS_Q     = WS_H2 + (size_t)T_ * 2048 * 2;
constexpr size_t WS_IDX   = WS_Q + (size_t)T_ * 2048 * 2;
constexpr size_t WS_GW    = WS_IDX + (size_t)T_ * 128 * 4;
static_assert(WS_GW + (size_t)T_ * 128 * 4 <= WS_CST, "alias overflow");
constexpr size_t WS_X1    = WS_CST;
constexpr size_t WS_EWT   = WS_GW + (size_t)T_ * 128 * 4;
static_assert(WS_EWT + (size_t)T_ * 128 * 4 <= WS_CST, "alias overflow 2");

struct Params {
    const float *x, *c, *w_ada, *b_ada, *g1, *g2, *w_in, *fox_fb, *fox_qg, *fox_kg, *conv_w, *conv_b, *m_ib, *m_fb, *m_hg, *w_out, *w_q, *sk1, *sk2, *e_down, *e_up;
    float* out; unsigned char* ws; int ph_lo, ph_hi;
};

__device__ __forceinline__ int get_tid() { int t = threadIdx.x; asm volatile("" : "+v"(t)); return t; }
__device__ __forceinline__ void lds_barrier() { asm volatile("s_waitcnt lgkmcnt(0)\n\ts_barrier" ::: "memory"); }
__device__ __forceinline__ unsigned cvt_pk(float lo, float hi) { unsigned r; asm("v_cvt_pk_bf16_f32 %0, %1, %2" : "=v"(r) : "v"(lo), "v"(hi)); return r; }
__device__ __forceinline__ void fmac(float& acc, float a, float b) { asm("v_fmac_f32 %0, %1, %2" : "+v"(acc) : "v"(a), "v"(b)); }
__device__ __forceinline__ float bf2f(unsigned short h) { return __builtin_bit_cast(float, ((unsigned)h) << 16); }
__device__ __forceinline__ float bflo(unsigned w) { return __builtin_bit_cast(float, w << 16); }
__device__ __forceinline__ float bfhi(unsigned w) { return __builtin_bit_cast(float, w & 0xffff0000u); }
__device__ __forceinline__ float wsum(float v) {
#pragma unroll
    for (int o = 32; o; o >>= 1) v += __shfl_xor(v, o);
    return v; }
__device__ __forceinline__ float wmax(float v) {
#pragma unroll
    for (int o = 32; o; o >>= 1) v = fmaxf(v, __shfl_xor(v, o));
    return v; }
__device__ __forceinline__ float logsig(float x) { return fminf(x, 0.f) - log1pf(expf(-fabsf(x))); }
__device__ __forceinline__ float sigm(float x) { return 1.f / (1.f + expf(-x)); }
__device__ __forceinline__ float silu_f(float x) { return x / (1.f + expf(-x)); }
namespace pg8 {
#define PG8_LAS __attribute__((address_space(3)))
typedef unsigned short bf16_t;
typedef short bf16x8 __attribute__((ext_vector_type(8)));
typedef float f32x4 __attribute__((ext_vector_type(4)));
typedef unsigned u32x4 __attribute__((ext_vector_type(4)));
constexpr int BM = 256, BK = 64, HALF = 128, HTB = HALF * BK * 2  , STAGE_BYTES = 8 * HTB, NXCD = 8, WGM = 8;

__host__ __device__ __forceinline__ int lds_byte(int r, int c) { const int st = (r >> 4) * 2 + (c >> 5), rr = r & 15, cc = c & 31, ob = rr * 64 + cc * 2; return st * 1024 + (ob ^ (((ob >> 9) & 1) << 5)); }
__host__ __device__ __forceinline__ void stage_rc(int b, int& R, int& C) { const int st = b / 1024, sb = b % 1024, swz = sb ^ (((sb >> 9) & 1) << 5); R = (st >> 1) * 16 + swz / 64; C = (st & 1) * 32 + (swz % 64) / 2; }
__host__ __device__ __forceinline__ int perm32(int rho) { const int n = rho >> 4, i = rho & 15; return 8 * (i >> 2) + 4 * n + (i & 3); }

struct Unit { int pm, pn; };
struct Gemm { const bf16_t* A; const bf16_t* Bt; int M, N, K; };

struct StaticOrder {
    int nM, nN, nwg, G, c;
    __host__ __device__ void init(int M, int N, int G_, int c_) { nM = M / BM; nN = N / BM; nwg = nM * nN; G = G_; c = c_; }
    __host__ __device__ bool next(int i, Unit& u) const {
        const long L = (long)i * G + c; if (L >= nwg) return false;
        int wgid = (int)L; { const int q = nwg / NXCD, r = nwg % NXCD, xcd = wgid % NXCD, off = wgid / NXCD; wgid = (xcd < r ? xcd * (q + 1) : r * (q + 1) + (xcd - r) * q) + off; }
        const int nig = WGM * nN, gid = wgid / nig, fm = gid * WGM, gsz = (nM - fm) < WGM ? (nM - fm) : WGM;
        u.pm = fm + ((wgid % nig) % gsz); u.pn = (wgid % nig) / gsz; return true;
    }
    __device__ __forceinline__ void a_ready(const Unit&) const {}
    __device__ __forceinline__ void done(const Unit&) const {}
};
struct EpiSeg {
    static constexpr bool PERM = true, AFTER_DRAIN = false;
    bf16_t* P;
    __device__ __forceinline__ void operator()(const f32x4 (&acc)[2][2][4][2], const Unit& u, int wr, int wc, int fr, int fq) const {
        const int seg = u.pn >> 2; bf16_t* base = P + (size_t)seg * ((size_t)T_ * 1024);
        const int row0 = u.pm * BM + wr * 64 + fr, col0 = (u.pn & 3) * 256 + wc * 32 + 8 * fq;
#pragma unroll
        for (int ai = 0; ai < 2; ++ai)
#pragma unroll
            for (int m = 0; m < 4; ++m) { bf16_t* rowp = base + (size_t)(row0 + ai * HALF + m * 16) * 1024 + col0;
#pragma unroll
                for (int bj = 0; bj < 2; ++bj) { const f32x4 v0 = acc[ai][bj][m][0], v1 = acc[ai][bj][m][1];
                    u32x4 w; w.x = cvt_pk(v0[0], v0[1]); w.y = cvt_pk(v0[2], v0[3]); w.z = cvt_pk(v1[0], v1[1]); w.w = cvt_pk(v1[2], v1[3]);
                    *(u32x4*)(rowp + bj * HALF) = w; } }
    }
};
struct EpiBf {
    static constexpr bool PERM = true, AFTER_DRAIN = false;
    bf16_t* O; int ldc;
    __device__ __forceinline__ void operator()(const f32x4 (&acc)[2][2][4][2], const Unit& u, int wr, int wc, int fr, int fq) const {
        const int row0 = u.pm * BM + wr * 64 + fr, col0 = u.pn * BM + wc * 32 + 8 * fq;
#pragma unroll
        for (int ai = 0; ai < 2; ++ai)
#pragma unroll
            for (int m = 0; m < 4; ++m) { bf16_t* rowp = O + (size_t)(row0 + ai * HALF + m * 16) * ldc + col0;
#pragma unroll
                for (int bj = 0; bj < 2; ++bj) { const f32x4 v0 = acc[ai][bj][m][0], v1 = acc[ai][bj][m][1];
                    u32x4 w; w.x = cvt_pk(v0[0], v0[1]); w.y = cvt_pk(v0[2], v0[3]); w.z = cvt_pk(v1[0], v1[1]); w.w = cvt_pk(v1[2], v1[3]);
                    *(u32x4*)(rowp + bj * HALF) = w; } }
    }
};
struct EpiRes {
    static constexpr bool PERM = false, AFTER_DRAIN = false;
    const float* X; float* O; const float* mod; int goff;
    __device__ __forceinline__ void operator()(const f32x4 (&acc)[2][2][4][2], const Unit& u, int wr, int wc, int fr, int fq) const {
        const int row0 = u.pm * BM + wr * 64 + fr, col0 = u.pn * BM + wc * 32 + 4 * fq;
        const float* gp = mod + (size_t)((u.pm * BM) >> 11) * NMOD + goff + col0;
        f32x4 gv[2][2];
#pragma unroll
        for (int bj = 0; bj < 2; ++bj)
#pragma unroll
            for (int n = 0; n < 2; ++n) gv[bj][n] = *(const f32x4*)(gp + bj * HALF + 16 * n);
#pragma unroll
        for (int ai = 0; ai < 2; ++ai)
#pragma unroll
            for (int m = 0; m < 4; ++m) { const size_t ro = (size_t)(row0 + ai * HALF + m * 16) * D_ + col0;
#pragma unroll
                for (int bj = 0; bj < 2; ++bj)
#pragma unroll
                    for (int n = 0; n < 2; ++n) { const f32x4 xv = *(const f32x4*)(X + ro + bj * HALF + 16 * n);
                        *(f32x4*)(O + ro + bj * HALF + 16 * n) = xv + gv[bj][n] * acc[ai][bj][m][n]; } }
    }
};
template <class Epi, class Sched, bool ALIGN_EPI = false, bool SP2 = false>
__device__ __forceinline__ void gemm_phase(PG8_LAS unsigned char* lds, const Gemm g, const Sched& S, const Epi& E) {
    const int tid = get_tid(), wid = __builtin_amdgcn_readfirstlane(tid >> 6), lane = tid & 63, wr = wid >> 2, wc = wid & 3, fr = lane & 15, fq = lane >> 4;
    const int K = g.K, nt = K / BK;
    unsigned voffA[2], voffB[2];
#pragma unroll
    for (int i = 0; i < 2; ++i) { int R, C; stage_rc(tid * 16 + i * 8192, R, C); const int Rb = Epi::PERM ? ((R & ~31) + perm32(R & 31)) : R;
        voffA[i] = (unsigned)(R * K + C) * 2u; voffB[i] = (unsigned)(Rb * K + C) * 2u; }
    const size_t kstep = (size_t)(BK * 2);
    const size_t hstep = (size_t)HALF * K * 2;
    const size_t tstep = 2 * hstep;
    const unsigned ldsw = (unsigned)wid * 1024u;
    const int aoff = lds_byte(wr * 64 + fr, fq * 8), boff = lds_byte(wc * 32 + fr, fq * 8);
#define PG8_SA(b, h) (((b) * 2 + (h)) * HTB)
#define PG8_SB(b, h) ((4 + (b) * 2 + (h)) * HTB)
#define PG8_STAGE(bufoff, gbase, voff) do { _Pragma("unroll") for (int _i = 0; _i < 2; ++_i) \
        __builtin_amdgcn_global_load_lds((const unsigned*)((const char*)(gbase) + (voff)[_i]), (PG8_LAS unsigned*)(lds + (bufoff) + ldsw + _i * 8192), 16, 0, 0); } while (0)
#define PG8_LDA(dst, b, h) do { _Pragma("unroll") for (int m = 0; m < 4; ++m) _Pragma("unroll") for (int k = 0; k < 2; ++k) dst[m][k] = *(const PG8_LAS bf16x8*)(lds + PG8_SA(b, h) + aoff + m * 2048 + k * 1024); } while (0)
#define PG8_LDB(dst, b, h) do { _Pragma("unroll") for (int n = 0; n < 2; ++n) _Pragma("unroll") for (int k = 0; k < 2; ++k) dst[n][k] = *(const PG8_LAS bf16x8*)(lds + PG8_SB(b, h) + boff + n * 2048 + k * 1024); } while (0)
#define PG8_MMA(ai, bj, At, Bt) do { __builtin_amdgcn_s_setprio(1); _Pragma("unroll") for (int m = 0; m < 4; ++m) _Pragma("unroll") for (int n = 0; n < 2; ++n) _Pragma("unroll") for (int k = 0; k < 2; ++k) \
        acc[ai][bj][m][n] = __builtin_amdgcn_mfma_f32_16x16x32_bf16(Bt[n][k], At[m][k], acc[ai][bj][m][n], 0, 0, 0); __builtin_amdgcn_s_setprio(0); } while (0)
#define PG8_WAIT_V(n) asm volatile("s_waitcnt vmcnt(" #n ")" ::: "memory")
#define PG8_WAIT_L(n) asm volatile("s_waitcnt lgkmcnt(" #n ")" ::: "memory")
#define PG8_BAR __builtin_amdgcn_s_barrier()
#define PG8_SCHED __builtin_amdgcn_sched_barrier(0)
    Unit cur, nxt; int ui = 0;
    if (!S.next(0, cur)) return;
    f32x4 acc[2][2][4][2];
#pragma unroll
    for (int a = 0; a < 2; ++a)
#pragma unroll
        for (int b = 0; b < 2; ++b)
#pragma unroll
            for (int m = 0; m < 4; ++m)
#pragma unroll
                for (int n = 0; n < 2; ++n) acc[a][b][m][n] = (f32x4){0.f, 0.f, 0.f, 0.f};
    bf16x8 At[4][2], B0[2][2], B1[2][2];
    const char* cA = (const char*)g.A + (size_t)cur.pm * tstep; const char* cB = (const char*)g.Bt + (size_t)cur.pn * tstep;
    S.a_ready(cur);
    if constexpr (SP2) {
        PG8_STAGE(PG8_SB(0, 0), cB, voffB); PG8_STAGE(PG8_SB(0, 1), cB + hstep, voffB); PG8_STAGE(PG8_SA(0, 0), cA, voffA); PG8_STAGE(PG8_SA(0, 1), cA + hstep, voffA);
        if (wr == 1) PG8_BAR;
        PG8_WAIT_V(2); PG8_BAR;
        PG8_STAGE(PG8_SB(1, 0), cB + kstep, voffB); PG8_STAGE(PG8_SA(1, 0), cA + kstep, voffA); PG8_STAGE(PG8_SB(1, 1), cB + hstep + kstep, voffB);
        PG8_WAIT_V(6); PG8_BAR;
    } else {
        PG8_STAGE(PG8_SB(0, 0), cB, voffB); PG8_STAGE(PG8_SA(0, 0), cA, voffA); PG8_STAGE(PG8_SB(0, 1), cB + hstep, voffB); PG8_STAGE(PG8_SA(0, 1), cA + hstep, voffA);
        if (wr == 1) PG8_BAR;
        PG8_WAIT_V(4); PG8_BAR;
        PG8_STAGE(PG8_SB(1, 0), cB + kstep, voffB); PG8_STAGE(PG8_SA(1, 0), cA + kstep, voffA); PG8_STAGE(PG8_SB(1, 1), cB + hstep + kstep, voffB);
        PG8_WAIT_V(6); PG8_BAR;
    }
    for (;;) {
        const bool has_next = S.next(ui + 1, nxt);
        const char* nA = has_next ? (const char*)g.A + (size_t)nxt.pm * tstep : cA; const char* nB = has_next ? (const char*)g.Bt + (size_t)nxt.pn * tstep : cB;
        for (int t = 0; t < nt; t += 2) {
            const bool last = (t == nt - 2);
            const char* a1 = cA + (size_t)(t + 1) * kstep;
            const char* a2 = last ? nA : cA + (size_t)(t + 2) * kstep; const char* b2 = last ? nB : cB + (size_t)(t + 2) * kstep;
            const char* a3 = a2 + kstep; const char* b3 = b2 + kstep;
            if (last && has_next) S.a_ready(nxt);
            if constexpr (SP2) {
            PG8_LDB(B0, 0, 0); PG8_LDB(B1, 0, 1); PG8_SCHED; PG8_LDA(At, 0, 0); PG8_STAGE(PG8_SA(1, 1), a1 + hstep, voffA);
            PG8_WAIT_V(8); PG8_WAIT_L(0); PG8_BAR; PG8_MMA(0, 0, At, B0); PG8_MMA(0, 1, At, B1); PG8_BAR; PG8_SCHED;
            PG8_LDA(At, 0, 1); PG8_STAGE(PG8_SB(0, 0), b2, voffB); PG8_STAGE(PG8_SB(0, 1), b2 + hstep, voffB); PG8_STAGE(PG8_SA(0, 0), a2, voffA);
            PG8_WAIT_V(8); PG8_WAIT_L(0); PG8_BAR; PG8_MMA(1, 0, At, B0); PG8_MMA(1, 1, At, B1); PG8_BAR; PG8_SCHED;
            PG8_LDB(B0, 1, 0); PG8_LDB(B1, 1, 1); PG8_SCHED; PG8_LDA(At, 1, 0); PG8_STAGE(PG8_SA(0, 1), a2 + hstep, voffA);
            PG8_WAIT_V(8); PG8_WAIT_L(0); PG8_BAR; PG8_MMA(0, 0, At, B0); PG8_MMA(0, 1, At, B1); PG8_BAR; PG8_SCHED;
            PG8_LDA(At, 1, 1); PG8_STAGE(PG8_SB(1, 0), b3, voffB); PG8_STAGE(PG8_SB(1, 1), b3 + hstep, voffB); PG8_STAGE(PG8_SA(1, 0), a3, voffA);
            PG8_WAIT_V(8); PG8_WAIT_L(0); PG8_BAR; PG8_MMA(1, 0, At, B0); PG8_MMA(1, 1, At, B1); PG8_BAR; PG8_SCHED;
            } else {
            PG8_LDB(B0, 0, 0); PG8_SCHED; PG8_LDA(At, 0, 0); PG8_STAGE(PG8_SA(1, 1), a1 + hstep, voffA);
            PG8_WAIT_L(8); PG8_BAR; PG8_WAIT_L(0); PG8_MMA(0, 0, At, B0); PG8_BAR; PG8_SCHED;
            PG8_LDB(B1, 0, 1); PG8_STAGE(PG8_SB(0, 0), b2, voffB);
            PG8_BAR; PG8_WAIT_L(0); PG8_MMA(0, 1, At, B1); PG8_BAR;
            PG8_LDA(At, 0, 1); PG8_STAGE(PG8_SA(0, 0), a2, voffA);
            PG8_BAR; PG8_WAIT_L(0); PG8_MMA(1, 0, At, B0); PG8_BAR; PG8_SCHED;
            PG8_STAGE(PG8_SB(0, 1), b2 + hstep, voffB);
            PG8_WAIT_V(6); PG8_BAR; PG8_MMA(1, 1, At, B1); PG8_BAR;
            PG8_LDB(B0, 1, 0); PG8_SCHED; PG8_LDA(At, 1, 0); PG8_STAGE(PG8_SA(0, 1), a2 + hstep, voffA);
            PG8_WAIT_L(8); PG8_BAR; PG8_WAIT_L(0); PG8_MMA(0, 0, At, B0); PG8_BAR; PG8_SCHED;
            PG8_LDB(B1, 1, 1); PG8_STAGE(PG8_SB(1, 0), b3, voffB);
            PG8_BAR; PG8_WAIT_L(0); PG8_MMA(0, 1, At, B1); PG8_BAR;
            PG8_LDA(At, 1, 1); PG8_STAGE(PG8_SA(1, 0), a3, voffA);
            PG8_BAR; PG8_WAIT_L(0); PG8_MMA(1, 0, At, B0); PG8_BAR; PG8_SCHED;
            PG8_STAGE(PG8_SB(1, 1), b3 + hstep, voffB);
            PG8_WAIT_V(6); PG8_BAR; PG8_MMA(1, 1, At, B1); PG8_BAR;
            }
        }
        if constexpr (ALIGN_EPI) { if (wr == 0) PG8_BAR; }
        if constexpr (!Epi::AFTER_DRAIN) { E(acc, cur, wr, wc, fr, fq); S.done(cur); }
        if (!has_next) break;
#pragma unroll
        for (int a = 0; a < 2; ++a)
#pragma unroll
            for (int b = 0; b < 2; ++b)
#pragma unroll
                for (int m = 0; m < 4; ++m)
#pragma unroll
                    for (int n = 0; n < 2; ++n) acc[a][b][m][n] = (f32x4){0.f, 0.f, 0.f, 0.f};
        cur = nxt; cA = nA; cB = nB; ++ui;
        if constexpr (ALIGN_EPI) { if (wr == 1) PG8_BAR; }
    }
    PG8_WAIT_V(0);
    if constexpr (!ALIGN_EPI) { if (wr == 0) PG8_BAR; }
    PG8_BAR;
    if constexpr (Epi::AFTER_DRAIN) { E.fused(acc, cur, wr, wc, fr, fq, lds, wid, lane); S.done(cur); }
#undef PG8_SA
#undef PG8_SB
#undef PG8_STAGE
#undef PG8_LDA
#undef PG8_LDB
#undef PG8_MMA
#undef PG8_WAIT_V
#undef PG8_WAIT_L
#undef PG8_BAR
#undef PG8_SCHED
}
}
#define XB_TMO      128
#define XB_XCNT(j)  (256  + 64 * (j))
#define XB_XSUB(j)  (1280 + 64 * (j))
#define XB_XGEN(j)  (2304 + 64 * (j))
#define XB_TOP      3328
#define XB_TOPGEN   3392
#define XCD_BAR_WORDS 3456
#define XB_SPIN_CAP (1u << 18)

__device__ __forceinline__ unsigned xb_ld(unsigned* p)              { return __hip_atomic_load(p, __ATOMIC_RELAXED, __HIP_MEMORY_SCOPE_AGENT); }
__device__ __forceinline__ unsigned xb_add(unsigned* p, unsigned v) { return __hip_atomic_fetch_add(p, v, __ATOMIC_RELAXED, __HIP_MEMORY_SCOPE_AGENT); }
__device__ __forceinline__ unsigned xb_xcc_id() { return (unsigned)__builtin_amdgcn_s_getreg((3 << 11) | 20) & 0xFu; }
#define XB_SPIN(cond, bar) do { unsigned _sp = 0; while (cond) { __builtin_amdgcn_s_sleep(1); \
    if ((++_sp & 255u) == 0u) { if (xb_ld(&(bar)[XB_TMO])) break; if (_sp > XB_SPIN_CAP) { atomicAdd(&(bar)[XB_TMO], 1u); break; } } } } while (0)

struct XcdBarrier {
    unsigned* bar; unsigned x;
    volatile LAS unsigned* st;
};

__device__ __forceinline__ XcdBarrier xcd_barrier_post(unsigned* bar, volatile LAS unsigned* st) {
    XcdBarrier b; b.bar = bar; b.x = xb_xcc_id(); b.st = st;
    if (threadIdx.x == 0) (void)xb_add(&bar[XB_XCNT(b.x)], 1u);
    return b;
}
__device__ __forceinline__ void xcd_barrier_complete(unsigned* bar, unsigned x, unsigned& nloc, unsigned& nx) {
    const unsigned G = gridDim.x * gridDim.y * gridDim.z;
    unsigned sum, cnt, mine, sp = 0u;
    for (;;) {
        sum = 0u; cnt = 0u; mine = 0u;
#pragma unroll
        for (unsigned j = 0; j < 16; ++j) { const unsigned c = xb_ld(&bar[XB_XCNT(j)]); sum += c; cnt += (c > 0u) ? 1u : 0u; mine = (j == x) ? c : mine; }
        if (sum == G) break;
        __builtin_amdgcn_s_sleep(1);
        if ((++sp & 255u) == 0u) { if (xb_ld(&bar[XB_TMO])) break; if (sp > XB_SPIN_CAP) { atomicAdd(&bar[XB_TMO], 1u); break; } }
    }
    nloc = mine > 0u ? mine : 1u; nx = cnt > 0u ? cnt : 1u;
}

__device__ __forceinline__ void xcd_barrier(const XcdBarrier& b) {
    asm volatile("s_waitcnt vmcnt(0)" ::: "memory");
    __syncthreads();
    if (threadIdx.x == 0) {
        unsigned* bar = b.bar;
        __builtin_amdgcn_s_waitcnt(0);
        unsigned nloc = b.st[0], nx = b.st[1];
        if (nloc == 0u) { xcd_barrier_complete(bar, b.x, nloc, nx); b.st[0] = nloc; b.st[1] = nx; }
        const unsigned old = xb_add(&bar[XB_XSUB(b.x)], 1u);
        const unsigned gen = old / nloc;
        if (old + 1u == (gen + 1u) * nloc) {
            __builtin_amdgcn_fence(__ATOMIC_RELEASE, "agent");
            asm volatile("s_waitcnt vmcnt(0)" ::: "memory");
            const unsigned og = xb_add(&bar[XB_TOP], 1u);
            const unsigned tg = og / nx;
            if (og + 1u == (tg + 1u) * nx) xb_add(&bar[XB_TOPGEN], 1u);
            else XB_SPIN(xb_ld(&bar[XB_TOPGEN]) == tg, bar);
            __builtin_amdgcn_fence(__ATOMIC_ACQUIRE, "agent");
            xb_add(&bar[XB_XGEN(b.x)], 1u);
            asm volatile("s_waitcnt vmcnt(0)" ::: "memory");
        } else {
            XB_SPIN(xb_ld(&bar[XB_XGEN(b.x)]) == gen, bar);
            __builtin_amdgcn_fence(__ATOMIC_ACQUIRE, "agent");
            asm volatile("s_waitcnt vmcnt(0)" ::: "memory");
        }
    }
    __syncthreads();
}
__device__ __forceinline__ void phase_prep(const Params& p, unsigned char* lds, int bid, int nb) {
    const int tid = get_tid(), lane = tid & 63, wave = tid >> 6;
    unsigned char* ws = p.ws;
    float* mod = (float*)(ws + WS_MOD);
    if (bid < 192) {
        float* sc = (float*)lds;
        float* red = sc + 8 * 2048;
        for (int i = tid; i < 8 * 2048; i += NTHR) sc[i] = silu_f(p.c[i]);
        __syncthreads();
        for (int it = bid; it < 192; it += nb) {
            const int col = it * 64 + lane;
            float acc[8];
#pragma unroll
            for (int b = 0; b < 8; ++b) acc[b] = 0.f;
            const float* w = p.w_ada + (size_t)(wave * 256) * NMOD + col;
            const float* s0 = sc + wave * 256;
#pragma unroll 16
            for (int k = 0; k < 256; ++k) {
                const float wv = __builtin_nontemporal_load(w + (size_t)k * NMOD);
#pragma unroll
                for (int b = 0; b < 8; ++b) acc[b] += s0[b * 2048 + k] * wv;
            }
#pragma unroll
            for (int b = 0; b < 8; ++b) red[(wave * 8 + b) * 64 + lane] = acc[b];
            __syncthreads();
            {   const int b = wave; float s = p.b_ada[col];
#pragma unroll
                for (int w2 = 0; w2 < 8; ++w2) s += red[(w2 * 8 + b) * 64 + lane];
                mod[b * NMOD + col] = s; }
            __syncthreads();
        }
    }
    __syncthreads();
    {
        float* tile = (float*)lds;
        bf16_t* WinT = (bf16_t*)(ws + WS_WINT); bf16_t* WoT = (bf16_t*)(ws + WS_WOT); bf16_t* WqT = (bf16_t*)(ws + WS_WQT);
        for (int item = bid; item < 5632; item += nb) {
            const float* src; int ld, scol; bf16_t* dst; int kt;
            if (item < 3584) { const int seg = item >> 9, rem = item & 511, ntile = rem >> 5; kt = rem & 31;
                src = p.w_in; ld = INCOLS; scol = (seg < 3 ? seg * 1024 : 3080 + (seg - 3) * 1024) + ntile * 64; dst = WinT + (size_t)(seg * 1024 + ntile * 64) * 2048; }
            else if (item < 4608) { const int rem = item - 3584, ntile = rem >> 5; kt = rem & 31; src = p.w_out; ld = 2048; scol = ntile * 64; dst = WoT + (size_t)(ntile * 64) * 2048; }
            else { const int rem = item - 4608, ntile = rem >> 5; kt = rem & 31; src = p.w_q; ld = 2048; scol = ntile * 64; dst = WqT + (size_t)(ntile * 64) * 2048; }
            const int k0 = kt * 64;
#pragma unroll
            for (int ii = 0; ii < 8; ++ii) { const int k = wave + 8 * ii; tile[k * 65 + lane] = src[(size_t)(k0 + k) * ld + scol + lane]; }
            __syncthreads();
#pragma unroll
            for (int ii = 0; ii < 8; ++ii) { const int n = wave + 8 * ii; dst[(size_t)n * 2048 + k0 + lane] = (bf16_t)(cvt_pk(tile[lane * 65 + n], 0.f) & 0xffffu); }
            __syncthreads();
        }
    }
    {
        bf16_t* Wg = (bf16_t*)(ws + WS_WG);
        for (int i = bid * NTHR + tid; i < 16 * 2048; i += nb * NTHR) { const int g = i >> 11, k = i & 2047; const int col = g < 8 ? 3072 + g : 7176 + (g - 8);
            Wg[i] = (bf16_t)(cvt_pk(p.w_in[(size_t)k * INCOLS + col], 0.f) & 0xffffu); }
    }
}

__device__ __forceinline__ unsigned pack4_fp8(const f32x4 a) { int t = __builtin_amdgcn_cvt_pk_fp8_f32(a[0], a[1], 0, false); t = __builtin_amdgcn_cvt_pk_fp8_f32(a[2], a[3], t, true); return (unsigned)t; }
__device__ __forceinline__ void convert_experts(const Params& p, int bid, int nb) {
    const int tid = get_tid(); unsigned char* ws = p.ws;
    unsigned char* E8D = ws + WS_E8D; unsigned char* E8US = ws + WS_E8U;
    {
        const int lane = tid & 63, wave = tid >> 6; float* DSC = (float*)(ws + WS_DSC);
        for (int e = bid * 8 + wave; e < 16384; e += nb * 8) {
            const float* rp = p.e_down + (size_t)e * 2048;
            f32x4 v[8]; float mx = 0.f;
#pragma unroll
            for (int hf = 0; hf < 2; ++hf)
#pragma unroll
                for (int q = 0; q < 4; ++q) { v[hf * 4 + q] = *(const f32x4*)(rp + hf * 1024 + 16 * lane + 4 * q);
#pragma unroll
                    for (int c = 0; c < 4; ++c) mx = fmaxf(mx, fabsf(v[hf * 4 + q][c])); }
            mx = fmaxf(wmax(mx), 1e-30f);
            const float inv = 127.f / mx;
            if (lane == 0) DSC[e] = mx * (1.f / 127.f);
#pragma unroll
            for (int hf = 0; hf < 2; ++hf) { u32x4 o;
#pragma unroll
                for (int q = 0; q < 4; ++q) { unsigned w = 0u;
#pragma unroll
                    for (int c = 0; c < 4; ++c) w |= ((unsigned)__float2int_rn(v[hf * 4 + q][c] * inv) & 0xffu) << (8 * c);
                    o[q] = w; }
                *(u32x4*)(E8D + (size_t)e * 2048 + hf * 1024 + 16 * lane) = o; }
        }
    }
    for (int i = bid * NTHR + tid; i < 524288; i += nb * NTHR) {
        const int s = i & 255, eg = i >> 8;
        const float* sp = p.e_up + (size_t)(eg * 8) * 2048 + 8 * s;
        unsigned w[16];
#pragma unroll
        for (int q = 0; q < 8; ++q) { const f32x4 a = *(const f32x4*)(sp + (size_t)q * 2048), b = *(const f32x4*)(sp + (size_t)q * 2048 + 4); w[2 * q] = pack4_fp8(a * 32.f); w[2 * q + 1] = pack4_fp8(b * 32.f); }
        u32x4* dp = (u32x4*)(E8US + ((size_t)s * 16384 + eg * 8) * 8);
#pragma unroll
        for (int q = 0; q < 4; ++q) { u32x4 o; o.x = w[4 * q]; o.y = w[4 * q + 1]; o.z = w[4 * q + 2]; o.w = w[4 * q + 3]; dp[q] = o; }
    }
}

template <bool RES>
__device__ __forceinline__ void phase_norm(const float* xin, const bf16_t* yin, int gate_off, const float* gain, const float* mod, int shift_off, int scale_off, bf16_t* hout, int bid, int nb) {
    const int tid = get_tid(), lane = tid & 63, wave = tid >> 6;
    for (int row = bid * 8 + wave; row < T_; row += nb * 8) {
        const f32x4* xr = (const f32x4*)(xin + (size_t)row * D_);
        f32x4 v[8]; float ss = 0.f;
        const float* mb = mod + (size_t)(row >> 11) * NMOD;
#pragma unroll
        for (int j = 0; j < 8; ++j) { v[j] = xr[lane + 64 * j];
            if (RES) { const int k = 4 * (lane + 64 * j); const u32x2 yw = *(const u32x2*)(yin + (size_t)row * D_ + k); const f32x4 gv = *(const f32x4*)(mb + gate_off + k);
                v[j][0] += gv[0] * bflo(yw.x); v[j][1] += gv[1] * bfhi(yw.x); v[j][2] += gv[2] * bflo(yw.y); v[j][3] += gv[3] * bfhi(yw.y); }
            ss += v[j][0] * v[j][0] + v[j][1] * v[j][1] + v[j][2] * v[j][2] + v[j][3] * v[j][3]; }
        ss = wsum(ss);
        const float r = rsqrtf(ss * (1.f / D_) + EPS_);
        f32x4 hv[8];
#pragma unroll
        for (int j = 0; j < 8; ++j) {
            const int k = 4 * (lane + 64 * j);
            const f32x4 gn = *(const f32x4*)(gain + k), sh = *(const f32x4*)(mb + shift_off + k), scl = *(const f32x4*)(mb + scale_off + k);
#pragma unroll
            for (int e = 0; e < 4; ++e) hv[j][e] = (v[j][e] * r) * gn[e] * (1.f + scl[e]) + sh[e];
            u32x2 w; w.x = cvt_pk(hv[j][0], hv[j][1]); w.y = cvt_pk(hv[j][2], hv[j][3]);
            *(u32x2*)(hout + (size_t)row * D_ + k) = w;
        }
    }
}

__device__ __forceinline__ void phase_gates(const Params& p, unsigned char* lds, int bid, int nb) {
    const int tid = get_tid(), lane = tid & 63, wave = tid >> 6, r = lane & 31, hh = lane >> 5;
    unsigned char* ws = p.ws;
    const bf16_t* H = (const bf16_t*)(ws + WS_H); const bf16_t* Wg = (const bf16_t*)(ws + WS_WG); float* gate = (float*)(ws + WS_GATE);
    constexpr int WST = 4096 + 16;
    for (int i = tid; i < 16 * 256; i += NTHR) { const int g = i >> 8, c = i & 255; *(u32x4*)(lds + g * WST + c * 16) = *(const u32x4*)(Wg + (size_t)g * 2048 + c * 8); }
    __syncthreads();
    float* part = (float*)(lds + 16 * WST);
    for (int pr = bid; pr < T_ / 64; pr += nb) {
        const int t = pr * 64 + (wave >> 2) * 32 + r, kq = wave & 3;
        f32x16 acc;
#pragma unroll
        for (int i = 0; i < 16; ++i) acc[i] = 0.f;
        const bf16_t* hp = H + (size_t)t * D_ + kq * 512 + hh * 8; const unsigned char* wp = lds + (r & 15) * WST + kq * 1024 + hh * 16;
#pragma unroll 1
        for (int k0 = 0; k0 < 32; k0 += 16) {
            bf16x8 bfr[16];
#pragma unroll
            for (int j = 0; j < 16; ++j) bfr[j] = *(const bf16x8*)(hp + (k0 + j) * 16);
#pragma unroll
            for (int j = 0; j < 16; ++j) { bf16x8 a = *(const bf16x8*)(wp + (k0 + j) * 32); if (r >= 16) a = (bf16x8){0, 0, 0, 0, 0, 0, 0, 0};
                acc = __builtin_amdgcn_mfma_f32_32x32x16_bf16(a, bfr[j], acc, 0, 0, 0); }
        }
        __syncthreads();
#pragma unroll
        for (int i = 0; i < 8; ++i) part[(wave * 8 + i) * 64 + lane] = acc[i];
        __syncthreads();
        if (kq == 0) {
            float s[8];
#pragma unroll
            for (int i = 0; i < 8; ++i) s[i] = part[(wave * 8 + i) * 64 + lane] + part[((wave + 1) * 8 + i) * 64 + lane] + part[((wave + 2) * 8 + i) * 64 + lane] + part[((wave + 3) * 8 + i) * 64 + lane];
            f32x4 g0, g1; g0[0] = s[0]; g0[1] = s[1]; g0[2] = s[2]; g0[3] = s[3]; g1[0] = s[4]; g1[1] = s[5]; g1[2] = s[6]; g1[3] = s[7];
            *(f32x4*)(gate + (size_t)t * 16 + 4 * hh) = g0; *(f32x4*)(gate + (size_t)t * 16 + 8 + 4 * hh) = g1;
        }
    }
    __syncthreads();
}

__device__ __forceinline__ void phase_post(const Params& p, int bid, int nb) {
    const int tid = get_tid(), lane = tid & 63, wave = tid >> 6;
    unsigned char* ws = p.ws;
    bf16_t* Pq = (bf16_t*)(ws + WS_P); bf16_t* Pk = (bf16_t*)(ws + WS_P + SEG_B);
    const float qscale = 0.08838834764831845f * 1.4426950408889634f;
    for (int r = bid * 8 + wave; r < 2 * T_; r += nb * 8) {
        const int which = r >= T_ ? 1 : 0; const int t = r - which * T_;
        bf16_t* ptr = (which ? Pk : Pq) + (size_t)t * 1024 + lane * 16;
        const float* gn = (which ? p.fox_kg : p.fox_qg) + (lane & 7) * 16;
        u32x4 a = *(const u32x4*)ptr, b = *(const u32x4*)(ptr + 8);
        float f[16];
        f[0] = bflo(a.x); f[1] = bfhi(a.x); f[2] = bflo(a.y); f[3] = bfhi(a.y); f[4] = bflo(a.z); f[5] = bfhi(a.z); f[6] = bflo(a.w); f[7] = bfhi(a.w);
        f[8] = bflo(b.x); f[9] = bfhi(b.x); f[10] = bflo(b.y); f[11] = bfhi(b.y); f[12] = bflo(b.z); f[13] = bfhi(b.z); f[14] = bflo(b.w); f[15] = bfhi(b.w);
        float ss = 0.f;
#pragma unroll
        for (int i = 0; i < 16; ++i) ss += f[i] * f[i];
        ss += __shfl_xor(ss, 1); ss += __shfl_xor(ss, 2); ss += __shfl_xor(ss, 4);
        const float rr = rsqrtf(ss * (1.f / 128.f) + EPS_) * (which ? 1.f : qscale);
#pragma unroll
        for (int i = 0; i < 16; ++i) f[i] = (f[i] * rr) * gn[i];
        a.x = cvt_pk(f[0], f[1]); a.y = cvt_pk(f[2], f[3]); a.z = cvt_pk(f[4], f[5]); a.w = cvt_pk(f[6], f[7]);
        b.x = cvt_pk(f[8], f[9]); b.y = cvt_pk(f[10], f[11]); b.z = cvt_pk(f[12], f[13]); b.w = cvt_pk(f[14], f[15]);
        *(u32x4*)ptr = a; *(u32x4*)(ptr + 8) = b;
    }
    {
        const bf16_t* Mq = (const bf16_t*)(ws + WS_P + 3 * SEG_B); const bf16_t* Mk = (const bf16_t*)(ws + WS_P + 4 * SEG_B);
        bf16_t* QC = (bf16_t*)(ws + WS_QC); bf16_t* KC = (bf16_t*)(ws + WS_KC);
        for (int item = bid; item < 256; item += nb) {
            const int which = item >> 7, tb = item & 127, cg = tid & 127, run = tid >> 7, ch0 = cg * 8, ts = tb * 128 + run * 32, sp = ts & 2047;
            const bf16_t* src = (which ? Mk : Mq) + (size_t)ts * 1024 + ch0; bf16_t* dst = (which ? KC : QC) + (size_t)ts * 1024 + ch0;
            float w0[8], w1[8], w2[8], w3[8], cb[8], x0[8], x1[8], x2[8];
#pragma unroll
            for (int e = 0; e < 8; ++e) { const int ci = which * 1024 + ch0 + e; w0[e] = p.conv_w[ci]; w1[e] = p.conv_w[2048 + ci]; w2[e] = p.conv_w[4096 + ci]; w3[e] = p.conv_w[6144 + ci]; cb[e] = p.conv_b[ci]; }
            {   u32x4 a = {0u, 0u, 0u, 0u}, b = a, c = a;
                if (sp != 0) { a = *(const u32x4*)(src - 3 * 1024); b = *(const u32x4*)(src - 2 * 1024); c = *(const u32x4*)(src - 1024); }
#pragma unroll
                for (int e = 0; e < 4; ++e) { x0[2 * e] = bflo(a[e]); x0[2 * e + 1] = bfhi(a[e]); x1[2 * e] = bflo(b[e]); x1[2 * e + 1] = bfhi(b[e]); x2[2 * e] = bflo(c[e]); x2[2 * e + 1] = bfhi(c[e]); } }
            const float osc = which ? 0.0625f : 1.f;
            for (int s = 0; s < 32; ++s) {
                const u32x4 d = *(const u32x4*)(src + (size_t)s * 1024); float x3[8], y[8];
#pragma unroll
                for (int e = 0; e < 4; ++e) { x3[2 * e] = bflo(d[e]); x3[2 * e + 1] = bfhi(d[e]); }
#pragma unroll
                for (int e = 0; e < 8; ++e) { y[e] = silu_f(w0[e] * x0[e] + w1[e] * x1[e] + w2[e] * x2[e] + w3[e] * x3[e] + cb[e]) * osc; x0[e] = x1[e]; x1[e] = x2[e]; x2[e] = x3[e]; }
                u32x4 o; o.x = cvt_pk(y[0], y[1]); o.y = cvt_pk(y[2], y[3]); o.z = cvt_pk(y[4], y[5]); o.w = cvt_pk(y[6], y[7]);
                *(u32x4*)(dst + (size_t)s * 1024) = o;
            }
        }
    }
    const float* gate = (const float*)(ws + WS_GATE); float* F = (float*)(ws + WS_F);
    for (int sq = bid * 8 + wave; sq < 64; sq += nb * 8) {
        const int b = sq >> 3, h = sq & 7; const float fb = p.fox_fb[h];
        float v[32]; float run = 0.f;
#pragma unroll
        for (int i = 0; i < 32; ++i) { const int t = lane * 32 + i; run += logsig(gate[(size_t)(b * S_ + t) * 16 + h] + fb); v[i] = run; }
        float inc = run;
#pragma unroll
        for (int o = 1; o < 64; o <<= 1) { const float u = __shfl_up(inc, o); if (lane >= o) inc += u; }
        const float excl = inc - run;
#pragma unroll
        for (int i = 0; i < 32; ++i) F[(size_t)sq * S_ + lane * 32 + i] = (v[i] + excl) * 1.4426950408889634f;
    }
}
typedef short s16x4 __attribute__((ext_vector_type(4)));
__device__ __forceinline__ s16x4 lds_tr16(const unsigned char* p) { return __builtin_amdgcn_ds_read_tr16_b64_v4i16((LAS s16x4*)p); }
__device__ __forceinline__ bf16x8 tr_frag(const unsigned char* p0, int second_bytes) {
    const s16x4 a = lds_tr16(p0), b = lds_tr16(p0 + second_bytes);
    bf16x8 f; f[0] = a[0]; f[1] = a[1]; f[2] = a[2]; f[3] = a[3]; f[4] = b[0]; f[5] = b[1]; f[6] = b[2]; f[7] = b[3]; return f;
}
__device__ __forceinline__ unsigned split_bf16(float v, float& eff) { const unsigned hi = cvt_pk(v, 0.f) & 0xffffu; const float hf = bf2f((bf16_t)hi); const unsigned lo = cvt_pk(v - hf, 0.f) & 0xffffu; eff = hf + bf2f((bf16_t)lo); return hi | (lo << 16); }
__device__ __forceinline__ void fox_unit(const Params& p, unsigned char* lds, int b, int h, int qb) {
    const int tid = get_tid(), lane = tid & 63, wave = tid >> 6, r = lane & 31, hh = lane >> 5, li = lane & 15;
    unsigned char* ws = p.ws;
    const bf16_t* Pq = (const bf16_t*)(ws + WS_P); const bf16_t* Pk = (const bf16_t*)(ws + WS_P + SEG_B); const bf16_t* Pv = (const bf16_t*)(ws + WS_P + 2 * SEG_B);
    const float* F = (const float*)(ws + WS_F) + (size_t)(b * 8 + h) * S_;
    bf16_t* Oc = (bf16_t*)(ws + WS_H);
    constexpr int KST = 272, VST = 544, BUF = 64 * KST + 64 * VST;
    constexpr float THR = 8.f;
    const int q0w = qb * 256 + wave * 32, qs = q0w + r; const int q0s = __builtin_amdgcn_readfirstlane(q0w);
    const size_t trow = (size_t)(b * S_ + qs);
    bf16x8 qf[8];
#pragma unroll
    for (int ks = 0; ks < 8; ++ks) qf[ks] = *(const bf16x8*)(Pq + trow * 1024 + h * 128 + ks * 16 + hh * 8);
    float feff; const unsigned fq2 = split_bf16(F[qs], feff);
    float m = 0.f;
    u32x4 qa; qa.x = hh ? 0u : fq2; qa.y = 0u; qa.z = hh ? 0u : 0x3f803f80u; qa.w = 0u;
    f32x16 o[4];
#pragma unroll
    for (int d = 0; d < 4; ++d)
#pragma unroll
        for (int i = 0; i < 16; ++i) o[d][i] = 0.f;
    float l = 0.f;
    const int ntile = (qb * 256 + 256) / 64;
    const int srow0 = tid >> 4, scc = tid & 15;
    const bf16_t* kg = Pk + (size_t)(b * S_ + srow0) * 1024 + h * 128 + scc * 8; const bf16_t* vg = Pv + (size_t)(b * S_ + srow0) * 1024 + h * 128 + scc * 8;
    u32x4 kr[2], vr[2]; float fr = 0.f;
    const int vb_off = 64 * KST + (4 * hh + (li >> 2)) * VST + (16 * (r >> 4) + 4 * (li & 3)) * 2;
#define FOX_AUG(dst, fval) do { float e_; const unsigned s2_ = split_bf16(-(fval), e_); u32x4 w_; w_.x = 0x3f803f80u; w_.y = 0x3f803f80u; w_.z = s2_; w_.w = 0u; *(u32x4*)(dst) = w_; } while (0)
    __syncthreads();
#pragma unroll
    for (int i = 0; i < 2; ++i) { kr[i] = *(const u32x4*)(kg + (size_t)(32 * i) * 1024); vr[i] = *(const u32x4*)(vg + (size_t)(32 * i) * 1024); }
    if (tid < 64) fr = F[tid];
#pragma unroll
    for (int i = 0; i < 2; ++i) { *(u32x4*)(lds + (srow0 + 32 * i) * KST + scc * 16) = kr[i]; *(u32x4*)(lds + 64 * KST + (srow0 + 32 * i) * VST + scc * 16) = vr[i]; }
    if (tid < 64) FOX_AUG(lds + tid * KST + 256, fr);
    __syncthreads();
    for (int kt = 0; kt < ntile; ++kt) {
        const int k0 = kt * 64; unsigned char* cur = lds + (kt & 1) * BUF; unsigned char* nxt = lds + ((kt & 1) ^ 1) * BUF;
        const bool more = kt + 1 < ntile;
        if (more) {
#pragma unroll
            for (int i = 0; i < 2; ++i) { kr[i] = *(const u32x4*)(kg + (size_t)(k0 + 64 + 32 * i) * 1024); vr[i] = *(const u32x4*)(vg + (size_t)(k0 + 64 + 32 * i) * 1024); }
            if (tid < 64) fr = F[k0 + 64 + tid];
        }
        if (k0 <= q0s + 31) {
            f32x16 s[2];
            const bf16x8 qaf = __builtin_bit_cast(bf16x8, qa);
#pragma unroll
            for (int kb = 0; kb < 2; ++kb) {
#pragma unroll
                for (int i = 0; i < 16; ++i) s[kb][i] = 0.f;
#pragma unroll
                for (int ks = 0; ks < 8; ++ks) { const bf16x8 a = *(const bf16x8*)(cur + (kb * 32 + r) * KST + ks * 32 + hh * 16);
                    s[kb] = __builtin_amdgcn_mfma_f32_32x32x16_bf16(a, qf[ks], s[kb], 0, 0, 0); }
                {   const bf16x8 a = *(const bf16x8*)(cur + (kb * 32 + r) * KST + 256);
                    s[kb] = __builtin_amdgcn_mfma_f32_32x32x16_bf16(a, qaf, s[kb], 0, 0, 0); }
            }
            if (k0 + 63 > q0s) {
                const int lim = qs - k0;
#pragma unroll
                for (int kb = 0; kb < 2; ++kb)
#pragma unroll
                    for (int i = 0; i < 16; ++i) s[kb][i] = (kb * 32 + (i & 3) + 8 * (i >> 2) + 4 * hh > lim) ? -INFINITY : s[kb][i];
            }
            float mx = fmaxf(s[0][0], s[1][0]);
#pragma unroll
            for (int i = 1; i < 16; ++i) mx = fmaxf(mx, fmaxf(s[0][i], s[1][i]));
            mx = fmaxf(mx, __shfl_xor(mx, 32));
            if (__builtin_amdgcn_ballot_w64(mx > THR) != 0ull) {
                const float mnew_f = m + fmaxf(mx, 0.f); float meff; const unsigned m2 = split_bf16(-mnew_f, meff); meff = -meff;
                const float delta = meff - m, alpha = __builtin_amdgcn_exp2f(-delta);
                m = meff; if (!hh) qa.y = m2;
                l *= alpha;
#pragma unroll
                for (int d = 0; d < 4; ++d)
#pragma unroll
                    for (int i = 0; i < 16; ++i) o[d][i] *= alpha;
#pragma unroll
                for (int kb = 0; kb < 2; ++kb)
#pragma unroll
                    for (int i = 0; i < 16; ++i) s[kb][i] -= delta;
            }
            float ps = 0.f;
#pragma unroll
            for (int kb = 0; kb < 2; ++kb)
#pragma unroll
                for (int i = 0; i < 16; ++i) { const float pv = __builtin_amdgcn_exp2f(s[kb][i]); s[kb][i] = pv; ps += pv; }
            l += ps;
#pragma unroll
            for (int kb = 0; kb < 2; ++kb)
#pragma unroll
                for (int st = 0; st < 2; ++st) {
                    u32x4 pw; pw.x = cvt_pk(s[kb][8 * st + 0], s[kb][8 * st + 1]); pw.y = cvt_pk(s[kb][8 * st + 2], s[kb][8 * st + 3]);
                    pw.z = cvt_pk(s[kb][8 * st + 4], s[kb][8 * st + 5]); pw.w = cvt_pk(s[kb][8 * st + 6], s[kb][8 * st + 7]);
                    const bf16x8 pf = __builtin_bit_cast(bf16x8, pw);
#pragma unroll
                    for (int d = 0; d < 4; ++d) { const bf16x8 vf = tr_frag(cur + vb_off + (kb * 32 + st * 16) * VST + d * 64, 8 * VST);
                        o[d] = __builtin_amdgcn_mfma_f32_32x32x16_bf16(vf, pf, o[d], 0, 0, 0); }
                }
        }
        if (more) {
#pragma unroll
            for (int i = 0; i < 2; ++i) { *(u32x4*)(nxt + (srow0 + 32 * i) * KST + scc * 16) = kr[i]; *(u32x4*)(nxt + 64 * KST + (srow0 + 32 * i) * VST + scc * 16) = vr[i]; }
            if (tid < 64) FOX_AUG(nxt + tid * KST + 256, fr);
        }
        lds_barrier();
    }
#undef FOX_AUG
    l += __shfl_xor(l, 32);
    const float inv = 1.f / l;
#pragma unroll
    for (int d = 0; d < 4; ++d)
#pragma unroll
        for (int g = 0; g < 4; ++g) { u32x2 w; w.x = cvt_pk(o[d][4 * g] * inv, o[d][4 * g + 1] * inv); w.y = cvt_pk(o[d][4 * g + 2] * inv, o[d][4 * g + 3] * inv);
            *(u32x2*)(Oc + trow * D_ + h * 128 + d * 32 + 8 * g + 4 * hh) = w; }
}

__device__ __forceinline__ void mlstm_passA(const Params& p, unsigned char* lds, int unit) {
    const int tid = get_tid(), lane = tid & 63, wave = tid >> 6, r = lane & 31, hh = lane >> 5, li = lane & 15;
    const int b = unit >> 3, h = (unit >> 1) & 3, eh = unit & 1;
    unsigned char* ws = p.ws;
    const bf16_t* KC = (const bf16_t*)(ws + WS_KC); const bf16_t* Mv = (const bf16_t*)(ws + WS_P + 5 * SEG_B);
    const float* gate = (const float*)(ws + WS_GATE);
    bf16_t* Cst = (bf16_t*)(ws + WS_CST); float* nst = (float*)(ws + WS_NST); float* mst = (float*)(ws + WS_MST);
    constexpr int KST = 528, VST = 272;
    unsigned char* ksm = lds;
    unsigned char* vsm = ksm + 64 * KST;
    float* WSV = (float*)(vsm + 64 * VST);
    float* SCL = WSV + 2048;
    constexpr int STGS = 528;
    unsigned char* stg = (unsigned char*)(SCL + 128);
    __syncthreads();
    for (int cc = wave; cc < 32; cc += 8) {
        const int t = b * S_ + cc * 64 + lane;
        const float ipre = gate[(size_t)t * 16 + 8 + h] + p.m_ib[h], fpre = gate[(size_t)t * 16 + 12 + h] + p.m_fb[h];
        float bc = logsig(fpre);
#pragma unroll
        for (int o = 1; o < 64; o <<= 1) { const float u = __shfl_up(bc, o); if (lane >= o) bc += u; }
        const float a = ipre - bc; const float amax = wmax(a); const float bL = __shfl(bc, 63);
        WSV[cc * 64 + lane] = a; if (lane == 0) { SCL[cc] = bL; SCL[32 + cc] = amax; }
    }
    __syncthreads();
    if (tid == 0) { float m = 0.f; for (int cc = 0; cc < 32; ++cc) { const float mn = SCL[cc] + fmaxf(m, SCL[32 + cc]); SCL[64 + cc] = expf(SCL[cc] + m - mn); SCL[96 + cc] = mn; if (eh == 0) mst[(b * 4 + h) * 32 + cc] = m; m = mn; } }
    __syncthreads();
    for (int i = tid; i < 2048; i += NTHR) { const int cc = i >> 6; WSV[i] = expf(SCL[cc] + WSV[i] - SCL[96 + cc]); }
    f32x16 acc[4];
#pragma unroll
    for (int et = 0; et < 4; ++et)
#pragma unroll
        for (int i = 0; i < 16; ++i) acc[et][i] = 0.f;
    f32x16 accn;
#pragma unroll
    for (int i = 0; i < 16; ++i) accn[i] = 0.f;
    const int kb_off = (8 * hh + (li >> 2)) * KST + (wave * 32 + 16 * (r >> 4) + 4 * (li & 3)) * 2;
    const int vb_off = (8 * hh + (li >> 2)) * VST + (16 * (r >> 4) + 4 * (li & 3)) * 2;
    u32x4 pk[4], pv[2];
#pragma unroll
    for (int i = 0; i < 4; ++i) { const int c = tid + NTHR * i, row = c >> 5, c16 = c & 31; pk[i] = *(const u32x4*)(KC + (size_t)(b * S_ + row) * 1024 + h * 256 + c16 * 8); }
#pragma unroll
    for (int i = 0; i < 2; ++i) { const int c = tid + NTHR * i, row = c >> 4, c16 = c & 15; pv[i] = *(const u32x4*)(Mv + (size_t)(b * S_ + row) * 1024 + h * 256 + eh * 128 + c16 * 8); }
    for (int cc = 0; cc < 32; ++cc) {
        const int bhc = (b * 4 + h) * 32 + cc, t0 = b * S_ + cc * 64;
#pragma unroll
        for (int et = 0; et < 4; ++et)
#pragma unroll
            for (int g = 0; g < 4; ++g) { u32x2 o; o.x = cvt_pk(acc[et][4 * g], acc[et][4 * g + 1]); o.y = cvt_pk(acc[et][4 * g + 2], acc[et][4 * g + 3]);
                *(u32x2*)(stg + (et * 32 + r) * STGS + (wave * 32 + 8 * g + 4 * hh) * 2) = o; }
        if (eh == 0 && r == 0) {
#pragma unroll
            for (int g = 0; g < 4; ++g) { f32x4 o; o[0] = accn[4 * g]; o[1] = accn[4 * g + 1]; o[2] = accn[4 * g + 2]; o[3] = accn[4 * g + 3]; *(f32x4*)(nst + (size_t)bhc * 256 + wave * 32 + 8 * g + 4 * hh) = o; } }
        lds_barrier();
#pragma unroll
        for (int i = 0; i < 8; ++i) { const int c = tid + NTHR * i, row = c >> 5, c16 = c & 31;
            *(u32x4*)(Cst + ((size_t)bhc * 256 + eh * 128 + row) * 256 + c16 * 8) = *(const u32x4*)(stg + row * STGS + c16 * 16); }
        if (cc == 31) break;
#pragma unroll
        for (int i = 0; i < 4; ++i) { const int c = tid + NTHR * i, row = c >> 5, c16 = c & 31; *(u32x4*)(ksm + row * KST + c16 * 16) = pk[i]; }
#pragma unroll
        for (int i = 0; i < 2; ++i) { const int c = tid + NTHR * i, row = c >> 4, c16 = c & 15; const float wv = WSV[cc * 64 + row]; const u32x4 w = pv[i];
            u32x4 o; o.x = cvt_pk(bflo(w.x) * wv, bfhi(w.x) * wv); o.y = cvt_pk(bflo(w.y) * wv, bfhi(w.y) * wv); o.z = cvt_pk(bflo(w.z) * wv, bfhi(w.z) * wv); o.w = cvt_pk(bflo(w.w) * wv, bfhi(w.w) * wv);
            *(u32x4*)(vsm + row * VST + c16 * 16) = o; }
        if (cc + 1 < 31) { const int t1 = t0 + 64;
#pragma unroll
            for (int i = 0; i < 4; ++i) { const int c = tid + NTHR * i, row = c >> 5, c16 = c & 31; pk[i] = *(const u32x4*)(KC + (size_t)(t1 + row) * 1024 + h * 256 + c16 * 8); }
#pragma unroll
            for (int i = 0; i < 2; ++i) { const int c = tid + NTHR * i, row = c >> 4, c16 = c & 15; pv[i] = *(const u32x4*)(Mv + (size_t)(t1 + row) * 1024 + h * 256 + eh * 128 + c16 * 8); } }
        lds_barrier();
        const float decay = SCL[64 + cc];
#pragma unroll
        for (int et = 0; et < 4; ++et)
#pragma unroll
            for (int i = 0; i < 16; ++i) acc[et][i] *= decay;
#pragma unroll
        for (int i = 0; i < 16; ++i) accn[i] *= decay;
#pragma unroll
        for (int ks = 0; ks < 4; ++ks) {
            const bf16x8 bfr = tr_frag(ksm + kb_off + ks * 16 * KST, 4 * KST);
            {
                const f32x4 w0 = *(const f32x4*)(WSV + cc * 64 + ks * 16 + hh * 8), w1 = *(const f32x4*)(WSV + cc * 64 + ks * 16 + hh * 8 + 4);
                u32x4 wb; wb.x = cvt_pk(w0[0], w0[1]); wb.y = cvt_pk(w0[2], w0[3]); wb.z = cvt_pk(w1[0], w1[1]); wb.w = cvt_pk(w1[2], w1[3]);
                if (r != 0) wb = (u32x4){0u, 0u, 0u, 0u};
                accn = __builtin_amdgcn_mfma_f32_32x32x16_bf16(bfr, __builtin_bit_cast(bf16x8, wb), accn, 0, 0, 0); }
#pragma unroll
            for (int et = 0; et < 4; ++et) { const bf16x8 afr = tr_frag(vsm + vb_off + ks * 16 * VST + et * 64, 4 * VST);
                acc[et] = __builtin_amdgcn_mfma_f32_32x32x16_bf16(bfr, afr, acc[et], 0, 0, 0); }
        }
    }
}

__device__ __forceinline__ void mlstm_passB(const Params& p, unsigned char* lds, int unit) {
    const int tid = get_tid(), lane = tid & 63, wave = tid >> 6, r = lane & 31, hh = lane >> 5, li = lane & 15;
    const int b = unit >> 7, h = (unit >> 5) & 3, cc = unit & 31;
    unsigned char* ws = p.ws;
    const bf16_t* QC = (const bf16_t*)(ws + WS_QC); const bf16_t* KC = (const bf16_t*)(ws + WS_KC);
    const bf16_t* Mv = (const bf16_t*)(ws + WS_P + 5 * SEG_B); const bf16_t* Mo = (const bf16_t*)(ws + WS_P + 6 * SEG_B);
    const float* gate = (const float*)(ws + WS_GATE);
    const bf16_t* Cst = (const bf16_t*)(ws + WS_CST); const float* nst = (const float*)(ws + WS_NST); const float* mst = (const float*)(ws + WS_MST);
    bf16_t* Oc = (bf16_t*)(ws + WS_H);
    constexpr int QST = 528, VST = 544, WST = 144, HST = 1040;
    unsigned char* qsm = lds;
    unsigned char* ksm = qsm + 64 * QST;
    unsigned char* vsm = ksm + 64 * QST;
    unsigned char* wsm = vsm + 64 * VST;
    float* sc = (float*)(wsm + 64 * WST);
    float* hsm = (float*)lds;
    const int bhc = (b * 4 + h) * 32 + cc, t0 = b * S_ + cc * 64;
    __syncthreads();
    if (wave == 0) {
        const float ipre = gate[(size_t)(t0 + lane) * 16 + 8 + h] + p.m_ib[h], fpre = gate[(size_t)(t0 + lane) * 16 + 12 + h] + p.m_fb[h];
        float bc = logsig(fpre);
#pragma unroll
        for (int o = 1; o < 64; o <<= 1) { const float u = __shfl_up(bc, o); if (lane >= o) bc += u; }
        const float a = ipre - bc; float pm = a;
#pragma unroll
        for (int o = 1; o < 64; o <<= 1) { const float u = __shfl_up(pm, o); if (lane >= o) pm = fmaxf(pm, u); }
        const float mc = mst[bhc]; const float mt = bc + fmaxf(mc, pm);
        sc[lane] = bc - mt; sc[64 + lane] = a; sc[128 + lane] = mt; sc[192 + lane] = expf(bc + mc - mt);
    }
    bf16x8 cfr[16];
#pragma unroll
    for (int ks = 0; ks < 16; ++ks) cfr[ks] = *(const bf16x8*)(Cst + ((size_t)bhc * 256 + wave * 32 + r) * 256 + ks * 16 + hh * 8);
#pragma unroll
    for (int i = 0; i < 4; ++i) { const int c = tid + NTHR * i, row = c >> 5, c16 = c & 31;
        *(u32x4*)(qsm + row * QST + c16 * 16) = *(const u32x4*)(QC + (size_t)(t0 + row) * 1024 + h * 256 + c16 * 8);
        *(u32x4*)(ksm + row * QST + c16 * 16) = *(const u32x4*)(KC + (size_t)(t0 + row) * 1024 + h * 256 + c16 * 8);
        *(u32x4*)(vsm + row * VST + c16 * 16) = *(const u32x4*)(Mv + (size_t)(t0 + row) * 1024 + h * 256 + c16 * 8); }
    __syncthreads();
    if (wave < 3) {
        const int sb = wave >> 1, lb = wave ? 1 : 0;
        f32x16 s;
#pragma unroll
        for (int i = 0; i < 16; ++i) s[i] = 0.f;
#pragma unroll
        for (int ks = 0; ks < 16; ++ks) { const bf16x8 a = *(const bf16x8*)(ksm + (sb * 32 + r) * QST + ks * 32 + hh * 16), q = *(const bf16x8*)(qsm + (lb * 32 + r) * QST + ks * 32 + hh * 16);
            s = __builtin_amdgcn_mfma_f32_32x32x16_bf16(a, q, s, 0, 0, 0); }
        const int l = lb * 32 + r; const float bl = sc[l]; float rs = 0.f;
#pragma unroll
        for (int g = 0; g < 4; ++g) { float w[4];
#pragma unroll
            for (int e = 0; e < 4; ++e) { const int sI = sb * 32 + 8 * g + 4 * hh + e; w[e] = (sI <= l) ? s[4 * g + e] * __expf(bl + sc[64 + sI]) : 0.f; rs += w[e]; }
            u32x2 o; o.x = cvt_pk(w[0], w[1]); o.y = cvt_pk(w[2], w[3]);
            *(u32x2*)(wsm + l * WST + (sb * 32 + 8 * g + 4 * hh) * 2) = o; }
        sc[256 + l * 4 + sb * 2 + hh] = rs;
    } else if (wave == 3) {
        const int l = r;
#pragma unroll
        for (int g = 0; g < 4; ++g) { u32x2 o; o.x = 0u; o.y = 0u; *(u32x2*)(wsm + l * WST + (32 + 8 * g + 4 * hh) * 2) = o; }
        sc[256 + l * 4 + 2 + hh] = 0.f;
    }
    {
        const int l = tid & 63, part = tid >> 6; const float* np = nst + (size_t)bhc * 256 + part * 32; float s = 0.f;
#pragma unroll
        for (int q = 0; q < 4; ++q) { const u32x4 w = *(const u32x4*)(qsm + l * QST + part * 64 + q * 16);
            s += bflo(w.x) * np[8 * q] + bfhi(w.x) * np[8 * q + 1] + bflo(w.y) * np[8 * q + 2] + bfhi(w.y) * np[8 * q + 3] + bflo(w.z) * np[8 * q + 4] + bfhi(w.z) * np[8 * q + 5] + bflo(w.w) * np[8 * q + 6] + bfhi(w.w) * np[8 * q + 7]; }
        sc[512 + l * 8 + part] = s;
    }
    f32x16 acc[2];
#pragma unroll
    for (int lb = 0; lb < 2; ++lb)
#pragma unroll
        for (int i = 0; i < 16; ++i) acc[lb][i] = 0.f;
#pragma unroll
    for (int ks = 0; ks < 16; ++ks)
#pragma unroll
        for (int lb = 0; lb < 2; ++lb) { const bf16x8 q = *(const bf16x8*)(qsm + (lb * 32 + r) * QST + ks * 32 + hh * 16);
            acc[lb] = __builtin_amdgcn_mfma_f32_32x32x16_bf16(cfr[ks], q, acc[lb], 0, 0, 0); }
    __syncthreads();
#pragma unroll
    for (int lb = 0; lb < 2; ++lb) { const float it = sc[192 + lb * 32 + r];
#pragma unroll
        for (int i = 0; i < 16; ++i) acc[lb][i] *= it; }
    const int vb_off = (8 * hh + (li >> 2)) * VST + (wave * 32 + 16 * (r >> 4) + 4 * (li & 3)) * 2;
#pragma unroll
    for (int ks = 0; ks < 4; ++ks) { const bf16x8 afr = tr_frag(vsm + vb_off + ks * 16 * VST, 4 * VST);
#pragma unroll
        for (int lb = 0; lb < 2; ++lb) { if (lb == 0 && ks >= 2) continue;
            const bf16x8 wf = *(const bf16x8*)(wsm + (lb * 32 + r) * WST + ks * 32 + hh * 16);
            acc[lb] = __builtin_amdgcn_mfma_f32_32x32x16_bf16(afr, wf, acc[lb], 0, 0, 0); } }
    float ssq[2];
#pragma unroll
    for (int lb = 0; lb < 2; ++lb) { const int l = lb * 32 + r;
        const f32x4 rsv = *(const f32x4*)(sc + 256 + l * 4); const f32x4 q0 = *(const f32x4*)(sc + 512 + l * 8), q1 = *(const f32x4*)(sc + 512 + l * 8 + 4);
        const float den = (rsv[0] + rsv[1] + rsv[2] + rsv[3]) + sc[192 + l] * ((q0[0] + q0[1] + q0[2] + q0[3]) + (q1[0] + q1[1] + q1[2] + q1[3]));
        const float inv = 1.f / fmaxf(fabsf(den), __expf(-sc[128 + l]));
        float s2 = 0.f;
#pragma unroll
        for (int i = 0; i < 16; ++i) { acc[lb][i] *= inv; s2 += acc[lb][i] * acc[lb][i]; }
        s2 += __shfl_xor(s2, 32); ssq[lb] = s2; }
    __syncthreads();
    if (hh == 0) { sc[1024 + r * 8 + wave] = ssq[0]; sc[1024 + (32 + r) * 8 + wave] = ssq[1]; }
#pragma unroll
    for (int lb = 0; lb < 2; ++lb)
#pragma unroll
        for (int g = 0; g < 4; ++g) { f32x4 v; v[0] = acc[lb][4 * g]; v[1] = acc[lb][4 * g + 1]; v[2] = acc[lb][4 * g + 2]; v[3] = acc[lb][4 * g + 3];
            *(f32x4*)((unsigned char*)hsm + (lb * 32 + r) * HST + (wave * 32 + 8 * g + 4 * hh) * 4) = v; }
    __syncthreads();
#pragma unroll
    for (int i = 0; i < 4; ++i) { const int c = tid + NTHR * i, l = c >> 5, e0 = (c & 31) * 8;
        const f32x4 s0 = *(const f32x4*)(sc + 1024 + l * 8), s1 = *(const f32x4*)(sc + 1024 + l * 8 + 4);
        const float rr = rsqrtf(((s0[0] + s0[1] + s0[2] + s0[3]) + (s1[0] + s1[1] + s1[2] + s1[3])) * (1.f / 256.f) + EPS_);
        const f32x4 h0 = *(const f32x4*)((unsigned char*)hsm + l * HST + e0 * 4), h1 = *(const f32x4*)((unsigned char*)hsm + l * HST + e0 * 4 + 16);
        const f32x4 g0 = *(const f32x4*)(p.m_hg + h * 256 + e0), g1 = *(const f32x4*)(p.m_hg + h * 256 + e0 + 4);
        const u32x4 mo = *(const u32x4*)(Mo + (size_t)(t0 + l) * 1024 + h * 256 + e0);
        u32x4 o;
        o.x = cvt_pk(h0[0] * rr * g0[0] * sigm(bflo(mo.x)), h0[1] * rr * g0[1] * sigm(bfhi(mo.x))); o.y = cvt_pk(h0[2] * rr * g0[2] * sigm(bflo(mo.y)), h0[3] * rr * g0[3] * sigm(bfhi(mo.y)));
        o.z = cvt_pk(h1[0] * rr * g1[0] * sigm(bflo(mo.z)), h1[1] * rr * g1[1] * sigm(bfhi(mo.z))); o.w = cvt_pk(h1[2] * rr * g1[2] * sigm(bflo(mo.w)), h1[3] * rr * g1[3] * sigm(bfhi(mo.w)));
        *(u32x4*)(Oc + (size_t)(t0 + l) * D_ + 1024 + h * 256 + e0) = o; }
}

__device__ __forceinline__ void ce_desc(float& a, float& b) { const float hi = fmaxf(a, b), lo = fminf(a, b); a = hi; b = lo; }
__device__ __forceinline__ void sort16_desc(float (&v)[16]) {
#pragma unroll
    for (int k = 2; k <= 16; k <<= 1)
#pragma unroll
        for (int j = k >> 1; j > 0; j >>= 1)
#pragma unroll
            for (int i = 0; i < 16; ++i) { const int l = i ^ j; if (l > i) { if ((i & k) == 0) ce_desc(v[i], v[l]); else ce_desc(v[l], v[i]); } }
}
__device__ __forceinline__ void bmerge16_desc(float (&v)[16]) {
#pragma unroll
    for (int j = 8; j > 0; j >>= 1)
#pragma unroll
        for (int i = 0; i < 16; ++i) { const int l = i ^ j; if (l > i) ce_desc(v[i], v[l]); }
}
__device__ __forceinline__ void merge_top16(float (&a)[16], const float (&b)[16]) {
#pragma unroll
    for (int i = 0; i < 16; ++i) a[i] = fmaxf(a[i], b[15 - i]);
    bmerge16_desc(a);
}
__device__ __forceinline__ float pack_idx(float v, unsigned mask, unsigned idx) { return __builtin_bit_cast(float, (__builtin_bit_cast(unsigned, v) & mask) | idx); }
__device__ __forceinline__ void top16_from_acc(const f32x16 (&acc)[4], int h, float (&out)[16]) {
    float g[4][16];
#pragma unroll
    for (int mt = 0; mt < 4; ++mt) {
#pragma unroll
        for (int i = 0; i < 16; ++i) g[mt][i] = pack_idx(acc[mt][i], 0xffffff80u, (unsigned)(32 * mt + (i & 3) + 8 * (i >> 2)) | ((unsigned)h << 2));
        sort16_desc(g[mt]);
    }
    merge_top16(g[0], g[1]); merge_top16(g[2], g[3]); merge_top16(g[0], g[2]);
    float o[16];
#pragma unroll
    for (int i = 0; i < 16; ++i) o[i] = __shfl_xor(g[0][i], 32);
    merge_top16(g[0], o);
#pragma unroll
    for (int i = 0; i < 16; ++i) out[i] = g[0][i];
}
__device__ __forceinline__ unsigned lut16(const unsigned (&P)[4], unsigned i) {
    const unsigned long long lo = (unsigned long long)P[0] | ((unsigned long long)P[1] << 32), hi = (unsigned long long)P[2] | ((unsigned long long)P[3] << 32);
    const unsigned long long s = (i & 8u) ? hi : lo;
    return (unsigned)(s >> ((i & 7u) * 8u)) & 0xffu;
}
struct CandTab { int i[50]; int j[50]; };
constexpr CandTab make_cand_tab() { CandTab t{}; int n = 0; for (int i = 0; i < 16; ++i) for (int j = 0; j < 16; ++j) if ((i + 1) * (j + 1) <= 16) { t.i[n] = i; t.j[n] = j; ++n; } return t; }
__device__ __forceinline__ void phase_topk(const Params& p, unsigned char* lds, int bid, int nb) {
    const int tid = get_tid(), lane = tid & 63, wave = tid >> 6, r = lane & 31, h = lane >> 5;
    unsigned char* ws = p.ws;
    const bf16_t* Q = (const bf16_t*)(ws + WS_Q); int* IDX = (int*)(ws + WS_IDX); float* GW = (float*)(ws + WS_GW);
    constexpr int KP = 136;
    bf16_t* KS = (bf16_t*)lds;
    for (int i = tid; i < 2 * 16384; i += NTHR) { const int which = i >> 14, n = (i >> 7) & 127, d = i & 127; const float v = (which ? p.sk2 : p.sk1)[i & 16383];
        const unsigned hb = cvt_pk(v, 0.f) & 0xffffu; const float lo = v - bf2f((bf16_t)hb);
        KS[((which * 2 + 0) * 128 + n) * KP + d] = (bf16_t)hb; KS[((which * 2 + 1) * 128 + n) * KP + d] = (bf16_t)(cvt_pk(lo, 0.f) & 0xffffu); }
    __syncthreads();
    for (int item = bid * 8 + wave; item < 512 * 8; item += nb * 8) {
        const int tt = item >> 3, hh = item & 7, t = tt * 32 + r;
        float top[2][16];
#pragma unroll
        for (int list = 0; list < 2; ++list) {
            bf16x8 qf[8];
#pragma unroll
            for (int ks = 0; ks < 8; ++ks) qf[ks] = *(const bf16x8*)(Q + (size_t)t * D_ + hh * 256 + list * 128 + ks * 16 + h * 8);
            float g[4][16];
#pragma unroll
            for (int mt = 0; mt < 4; ++mt) {
                f32x16 acc;
#pragma unroll
                for (int i = 0; i < 16; ++i) acc[i] = 0.f;
#pragma unroll
                for (int hl = 0; hl < 2; ++hl)
#pragma unroll
                    for (int ks = 0; ks < 8; ++ks) { const bf16x8 a = *(const bf16x8*)(KS + ((list * 2 + hl) * 128 + mt * 32 + r) * KP + ks * 16 + h * 8);
                        acc = __builtin_amdgcn_mfma_f32_32x32x16_bf16(a, qf[ks], acc, 0, 0, 0); }
#pragma unroll
                for (int i = 0; i < 16; ++i) g[mt][i] = pack_idx(acc[i], 0xffffff80u, (unsigned)(32 * mt + (i & 3) + 8 * (i >> 2)) | ((unsigned)h << 2));
                sort16_desc(g[mt]);
                __builtin_amdgcn_sched_barrier(0);
            }
            merge_top16(g[0], g[1]); merge_top16(g[2], g[3]); merge_top16(g[0], g[2]);
            {   float o[16];
#pragma unroll
                for (int i = 0; i < 16; ++i) o[i] = __shfl_xor(g[0][i], 32);
                merge_top16(g[0], o); }
#pragma unroll
            for (int i = 0; i < 16; ++i) top[list][i] = g[0][i];
            __builtin_amdgcn_sched_barrier(0);
        }
        unsigned P1[4], P2[4];
#pragma unroll
        for (int q = 0; q < 4; ++q) { P1[q] = 0u; P2[q] = 0u;
#pragma unroll
            for (int e = 0; e < 4; ++e) { P1[q] |= (__builtin_bit_cast(unsigned, top[0][4 * q + e]) & 127u) << (8 * e); P2[q] |= (__builtin_bit_cast(unsigned, top[1][4 * q + e]) & 127u) << (8 * e); } }
        float c[4][16];
#pragma unroll
        for (int n = 0; n < 64; ++n) {
            if (n < 50) { constexpr CandTab CT = make_cand_tab(); const int i = CT.i[n], j = CT.j[n];
                c[n >> 4][n & 15] = pack_idx(top[0][i] + top[1][j], 0xffffff00u, (unsigned)(i * 16 + j)); }
            else c[n >> 4][n & 15] = -INFINITY;
        }
        sort16_desc(c[0]); __builtin_amdgcn_sched_barrier(0); sort16_desc(c[1]); __builtin_amdgcn_sched_barrier(0); merge_top16(c[0], c[1]); __builtin_amdgcn_sched_barrier(0);
        sort16_desc(c[2]); __builtin_amdgcn_sched_barrier(0); sort16_desc(c[3]); __builtin_amdgcn_sched_barrier(0); merge_top16(c[2], c[3]); __builtin_amdgcn_sched_barrier(0); merge_top16(c[0], c[2]);
        float ex[16], sum = 0.f;
#pragma unroll
        for (int k = 0; k < 16; ++k) { ex[k] = __expf(c[0][k] - c[0][0]); sum += ex[k]; }
        const float inv = 1.f / sum;
        if (h == 0) {
            int* ip = IDX + (size_t)t * 128 + hh * 16; float* gp = GW + (size_t)t * 128 + hh * 16;
#pragma unroll
            for (int q = 0; q < 4; ++q) { u32x4 iv; f32x4 gv;
#pragma unroll
                for (int e = 0; e < 4; ++e) { const unsigned pos = __builtin_bit_cast(unsigned, c[0][4 * q + e]) & 255u;
                    iv[e] = lut16(P1, pos >> 4) * 128u + lut16(P2, pos & 15u); gv[e] = ex[4 * q + e] * inv; }
                *(u32x4*)(ip + 4 * q) = iv; *(f32x4*)(gp + 4 * q) = gv; }
        }
    }
}

typedef float f32x2 __attribute__((ext_vector_type(2)));
__device__ __forceinline__ float dot16_fp8(const u32x4 w, const float (&h)[32], int o) {
    float s = 0.f;
#pragma unroll
    for (int q = 0; q < 4; ++q) { const f32x2 lo = __builtin_amdgcn_cvt_pk_f32_fp8((int)w[q], false), hi = __builtin_amdgcn_cvt_pk_f32_fp8((int)w[q], true);
        fmac(s, lo[0], h[o + 4 * q]); fmac(s, lo[1], h[o + 4 * q + 1]); fmac(s, hi[0], h[o + 4 * q + 2]); fmac(s, hi[1], h[o + 4 * q + 3]); }
    return s;
}
template <int CTRL, int ROW_MASK, int BANK_MASK>
__device__ __forceinline__ int dpp_mov0i(int v) { return __builtin_amdgcn_update_dpp(0, v, CTRL, ROW_MASK, BANK_MASK, true); }
__device__ __forceinline__ void phase_peer1(const Params& p, unsigned char* lds, int bid, int nb, int probe) {
    const int tid = get_tid(), lane = tid & 63, wave = tid >> 6, r = lane >> 4, c16 = lane & 15;
    unsigned char* ws = p.ws;
    const bf16_t* H2 = (const bf16_t*)(ws + WS_H2); const int* IDX = (const int*)(ws + WS_IDX); const float* GW = (const float*)(ws + WS_GW);
    unsigned* EWT = (unsigned*)(ws + WS_EWT); const float* DSC = (const float*)(ws + WS_DSC);
    const unsigned char* E8D = ws + WS_E8D + 16 * c16; const unsigned emask = probe ? 0x3ffu : 0x3fffu;
    LAS unsigned* seq = (LAS unsigned*)((LAS unsigned char*)lds + wave * 2048 + r * 512);
    LAS unsigned* hist = (LAS unsigned*)((LAS unsigned char*)lds + 16384 + wave * 512 + r * 128);
    for (int tile = bid; tile < 256; tile += nb)
        for (int ps = 0; ps < 2; ++ps) {
            const int t = tile * 64 + ps * 32 + wave * 4 + r;
            unsigned hq[32]; float hsc;
            {   float mx = 0.f; u32x4 raw[16];
#pragma unroll
                for (int q = 0; q < 8; ++q) { raw[2 * q] = *(const u32x4*)(H2 + (size_t)t * D_ + 256 * q + 16 * c16); raw[2 * q + 1] = *(const u32x4*)(H2 + (size_t)t * D_ + 256 * q + 16 * c16 + 8); }
#pragma unroll
                for (int i = 0; i < 16; ++i)
#pragma unroll
                    for (int e = 0; e < 4; ++e) mx = fmaxf(mx, fmaxf(fabsf(bflo(raw[i][e])), fabsf(bfhi(raw[i][e]))));
                mx = fmaxf(mx, __shfl_xor(mx, 1)); mx = fmaxf(mx, __shfl_xor(mx, 2)); mx = fmaxf(mx, __shfl_xor(mx, 4)); mx = fmaxf(mx, __shfl_xor(mx, 8));
                mx = fmaxf(mx, 1e-30f); const float inv = 127.f / mx; hsc = mx * (1.f / 127.f);
#pragma unroll
                for (int i = 0; i < 16; ++i)
#pragma unroll
                    for (int hh = 0; hh < 2; ++hh) {
                        const unsigned w0 = raw[i][2 * hh], w1 = raw[i][2 * hh + 1];
                        hq[2 * i + hh] = ((unsigned)__float2int_rn(bflo(w0) * inv) & 0xffu) | (((unsigned)__float2int_rn(bfhi(w0) * inv) & 0xffu) << 8) | (((unsigned)__float2int_rn(bflo(w1) * inv) & 0xffu) << 16) | (((unsigned)__float2int_rn(bfhi(w1) * inv) & 0xffu) << 24); }
            }
            int idx[8]; unsigned pos[8];
#pragma unroll
            for (int m = 0; m < 8; ++m) idx[m] = IDX[(size_t)t * 128 + c16 + 16 * m];
            hist[c16] = 0u; hist[16 + c16] = 0u;
#pragma unroll
            for (int m = 0; m < 8; ++m) pos[m] = __hip_atomic_fetch_add(&hist[idx[m] >> 9], 1u, __ATOMIC_RELAXED, __HIP_MEMORY_SCOPE_WORKGROUP);
            {   const unsigned c0 = hist[2 * c16], c1 = hist[2 * c16 + 1]; unsigned inc = c0 + c1;
#pragma unroll
                for (int o = 1; o < 16; o <<= 1) { const unsigned u = __shfl_up(inc, o, 16); if (c16 >= o) inc += u; }
                const unsigned base = inc - (c0 + c1);
                hist[2 * c16] = base; hist[2 * c16 + 1] = base + c0; }
#pragma unroll
            for (int m = 0; m < 8; ++m) { pos[m] += hist[idx[m] >> 9]; seq[pos[m]] = (unsigned)idx[m] | ((unsigned)(c16 + 16 * m) << 14); }
            u32x4 cur[8], nxt[8];
            {   const unsigned char* rp = E8D + (size_t)(seq[0] & emask) * 2048;
#pragma unroll
                for (int q = 0; q < 8; ++q) cur[q] = *(const u32x4*)(rp + 256 * q); }
            for (int s = 0; s < 128; ++s) {
                if (s + 1 < 128) { const unsigned char* rp = E8D + (size_t)(seq[s + 1] & emask) * 2048;
#pragma unroll
                    for (int q = 0; q < 8; ++q) nxt[q] = *(const u32x4*)(rp + 256 * q); }
                int d0 = 0, d1 = 0;
#pragma unroll
                for (int q = 0; q < 8; ++q) { d0 = __builtin_amdgcn_sdot4((int)cur[q][0], (int)hq[4 * q], d0, false); d1 = __builtin_amdgcn_sdot4((int)cur[q][1], (int)hq[4 * q + 1], d1, false);
                    d0 = __builtin_amdgcn_sdot4((int)cur[q][2], (int)hq[4 * q + 2], d0, false); d1 = __builtin_amdgcn_sdot4((int)cur[q][3], (int)hq[4 * q + 3], d1, false); }
                int d = d0 + d1;
                d += dpp_mov0i<0x111, 0xf, 0xf>(d); d += dpp_mov0i<0x112, 0xf, 0xf>(d); d += dpp_mov0i<0x114, 0xf, 0xe>(d); d += dpp_mov0i<0x118, 0xf, 0xc>(d);
                if (c16 == 15) seq[s] = (unsigned)d;
#pragma unroll
                for (int q = 0; q < 8; ++q) cur[q] = nxt[q];
            }
            if (probe) continue;
            unsigned* ep = EWT + (size_t)(t >> 6) * 8192 + (t & 63) * 4;
#pragma unroll
            for (int m = 0; m < 8; ++m) { const int j = c16 + 16 * m;
                const float a = (float)(int)seq[pos[m]] * hsc * DSC[idx[m]];
                const float w = GW[(size_t)t * 128 + j] * 0.5f * a * (1.f + erff(a * 0.7071067811865476f));
                ep[(j >> 2) * 256 + (j & 3)] = (cvt_pk(0.f, w) & 0xffff0000u) | (unsigned)idx[m]; }
        }
}
__device__ __forceinline__ void phase_peer2(const Params& p, unsigned char* lds, int bid, int nb) {
    const int tid = get_tid(), lane = tid & 63, wave = tid >> 6;
    unsigned char* ws = p.ws;
    const unsigned* EWT = (const unsigned*)(ws + WS_EWT); const bf16_t* Y = (const bf16_t*)(ws + WS_X1); const float* mod = (const float*)(ws + WS_MOD);
    for (int si = bid; si < 256; si += nb) {
        const int s = (si & 7) * 32 + (si >> 3);
        __syncthreads();
        {   const u32x4* sp = (const u32x4*)(ws + WS_E8U + (size_t)s * 131072);
#pragma unroll
            for (int i = 0; i < 16; ++i) ((u32x4*)lds)[tid + NTHR * i] = sp[tid + NTHR * i]; }
        __syncthreads();
        const int tb0 = ((si >> 5) * 32 + wave) & 255;
        unsigned cur[16], nxt[16];
        {   const u32x4* wp = (const u32x4*)(EWT + (size_t)tb0 * 8192) + lane;
#pragma unroll
            for (int u = 0; u < 4; ++u) { const u32x4 v = wp[u * 64]; cur[4 * u] = v.x; cur[4 * u + 1] = v.y; cur[4 * u + 2] = v.z; cur[4 * u + 3] = v.w; } }
        float acc[8];
#pragma unroll
        for (int c = 0; c < 8; ++c) acc[c] = 0.f;
        f32x4 xa = {0.f, 0.f, 0.f, 0.f}, xb = xa;
        for (int q = 0; q < 256; ++q) {
            const int tb = (tb0 + 8 * (q >> 3)) & 255, g = q & 7;
            if (q + 1 < 256) { const int tbn = (tb0 + 8 * ((q + 1) >> 3)) & 255; const u32x4* wp = (const u32x4*)(EWT + (size_t)tbn * 8192 + ((q + 1) & 7) * 1024) + lane;
#pragma unroll
                for (int u = 0; u < 4; ++u) { const u32x4 v = wp[u * 64]; nxt[4 * u] = v.x; nxt[4 * u + 1] = v.y; nxt[4 * u + 2] = v.z; nxt[4 * u + 3] = v.w; } }
            const int t = tb * 64 + lane;
            if (g == 0) { xa = *(const f32x4*)(p.x + (size_t)t * D_ + 8 * s); xb = *(const f32x4*)(p.x + (size_t)t * D_ + 8 * s + 4);
                const u32x4 yw = *(const u32x4*)(Y + (size_t)t * D_ + 8 * s); const float* g1 = mod + (size_t)(t >> 11) * NMOD + 2 * D_ + 8 * s; const f32x4 ha = *(const f32x4*)g1, hb = *(const f32x4*)(g1 + 4);
                xa[0] += ha[0] * bflo(yw.x); xa[1] += ha[1] * bfhi(yw.x); xa[2] += ha[2] * bflo(yw.y); xa[3] += ha[3] * bfhi(yw.y); xb[0] += hb[0] * bflo(yw.z); xb[1] += hb[1] * bfhi(yw.z); xb[2] += hb[2] * bflo(yw.w); xb[3] += hb[3] * bfhi(yw.w); }
            u32x2 row[16];
#pragma unroll
            for (int u = 0; u < 16; ++u) row[u] = *(const LAS u32x2*)(unsigned)((cur[u] << 3) & 0x1fff8u);
#pragma unroll
            for (int u = 0; u < 16; ++u) {
                const float w = __builtin_bit_cast(float, cur[u]);
                const f32x2 v0 = __builtin_amdgcn_cvt_pk_f32_fp8((int)row[u].x, false), v1 = __builtin_amdgcn_cvt_pk_f32_fp8((int)row[u].x, true), v2 = __builtin_amdgcn_cvt_pk_f32_fp8((int)row[u].y, false), v3 = __builtin_amdgcn_cvt_pk_f32_fp8((int)row[u].y, true);
                fmac(acc[0], w, v0[0]); fmac(acc[1], w, v0[1]); fmac(acc[2], w, v1[0]); fmac(acc[3], w, v1[1]); fmac(acc[4], w, v2[0]); fmac(acc[5], w, v2[1]); fmac(acc[6], w, v3[0]); fmac(acc[7], w, v3[1]);
            }
            if (g == 7) {
                const float* g2 = mod + (size_t)(t >> 11) * NMOD + 5 * D_ + 8 * s;
                const f32x4 ga = *(const f32x4*)g2, gb = *(const f32x4*)(g2 + 4);
                f32x4 oa, ob;
#pragma unroll
                for (int c = 0; c < 4; ++c) { oa[c] = xa[c] + ga[c] * acc[c] * (1.f / 32.f); ob[c] = xb[c] + gb[c] * acc[4 + c] * (1.f / 32.f); }
                *(f32x4*)(p.out + (size_t)t * D_ + 8 * s) = oa; *(f32x4*)(p.out + (size_t)t * D_ + 8 * s + 4) = ob;
#pragma unroll
                for (int c = 0; c < 8; ++c) acc[c] = 0.f;
            }
#pragma unroll
            for (int u = 0; u < 16; ++u) cur[u] = nxt[u];
        }
    }
}

typedef const __attribute__((address_space(4))) Params* KargPtr;
__device__ __forceinline__ Params load_params() {
#if defined(__HIP_DEVICE_COMPILE__)
    KargPtr kp = (KargPtr)__builtin_amdgcn_kernarg_segment_ptr(); asm volatile("" : "+s"(kp)); Params r; __builtin_memcpy(&r, kp, sizeof(Params)); return r;
#else
    return Params{};
#endif
}
constexpr int N_PHASES = 12;
constexpr int LDS_BYTES = 152 * 1024;
__global__ void __launch_bounds__(NTHR) fwd_kernel(Params p_arg) {
    extern __shared__ __attribute__((aligned(16))) unsigned char lds[];
    const int bid = blockIdx.x, nb = gridDim.x, tid = get_tid();
    unsigned char* ws = p_arg.ws;
    volatile LAS unsigned* xbst = (volatile LAS unsigned*)((LAS unsigned char*)lds + LDS_BYTES - 16);
    if (tid == 0) { xbst[0] = 0u; xbst[1] = 0u; xbst[2] = 0u; xbst[3] = 0u; }
    __syncthreads();
    if ((p_arg.ph_hi - p_arg.ph_lo) > 1) (void)xcd_barrier_post((unsigned*)(ws + WS_BAR), xbst);
#ifdef ONLY_PHASE
#define IN(k) ((k) == ONLY_PHASE && p.ph_lo <= (k) && (k) < p.ph_hi)
#else
#define IN(k) (p.ph_lo <= (k) && (k) < p.ph_hi)
#endif
#define SEAM(k) do { const Params p = load_params(); if (p.ph_lo <= (k) && (k) + 1 < p.ph_hi) { XcdBarrier bar; bar.bar = (unsigned*)(p.ws + WS_BAR); bar.x = xb_xcc_id(); bar.st = xbst; xcd_barrier(bar); } } while (0)
#ifndef REPEAT_MASK
#define REPEAT_MASK 0
#endif
#define REP(k) for (int rep_ = 0; rep_ < (((REPEAT_MASK) >> (k)) & 1) + 1; ++rep_)
    REP(0) { const Params p = load_params(); if (IN(0)) { unsigned char* ws = p.ws; const float* mod = (const float*)(ws + WS_MOD); (void)mod;
        phase_prep(p, lds, bid, nb);
    } }
    SEAM(0);
    REP(1) { const Params p = load_params(); if (IN(1)) { unsigned char* ws = p.ws; const float* mod = (const float*)(ws + WS_MOD); (void)mod;
        phase_norm<false>(p.x, nullptr, 0, p.g1, mod, 0, D_, (bf16_t*)(ws + WS_H), bid, nb);
    } }
    SEAM(1);
    REP(2) { const Params p = load_params(); if (IN(2)) { unsigned char* ws = p.ws; const float* mod = (const float*)(ws + WS_MOD); (void)mod;
        phase_gates(p, lds, bid, nb);
        { pg8::Gemm g{(const bf16_t*)(ws + WS_H), (const bf16_t*)(ws + WS_WINT), T_, 7168, D_}; pg8::StaticOrder S; S.init(T_, 7168, nb, bid);
        pg8::EpiSeg E{(bf16_t*)(ws + WS_P)}; pg8::gemm_phase<pg8::EpiSeg, pg8::StaticOrder, true, true>((LAS unsigned char*)lds, g, S, E); }
    } }
    SEAM(2);
    REP(3) { const Params p = load_params(); if (IN(3)) { unsigned char* ws = p.ws; const float* mod = (const float*)(ws + WS_MOD); (void)mod;
        phase_post(p, bid, nb);
    } }
    SEAM(3);
    REP(4) { const Params p = load_params(); if (IN(4)) { unsigned char* ws = p.ws; const float* mod = (const float*)(ws + WS_MOD); (void)mod;
        { for (int u = bid; u < 64; u += nb) mlstm_passA(p, lds, u);
        unsigned* qctr = (unsigned*)(ws + WS_QCTR) + rep_; LAS int* slot = (LAS int*)((LAS unsigned char*)lds + LDS_BYTES - 32);
        for (;;) { __syncthreads(); if (tid == 0) *slot = (int)atomicAdd(qctr, 1u); __syncthreads(); const int u = *slot; if (u >= 512) break;
            const int bh = u & 63; fox_unit(p, lds, bh >> 3, bh & 7, 7 - (u >> 6)); } }
    } }
    SEAM(4);
    REP(5) { const Params p = load_params(); if (IN(5)) { unsigned char* ws = p.ws; const float* mod = (const float*)(ws + WS_MOD); (void)mod;
        { for (int u = bid; u < 1024; u += nb) mlstm_passB(p, lds, u); }
    } }
    SEAM(5);
    REP(6) { const Params p = load_params(); if (IN(6)) { unsigned char* ws = p.ws; const float* mod = (const float*)(ws + WS_MOD); (void)mod;
        { pg8::Gemm g{(const bf16_t*)(ws + WS_H), (const bf16_t*)(ws + WS_WOT), T_, D_, D_}; pg8::StaticOrder S; S.init(T_, D_, nb, bid);
        pg8::EpiBf E{(bf16_t*)(ws + WS_X1), D_}; pg8::gemm_phase<pg8::EpiBf, pg8::StaticOrder, true, true>((LAS unsigned char*)lds, g, S, E); }
    } }
    SEAM(6);
    REP(7) { const Params p = load_params(); if (IN(7)) { unsigned char* ws = p.ws; const float* mod = (const float*)(ws + WS_MOD); (void)mod;
        convert_experts(p, bid, nb);
    } }
    REP(7) { const Params p = load_params(); if (IN(7)) { unsigned char* ws = p.ws; const float* mod = (const float*)(ws + WS_MOD); (void)mod;
        phase_norm<true>(p.x, (const bf16_t*)(ws + WS_X1), 2 * D_, p.g2, mod, 3 * D_, 4 * D_, (bf16_t*)(ws + WS_H2), bid, nb);
    } }
    SEAM(7);
    REP(8) { const Params p = load_params(); if (IN(8)) { unsigned char* ws = p.ws; const float* mod = (const float*)(ws + WS_MOD); (void)mod;
        { pg8::Gemm g{(const bf16_t*)(ws + WS_H2), (const bf16_t*)(ws + WS_WQT), T_, D_, D_}; pg8::StaticOrder S; S.init(T_, D_, nb, bid);
        pg8::EpiBf E{(bf16_t*)(ws + WS_Q), D_}; pg8::gemm_phase<pg8::EpiBf, pg8::StaticOrder, true, true>((LAS unsigned char*)lds, g, S, E); }
    } }
    SEAM(8);
    REP(9) { const Params p = load_params(); if (IN(9)) { unsigned char* ws = p.ws; const float* mod = (const float*)(ws + WS_MOD); (void)mod;
        phase_topk(p, lds, bid, nb);
    } }
    SEAM(9);
    REP(10) { const Params p = load_params(); if (IN(10)) { unsigned char* ws = p.ws; const float* mod = (const float*)(ws + WS_MOD); (void)mod;
#ifdef PROBE_L2
        phase_peer1(p, lds, bid, nb, rep_);
#else
        phase_peer1(p, lds, bid, nb, 0);
#endif
    } }
    SEAM(10);
    REP(11) { const Params p = load_params(); if (IN(11)) { unsigned char* ws = p.ws; const float* mod = (const float*)(ws + WS_MOD); (void)mod;
        phase_peer2(p, lds, bid, nb);
    } }
#undef IN
#undef SEAM
}

#ifndef ONE_LAUNCH
#define ONE_LAUNCH 1
#endif
extern "C" void kernel_launch(void* const* d_in, const int* in_sizes, int n_in, void* d_out, int out_size, void* d_ws, size_t ws_size, hipStream_t stream) {
    static int grid = 0;
    if (grid == 0) {
        int dev = 0, cus = 0, per_cu = 0;
        if (n_in != 21 || ws_size < WS_END) { fprintf(stderr, "kernel_launch: unexpected n_in %d / ws_size %zu (need %zu)\n", n_in, ws_size, (size_t)WS_END); grid = -1; return; }
        hipGetDevice(&dev); hipDeviceGetAttribute(&cus, hipDeviceAttributeMultiprocessorCount, dev);
        if (hipFuncSetAttribute((const void*)fwd_kernel, hipFuncAttributeMaxDynamicSharedMemorySize, LDS_BYTES) != hipSuccess) { fprintf(stderr, "kernel_launch: hipFuncSetAttribute failed\n"); grid = -1; return; }
        if (hipOccupancyMaxActiveBlocksPerMultiprocessor(&per_cu, (const void*)fwd_kernel, NTHR, LDS_BYTES) != hipSuccess || per_cu < 1) { fprintf(stderr, "kernel_launch: occupancy query says %d\n", per_cu); (void)hipGetLastError(); }
        grid = cus > 0 ? cus : 256;
    }
    if (grid < 0) return;
    Params p{};
    const float** pp = (const float**)&p;
    for (int i = 0; i < 21; ++i) pp[i] = (const float*)d_in[i];
    p.out = (float*)d_out; p.ws = (unsigned char*)d_ws;
    hipMemsetAsync((char*)d_ws + WS_BAR, 0, 16384, stream);
#if ONE_LAUNCH
    p.ph_lo = 0; p.ph_hi = N_PHASES;
    void* args[] = {&p};
    hipError_t e = hipLaunchCooperativeKernel((const void*)fwd_kernel, dim3(grid), dim3(NTHR), args, LDS_BYTES, stream);
    if (e != hipSuccess) fprintf(stderr, "cooperative launch failed: %s (grid %d)\n", hipGetErrorString(e), grid);
#else
    for (int ph = 0; ph < N_PHASES; ++ph) { p.ph_lo = ph; p.ph_hi = ph + 1; hipLaunchKernelGGL(fwd_kernel, dim3(grid), dim3(NTHR), LDS_BYTES, stream, p); }
#endif
}
```

```cpp
#include <hip/hip_runtime.h>
#include <cstdio>
#include <cstdint>

#define GAS __attribute__((address_space(1)))
#define LAS __attribute__((address_space(3)))
typedef unsigned short bf16_t;
typedef short bf16x8 __attribute__((ext_vector_type(8)));
typedef float f32x4 __attribute__((ext_vector_type(4)));
typedef float f32x16 __attribute__((ext_vector_type(16)));
typedef unsigned u32x4 __attribute__((ext_vector_type(4)));
typedef unsigned u32x2 __attribute__((ext_vector_type(2)));

constexpr int T_ = 16384, D_ = 2048, B_ = 8, S_ = 2048, NTHR = 512;
constexpr float EPS_ = 1e-6f;
constexpr int NMOD = 6 * D_;
constexpr int INCOLS = 7184;

constexpr size_t WS_BAR   = 0;
constexpr size_t WS_MOD   = 16384;
constexpr size_t WS_WG    = WS_MOD + (size_t)B_ * NMOD * 4;
constexpr size_t WS_GATE  = WS_WG + 16 * 2048 * 4;
constexpr size_t WS_F     = WS_GATE + (size_t)T_ * 16 * 4;
constexpr size_t WS_NST   = WS_F + 64 * 2048 * 4;
constexpr size_t WS_MST   = WS_NST + 1024 * 256 * 4;
constexpr size_t WS_DSC   = WS_MST + 4096;
constexpr size_t WS_WINT  = WS_DSC + 16384 * 4;
constexpr size_t WS_WOT   = WS_WINT + (size_t)7168 * 2048 * 2;
constexpr size_t WS_WQT   = WS_WOT + (size_t)2048 * 2048 * 2;
constexpr size_t WS_H     = WS_WQT + (size_t)2048 * 2048 * 2;
constexpr size_t WS_P     = WS_H + (size_t)T_ * 2048 * 2;
constexpr size_t SEG_B    = (size_t)T_ * 1024 * 2;
constexpr size_t WS_CST   = WS_P + 7 * SEG_B;
constexpr size_t WS_E8D   = WS_CST + (size_t)1024 * 256 * 256 * 2;
constexpr size_t WS_E8U   = WS_E8D + (size_t)16384 * 2048;
constexpr size_t WS_END   = WS_E8U + (size_t)16384 * 2048;
constexpr size_t WS_QC    = WS_E8D;
constexpr size_t WS_KC    = WS_E8U;
constexpr size_t WS_QCTR  = 15360;
constexpr size_t WS_H2    = WS_P;
constexpr size_t WS_Q     = WS_H2 + (size_t)T_ * 2048 * 2;
constexpr size_t WS_IDX   = WS_Q + (size_t)T_ * 2048 * 2;
constexpr size_t WS_GW    = WS_IDX + (size_t)T_ * 128 * 4;
static_assert(WS_GW + (size_t)T_ * 128 * 4 <= WS_CST, "alias overflow");
constexpr size_t WS_X1    = WS_CST;
constexpr size_t WS_EWT   = WS_GW + (size_t)T_ * 128 * 4;
static_assert(WS_EWT + (size_t)T_ * 128 * 4 <= WS_CST, "alias overflow 2");

struct Params {
    const float *x, *c, *w_ada, *b_ada, *g1, *g2, *w_in, *fox_fb, *fox_qg, *fox_kg, *conv_w, *conv_b, *m_ib, *m_fb, *m_hg, *w_out, *w_q, *sk1, *sk2, *e_down, *e_up;
    float* out; unsigned char* ws; int ph_lo, ph_hi;
};

__device__ __forceinline__ int get_tid() { int t = threadIdx.x; asm volatile("" : "+v"(t)); return t; }
__device__ __forceinline__ void lds_barrier() { asm volatile("s_waitcnt lgkmcnt(0)\n\ts_barrier" ::: "memory"); }
__device__ __forceinline__ unsigned cvt_pk(float lo, float hi) { unsigned r; asm("v_cvt_pk_bf16_f32 %0, %1, %2" : "=v"(r) : "v"(lo), "v"(hi)); return r; }
__device__ __forceinline__ void fmac(float& acc, float a, float b) { asm("v_fmac_f32 %0, %1, %2" : "+v"(acc) : "v"(a), "v"(b)); }
__device__ __forceinline__ float bf2f(unsigned short h) { return __builtin_bit_cast(float, ((unsigned)h) << 16); }
__device__ __forceinline__ float bflo(unsigned w) { return __builtin_bit_cast(float, w << 16); }
__device__ __forceinline__ float bfhi(unsigned w) { return __builtin_bit_cast(float, w & 0xffff0000u); }
__device__ __forceinline__ float wsum(float v) {
#pragma unroll
    for (int o = 32; o; o >>= 1) v += __shfl_xor(v, o);
    return v; }
__device__ __forceinline__ float wmax(float v) {
#pragma unroll
    for (int o = 32; o; o >>= 1) v = fmaxf(v, __shfl_xor(v, o));
    return v; }
__device__ __forceinline__ float logsig(float x) { return fminf(x, 0.f) - log1pf(expf(-fabsf(x))); }
__device__ __forceinline__ float sigm(float x) { return 1.f / (1.f + expf(-x)); }
__device__ __forceinline__ float silu_f(float x) { return x / (1.f + expf(-x)); }
namespace pg8 {
#define PG8_LAS __attribute__((address_space(3)))
typedef unsigned short bf16_t;
typedef short bf16x8 __attribute__((ext_vector_type(8)));
typedef float f32x4 __attribute__((ext_vector_type(4)));
typedef unsigned u32x4 __attribute__((ext_vector_type(4)));
constexpr int BM = 256, BK = 64, HALF = 128, HTB = HALF * BK * 2  , STAGE_BYTES = 8 * HTB, NXCD = 8, WGM = 8;

__host__ __device__ __forceinline__ int lds_byte(int r, int c) { const int st = (r >> 4) * 2 + (c >> 5), rr = r & 15, cc = c & 31, ob = rr * 64 + cc * 2; return st * 1024 + (ob ^ (((ob >> 9) & 1) << 5)); }
__host__ __device__ __forceinline__ void stage_rc(int b, int& R, int& C) { const int st = b / 1024, sb = b % 1024, swz = sb ^ (((sb >> 9) & 1) << 5); R = (st >> 1) * 16 + swz / 64; C = (st & 1) * 32 + (swz % 64) / 2; }
__host__ __device__ __forceinline__ int perm32(int rho) { const int n = rho >> 4, i = rho & 15; return 8 * (i >> 2) + 4 * n + (i & 3); }

struct Unit { int pm, pn; };
struct Gemm { const bf16_t* A; const bf16_t* Bt; int M, N, K; };

struct StaticOrder {
    int nM, nN, nwg, G, c;
    __host__ __device__ void init(int M, int N, int G_, int c_) { nM = M / BM; nN = N / BM; nwg = nM * nN; G = G_; c = c_; }
    __host__ __device__ bool next(int i, Unit& u) const {
        const long L = (long)i * G + c; if (L >= nwg) return false;
        int wgid = (int)L; { const int q = nwg / NXCD, r = nwg % NXCD, xcd = wgid % NXCD, off = wgid / NXCD; wgid = (xcd < r ? xcd * (q + 1) : r * (q + 1) + (xcd - r) * q) + off; }
        const int nig = WGM * nN, gid = wgid / nig, fm = gid * WGM, gsz = (nM - fm) < WGM ? (nM - fm) : WGM;
        u.pm = fm + ((wgid % nig) % gsz); u.pn = (wgid % nig) / gsz; return true;
    }
    __device__ __forceinline__ void a_ready(const Unit&) const {}
    __device__ __forceinline__ void done(const Unit&) const {}
};
struct EpiSeg {
    static constexpr bool PERM = true, AFTER_DRAIN = false;
    bf16_t* P;
    __device__ __forceinline__ void operator()(const f32x4 (&acc)[2][2][4][2], const Unit& u, int wr, int wc, int fr, int fq) const {
        const int seg = u.pn >> 2; bf16_t* base = P + (size_t)seg * ((size_t)T_ * 1024);
        const int row0 = u.pm * BM + wr * 64 + fr, col0 = (u.pn & 3) * 256 + wc * 32 + 8 * fq;
#pragma unroll
        for (int ai = 0; ai < 2; ++ai)
#pragma unroll
            for (int m = 0; m < 4; ++m) { bf16_t* rowp = base + (size_t)(row0 + ai * HALF + m * 16) * 1024 + col0;
#pragma unroll
                for (int bj = 0; bj < 2; ++bj) { const f32x4 v0 = acc[ai][bj][m][0], v1 = acc[ai][bj][m][1];
                    u32x4 w; w.x = cvt_pk(v0[0], v0[1]); w.y = cvt_pk(v0[2], v0[3]); w.z = cvt_pk(v1[0], v1[1]); w.w = cvt_pk(v1[2], v1[3]);
                    *(u32x4*)(rowp + bj * HALF) = w; } }
    }
};
struct EpiBf {
    static constexpr bool PERM = true, AFTER_DRAIN = false;
    bf16_t* O; int ldc;
    __device__ __forceinline__ void operator()(const f32x4 (&acc)[2][2][4][2], const Unit& u, int wr, int wc, int fr, int fq) const {
        const int row0 = u.pm * BM + wr * 64 + fr, col0 = u.pn * BM + wc * 32 + 8 * fq;
#pragma unroll
        for (int ai = 0; ai < 2; ++ai)
#pragma unroll
            for (int m = 0; m < 4; ++m) { bf16_t* rowp = O + (size_t)(row0 + ai * HALF + m * 16) * ldc + col0;
#pragma unroll
                for (int bj = 0; bj < 2; ++bj) { const f32x4 v0 = acc[ai][bj][m][0], v1 = acc[ai][bj][m][1];
                    u32x4 w; w.x = cvt_pk(v0[0], v0[1]); w.y = cvt_pk(v0[2], v0[3]); w.z = cvt_pk(v1[0], v1[1]); w.w = cvt_pk(v1[2], v1[3]);
                    *(u32x4*)(rowp + bj * HALF) = w; } }
    }
};
struct EpiRes {
    static constexpr bool PERM = false, AFTER_DRAIN = false;
    const float* X; float* O; const float* mod; int goff;
    __device__ __forceinline__ void operator()(const f32x4 (&acc)[2][2][4][2], const Unit& u, int wr, int wc, int fr, int fq) const {
        const int row0 = u.pm * BM + wr * 64 + fr, col0 = u.pn * BM + wc * 32 + 4 * fq;
        const float* gp = mod + (size_t)((u.pm * BM) >> 11) * NMOD + goff + col0;
        f32x4 gv[2][2];
#pragma unroll
        for (int bj = 0; bj < 2; ++bj)
#pragma unroll
            for (int n = 0; n < 2; ++n) gv[bj][n] = *(const f32x4*)(gp + bj * HALF + 16 * n);
#pragma unroll
        for (int ai = 0; ai < 2; ++ai)
#pragma unroll
            for (int m = 0; m < 4; ++m) { const size_t ro = (size_t)(row0 + ai * HALF + m * 16) * D_ + col0;
#pragma unroll
                for (int bj = 0; bj < 2; ++bj)
#pragma unroll
                    for (int n = 0; n < 2; ++n) { const f32x4 xv = *(const f32x4*)(X + ro + bj * HALF + 16 * n);
                        *(f32x4*)(O + ro + bj * HALF + 16 * n) = xv + gv[bj][n] * acc[ai][bj][m][n]; } }
    }
};
template <class Epi, class Sched, bool ALIGN_EPI = false, bool SP2 = false>
__device__ __forceinline__ void gemm_phase(PG8_LAS unsigned char* lds, const Gemm g, const Sched& S, const Epi& E) {
    const int tid = get_tid(), wid = __builtin_amdgcn_readfirstlane(tid >> 6), lane = tid & 63, wr = wid >> 2, wc = wid & 3, fr = lane & 15, fq = lane >> 4;
    const int K = g.K, nt = K / BK;
    unsigned voffA[2], voffB[2];
#pragma unroll
    for (int i = 0; i < 2; ++i) { int R, C; stage_rc(tid * 16 + i * 8192, R, C); const int Rb = Epi::PERM ? ((R & ~31) + perm32(R & 31)) : R;
        voffA[i] = (unsigned)(R * K + C) * 2u; voffB[i] = (unsigned)(Rb * K + C) * 2u; }
    const size_t kstep = (size_t)(BK * 2);
    const size_t hstep = (size_t)HALF * K * 2;
    const size_t tstep = 2 * hstep;
    const unsigned ldsw = (unsigned)wid * 1024u;
    const int aoff = lds_byte(wr * 64 + fr, fq * 8), boff = lds_byte(wc * 32 + fr, fq * 8);
#define PG8_SA(b, h) (((b) * 2 + (h)) * HTB)
#define PG8_SB(b, h) ((4 + (b) * 2 + (h)) * HTB)
#define PG8_STAGE(bufoff, gbase, voff) do { _Pragma("unroll") for (int _i = 0; _i < 2; ++_i) \
        __builtin_amdgcn_global_load_lds((const unsigned*)((const char*)(gbase) + (voff)[_i]), (PG8_LAS unsigned*)(lds + (bufoff) + ldsw + _i * 8192), 16, 0, 0); } while (0)
#define PG8_LDA(dst, b, h) do { _Pragma("unroll") for (int m = 0; m < 4; ++m) _Pragma("unroll") for (int k = 0; k < 2; ++k) dst[m][k] = *(const PG8_LAS bf16x8*)(lds + PG8_SA(b, h) + aoff + m * 2048 + k * 1024); } while (0)
#define PG8_LDB(dst, b, h) do { _Pragma("unroll") for (int n = 0; n < 2; ++n) _Pragma("unroll") for (int k = 0; k < 2; ++k) dst[n][k] = *(const PG8_LAS bf16x8*)(lds + PG8_SB(b, h) + boff + n * 2048 + k * 1024); } while (0)
#define PG8_MMA(ai, bj, At, Bt) do { __builtin_amdgcn_s_setprio(1); _Pragma("unroll") for (int m = 0; m < 4; ++m) _Pragma("unroll") for (int n = 0; n < 2; ++n) _Pragma("unroll") for (int k = 0; k < 2; ++k) \
        acc[ai][bj][m][n] = __builtin_amdgcn_mfma_f32_16x16x32_bf16(Bt[n][k], At[m][k], acc[ai][bj][m][n], 0, 0, 0); __builtin_amdgcn_s_setprio(0); } while (0)
#define PG8_WAIT_V(n) asm volatile("s_waitcnt vmcnt(" #n ")" ::: "memory")
#define PG8_WAIT_L(n) asm volatile("s_waitcnt lgkmcnt(" #n ")" ::: "memory")
#define PG8_BAR __builtin_amdgcn_s_barrier()
#define PG8_SCHED __builtin_amdgcn_sched_barrier(0)
    Unit cur, nxt; int ui = 0;
    if (!S.next(0, cur)) return;
    f32x4 acc[2][2][4][2];
#pragma unroll
    for (int a = 0; a < 2; ++a)
#pragma unroll
        for (int b = 0; b < 2; ++b)
#pragma unroll
            for (int m = 0; m < 4; ++m)
#pragma unroll
                for (int n = 0; n < 2; ++n) acc[a][b][m][n] = (f32x4){0.f, 0.f, 0.f, 0.f};
    bf16x8 At[4][2], B0[2][2], B1[2][2];
    const char* cA = (const char*)g.A + (size_t)cur.pm * tstep; const char* cB = (const char*)g.Bt + (size_t)cur.pn * tstep;
    S.a_ready(cur);
    if constexpr (SP2) {
        PG8_STAGE(PG8_SB(0, 0), cB, voffB); PG8_STAGE(PG8_SB(0, 1), cB + hstep, voffB); PG8_STAGE(PG8_SA(0, 0), cA, voffA); PG8_STAGE(PG8_SA(0, 1), cA + hstep, voffA);
        if (wr == 1) PG8_BAR;
        PG8_WAIT_V(2); PG8_BAR;
        PG8_STAGE(PG8_SB(1, 0), cB + kstep, voffB); PG8_STAGE(PG8_SA(1, 0), cA + kstep, voffA); PG8_STAGE(PG8_SB(1, 1), cB + hstep + kstep, voffB);
        PG8_WAIT_V(6); PG8_BAR;
    } else {
        PG8_STAGE(PG8_SB(0, 0), cB, voffB); PG8_STAGE(PG8_SA(0, 0), cA, voffA); PG8_STAGE(PG8_SB(0, 1), cB + hstep, voffB); PG8_STAGE(PG8_SA(0, 1), cA + hstep, voffA);
        if (wr == 1) PG8_BAR;
        PG8_WAIT_V(4); PG8_BAR;
        PG8_STAGE(PG8_SB(1, 0), cB + kstep, voffB); PG8_STAGE(PG8_SA(1, 0), cA + kstep, voffA); PG8_STAGE(PG8_SB(1, 1), cB + hstep + kstep, voffB);
        PG8_WAIT_V(6); PG8_BAR;
    }
    for (;;) {
        const bool has_next = S.next(ui + 1, nxt);
        const char* nA = has_next ? (const char*)g.A + (size_t)nxt.pm * tstep : cA; const char* nB = has_next ? (const char*)g.Bt + (size_t)nxt.pn * tstep : cB;
        for (int t = 0; t < nt; t += 2) {
            const bool last = (t == nt - 2);
            const char* a1 = cA + (size_t)(t + 1) * kstep;
            const char* a2 = last ? nA : cA + (size_t)(t + 2) * kstep; const char* b2 = last ? nB : cB + (size_t)(t + 2) * kstep;
            const char* a3 = a2 + kstep; const char* b3 = b2 + kstep;
            if (last && has_next) S.a_ready(nxt);
            if constexpr (SP2) {
            PG8_LDB(B0, 0, 0); PG8_LDB(B1, 0, 1); PG8_SCHED; PG8_LDA(At, 0, 0); PG8_STAGE(PG8_SA(1, 1), a1 + hstep, voffA);
            PG8_WAIT_V(8); PG8_WAIT_L(0); PG8_BAR; PG8_MMA(0, 0, At, B0); PG8_MMA(0, 1, At, B1); PG8_BAR; PG8_SCHED;
            PG8_LDA(At, 0, 1); PG8_STAGE(PG8_SB(0, 0), b2, voffB); PG8_STAGE(PG8_SB(0, 1), b2 + hstep, voffB); PG8_STAGE(PG8_SA(0, 0), a2, voffA);
            PG8_WAIT_V(8); PG8_WAIT_L(0); PG8_BAR; PG8_MMA(1, 0, At, B0); PG8_MMA(1, 1, At, B1); PG8_BAR; PG8_SCHED;
            PG8_LDB(B0, 1, 0); PG8_LDB(B1, 1, 1); PG8_SCHED; PG8_LDA(At, 1, 0); PG8_STAGE(PG8_SA(0, 1), a2 + hstep, voffA);
            PG8_WAIT_V(8); PG8_WAIT_L(0); PG8_BAR; PG8_MMA(0, 0, At, B0); PG8_MMA(0, 1, At, B1); PG8_BAR; PG8_SCHED;
            PG8_LDA(At, 1, 1); PG8_STAGE(PG8_SB(1, 0), b3, voffB); PG8_STAGE(PG8_SB(1, 1), b3 + hstep, voffB); PG8_STAGE(PG8_SA(1, 0), a3, voffA);
            PG8_WAIT_V(8); PG8_WAIT_L(0); PG8_BAR; PG8_MMA(1, 0, At, B0); PG8_MMA(1, 1, At, B1); PG8_BAR; PG8_SCHED;
            } else {
            PG8_LDB(B0, 0, 0); PG8_SCHED; PG8_LDA(At, 0, 0); PG8_STAGE(PG8_SA(1, 1), a1 + hstep, voffA);
            PG8_WAIT_L(8); PG8_BAR; PG8_WAIT_L(0); PG8_MMA(0, 0, At, B0); PG8_BAR; PG8_SCHED;
            PG8_LDB(B1, 0, 1); PG8_STAGE(PG8_SB(0, 0), b2, voffB);
            PG8_BAR; PG8_WAIT_L(0); PG8_MMA(0, 1, At, B1); PG8_BAR;
            PG8_LDA(At, 0, 1); PG8_STAGE(PG8_SA(0, 0), a2, voffA);
            PG8_BAR; PG8_WAIT_L(0); PG8_MMA(1, 0, At, B0); PG8_BAR; PG8_SCHED;
            PG8_STAGE(PG8_SB(0, 1), b2 + hstep, voffB);
            PG8_WAIT_V(6); PG8_BAR; PG8_MMA(1, 1, At, B1); PG8_BAR;
            PG8_LDB(B0, 1, 0); PG8_SCHED; PG8_LDA(At, 1, 0); PG8_STAGE(PG8_SA(0, 1), a2 + hstep, voffA);
            PG8_WAIT_L(8); PG8_BAR; PG8_WAIT_L(0); PG8_MMA(0, 0, At, B0); PG8_BAR; PG8_SCHED;
            PG8_LDB(B1, 1, 1); PG8_STAGE(PG8_SB(1, 0), b3, voffB);
            PG8_BAR; PG8_WAIT_L(0); PG8_MMA(0, 1, At, B1); PG8_BAR;
            PG8_LDA(At, 1, 1); PG8_STAGE(PG8_SA(1, 0), a3, voffA);
            PG8_BAR; PG8_WAIT_L(0); PG8_MMA(1, 0, At, B0); PG8_BAR; PG8_SCHED;
            PG8_STAGE(PG8_SB(1, 1), b3 + hstep, voffB);
            PG8_WAIT_V(6); PG8_BAR; PG8_MMA(1, 1, At, B1); PG8_BAR;
            }
        }
        if constexpr (ALIGN_EPI) { if (wr == 0) PG8_BAR; }
        if constexpr (!Epi::AFTER_DRAIN) { E(acc, cur, wr, wc, fr, fq); S.done(cur); }
        if (!has_next) break;
#pragma unroll
        for (int a = 0; a < 2; ++a)
#pragma unroll
            for (int b = 0; b < 2; ++b)
#pragma unroll
                for (int m = 0; m < 4; ++m)
#pragma unroll
                    for (int n = 0; n < 2; ++n) acc[a][b][m][n] = (f32x4){0.f, 0.f, 0.f, 0.f};
        cur = nxt; cA = nA; cB = nB; ++ui;
        if constexpr (ALIGN_EPI) { if (wr == 1) PG8_BAR; }
    }
    PG8_WAIT_V(0);
    if constexpr (!ALIGN_EPI) { if (wr == 0) PG8_BAR; }
    PG8_BAR;
    if constexpr (Epi::AFTER_DRAIN) { E.fused(acc, cur, wr, wc, fr, fq, lds, wid, lane); S.done(cur); }
#undef PG8_SA
#undef PG8_SB
#undef PG8_STAGE
#undef PG8_LDA
#undef PG8_LDB
#undef PG8_MMA
#undef PG8_WAIT_V
#undef PG8_WAIT_L
#undef PG8_BAR
#undef PG8_SCHED
}
}
#define XB_TMO      128
#define XB_XCNT(j)  (256  + 64 * (j))
#define XB_XSUB(j)  (1280 + 64 * (j))
#define XB_XGEN(j)  (2304 + 64 * (j))
#define XB_TOP      3328
#define XB_TOPGEN   3392
#define XCD_BAR_WORDS 3456
#define XB_SPIN_CAP (1u << 18)

__device__ __forceinline__ unsigned xb_ld(unsigned* p)              { return __hip_atomic_load(p, __ATOMIC_RELAXED, __HIP_MEMORY_SCOPE_AGENT); }
__device__ __forceinline__ unsigned xb_add(unsigned* p, unsigned v) { return __hip_atomic_fetch_add(p, v, __ATOMIC_RELAXED, __HIP_MEMORY_SCOPE_AGENT); }
__device__ __forceinline__ unsigned xb_xcc_id() { return (unsigned)__builtin_amdgcn_s_getreg((3 << 11) | 20) & 0xFu; }
#define XB_SPIN(cond, bar) do { unsigned _sp = 0; while (cond) { __builtin_amdgcn_s_sleep(1); \
    if ((++_sp & 255u) == 0u) { if (xb_ld(&(bar)[XB_TMO])) break; if (_sp > XB_SPIN_CAP) { atomicAdd(&(bar)[XB_TMO], 1u); break; } } } } while (0)

struct XcdBarrier {
    unsigned* bar; unsigned x;
    volatile LAS unsigned* st;
};

__device__ __forceinline__ XcdBarrier xcd_barrier_post(unsigned* bar, volatile LAS unsigned* st) {
    XcdBarrier b; b.bar = bar; b.x = xb_xcc_id(); b.st = st;
    if (threadIdx.x == 0) (void)xb_add(&bar[XB_XCNT(b.x)], 1u);
    return b;
}
__device__ __forceinline__ void xcd_barrier_complete(unsigned* bar, unsigned x, unsigned& nloc, unsigned& nx) {
    const unsigned G = gridDim.x * gridDim.y * gridDim.z;
    unsigned sum, cnt, mine, sp = 0u;
    for (;;) {
        sum = 0u; cnt = 0u; mine = 0u;
#pragma unroll
        for (unsigned j = 0; j < 16; ++j) { const unsigned c = xb_ld(&bar[XB_XCNT(j)]); sum += c; cnt += (c > 0u) ? 1u : 0u; mine = (j == x) ? c : mine; }
        if (sum == G) break;
        __builtin_amdgcn_s_sleep(1);
        if ((++sp & 255u) == 0u) { if (xb_ld(&bar[XB_TMO])) break; if (sp > XB_SPIN_CAP) { atomicAdd(&bar[XB_TMO], 1u); break; } }
    }
    nloc = mine > 0u ? mine : 1u; nx = cnt > 0u ? cnt : 1u;
}

__device__ __forceinline__ void xcd_barrier(const XcdBarrier& b) {
    asm volatile("s_waitcnt vmcnt(0)" ::: "memory");
    __syncthreads();
    if (threadIdx.x == 0) {
        unsigned* bar = b.bar;
        __builtin_amdgcn_s_waitcnt(0);
        unsigned nloc = b.st[0], nx = b.st[1];
        if (nloc == 0u) { xcd_barrier_complete(bar, b.x, nloc, nx); b.st[0] = nloc; b.st[1] = nx; }
        const unsigned old = xb_add(&bar[XB_XSUB(b.x)], 1u);
        const unsigned gen = old / nloc;
        if (old + 1u == (gen + 1u) * nloc) {
            __builtin_amdgcn_fence(__ATOMIC_RELEASE, "agent");
            asm volatile("s_waitcnt vmcnt(0)" ::: "memory");
            const unsigned og = xb_add(&bar[XB_TOP], 1u);
            const unsigned tg = og / nx;
            if (og + 1u == (tg + 1u) * nx) xb_add(&bar[XB_TOPGEN], 1u);
            else XB_SPIN(xb_ld(&bar[XB_TOPGEN]) == tg, bar);
            __builtin_amdgcn_fence(__ATOMIC_ACQUIRE, "agent");
            xb_add(&bar[XB_XGEN(b.x)], 1u);
            asm volatile("s_waitcnt vmcnt(0)" ::: "memory");
        } else {
            XB_SPIN(xb_ld(&bar[XB_XGEN(b.x)]) == gen, bar);
            __builtin_amdgcn_fence(__ATOMIC_ACQUIRE, "agent");
            asm volatile("s_waitcnt vmcnt(0)" ::: "memory");
        }
    }
    __syncthreads();
}
__device__ __forceinline__ void phase_prep(const Params& p, unsigned char* lds, int bid, int nb) {
    const int tid = get_tid(), lane = tid & 63, wave = tid >> 6;
    unsigned char* ws = p.ws;
    float* mod = (float*)(ws + WS_MOD);
    if (bid < 192) {
        float* sc = (float*)lds;
        float* red = sc + 8 * 2048;
        for (int i = tid; i < 8 * 2048; i += NTHR) sc[i] = silu_f(p.c[i]);
        __syncthreads();
        for (int it = bid; it < 192; it += nb) {
            const int col = it * 64 + lane;
            float acc[8];
#pragma unroll
            for (int b = 0; b < 8; ++b) acc[b] = 0.f;
            const float* w = p.w_ada + (size_t)(wave * 256) * NMOD + col;
            const float* s0 = sc + wave * 256;
#pragma unroll 16
            for (int k = 0; k < 256; ++k) {
                const float wv = __builtin_nontemporal_load(w + (size_t)k * NMOD);
#pragma unroll
                for (int b = 0; b < 8; ++b) acc[b] += s0[b * 2048 + k] * wv;
            }
#pragma unroll
            for (int b = 0; b < 8; ++b) red[(wave * 8 + b) * 64 + lane] = acc[b];
            __syncthreads();
            {   const int b = wave; float s = p.b_ada[col];
#pragma unroll
                for (int w2 = 0; w2 < 8; ++w2) s += red[(w2 * 8 + b) * 64 + lane];
                mod[b * NMOD + col] = s; }
            __syncthreads();
        }
    }
    __syncthreads();
    {
        float* tile = (float*)lds;
        bf16_t* WinT = (bf16_t*)(ws + WS_WINT); bf16_t* WoT = (bf16_t*)(ws + WS_WOT); bf16_t* WqT = (bf16_t*)(ws + WS_WQT);
        for (int item = bid; item < 5632; item += nb) {
            const float* src; int ld, scol; bf16_t* dst; int kt;
            if (item < 3584) { const int seg = item >> 9, rem = item & 511, ntile = rem >> 5; kt = rem & 31;
                src = p.w_in; ld = INCOLS; scol = (seg < 3 ? seg * 1024 : 3080 + (seg - 3) * 1024) + ntile * 64; dst = WinT + (size_t)(seg * 1024 + ntile * 64) * 2048; }
            else if (item < 4608) { const int rem = item - 3584, ntile = rem >> 5; kt = rem & 31; src = p.w_out; ld = 2048; scol = ntile * 64; dst = WoT + (size_t)(ntile * 64) * 2048; }
            else { const int rem = item - 4608, ntile = rem >> 5; kt = rem & 31; src = p.w_q; ld = 2048; scol = ntile * 64; dst = WqT + (size_t)(ntile * 64) * 2048; }
            const int k0 = kt * 64;
#pragma unroll
            for (int ii = 0; ii < 8; ++ii) { const int k = wave + 8 * ii; tile[k * 65 + lane] = src[(size_t)(k0 + k) * ld + scol + lane]; }
            __syncthreads();
#pragma unroll
            for (int ii = 0; ii < 8; ++ii) { const int n = wave + 8 * ii; dst[(size_t)n * 2048 + k0 + lane] = (bf16_t)(cvt_pk(tile[lane * 65 + n], 0.f) & 0xffffu); }
            __syncthreads();
        }
    }
    {
        bf16_t* Wg = (bf16_t*)(ws + WS_WG);
        for (int i = bid * NTHR + tid; i < 16 * 2048; i += nb * NTHR) { const int g = i >> 11, k = i & 2047; const int col = g < 8 ? 3072 + g : 7176 + (g - 8);
            Wg[i] = (bf16_t)(cvt_pk(p.w_in[(size_t)k * INCOLS + col], 0.f) & 0xffffu); }
    }
}

__device__ __forceinline__ unsigned pack4_fp8(const f32x4 a) { int t = __builtin_amdgcn_cvt_pk_fp8_f32(a[0], a[1], 0, false); t = __builtin_amdgcn_cvt_pk_fp8_f32(a[2], a[3], t, true); return (unsigned)t; }
__device__ __forceinline__ void convert_experts(const Params& p, int bid, int nb) {
    const int tid = get_tid(); unsigned char* ws = p.ws;
    unsigned char* E8D = ws + WS_E8D; unsigned char* E8US = ws + WS_E8U;
    {
        const int lane = tid & 63, wave = tid >> 6; float* DSC = (float*)(ws + WS_DSC);
        for (int e = bid * 8 + wave; e < 16384; e += nb * 8) {
            const float* rp = p.e_down + (size_t)e * 2048;
            f32x4 v[8]; float mx = 0.f;
#pragma unroll
            for (int hf = 0; hf < 2; ++hf)
#pragma unroll
                for (int q = 0; q < 4; ++q) { v[hf * 4 + q] = *(const f32x4*)(rp + hf * 1024 + 16 * lane + 4 * q);
#pragma unroll
                    for (int c = 0; c < 4; ++c) mx = fmaxf(mx, fabsf(v[hf * 4 + q][c])); }
            mx = fmaxf(wmax(mx), 1e-30f);
            const float inv = 127.f / mx;
            if (lane == 0) DSC[e] = mx * (1.f / 127.f);
#pragma unroll
            for (int hf = 0; hf < 2; ++hf) { u32x4 o;
#pragma unroll
                for (int q = 0; q < 4; ++q) { unsigned w = 0u;
#pragma unroll
                    for (int c = 0; c < 4; ++c) w |= ((unsigned)__float2int_rn(v[hf * 4 + q][c] * inv) & 0xffu) << (8 * c);
                    o[q] = w; }
                *(u32x4*)(E8D + (size_t)e * 2048 + hf * 1024 + 16 * lane) = o; }
        }
    }
    for (int i = bid * NTHR + tid; i < 524288; i += nb * NTHR) {
        const int s = i & 255, eg = i >> 8;
        const float* sp = p.e_up + (size_t)(eg * 8) * 2048 + 8 * s;
        unsigned w[16];
#pragma unroll
        for (int q = 0; q < 8; ++q) { const f32x4 a = *(const f32x4*)(sp + (size_t)q * 2048), b = *(const f32x4*)(sp + (size_t)q * 2048 + 4); w[2 * q] = pack4_fp8(a * 32.f); w[2 * q + 1] = pack4_fp8(b * 32.f); }
        u32x4* dp = (u32x4*)(E8US + ((size_t)s * 16384 + eg * 8) * 8);
#pragma unroll
        for (int q = 0; q < 4; ++q) { u32x4 o; o.x = w[4 * q]; o.y = w[4 * q + 1]; o.z = w[4 * q + 2]; o.w = w[4 * q + 3]; dp[q] = o; }
    }
}

template <bool RES>
__device__ __forceinline__ void phase_norm(const float* xin, const bf16_t* yin, int gate_off, const float* gain, const float* mod, int shift_off, int scale_off, bf16_t* hout, int bid, int nb) {
    const int tid = get_tid(), lane = tid & 63, wave = tid >> 6;
    for (int row = bid * 8 + wave; row < T_; row += nb * 8) {
        const f32x4* xr = (const f32x4*)(xin + (size_t)row * D_);
        f32x4 v[8]; float ss = 0.f;
        const float* mb = mod + (size_t)(row >> 11) * NMOD;
#pragma unroll
        for (int j = 0; j < 8; ++j) { v[j] = xr[lane + 64 * j];
            if (RES) { const int k = 4 * (lane + 64 * j); const u32x2 yw = *(const u32x2*)(yin + (size_t)row * D_ + k); const f32x4 gv = *(const f32x4*)(mb + gate_off + k);
                v[j][0] += gv[0] * bflo(yw.x); v[j][1] += gv[1] * bfhi(yw.x); v[j][2] += gv[2] * bflo(yw.y); v[j][3] += gv[3] * bfhi(yw.y); }
            ss += v[j][0] * v[j][0] + v[j][1] * v[j][1] + v[j][2] * v[j][2] + v[j][3] * v[j][3]; }
        ss = wsum(ss);
        const float r = rsqrtf(ss * (1.f / D_) + EPS_);
        f32x4 hv[8];
#pragma unroll
        for (int j = 0; j < 8; ++j) {
            const int k = 4 * (lane + 64 * j);
            const f32x4 gn = *(const f32x4*)(gain + k), sh = *(const f32x4*)(mb + shift_off + k), scl = *(const f32x4*)(mb + scale_off + k);
#pragma unroll
            for (int e = 0; e < 4; ++e) hv[j][e] = (v[j][e] * r) * gn[e] * (1.f + scl[e]) + sh[e];
            u32x2 w; w.x = cvt_pk(hv[j][0], hv[j][1]); w.y = cvt_pk(hv[j][2], hv[j][3]);
            *(u32x2*)(hout + (size_t)row * D_ + k) = w;
        }
    }
}

__device__ __forceinline__ void phase_gates(const Params& p, unsigned char* lds, int bid, int nb) {
    const int tid = get_tid(), lane = tid & 63, wave = tid >> 6, r = lane & 31, hh = lane >> 5;
    unsigned char* ws = p.ws;
    const bf16_t* H = (const bf16_t*)(ws + WS_H); const bf16_t* Wg = (const bf16_t*)(ws + WS_WG); float* gate = (float*)(ws + WS_GATE);
    constexpr int WST = 4096 + 16;
    for (int i = tid; i < 16 * 256; i += NTHR) { const int g = i >> 8, c = i & 255; *(u32x4*)(lds + g * WST + c * 16) = *(const u32x4*)(Wg + (size_t)g * 2048 + c * 8); }
    __syncthreads();
    float* part = (float*)(lds + 16 * WST);
    for (int pr = bid; pr < T_ / 64; pr += nb) {
        const int t = pr * 64 + (wave >> 2) * 32 + r, kq = wave & 3;
        f32x16 acc;
#pragma unroll
        for (int i = 0; i < 16; ++i) acc[i] = 0.f;
        const bf16_t* hp = H + (size_t)t * D_ + kq * 512 + hh * 8; const unsigned char* wp = lds + (r & 15) * WST + kq * 1024 + hh * 16;
#pragma unroll 1
        for (int k0 = 0; k0 < 32; k0 += 16) {
            bf16x8 bfr[16];
#pragma unroll
            for (int j = 0; j < 16; ++j) bfr[j] = *(const bf16x8*)(hp + (k0 + j) * 16);
#pragma unroll
            for (int j = 0; j < 16; ++j) { bf16x8 a = *(const bf16x8*)(wp + (k0 + j) * 32); if (r >= 16) a = (bf16x8){0, 0, 0, 0, 0, 0, 0, 0};
                acc = __builtin_amdgcn_mfma_f32_32x32x16_bf16(a, bfr[j], acc, 0, 0, 0); }
        }
        __syncthreads();
#pragma unroll
        for (int i = 0; i < 8; ++i) part[(wave * 8 + i) * 64 + lane] = acc[i];
        __syncthreads();
        if (kq == 0) {
            float s[8];
#pragma unroll
            for (int i = 0; i < 8; ++i) s[i] = part[(wave * 8 + i) * 64 + lane] + part[((wave + 1) * 8 + i) * 64 + lane] + part[((wave + 2) * 8 + i) * 64 + lane] + part[((wave + 3) * 8 + i) * 64 + lane];
            f32x4 g0, g1; g0[0] = s[0]; g0[1] = s[1]; g0[2] = s[2]; g0[3] = s[3]; g1[0] = s[4]; g1[1] = s[5]; g1[2] = s[6]; g1[3] = s[7];
            *(f32x4*)(gate + (size_t)t * 16 + 4 * hh) = g0; *(f32x4*)(gate + (size_t)t * 16 + 8 + 4 * hh) = g1;
        }
    }
    __syncthreads();
}

__device__ __forceinline__ void phase_post(const Params& p, int bid, int nb) {
    const int tid = get_tid(), lane = tid & 63, wave = tid >> 6;
    unsigned char* ws = p.ws;
    bf16_t* Pq = (bf16_t*)(ws + WS_P); bf16_t* Pk = (bf16_t*)(ws + WS_P + SEG_B);
    const float qscale = 0.08838834764831845f * 1.4426950408889634f;
    for (int r = bid * 8 + wave; r < 2 * T_; r += nb * 8) {
        const int which = r >= T_ ? 1 : 0; const int t = r - which * T_;
        bf16_t* ptr = (which ? Pk : Pq) + (size_t)t * 1024 + lane * 16;
        const float* gn = (which ? p.fox_kg : p.fox_qg) + (lane & 7) * 16;
        u32x4 a = *(const u32x4*)ptr, b = *(const u32x4*)(ptr + 8);
        float f[16];
        f[0] = bflo(a.x); f[1] = bfhi(a.x); f[2] = bflo(a.y); f[3] = bfhi(a.y); f[4] = bflo(a.z); f[5] = bfhi(a.z); f[6] = bflo(a.w); f[7] = bfhi(a.w);
        f[8] = bflo(b.x); f[9] = bfhi(b.x); f[10] = bflo(b.y); f[11] = bfhi(b.y); f[12] = bflo(b.z); f[13] = bfhi(b.z); f[14] = bflo(b.w); f[15] = bfhi(b.w);
        float ss = 0.f;
#pragma unroll
        for (int i = 0; i < 16; ++i) ss += f[i] * f[i];
        ss += __shfl_xor(ss, 1); ss += __shfl_xor(ss, 2); ss += __shfl_xor(ss, 4);
        const float rr = rsqrtf(ss * (1.f / 128.f) + EPS_) * (which ? 1.f : qscale);
#pragma unroll
        for (int i = 0; i < 16; ++i) f[i] = (f[i] * rr) * gn[i];
        a.x = cvt_pk(f[0], f[1]); a.y = cvt_pk(f[2], f[3]); a.z = cvt_pk(f[4], f[5]); a.w = cvt_pk(f[6], f[7]);
        b.x = cvt_pk(f[8], f[9]); b.y = cvt_pk(f[10], f[11]); b.z = cvt_pk(f[12], f[13]); b.w = cvt_pk(f[14], f[15]);
        *(u32x4*)ptr = a; *(u32x4*)(ptr + 8) = b;
    }
    {
        const bf16_t* Mq = (const bf16_t*)(ws + WS_P + 3 * SEG_B); const bf16_t* Mk = (const bf16_t*)(ws + WS_P + 4 * SEG_B);
        bf16_t* QC = (bf16_t*)(ws + WS_QC); bf16_t* KC = (bf16_t*)(ws + WS_KC);
        for (int item = bid; item < 256; item += nb) {
            const int which = item >> 7, tb = item & 127, cg = tid & 127, run = tid >> 7, ch0 = cg * 8, ts = tb * 128 + run * 32, sp = ts & 2047;
            const bf16_t* src = (which ? Mk : Mq) + (size_t)ts * 1024 + ch0; bf16_t* dst = (which ? KC : QC) + (size_t)ts * 1024 + ch0;
            float w0[8], w1[8], w2[8], w3[8], cb[8], x0[8], x1[8], x2[8];
#pragma unroll
            for (int e = 0; e < 8; ++e) { const int ci = which * 1024 + ch0 + e; w0[e] = p.conv_w[ci]; w1[e] = p.conv_w[2048 + ci]; w2[e] = p.conv_w[4096 + ci]; w3[e] = p.conv_w[6144 + ci]; cb[e] = p.conv_b[ci]; }
            {   u32x4 a = {0u, 0u, 0u, 0u}, b = a, c = a;
                if (sp != 0) { a = *(const u32x4*)(src - 3 * 1024); b = *(const u32x4*)(src - 2 * 1024); c = *(const u32x4*)(src - 1024); }
#pragma unroll
                for (int e = 0; e < 4; ++e) { x0[2 * e] = bflo(a[e]); x0[2 * e + 1] = bfhi(a[e]); x1[2 * e] = bflo(b[e]); x1[2 * e + 1] = bfhi(b[e]); x2[2 * e] = bflo(c[e]); x2[2 * e + 1] = bfhi(c[e]); } }
            const float osc = which ? 0.0625f : 1.f;
            for (int s = 0; s < 32; ++s) {
                const u32x4 d = *(const u32x4*)(src + (size_t)s * 1024); float x3[8], y[8];
#pragma unroll
                for (int e = 0; e < 4; ++e) { x3[2 * e] = bflo(d[e]); x3[2 * e + 1] = bfhi(d[e]); }
#pragma unroll
                for (int e = 0; e < 8; ++e) { y[e] = silu_f(w0[e] * x0[e] + w1[e] * x1[e] + w2[e] * x2[e] + w3[e] * x3[e] + cb[e]) * osc; x0[e] = x1[e]; x1[e] = x2[e]; x2[e] = x3[e]; }
                u32x4 o; o.x = cvt_pk(y[0], y[1]); o.y = cvt_pk(y[2], y[3]); o.z = cvt_pk(y[4], y[5]); o.w = cvt_pk(y[6], y[7]);
                *(u32x4*)(dst + (size_t)s * 1024) = o;
            }
        }
    }
    const float* gate = (const float*)(ws + WS_GATE); float* F = (float*)(ws + WS_F);
    for (int sq = bid * 8 + wave; sq < 64; sq += nb * 8) {
        const int b = sq >> 3, h = sq & 7; const float fb = p.fox_fb[h];
        float v[32]; float run = 0.f;
#pragma unroll
        for (int i = 0; i < 32; ++i) { const int t = lane * 32 + i; run += logsig(gate[(size_t)(b * S_ + t) * 16 + h] + fb); v[i] = run; }
        float inc = run;
#pragma unroll
        for (int o = 1; o < 64; o <<= 1) { const float u = __shfl_up(inc, o); if (lane >= o) inc += u; }
        const float excl = inc - run;
#pragma unroll
        for (int i = 0; i < 32; ++i) F[(size_t)sq * S_ + lane * 32 + i] = (v[i] + excl) * 1.4426950408889634f;
    }
}
typedef short s16x4 __attribute__((ext_vector_type(4)));
__device__ __forceinline__ s16x4 lds_tr16(const unsigned char* p) { return __builtin_amdgcn_ds_read_tr16_b64_v4i16((LAS s16x4*)p); }
__device__ __forceinline__ bf16x8 tr_frag(const unsigned char* p0, int second_bytes) {
    const s16x4 a = lds_tr16(p0), b = lds_tr16(p0 + second_bytes);
    bf16x8 f; f[0] = a[0]; f[1] = a[1]; f[2] = a[2]; f[3] = a[3]; f[4] = b[0]; f[5] = b[1]; f[6] = b[2]; f[7] = b[3]; return f;
}
__device__ __forceinline__ unsigned split_bf16(float v, float& eff) { const unsigned hi = cvt_pk(v, 0.f) & 0xffffu; const float hf = bf2f((bf16_t)hi); const unsigned lo = cvt_pk(v - hf, 0.f) & 0xffffu; eff = hf + bf2f((bf16_t)lo); return hi | (lo << 16); }
__device__ __forceinline__ void fox_unit(const Params& p, unsigned char* lds, int b, int h, int qb) {
    const int tid = get_tid(), lane = tid & 63, wave = tid >> 6, r = lane & 31, hh = lane >> 5, li = lane & 15;
    unsigned char* ws = p.ws;
    const bf16_t* Pq = (const bf16_t*)(ws + WS_P); const bf16_t* Pk = (const bf16_t*)(ws + WS_P + SEG_B); const bf16_t* Pv = (const bf16_t*)(ws + WS_P + 2 * SEG_B);
    const float* F = (const float*)(ws + WS_F) + (size_t)(b * 8 + h) * S_;
    bf16_t* Oc = (bf16_t*)(ws + WS_H);
    constexpr int KST = 272, VST = 544, BUF = 64 * KST + 64 * VST;
    constexpr float THR = 8.f;
    const int q0w = qb * 256 + wave * 32, qs = q0w + r; const int q0s = __builtin_amdgcn_readfirstlane(q0w);
    const size_t trow = (size_t)(b * S_ + qs);
    bf16x8 qf[8];
#pragma unroll
    for (int ks = 0; ks < 8; ++ks) qf[ks] = *(const bf16x8*)(Pq + trow * 1024 + h * 128 + ks * 16 + hh * 8);
    float feff; const unsigned fq2 = split_bf16(F[qs], feff);
    float m = 0.f;
    u32x4 qa; qa.x = hh ? 0u : fq2; qa.y = 0u; qa.z = hh ? 0u : 0x3f803f80u; qa.w = 0u;
    f32x16 o[4];
#pragma unroll
    for (int d = 0; d < 4; ++d)
#pragma unroll
        for (int i = 0; i < 16; ++i) o[d][i] = 0.f;
    float l = 0.f;
    const int ntile = (qb * 256 + 256) / 64;
    const int srow0 = tid >> 4, scc = tid & 15;
    const bf16_t* kg = Pk + (size_t)(b * S_ + srow0) * 1024 + h * 128 + scc * 8; const bf16_t* vg = Pv + (size_t)(b * S_ + srow0) * 1024 + h * 128 + scc * 8;
    u32x4 kr[2], vr[2]; float fr = 0.f;
    const int vb_off = 64 * KST + (4 * hh + (li >> 2)) * VST + (16 * (r >> 4) + 4 * (li & 3)) * 2;
#define FOX_AUG(dst, fval) do { float e_; const unsigned s2_ = split_bf16(-(fval), e_); u32x4 w_; w_.x = 0x3f803f80u; w_.y = 0x3f803f80u; w_.z = s2_; w_.w = 0u; *(u32x4*)(dst) = w_; } while (0)
    __syncthreads();
#pragma unroll
    for (int i = 0; i < 2; ++i) { kr[i] = *(const u32x4*)(kg + (size_t)(32 * i) * 1024); vr[i] = *(const u32x4*)(vg + (size_t)(32 * i) * 1024); }
    if (tid < 64) fr = F[tid];
#pragma unroll
    for (int i = 0; i < 2; ++i) { *(u32x4*)(lds + (srow0 + 32 * i) * KST + scc * 16) = kr[i]; *(u32x4*)(lds + 64 * KST + (srow0 + 32 * i) * VST + scc * 16) = vr[i]; }
    if (tid < 64) FOX_AUG(lds + tid * KST + 256, fr);
    __syncthreads();
    for (int kt = 0; kt < ntile; ++kt) {
        const int k0 = kt * 64; unsigned char* cur = lds + (kt & 1) * BUF; unsigned char* nxt = lds + ((kt & 1) ^ 1) * BUF;
        const bool more = kt + 1 < ntile;
        if (more) {
#pragma unroll
            for (int i = 0; i < 2; ++i) { kr[i] = *(const u32x4*)(kg + (size_t)(k0 + 64 + 32 * i) * 1024); vr[i] = *(const u32x4*)(vg + (size_t)(k0 + 64 + 32 * i) * 1024); }
            if (tid < 64) fr = F[k0 + 64 + tid];
        }
        if (k0 <= q0s + 31) {
            f32x16 s[2];
            const bf16x8 qaf = __builtin_bit_cast(bf16x8, qa);
#pragma unroll
            for (int kb = 0; kb < 2; ++kb) {
#pragma unroll
                for (int i = 0; i < 16; ++i) s[kb][i] = 0.f;
#pragma unroll
                for (int ks = 0; ks < 8; ++ks) { const bf16x8 a = *(const bf16x8*)(cur + (kb * 32 + r) * KST + ks * 32 + hh * 16);
                    s[kb] = __builtin_amdgcn_mfma_f32_32x32x16_bf16(a, qf[ks], s[kb], 0, 0, 0); }
                {   const bf16x8 a = *(const bf16x8*)(cur + (kb * 32 + r) * KST + 256);
                    s[kb] = __builtin_amdgcn_mfma_f32_32x32x16_bf16(a, qaf, s[kb], 0, 0, 0); }
            }
            if (k0 + 63 > q0s) {
                const int lim = qs - k0;
#pragma unroll
                for (int kb = 0; kb < 2; ++kb)
#pragma unroll
                    for (int i = 0; i < 16; ++i) s[kb][i] = (kb * 32 + (i & 3) + 8 * (i >> 2) + 4 * hh > lim) ? -INFINITY : s[kb][i];
            }
            float mx = fmaxf(s[0][0], s[1][0]);
#pragma unroll
            for (int i = 1; i < 16; ++i) mx = fmaxf(mx, fmaxf(s[0][i], s[1][i]));
            mx = fmaxf(mx, __shfl_xor(mx, 32));
            if (__builtin_amdgcn_ballot_w64(mx > THR) != 0ull) {
                const float mnew_f = m + fmaxf(mx, 0.f); float meff; const unsigned m2 = split_bf16(-mnew_f, meff); meff = -meff;
                const float delta = meff - m, alpha = __builtin_amdgcn_exp2f(-delta);
                m = meff; if (!hh) qa.y = m2;
                l *= alpha;
#pragma unroll
                for (int d = 0; d < 4; ++d)
#pragma unroll
                    for (int i = 0; i < 16; ++i) o[d][i] *= alpha;
#pragma unroll
                for (int kb = 0; kb < 2; ++kb)
#pragma unroll
                    for (int i = 0; i < 16; ++i) s[kb][i] -= delta;
            }
            float ps = 0.f;
#pragma unroll
            for (int kb = 0; kb < 2; ++kb)
#pragma unroll
                for (int i = 0; i < 16; ++i) { const float pv = __builtin_amdgcn_exp2f(s[kb][i]); s[kb][i] = pv; ps += pv; }
            l += ps;
#pragma unroll
            for (int kb = 0; kb < 2; ++kb)
#pragma unroll
                for (int st = 0; st < 2; ++st) {
                    u32x4 pw; pw.x = cvt_pk(s[kb][8 * st + 0], s[kb][8 * st + 1]); pw.y = cvt_pk(s[kb][8 * st + 2], s[kb][8 * st + 3]);
                    pw.z = cvt_pk(s[kb][8 * st + 4], s[kb][8 * st + 5]); pw.w = cvt_pk(s[kb][8 * st + 6], s[kb][8 * st + 7]);
                    const bf16x8 pf = __builtin_bit_cast(bf16x8, pw);
#pragma unroll
                    for (int d = 0; d < 4; ++d) { const bf16x8 vf = tr_frag(cur + vb_off + (kb * 32 + st * 16) * VST + d * 64, 8 * VST);
                        o[d] = __builtin_amdgcn_mfma_f32_32x32x16_bf16(vf, pf, o[d], 0, 0, 0); }
                }
        }
        if (more) {
#pragma unroll
            for (int i = 0; i < 2; ++i) { *(u32x4*)(nxt + (srow0 + 32 * i) * KST + scc * 16) = kr[i]; *(u32x4*)(nxt + 64 * KST + (srow0 + 32 * i) * VST + scc * 16) = vr[i]; }
            if (tid < 64) FOX_AUG(nxt + tid * KST + 256, fr);
        }
        lds_barrier();
    }
#undef FOX_AUG
    l += __shfl_xor(l, 32);
    const float inv = 1.f / l;
#pragma unroll
    for (int d = 0; d < 4; ++d)
#pragma unroll
        for (int g = 0; g < 4; ++g) { u32x2 w; w.x = cvt_pk(o[d][4 * g] * inv, o[d][4 * g + 1] * inv); w.y = cvt_pk(o[d][4 * g + 2] * inv, o[d][4 * g + 3] * inv);
            *(u32x2*)(Oc + trow * D_ + h * 128 + d * 32 + 8 * g + 4 * hh) = w; }
}

__device__ __forceinline__ void mlstm_passA(const Params& p, unsigned char* lds, int unit) {
    const int tid = get_tid(), lane = tid & 63, wave = tid >> 6, r = lane & 31, hh = lane >> 5, li = lane & 15;
    const int b = unit >> 3, h = (unit >> 1) & 3, eh = unit & 1;
    unsigned char* ws = p.ws;
    const bf16_t* KC = (const bf16_t*)(ws + WS_KC); const bf16_t* Mv = (const bf16_t*)(ws + WS_P + 5 * SEG_B);
    const float* gate = (const float*)(ws + WS_GATE);
    bf16_t* Cst = (bf16_t*)(ws + WS_CST); float* nst = (float*)(ws + WS_NST); float* mst = (float*)(ws + WS_MST);
    constexpr int KST = 528, VST = 272;
    unsigned char* ksm = lds;
    unsigned char* vsm = ksm + 64 * KST;
    float* WSV = (float*)(vsm + 64 * VST);
    float* SCL = WSV + 2048;
    constexpr int STGS = 528;
    unsigned char* stg = (unsigned char*)(SCL + 128);
    __syncthreads();
    for (int cc = wave; cc < 32; cc += 8) {
        const int t = b * S_ + cc * 64 + lane;
        const float ipre = gate[(size_t)t * 16 + 8 + h] + p.m_ib[h], fpre = gate[(size_t)t * 16 + 12 + h] + p.m_fb[h];
        float bc = logsig(fpre);
#pragma unroll
        for (int o = 1; o < 64; o <<= 1) { const float u = __shfl_up(bc, o); if (lane >= o) bc += u; }
        const float a = ipre - bc; const float amax = wmax(a); const float bL = __shfl(bc, 63);
        WSV[cc * 64 + lane] = a; if (lane == 0) { SCL[cc] = bL; SCL[32 + cc] = amax; }
    }
    __syncthreads();
    if (tid == 0) { float m = 0.f; for (int cc = 0; cc < 32; ++cc) { const float mn = SCL[cc] + fmaxf(m, SCL[32 + cc]); SCL[64 + cc] = expf(SCL[cc] + m - mn); SCL[96 + cc] = mn; if (eh == 0) mst[(b * 4 + h) * 32 + cc] = m; m = mn; } }
    __syncthreads();
    for (int i = tid; i < 2048; i += NTHR) { const int cc = i >> 6; WSV[i] = expf(SCL[cc] + WSV[i] - SCL[96 + cc]); }
    f32x16 acc[4];
#pragma unroll
    for (int et = 0; et < 4; ++et)
#pragma unroll
        for (int i = 0; i < 16; ++i) acc[et][i] = 0.f;
    f32x16 accn;
#pragma unroll
    for (int i = 0; i < 16; ++i) accn[i] = 0.f;
    const int kb_off = (8 * hh + (li >> 2)) * KST + (wave * 32 + 16 * (r >> 4) + 4 * (li & 3)) * 2;
    const int vb_off = (8 * hh + (li >> 2)) * VST + (16 * (r >> 4) + 4 * (li & 3)) * 2;
    u32x4 pk[4], pv[2];
#pragma unroll
    for (int i = 0; i < 4; ++i) { const int c = tid + NTHR * i, row = c >> 5, c16 = c & 31; pk[i] = *(const u32x4*)(KC + (size_t)(b * S_ + row) * 1024 + h * 256 + c16 * 8); }
#pragma unroll
    for (int i = 0; i < 2; ++i) { const int c = tid + NTHR * i, row = c >> 4, c16 = c & 15; pv[i] = *(const u32x4*)(Mv + (size_t)(b * S_ + row) * 1024 + h * 256 + eh * 128 + c16 * 8); }
    for (int cc = 0; cc < 32; ++cc) {
        const int bhc = (b * 4 + h) * 32 + cc, t0 = b * S_ + cc * 64;
#pragma unroll
        for (int et = 0; et < 4; ++et)
#pragma unroll
            for (int g = 0; g < 4; ++g) { u32x2 o; o.x = cvt_pk(acc[et][4 * g], acc[et][4 * g + 1]); o.y = cvt_pk(acc[et][4 * g + 2], acc[et][4 * g + 3]);
                *(u32x2*)(stg + (et * 32 + r) * STGS + (wave * 32 + 8 * g + 4 * hh) * 2) = o; }
        if (eh == 0 && r == 0) {
#pragma unroll
            for (int g = 0; g < 4; ++g) { f32x4 o; o[0] = accn[4 * g]; o[1] = accn[4 * g + 1]; o[2] = accn[4 * g + 2]; o[3] = accn[4 * g + 3]; *(f32x4*)(nst + (size_t)bhc * 256 + wave * 32 + 8 * g + 4 * hh) = o; } }
        lds_barrier();
#pragma unroll
        for (int i = 0; i < 8; ++i) { const int c = tid + NTHR * i, row = c >> 5, c16 = c & 31;
            *(u32x4*)(Cst + ((size_t)bhc * 256 + eh * 128 + row) * 256 + c16 * 8) = *(const u32x4*)(stg + row * STGS + c16 * 16); }
        if (cc == 31) break;
#pragma unroll
        for (int i = 0; i < 4; ++i) { const int c = tid + NTHR * i, row = c >> 5, c16 = c & 31; *(u32x4*)(ksm + row * KST + c16 * 16) = pk[i]; }
#pragma unroll
        for (int i = 0; i < 2; ++i) { const int c = tid + NTHR * i, row = c >> 4, c16 = c & 15; const float wv = WSV[cc * 64 + row]; const u32x4 w = pv[i];
            u32x4 o; o.x = cvt_pk(bflo(w.x) * wv, bfhi(w.x) * wv); o.y = cvt_pk(bflo(w.y) * wv, bfhi(w.y) * wv); o.z = cvt_pk(bflo(w.z) * wv, bfhi(w.z) * wv); o.w = cvt_pk(bflo(w.w) * wv, bfhi(w.w) * wv);
            *(u32x4*)(vsm + row * VST + c16 * 16) = o; }
        if (cc + 1 < 31) { const int t1 = t0 + 64;
#pragma unroll
            for (int i = 0; i < 4; ++i) { const int c = tid + NTHR * i, row = c >> 5, c16 = c & 31; pk[i] = *(const u32x4*)(KC + (size_t)(t1 + row) * 1024 + h * 256 + c16 * 8); }
#pragma unroll
            for (int i = 0; i < 2; ++i) { const int c = tid + NTHR * i, row = c >> 4, c16 = c & 15; pv[i] = *(const u32x4*)(Mv + (size_t)(t1 + row) * 1024 + h * 256 + eh * 128 + c16 * 8); } }
        lds_barrier();
        const float decay = SCL[64 + cc];
#pragma unroll
        for (int et = 0; et < 4; ++et)
#pragma unroll
            for (int i = 0; i < 16; ++i) acc[et][i] *= decay;
#pragma unroll
        for (int i = 0; i < 16; ++i) accn[i] *= decay;
#pragma unroll
        for (int ks = 0; ks < 4; ++ks) {
            const bf16x8 bfr = tr_frag(ksm + kb_off + ks * 16 * KST, 4 * KST);
            {
                const f32x4 w0 = *(const f32x4*)(WSV + cc * 64 + ks * 16 + hh * 8), w1 = *(const f32x4*)(WSV + cc * 64 + ks * 16 + hh * 8 + 4);
                u32x4 wb; wb.x = cvt_pk(w0[0], w0[1]); wb.y = cvt_pk(w0[2], w0[3]); wb.z = cvt_pk(w1[0], w1[1]); wb.w = cvt_pk(w1[2], w1[3]);
                if (r != 0) wb = (u32x4){0u, 0u, 0u, 0u};
                accn = __builtin_amdgcn_mfma_f32_32x32x16_bf16(bfr, __builtin_bit_cast(bf16x8, wb), accn, 0, 0, 0); }
#pragma unroll
            for (int et = 0; et < 4; ++et) { const bf16x8 afr = tr_frag(vsm + vb_off + ks * 16 * VST + et * 64, 4 * VST);
                acc[et] = __builtin_amdgcn_mfma_f32_32x32x16_bf16(bfr, afr, acc[et], 0, 0, 0); }
        }
    }
}

__device__ __forceinline__ void mlstm_passB(const Params& p, unsigned char* lds, int unit) {
    const int tid = get_tid(), lane = tid & 63, wave = tid >> 6, r = lane & 31, hh = lane >> 5, li = lane & 15;
    const int b = unit >> 7, h = (unit >> 5) & 3, cc = unit & 31;
    unsigned char* ws = p.ws;
    const bf16_t* QC = (const bf16_t*)(ws + WS_QC); const bf16_t* KC = (const bf16_t*)(ws + WS_KC);
    const bf16_t* Mv = (const bf16_t*)(ws + WS_P + 5 * SEG_B); const bf16_t* Mo = (const bf16_t*)(ws + WS_P + 6 * SEG_B);
    const float* gate = (const float*)(ws + WS_GATE);
    const bf16_t* Cst = (const bf16_t*)(ws + WS_CST); const float* nst = (const float*)(ws + WS_NST); const float* mst = (const float*)(ws + WS_MST);
    bf16_t* Oc = (bf16_t*)(ws + WS_H);
    constexpr int QST = 528, VST = 544, WST = 144, HST = 1040;
    unsigned char* qsm = lds;
    unsigned char* ksm = qsm + 64 * QST;
    unsigned char* vsm = ksm + 64 * QST;
    unsigned char* wsm = vsm + 64 * VST;
    float* sc = (float*)(wsm + 64 * WST);
    float* hsm = (float*)lds;
    const int bhc = (b * 4 + h) * 32 + cc, t0 = b * S_ + cc * 64;
    __syncthreads();
    if (wave == 0) {
        const float ipre = gate[(size_t)(t0 + lane) * 16 + 8 + h] + p.m_ib[h], fpre = gate[(size_t)(t0 + lane) * 16 + 12 + h] + p.m_fb[h];
        float bc = logsig(fpre);
#pragma unroll
        for (int o = 1; o < 64; o <<= 1) { const float u = __shfl_up(bc, o); if (lane >= o) bc += u; }
        const float a = ipre - bc; float pm = a;
#pragma unroll
        for (int o = 1; o < 64; o <<= 1) { const float u = __shfl_up(pm, o); if (lane >= o) pm = fmaxf(pm, u); }
        const float mc = mst[bhc]; const float mt = bc + fmaxf(mc, pm);
        sc[lane] = bc - mt; sc[64 + lane] = a; sc[128 + lane] = mt; sc[192 + lane] = expf(bc + mc - mt);
    }
    bf16x8 cfr[16];
#pragma unroll
    for (int ks = 0; ks < 16; ++ks) cfr[ks] = *(const bf16x8*)(Cst + ((size_t)bhc * 256 + wave * 32 + r) * 256 + ks * 16 + hh * 8);
#pragma unroll
    for (int i = 0; i < 4; ++i) { const int c = tid + NTHR * i, row = c >> 5, c16 = c & 31;
        *(u32x4*)(qsm + row * QST + c16 * 16) = *(const u32x4*)(QC + (size_t)(t0 + row) * 1024 + h * 256 + c16 * 8);
        *(u32x4*)(ksm + row * QST + c16 * 16) = *(const u32x4*)(KC + (size_t)(t0 + row) * 1024 + h * 256 + c16 * 8);
        *(u32x4*)(vsm + row * VST + c16 * 16) = *(const u32x4*)(Mv + (size_t)(t0 + row) * 1024 + h * 256 + c16 * 8); }
    __syncthreads();
    if (wave < 3) {
        const int sb = wave >> 1, lb = wave ? 1 : 0;
        f32x16 s;
#pragma unroll
        for (int i = 0; i < 16; ++i) s[i] = 0.f;
#pragma unroll
        for (int ks = 0; ks < 16; ++ks) { const bf16x8 a = *(const bf16x8*)(ksm + (sb * 32 + r) * QST + ks * 32 + hh * 16), q = *(const bf16x8*)(qsm + (lb * 32 + r) * QST + ks * 32 + hh * 16);
            s = __builtin_amdgcn_mfma_f32_32x32x16_bf16(a, q, s, 0, 0, 0); }
        const int l = lb * 32 + r; const float bl = sc[l]; float rs = 0.f;
#pragma unroll
        for (int g = 0; g < 4; ++g) { float w[4];
#pragma unroll
            for (int e = 0; e < 4; ++e) { const int sI = sb * 32 + 8 * g + 4 * hh + e; w[e] = (sI <= l) ? s[4 * g + e] * __expf(bl + sc[64 + sI]) : 0.f; rs += w[e]; }
            u32x2 o; o.x = cvt_pk(w[0], w[1]); o.y = cvt_pk(w[2], w[3]);
            *(u32x2*)(wsm + l * WST + (sb * 32 + 8 * g + 4 * hh) * 2) = o; }
        sc[256 + l * 4 + sb * 2 + hh] = rs;
    } else if (wave == 3) {
        const int l = r;
#pragma unroll
        for (int g = 0; g < 4; ++g) { u32x2 o; o.x = 0u; o.y = 0u; *(u32x2*)(wsm + l * WST + (32 + 8 * g + 4 * hh) * 2) = o; }
        sc[256 + l * 4 + 2 + hh] = 0.f;
    }
    {
        const int l = tid & 63, part = tid >> 6; const float* np = nst + (size_t)bhc * 256 + part * 32; float s = 0.f;
#pragma unroll
        for (int q = 0; q < 4; ++q) { const u32x4 w = *(const u32x4*)(qsm + l * QST + part * 64 + q * 16);
            s += bflo(w.x) * np[8 * q] + bfhi(w.x) * np[8 * q + 1] + bflo(w.y) * np[8 * q + 2] + bfhi(w.y) * np[8 * q + 3] + bflo(w.z) * np[8 * q + 4] + bfhi(w.z) * np[8 * q + 5] + bflo(w.w) * np[8 * q + 6] + bfhi(w.w) * np[8 * q + 7]; }
        sc[512 + l * 8 + part] = s;
    }
    f32x16 acc[2];
#pragma unroll
    for (int lb = 0; lb < 2; ++lb)
#pragma unroll
        for (int i = 0; i < 16; ++i) acc[lb][i] = 0.f;
#pragma unroll
    for (int ks = 0; ks < 16; ++ks)
#pragma unroll
        for (int lb = 0; lb < 2; ++lb) { const bf16x8 q = *(const bf16x8*)(qsm + (lb * 32 + r) * QST + ks * 32 + hh * 16);
            acc[lb] = __builtin_amdgcn_mfma_f32_32x32x16_bf16(cfr[ks], q, acc[lb], 0, 0, 0); }
    __syncthreads();
#pragma unroll
    for (int lb = 0; lb < 2; ++lb) { const float it = sc[192 + lb * 32 + r];
#pragma unroll
        for (int i = 0; i < 16; ++i) acc[lb][i] *= it; }
    const int vb_off = (8 * hh + (li >> 2)) * VST + (wave * 32 + 16 * (r >> 4) + 4 * (li & 3)) * 2;
#pragma unroll
    for (int ks = 0; ks < 4; ++ks) { const bf16x8 afr = tr_frag(vsm + vb_off + ks * 16 * VST, 4 * VST);
#pragma unroll
        for (int lb = 0; lb < 2; ++lb) { if (lb == 0 && ks >= 2) continue;
            const bf16x8 wf = *(const bf16x8*)(wsm + (lb * 32 + r) * WST + ks * 32 + hh * 16);
            acc[lb] = __builtin_amdgcn_mfma_f32_32x32x16_bf16(afr, wf, acc[lb], 0, 0, 0); } }
    float ssq[2];
#pragma unroll
    for (int lb = 0; lb < 2; ++lb) { const int l = lb * 32 + r;
        const f32x4 rsv = *(const f32x4*)(sc + 256 + l * 4); const f32x4 q0 = *(const f32x4*)(sc + 512 + l * 8), q1 = *(const f32x4*)(sc + 512 + l * 8 + 4);
        const float den = (rsv[0] + rsv[1] + rsv[2] + rsv[3]) + sc[192 + l] * ((q0[0] + q0[1] + q0[2] + q0[3]) + (q1[0] + q1[1] + q1[2] + q1[3]));
        const float inv = 1.f / fmaxf(fabsf(den), __expf(-sc[128 + l]));
        float s2 = 0.f;
#pragma unroll
        for (int i = 0; i < 16; ++i) { acc[lb][i] *= inv; s2 += acc[lb][i] * acc[lb][i]; }
        s2 += __shfl_xor(s2, 32); ssq[lb] = s2; }
    __syncthreads();
    if (hh == 0) { sc[1024 + r * 8 + wave] = ssq[0]; sc[1024 + (32 + r) * 8 + wave] = ssq[1]; }
#pragma unroll
    for (int lb = 0; lb < 2; ++lb)
#pragma unroll
        for (int g = 0; g < 4; ++g) { f32x4 v; v[0] = acc[lb][4 * g]; v[1] = acc[lb][4 * g + 1]; v[2] = acc[lb][4 * g + 2]; v[3] = acc[lb][4 * g + 3];
            *(f32x4*)((unsigned char*)hsm + (lb * 32 + r) * HST + (wave * 32 + 8 * g + 4 * hh) * 4) = v; }
    __syncthreads();
#pragma unroll
    for (int i = 0; i < 4; ++i) { const int c = tid + NTHR * i, l = c >> 5, e0 = (c & 31) * 8;
        const f32x4 s0 = *(const f32x4*)(sc + 1024 + l * 8), s1 = *(const f32x4*)(sc + 1024 + l * 8 + 4);
        const float rr = rsqrtf(((s0[0] + s0[1] + s0[2] + s0[3]) + (s1[0] + s1[1] + s1[2] + s1[3])) * (1.f / 256.f) + EPS_);
        const f32x4 h0 = *(const f32x4*)((unsigned char*)hsm + l * HST + e0 * 4), h1 = *(const f32x4*)((unsigned char*)hsm + l * HST + e0 * 4 + 16);
        const f32x4 g0 = *(const f32x4*)(p.m_hg + h * 256 + e0), g1 = *(const f32x4*)(p.m_hg + h * 256 + e0 + 4);
        const u32x4 mo = *(const u32x4*)(Mo + (size_t)(t0 + l) * 1024 + h * 256 + e0);
        u32x4 o;
        o.x = cvt_pk(h0[0] * rr * g0[0] * sigm(bflo(mo.x)), h0[1] * rr * g0[1] * sigm(bfhi(mo.x))); o.y = cvt_pk(h0[2] * rr * g0[2] * sigm(bflo(mo.y)), h0[3] * rr * g0[3] * sigm(bfhi(mo.y)));
        o.z = cvt_pk(h1[0] * rr * g1[0] * sigm(bflo(mo.z)), h1[1] * rr * g1[1] * sigm(bfhi(mo.z))); o.w = cvt_pk(h1[2] * rr * g1[2] * sigm(bflo(mo.w)), h1[3] * rr * g1[3] * sigm(bfhi(mo.w)));
        *(u32x4*)(Oc + (size_t)(t0 + l) * D_ + 1024 + h * 256 + e0) = o; }
}

__device__ __forceinline__ void ce_desc(float& a, float& b) { const float hi = fmaxf(a, b), lo = fminf(a, b); a = hi; b = lo; }
__device__ __forceinline__ void sort16_desc(float (&v)[16]) {
#pragma unroll
    for (int k = 2; k <= 16; k <<= 1)
#pragma unroll
        for (int j = k >> 1; j > 0; j >>= 1)
#pragma unroll
            for (int i = 0; i < 16; ++i) { const int l = i ^ j; if (l > i) { if ((i & k) == 0) ce_desc(v[i], v[l]); else ce_desc(v[l], v[i]); } }
}
__device__ __forceinline__ void bmerge16_desc(float (&v)[16]) {
#pragma unroll
    for (int j = 8; j > 0; j >>= 1)
#pragma unroll
        for (int i = 0; i < 16; ++i) { const int l = i ^ j; if (l > i) ce_desc(v[i], v[l]); }
}
__device__ __forceinline__ void merge_top16(float (&a)[16], const float (&b)[16]) {
#pragma unroll
    for (int i = 0; i < 16; ++i) a[i] = fmaxf(a[i], b[15 - i]);
    bmerge16_desc(a);
}
__device__ __forceinline__ float pack_idx(float v, unsigned mask, unsigned idx) { return __builtin_bit_cast(float, (__builtin_bit_cast(unsigned, v) & mask) | idx); }
__device__ __forceinline__ void top16_from_acc(const f32x16 (&acc)[4], int h, float (&out)[16]) {
    float g[4][16];
#pragma unroll
    for (int mt = 0; mt < 4; ++mt) {
#pragma unroll
        for (int i = 0; i < 16; ++i) g[mt][i] = pack_idx(acc[mt][i], 0xffffff80u, (unsigned)(32 * mt + (i & 3) + 8 * (i >> 2)) | ((unsigned)h << 2));
        sort16_desc(g[mt]);
    }
    merge_top16(g[0], g[1]); merge_top16(g[2], g[3]); merge_top16(g[0], g[2]);
    float o[16];
#pragma unroll
    for (int i = 0; i < 16; ++i) o[i] = __shfl_xor(g[0][i], 32);
    merge_top16(g[0], o);
#pragma unroll
    for (int i = 0; i < 16; ++i) out[i] = g[0][i];
}
__device__ __forceinline__ unsigned lut16(const unsigned (&P)[4], unsigned i) {
    const unsigned long long lo = (unsigned long long)P[0] | ((unsigned long long)P[1] << 32), hi = (unsigned long long)P[2] | ((unsigned long long)P[3] << 32);
    const unsigned long long s = (i & 8u) ? hi : lo;
    return (unsigned)(s >> ((i & 7u) * 8u)) & 0xffu;
}
struct CandTab { int i[50]; int j[50]; };
constexpr CandTab make_cand_tab() { CandTab t{}; int n = 0; for (int i = 0; i < 16; ++i) for (int j = 0; j < 16; ++j) if ((i + 1) * (j + 1) <= 16) { t.i[n] = i; t.j[n] = j; ++n; } return t; }
__device__ __forceinline__ void phase_topk(const Params& p, unsigned char* lds, int bid, int nb) {
    const int tid = get_tid(), lane = tid & 63, wave = tid >> 6, r = lane & 31, h = lane >> 5;
    unsigned char* ws = p.ws;
    const bf16_t* Q = (const bf16_t*)(ws + WS_Q); int* IDX = (int*)(ws + WS_IDX); float* GW = (float*)(ws + WS_GW);
    constexpr int KP = 136;
    bf16_t* KS = (bf16_t*)lds;
    for (int i = tid; i < 2 * 16384; i += NTHR) { const int which = i >> 14, n = (i >> 7) & 127, d = i & 127; const float v = (which ? p.sk2 : p.sk1)[i & 16383];
        const unsigned hb = cvt_pk(v, 0.f) & 0xffffu; const float lo = v - bf2f((bf16_t)hb);
        KS[((which * 2 + 0) * 128 + n) * KP + d] = (bf16_t)hb; KS[((which * 2 + 1) * 128 + n) * KP + d] = (bf16_t)(cvt_pk(lo, 0.f) & 0xffffu); }
    __syncthreads();
    for (int item = bid * 8 + wave; item < 512 * 8; item += nb * 8) {
        const int tt = item >> 3, hh = item & 7, t = tt * 32 + r;
        float top[2][16];
#pragma unroll
        for (int list = 0; list < 2; ++list) {
            bf16x8 qf[8];
#pragma unroll
            for (int ks = 0; ks < 8; ++ks) qf[ks] = *(const bf16x8*)(Q + (size_t)t * D_ + hh * 256 + list * 128 + ks * 16 + h * 8);
            float g[4][16];
#pragma unroll
            for (int mt = 0; mt < 4; ++mt) {
                f32x16 acc;
#pragma unroll
                for (int i = 0; i < 16; ++i) acc[i] = 0.f;
#pragma unroll
                for (int hl = 0; hl < 2; ++hl)
#pragma unroll
                    for (int ks = 0; ks < 8; ++ks) { const bf16x8 a = *(const bf16x8*)(KS + ((list * 2 + hl) * 128 + mt * 32 + r) * KP + ks * 16 + h * 8);
                        acc = __builtin_amdgcn_mfma_f32_32x32x16_bf16(a, qf[ks], acc, 0, 0, 0); }
#pragma unroll
                for (int i = 0; i < 16; ++i) g[mt][i] = pack_idx(acc[i], 0xffffff80u, (unsigned)(32 * mt + (i & 3) + 8 * (i >> 2)) | ((unsigned)h << 2));
                sort16_desc(g[mt]);
                __builtin_amdgcn_sched_barrier(0);
            }
            merge_top16(g[0], g[1]); merge_top16(g[2], g[3]); merge_top16(g[0], g[2]);
            {   float o[16];
#pragma unroll
                for (int i = 0; i < 16; ++i) o[i] = __shfl_xor(g[0][i], 32);
                merge_top16(g[0], o); }
#pragma unroll
            for (int i = 0; i < 16; ++i) top[list][i] = g[0][i];
            __builtin_amdgcn_sched_barrier(0);
        }
        unsigned P1[4], P2[4];
#pragma unroll
        for (int q = 0; q < 4; ++q) { P1[q] = 0u; P2[q] = 0u;
#pragma unroll
            for (int e = 0; e < 4; ++e) { P1[q] |= (__builtin_bit_cast(unsigned, top[0][4 * q + e]) & 127u) << (8 * e); P2[q] |= (__builtin_bit_cast(unsigned, top[1][4 * q + e]) & 127u) << (8 * e); } }
        float c[4][16];
#pragma unroll
        for (int n = 0; n < 64; ++n) {
            if (n < 50) { constexpr CandTab CT = make_cand_tab(); const int i = CT.i[n], j = CT.j[n];
                c[n >> 4][n & 15] = pack_idx(top[0][i] + top[1][j], 0xffffff00u, (unsigned)(i * 16 + j)); }
            else c[n >> 4][n & 15] = -INFINITY;
        }
        sort16_desc(c[0]); __builtin_amdgcn_sched_barrier(0); sort16_desc(c[1]); __builtin_amdgcn_sched_barrier(0); merge_top16(c[0], c[1]); __builtin_amdgcn_sched_barrier(0);
        sort16_desc(c[2]); __builtin_amdgcn_sched_barrier(0); sort16_desc(c[3]); __builtin_amdgcn_sched_barrier(0); merge_top16(c[2], c[3]); __builtin_amdgcn_sched_barrier(0); merge_top16(c[0], c[2]);
        float ex[16], sum = 0.f;
#pragma unroll
        for (int k = 0; k < 16; ++k) { ex[k] = __expf(c[0][k] - c[0][0]); sum += ex[k]; }
        const float inv = 1.f / sum;
        if (h == 0) {
            int* ip = IDX + (size_t)t * 128 + hh * 16; float* gp = GW + (size_t)t * 128 + hh * 16;
#pragma unroll
            for (int q = 0; q < 4; ++q) { u32x4 iv; f32x4 gv;
#pragma unroll
                for (int e = 0; e < 4; ++e) { const unsigned pos = __builtin_bit_cast(unsigned, c[0][4 * q + e]) & 255u;
                    iv[e] = lut16(P1, pos >> 4) * 128u + lut16(P2, pos & 15u); gv[e] = ex[4 * q + e] * inv; }
                *(u32x4*)(ip + 4 * q) = iv; *(f32x4*)(gp + 4 * q) = gv; }
        }
    }
}

typedef float f32x2 __attribute__((ext_vector_type(2)));
__device__ __forceinline__ float dot16_fp8(const u32x4 w, const float (&h)[32], int o) {
    float s = 0.f;
#pragma unroll
    for (int q = 0; q < 4; ++q) { const f32x2 lo = __builtin_amdgcn_cvt_pk_f32_fp8((int)w[q], false), hi = __builtin_amdgcn_cvt_pk_f32_fp8((int)w[q], true);
        fmac(s, lo[0], h[o + 4 * q]); fmac(s, lo[1], h[o + 4 * q + 1]); fmac(s, hi[0], h[o + 4 * q + 2]); fmac(s, hi[1], h[o + 4 * q + 3]); }
    return s;
}
template <int CTRL, int ROW_MASK, int BANK_MASK>
__device__ __forceinline__ int dpp_mov0i(int v) { return __builtin_amdgcn_update_dpp(0, v, CTRL, ROW_MASK, BANK_MASK, true); }
__device__ __forceinline__ void quant_row_i8(const bf16_t* hp, int c16, unsigned (&hq)[32], float& hsc) {
    float mx = 0.f;
#pragma unroll
    for (int i = 0; i < 16; ++i) { const u32x4 w = *(const u32x4*)(hp + 256 * (i >> 1) + 8 * (i & 1));
#pragma unroll
        for (int e = 0; e < 4; ++e) mx = fmaxf(mx, fmaxf(fabsf(bflo(w[e])), fabsf(bfhi(w[e])))); }
    mx = fmaxf(mx, __shfl_xor(mx, 1)); mx = fmaxf(mx, __shfl_xor(mx, 2)); mx = fmaxf(mx, __shfl_xor(mx, 4)); mx = fmaxf(mx, __shfl_xor(mx, 8));
    mx = fmaxf(mx, 1e-30f); const float inv = 127.f / mx; hsc = mx * (1.f / 127.f);
    asm volatile("" ::: "memory");
#pragma unroll
    for (int i = 0; i < 16; ++i) { const u32x4 w = *(const u32x4*)(hp + 256 * (i >> 1) + 8 * (i & 1));
#pragma unroll
        for (int hh = 0; hh < 2; ++hh) { const unsigned w0 = w[2 * hh], w1 = w[2 * hh + 1];
            hq[2 * i + hh] = ((unsigned)__float2int_rn(bflo(w0) * inv) & 0xffu) | (((unsigned)__float2int_rn(bfhi(w0) * inv) & 0xffu) << 8) | (((unsigned)__float2int_rn(bflo(w1) * inv) & 0xffu) << 16) | (((unsigned)__float2int_rn(bfhi(w1) * inv) & 0xffu) << 24); } }
}
__device__ __forceinline__ void phase_peer1(const Params& p, unsigned char* lds, int bid, int nb, int probe) {
    const int tid = get_tid(), lane = tid & 63, wave = tid >> 6, r = lane >> 4, c16 = lane & 15;
    unsigned char* ws = p.ws;
    const bf16_t* H2 = (const bf16_t*)(ws + WS_H2); const int* IDX = (const int*)(ws + WS_IDX); const float* GW = (const float*)(ws + WS_GW);
    unsigned* EWT = (unsigned*)(ws + WS_EWT); const float* DSC = (const float*)(ws + WS_DSC);
    const unsigned char* E8D = ws + WS_E8D + 16 * c16; const unsigned emask = probe ? 0x3ffu : 0x3fffu;
    LAS unsigned* seq = (LAS unsigned*)((LAS unsigned char*)lds + (wave * 4 + r) * 1024);
    LAS unsigned* hist = (LAS unsigned*)((LAS unsigned char*)lds + 32768 + (wave * 4 + r) * 128);
    for (int tile = bid; tile < 256; tile += nb) {
        const int tA = tile * 64 + wave * 4 + r, tB = tA + 32;
        unsigned hqA[32], hqB[32]; float hscA, hscB;
        quant_row_i8(H2 + (size_t)tA * D_ + 16 * c16, c16, hqA, hscA);
        quant_row_i8(H2 + (size_t)tB * D_ + 16 * c16, c16, hqB, hscB);
        unsigned ppA0, ppA1, ppB0, ppB1;
        {   int idx[16]; unsigned pos[16];
#pragma unroll
            for (int m = 0; m < 8; ++m) { idx[m] = IDX[(size_t)tA * 128 + c16 + 16 * m]; idx[8 + m] = IDX[(size_t)tB * 128 + c16 + 16 * m]; }
            hist[c16] = 0u;
#pragma unroll
            for (int m = 0; m < 16; ++m) pos[m] = __hip_atomic_fetch_add(&hist[idx[m] >> 10], 1u, __ATOMIC_RELAXED, __HIP_MEMORY_SCOPE_WORKGROUP);
            {   const unsigned c = hist[c16]; unsigned inc = c;
#pragma unroll
                for (int o = 1; o < 16; o <<= 1) { const unsigned u = __shfl_up(inc, o, 16); if (c16 >= o) inc += u; }
                hist[c16] = inc - c; }
#pragma unroll
            for (int m = 0; m < 16; ++m) { pos[m] += hist[idx[m] >> 10]; seq[pos[m]] = (unsigned)idx[m] | ((unsigned)(c16 + 16 * (m & 7)) << 14) | ((unsigned)(m >> 3) << 21); }
            ppA0 = pos[0] | (pos[1] << 8) | (pos[2] << 16) | (pos[3] << 24); ppA1 = pos[4] | (pos[5] << 8) | (pos[6] << 16) | (pos[7] << 24);
            ppB0 = pos[8] | (pos[9] << 8) | (pos[10] << 16) | (pos[11] << 24); ppB1 = pos[12] | (pos[13] << 8) | (pos[14] << 16) | (pos[15] << 24);
        }
        u32x4 cur[8], nxt[8]; unsigned ecur = seq[0], enxt = 0u;
        {   const unsigned char* rp = E8D + (size_t)(ecur & emask) * 2048;
#pragma unroll
            for (int q = 0; q < 8; ++q) cur[q] = *(const u32x4*)(rp + 256 * q); }
        for (int s = 0; s < 256; ++s) {
            if (s + 1 < 256) { enxt = seq[s + 1]; const unsigned char* rp = E8D + (size_t)(enxt & emask) * 2048;
#pragma unroll
                for (int q = 0; q < 8; ++q) nxt[q] = *(const u32x4*)(rp + 256 * q); }
            int a0 = 0, a1 = 0, b0 = 0, b1 = 0;
#pragma unroll
            for (int q = 0; q < 8; ++q) {
                a0 = __builtin_amdgcn_sdot4((int)cur[q][0], (int)hqA[4 * q], a0, false); a1 = __builtin_amdgcn_sdot4((int)cur[q][1], (int)hqA[4 * q + 1], a1, false);
                a0 = __builtin_amdgcn_sdot4((int)cur[q][2], (int)hqA[4 * q + 2], a0, false); a1 = __builtin_amdgcn_sdot4((int)cur[q][3], (int)hqA[4 * q + 3], a1, false);
                b0 = __builtin_amdgcn_sdot4((int)cur[q][0], (int)hqB[4 * q], b0, false); b1 = __builtin_amdgcn_sdot4((int)cur[q][1], (int)hqB[4 * q + 1], b1, false);
                b0 = __builtin_amdgcn_sdot4((int)cur[q][2], (int)hqB[4 * q + 2], b0, false); b1 = __builtin_amdgcn_sdot4((int)cur[q][3], (int)hqB[4 * q + 3], b1, false); }
            int d = ((ecur >> 21) & 1u) ? (b0 + b1) : (a0 + a1);
            d += dpp_mov0i<0x111, 0xf, 0xf>(d); d += dpp_mov0i<0x112, 0xf, 0xf>(d); d += dpp_mov0i<0x114, 0xf, 0xe>(d); d += dpp_mov0i<0x118, 0xf, 0xc>(d);
            if (c16 == 15) seq[s] = (unsigned)d;
#pragma unroll
            for (int q = 0; q < 8; ++q) cur[q] = nxt[q];
            ecur = enxt;
        }
        if (probe) continue;
#pragma unroll
        for (int tk = 0; tk < 2; ++tk) {
            const int t = tk ? tB : tA; const float hsc = tk ? hscB : hscA;
            unsigned* ep = EWT + (size_t)(t >> 6) * 8192 + (t & 63) * 4;
#pragma unroll
            for (int m = 0; m < 8; ++m) { const int j = c16 + 16 * m; const int ix = IDX[(size_t)t * 128 + j];
                const unsigned ps = ((tk ? (m < 4 ? ppB0 : ppB1) : (m < 4 ? ppA0 : ppA1)) >> (8 * (m & 3))) & 0xffu;
                const float a = (float)(int)seq[ps] * hsc * DSC[ix];
                const float w = GW[(size_t)t * 128 + j] * 0.5f * a * (1.f + erff(a * 0.7071067811865476f));
                ep[(j >> 2) * 256 + (j & 3)] = (cvt_pk(0.f, w) & 0xffff0000u) | (unsigned)ix; }
        }
    }
}
__device__ __forceinline__ void phase_peer2(const Params& p, unsigned char* lds, int bid, int nb) {
    const int tid = get_tid(), lane = tid & 63, wave = tid >> 6;
    unsigned char* ws = p.ws;
    const unsigned* EWT = (const unsigned*)(ws + WS_EWT); const bf16_t* Y = (const bf16_t*)(ws + WS_X1); const float* mod = (const float*)(ws + WS_MOD);
    for (int si = bid; si < 256; si += nb) {
        const int s = (si & 7) * 32 + (si >> 3);
        __syncthreads();
        {   const u32x4* sp = (const u32x4*)(ws + WS_E8U + (size_t)s * 131072);
#pragma unroll
            for (int i = 0; i < 16; ++i) ((u32x4*)lds)[tid + NTHR * i] = sp[tid + NTHR * i]; }
        __syncthreads();
        const int tb0 = ((si >> 5) * 32 + wave) & 255;
        unsigned cur[16], nxt[16];
        {   const u32x4* wp = (const u32x4*)(EWT + (size_t)tb0 * 8192) + lane;
#pragma unroll
            for (int u = 0; u < 4; ++u) { const u32x4 v = wp[u * 64]; cur[4 * u] = v.x; cur[4 * u + 1] = v.y; cur[4 * u + 2] = v.z; cur[4 * u + 3] = v.w; } }
        float acc[8];
#pragma unroll
        for (int c = 0; c < 8; ++c) acc[c] = 0.f;
        f32x4 xa = {0.f, 0.f, 0.f, 0.f}, xb = xa;
        for (int q = 0; q < 256; ++q) {
            const int tb = (tb0 + 8 * (q >> 3)) & 255, g = q & 7;
            if (q + 1 < 256) { const int tbn = (tb0 + 8 * ((q + 1) >> 3)) & 255; const u32x4* wp = (const u32x4*)(EWT + (size_t)tbn * 8192 + ((q + 1) & 7) * 1024) + lane;
#pragma unroll
                for (int u = 0; u < 4; ++u) { const u32x4 v = wp[u * 64]; nxt[4 * u] = v.x; nxt[4 * u + 1] = v.y; nxt[4 * u + 2] = v.z; nxt[4 * u + 3] = v.w; } }
            const int t = tb * 64 + lane;
            if (g == 0) { xa = *(const f32x4*)(p.x + (size_t)t * D_ + 8 * s); xb = *(const f32x4*)(p.x + (size_t)t * D_ + 8 * s + 4);
                const u32x4 yw = *(const u32x4*)(Y + (size_t)t * D_ + 8 * s); const float* g1 = mod + (size_t)(t >> 11) * NMOD + 2 * D_ + 8 * s; const f32x4 ha = *(const f32x4*)g1, hb = *(const f32x4*)(g1 + 4);
                xa[0] += ha[0] * bflo(yw.x); xa[1] += ha[1] * bfhi(yw.x); xa[2] += ha[2] * bflo(yw.y); xa[3] += ha[3] * bfhi(yw.y); xb[0] += hb[0] * bflo(yw.z); xb[1] += hb[1] * bfhi(yw.z); xb[2] += hb[2] * bflo(yw.w); xb[3] += hb[3] * bfhi(yw.w); }
            u32x2 row[16];
#pragma unroll
            for (int u = 0; u < 16; ++u) row[u] = *(const LAS u32x2*)(unsigned)((cur[u] << 3) & 0x1fff8u);
#pragma unroll
            for (int u = 0; u < 16; ++u) {
                const float w = __builtin_bit_cast(float, cur[u]);
                const f32x2 v0 = __builtin_amdgcn_cvt_pk_f32_fp8((int)row[u].x, false), v1 = __builtin_amdgcn_cvt_pk_f32_fp8((int)row[u].x, true), v2 = __builtin_amdgcn_cvt_pk_f32_fp8((int)row[u].y, false), v3 = __builtin_amdgcn_cvt_pk_f32_fp8((int)row[u].y, true);
                fmac(acc[0], w, v0[0]); fmac(acc[1], w, v0[1]); fmac(acc[2], w, v1[0]); fmac(acc[3], w, v1[1]); fmac(acc[4], w, v2[0]); fmac(acc[5], w, v2[1]); fmac(acc[6], w, v3[0]); fmac(acc[7], w, v3[1]);
            }
            if (g == 7) {
                const float* g2 = mod + (size_t)(t >> 11) * NMOD + 5 * D_ + 8 * s;
                const f32x4 ga = *(const f32x4*)g2, gb = *(const f32x4*)(g2 + 4);
                f32x4 oa, ob;
#pragma unroll
                for (int c = 0; c < 4; ++c) { oa[c] = xa[c] + ga[c] * acc[c] * (1.f / 32.f); ob[c] = xb[c] + gb[c] * acc[4 + c] * (1.f / 32.f); }
                *(f32x4*)(p.out + (size_t)t * D_ + 8 * s) = oa; *(f32x4*)(p.out + (size_t)t * D_ + 8 * s + 4) = ob;
#pragma unroll
                for (int c = 0; c < 8; ++c) acc[c] = 0.f;
            }
#pragma unroll
            for (int u = 0; u < 16; ++u) cur[u] = nxt[u];
        }
    }
}

typedef const __attribute__((address_space(4))) Params* KargPtr;
__device__ __forceinline__ Params load_params() {
#if defined(__HIP_DEVICE_COMPILE__)
    KargPtr kp = (KargPtr)__builtin_amdgcn_kernarg_segment_ptr(); asm volatile("" : "+s"(kp)); Params r; __builtin_memcpy(&r, kp, sizeof(Params)); return r;
#else
    return Params{};
#endif
}
constexpr int N_PHASES = 12;
constexpr int LDS_BYTES = 152 * 1024;
__global__ void __launch_bounds__(NTHR) fwd_kernel(Params p_arg) {
    extern __shared__ __attribute__((aligned(16))) unsigned char lds[];
    const int bid = blockIdx.x, nb = gridDim.x, tid = get_tid();
    unsigned char* ws = p_arg.ws;
    volatile LAS unsigned* xbst = (volatile LAS unsigned*)((LAS unsigned char*)lds + LDS_BYTES - 16);
    if (tid == 0) { xbst[0] = 0u; xbst[1] = 0u; xbst[2] = 0u; xbst[3] = 0u; }
    __syncthreads();
    if ((p_arg.ph_hi - p_arg.ph_lo) > 1) (void)xcd_barrier_post((unsigned*)(ws + WS_BAR), xbst);
#ifdef ONLY_PHASE
#define IN(k) ((k) == ONLY_PHASE && p.ph_lo <= (k) && (k) < p.ph_hi)
#else
#define IN(k) (p.ph_lo <= (k) && (k) < p.ph_hi)
#endif
#define SEAM(k) do { const Params p = load_params(); if (p.ph_lo <= (k) && (k) + 1 < p.ph_hi) { XcdBarrier bar; bar.bar = (unsigned*)(p.ws + WS_BAR); bar.x = xb_xcc_id(); bar.st = xbst; xcd_barrier(bar); } } while (0)
#ifndef REPEAT_MASK
#define REPEAT_MASK 0
#endif
#define REP(k) for (int rep_ = 0; rep_ < (((REPEAT_MASK) >> (k)) & 1) + 1; ++rep_)
    REP(0) { const Params p = load_params(); if (IN(0)) { unsigned char* ws = p.ws; const float* mod = (const float*)(ws + WS_MOD); (void)mod;
        phase_prep(p, lds, bid, nb);
    } }
    SEAM(0);
    REP(1) { const Params p = load_params(); if (IN(1)) { unsigned char* ws = p.ws; const float* mod = (const float*)(ws + WS_MOD); (void)mod;
        phase_norm<false>(p.x, nullptr, 0, p.g1, mod, 0, D_, (bf16_t*)(ws + WS_H), bid, nb);
    } }
    SEAM(1);
    REP(2) { const Params p = load_params(); if (IN(2)) { unsigned char* ws = p.ws; const float* mod = (const float*)(ws + WS_MOD); (void)mod;
        phase_gates(p, lds, bid, nb);
        { pg8::Gemm g{(const bf16_t*)(ws + WS_H), (const bf16_t*)(ws + WS_WINT), T_, 7168, D_}; pg8::StaticOrder S; S.init(T_, 7168, nb, bid);
        pg8::EpiSeg E{(bf16_t*)(ws + WS_P)}; pg8::gemm_phase<pg8::EpiSeg, pg8::StaticOrder, true, true>((LAS unsigned char*)lds, g, S, E); }
    } }
    SEAM(2);
    REP(3) { const Params p = load_params(); if (IN(3)) { unsigned char* ws = p.ws; const float* mod = (const float*)(ws + WS_MOD); (void)mod;
        phase_post(p, bid, nb);
    } }
    SEAM(3);
    REP(4) { const Params p = load_params(); if (IN(4)) { unsigned char* ws = p.ws; const float* mod = (const float*)(ws + WS_MOD); (void)mod;
        { for (int u = bid; u < 64; u += nb) mlstm_passA(p, lds, u);
        unsigned* qctr = (unsigned*)(ws + WS_QCTR) + rep_; LAS int* slot = (LAS int*)((LAS unsigned char*)lds + LDS_BYTES - 32);
        for (;;) { __syncthreads(); if (tid == 0) *slot = (int)atomicAdd(qctr, 1u); __syncthreads(); const int u = *slot; if (u >= 512) break;
            const int bh = u & 63; fox_unit(p, lds, bh >> 3, bh & 7, 7 - (u >> 6)); } }
    } }
    SEAM(4);
    REP(5) { const Params p = load_params(); if (IN(5)) { unsigned char* ws = p.ws; const float* mod = (const float*)(ws + WS_MOD); (void)mod;
        { for (int u = bid; u < 1024; u += nb) mlstm_passB(p, lds, u); }
    } }
    SEAM(5);
    REP(6) { const Params p = load_params(); if (IN(6)) { unsigned char* ws = p.ws; const float* mod = (const float*)(ws + WS_MOD); (void)mod;
        { pg8::Gemm g{(const bf16_t*)(ws + WS_H), (const bf16_t*)(ws + WS_WOT), T_, D_, D_}; pg8::StaticOrder S; S.init(T_, D_, nb, bid);
        pg8::EpiBf E{(bf16_t*)(ws + WS_X1), D_}; pg8::gemm_phase<pg8::EpiBf, pg8::StaticOrder, true, true>((LAS unsigned char*)lds, g, S, E); }
    } }
    SEAM(6);
    REP(7) { const Params p = load_params(); if (IN(7)) { unsigned char* ws = p.ws; const float* mod = (const float*)(ws + WS_MOD); (void)mod;
        convert_experts(p, bid, nb);
    } }
    REP(7) { const Params p = load_params(); if (IN(7)) { unsigned char* ws = p.ws; const float* mod = (const float*)(ws + WS_MOD); (void)mod;
        phase_norm<true>(p.x, (const bf16_t*)(ws + WS_X1), 2 * D_, p.g2, mod, 3 * D_, 4 * D_, (bf16_t*)(ws + WS_H2), bid, nb);
    } }
    SEAM(7);
    REP(8) { const Params p = load_params(); if (IN(8)) { unsigned char* ws = p.ws; const float* mod = (const float*)(ws + WS_MOD); (void)mod;
        { pg8::Gemm g{(const bf16_t*)(ws + WS_H2), (const bf16_t*)(ws + WS_WQT), T_, D_, D_}; pg8::StaticOrder S; S.init(T_, D_, nb, bid);
        pg8::EpiBf E{(bf16_t*)(ws + WS_Q), D_}; pg8::gemm_phase<pg8::EpiBf, pg8::StaticOrder, true, true>((LAS unsigned char*)lds, g, S, E); }
    } }
    SEAM(8);
    REP(9) { const Params p = load_params(); if (IN(9)) { unsigned char* ws = p.ws; const float* mod = (const float*)(ws + WS_MOD); (void)mod;
        phase_topk(p, lds, bid, nb);
    } }
    SEAM(9);
    REP(10) { const Params p = load_params(); if (IN(10)) { unsigned char* ws = p.ws; const float* mod = (const float*)(ws + WS_MOD); (void)mod;
#ifdef PROBE_L2
        phase_peer1(p, lds, bid, nb, rep_);
#else
        phase_peer1(p, lds, bid, nb, 0);
#endif
    } }
    SEAM(10);
    REP(11) { const Params p = load_params(); if (IN(11)) { unsigned char* ws = p.ws; const float* mod = (const float*)(ws + WS_MOD); (void)mod;
        phase_peer2(p, lds, bid, nb);
    } }
#undef IN
#undef SEAM
}

#ifndef ONE_LAUNCH
#define ONE_LAUNCH 1
#endif
extern "C" void kernel_launch(void* const* d_in, const int* in_sizes, int n_in, void* d_out, int out_size, void* d_ws, size_t ws_size, hipStream_t stream) {
    static int grid = 0;
    if (grid == 0) {
        int dev = 0, cus = 0, per_cu = 0;
        if (n_in != 21 || ws_size < WS_END) { fprintf(stderr, "kernel_launch: unexpected n_in %d / ws_size %zu (need %zu)\n", n_in, ws_size, (size_t)WS_END); grid = -1; return; }
        hipGetDevice(&dev); hipDeviceGetAttribute(&cus, hipDeviceAttributeMultiprocessorCount, dev);
        if (hipFuncSetAttribute((const void*)fwd_kernel, hipFuncAttributeMaxDynamicSharedMemorySize, LDS_BYTES) != hipSuccess) { fprintf(stderr, "kernel_launch: hipFuncSetAttribute failed\n"); grid = -1; return; }
        if (hipOccupancyMaxActiveBlocksPerMultiprocessor(&per_cu, (const void*)fwd_kernel, NTHR, LDS_BYTES) != hipSuccess || per_cu < 1) { fprintf(stderr, "kernel_launch: occupancy query says %d\n", per_cu); (void)hipGetLastError(); }
        grid = cus > 0 ? cus : 256;
    }
    if (grid < 0) return;
    Params p{};
    const float** pp = (const float**)&p;
    for (int i = 0; i < 21; ++i) pp[i] = (const float*)d_in[i];
    p.out = (float*)d_out; p.ws = (unsigned char*)d_ws;
    hipMemsetAsync((char*)d_ws + WS_BAR, 0, 16384, stream);
#if ONE_LAUNCH
    p.ph_lo = 0; p.ph_hi = N_PHASES;
    void* args[] = {&p};
    hipError_t e = hipLaunchCooperativeKernel((const void*)fwd_kernel, dim3(grid), dim3(NTHR), args, LDS_BYTES, stream);
    if (e != hipSuccess) fprintf(stderr, "cooperative launch failed: %s (grid %d)\n", hipGetErrorString(e), grid);
#else
    for (int ph = 0; ph < N_PHASES; ++ph) { p.ph_lo = ph; p.ph_hi = ph + 1; hipLaunchKernelGGL(fwd_kernel, dim3(grid), dim3(NTHR), LDS_BYTES, stream, p); }
#endif
}
```

```cpp
#include <hip/hip_runtime.h>
#include <cstdio>
#include <cstdint>

#define GAS __attribute__((address_space(1)))
#define LAS __attribute__((address_space(3)))
typedef unsigned short bf16_t;
typedef short bf16x8 __attribute__((ext_vector_type(8)));
typedef float f32x4 __attribute__((ext_vector_type(4)));
typedef float f32x16 __attribute__((ext_vector_type(16)));
typedef unsigned u32x4 __attribute__((ext_vector_type(4)));
typedef unsigned u32x2 __attribute__((ext_vector_type(2)));

constexpr int T_ = 16384, D_ = 2048, B_ = 8, S_ = 2048, NTHR = 512;
constexpr float EPS_ = 1e-6f;
constexpr int NMOD = 6 * D_;
constexpr int INCOLS = 7184;

constexpr size_t WS_BAR   = 0;
constexpr size_t WS_MOD   = 16384;
constexpr size_t WS_WG    = WS_MOD + (size_t)B_ * NMOD * 4;
constexpr size_t WS_GATE  = WS_WG + 16 * 2048 * 4;
constexpr size_t WS_F     = WS_GATE + (size_t)T_ * 16 * 4;
constexpr size_t WS_NST   = WS_F + 64 * 2048 * 4;
constexpr size_t WS_MST   = WS_NST + 1024 * 256 * 4;
constexpr size_t WS_DSC   = WS_MST + 4096;
constexpr size_t WS_WINT  = WS_DSC + 16384 * 4;
constexpr size_t WS_WOT   = WS_WINT + (size_t)7168 * 2048 * 2;
constexpr size_t WS_WQT   = WS_WOT + (size_t)2048 * 2048 * 2;
constexpr size_t WS_H     = WS_WQT + (size_t)2048 * 2048 * 2;
constexpr size_t WS_P     = WS_H + (size_t)T_ * 2048 * 2;
constexpr size_t SEG_B    = (size_t)T_ * 1024 * 2;
constexpr size_t WS_CST   = WS_P + 7 * SEG_B;
constexpr size_t WS_E8D   = WS_CST + (size_t)1024 * 256 * 256 * 2;
constexpr size_t WS_E8U   = WS_E8D + (size_t)16384 * 2048;
constexpr size_t WS_END   = WS_E8U + (size_t)16384 * 2048;
constexpr size_t WS_QC    = WS_E8D;
constexpr size_t WS_KC    = WS_E8U;
constexpr size_t WS_QCTR  = 15360;
constexpr size_t WS_H2    = WS_P;
constexpr size_t WS_Q     = WS_H2 + (size_t)T_ * 2048 * 2;
constexpr size_t WS_IDX   = WS_Q + (size_t)T_ * 2048 * 2;
constexpr size_t WS_GW    = WS_IDX + (size_t)T_ * 128 * 4;
static_assert(WS_GW + (size_t)T_ * 128 * 4 <= WS_CST, "alias overflow");
constexpr size_t WS_X1    = WS_CST;
constexpr size_t WS_EWT   = WS_GW + (size_t)T_ * 128 * 4;
static_assert(WS_EWT + (size_t)T_ * 128 * 4 <= WS_CST, "alias overflow 2");

struct Params {
    const float *x, *c, *w_ada, *b_ada, *g1, *g2, *w_in, *fox_fb, *fox_qg, *fox_kg, *conv_w, *conv_b, *m_ib, *m_fb, *m_hg, *w_out, *w_q, *sk1, *sk2, *e_down, *e_up;
    float* out; unsigned char* ws; int ph_lo, ph_hi;
};

__device__ __forceinline__ int get_tid() { int t = threadIdx.x; asm volatile("" : "+v"(t)); return t; }
__device__ __forceinline__ void lds_barrier() { asm volatile("s_waitcnt lgkmcnt(0)\n\ts_barrier" ::: "memory"); }
__device__ __forceinline__ unsigned cvt_pk(float lo, float hi) { unsigned r; asm("v_cvt_pk_bf16_f32 %0, %1, %2" : "=v"(r) : "v"(lo), "v"(hi)); return r; }
__device__ __forceinline__ void fmac(float& acc, float a, float b) { asm("v_fmac_f32 %0, %1, %2" : "+v"(acc) : "v"(a), "v"(b)); }
__device__ __forceinline__ float bf2f(unsigned short h) { return __builtin_bit_cast(float, ((unsigned)h) << 16); }
__device__ __forceinline__ float bflo(unsigned w) { return __builtin_bit_cast(float, w << 16); }
__device__ __forceinline__ float bfhi(unsigned w) { return __builtin_bit_cast(float, w & 0xffff0000u); }
__device__ __forceinline__ float wsum(float v) {
#pragma unroll
    for (int o = 32; o; o >>= 1) v += __shfl_xor(v, o);
    return v; }
__device__ __forceinline__ float wmax(float v) {
#pragma unroll
    for (int o = 32; o; o >>= 1) v = fmaxf(v, __shfl_xor(v, o));
    return v; }
__device__ __forceinline__ float logsig(float x) { return fminf(x, 0.f) - log1pf(expf(-fabsf(x))); }
__device__ __forceinline__ float sigm(float x) { return 1.f / (1.f + expf(-x)); }
__device__ __forceinline__ float silu_f(float x) { return x / (1.f + expf(-x)); }
namespace pg8 {
#define PG8_LAS __attribute__((address_space(3)))
typedef unsigned short bf16_t;
typedef short bf16x8 __attribute__((ext_vector_type(8)));
typedef float f32x4 __attribute__((ext_vector_type(4)));
typedef unsigned u32x4 __attribute__((ext_vector_type(4)));
constexpr int BM = 256, BK = 64, HALF = 128, HTB = HALF * BK * 2  , STAGE_BYTES = 8 * HTB, NXCD = 8, WGM = 8;

__host__ __device__ __forceinline__ int lds_byte(int r, int c) { const int st = (r >> 4) * 2 + (c >> 5), rr = r & 15, cc = c & 31, ob = rr * 64 + cc * 2; return st * 1024 + (ob ^ (((ob >> 9) & 1) << 5)); }
__host__ __device__ __forceinline__ void stage_rc(int b, int& R, int& C) { const int st = b / 1024, sb = b % 1024, swz = sb ^ (((sb >> 9) & 1) << 5); R = (st >> 1) * 16 + swz / 64; C = (st & 1) * 32 + (swz % 64) / 2; }
__host__ __device__ __forceinline__ int perm32(int rho) { const int n = rho >> 4, i = rho & 15; return 8 * (i >> 2) + 4 * n + (i & 3); }

struct Unit { int pm, pn; };
struct Gemm { const bf16_t* A; const bf16_t* Bt; int M, N, K; };

struct StaticOrder {
    int nM, nN, nwg, G, c;
    __host__ __device__ void init(int M, int N, int G_, int c_) { nM = M / BM; nN = N / BM; nwg = nM * nN; G = G_; c = c_; }
    __host__ __device__ bool next(int i, Unit& u) const {
        const long L = (long)i * G + c; if (L >= nwg) return false;
        int wgid = (int)L; { const int q = nwg / NXCD, r = nwg % NXCD, xcd = wgid % NXCD, off = wgid / NXCD; wgid = (xcd < r ? xcd * (q + 1) : r * (q + 1) + (xcd - r) * q) + off; }
        const int nig = WGM * nN, gid = wgid / nig, fm = gid * WGM, gsz = (nM - fm) < WGM ? (nM - fm) : WGM;
        u.pm = fm + ((wgid % nig) % gsz); u.pn = (wgid % nig) / gsz; return true;
    }
    __device__ __forceinline__ void a_ready(const Unit&) const {}
    __device__ __forceinline__ void done(const Unit&) const {}
};
struct EpiSeg {
    static constexpr bool PERM = true, AFTER_DRAIN = false;
    bf16_t* P;
    __device__ __forceinline__ void operator()(const f32x4 (&acc)[2][2][4][2], const Unit& u, int wr, int wc, int fr, int fq) const {
        const int seg = u.pn >> 2; bf16_t* base = P + (size_t)seg * ((size_t)T_ * 1024);
        const int row0 = u.pm * BM + wr * 64 + fr, col0 = (u.pn & 3) * 256 + wc * 32 + 8 * fq;
#pragma unroll
        for (int ai = 0; ai < 2; ++ai)
#pragma unroll
            for (int m = 0; m < 4; ++m) { bf16_t* rowp = base + (size_t)(row0 + ai * HALF + m * 16) * 1024 + col0;
#pragma unroll
                for (int bj = 0; bj < 2; ++bj) { const f32x4 v0 = acc[ai][bj][m][0], v1 = acc[ai][bj][m][1];
                    u32x4 w; w.x = cvt_pk(v0[0], v0[1]); w.y = cvt_pk(v0[2], v0[3]); w.z = cvt_pk(v1[0], v1[1]); w.w = cvt_pk(v1[2], v1[3]);
                    *(u32x4*)(rowp + bj * HALF) = w; } }
    }
};
struct EpiBf {
    static constexpr bool PERM = true, AFTER_DRAIN = false;
    bf16_t* O; int ldc;
    __device__ __forceinline__ void operator()(const f32x4 (&acc)[2][2][4][2], const Unit& u, int wr, int wc, int fr, int fq) const {
        const int row0 = u.pm * BM + wr * 64 + fr, col0 = u.pn * BM + wc * 32 + 8 * fq;
#pragma unroll
        for (int ai = 0; ai < 2; ++ai)
#pragma unroll
            for (int m = 0; m < 4; ++m) { bf16_t* rowp = O + (size_t)(row0 + ai * HALF + m * 16) * ldc + col0;
#pragma unroll
                for (int bj = 0; bj < 2; ++bj) { const f32x4 v0 = acc[ai][bj][m][0], v1 = acc[ai][bj][m][1];
                    u32x4 w; w.x = cvt_pk(v0[0], v0[1]); w.y = cvt_pk(v0[2], v0[3]); w.z = cvt_pk(v1[0], v1[1]); w.w = cvt_pk(v1[2], v1[3]);
                    *(u32x4*)(rowp + bj * HALF) = w; } }
    }
};
struct EpiRes {
    static constexpr bool PERM = false, AFTER_DRAIN = false;
    const float* X; float* O; const float* mod; int goff;
    __device__ __forceinline__ void operator()(const f32x4 (&acc)[2][2][4][2], const Unit& u, int wr, int wc, int fr, int fq) const {
        const int row0 = u.pm * BM + wr * 64 + fr, col0 = u.pn * BM + wc * 32 + 4 * fq;
        const float* gp = mod + (size_t)((u.pm * BM) >> 11) * NMOD + goff + col0;
        f32x4 gv[2][2];
#pragma unroll
        for (int bj = 0; bj < 2; ++bj)
#pragma unroll
            for (int n = 0; n < 2; ++n) gv[bj][n] = *(const f32x4*)(gp + bj * HALF + 16 * n);
#pragma unroll
        for (int ai = 0; ai < 2; ++ai)
#pragma unroll
            for (int m = 0; m < 4; ++m) { const size_t ro = (size_t)(row0 + ai * HALF + m * 16) * D_ + col0;
#pragma unroll
                for (int bj = 0; bj < 2; ++bj)
#pragma unroll
                    for (int n = 0; n < 2; ++n) { const f32x4 xv = *(const f32x4*)(X + ro + bj * HALF + 16 * n);
                        *(f32x4*)(O + ro + bj * HALF + 16 * n) = xv + gv[bj][n] * acc[ai][bj][m][n]; } }
    }
};
template <class Epi, class Sched, bool ALIGN_EPI = false, bool SP2 = false>
__device__ __forceinline__ void gemm_phase(PG8_LAS unsigned char* lds, const Gemm g, const Sched& S, const Epi& E) {
    const int tid = get_tid(), wid = __builtin_amdgcn_readfirstlane(tid >> 6), lane = tid & 63, wr = wid >> 2, wc = wid & 3, fr = lane & 15, fq = lane >> 4;
    const int K = g.K, nt = K / BK;
    unsigned voffA[2], voffB[2];
#pragma unroll
    for (int i = 0; i < 2; ++i) { int R, C; stage_rc(tid * 16 + i * 8192, R, C); const int Rb = Epi::PERM ? ((R & ~31) + perm32(R & 31)) : R;
        voffA[i] = (unsigned)(R * K + C) * 2u; voffB[i] = (unsigned)(Rb * K + C) * 2u; }
    const size_t kstep = (size_t)(BK * 2);
    const size_t hstep = (size_t)HALF * K * 2;
    const size_t tstep = 2 * hstep;
    const unsigned ldsw = (unsigned)wid * 1024u;
    const int aoff = lds_byte(wr * 64 + fr, fq * 8), boff = lds_byte(wc * 32 + fr, fq * 8);
#define PG8_SA(b, h) (((b) * 2 + (h)) * HTB)
#define PG8_SB(b, h) ((4 + (b) * 2 + (h)) * HTB)
#define PG8_STAGE(bufoff, gbase, voff) do { _Pragma("unroll") for (int _i = 0; _i < 2; ++_i) \
        __builtin_amdgcn_global_load_lds((const unsigned*)((const char*)(gbase) + (voff)[_i]), (PG8_LAS unsigned*)(lds + (bufoff) + ldsw + _i * 8192), 16, 0, 0); } while (0)
#define PG8_LDA(dst, b, h) do { _Pragma("unroll") for (int m = 0; m < 4; ++m) _Pragma("unroll") for (int k = 0; k < 2; ++k) dst[m][k] = *(const PG8_LAS bf16x8*)(lds + PG8_SA(b, h) + aoff + m * 2048 + k * 1024); } while (0)
#define PG8_LDB(dst, b, h) do { _Pragma("unroll") for (int n = 0; n < 2; ++n) _Pragma("unroll") for (int k = 0; k < 2; ++k) dst[n][k] = *(const PG8_LAS bf16x8*)(lds + PG8_SB(b, h) + boff + n * 2048 + k * 1024); } while (0)
#define PG8_MMA(ai, bj, At, Bt) do { __builtin_amdgcn_s_setprio(1); _Pragma("unroll") for (int m = 0; m < 4; ++m) _Pragma("unroll") for (int n = 0; n < 2; ++n) _Pragma("unroll") for (int k = 0; k < 2; ++k) \
        acc[ai][bj][m][n] = __builtin_amdgcn_mfma_f32_16x16x32_bf16(Bt[n][k], At[m][k], acc[ai][bj][m][n], 0, 0, 0); __builtin_amdgcn_s_setprio(0); } while (0)
#define PG8_WAIT_V(n) asm volatile("s_waitcnt vmcnt(" #n ")" ::: "memory")
#define PG8_WAIT_L(n) asm volatile("s_waitcnt lgkmcnt(" #n ")" ::: "memory")
#define PG8_BAR __builtin_amdgcn_s_barrier()
#define PG8_SCHED __builtin_amdgcn_sched_barrier(0)
    Unit cur, nxt; int ui = 0;
    if (!S.next(0, cur)) return;
    f32x4 acc[2][2][4][2];
#pragma unroll
    for (int a = 0; a < 2; ++a)
#pragma unroll
        for (int b = 0; b < 2; ++b)
#pragma unroll
            for (int m = 0; m < 4; ++m)
#pragma unroll
                for (int n = 0; n < 2; ++n) acc[a][b][m][n] = (f32x4){0.f, 0.f, 0.f, 0.f};
    bf16x8 At[4][2], B0[2][2], B1[2][2];
    const char* cA = (const char*)g.A + (size_t)cur.pm * tstep; const char* cB = (const char*)g.Bt + (size_t)cur.pn * tstep;
    S.a_ready(cur);
    if constexpr (SP2) {
        PG8_STAGE(PG8_SB(0, 0), cB, voffB); PG8_STAGE(PG8_SB(0, 1), cB + hstep, voffB); PG8_STAGE(PG8_SA(0, 0), cA, voffA); PG8_STAGE(PG8_SA(0, 1), cA + hstep, voffA);
        if (wr == 1) PG8_BAR;
        PG8_WAIT_V(2); PG8_BAR;
        PG8_STAGE(PG8_SB(1, 0), cB + kstep, voffB); PG8_STAGE(PG8_SA(1, 0), cA + kstep, voffA); PG8_STAGE(PG8_SB(1, 1), cB + hstep + kstep, voffB);
        PG8_WAIT_V(6); PG8_BAR;
    } else {
        PG8_STAGE(PG8_SB(0, 0), cB, voffB); PG8_STAGE(PG8_SA(0, 0), cA, voffA); PG8_STAGE(PG8_SB(0, 1), cB + hstep, voffB); PG8_STAGE(PG8_SA(0, 1), cA + hstep, voffA);
        if (wr == 1) PG8_BAR;
        PG8_WAIT_V(4); PG8_BAR;
        PG8_STAGE(PG8_SB(1, 0), cB + kstep, voffB); PG8_STAGE(PG8_SA(1, 0), cA + kstep, voffA); PG8_STAGE(PG8_SB(1, 1), cB + hstep + kstep, voffB);
        PG8_WAIT_V(6); PG8_BAR;
    }
    for (;;) {
        const bool has_next = S.next(ui + 1, nxt);
        const char* nA = has_next ? (const char*)g.A + (size_t)nxt.pm * tstep : cA; const char* nB = has_next ? (const char*)g.Bt + (size_t)nxt.pn * tstep : cB;
        for (int t = 0; t < nt; t += 2) {
            const bool last = (t == nt - 2);
            const char* a1 = cA + (size_t)(t + 1) * kstep;
            const char* a2 = last ? nA : cA + (size_t)(t + 2) * kstep; const char* b2 = last ? nB : cB + (size_t)(t + 2) * kstep;
            const char* a3 = a2 + kstep; const char* b3 = b2 + kstep;
            if (last && has_next) S.a_ready(nxt);
            if constexpr (SP2) {
            PG8_LDB(B0, 0, 0); PG8_LDB(B1, 0, 1); PG8_SCHED; PG8_LDA(At, 0, 0); PG8_STAGE(PG8_SA(1, 1), a1 + hstep, voffA);
            PG8_WAIT_V(8); PG8_WAIT_L(0); PG8_BAR; PG8_MMA(0, 0, At, B0); PG8_MMA(0, 1, At, B1); PG8_BAR; PG8_SCHED;
            PG8_LDA(At, 0, 1); PG8_STAGE(PG8_SB(0, 0), b2, voffB); PG8_STAGE(PG8_SB(0, 1), b2 + hstep, voffB); PG8_STAGE(PG8_SA(0, 0), a2, voffA);
            PG8_WAIT_V(8); PG8_WAIT_L(0); PG8_BAR; PG8_MMA(1, 0, At, B0); PG8_MMA(1, 1, At, B1); PG8_BAR; PG8_SCHED;
            PG8_LDB(B0, 1, 0); PG8_LDB(B1, 1, 1); PG8_SCHED; PG8_LDA(At, 1, 0); PG8_STAGE(PG8_SA(0, 1), a2 + hstep, voffA);
            PG8_WAIT_V(8); PG8_WAIT_L(0); PG8_BAR; PG8_MMA(0, 0, At, B0); PG8_MMA(0, 1, At, B1); PG8_BAR; PG8_SCHED;
            PG8_LDA(At, 1, 1); PG8_STAGE(PG8_SB(1, 0), b3, voffB); PG8_STAGE(PG8_SB(1, 1), b3 + hstep, voffB); PG8_STAGE(PG8_SA(1, 0), a3, voffA);
            PG8_WAIT_V(8); PG8_WAIT_L(0); PG8_BAR; PG8_MMA(1, 0, At, B0); PG8_MMA(1, 1, At, B1); PG8_BAR; PG8_SCHED;
            } else {
            PG8_LDB(B0, 0, 0); PG8_SCHED; PG8_LDA(At, 0, 0); PG8_STAGE(PG8_SA(1, 1), a1 + hstep, voffA);
            PG8_WAIT_L(8); PG8_BAR; PG8_WAIT_L(0); PG8_MMA(0, 0, At, B0); PG8_BAR; PG8_SCHED;
            PG8_LDB(B1, 0, 1); PG8_STAGE(PG8_SB(0, 0), b2, voffB);
            PG8_BAR; PG8_WAIT_L(0); PG8_MMA(0, 1, At, B1); PG8_BAR;
            PG8_LDA(At, 0, 1); PG8_STAGE(PG8_SA(0, 0), a2, voffA);
            PG8_BAR; PG8_WAIT_L(0); PG8_MMA(1, 0, At, B0); PG8_BAR; PG8_SCHED;
            PG8_STAGE(PG8_SB(0, 1), b2 + hstep, voffB);
            PG8_WAIT_V(6); PG8_BAR; PG8_MMA(1, 1, At, B1); PG8_BAR;
            PG8_LDB(B0, 1, 0); PG8_SCHED; PG8_LDA(At, 1, 0); PG8_STAGE(PG8_SA(0, 1), a2 + hstep, voffA);
            PG8_WAIT_L(8); PG8_BAR; PG8_WAIT_L(0); PG8_MMA(0, 0, At, B0); PG8_BAR; PG8_SCHED;
            PG8_LDB(B1, 1, 1); PG8_STAGE(PG8_SB(1, 0), b3, voffB);
            PG8_BAR; PG8_WAIT_L(0); PG8_MMA(0, 1, At, B1); PG8_BAR;
            PG8_LDA(At, 1, 1); PG8_STAGE(PG8_SA(1, 0), a3, voffA);
            PG8_BAR; PG8_WAIT_L(0); PG8_MMA(1, 0, At, B0); PG8_BAR; PG8_SCHED;
            PG8_STAGE(PG8_SB(1, 1), b3 + hstep, voffB);
            PG8_WAIT_V(6); PG8_BAR; PG8_MMA(1, 1, At, B1); PG8_BAR;
            }
        }
        if constexpr (ALIGN_EPI) { if (wr == 0) PG8_BAR; }
        if constexpr (!Epi::AFTER_DRAIN) { E(acc, cur, wr, wc, fr, fq); S.done(cur); }
        if (!has_next) break;
#pragma unroll
        for (int a = 0; a < 2; ++a)
#pragma unroll
            for (int b = 0; b < 2; ++b)
#pragma unroll
                for (int m = 0; m < 4; ++m)
#pragma unroll
                    for (int n = 0; n < 2; ++n) acc[a][b][m][n] = (f32x4){0.f, 0.f, 0.f, 0.f};
        cur = nxt; cA = nA; cB = nB; ++ui;
        if constexpr (ALIGN_EPI) { if (wr == 1) PG8_BAR; }
    }
    PG8_WAIT_V(0);
    if constexpr (!ALIGN_EPI) { if (wr == 0) PG8_BAR; }
    PG8_BAR;
    if constexpr (Epi::AFTER_DRAIN) { E.fused(acc, cur, wr, wc, fr, fq, lds, wid, lane); S.done(cur); }
#undef PG8_SA
#undef PG8_SB
#undef PG8_STAGE
#undef PG8_LDA
#undef PG8_LDB
#undef PG8_MMA
#undef PG8_WAIT_V
#undef PG8_WAIT_L
#undef PG8_BAR
#undef PG8_SCHED
}
}
#define XB_TMO      128
#define XB_XCNT(j)  (256  + 64 * (j))
#define XB_XSUB(j)  (1280 + 64 * (j))
#define XB_XGEN(j)  (2304 + 64 * (j))
#define XB_TOP      3328
#define XB_TOPGEN   3392
#define XCD_BAR_WORDS 3456
#define XB_SPIN_CAP (1u << 18)

__device__ __forceinline__ unsigned xb_ld(unsigned* p)              { return __hip_atomic_load(p, __ATOMIC_RELAXED, __HIP_MEMORY_SCOPE_AGENT); }
__device__ __forceinline__ unsigned xb_add(unsigned* p, unsigned v) { return __hip_atomic_fetch_add(p, v, __ATOMIC_RELAXED, __HIP_MEMORY_SCOPE_AGENT); }
__device__ __forceinline__ unsigned xb_xcc_id() { return (unsigned)__builtin_amdgcn_s_getreg((3 << 11) | 20) & 0xFu; }
#define XB_SPIN(cond, bar) do { unsigned _sp = 0; while (cond) { __builtin_amdgcn_s_sleep(1); \
    if ((++_sp & 255u) == 0u) { if (xb_ld(&(bar)[XB_TMO])) break; if (_sp > XB_SPIN_CAP) { atomicAdd(&(bar)[XB_TMO], 1u); break; } } } } while (0)

struct XcdBarrier {
    unsigned* bar; unsigned x;
    volatile LAS unsigned* st;
};

__device__ __forceinline__ XcdBarrier xcd_barrier_post(unsigned* bar, volatile LAS unsigned* st) {
    XcdBarrier b; b.bar = bar; b.x = xb_xcc_id(); b.st = st;
    if (threadIdx.x == 0) (void)xb_add(&bar[XB_XCNT(b.x)], 1u);
    return b;
}
__device__ __forceinline__ void xcd_barrier_complete(unsigned* bar, unsigned x, unsigned& nloc, unsigned& nx) {
    const unsigned G = gridDim.x * gridDim.y * gridDim.z;
    unsigned sum, cnt, mine, sp = 0u;
    for (;;) {
        sum = 0u; cnt = 0u; mine = 0u;
#pragma unroll
        for (unsigned j = 0; j < 16; ++j) { const unsigned c = xb_ld(&bar[XB_XCNT(j)]); sum += c; cnt += (c > 0u) ? 1u : 0u; mine = (j == x) ? c : mine; }
        if (sum == G) break;
        __builtin_amdgcn_s_sleep(1);
        if ((++sp & 255u) == 0u) { if (xb_ld(&bar[XB_TMO])) break; if (sp > XB_SPIN_CAP) { atomicAdd(&bar[XB_TMO], 1u); break; } }
    }
    nloc = mine > 0u ? mine : 1u; nx = cnt > 0u ? cnt : 1u;
}

__device__ __forceinline__ void xcd_barrier(const XcdBarrier& b) {
    asm volatile("s_waitcnt vmcnt(0)" ::: "memory");
    __syncthreads();
    if (threadIdx.x == 0) {
        unsigned* bar = b.bar;
        __builtin_amdgcn_s_waitcnt(0);
        unsigned nloc = b.st[0], nx = b.st[1];
        if (nloc == 0u) { xcd_barrier_complete(bar, b.x, nloc, nx); b.st[0] = nloc; b.st[1] = nx; }
        const unsigned old = xb_add(&bar[XB_XSUB(b.x)], 1u);
        const unsigned gen = old / nloc;
        if (old + 1u == (gen + 1u) * nloc) {
            __builtin_amdgcn_fence(__ATOMIC_RELEASE, "agent");
            asm volatile("s_waitcnt vmcnt(0)" ::: "memory");
            const unsigned og = xb_add(&bar[XB_TOP], 1u);
            const unsigned tg = og / nx;
            if (og + 1u == (tg + 1u) * nx) xb_add(&bar[XB_TOPGEN], 1u);
            else XB_SPIN(xb_ld(&bar[XB_TOPGEN]) == tg, bar);
            __builtin_amdgcn_fence(__ATOMIC_ACQUIRE, "agent");
            xb_add(&bar[XB_XGEN(b.x)], 1u);
            asm volatile("s_waitcnt vmcnt(0)" ::: "memory");
        } else {
            XB_SPIN(xb_ld(&bar[XB_XGEN(b.x)]) == gen, bar);
            __builtin_amdgcn_fence(__ATOMIC_ACQUIRE, "agent");
            asm volatile("s_waitcnt vmcnt(0)" ::: "memory");
        }
    }
    __syncthreads();
}
__device__ __forceinline__ void phase_prep(const Params& p, unsigned char* lds, int bid, int nb) {
    const int tid = get_tid(), lane = tid & 63, wave = tid >> 6;
    unsigned char* ws = p.ws;
    float* mod = (float*)(ws + WS_MOD);
    if (bid < 192) {
        float* sc = (float*)lds;
        float* red = sc + 8 * 2048;
        for (int i = tid; i < 8 * 2048; i += NTHR) sc[i] = silu_f(p.c[i]);
        __syncthreads();
        for (int it = bid; it < 192; it += nb) {
            const int col = it * 64 + lane;
            float acc[8];
#pragma unroll
            for (int b = 0; b < 8; ++b) acc[b] = 0.f;
            const float* w = p.w_ada + (size_t)(wave * 256) * NMOD + col;
            const float* s0 = sc + wave * 256;
#pragma unroll 16
            for (int k = 0; k < 256; ++k) {
                const float wv = __builtin_nontemporal_load(w + (size_t)k * NMOD);
#pragma unroll
                for (int b = 0; b < 8; ++b) acc[b] += s0[b * 2048 + k] * wv;
            }
#pragma unroll
            for (int b = 0; b < 8; ++b) red[(wave * 8 + b) * 64 + lane] = acc[b];
            __syncthreads();
            {   const int b = wave; float s = p.b_ada[col];
#pragma unroll
                for (int w2 = 0; w2 < 8; ++w2) s += red[(w2 * 8 + b) * 64 + lane];
                mod[b * NMOD + col] = s; }
            __syncthreads();
        }
    }
    __syncthreads();
    {
        float* tile = (float*)lds;
        bf16_t* WinT = (bf16_t*)(ws + WS_WINT); bf16_t* WoT = (bf16_t*)(ws + WS_WOT); bf16_t* WqT = (bf16_t*)(ws + WS_WQT);
        for (int item = bid; item < 5632; item += nb) {
            const float* src; int ld, scol; bf16_t* dst; int kt;
            if (item < 3584) { const int seg = item >> 9, rem = item & 511, ntile = rem >> 5; kt = rem & 31;
                src = p.w_in; ld = INCOLS; scol = (seg < 3 ? seg * 1024 : 3080 + (seg - 3) * 1024) + ntile * 64; dst = WinT + (size_t)(seg * 1024 + ntile * 64) * 2048; }
            else if (item < 4608) { const int rem = item - 3584, ntile = rem >> 5; kt = rem & 31; src = p.w_out; ld = 2048; scol = ntile * 64; dst = WoT + (size_t)(ntile * 64) * 2048; }
            else { const int rem = item - 4608, ntile = rem >> 5; kt = rem & 31; src = p.w_q; ld = 2048; scol = ntile * 64; dst = WqT + (size_t)(ntile * 64) * 2048; }
            const int k0 = kt * 64;
#pragma unroll
            for (int ii = 0; ii < 8; ++ii) { const int k = wave + 8 * ii; tile[k * 65 + lane] = src[(size_t)(k0 + k) * ld + scol + lane]; }
            __syncthreads();
#pragma unroll
            for (int ii = 0; ii < 8; ++ii) { const int n = wave + 8 * ii; dst[(size_t)n * 2048 + k0 + lane] = (bf16_t)(cvt_pk(tile[lane * 65 + n], 0.f) & 0xffffu); }
            __syncthreads();
        }
    }
    {
        bf16_t* Wg = (bf16_t*)(ws + WS_WG);
        for (int i = bid * NTHR + tid; i < 16 * 2048; i += nb * NTHR) { const int g = i >> 11, k = i & 2047; const int col = g < 8 ? 3072 + g : 7176 + (g - 8);
            Wg[i] = (bf16_t)(cvt_pk(p.w_in[(size_t)k * INCOLS + col], 0.f) & 0xffffu); }
    }
}

__device__ __forceinline__ unsigned pack4_fp8(const f32x4 a) { int t = __builtin_amdgcn_cvt_pk_fp8_f32(a[0], a[1], 0, false); t = __builtin_amdgcn_cvt_pk_fp8_f32(a[2], a[3], t, true); return (unsigned)t; }
__device__ __forceinline__ void convert_experts(const Params& p, int bid, int nb) {
    const int tid = get_tid(); unsigned char* ws = p.ws;
    unsigned char* E8D = ws + WS_E8D; unsigned char* E8US = ws + WS_E8U;
    {
        const int lane = tid & 63, wave = tid >> 6; float* DSC = (float*)(ws + WS_DSC);
        for (int e = bid * 8 + wave; e < 16384; e += nb * 8) {
            const float* rp = p.e_down + (size_t)e * 2048;
            f32x4 v[8]; float mx = 0.f;
#pragma unroll
            for (int hf = 0; hf < 2; ++hf)
#pragma unroll
                for (int q = 0; q < 4; ++q) { v[hf * 4 + q] = *(const f32x4*)(rp + hf * 1024 + 16 * lane + 4 * q);
#pragma unroll
                    for (int c = 0; c < 4; ++c) mx = fmaxf(mx, fabsf(v[hf * 4 + q][c])); }
            mx = fmaxf(wmax(mx), 1e-30f);
            const float inv = 127.f / mx;
            if (lane == 0) DSC[e] = mx * (1.f / 127.f);
#pragma unroll
            for (int hf = 0; hf < 2; ++hf) { u32x4 o;
#pragma unroll
                for (int q = 0; q < 4; ++q) { unsigned w = 0u;
#pragma unroll
                    for (int c = 0; c < 4; ++c) w |= ((unsigned)__float2int_rn(v[hf * 4 + q][c] * inv) & 0xffu) << (8 * c);
                    o[q] = w; }
                *(u32x4*)(E8D + (size_t)e * 2048 + hf * 1024 + 16 * lane) = o; }
        }
    }
    for (int i = bid * NTHR + tid; i < 524288; i += nb * NTHR) {
        const int s = i & 255, eg = i >> 8;
        const float* sp = p.e_up + (size_t)(eg * 8) * 2048 + 8 * s;
        unsigned w[16];
#pragma unroll
        for (int q = 0; q < 8; ++q) { const f32x4 a = *(const f32x4*)(sp + (size_t)q * 2048), b = *(const f32x4*)(sp + (size_t)q * 2048 + 4); w[2 * q] = pack4_fp8(a * 32.f); w[2 * q + 1] = pack4_fp8(b * 32.f); }
        u32x4* dp = (u32x4*)(E8US + ((size_t)s * 16384 + eg * 8) * 8);
#pragma unroll
        for (int q = 0; q < 4; ++q) { u32x4 o; o.x = w[4 * q]; o.y = w[4 * q + 1]; o.z = w[4 * q + 2]; o.w = w[4 * q + 3]; dp[q] = o; }
    }
}

template <bool RES>
__device__ __forceinline__ void phase_norm(const float* xin, const bf16_t* yin, int gate_off, const float* gain, const float* mod, int shift_off, int scale_off, bf16_t* hout, int bid, int nb) {
    const int tid = get_tid(), lane = tid & 63, wave = tid >> 6;
    for (int row = bid * 8 + wave; row < T_; row += nb * 8) {
        const f32x4* xr = (const f32x4*)(xin + (size_t)row * D_);
        f32x4 v[8]; float ss = 0.f;
        const float* mb = mod + (size_t)(row >> 11) * NMOD;
#pragma unroll
        for (int j = 0; j < 8; ++j) { v[j] = xr[lane + 64 * j];
            if (RES) { const int k = 4 * (lane + 64 * j); const u32x2 yw = *(const u32x2*)(yin + (size_t)row * D_ + k); const f32x4 gv = *(const f32x4*)(mb + gate_off + k);
                v[j][0] += gv[0] * bflo(yw.x); v[j][1] += gv[1] * bfhi(yw.x); v[j][2] += gv[2] * bflo(yw.y); v[j][3] += gv[3] * bfhi(yw.y); }
            ss += v[j][0] * v[j][0] + v[j][1] * v[j][1] + v[j][2] * v[j][2] + v[j][3] * v[j][3]; }
        ss = wsum(ss);
        const float r = rsqrtf(ss * (1.f / D_) + EPS_);
        f32x4 hv[8];
#pragma unroll
        for (int j = 0; j < 8; ++j) {
            const int k = 4 * (lane + 64 * j);
            const f32x4 gn = *(const f32x4*)(gain + k), sh = *(const f32x4*)(mb + shift_off + k), scl = *(const f32x4*)(mb + scale_off + k);
#pragma unroll
            for (int e = 0; e < 4; ++e) hv[j][e] = (v[j][e] * r) * gn[e] * (1.f + scl[e]) + sh[e];
            u32x2 w; w.x = cvt_pk(hv[j][0], hv[j][1]); w.y = cvt_pk(hv[j][2], hv[j][3]);
            *(u32x2*)(hout + (size_t)row * D_ + k) = w;
        }
    }
}

__device__ __forceinline__ void phase_gates(const Params& p, unsigned char* lds, int bid, int nb) {
    const int tid = get_tid(), lane = tid & 63, wave = tid >> 6, r = lane & 31, hh = lane >> 5;
    unsigned char* ws = p.ws;
    const bf16_t* H = (const bf16_t*)(ws + WS_H); const bf16_t* Wg = (const bf16_t*)(ws + WS_WG); float* gate = (float*)(ws + WS_GATE);
    constexpr int WST = 4096 + 16;
    for (int i = tid; i < 16 * 256; i += NTHR) { const int g = i >> 8, c = i & 255; *(u32x4*)(lds + g * WST + c * 16) = *(const u32x4*)(Wg + (size_t)g * 2048 + c * 8); }
    __syncthreads();
    float* part = (float*)(lds + 16 * WST);
    for (int pr = bid; pr < T_ / 64; pr += nb) {
        const int t = pr * 64 + (wave >> 2) * 32 + r, kq = wave & 3;
        f32x16 acc;
#pragma unroll
        for (int i = 0; i < 16; ++i) acc[i] = 0.f;
        const bf16_t* hp = H + (size_t)t * D_ + kq * 512 + hh * 8; const unsigned char* wp = lds + (r & 15) * WST + kq * 1024 + hh * 16;
#pragma unroll 1
        for (int k0 = 0; k0 < 32; k0 += 16) {
            bf16x8 bfr[16];
#pragma unroll
            for (int j = 0; j < 16; ++j) bfr[j] = *(const bf16x8*)(hp + (k0 + j) * 16);
#pragma unroll
            for (int j = 0; j < 16; ++j) { bf16x8 a = *(const bf16x8*)(wp + (k0 + j) * 32); if (r >= 16) a = (bf16x8){0, 0, 0, 0, 0, 0, 0, 0};
                acc = __builtin_amdgcn_mfma_f32_32x32x16_bf16(a, bfr[j], acc, 0, 0, 0); }
        }
        __syncthreads();
#pragma unroll
        for (int i = 0; i < 8; ++i) part[(wave * 8 + i) * 64 + lane] = acc[i];
        __syncthreads();
        if (kq == 0) {
            float s[8];
#pragma unroll
            for (int i = 0; i < 8; ++i) s[i] = part[(wave * 8 + i) * 64 + lane] + part[((wave + 1) * 8 + i) * 64 + lane] + part[((wave + 2) * 8 + i) * 64 + lane] + part[((wave + 3) * 8 + i) * 64 + lane];
            f32x4 g0, g1; g0[0] = s[0]; g0[1] = s[1]; g0[2] = s[2]; g0[3] = s[3]; g1[0] = s[4]; g1[1] = s[5]; g1[2] = s[6]; g1[3] = s[7];
            *(f32x4*)(gate + (size_t)t * 16 + 4 * hh) = g0; *(f32x4*)(gate + (size_t)t * 16 + 8 + 4 * hh) = g1;
        }
    }
    __syncthreads();
}

__device__ __forceinline__ void phase_post(const Params& p, int bid, int nb) {
    const int tid = get_tid(), lane = tid & 63, wave = tid >> 6;
    unsigned char* ws = p.ws;
    bf16_t* Pq = (bf16_t*)(ws + WS_P); bf16_t* Pk = (bf16_t*)(ws + WS_P + SEG_B);
    const float qscale = 0.08838834764831845f * 1.4426950408889634f;
    for (int r = bid * 8 + wave; r < 2 * T_; r += nb * 8) {
        const int which = r >= T_ ? 1 : 0; const int t = r - which * T_;
        bf16_t* ptr = (which ? Pk : Pq) + (size_t)t * 1024 + lane * 16;
        const float* gn = (which ? p.fox_kg : p.fox_qg) + (lane & 7) * 16;
        u32x4 a = *(const u32x4*)ptr, b = *(const u32x4*)(ptr + 8);
        float f[16];
        f[0] = bflo(a.x); f[1] = bfhi(a.x); f[2] = bflo(a.y); f[3] = bfhi(a.y); f[4] = bflo(a.z); f[5] = bfhi(a.z); f[6] = bflo(a.w); f[7] = bfhi(a.w);
        f[8] = bflo(b.x); f[9] = bfhi(b.x); f[10] = bflo(b.y); f[11] = bfhi(b.y); f[12] = bflo(b.z); f[13] = bfhi(b.z); f[14] = bflo(b.w); f[15] = bfhi(b.w);
        float ss = 0.f;
#pragma unroll
        for (int i = 0; i < 16; ++i) ss += f[i] * f[i];
        ss += __shfl_xor(ss, 1); ss += __shfl_xor(ss, 2); ss += __shfl_xor(ss, 4);
        const float rr = rsqrtf(ss * (1.f / 128.f) + EPS_) * (which ? 1.f : qscale);
#pragma unroll
        for (int i = 0; i < 16; ++i) f[i] = (f[i] * rr) * gn[i];
        a.x = cvt_pk(f[0], f[1]); a.y = cvt_pk(f[2], f[3]); a.z = cvt_pk(f[4], f[5]); a.w = cvt_pk(f[6], f[7]);
        b.x = cvt_pk(f[8], f[9]); b.y = cvt_pk(f[10], f[11]); b.z = cvt_pk(f[12], f[13]); b.w = cvt_pk(f[14], f[15]);
        *(u32x4*)ptr = a; *(u32x4*)(ptr + 8) = b;
    }
    {
        const bf16_t* Mq = (const bf16_t*)(ws + WS_P + 3 * SEG_B); const bf16_t* Mk = (const bf16_t*)(ws + WS_P + 4 * SEG_B);
        bf16_t* QC = (bf16_t*)(ws + WS_QC); bf16_t* KC = (bf16_t*)(ws + WS_KC);
        for (int item = bid; item < 256; item += nb) {
            const int which = item >> 7, tb = item & 127, cg = tid & 127, run = tid >> 7, ch0 = cg * 8, ts = tb * 128 + run * 32, sp = ts & 2047;
            const bf16_t* src = (which ? Mk : Mq) + (size_t)ts * 1024 + ch0; bf16_t* dst = (which ? KC : QC) + (size_t)ts * 1024 + ch0;
            float w0[8], w1[8], w2[8], w3[8], cb[8], x0[8], x1[8], x2[8];
#pragma unroll
            for (int e = 0; e < 8; ++e) { const int ci = which * 1024 + ch0 + e; w0[e] = p.conv_w[ci]; w1[e] = p.conv_w[2048 + ci]; w2[e] = p.conv_w[4096 + ci]; w3[e] = p.conv_w[6144 + ci]; cb[e] = p.conv_b[ci]; }
            {   u32x4 a = {0u, 0u, 0u, 0u}, b = a, c = a;
                if (sp != 0) { a = *(const u32x4*)(src - 3 * 1024); b = *(const u32x4*)(src - 2 * 1024); c = *(const u32x4*)(src - 1024); }
#pragma unroll
                for (int e = 0; e < 4; ++e) { x0[2 * e] = bflo(a[e]); x0[2 * e + 1] = bfhi(a[e]); x1[2 * e] = bflo(b[e]); x1[2 * e + 1] = bfhi(b[e]); x2[2 * e] = bflo(c[e]); x2[2 * e + 1] = bfhi(c[e]); } }
            const float osc = which ? 0.0625f : 1.f;
            for (int s = 0; s < 32; ++s) {
                const u32x4 d = *(const u32x4*)(src + (size_t)s * 1024); float x3[8], y[8];
#pragma unroll
                for (int e = 0; e < 4; ++e) { x3[2 * e] = bflo(d[e]); x3[2 * e + 1] = bfhi(d[e]); }
#pragma unroll
                for (int e = 0; e < 8; ++e) { y[e] = silu_f(w0[e] * x0[e] + w1[e] * x1[e] + w2[e] * x2[e] + w3[e] * x3[e] + cb[e]) * osc; x0[e] = x1[e]; x1[e] = x2[e]; x2[e] = x3[e]; }
                u32x4 o; o.x = cvt_pk(y[0], y[1]); o.y = cvt_pk(y[2], y[3]); o.z = cvt_pk(y[4], y[5]); o.w = cvt_pk(y[6], y[7]);
                *(u32x4*)(dst + (size_t)s * 1024) = o;
            }
        }
    }
    const float* gate = (const float*)(ws + WS_GATE); float* F = (float*)(ws + WS_F);
    for (int sq = bid * 8 + wave; sq < 64; sq += nb * 8) {
        const int b = sq >> 3, h = sq & 7; const float fb = p.fox_fb[h];
        float v[32]; float run = 0.f;
#pragma unroll
        for (int i = 0; i < 32; ++i) { const int t = lane * 32 + i; run += logsig(gate[(size_t)(b * S_ + t) * 16 + h] + fb); v[i] = run; }
        float inc = run;
#pragma unroll
        for (int o = 1; o < 64; o <<= 1) { const float u = __shfl_up(inc, o); if (lane >= o) inc += u; }
        const float excl = inc - run;
#pragma unroll
        for (int i = 0; i < 32; ++i) F[(size_t)sq * S_ + lane * 32 + i] = (v[i] + excl) * 1.4426950408889634f;
    }
}
typedef short s16x4 __attribute__((ext_vector_type(4)));
__device__ __forceinline__ s16x4 lds_tr16(const unsigned char* p) { return __builtin_amdgcn_ds_read_tr16_b64_v4i16((LAS s16x4*)p); }
__device__ __forceinline__ bf16x8 tr_frag(const unsigned char* p0, int second_bytes) {
    const s16x4 a = lds_tr16(p0), b = lds_tr16(p0 + second_bytes);
    bf16x8 f; f[0] = a[0]; f[1] = a[1]; f[2] = a[2]; f[3] = a[3]; f[4] = b[0]; f[5] = b[1]; f[6] = b[2]; f[7] = b[3]; return f;
}
__device__ __forceinline__ unsigned split_bf16(float v, float& eff) { const unsigned hi = cvt_pk(v, 0.f) & 0xffffu; const float hf = bf2f((bf16_t)hi); const unsigned lo = cvt_pk(v - hf, 0.f) & 0xffffu; eff = hf + bf2f((bf16_t)lo); return hi | (lo << 16); }
__device__ __forceinline__ void fox_unit(const Params& p, unsigned char* lds, int b, int h, int qb) {
    const int tid = get_tid(), lane = tid & 63, wave = tid >> 6, r = lane & 31, hh = lane >> 5, li = lane & 15;
    unsigned char* ws = p.ws;
    const bf16_t* Pq = (const bf16_t*)(ws + WS_P); const bf16_t* Pk = (const bf16_t*)(ws + WS_P + SEG_B); const bf16_t* Pv = (const bf16_t*)(ws + WS_P + 2 * SEG_B);
    const float* F = (const float*)(ws + WS_F) + (size_t)(b * 8 + h) * S_;
    bf16_t* Oc = (bf16_t*)(ws + WS_H);
    constexpr int KST = 272, VST = 544, BUF = 64 * KST + 64 * VST;
    constexpr float THR = 8.f;
    const int q0w = qb * 256 + wave * 32, qs = q0w + r; const int q0s = __builtin_amdgcn_readfirstlane(q0w);
    const size_t trow = (size_t)(b * S_ + qs);
    bf16x8 qf[8];
#pragma unroll
    for (int ks = 0; ks < 8; ++ks) qf[ks] = *(const bf16x8*)(Pq + trow * 1024 + h * 128 + ks * 16 + hh * 8);
    float feff; const unsigned fq2 = split_bf16(F[qs], feff);
    float m = 0.f;
    u32x4 qa; qa.x = hh ? 0u : fq2; qa.y = 0u; qa.z = hh ? 0u : 0x3f803f80u; qa.w = 0u;
    f32x16 o[4];
#pragma unroll
    for (int d = 0; d < 4; ++d)
#pragma unroll
        for (int i = 0; i < 16; ++i) o[d][i] = 0.f;
    float l = 0.f;
    const int ntile = (qb * 256 + 256) / 64;
    const int srow0 = tid >> 4, scc = tid & 15;
    const bf16_t* kg = Pk + (size_t)(b * S_ + srow0) * 1024 + h * 128 + scc * 8; const bf16_t* vg = Pv + (size_t)(b * S_ + srow0) * 1024 + h * 128 + scc * 8;
    u32x4 kr[2], vr[2]; float fr = 0.f;
    const int vb_off = 64 * KST + (4 * hh + (li >> 2)) * VST + (16 * (r >> 4) + 4 * (li & 3)) * 2;
#define FOX_AUG(dst, fval) do { float e_; const unsigned s2_ = split_bf16(-(fval), e_); u32x4 w_; w_.x = 0x3f803f80u; w_.y = 0x3f803f80u; w_.z = s2_; w_.w = 0u; *(u32x4*)(dst) = w_; } while (0)
    __syncthreads();
#pragma unroll
    for (int i = 0; i < 2; ++i) { kr[i] = *(const u32x4*)(kg + (size_t)(32 * i) * 1024); vr[i] = *(const u32x4*)(vg + (size_t)(32 * i) * 1024); }
    if (tid < 64) fr = F[tid];
#pragma unroll
    for (int i = 0; i < 2; ++i) { *(u32x4*)(lds + (srow0 + 32 * i) * KST + scc * 16) = kr[i]; *(u32x4*)(lds + 64 * KST + (srow0 + 32 * i) * VST + scc * 16) = vr[i]; }
    if (tid < 64) FOX_AUG(lds + tid * KST + 256, fr);
    __syncthreads();
    for (int kt = 0; kt < ntile; ++kt) {
        const int k0 = kt * 64; unsigned char* cur = lds + (kt & 1) * BUF; unsigned char* nxt = lds + ((kt & 1) ^ 1) * BUF;
        const bool more = kt + 1 < ntile;
        if (more) {
#pragma unroll
            for (int i = 0; i < 2; ++i) { kr[i] = *(const u32x4*)(kg + (size_t)(k0 + 64 + 32 * i) * 1024); vr[i] = *(const u32x4*)(vg + (size_t)(k0 + 64 + 32 * i) * 1024); }
            if (tid < 64) fr = F[k0 + 64 + tid];
        }
        if (k0 <= q0s + 31) {
            f32x16 s[2];
            const bf16x8 qaf = __builtin_bit_cast(bf16x8, qa);
#pragma unroll
            for (int kb = 0; kb < 2; ++kb) {
#pragma unroll
                for (int i = 0; i < 16; ++i) s[kb][i] = 0.f;
#pragma unroll
                for (int ks = 0; ks < 8; ++ks) { const bf16x8 a = *(const bf16x8*)(cur + (kb * 32 + r) * KST + ks * 32 + hh * 16);
                    s[kb] = __builtin_amdgcn_mfma_f32_32x32x16_bf16(a, qf[ks], s[kb], 0, 0, 0); }
                {   const bf16x8 a = *(const bf16x8*)(cur + (kb * 32 + r) * KST + 256);
                    s[kb] = __builtin_amdgcn_mfma_f32_32x32x16_bf16(a, qaf, s[kb], 0, 0, 0); }
            }
            if (k0 + 63 > q0s) {
                const int lim = qs - k0;
#pragma unroll
                for (int kb = 0; kb < 2; ++kb)
#pragma unroll
                    for (int i = 0; i < 16; ++i) s[kb][i] = (kb * 32 + (i & 3) + 8 * (i >> 2) + 4 * hh > lim) ? -INFINITY : s[kb][i];
            }
            float mx = fmaxf(s[0][0], s[1][0]);
#pragma unroll
            for (int i = 1; i < 16; ++i) mx = fmaxf(mx, fmaxf(s[0][i], s[1][i]));
            mx = fmaxf(mx, __shfl_xor(mx, 32));
            if (__builtin_amdgcn_ballot_w64(mx > THR) != 0ull) {
                const float mnew_f = m + fmaxf(mx, 0.f); float meff; const unsigned m2 = split_bf16(-mnew_f, meff); meff = -meff;
                const float delta = meff - m, alpha = __builtin_amdgcn_exp2f(-delta);
                m = meff; if (!hh) qa.y = m2;
                l *= alpha;
#pragma unroll
                for (int d = 0; d < 4; ++d)
#pragma unroll
                    for (int i = 0; i < 16; ++i) o[d][i] *= alpha;
#pragma unroll
                for (int kb = 0; kb < 2; ++kb)
#pragma unroll
                    for (int i = 0; i < 16; ++i) s[kb][i] -= delta;
            }
            float ps = 0.f;
#pragma unroll
            for (int kb = 0; kb < 2; ++kb)
#pragma unroll
                for (int i = 0; i < 16; ++i) { const float pv = __builtin_amdgcn_exp2f(s[kb][i]); s[kb][i] = pv; ps += pv; }
            l += ps;
#pragma unroll
            for (int kb = 0; kb < 2; ++kb)
#pragma unroll
                for (int st = 0; st < 2; ++st) {
                    u32x4 pw; pw.x = cvt_pk(s[kb][8 * st + 0], s[kb][8 * st + 1]); pw.y = cvt_pk(s[kb][8 * st + 2], s[kb][8 * st + 3]);
                    pw.z = cvt_pk(s[kb][8 * st + 4], s[kb][8 * st + 5]); pw.w = cvt_pk(s[kb][8 * st + 6], s[kb][8 * st + 7]);
                    const bf16x8 pf = __builtin_bit_cast(bf16x8, pw);
#pragma unroll
                    for (int d = 0; d < 4; ++d) { const bf16x8 vf = tr_frag(cur + vb_off + (kb * 32 + st * 16) * VST + d * 64, 8 * VST);
                        o[d] = __builtin_amdgcn_mfma_f32_32x32x16_bf16(vf, pf, o[d], 0, 0, 0); }
                }
        }
        if (more) {
#pragma unroll
            for (int i = 0; i < 2; ++i) { *(u32x4*)(nxt + (srow0 + 32 * i) * KST + scc * 16) = kr[i]; *(u32x4*)(nxt + 64 * KST + (srow0 + 32 * i) * VST + scc * 16) = vr[i]; }
            if (tid < 64) FOX_AUG(nxt + tid * KST + 256, fr);
        }
        lds_barrier();
    }
#undef FOX_AUG
    l += __shfl_xor(l, 32);
    const float inv = 1.f / l;
#pragma unroll
    for (int d = 0; d < 4; ++d)
#pragma unroll
        for (int g = 0; g < 4; ++g) { u32x2 w; w.x = cvt_pk(o[d][4 * g] * inv, o[d][4 * g + 1] * inv); w.y = cvt_pk(o[d][4 * g + 2] * inv, o[d][4 * g + 3] * inv);
            *(u32x2*)(Oc + trow * D_ + h * 128 + d * 32 + 8 * g + 4 * hh) = w; }
}

__device__ __forceinline__ void mlstm_passA(const Params& p, unsigned char* lds, int unit) {
    const int tid = get_tid(), lane = tid & 63, wave = tid >> 6, r = lane & 31, hh = lane >> 5, li = lane & 15;
    const int b = unit >> 3, h = (unit >> 1) & 3, eh = unit & 1;
    unsigned char* ws = p.ws;
    const bf16_t* KC = (const bf16_t*)(ws + WS_KC); const bf16_t* Mv = (const bf16_t*)(ws + WS_P + 5 * SEG_B);
    const float* gate = (const float*)(ws + WS_GATE);
    bf16_t* Cst = (bf16_t*)(ws + WS_CST); float* nst = (float*)(ws + WS_NST); float* mst = (float*)(ws + WS_MST);
    constexpr int KST = 528, VST = 272;
    unsigned char* ksm = lds;
    unsigned char* vsm = ksm + 64 * KST;
    float* WSV = (float*)(vsm + 64 * VST);
    float* SCL = WSV + 2048;
    constexpr int STGS = 528;
    unsigned char* stg = (unsigned char*)(SCL + 128);
    __syncthreads();
    for (int cc = wave; cc < 32; cc += 8) {
        const int t = b * S_ + cc * 64 + lane;
        const float ipre = gate[(size_t)t * 16 + 8 + h] + p.m_ib[h], fpre = gate[(size_t)t * 16 + 12 + h] + p.m_fb[h];
        float bc = logsig(fpre);
#pragma unroll
        for (int o = 1; o < 64; o <<= 1) { const float u = __shfl_up(bc, o); if (lane >= o) bc += u; }
        const float a = ipre - bc; const float amax = wmax(a); const float bL = __shfl(bc, 63);
        WSV[cc * 64 + lane] = a; if (lane == 0) { SCL[cc] = bL; SCL[32 + cc] = amax; }
    }
    __syncthreads();
    if (tid == 0) { float m = 0.f; for (int cc = 0; cc < 32; ++cc) { const float mn = SCL[cc] + fmaxf(m, SCL[32 + cc]); SCL[64 + cc] = expf(SCL[cc] + m - mn); SCL[96 + cc] = mn; if (eh == 0) mst[(b * 4 + h) * 32 + cc] = m; m = mn; } }
    __syncthreads();
    for (int i = tid; i < 2048; i += NTHR) { const int cc = i >> 6; WSV[i] = expf(SCL[cc] + WSV[i] - SCL[96 + cc]); }
    f32x16 acc[4];
#pragma unroll
    for (int et = 0; et < 4; ++et)
#pragma unroll
        for (int i = 0; i < 16; ++i) acc[et][i] = 0.f;
    f32x16 accn;
#pragma unroll
    for (int i = 0; i < 16; ++i) accn[i] = 0.f;
    const int kb_off = (8 * hh + (li >> 2)) * KST + (wave * 32 + 16 * (r >> 4) + 4 * (li & 3)) * 2;
    const int vb_off = (8 * hh + (li >> 2)) * VST + (16 * (r >> 4) + 4 * (li & 3)) * 2;
    u32x4 pk[4], pv[2];
#pragma unroll
    for (int i = 0; i < 4; ++i) { const int c = tid + NTHR * i, row = c >> 5, c16 = c & 31; pk[i] = *(const u32x4*)(KC + (size_t)(b * S_ + row) * 1024 + h * 256 + c16 * 8); }
#pragma unroll
    for (int i = 0; i < 2; ++i) { const int c = tid + NTHR * i, row = c >> 4, c16 = c & 15; pv[i] = *(const u32x4*)(Mv + (size_t)(b * S_ + row) * 1024 + h * 256 + eh * 128 + c16 * 8); }
    for (int cc = 0; cc < 32; ++cc) {
        const int bhc = (b * 4 + h) * 32 + cc, t0 = b * S_ + cc * 64;
#pragma unroll
        for (int et = 0; et < 4; ++et)
#pragma unroll
            for (int g = 0; g < 4; ++g) { u32x2 o; o.x = cvt_pk(acc[et][4 * g], acc[et][4 * g + 1]); o.y = cvt_pk(acc[et][4 * g + 2], acc[et][4 * g + 3]);
                *(u32x2*)(stg + (et * 32 + r) * STGS + (wave * 32 + 8 * g + 4 * hh) * 2) = o; }
        if (eh == 0 && r == 0) {
#pragma unroll
            for (int g = 0; g < 4; ++g) { f32x4 o; o[0] = accn[4 * g]; o[1] = accn[4 * g + 1]; o[2] = accn[4 * g + 2]; o[3] = accn[4 * g + 3]; *(f32x4*)(nst + (size_t)bhc * 256 + wave * 32 + 8 * g + 4 * hh) = o; } }
        lds_barrier();
#pragma unroll
        for (int i = 0; i < 8; ++i) { const int c = tid + NTHR * i, row = c >> 5, c16 = c & 31;
            *(u32x4*)(Cst + ((size_t)bhc * 256 + eh * 128 + row) * 256 + c16 * 8) = *(const u32x4*)(stg + row * STGS + c16 * 16); }
        if (cc == 31) break;
#pragma unroll
        for (int i = 0; i < 4; ++i) { const int c = tid + NTHR * i, row = c >> 5, c16 = c & 31; *(u32x4*)(ksm + row * KST + c16 * 16) = pk[i]; }
#pragma unroll
        for (int i = 0; i < 2; ++i) { const int c = tid + NTHR * i, row = c >> 4, c16 = c & 15; const float wv = WSV[cc * 64 + row]; const u32x4 w = pv[i];
            u32x4 o; o.x = cvt_pk(bflo(w.x) * wv, bfhi(w.x) * wv); o.y = cvt_pk(bflo(w.y) * wv, bfhi(w.y) * wv); o.z = cvt_pk(bflo(w.z) * wv, bfhi(w.z) * wv); o.w = cvt_pk(bflo(w.w) * wv, bfhi(w.w) * wv);
            *(u32x4*)(vsm + row * VST + c16 * 16) = o; }
        if (cc + 1 < 31) { const int t1 = t0 + 64;
#pragma unroll
            for (int i = 0; i < 4; ++i) { const int c = tid + NTHR * i, row = c >> 5, c16 = c & 31; pk[i] = *(const u32x4*)(KC + (size_t)(t1 + row) * 1024 + h * 256 + c16 * 8); }
#pragma unroll
            for (int i = 0; i < 2; ++i) { const int c = tid + NTHR * i, row = c >> 4, c16 = c & 15; pv[i] = *(const u32x4*)(Mv + (size_t)(t1 + row) * 1024 + h * 256 + eh * 128 + c16 * 8); } }
        lds_barrier();
        const float decay = SCL[64 + cc];
#pragma unroll
        for (int et = 0; et < 4; ++et)
#pragma unroll
            for (int i = 0; i < 16; ++i) acc[et][i] *= decay;
#pragma unroll
        for (int i = 0; i < 16; ++i) accn[i] *= decay;
#pragma unroll
        for (int ks = 0; ks < 4; ++ks) {
            const bf16x8 bfr = tr_frag(ksm + kb_off + ks * 16 * KST, 4 * KST);
            {
                const f32x4 w0 = *(const f32x4*)(WSV + cc * 64 + ks * 16 + hh * 8), w1 = *(const f32x4*)(WSV + cc * 64 + ks * 16 + hh * 8 + 4);
                u32x4 wb; wb.x = cvt_pk(w0[0], w0[1]); wb.y = cvt_pk(w0[2], w0[3]); wb.z = cvt_pk(w1[0], w1[1]); wb.w = cvt_pk(w1[2], w1[3]);
                if (r != 0) wb = (u32x4){0u, 0u, 0u, 0u};
                accn = __builtin_amdgcn_mfma_f32_32x32x16_bf16(bfr, __builtin_bit_cast(bf16x8, wb), accn, 0, 0, 0); }
#pragma unroll
            for (int et = 0; et < 4; ++et) { const bf16x8 afr = tr_frag(vsm + vb_off + ks * 16 * VST + et * 64, 4 * VST);
                acc[et] = __builtin_amdgcn_mfma_f32_32x32x16_bf16(bfr, afr, acc[et], 0, 0, 0); }
        }
    }
}

__device__ __forceinline__ void mlstm_passB(const Params& p, unsigned char* lds, int unit) {
    const int tid = get_tid(), lane = tid & 63, wave = tid >> 6, r = lane & 31, hh = lane >> 5, li = lane & 15;
    const int b = unit >> 7, h = (unit >> 5) & 3, cc = unit & 31;
    unsigned char* ws = p.ws;
    const bf16_t* QC = (const bf16_t*)(ws + WS_QC); const bf16_t* KC = (const bf16_t*)(ws + WS_KC);
    const bf16_t* Mv = (const bf16_t*)(ws + WS_P + 5 * SEG_B); const bf16_t* Mo = (const bf16_t*)(ws + WS_P + 6 * SEG_B);
    const float* gate = (const float*)(ws + WS_GATE);
    const bf16_t* Cst = (const bf16_t*)(ws + WS_CST); const float* nst = (const float*)(ws + WS_NST); const float* mst = (const float*)(ws + WS_MST);
    bf16_t* Oc = (bf16_t*)(ws + WS_H);
    constexpr int QST = 528, VST = 544, WST = 144, HST = 1040;
    unsigned char* qsm = lds;
    unsigned char* ksm = qsm + 64 * QST;
    unsigned char* vsm = ksm + 64 * QST;
    unsigned char* wsm = vsm + 64 * VST;
    float* sc = (float*)(wsm + 64 * WST);
    float* hsm = (float*)lds;
    const int bhc = (b * 4 + h) * 32 + cc, t0 = b * S_ + cc * 64;
    __syncthreads();
    if (wave == 0) {
        const float ipre = gate[(size_t)(t0 + lane) * 16 + 8 + h] + p.m_ib[h], fpre = gate[(size_t)(t0 + lane) * 16 + 12 + h] + p.m_fb[h];
        float bc = logsig(fpre);
#pragma unroll
        for (int o = 1; o < 64; o <<= 1) { const float u = __shfl_up(bc, o); if (lane >= o) bc += u; }
        const float a = ipre - bc; float pm = a;
#pragma unroll
        for (int o = 1; o < 64; o <<= 1) { const float u = __shfl_up(pm, o); if (lane >= o) pm = fmaxf(pm, u); }
        const float mc = mst[bhc]; const float mt = bc + fmaxf(mc, pm);
        sc[lane] = bc - mt; sc[64 + lane] = a; sc[128 + lane] = mt; sc[192 + lane] = expf(bc + mc - mt);
    }
    bf16x8 cfr[16];
#pragma unroll
    for (int ks = 0; ks < 16; ++ks) cfr[ks] = *(const bf16x8*)(Cst + ((size_t)bhc * 256 + wave * 32 + r) * 256 + ks * 16 + hh * 8);
#pragma unroll
    for (int i = 0; i < 4; ++i) { const int c = tid + NTHR * i, row = c >> 5, c16 = c & 31;
        *(u32x4*)(qsm + row * QST + c16 * 16) = *(const u32x4*)(QC + (size_t)(t0 + row) * 1024 + h * 256 + c16 * 8);
        *(u32x4*)(ksm + row * QST + c16 * 16) = *(const u32x4*)(KC + (size_t)(t0 + row) * 1024 + h * 256 + c16 * 8);
        *(u32x4*)(vsm + row * VST + c16 * 16) = *(const u32x4*)(Mv + (size_t)(t0 + row) * 1024 + h * 256 + c16 * 8); }
    __syncthreads();
    if (wave < 3) {
        const int sb = wave >> 1, lb = wave ? 1 : 0;
        f32x16 s;
#pragma unroll
        for (int i = 0; i < 16; ++i) s[i] = 0.f;
#pragma unroll
        for (int ks = 0; ks < 16; ++ks) { const bf16x8 a = *(const bf16x8*)(ksm + (sb * 32 + r) * QST + ks * 32 + hh * 16), q = *(const bf16x8*)(qsm + (lb * 32 + r) * QST + ks * 32 + hh * 16);
            s = __builtin_amdgcn_mfma_f32_32x32x16_bf16(a, q, s, 0, 0, 0); }
        const int l = lb * 32 + r; const float bl = sc[l]; float rs = 0.f;
#pragma unroll
        for (int g = 0; g < 4; ++g) { float w[4];
#pragma unroll
            for (int e = 0; e < 4; ++e) { const int sI = sb * 32 + 8 * g + 4 * hh + e; w[e] = (sI <= l) ? s[4 * g + e] * __expf(bl + sc[64 + sI]) : 0.f; rs += w[e]; }
            u32x2 o; o.x = cvt_pk(w[0], w[1]); o.y = cvt_pk(w[2], w[3]);
            *(u32x2*)(wsm + l * WST + (sb * 32 + 8 * g + 4 * hh) * 2) = o; }
        sc[256 + l * 4 + sb * 2 + hh] = rs;
    } else if (wave == 3) {
        const int l = r;
#pragma unroll
        for (int g = 0; g < 4; ++g) { u32x2 o; o.x = 0u; o.y = 0u; *(u32x2*)(wsm + l * WST + (32 + 8 * g + 4 * hh) * 2) = o; }
        sc[256 + l * 4 + 2 + hh] = 0.f;
    }
    {
        const int l = tid & 63, part = tid >> 6; const float* np = nst + (size_t)bhc * 256 + part * 32; float s = 0.f;
#pragma unroll
        for (int q = 0; q < 4; ++q) { const u32x4 w = *(const u32x4*)(qsm + l * QST + part * 64 + q * 16);
            s += bflo(w.x) * np[8 * q] + bfhi(w.x) * np[8 * q + 1] + bflo(w.y) * np[8 * q + 2] + bfhi(w.y) * np[8 * q + 3] + bflo(w.z) * np[8 * q + 4] + bfhi(w.z) * np[8 * q + 5] + bflo(w.w) * np[8 * q + 6] + bfhi(w.w) * np[8 * q + 7]; }
        sc[512 + l * 8 + part] = s;
    }
    f32x16 acc[2];
#pragma unroll
    for (int lb = 0; lb < 2; ++lb)
#pragma unroll
        for (int i = 0; i < 16; ++i) acc[lb][i] = 0.f;
#pragma unroll
    for (int ks = 0; ks < 16; ++ks)
#pragma unroll
        for (int lb = 0; lb < 2; ++lb) { const bf16x8 q = *(const bf16x8*)(qsm + (lb * 32 + r) * QST + ks * 32 + hh * 16);
            acc[lb] = __builtin_amdgcn_mfma_f32_32x32x16_bf16(cfr[ks], q, acc[lb], 0, 0, 0); }
    __syncthreads();
#pragma unroll
    for (int lb = 0; lb < 2; ++lb) { const float it = sc[192 + lb * 32 + r];
#pragma unroll
        for (int i = 0; i < 16; ++i) acc[lb][i] *= it; }
    const int vb_off = (8 * hh + (li >> 2)) * VST + (wave * 32 + 16 * (r >> 4) + 4 * (li & 3)) * 2;
#pragma unroll
    for (int ks = 0; ks < 4; ++ks) { const bf16x8 afr = tr_frag(vsm + vb_off + ks * 16 * VST, 4 * VST);
#pragma unroll
        for (int lb = 0; lb < 2; ++lb) { if (lb == 0 && ks >= 2) continue;
            const bf16x8 wf = *(const bf16x8*)(wsm + (lb * 32 + r) * WST + ks * 32 + hh * 16);
            acc[lb] = __builtin_amdgcn_mfma_f32_32x32x16_bf16(afr, wf, acc[lb], 0, 0, 0); } }
    float ssq[2];
#pragma unroll
    for (int lb = 0; lb < 2; ++lb) { const int l = lb * 32 + r;
        const f32x4 rsv = *(const f32x4*)(sc + 256 + l * 4); const f32x4 q0 = *(const f32x4*)(sc + 512 + l * 8), q1 = *(const f32x4*)(sc + 512 + l * 8 + 4);
        const float den = (rsv[0] + rsv[1] + rsv[2] + rsv[3]) + sc[192 + l] * ((q0[0] + q0[1] + q0[2] + q0[3]) + (q1[0] + q1[1] + q1[2] + q1[3]));
        const float inv = 1.f / fmaxf(fabsf(den), __expf(-sc[128 + l]));
        float s2 = 0.f;
#pragma unroll
        for (int i = 0; i < 16; ++i) { acc[lb][i] *= inv; s2 += acc[lb][i] * acc[lb][i]; }
        s2 += __shfl_xor(s2, 32); ssq[lb] = s2; }
    __syncthreads();
    if (hh == 0) { sc[1024 + r * 8 + wave] = ssq[0]; sc[1024 + (32 + r) * 8 + wave] = ssq[1]; }
#pragma unroll
    for (int lb = 0; lb < 2; ++lb)
#pragma unroll
        for (int g = 0; g < 4; ++g) { f32x4 v; v[0] = acc[lb][4 * g]; v[1] = acc[lb][4 * g + 1]; v[2] = acc[lb][4 * g + 2]; v[3] = acc[lb][4 * g + 3];
            *(f32x4*)((unsigned char*)hsm + (lb * 32 + r) * HST + (wave * 32 + 8 * g + 4 * hh) * 4) = v; }
    __syncthreads();
#pragma unroll
    for (int i = 0; i < 4; ++i) { const int c = tid + NTHR * i, l = c >> 5, e0 = (c & 31) * 8;
        const f32x4 s0 = *(const f32x4*)(sc + 1024 + l * 8), s1 = *(const f32x4*)(sc + 1024 + l * 8 + 4);
        const float rr = rsqrtf(((s0[0] + s0[1] + s0[2] + s0[3]) + (s1[0] + s1[1] + s1[2] + s1[3])) * (1.f / 256.f) + EPS_);
        const f32x4 h0 = *(const f32x4*)((unsigned char*)hsm + l * HST + e0 * 4), h1 = *(const f32x4*)((unsigned char*)hsm + l * HST + e0 * 4 + 16);
        const f32x4 g0 = *(const f32x4*)(p.m_hg + h * 256 + e0), g1 = *(const f32x4*)(p.m_hg + h * 256 + e0 + 4);
        const u32x4 mo = *(const u32x4*)(Mo + (size_t)(t0 + l) * 1024 + h * 256 + e0);
        u32x4 o;
        o.x = cvt_pk(h0[0] * rr * g0[0] * sigm(bflo(mo.x)), h0[1] * rr * g0[1] * sigm(bfhi(mo.x))); o.y = cvt_pk(h0[2] * rr * g0[2] * sigm(bflo(mo.y)), h0[3] * rr * g0[3] * sigm(bfhi(mo.y)));
        o.z = cvt_pk(h1[0] * rr * g1[0] * sigm(bflo(mo.z)), h1[1] * rr * g1[1] * sigm(bfhi(mo.z))); o.w = cvt_pk(h1[2] * rr * g1[2] * sigm(bflo(mo.w)), h1[3] * rr * g1[3] * sigm(bfhi(mo.w)));
        *(u32x4*)(Oc + (size_t)(t0 + l) * D_ + 1024 + h * 256 + e0) = o; }
}

__device__ __forceinline__ void ce_desc(float& a, float& b) { const float hi = fmaxf(a, b), lo = fminf(a, b); a = hi; b = lo; }
__device__ __forceinline__ void sort16_desc(float (&v)[16]) {
#pragma unroll
    for (int k = 2; k <= 16; k <<= 1)
#pragma unroll
        for (int j = k >> 1; j > 0; j >>= 1)
#pragma unroll
            for (int i = 0; i < 16; ++i) { const int l = i ^ j; if (l > i) { if ((i & k) == 0) ce_desc(v[i], v[l]); else ce_desc(v[l], v[i]); } }
}
__device__ __forceinline__ void bmerge16_desc(float (&v)[16]) {
#pragma unroll
    for (int j = 8; j > 0; j >>= 1)
#pragma unroll
        for (int i = 0; i < 16; ++i) { const int l = i ^ j; if (l > i) ce_desc(v[i], v[l]); }
}
__device__ __forceinline__ void merge_top16(float (&a)[16], const float (&b)[16]) {
#pragma unroll
    for (int i = 0; i < 16; ++i) a[i] = fmaxf(a[i], b[15 - i]);
    bmerge16_desc(a);
}
__device__ __forceinline__ float pack_idx(float v, unsigned mask, unsigned idx) { return __builtin_bit_cast(float, (__builtin_bit_cast(unsigned, v) & mask) | idx); }
__device__ __forceinline__ void top16_from_acc(const f32x16 (&acc)[4], int h, float (&out)[16]) {
    float g[4][16];
#pragma unroll
    for (int mt = 0; mt < 4; ++mt) {
#pragma unroll
        for (int i = 0; i < 16; ++i) g[mt][i] = pack_idx(acc[mt][i], 0xffffff80u, (unsigned)(32 * mt + (i & 3) + 8 * (i >> 2)) | ((unsigned)h << 2));
        sort16_desc(g[mt]);
    }
    merge_top16(g[0], g[1]); merge_top16(g[2], g[3]); merge_top16(g[0], g[2]);
    float o[16];
#pragma unroll
    for (int i = 0; i < 16; ++i) o[i] = __shfl_xor(g[0][i], 32);
    merge_top16(g[0], o);
#pragma unroll
    for (int i = 0; i < 16; ++i) out[i] = g[0][i];
}
__device__ __forceinline__ unsigned lut16(const unsigned (&P)[4], unsigned i) {
    const unsigned long long lo = (unsigned long long)P[0] | ((unsigned long long)P[1] << 32), hi = (unsigned long long)P[2] | ((unsigned long long)P[3] << 32);
    const unsigned long long s = (i & 8u) ? hi : lo;
    return (unsigned)(s >> ((i & 7u) * 8u)) & 0xffu;
}
struct CandTab { int i[50]; int j[50]; };
constexpr CandTab make_cand_tab() { CandTab t{}; int n = 0; for (int i = 0; i < 16; ++i) for (int j = 0; j < 16; ++j) if ((i + 1) * (j + 1) <= 16) { t.i[n] = i; t.j[n] = j; ++n; } return t; }
__device__ __forceinline__ void phase_topk(const Params& p, unsigned char* lds, int bid, int nb) {
    const int tid = get_tid(), lane = tid & 63, wave = tid >> 6, r = lane & 31, h = lane >> 5;
    unsigned char* ws = p.ws;
    const bf16_t* Q = (const bf16_t*)(ws + WS_Q); int* IDX = (int*)(ws + WS_IDX); float* GW = (float*)(ws + WS_GW);
    constexpr int KP = 136;
    bf16_t* KS = (bf16_t*)lds;
    for (int i = tid; i < 2 * 2048; i += NTHR) {
        const int which = i >> 11, n = (i >> 4) & 127, d0 = (i & 15) * 8; const float* sp = (which ? p.sk2 : p.sk1) + n * 128 + d0;
        const f32x4 a = *(const f32x4*)sp, b = *(const f32x4*)(sp + 4);
        u32x4 hi, lo;
        hi.x = cvt_pk(a[0], a[1]); hi.y = cvt_pk(a[2], a[3]); hi.z = cvt_pk(b[0], b[1]); hi.w = cvt_pk(b[2], b[3]);
        lo.x = cvt_pk(a[0] - bflo(hi.x), a[1] - bfhi(hi.x)); lo.y = cvt_pk(a[2] - bflo(hi.y), a[3] - bfhi(hi.y)); lo.z = cvt_pk(b[0] - bflo(hi.z), b[1] - bfhi(hi.z)); lo.w = cvt_pk(b[2] - bflo(hi.w), b[3] - bfhi(hi.w));
        *(u32x4*)(KS + ((which * 2 + 0) * 128 + n) * KP + d0) = hi; *(u32x4*)(KS + ((which * 2 + 1) * 128 + n) * KP + d0) = lo; }
    __syncthreads();
    for (int item = bid * 8 + wave; item < 512 * 8; item += nb * 8) {
        const int tt = item >> 3, hh = item & 7, t = tt * 32 + r;
        float top[2][16];
#pragma unroll
        for (int list = 0; list < 2; ++list) {
            bf16x8 qf[8];
#pragma unroll
            for (int ks = 0; ks < 8; ++ks) qf[ks] = *(const bf16x8*)(Q + (size_t)t * D_ + hh * 256 + list * 128 + ks * 16 + h * 8);
            float g[4][16];
#pragma unroll
            for (int mt = 0; mt < 4; ++mt) {
                f32x16 acc;
#pragma unroll
                for (int i = 0; i < 16; ++i) acc[i] = 0.f;
#pragma unroll
                for (int hl = 0; hl < 2; ++hl)
#pragma unroll
                    for (int ks = 0; ks < 8; ++ks) { const bf16x8 a = *(const bf16x8*)(KS + ((list * 2 + hl) * 128 + mt * 32 + r) * KP + ks * 16 + h * 8);
                        acc = __builtin_amdgcn_mfma_f32_32x32x16_bf16(a, qf[ks], acc, 0, 0, 0); }
#pragma unroll
                for (int i = 0; i < 16; ++i) g[mt][i] = pack_idx(acc[i], 0xffffff80u, (unsigned)(32 * mt + (i & 3) + 8 * (i >> 2)) | ((unsigned)h << 2));
                sort16_desc(g[mt]);
                __builtin_amdgcn_sched_barrier(0);
            }
            merge_top16(g[0], g[1]); merge_top16(g[2], g[3]); merge_top16(g[0], g[2]);
            {   float o[16];
#pragma unroll
                for (int i = 0; i < 16; ++i) o[i] = __shfl_xor(g[0][i], 32);
                merge_top16(g[0], o); }
#pragma unroll
            for (int i = 0; i < 16; ++i) top[list][i] = g[0][i];
            __builtin_amdgcn_sched_barrier(0);
        }
        unsigned P1[4], P2[4];
#pragma unroll
        for (int q = 0; q < 4; ++q) { P1[q] = 0u; P2[q] = 0u;
#pragma unroll
            for (int e = 0; e < 4; ++e) { P1[q] |= (__builtin_bit_cast(unsigned, top[0][4 * q + e]) & 127u) << (8 * e); P2[q] |= (__builtin_bit_cast(unsigned, top[1][4 * q + e]) & 127u) << (8 * e); } }
        float c[4][16];
#pragma unroll
        for (int n = 0; n < 64; ++n) {
            if (n < 50) { constexpr CandTab CT = make_cand_tab(); const int i = CT.i[n], j = CT.j[n];
                c[n >> 4][n & 15] = pack_idx(top[0][i] + top[1][j], 0xffffff00u, (unsigned)(i * 16 + j)); }
            else c[n >> 4][n & 15] = -INFINITY;
        }
        sort16_desc(c[0]); __builtin_amdgcn_sched_barrier(0); sort16_desc(c[1]); __builtin_amdgcn_sched_barrier(0); merge_top16(c[0], c[1]); __builtin_amdgcn_sched_barrier(0);
        sort16_desc(c[2]); __builtin_amdgcn_sched_barrier(0); sort16_desc(c[3]); __builtin_amdgcn_sched_barrier(0); merge_top16(c[2], c[3]); __builtin_amdgcn_sched_barrier(0); merge_top16(c[0], c[2]);
        float ex[16], sum = 0.f;
#pragma unroll
        for (int k = 0; k < 16; ++k) { ex[k] = __expf(c[0][k] - c[0][0]); sum += ex[k]; }
        const float inv = 1.f / sum;
        if (h == 0) {
            int* ip = IDX + (size_t)t * 128 + hh * 16; float* gp = GW + (size_t)t * 128 + hh * 16;
#pragma unroll
            for (int q = 0; q < 4; ++q) { u32x4 iv; f32x4 gv;
#pragma unroll
                for (int e = 0; e < 4; ++e) { const unsigned pos = __builtin_bit_cast(unsigned, c[0][4 * q + e]) & 255u;
                    iv[e] = lut16(P1, pos >> 4) * 128u + lut16(P2, pos & 15u); gv[e] = ex[4 * q + e] * inv; }
                *(u32x4*)(ip + 4 * q) = iv; *(f32x4*)(gp + 4 * q) = gv; }
        }
    }
}

typedef float f32x2 __attribute__((ext_vector_type(2)));
__device__ __forceinline__ float dot16_fp8(const u32x4 w, const float (&h)[32], int o) {
    float s = 0.f;
#pragma unroll
    for (int q = 0; q < 4; ++q) { const f32x2 lo = __builtin_amdgcn_cvt_pk_f32_fp8((int)w[q], false), hi = __builtin_amdgcn_cvt_pk_f32_fp8((int)w[q], true);
        fmac(s, lo[0], h[o + 4 * q]); fmac(s, lo[1], h[o + 4 * q + 1]); fmac(s, hi[0], h[o + 4 * q + 2]); fmac(s, hi[1], h[o + 4 * q + 3]); }
    return s;
}
template <int CTRL, int ROW_MASK, int BANK_MASK>
__device__ __forceinline__ int dpp_mov0i(int v) { return __builtin_amdgcn_update_dpp(0, v, CTRL, ROW_MASK, BANK_MASK, true); }
__device__ __forceinline__ void quant_row_i8(const bf16_t* hp, int c16, unsigned (&hq)[32], float& hsc) {
    float mx = 0.f;
#pragma unroll
    for (int i = 0; i < 16; ++i) { const u32x4 w = *(const u32x4*)(hp + 256 * (i >> 1) + 8 * (i & 1));
#pragma unroll
        for (int e = 0; e < 4; ++e) mx = fmaxf(mx, fmaxf(fabsf(bflo(w[e])), fabsf(bfhi(w[e])))); }
    mx = fmaxf(mx, __shfl_xor(mx, 1)); mx = fmaxf(mx, __shfl_xor(mx, 2)); mx = fmaxf(mx, __shfl_xor(mx, 4)); mx = fmaxf(mx, __shfl_xor(mx, 8));
    mx = fmaxf(mx, 1e-30f); const float inv = 127.f / mx; hsc = mx * (1.f / 127.f);
    asm volatile("" ::: "memory");
#pragma unroll
    for (int i = 0; i < 16; ++i) { const u32x4 w = *(const u32x4*)(hp + 256 * (i >> 1) + 8 * (i & 1));
#pragma unroll
        for (int hh = 0; hh < 2; ++hh) { const unsigned w0 = w[2 * hh], w1 = w[2 * hh + 1];
            hq[2 * i + hh] = ((unsigned)__float2int_rn(bflo(w0) * inv) & 0xffu) | (((unsigned)__float2int_rn(bfhi(w0) * inv) & 0xffu) << 8) | (((unsigned)__float2int_rn(bflo(w1) * inv) & 0xffu) << 16) | (((unsigned)__float2int_rn(bfhi(w1) * inv) & 0xffu) << 24); } }
}
__device__ __forceinline__ void phase_peer1(const Params& p, unsigned char* lds, int bid, int nb, int probe) {
    const int tid = get_tid(), lane = tid & 63, wave = tid >> 6, r = lane >> 4, c16 = lane & 15;
    unsigned char* ws = p.ws;
    const bf16_t* H2 = (const bf16_t*)(ws + WS_H2); const int* IDX = (const int*)(ws + WS_IDX); const float* GW = (const float*)(ws + WS_GW);
    unsigned* EWT = (unsigned*)(ws + WS_EWT); const float* DSC = (const float*)(ws + WS_DSC);
    const unsigned char* E8D = ws + WS_E8D + 16 * c16; const unsigned emask = probe ? 0x3ffu : 0x3fffu;
    LAS unsigned* seq = (LAS unsigned*)((LAS unsigned char*)lds + (wave * 4 + r) * 1024);
    LAS unsigned* hist = (LAS unsigned*)((LAS unsigned char*)lds + 32768 + (wave * 4 + r) * 128);
    for (int tile = bid; tile < 256; tile += nb) {
        const int tA = tile * 64 + wave * 4 + r, tB = tA + 32;
        unsigned hqA[32], hqB[32]; float hscA, hscB;
        quant_row_i8(H2 + (size_t)tA * D_ + 16 * c16, c16, hqA, hscA);
        quant_row_i8(H2 + (size_t)tB * D_ + 16 * c16, c16, hqB, hscB);
        unsigned ppA0, ppA1, ppB0, ppB1;
        {   int idx[16]; unsigned pos[16];
#pragma unroll
            for (int m = 0; m < 8; ++m) { idx[m] = IDX[(size_t)tA * 128 + c16 + 16 * m]; idx[8 + m] = IDX[(size_t)tB * 128 + c16 + 16 * m]; }
            hist[c16] = 0u;
#pragma unroll
            for (int m = 0; m < 16; ++m) pos[m] = __hip_atomic_fetch_add(&hist[idx[m] >> 10], 1u, __ATOMIC_RELAXED, __HIP_MEMORY_SCOPE_WORKGROUP);
            {   const unsigned c = hist[c16]; unsigned inc = c;
#pragma unroll
                for (int o = 1; o < 16; o <<= 1) { const unsigned u = __shfl_up(inc, o, 16); if (c16 >= o) inc += u; }
                hist[c16] = inc - c; }
#pragma unroll
            for (int m = 0; m < 16; ++m) { pos[m] += hist[idx[m] >> 10]; seq[pos[m]] = (unsigned)idx[m] | ((unsigned)(c16 + 16 * (m & 7)) << 14) | ((unsigned)(m >> 3) << 21); }
            ppA0 = pos[0] | (pos[1] << 8) | (pos[2] << 16) | (pos[3] << 24); ppA1 = pos[4] | (pos[5] << 8) | (pos[6] << 16) | (pos[7] << 24);
            ppB0 = pos[8] | (pos[9] << 8) | (pos[10] << 16) | (pos[11] << 24); ppB1 = pos[12] | (pos[13] << 8) | (pos[14] << 16) | (pos[15] << 24);
        }
        u32x4 cur[8], nxt[8]; unsigned ecur = seq[0], enxt = 0u;
        {   const unsigned char* rp = E8D + (size_t)(ecur & emask) * 2048;
#pragma unroll
            for (int q = 0; q < 8; ++q) cur[q] = *(const u32x4*)(rp + 256 * q); }
        for (int s = 0; s < 256; ++s) {
            if (s + 1 < 256) { enxt = seq[s + 1]; const unsigned char* rp = E8D + (size_t)(enxt & emask) * 2048;
#pragma unroll
                for (int q = 0; q < 8; ++q) nxt[q] = *(const u32x4*)(rp + 256 * q); }
            int a0 = 0, a1 = 0, b0 = 0, b1 = 0;
#pragma unroll
            for (int q = 0; q < 8; ++q) {
                a0 = __builtin_amdgcn_sdot4((int)cur[q][0], (int)hqA[4 * q], a0, false); a1 = __builtin_amdgcn_sdot4((int)cur[q][1], (int)hqA[4 * q + 1], a1, false);
                a0 = __builtin_amdgcn_sdot4((int)cur[q][2], (int)hqA[4 * q + 2], a0, false); a1 = __builtin_amdgcn_sdot4((int)cur[q][3], (int)hqA[4 * q + 3], a1, false);
                b0 = __builtin_amdgcn_sdot4((int)cur[q][0], (int)hqB[4 * q], b0, false); b1 = __builtin_amdgcn_sdot4((int)cur[q][1], (int)hqB[4 * q + 1], b1, false);
                b0 = __builtin_amdgcn_sdot4((int)cur[q][2], (int)hqB[4 * q + 2], b0, false); b1 = __builtin_amdgcn_sdot4((int)cur[q][3], (int)hqB[4 * q + 3], b1, false); }
            int d = ((ecur >> 21) & 1u) ? (b0 + b1) : (a0 + a1);
            d += dpp_mov0i<0x111, 0xf, 0xf>(d); d += dpp_mov0i<0x112, 0xf, 0xf>(d); d += dpp_mov0i<0x114, 0xf, 0xe>(d); d += dpp_mov0i<0x118, 0xf, 0xc>(d);
            if (c16 == 15) seq[s] = (unsigned)d;
#pragma unroll
            for (int q = 0; q < 8; ++q) cur[q] = nxt[q];
            ecur = enxt;
        }
        if (probe) continue;
#pragma unroll
        for (int tk = 0; tk < 2; ++tk) {
            const int t = tk ? tB : tA; const float hsc = tk ? hscB : hscA;
            unsigned* ep = EWT + (size_t)(t >> 6) * 8192 + (t & 63) * 4;
#pragma unroll
            for (int m = 0; m < 8; ++m) { const int j = c16 + 16 * m; const int ix = IDX[(size_t)t * 128 + j];
                const unsigned ps = ((tk ? (m < 4 ? ppB0 : ppB1) : (m < 4 ? ppA0 : ppA1)) >> (8 * (m & 3))) & 0xffu;
                const float a = (float)(int)seq[ps] * hsc * DSC[ix];
                const float w = GW[(size_t)t * 128 + j] * 0.5f * a * (1.f + erff(a * 0.7071067811865476f));
                ep[(j >> 2) * 256 + (j & 3)] = (cvt_pk(0.f, w) & 0xffff0000u) | (unsigned)ix; }
        }
    }
}
__device__ __forceinline__ void phase_peer2(const Params& p, unsigned char* lds, int bid, int nb) {
    const int tid = get_tid(), lane = tid & 63, wave = tid >> 6;
    unsigned char* ws = p.ws;
    const unsigned* EWT = (const unsigned*)(ws + WS_EWT); const bf16_t* Y = (const bf16_t*)(ws + WS_X1); const float* mod = (const float*)(ws + WS_MOD);
    for (int si = bid; si < 256; si += nb) {
        const int s = (si & 7) * 32 + (si >> 3);
        __syncthreads();
        {   const u32x4* sp = (const u32x4*)(ws + WS_E8U + (size_t)s * 131072);
#pragma unroll
            for (int i = 0; i < 16; ++i) ((u32x4*)lds)[tid + NTHR * i] = sp[tid + NTHR * i]; }
        __syncthreads();
        const int tb0 = ((si >> 5) * 32 + wave) & 255;
        unsigned cur[16], nxt[16];
        {   const u32x4* wp = (const u32x4*)(EWT + (size_t)tb0 * 8192) + lane;
#pragma unroll
            for (int u = 0; u < 4; ++u) { const u32x4 v = wp[u * 64]; cur[4 * u] = v.x; cur[4 * u + 1] = v.y; cur[4 * u + 2] = v.z; cur[4 * u + 3] = v.w; } }
        float acc[8];
#pragma unroll
        for (int c = 0; c < 8; ++c) acc[c] = 0.f;
        f32x4 xa = {0.f, 0.f, 0.f, 0.f}, xb = xa;
        for (int q = 0; q < 256; ++q) {
            const int tb = (tb0 + 8 * (q >> 3)) & 255, g = q & 7;
            if (q + 1 < 256) { const int tbn = (tb0 + 8 * ((q + 1) >> 3)) & 255; const u32x4* wp = (const u32x4*)(EWT + (size_t)tbn * 8192 + ((q + 1) & 7) * 1024) + lane;
#pragma unroll
                for (int u = 0; u < 4; ++u) { const u32x4 v = wp[u * 64]; nxt[4 * u] = v.x; nxt[4 * u + 1] = v.y; nxt[4 * u + 2] = v.z; nxt[4 * u + 3] = v.w; } }
            const int t = tb * 64 + lane;
            if (g == 0) { xa = *(const f32x4*)(p.x + (size_t)t * D_ + 8 * s); xb = *(const f32x4*)(p.x + (size_t)t * D_ + 8 * s + 4);
                const u32x4 yw = *(const u32x4*)(Y + (size_t)t * D_ + 8 * s); const float* g1 = mod + (size_t)(t >> 11) * NMOD + 2 * D_ + 8 * s; const f32x4 ha = *(const f32x4*)g1, hb = *(const f32x4*)(g1 + 4);
                xa[0] += ha[0] * bflo(yw.x); xa[1] += ha[1] * bfhi(yw.x); xa[2] += ha[2] * bflo(yw.y); xa[3] += ha[3] * bfhi(yw.y); xb[0] += hb[0] * bflo(yw.z); xb[1] += hb[1] * bfhi(yw.z); xb[2] += hb[2] * bflo(yw.w); xb[3] += hb[3] * bfhi(yw.w); }
            u32x2 row[16];
#pragma unroll
            for (int u = 0; u < 16; ++u) row[u] = *(const LAS u32x2*)(unsigned)((cur[u] << 3) & 0x1fff8u);
#pragma unroll
            for (int u = 0; u < 16; ++u) {
                const float w = __builtin_bit_cast(float, cur[u]);
                const f32x2 v0 = __builtin_amdgcn_cvt_pk_f32_fp8((int)row[u].x, false), v1 = __builtin_amdgcn_cvt_pk_f32_fp8((int)row[u].x, true), v2 = __builtin_amdgcn_cvt_pk_f32_fp8((int)row[u].y, false), v3 = __builtin_amdgcn_cvt_pk_f32_fp8((int)row[u].y, true);
                fmac(acc[0], w, v0[0]); fmac(acc[1], w, v0[1]); fmac(acc[2], w, v1[0]); fmac(acc[3], w, v1[1]); fmac(acc[4], w, v2[0]); fmac(acc[5], w, v2[1]); fmac(acc[6], w, v3[0]); fmac(acc[7], w, v3[1]);
            }
            if (g == 7) {
                const float* g2 = mod + (size_t)(t >> 11) * NMOD + 5 * D_ + 8 * s;
                const f32x4 ga = *(const f32x4*)g2, gb = *(const f32x4*)(g2 + 4);
                f32x4 oa, ob;
#pragma unroll
                for (int c = 0; c < 4; ++c) { oa[c] = xa[c] + ga[c] * acc[c] * (1.f / 32.f); ob[c] = xb[c] + gb[c] * acc[4 + c] * (1.f / 32.f); }
                *(f32x4*)(p.out + (size_t)t * D_ + 8 * s) = oa; *(f32x4*)(p.out + (size_t)t * D_ + 8 * s + 4) = ob;
#pragma unroll
                for (int c = 0; c < 8; ++c) acc[c] = 0.f;
            }
#pragma unroll
            for (int u = 0; u < 16; ++u) cur[u] = nxt[u];
        }
    }
}

typedef const __attribute__((address_space(4))) Params* KargPtr;
__device__ __forceinline__ Params load_params() {
#if defined(__HIP_DEVICE_COMPILE__)
    KargPtr kp = (KargPtr)__builtin_amdgcn_kernarg_segment_ptr(); asm volatile("" : "+s"(kp)); Params r; __builtin_memcpy(&r, kp, sizeof(Params)); return r;
#else
    return Params{};
#endif
}
constexpr int N_PHASES = 12;
constexpr int LDS_BYTES = 152 * 1024;
__global__ void __launch_bounds__(NTHR) fwd_kernel(Params p_arg) {
    extern __shared__ __attribute__((aligned(16))) unsigned char lds[];
    const int bid = blockIdx.x, nb = gridDim.x, tid = get_tid();
    unsigned char* ws = p_arg.ws;
    volatile LAS unsigned* xbst = (volatile LAS unsigned*)((LAS unsigned char*)lds + LDS_BYTES - 16);
    if (tid == 0) { xbst[0] = 0u; xbst[1] = 0u; xbst[2] = 0u; xbst[3] = 0u; }
    __syncthreads();
    if ((p_arg.ph_hi - p_arg.ph_lo) > 1) (void)xcd_barrier_post((unsigned*)(ws + WS_BAR), xbst);
#ifdef ONLY_PHASE
#define IN(k) ((k) == ONLY_PHASE && p.ph_lo <= (k) && (k) < p.ph_hi)
#else
#define IN(k) (p.ph_lo <= (k) && (k) < p.ph_hi)
#endif
#define SEAM(k) do { const Params p = load_params(); if (p.ph_lo <= (k) && (k) + 1 < p.ph_hi) { XcdBarrier bar; bar.bar = (unsigned*)(p.ws + WS_BAR); bar.x = xb_xcc_id(); bar.st = xbst; xcd_barrier(bar); } } while (0)
#ifndef REPEAT_MASK
#define REPEAT_MASK 0
#endif
#define REP(k) for (int rep_ = 0; rep_ < (((REPEAT_MASK) >> (k)) & 1) + 1; ++rep_)
    REP(0) { const Params p = load_params(); if (IN(0)) { unsigned char* ws = p.ws; const float* mod = (const float*)(ws + WS_MOD); (void)mod;
        phase_prep(p, lds, bid, nb);
    } }
    SEAM(0);
    REP(1) { const Params p = load_params(); if (IN(1)) { unsigned char* ws = p.ws; const float* mod = (const float*)(ws + WS_MOD); (void)mod;
        phase_norm<false>(p.x, nullptr, 0, p.g1, mod, 0, D_, (bf16_t*)(ws + WS_H), bid, nb);
    } }
    SEAM(1);
    REP(2) { const Params p = load_params(); if (IN(2)) { unsigned char* ws = p.ws; const float* mod = (const float*)(ws + WS_MOD); (void)mod;
        phase_gates(p, lds, bid, nb);
        { pg8::Gemm g{(const bf16_t*)(ws + WS_H), (const bf16_t*)(ws + WS_WINT), T_, 7168, D_}; pg8::StaticOrder S; S.init(T_, 7168, nb, bid);
        pg8::EpiSeg E{(bf16_t*)(ws + WS_P)}; pg8::gemm_phase<pg8::EpiSeg, pg8::StaticOrder, true, true>((LAS unsigned char*)lds, g, S, E); }
    } }
    SEAM(2);
    REP(3) { const Params p = load_params(); if (IN(3)) { unsigned char* ws = p.ws; const float* mod = (const float*)(ws + WS_MOD); (void)mod;
        phase_post(p, bid, nb);
    } }
    SEAM(3);
    REP(4) { const Params p = load_params(); if (IN(4)) { unsigned char* ws = p.ws; const float* mod = (const float*)(ws + WS_MOD); (void)mod;
        { for (int u = bid; u < 64; u += nb) mlstm_passA(p, lds, u);
        unsigned* qctr = (unsigned*)(ws + WS_QCTR) + rep_; LAS int* slot = (LAS int*)((LAS unsigned char*)lds + LDS_BYTES - 32);
        for (;;) { __syncthreads(); if (tid == 0) *slot = (int)atomicAdd(qctr, 1u); __syncthreads(); const int u = *slot; if (u >= 512) break;
            const int bh = u & 63; fox_unit(p, lds, bh >> 3, bh & 7, 7 - (u >> 6)); } }
    } }
    SEAM(4);
    REP(5) { const Params p = load_params(); if (IN(5)) { unsigned char* ws = p.ws; const float* mod = (const float*)(ws + WS_MOD); (void)mod;
        { for (int u = bid; u < 1024; u += nb) mlstm_passB(p, lds, u); }
    } }
    SEAM(5);
    REP(6) { const Params p = load_params(); if (IN(6)) { unsigned char* ws = p.ws; const float* mod = (const float*)(ws + WS_MOD); (void)mod;
        { pg8::Gemm g{(const bf16_t*)(ws + WS_H), (const bf16_t*)(ws + WS_WOT), T_, D_, D_}; pg8::StaticOrder S; S.init(T_, D_, nb, bid);
        pg8::EpiBf E{(bf16_t*)(ws + WS_X1), D_}; pg8::gemm_phase<pg8::EpiBf, pg8::StaticOrder, true, true>((LAS unsigned char*)lds, g, S, E); }
    } }
    SEAM(6);
    REP(7) { const Params p = load_params(); if (IN(7)) { unsigned char* ws = p.ws; const float* mod = (const float*)(ws + WS_MOD); (void)mod;
        convert_experts(p, bid, nb);
    } }
    REP(7) { const Params p = load_params(); if (IN(7)) { unsigned char* ws = p.ws; const float* mod = (const float*)(ws + WS_MOD); (void)mod;
        phase_norm<true>(p.x, (const bf16_t*)(ws + WS_X1), 2 * D_, p.g2, mod, 3 * D_, 4 * D_, (bf16_t*)(ws + WS_H2), bid, nb);
    } }
    SEAM(7);
    REP(8) { const Params p = load_params(); if (IN(8)) { unsigned char* ws = p.ws; const float* mod = (const float*)(ws + WS_MOD); (void)mod;
        { pg8::Gemm g{(const bf16_t*)(ws + WS_H2), (const bf16_t*)(ws + WS_WQT), T_, D_, D_}; pg8::StaticOrder S; S.init(T_, D_, nb, bid);
        pg8::EpiBf E{(bf16_t*)(ws + WS_Q), D_}; pg8::gemm_phase<pg8::EpiBf, pg8::StaticOrder, true, true>((LAS unsigned char*)lds, g, S, E); }
    } }
    SEAM(8);
    REP(9) { const Params p = load_params(); if (IN(9)) { unsigned char* ws = p.ws; const float* mod = (const float*)(ws + WS_MOD); (void)mod;
        phase_topk(p, lds, bid, nb);
    } }
    SEAM(9);
    REP(10) { const Params p = load_params(); if (IN(10)) { unsigned char* ws = p.ws; const float* mod = (const float*)(ws + WS_MOD); (void)mod;
#ifdef PROBE_L2
        phase_peer1(p, lds, bid, nb, rep_);
#else
        phase_peer1(p, lds, bid, nb, 0);
#endif
    } }
    SEAM(10);
    REP(11) { const Params p = load_params(); if (IN(11)) { unsigned char* ws = p.ws; const float* mod = (const float*)(ws + WS_MOD); (void)mod;
        phase_peer2(p, lds, bid, nb);
    } }
#undef IN
#undef SEAM
}

#ifndef ONE_LAUNCH
#define ONE_LAUNCH 1
#endif
extern "C" void kernel_launch(void* const* d_in, const int* in_sizes, int n_in, void* d_out, int out_size, void* d_ws, size_t ws_size, hipStream_t stream) {
    static int grid = 0;
    if (grid == 0) {
        int dev = 0, cus = 0, per_cu = 0;
        if (n_in != 21 || ws_size < WS_END) { fprintf(stderr, "kernel_launch: unexpected n_in %d / ws_size %zu (need %zu)\n", n_in, ws_size, (size_t)WS_END); grid = -1; return; }
        hipGetDevice(&dev); hipDeviceGetAttribute(&cus, hipDeviceAttributeMultiprocessorCount, dev);
        if (hipFuncSetAttribute((const void*)fwd_kernel, hipFuncAttributeMaxDynamicSharedMemorySize, LDS_BYTES) != hipSuccess) { fprintf(stderr, "kernel_launch: hipFuncSetAttribute failed\n"); grid = -1; return; }
        if (hipOccupancyMaxActiveBlocksPerMultiprocessor(&per_cu, (const void*)fwd_kernel, NTHR, LDS_BYTES) != hipSuccess || per_cu < 1) { fprintf(stderr, "kernel_launch: occupancy query says %d\n", per_cu); (void)hipGetLastError(); }
        grid = cus > 0 ? cus : 256;
    }
    if (grid < 0) return;
    Params p{};
    const float** pp = (const float**)&p;
    for (int i = 0; i < 21; ++i) pp[i] = (const float*)d_in[i];
    p.out = (float*)d_out; p.ws = (unsigned char*)d_ws;
    hipMemsetAsync((char*)d_ws + WS_BAR, 0, 16384, stream);
#if ONE_LAUNCH
    p.ph_lo = 0; p.ph_hi = N_PHASES;
    void* args[] = {&p};
    hipError_t e = hipLaunchCooperativeKernel((const void*)fwd_kernel, dim3(grid), dim3(NTHR), args, LDS_BYTES, stream);
    if (e != hipSuccess) fprintf(stderr, "cooperative launch failed: %s (grid %d)\n", hipGetErrorString(e), grid);
#else
    for (int ph = 0; ph < N_PHASES; ++ph) { p.ph_lo = ph; p.ph_hi = ph + 1; hipLaunchKernelGGL(fwd_kernel, dim3(grid), dim3(NTHR), LDS_BYTES, stream, p); }
#endif
}
```

```cpp
#include <hip/hip_runtime.h>
#include <cstdio>
#include <cstdint>

#define GAS __attribute__((address_space(1)))
#define LAS __attribute__((address_space(3)))
typedef unsigned short bf16_t;
typedef short bf16x8 __attribute__((ext_vector_type(8)));
typedef float f32x4 __attribute__((ext_vector_type(4)));
typedef float f32x16 __attribute__((ext_vector_type(16)));
typedef unsigned u32x4 __attribute__((ext_vector_type(4)));
typedef unsigned u32x2 __attribute__((ext_vector_type(2)));

constexpr int T_ = 16384, D_ = 2048, B_ = 8, S_ = 2048, NTHR = 512;
constexpr float EPS_ = 1e-6f;
constexpr int NMOD = 6 * D_;
constexpr int INCOLS = 7184;

constexpr size_t WS_BAR   = 0;
constexpr size_t WS_MOD   = 16384;
constexpr size_t WS_WG    = WS_MOD + (size_t)B_ * NMOD * 4;
constexpr size_t WS_GATE  = WS_WG + 16 * 2048 * 4;
constexpr size_t WS_F     = WS_GATE + (size_t)T_ * 16 * 4;
constexpr size_t WS_NST   = WS_F + 64 * 2048 * 4;
constexpr size_t WS_MST   = WS_NST + 1024 * 256 * 4;
constexpr size_t WS_DSC   = WS_MST + 4096;
constexpr size_t WS_WINT  = WS_DSC + 16384 * 4;
constexpr size_t WS_WOT   = WS_WINT + (size_t)7168 * 2048 * 2;
constexpr size_t WS_WQT   = WS_WOT + (size_t)2048 * 2048 * 2;
constexpr size_t WS_H     = WS_WQT + (size_t)2048 * 2048 * 2;
constexpr size_t WS_P     = WS_H + (size_t)T_ * 2048 * 2;
constexpr size_t SEG_B    = (size_t)T_ * 1024 * 2;
constexpr size_t WS_CST   = WS_P + 7 * SEG_B;
constexpr size_t WS_E8D   = WS_CST + (size_t)1024 * 256 * 256 * 2;
constexpr size_t WS_E8U   = WS_E8D + (size_t)16384 * 2048;
constexpr size_t WS_END   = WS_E8U + (size_t)16384 * 2048;
constexpr size_t WS_QC    = WS_E8D;
constexpr size_t WS_KC    = WS_E8U;
constexpr size_t WS_QCTR  = 15360;
constexpr size_t WS_H2    = WS_P;
constexpr size_t WS_Q     = WS_H2 + (size_t)T_ * 2048 * 2;
constexpr size_t WS_IDX   = WS_Q + (size_t)T_ * 2048 * 2;
constexpr size_t WS_GW    = WS_IDX + (size_t)T_ * 128 * 4;
static_assert(WS_GW + (size_t)T_ * 128 * 4 <= WS_CST, "alias overflow");
constexpr size_t WS_X1    = WS_CST;
constexpr size_t WS_EWT   = WS_GW + (size_t)T_ * 128 * 4;
static_assert(WS_EWT + (size_t)T_ * 128 * 4 <= WS_CST, "alias overflow 2");

struct Params {
    const float *x, *c, *w_ada, *b_ada, *g1, *g2, *w_in, *fox_fb, *fox_qg, *fox_kg, *conv_w, *conv_b, *m_ib, *m_fb, *m_hg, *w_out, *w_q, *sk1, *sk2, *e_down, *e_up;
    float* out; unsigned char* ws; int ph_lo, ph_hi;
};

__device__ __forceinline__ int get_tid() { int t = threadIdx.x; asm volatile("" : "+v"(t)); return t; }
__device__ __forceinline__ void lds_barrier() { asm volatile("s_waitcnt lgkmcnt(0)\n\ts_barrier" ::: "memory"); }
__device__ __forceinline__ unsigned cvt_pk(float lo, float hi) { unsigned r; asm("v_cvt_pk_bf16_f32 %0, %1, %2" : "=v"(r) : "v"(lo), "v"(hi)); return r; }
__device__ __forceinline__ void fmac(float& acc, float a, float b) { asm("v_fmac_f32 %0, %1, %2" : "+v"(acc) : "v"(a), "v"(b)); }
__device__ __forceinline__ float bf2f(unsigned short h) { return __builtin_bit_cast(float, ((unsigned)h) << 16); }
__device__ __forceinline__ float bflo(unsigned w) { return __builtin_bit_cast(float, w << 16); }
__device__ __forceinline__ float bfhi(unsigned w) { return __builtin_bit_cast(float, w & 0xffff0000u); }
__device__ __forceinline__ float wsum(float v) {
#pragma unroll
    for (int o = 32; o; o >>= 1) v += __shfl_xor(v, o);
    return v; }
__device__ __forceinline__ float wmax(float v) {
#pragma unroll
    for (int o = 32; o; o >>= 1) v = fmaxf(v, __shfl_xor(v, o));
    return v; }
__device__ __forceinline__ float logsig(float x) { return fminf(x, 0.f) - log1pf(expf(-fabsf(x))); }
__device__ __forceinline__ float sigm(float x) { return 1.f / (1.f + expf(-x)); }
__device__ __forceinline__ float silu_f(float x) { return x / (1.f + expf(-x)); }
namespace pg8 {
#define PG8_LAS __attribute__((address_space(3)))
typedef unsigned short bf16_t;
typedef short bf16x8 __attribute__((ext_vector_type(8)));
typedef float f32x4 __attribute__((ext_vector_type(4)));
typedef unsigned u32x4 __attribute__((ext_vector_type(4)));
constexpr int BM = 256, BK = 64, HALF = 128, HTB = HALF * BK * 2  , STAGE_BYTES = 8 * HTB, NXCD = 8, WGM = 8;

__host__ __device__ __forceinline__ int lds_byte(int r, int c) { const int st = (r >> 4) * 2 + (c >> 5), rr = r & 15, cc = c & 31, ob = rr * 64 + cc * 2; return st * 1024 + (ob ^ (((ob >> 9) & 1) << 5)); }
__host__ __device__ __forceinline__ void stage_rc(int b, int& R, int& C) { const int st = b / 1024, sb = b % 1024, swz = sb ^ (((sb >> 9) & 1) << 5); R = (st >> 1) * 16 + swz / 64; C = (st & 1) * 32 + (swz % 64) / 2; }
__host__ __device__ __forceinline__ int perm32(int rho) { const int n = rho >> 4, i = rho & 15; return 8 * (i >> 2) + 4 * n + (i & 3); }

struct Unit { int pm, pn; };
struct Gemm { const bf16_t* A; const bf16_t* Bt; int M, N, K; };

struct StaticOrder {
    int nM, nN, nwg, G, c;
    __host__ __device__ void init(int M, int N, int G_, int c_) { nM = M / BM; nN = N / BM; nwg = nM * nN; G = G_; c = c_; }
    __host__ __device__ bool next(int i, Unit& u) const {
        const long L = (long)i * G + c; if (L >= nwg) return false;
        int wgid = (int)L; { const int q = nwg / NXCD, r = nwg % NXCD, xcd = wgid % NXCD, off = wgid / NXCD; wgid = (xcd < r ? xcd * (q + 1) : r * (q + 1) + (xcd - r) * q) + off; }
        const int nig = WGM * nN, gid = wgid / nig, fm = gid * WGM, gsz = (nM - fm) < WGM ? (nM - fm) : WGM;
        u.pm = fm + ((wgid % nig) % gsz); u.pn = (wgid % nig) / gsz; return true;
    }
    __device__ __forceinline__ void a_ready(const Unit&) const {}
    __device__ __forceinline__ void done(const Unit&) const {}
};
struct EpiSeg {
    static constexpr bool PERM = true, AFTER_DRAIN = false;
    bf16_t* P; const float* qg; const float* kg; PG8_LAS float* X;
    __device__ __forceinline__ void operator()(const f32x4 (&acc)[2][2][4][2], const Unit& u, int wr, int wc, int fr, int fq) const {
        const int seg = u.pn >> 2; bf16_t* base = P + (size_t)seg * ((size_t)T_ * 1024);
        const int row0 = u.pm * BM + wr * 64 + fr, col0 = (u.pn & 3) * 256 + wc * 32 + 8 * fq;
        if (seg < 2) {
            float ss[2][4][2];
#pragma unroll
            for (int ai = 0; ai < 2; ++ai)
#pragma unroll
                for (int m = 0; m < 4; ++m)
#pragma unroll
                    for (int bj = 0; bj < 2; ++bj) { const f32x4 v0 = acc[ai][bj][m][0], v1 = acc[ai][bj][m][1];
                        float s = v0[0] * v0[0] + v0[1] * v0[1] + v0[2] * v0[2] + v0[3] * v0[3] + v1[0] * v1[0] + v1[1] * v1[1] + v1[2] * v1[2] + v1[3] * v1[3];
                        s += __shfl_xor(s, 16); s += __shfl_xor(s, 32); ss[ai][m][bj] = s; }
            if (fq == 0) {
#pragma unroll
                for (int ai = 0; ai < 2; ++ai)
#pragma unroll
                    for (int m = 0; m < 4; ++m)
#pragma unroll
                        for (int bj = 0; bj < 2; ++bj) X[((ai * HALF + wr * 64 + m * 16 + fr) * 2 + bj) * 4 + wc] = ss[ai][m][bj];
            }
            asm volatile("s_waitcnt lgkmcnt(0)\n\ts_barrier" ::: "memory");
            const float* gn = (seg ? kg : qg) + wc * 32 + 8 * fq;
            const f32x4 g0 = *(const f32x4*)gn, g1 = *(const f32x4*)(gn + 4);
            const float sc = seg ? 1.f : 0.08838834764831845f * 1.4426950408889634f;
#pragma unroll
            for (int ai = 0; ai < 2; ++ai)
#pragma unroll
                for (int m = 0; m < 4; ++m) { bf16_t* rowp = base + (size_t)(row0 + ai * HALF + m * 16) * 1024 + col0;
#pragma unroll
                    for (int bj = 0; bj < 2; ++bj) { const f32x4 pv = *(const PG8_LAS f32x4*)(X + ((ai * HALF + wr * 64 + m * 16 + fr) * 2 + bj) * 4);
                        const float rr = rsqrtf((pv[0] + pv[1] + pv[2] + pv[3]) * (1.f / 128.f) + EPS_) * sc;
                        const f32x4 v0 = acc[ai][bj][m][0] * rr * g0, v1 = acc[ai][bj][m][1] * rr * g1;
                        u32x4 w; w.x = cvt_pk(v0[0], v0[1]); w.y = cvt_pk(v0[2], v0[3]); w.z = cvt_pk(v1[0], v1[1]); w.w = cvt_pk(v1[2], v1[3]);
                        *(u32x4*)(rowp + bj * HALF) = w; } }
            return;
        }
#pragma unroll
        for (int ai = 0; ai < 2; ++ai)
#pragma unroll
            for (int m = 0; m < 4; ++m) { bf16_t* rowp = base + (size_t)(row0 + ai * HALF + m * 16) * 1024 + col0;
#pragma unroll
                for (int bj = 0; bj < 2; ++bj) { const f32x4 v0 = acc[ai][bj][m][0], v1 = acc[ai][bj][m][1];
                    u32x4 w; w.x = cvt_pk(v0[0], v0[1]); w.y = cvt_pk(v0[2], v0[3]); w.z = cvt_pk(v1[0], v1[1]); w.w = cvt_pk(v1[2], v1[3]);
                    *(u32x4*)(rowp + bj * HALF) = w; } }
    }
};
struct EpiBf {
    static constexpr bool PERM = true, AFTER_DRAIN = false;
    bf16_t* O; int ldc;
    __device__ __forceinline__ void operator()(const f32x4 (&acc)[2][2][4][2], const Unit& u, int wr, int wc, int fr, int fq) const {
        const int row0 = u.pm * BM + wr * 64 + fr, col0 = u.pn * BM + wc * 32 + 8 * fq;
#pragma unroll
        for (int ai = 0; ai < 2; ++ai)
#pragma unroll
            for (int m = 0; m < 4; ++m) { bf16_t* rowp = O + (size_t)(row0 + ai * HALF + m * 16) * ldc + col0;
#pragma unroll
                for (int bj = 0; bj < 2; ++bj) { const f32x4 v0 = acc[ai][bj][m][0], v1 = acc[ai][bj][m][1];
                    u32x4 w; w.x = cvt_pk(v0[0], v0[1]); w.y = cvt_pk(v0[2], v0[3]); w.z = cvt_pk(v1[0], v1[1]); w.w = cvt_pk(v1[2], v1[3]);
                    *(u32x4*)(rowp + bj * HALF) = w; } }
    }
};
struct EpiRes {
    static constexpr bool PERM = false, AFTER_DRAIN = false;
    const float* X; float* O; const float* mod; int goff;
    __device__ __forceinline__ void operator()(const f32x4 (&acc)[2][2][4][2], const Unit& u, int wr, int wc, int fr, int fq) const {
        const int row0 = u.pm * BM + wr * 64 + fr, col0 = u.pn * BM + wc * 32 + 4 * fq;
        const float* gp = mod + (size_t)((u.pm * BM) >> 11) * NMOD + goff + col0;
        f32x4 gv[2][2];
#pragma unroll
        for (int bj = 0; bj < 2; ++bj)
#pragma unroll
            for (int n = 0; n < 2; ++n) gv[bj][n] = *(const f32x4*)(gp + bj * HALF + 16 * n);
#pragma unroll
        for (int ai = 0; ai < 2; ++ai)
#pragma unroll
            for (int m = 0; m < 4; ++m) { const size_t ro = (size_t)(row0 + ai * HALF + m * 16) * D_ + col0;
#pragma unroll
                for (int bj = 0; bj < 2; ++bj)
#pragma unroll
                    for (int n = 0; n < 2; ++n) { const f32x4 xv = *(const f32x4*)(X + ro + bj * HALF + 16 * n);
                        *(f32x4*)(O + ro + bj * HALF + 16 * n) = xv + gv[bj][n] * acc[ai][bj][m][n]; } }
    }
};
template <class Epi, class Sched, bool ALIGN_EPI = false, bool SP2 = false>
__device__ __forceinline__ void gemm_phase(PG8_LAS unsigned char* lds, const Gemm g, const Sched& S, const Epi& E) {
    const int tid = get_tid(), wid = __builtin_amdgcn_readfirstlane(tid >> 6), lane = tid & 63, wr = wid >> 2, wc = wid & 3, fr = lane & 15, fq = lane >> 4;
    const int K = g.K, nt = K / BK;
    unsigned voffA[2], voffB[2];
#pragma unroll
    for (int i = 0; i < 2; ++i) { int R, C; stage_rc(tid * 16 + i * 8192, R, C); const int Rb = Epi::PERM ? ((R & ~31) + perm32(R & 31)) : R;
        voffA[i] = (unsigned)(R * K + C) * 2u; voffB[i] = (unsigned)(Rb * K + C) * 2u; }
    const size_t kstep = (size_t)(BK * 2);
    const size_t hstep = (size_t)HALF * K * 2;
    const size_t tstep = 2 * hstep;
    const unsigned ldsw = (unsigned)wid * 1024u;
    const int aoff = lds_byte(wr * 64 + fr, fq * 8), boff = lds_byte(wc * 32 + fr, fq * 8);
#define PG8_SA(b, h) (((b) * 2 + (h)) * HTB)
#define PG8_SB(b, h) ((4 + (b) * 2 + (h)) * HTB)
#define PG8_STAGE(bufoff, gbase, voff) do { _Pragma("unroll") for (int _i = 0; _i < 2; ++_i) \
        __builtin_amdgcn_global_load_lds((const unsigned*)((const char*)(gbase) + (voff)[_i]), (PG8_LAS unsigned*)(lds + (bufoff) + ldsw + _i * 8192), 16, 0, 0); } while (0)
#define PG8_LDA(dst, b, h) do { _Pragma("unroll") for (int m = 0; m < 4; ++m) _Pragma("unroll") for (int k = 0; k < 2; ++k) dst[m][k] = *(const PG8_LAS bf16x8*)(lds + PG8_SA(b, h) + aoff + m * 2048 + k * 1024); } while (0)
#define PG8_LDB(dst, b, h) do { _Pragma("unroll") for (int n = 0; n < 2; ++n) _Pragma("unroll") for (int k = 0; k < 2; ++k) dst[n][k] = *(const PG8_LAS bf16x8*)(lds + PG8_SB(b, h) + boff + n * 2048 + k * 1024); } while (0)
#define PG8_MMA(ai, bj, At, Bt) do { __builtin_amdgcn_s_setprio(1); _Pragma("unroll") for (int m = 0; m < 4; ++m) _Pragma("unroll") for (int n = 0; n < 2; ++n) _Pragma("unroll") for (int k = 0; k < 2; ++k) \
        acc[ai][bj][m][n] = __builtin_amdgcn_mfma_f32_16x16x32_bf16(Bt[n][k], At[m][k], acc[ai][bj][m][n], 0, 0, 0); __builtin_amdgcn_s_setprio(0); } while (0)
#define PG8_WAIT_V(n) asm volatile("s_waitcnt vmcnt(" #n ")" ::: "memory")
#define PG8_WAIT_L(n) asm volatile("s_waitcnt lgkmcnt(" #n ")" ::: "memory")
#define PG8_BAR __builtin_amdgcn_s_barrier()
#define PG8_SCHED __builtin_amdgcn_sched_barrier(0)
    Unit cur, nxt; int ui = 0;
    if (!S.next(0, cur)) return;
    f32x4 acc[2][2][4][2];
#pragma unroll
    for (int a = 0; a < 2; ++a)
#pragma unroll
        for (int b = 0; b < 2; ++b)
#pragma unroll
            for (int m = 0; m < 4; ++m)
#pragma unroll
                for (int n = 0; n < 2; ++n) acc[a][b][m][n] = (f32x4){0.f, 0.f, 0.f, 0.f};
    bf16x8 At[4][2], B0[2][2], B1[2][2];
    const char* cA = (const char*)g.A + (size_t)cur.pm * tstep; const char* cB = (const char*)g.Bt + (size_t)cur.pn * tstep;
    S.a_ready(cur);
    if constexpr (SP2) {
        PG8_STAGE(PG8_SB(0, 0), cB, voffB); PG8_STAGE(PG8_SB(0, 1), cB + hstep, voffB); PG8_STAGE(PG8_SA(0, 0), cA, voffA); PG8_STAGE(PG8_SA(0, 1), cA + hstep, voffA);
        if (wr == 1) PG8_BAR;
        PG8_WAIT_V(2); PG8_BAR;
        PG8_STAGE(PG8_SB(1, 0), cB + kstep, voffB); PG8_STAGE(PG8_SA(1, 0), cA + kstep, voffA); PG8_STAGE(PG8_SB(1, 1), cB + hstep + kstep, voffB);
        PG8_WAIT_V(6); PG8_BAR;
    } else {
        PG8_STAGE(PG8_SB(0, 0), cB, voffB); PG8_STAGE(PG8_SA(0, 0), cA, voffA); PG8_STAGE(PG8_SB(0, 1), cB + hstep, voffB); PG8_STAGE(PG8_SA(0, 1), cA + hstep, voffA);
        if (wr == 1) PG8_BAR;
        PG8_WAIT_V(4); PG8_BAR;
        PG8_STAGE(PG8_SB(1, 0), cB + kstep, voffB); PG8_STAGE(PG8_SA(1, 0), cA + kstep, voffA); PG8_STAGE(PG8_SB(1, 1), cB + hstep + kstep, voffB);
        PG8_WAIT_V(6); PG8_BAR;
    }
    for (;;) {
        const bool has_next = S.next(ui + 1, nxt);
        const char* nA = has_next ? (const char*)g.A + (size_t)nxt.pm * tstep : cA; const char* nB = has_next ? (const char*)g.Bt + (size_t)nxt.pn * tstep : cB;
        for (int t = 0; t < nt; t += 2) {
            const bool last = (t == nt - 2);
            const char* a1 = cA + (size_t)(t + 1) * kstep;
            const char* a2 = last ? nA : cA + (size_t)(t + 2) * kstep; const char* b2 = last ? nB : cB + (size_t)(t + 2) * kstep;
            const char* a3 = a2 + kstep; const char* b3 = b2 + kstep;
            if (last && has_next) S.a_ready(nxt);
            if constexpr (SP2) {
            PG8_LDB(B0, 0, 0); PG8_LDB(B1, 0, 1); PG8_SCHED; PG8_LDA(At, 0, 0); PG8_STAGE(PG8_SA(1, 1), a1 + hstep, voffA);
            PG8_WAIT_V(8); PG8_WAIT_L(0); PG8_BAR; PG8_MMA(0, 0, At, B0); PG8_MMA(0, 1, At, B1); PG8_BAR; PG8_SCHED;
            PG8_LDA(At, 0, 1); PG8_STAGE(PG8_SB(0, 0), b2, voffB); PG8_STAGE(PG8_SB(0, 1), b2 + hstep, voffB); PG8_STAGE(PG8_SA(0, 0), a2, voffA);
            PG8_WAIT_V(8); PG8_WAIT_L(0); PG8_BAR; PG8_MMA(1, 0, At, B0); PG8_MMA(1, 1, At, B1); PG8_BAR; PG8_SCHED;
            PG8_LDB(B0, 1, 0); PG8_LDB(B1, 1, 1); PG8_SCHED; PG8_LDA(At, 1, 0); PG8_STAGE(PG8_SA(0, 1), a2 + hstep, voffA);
            PG8_WAIT_V(8); PG8_WAIT_L(0); PG8_BAR; PG8_MMA(0, 0, At, B0); PG8_MMA(0, 1, At, B1); PG8_BAR; PG8_SCHED;
            PG8_LDA(At, 1, 1); PG8_STAGE(PG8_SB(1, 0), b3, voffB); PG8_STAGE(PG8_SB(1, 1), b3 + hstep, voffB); PG8_STAGE(PG8_SA(1, 0), a3, voffA);
            PG8_WAIT_V(8); PG8_WAIT_L(0); PG8_BAR; PG8_MMA(1, 0, At, B0); PG8_MMA(1, 1, At, B1); PG8_BAR; PG8_SCHED;
            } else {
            PG8_LDB(B0, 0, 0); PG8_SCHED; PG8_LDA(At, 0, 0); PG8_STAGE(PG8_SA(1, 1), a1 + hstep, voffA);
            PG8_WAIT_L(8); PG8_BAR; PG8_WAIT_L(0); PG8_MMA(0, 0, At, B0); PG8_BAR; PG8_SCHED;
            PG8_LDB(B1, 0, 1); PG8_STAGE(PG8_SB(0, 0), b2, voffB);
            PG8_BAR; PG8_WAIT_L(0); PG8_MMA(0, 1, At, B1); PG8_BAR;
            PG8_LDA(At, 0, 1); PG8_STAGE(PG8_SA(0, 0), a2, voffA);
            PG8_BAR; PG8_WAIT_L(0); PG8_MMA(1, 0, At, B0); PG8_BAR; PG8_SCHED;
            PG8_STAGE(PG8_SB(0, 1), b2 + hstep, voffB);
            PG8_WAIT_V(6); PG8_BAR; PG8_MMA(1, 1, At, B1); PG8_BAR;
            PG8_LDB(B0, 1, 0); PG8_SCHED; PG8_LDA(At, 1, 0); PG8_STAGE(PG8_SA(0, 1), a2 + hstep, voffA);
            PG8_WAIT_L(8); PG8_BAR; PG8_WAIT_L(0); PG8_MMA(0, 0, At, B0); PG8_BAR; PG8_SCHED;
            PG8_LDB(B1, 1, 1); PG8_STAGE(PG8_SB(1, 0), b3, voffB);
            PG8_BAR; PG8_WAIT_L(0); PG8_MMA(0, 1, At, B1); PG8_BAR;
            PG8_LDA(At, 1, 1); PG8_STAGE(PG8_SA(1, 0), a3, voffA);
            PG8_BAR; PG8_WAIT_L(0); PG8_MMA(1, 0, At, B0); PG8_BAR; PG8_SCHED;
            PG8_STAGE(PG8_SB(1, 1), b3 + hstep, voffB);
            PG8_WAIT_V(6); PG8_BAR; PG8_MMA(1, 1, At, B1); PG8_BAR;
            }
        }
        if constexpr (ALIGN_EPI) { if (wr == 0) PG8_BAR; }
        if constexpr (!Epi::AFTER_DRAIN) { E(acc, cur, wr, wc, fr, fq); S.done(cur); }
        if (!has_next) break;
#pragma unroll
        for (int a = 0; a < 2; ++a)
#pragma unroll
            for (int b = 0; b < 2; ++b)
#pragma unroll
                for (int m = 0; m < 4; ++m)
#pragma unroll
                    for (int n = 0; n < 2; ++n) acc[a][b][m][n] = (f32x4){0.f, 0.f, 0.f, 0.f};
        cur = nxt; cA = nA; cB = nB; ++ui;
        if constexpr (ALIGN_EPI) { if (wr == 1) PG8_BAR; }
    }
    PG8_WAIT_V(0);
    if constexpr (!ALIGN_EPI) { if (wr == 0) PG8_BAR; }
    PG8_BAR;
    if constexpr (Epi::AFTER_DRAIN) { E.fused(acc, cur, wr, wc, fr, fq, lds, wid, lane); S.done(cur); }
#undef PG8_SA
#undef PG8_SB
#undef PG8_STAGE
#undef PG8_LDA
#undef PG8_LDB
#undef PG8_MMA
#undef PG8_WAIT_V
#undef PG8_WAIT_L
#undef PG8_BAR
#undef PG8_SCHED
}
}
#define XB_TMO      128
#define XB_XCNT(j)  (256  + 64 * (j))
#define XB_XSUB(j)  (1280 + 64 * (j))
#define XB_XGEN(j)  (2304 + 64 * (j))
#define XB_TOP      3328
#define XB_TOPGEN   3392
#define XCD_BAR_WORDS 3456
#define XB_SPIN_CAP (1u << 18)

__device__ __forceinline__ unsigned xb_ld(unsigned* p)              { return __hip_atomic_load(p, __ATOMIC_RELAXED, __HIP_MEMORY_SCOPE_AGENT); }
__device__ __forceinline__ unsigned xb_add(unsigned* p, unsigned v) { return __hip_atomic_fetch_add(p, v, __ATOMIC_RELAXED, __HIP_MEMORY_SCOPE_AGENT); }
__device__ __forceinline__ unsigned xb_xcc_id() { return (unsigned)__builtin_amdgcn_s_getreg((3 << 11) | 20) & 0xFu; }
#define XB_SPIN(cond, bar) do { unsigned _sp = 0; while (cond) { __builtin_amdgcn_s_sleep(1); \
    if ((++_sp & 255u) == 0u) { if (xb_ld(&(bar)[XB_TMO])) break; if (_sp > XB_SPIN_CAP) { atomicAdd(&(bar)[XB_TMO], 1u); break; } } } } while (0)

struct XcdBarrier {
    unsigned* bar; unsigned x;
    volatile LAS unsigned* st;
};

__device__ __forceinline__ XcdBarrier xcd_barrier_post(unsigned* bar, volatile LAS unsigned* st) {
    XcdBarrier b; b.bar = bar; b.x = xb_xcc_id(); b.st = st;
    if (threadIdx.x == 0) (void)xb_add(&bar[XB_XCNT(b.x)], 1u);
    return b;
}
__device__ __forceinline__ void xcd_barrier_complete(unsigned* bar, unsigned x, unsigned& nloc, unsigned& nx) {
    const unsigned G = gridDim.x * gridDim.y * gridDim.z;
    unsigned sum, cnt, mine, sp = 0u;
    for (;;) {
        sum = 0u; cnt = 0u; mine = 0u;
#pragma unroll
        for (unsigned j = 0; j < 16; ++j) { const unsigned c = xb_ld(&bar[XB_XCNT(j)]); sum += c; cnt += (c > 0u) ? 1u : 0u; mine = (j == x) ? c : mine; }
        if (sum == G) break;
        __builtin_amdgcn_s_sleep(1);
        if ((++sp & 255u) == 0u) { if (xb_ld(&bar[XB_TMO])) break; if (sp > XB_SPIN_CAP) { atomicAdd(&bar[XB_TMO], 1u); break; } }
    }
    nloc = mine > 0u ? mine : 1u; nx = cnt > 0u ? cnt : 1u;
}

__device__ __forceinline__ void xcd_barrier(const XcdBarrier& b) {
    asm volatile("s_waitcnt vmcnt(0)" ::: "memory");
    __syncthreads();
    if (threadIdx.x == 0) {
        unsigned* bar = b.bar;
        __builtin_amdgcn_s_waitcnt(0);
        unsigned nloc = b.st[0], nx = b.st[1];
        if (nloc == 0u) { xcd_barrier_complete(bar, b.x, nloc, nx); b.st[0] = nloc; b.st[1] = nx; }
        const unsigned old = xb_add(&bar[XB_XSUB(b.x)], 1u);
        const unsigned gen = old / nloc;
        if (old + 1u == (gen + 1u) * nloc) {
            __builtin_amdgcn_fence(__ATOMIC_RELEASE, "agent");
            asm volatile("s_waitcnt vmcnt(0)" ::: "memory");
            const unsigned og = xb_add(&bar[XB_TOP], 1u);
            const unsigned tg = og / nx;
            if (og + 1u == (tg + 1u) * nx) xb_add(&bar[XB_TOPGEN], 1u);
            else XB_SPIN(xb_ld(&bar[XB_TOPGEN]) == tg, bar);
            __builtin_amdgcn_fence(__ATOMIC_ACQUIRE, "agent");
            xb_add(&bar[XB_XGEN(b.x)], 1u);
            asm volatile("s_waitcnt vmcnt(0)" ::: "memory");
        } else {
            XB_SPIN(xb_ld(&bar[XB_XGEN(b.x)]) == gen, bar);
            __builtin_amdgcn_fence(__ATOMIC_ACQUIRE, "agent");
            asm volatile("s_waitcnt vmcnt(0)" ::: "memory");
        }
    }
    __syncthreads();
}
__device__ __forceinline__ void phase_prep(const Params& p, unsigned char* lds, int bid, int nb) {
    const int tid = get_tid(), lane = tid & 63, wave = tid >> 6;
    unsigned char* ws = p.ws;
    float* mod = (float*)(ws + WS_MOD);
    if (bid < 192) {
        float* sc = (float*)lds;
        float* red = sc + 8 * 2048;
        for (int i = tid; i < 8 * 2048; i += NTHR) sc[i] = silu_f(p.c[i]);
        __syncthreads();
        for (int it = bid; it < 192; it += nb) {
            const int col = it * 64 + lane;
            float acc[8];
#pragma unroll
            for (int b = 0; b < 8; ++b) acc[b] = 0.f;
            const float* w = p.w_ada + (size_t)(wave * 256) * NMOD + col;
            const float* s0 = sc + wave * 256;
#pragma unroll 16
            for (int k = 0; k < 256; ++k) {
                const float wv = __builtin_nontemporal_load(w + (size_t)k * NMOD);
#pragma unroll
                for (int b = 0; b < 8; ++b) acc[b] += s0[b * 2048 + k] * wv;
            }
#pragma unroll
            for (int b = 0; b < 8; ++b) red[(wave * 8 + b) * 64 + lane] = acc[b];
            __syncthreads();
            {   const int b = wave; float s = p.b_ada[col];
#pragma unroll
                for (int w2 = 0; w2 < 8; ++w2) s += red[(w2 * 8 + b) * 64 + lane];
                mod[b * NMOD + col] = s; }
            __syncthreads();
        }
    }
    __syncthreads();
    {
        float* tile = (float*)lds;
        bf16_t* WinT = (bf16_t*)(ws + WS_WINT); bf16_t* WoT = (bf16_t*)(ws + WS_WOT); bf16_t* WqT = (bf16_t*)(ws + WS_WQT);
        for (int item = bid; item < 5632; item += nb) {
            const float* src; int ld, scol; bf16_t* dst; int kt;
            if (item < 3584) { const int seg = item >> 9, rem = item & 511, ntile = rem >> 5; kt = rem & 31;
                src = p.w_in; ld = INCOLS; scol = (seg < 3 ? seg * 1024 : 3080 + (seg - 3) * 1024) + ntile * 64; dst = WinT + (size_t)(seg * 1024 + ntile * 64) * 2048; }
            else if (item < 4608) { const int rem = item - 3584, ntile = rem >> 5; kt = rem & 31; src = p.w_out; ld = 2048; scol = ntile * 64; dst = WoT + (size_t)(ntile * 64) * 2048; }
            else { const int rem = item - 4608, ntile = rem >> 5; kt = rem & 31; src = p.w_q; ld = 2048; scol = ntile * 64; dst = WqT + (size_t)(ntile * 64) * 2048; }
            const int k0 = kt * 64;
#pragma unroll
            for (int ii = 0; ii < 8; ++ii) { const int k = wave + 8 * ii; tile[k * 65 + lane] = src[(size_t)(k0 + k) * ld + scol + lane]; }
            __syncthreads();
#pragma unroll
            for (int ii = 0; ii < 8; ++ii) { const int n = wave + 8 * ii; dst[(size_t)n * 2048 + k0 + lane] = (bf16_t)(cvt_pk(tile[lane * 65 + n], 0.f) & 0xffffu); }
            __syncthreads();
        }
    }
    {
        bf16_t* Wg = (bf16_t*)(ws + WS_WG);
        for (int i = bid * NTHR + tid; i < 16 * 2048; i += nb * NTHR) { const int g = i >> 11, k = i & 2047; const int col = g < 8 ? 3072 + g : 7176 + (g - 8);
            Wg[i] = (bf16_t)(cvt_pk(p.w_in[(size_t)k * INCOLS + col], 0.f) & 0xffffu); }
    }
}

__device__ __forceinline__ unsigned pack4_fp8(const f32x4 a) { int t = __builtin_amdgcn_cvt_pk_fp8_f32(a[0], a[1], 0, false); t = __builtin_amdgcn_cvt_pk_fp8_f32(a[2], a[3], t, true); return (unsigned)t; }
__device__ __forceinline__ void convert_experts(const Params& p, int bid, int nb) {
    const int tid = get_tid(); unsigned char* ws = p.ws;
    unsigned char* E8D = ws + WS_E8D; unsigned char* E8US = ws + WS_E8U;
    {
        const int lane = tid & 63, wave = tid >> 6; float* DSC = (float*)(ws + WS_DSC);
        for (int e = bid * 8 + wave; e < 16384; e += nb * 8) {
            const float* rp = p.e_down + (size_t)e * 2048;
            f32x4 v[8]; float mx = 0.f;
#pragma unroll
            for (int hf = 0; hf < 2; ++hf)
#pragma unroll
                for (int q = 0; q < 4; ++q) { v[hf * 4 + q] = *(const f32x4*)(rp + hf * 1024 + 16 * lane + 4 * q);
#pragma unroll
                    for (int c = 0; c < 4; ++c) mx = fmaxf(mx, fabsf(v[hf * 4 + q][c])); }
            mx = fmaxf(wmax(mx), 1e-30f);
            const float inv = 127.f / mx;
            if (lane == 0) DSC[e] = mx * (1.f / 127.f);
#pragma unroll
            for (int hf = 0; hf < 2; ++hf) { u32x4 o;
#pragma unroll
                for (int q = 0; q < 4; ++q) { unsigned w = 0u;
#pragma unroll
                    for (int c = 0; c < 4; ++c) w |= ((unsigned)__float2int_rn(v[hf * 4 + q][c] * inv) & 0xffu) << (8 * c);
                    o[q] = w; }
                *(u32x4*)(E8D + (size_t)e * 2048 + hf * 1024 + 16 * lane) = o; }
        }
    }
    for (int i = bid * NTHR + tid; i < 524288; i += nb * NTHR) {
        const int s = i & 255, eg = i >> 8;
        const float* sp = p.e_up + (size_t)(eg * 8) * 2048 + 8 * s;
        unsigned w[16];
#pragma unroll
        for (int q = 0; q < 8; ++q) { const f32x4 a = *(const f32x4*)(sp + (size_t)q * 2048), b = *(const f32x4*)(sp + (size_t)q * 2048 + 4); w[2 * q] = pack4_fp8(a * 32.f); w[2 * q + 1] = pack4_fp8(b * 32.f); }
        u32x4* dp = (u32x4*)(E8US + ((size_t)s * 16384 + eg * 8) * 8);
#pragma unroll
        for (int q = 0; q < 4; ++q) { u32x4 o; o.x = w[4 * q]; o.y = w[4 * q + 1]; o.z = w[4 * q + 2]; o.w = w[4 * q + 3]; dp[q] = o; }
    }
}

template <bool RES>
__device__ __forceinline__ void phase_norm(const float* xin, const bf16_t* yin, int gate_off, const float* gain, const float* mod, int shift_off, int scale_off, bf16_t* hout, int bid, int nb) {
    const int tid = get_tid(), lane = tid & 63, wave = tid >> 6;
    for (int row = bid * 8 + wave; row < T_; row += nb * 8) {
        const f32x4* xr = (const f32x4*)(xin + (size_t)row * D_);
        f32x4 v[8]; float ss = 0.f;
        const float* mb = mod + (size_t)(row >> 11) * NMOD;
#pragma unroll
        for (int j = 0; j < 8; ++j) { v[j] = xr[lane + 64 * j];
            if (RES) { const int k = 4 * (lane + 64 * j); const u32x2 yw = *(const u32x2*)(yin + (size_t)row * D_ + k); const f32x4 gv = *(const f32x4*)(mb + gate_off + k);
                v[j][0] += gv[0] * bflo(yw.x); v[j][1] += gv[1] * bfhi(yw.x); v[j][2] += gv[2] * bflo(yw.y); v[j][3] += gv[3] * bfhi(yw.y); }
            ss += v[j][0] * v[j][0] + v[j][1] * v[j][1] + v[j][2] * v[j][2] + v[j][3] * v[j][3]; }
        ss = wsum(ss);
        const float r = rsqrtf(ss * (1.f / D_) + EPS_);
        f32x4 hv[8];
#pragma unroll
        for (int j = 0; j < 8; ++j) {
            const int k = 4 * (lane + 64 * j);
            const f32x4 gn = *(const f32x4*)(gain + k), sh = *(const f32x4*)(mb + shift_off + k), scl = *(const f32x4*)(mb + scale_off + k);
#pragma unroll
            for (int e = 0; e < 4; ++e) hv[j][e] = (v[j][e] * r) * gn[e] * (1.f + scl[e]) + sh[e];
            u32x2 w; w.x = cvt_pk(hv[j][0], hv[j][1]); w.y = cvt_pk(hv[j][2], hv[j][3]);
            *(u32x2*)(hout + (size_t)row * D_ + k) = w;
        }
    }
}

__device__ __forceinline__ void phase_gates(const Params& p, unsigned char* lds, int bid, int nb) {
    const int tid = get_tid(), lane = tid & 63, wave = tid >> 6, r = lane & 31, hh = lane >> 5;
    unsigned char* ws = p.ws;
    const bf16_t* H = (const bf16_t*)(ws + WS_H); const bf16_t* Wg = (const bf16_t*)(ws + WS_WG); float* gate = (float*)(ws + WS_GATE);
    constexpr int WST = 4096 + 16;
    for (int i = tid; i < 16 * 256; i += NTHR) { const int g = i >> 8, c = i & 255; *(u32x4*)(lds + g * WST + c * 16) = *(const u32x4*)(Wg + (size_t)g * 2048 + c * 8); }
    __syncthreads();
    float* part = (float*)(lds + 16 * WST);
    for (int pr = bid; pr < T_ / 64; pr += nb) {
        const int t = pr * 64 + (wave >> 2) * 32 + r, kq = wave & 3;
        f32x16 acc;
#pragma unroll
        for (int i = 0; i < 16; ++i) acc[i] = 0.f;
        const bf16_t* hp = H + (size_t)t * D_ + kq * 512 + hh * 8; const unsigned char* wp = lds + (r & 15) * WST + kq * 1024 + hh * 16;
#pragma unroll 1
        for (int k0 = 0; k0 < 32; k0 += 16) {
            bf16x8 bfr[16];
#pragma unroll
            for (int j = 0; j < 16; ++j) bfr[j] = *(const bf16x8*)(hp + (k0 + j) * 16);
#pragma unroll
            for (int j = 0; j < 16; ++j) { bf16x8 a = *(const bf16x8*)(wp + (k0 + j) * 32); if (r >= 16) a = (bf16x8){0, 0, 0, 0, 0, 0, 0, 0};
                acc = __builtin_amdgcn_mfma_f32_32x32x16_bf16(a, bfr[j], acc, 0, 0, 0); }
        }
        __syncthreads();
#pragma unroll
        for (int i = 0; i < 8; ++i) part[(wave * 8 + i) * 64 + lane] = acc[i];
        __syncthreads();
        if (kq == 0) {
            float s[8];
#pragma unroll
            for (int i = 0; i < 8; ++i) s[i] = part[(wave * 8 + i) * 64 + lane] + part[((wave + 1) * 8 + i) * 64 + lane] + part[((wave + 2) * 8 + i) * 64 + lane] + part[((wave + 3) * 8 + i) * 64 + lane];
            f32x4 g0, g1; g0[0] = s[0]; g0[1] = s[1]; g0[2] = s[2]; g0[3] = s[3]; g1[0] = s[4]; g1[1] = s[5]; g1[2] = s[6]; g1[3] = s[7];
            *(f32x4*)(gate + (size_t)t * 16 + 4 * hh) = g0; *(f32x4*)(gate + (size_t)t * 16 + 8 + 4 * hh) = g1;
        }
    }
    __syncthreads();
}

__device__ __forceinline__ void phase_post(const Params& p, int bid, int nb) {
    const int tid = get_tid(), lane = tid & 63, wave = tid >> 6;
    unsigned char* ws = p.ws;
    bf16_t* Pq = (bf16_t*)(ws + WS_P); bf16_t* Pk = (bf16_t*)(ws + WS_P + SEG_B);
    const float qscale = 0.08838834764831845f * 1.4426950408889634f;
    {
        const bf16_t* Mq = (const bf16_t*)(ws + WS_P + 3 * SEG_B); const bf16_t* Mk = (const bf16_t*)(ws + WS_P + 4 * SEG_B);
        bf16_t* QC = (bf16_t*)(ws + WS_QC); bf16_t* KC = (bf16_t*)(ws + WS_KC);
        for (int item = bid; item < 256; item += nb) {
            const int which = item >> 7, tb = item & 127, cg = tid & 127, run = tid >> 7, ch0 = cg * 8, ts = tb * 128 + run * 32, sp = ts & 2047;
            const bf16_t* src = (which ? Mk : Mq) + (size_t)ts * 1024 + ch0; bf16_t* dst = (which ? KC : QC) + (size_t)ts * 1024 + ch0;
            float w0[8], w1[8], w2[8], w3[8], cb[8], x0[8], x1[8], x2[8];
#pragma unroll
            for (int e = 0; e < 8; ++e) { const int ci = which * 1024 + ch0 + e; w0[e] = p.conv_w[ci]; w1[e] = p.conv_w[2048 + ci]; w2[e] = p.conv_w[4096 + ci]; w3[e] = p.conv_w[6144 + ci]; cb[e] = p.conv_b[ci]; }
            {   u32x4 a = {0u, 0u, 0u, 0u}, b = a, c = a;
                if (sp != 0) { a = *(const u32x4*)(src - 3 * 1024); b = *(const u32x4*)(src - 2 * 1024); c = *(const u32x4*)(src - 1024); }
#pragma unroll
                for (int e = 0; e < 4; ++e) { x0[2 * e] = bflo(a[e]); x0[2 * e + 1] = bfhi(a[e]); x1[2 * e] = bflo(b[e]); x1[2 * e + 1] = bfhi(b[e]); x2[2 * e] = bflo(c[e]); x2[2 * e + 1] = bfhi(c[e]); } }
            const float osc = which ? 0.0625f : 1.f;
            for (int s = 0; s < 32; ++s) {
                const u32x4 d = *(const u32x4*)(src + (size_t)s * 1024); float x3[8], y[8];
#pragma unroll
                for (int e = 0; e < 4; ++e) { x3[2 * e] = bflo(d[e]); x3[2 * e + 1] = bfhi(d[e]); }
#pragma unroll
                for (int e = 0; e < 8; ++e) { y[e] = silu_f(w0[e] * x0[e] + w1[e] * x1[e] + w2[e] * x2[e] + w3[e] * x3[e] + cb[e]) * osc; x0[e] = x1[e]; x1[e] = x2[e]; x2[e] = x3[e]; }
                u32x4 o; o.x = cvt_pk(y[0], y[1]); o.y = cvt_pk(y[2], y[3]); o.z = cvt_pk(y[4], y[5]); o.w = cvt_pk(y[6], y[7]);
                *(u32x4*)(dst + (size_t)s * 1024) = o;
            }
        }
    }
    const float* gate = (const float*)(ws + WS_GATE); float* F = (float*)(ws + WS_F);
    for (int sq = bid * 8 + wave; sq < 64; sq += nb * 8) {
        const int b = sq >> 3, h = sq & 7; const float fb = p.fox_fb[h];
        float v[32]; float run = 0.f;
#pragma unroll
        for (int i = 0; i < 32; ++i) { const int t = lane * 32 + i; run += logsig(gate[(size_t)(b * S_ + t) * 16 + h] + fb); v[i] = run; }
        float inc = run;
#pragma unroll
        for (int o = 1; o < 64; o <<= 1) { const float u = __shfl_up(inc, o); if (lane >= o) inc += u; }
        const float excl = inc - run;
#pragma unroll
        for (int i = 0; i < 32; ++i) F[(size_t)sq * S_ + lane * 32 + i] = (v[i] + excl) * 1.4426950408889634f;
    }
}
typedef short s16x4 __attribute__((ext_vector_type(4)));
__device__ __forceinline__ s16x4 lds_tr16(const unsigned char* p) { return __builtin_amdgcn_ds_read_tr16_b64_v4i16((LAS s16x4*)p); }
__device__ __forceinline__ bf16x8 tr_frag(const unsigned char* p0, int second_bytes) {
    const s16x4 a = lds_tr16(p0), b = lds_tr16(p0 + second_bytes);
    bf16x8 f; f[0] = a[0]; f[1] = a[1]; f[2] = a[2]; f[3] = a[3]; f[4] = b[0]; f[5] = b[1]; f[6] = b[2]; f[7] = b[3]; return f;
}
__device__ __forceinline__ unsigned split_bf16(float v, float& eff) { const unsigned hi = cvt_pk(v, 0.f) & 0xffffu; const float hf = bf2f((bf16_t)hi); const unsigned lo = cvt_pk(v - hf, 0.f) & 0xffffu; eff = hf + bf2f((bf16_t)lo); return hi | (lo << 16); }
__device__ __forceinline__ void fox_unit(const Params& p, unsigned char* lds, int b, int h, int qb) {
    const int tid = get_tid(), lane = tid & 63, wave = tid >> 6, r = lane & 31, hh = lane >> 5, li = lane & 15;
    unsigned char* ws = p.ws;
    const bf16_t* Pq = (const bf16_t*)(ws + WS_P); const bf16_t* Pk = (const bf16_t*)(ws + WS_P + SEG_B); const bf16_t* Pv = (const bf16_t*)(ws + WS_P + 2 * SEG_B);
    const float* F = (const float*)(ws + WS_F) + (size_t)(b * 8 + h) * S_;
    bf16_t* Oc = (bf16_t*)(ws + WS_H);
    constexpr int KST = 272, VST = 544, BUF = 64 * KST + 64 * VST;
    constexpr float THR = 8.f;
    const int q0w = qb * 256 + wave * 32, qs = q0w + r; const int q0s = __builtin_amdgcn_readfirstlane(q0w);
    const size_t trow = (size_t)(b * S_ + qs);
    bf16x8 qf[8];
#pragma unroll
    for (int ks = 0; ks < 8; ++ks) qf[ks] = *(const bf16x8*)(Pq + trow * 1024 + h * 128 + ks * 16 + hh * 8);
    float feff; const unsigned fq2 = split_bf16(F[qs], feff);
    float m = 0.f;
    u32x4 qa; qa.x = hh ? 0u : fq2; qa.y = 0u; qa.z = hh ? 0u : 0x3f803f80u; qa.w = 0u;
    f32x16 o[4];
#pragma unroll
    for (int d = 0; d < 4; ++d)
#pragma unroll
        for (int i = 0; i < 16; ++i) o[d][i] = 0.f;
    float l = 0.f;
    const int ntile = (qb * 256 + 256) / 64;
    const int srow0 = tid >> 4, scc = tid & 15;
    const bf16_t* kg = Pk + (size_t)(b * S_ + srow0) * 1024 + h * 128 + scc * 8; const bf16_t* vg = Pv + (size_t)(b * S_ + srow0) * 1024 + h * 128 + scc * 8;
    u32x4 kr[2], vr[2]; float fr = 0.f;
    const int vb_off = 64 * KST + (4 * hh + (li >> 2)) * VST + (16 * (r >> 4) + 4 * (li & 3)) * 2;
#define FOX_AUG(dst, fval) do { float e_; const unsigned s2_ = split_bf16(-(fval), e_); u32x4 w_; w_.x = 0x3f803f80u; w_.y = 0x3f803f80u; w_.z = s2_; w_.w = 0u; *(u32x4*)(dst) = w_; } while (0)
    __syncthreads();
#pragma unroll
    for (int i = 0; i < 2; ++i) { kr[i] = *(const u32x4*)(kg + (size_t)(32 * i) * 1024); vr[i] = *(const u32x4*)(vg + (size_t)(32 * i) * 1024); }
    if (tid < 64) fr = F[tid];
#pragma unroll
    for (int i = 0; i < 2; ++i) { *(u32x4*)(lds + (srow0 + 32 * i) * KST + scc * 16) = kr[i]; *(u32x4*)(lds + 64 * KST + (srow0 + 32 * i) * VST + scc * 16) = vr[i]; }
    if (tid < 64) FOX_AUG(lds + tid * KST + 256, fr);
    __syncthreads();
    for (int kt = 0; kt < ntile; ++kt) {
        const int k0 = kt * 64; unsigned char* cur = lds + (kt & 1) * BUF; unsigned char* nxt = lds + ((kt & 1) ^ 1) * BUF;
        const bool more = kt + 1 < ntile;
        if (more) {
#pragma unroll
            for (int i = 0; i < 2; ++i) { kr[i] = *(const u32x4*)(kg + (size_t)(k0 + 64 + 32 * i) * 1024); vr[i] = *(const u32x4*)(vg + (size_t)(k0 + 64 + 32 * i) * 1024); }
            if (tid < 64) fr = F[k0 + 64 + tid];
        }
        if (k0 <= q0s + 31) {
            f32x16 s[2];
            const bf16x8 qaf = __builtin_bit_cast(bf16x8, qa);
#pragma unroll
            for (int kb = 0; kb < 2; ++kb) {
#pragma unroll
                for (int i = 0; i < 16; ++i) s[kb][i] = 0.f;
#pragma unroll
                for (int ks = 0; ks < 8; ++ks) { const bf16x8 a = *(const bf16x8*)(cur + (kb * 32 + r) * KST + ks * 32 + hh * 16);
                    s[kb] = __builtin_amdgcn_mfma_f32_32x32x16_bf16(a, qf[ks], s[kb], 0, 0, 0); }
                {   const bf16x8 a = *(const bf16x8*)(cur + (kb * 32 + r) * KST + 256);
                    s[kb] = __builtin_amdgcn_mfma_f32_32x32x16_bf16(a, qaf, s[kb], 0, 0, 0); }
            }
            if (k0 + 63 > q0s) {
                const int lim = qs - k0;
#pragma unroll
                for (int kb = 0; kb < 2; ++kb)
#pragma unroll
                    for (int i = 0; i < 16; ++i) s[kb][i] = (kb * 32 + (i & 3) + 8 * (i >> 2) + 4 * hh > lim) ? -INFINITY : s[kb][i];
            }
            float mx = fmaxf(s[0][0], s[1][0]);
#pragma unroll
            for (int i = 1; i < 16; ++i) mx = fmaxf(mx, fmaxf(s[0][i], s[1][i]));
            mx = fmaxf(mx, __shfl_xor(mx, 32));
            if (__builtin_amdgcn_ballot_w64(mx > THR) != 0ull) {
                const float mnew_f = m + fmaxf(mx, 0.f); float meff; const unsigned m2 = split_bf16(-mnew_f, meff); meff = -meff;
                const float delta = meff - m, alpha = __builtin_amdgcn_exp2f(-delta);
                m = meff; if (!hh) qa.y = m2;
                l *= alpha;
#pragma unroll
                for (int d = 0; d < 4; ++d)
#pragma unroll
                    for (int i = 0; i < 16; ++i) o[d][i] *= alpha;
#pragma unroll
                for (int kb = 0; kb < 2; ++kb)
#pragma unroll
                    for (int i = 0; i < 16; ++i) s[kb][i] -= delta;
            }
            float ps = 0.f;
#pragma unroll
            for (int kb = 0; kb < 2; ++kb)
#pragma unroll
                for (int i = 0; i < 16; ++i) { const float pv = __builtin_amdgcn_exp2f(s[kb][i]); s[kb][i] = pv; ps += pv; }
            l += ps;
#pragma unroll
            for (int kb = 0; kb < 2; ++kb)
#pragma unroll
                for (int st = 0; st < 2; ++st) {
                    u32x4 pw; pw.x = cvt_pk(s[kb][8 * st + 0], s[kb][8 * st + 1]); pw.y = cvt_pk(s[kb][8 * st + 2], s[kb][8 * st + 3]);
                    pw.z = cvt_pk(s[kb][8 * st + 4], s[kb][8 * st + 5]); pw.w = cvt_pk(s[kb][8 * st + 6], s[kb][8 * st + 7]);
                    const bf16x8 pf = __builtin_bit_cast(bf16x8, pw);
#pragma unroll
                    for (int d = 0; d < 4; ++d) { const bf16x8 vf = tr_frag(cur + vb_off + (kb * 32 + st * 16) * VST + d * 64, 8 * VST);
                        o[d] = __builtin_amdgcn_mfma_f32_32x32x16_bf16(vf, pf, o[d], 0, 0, 0); }
                }
        }
        if (more) {
#pragma unroll
            for (int i = 0; i < 2; ++i) { *(u32x4*)(nxt + (srow0 + 32 * i) * KST + scc * 16) = kr[i]; *(u32x4*)(nxt + 64 * KST + (srow0 + 32 * i) * VST + scc * 16) = vr[i]; }
            if (tid < 64) FOX_AUG(nxt + tid * KST + 256, fr);
        }
        lds_barrier();
    }
#undef FOX_AUG
    l += __shfl_xor(l, 32);
    const float inv = 1.f / l;
#pragma unroll
    for (int d = 0; d < 4; ++d)
#pragma unroll
        for (int g = 0; g < 4; ++g) { u32x2 w; w.x = cvt_pk(o[d][4 * g] * inv, o[d][4 * g + 1] * inv); w.y = cvt_pk(o[d][4 * g + 2] * inv, o[d][4 * g + 3] * inv);
            *(u32x2*)(Oc + trow * D_ + h * 128 + d * 32 + 8 * g + 4 * hh) = w; }
}

__device__ __forceinline__ void mlstm_passA(const Params& p, unsigned char* lds, int unit) {
    const int tid = get_tid(), lane = tid & 63, wave = tid >> 6, r = lane & 31, hh = lane >> 5, li = lane & 15;
    const int b = unit >> 3, h = (unit >> 1) & 3, eh = unit & 1;
    unsigned char* ws = p.ws;
    const bf16_t* KC = (const bf16_t*)(ws + WS_KC); const bf16_t* Mv = (const bf16_t*)(ws + WS_P + 5 * SEG_B);
    const float* gate = (const float*)(ws + WS_GATE);
    bf16_t* Cst = (bf16_t*)(ws + WS_CST); float* nst = (float*)(ws + WS_NST); float* mst = (float*)(ws + WS_MST);
    constexpr int KST = 528, VST = 272;
    unsigned char* ksm = lds;
    unsigned char* vsm = ksm + 64 * KST;
    float* WSV = (float*)(vsm + 64 * VST);
    float* SCL = WSV + 2048;
    constexpr int STGS = 528;
    unsigned char* stg = (unsigned char*)(SCL + 128);
    __syncthreads();
    for (int cc = wave; cc < 32; cc += 8) {
        const int t = b * S_ + cc * 64 + lane;
        const float ipre = gate[(size_t)t * 16 + 8 + h] + p.m_ib[h], fpre = gate[(size_t)t * 16 + 12 + h] + p.m_fb[h];
        float bc = logsig(fpre);
#pragma unroll
        for (int o = 1; o < 64; o <<= 1) { const float u = __shfl_up(bc, o); if (lane >= o) bc += u; }
        const float a = ipre - bc; const float amax = wmax(a); const float bL = __shfl(bc, 63);
        WSV[cc * 64 + lane] = a; if (lane == 0) { SCL[cc] = bL; SCL[32 + cc] = amax; }
    }
    __syncthreads();
    if (tid == 0) { float m = 0.f; for (int cc = 0; cc < 32; ++cc) { const float mn = SCL[cc] + fmaxf(m, SCL[32 + cc]); SCL[64 + cc] = expf(SCL[cc] + m - mn); SCL[96 + cc] = mn; if (eh == 0) mst[(b * 4 + h) * 32 + cc] = m; m = mn; } }
    __syncthreads();
    for (int i = tid; i < 2048; i += NTHR) { const int cc = i >> 6; WSV[i] = expf(SCL[cc] + WSV[i] - SCL[96 + cc]); }
    f32x16 acc[4];
#pragma unroll
    for (int et = 0; et < 4; ++et)
#pragma unroll
        for (int i = 0; i < 16; ++i) acc[et][i] = 0.f;
    f32x16 accn;
#pragma unroll
    for (int i = 0; i < 16; ++i) accn[i] = 0.f;
    const int kb_off = (8 * hh + (li >> 2)) * KST + (wave * 32 + 16 * (r >> 4) + 4 * (li & 3)) * 2;
    const int vb_off = (8 * hh + (li >> 2)) * VST + (16 * (r >> 4) + 4 * (li & 3)) * 2;
    u32x4 pk[4], pv[2];
#pragma unroll
    for (int i = 0; i < 4; ++i) { const int c = tid + NTHR * i, row = c >> 5, c16 = c & 31; pk[i] = *(const u32x4*)(KC + (size_t)(b * S_ + row) * 1024 + h * 256 + c16 * 8); }
#pragma unroll
    for (int i = 0; i < 2; ++i) { const int c = tid + NTHR * i, row = c >> 4, c16 = c & 15; pv[i] = *(const u32x4*)(Mv + (size_t)(b * S_ + row) * 1024 + h * 256 + eh * 128 + c16 * 8); }
    for (int cc = 0; cc < 32; ++cc) {
        const int bhc = (b * 4 + h) * 32 + cc, t0 = b * S_ + cc * 64;
#pragma unroll
        for (int et = 0; et < 4; ++et)
#pragma unroll
            for (int g = 0; g < 4; ++g) { u32x2 o; o.x = cvt_pk(acc[et][4 * g], acc[et][4 * g + 1]); o.y = cvt_pk(acc[et][4 * g + 2], acc[et][4 * g + 3]);
                *(u32x2*)(stg + (et * 32 + r) * STGS + (wave * 32 + 8 * g + 4 * hh) * 2) = o; }
        if (eh == 0 && r == 0) {
#pragma unroll
            for (int g = 0; g < 4; ++g) { f32x4 o; o[0] = accn[4 * g]; o[1] = accn[4 * g + 1]; o[2] = accn[4 * g + 2]; o[3] = accn[4 * g + 3]; *(f32x4*)(nst + (size_t)bhc * 256 + wave * 32 + 8 * g + 4 * hh) = o; } }
        lds_barrier();
#pragma unroll
        for (int i = 0; i < 8; ++i) { const int c = tid + NTHR * i, row = c >> 5, c16 = c & 31;
            *(u32x4*)(Cst + ((size_t)bhc * 256 + eh * 128 + row) * 256 + c16 * 8) = *(const u32x4*)(stg + row * STGS + c16 * 16); }
        if (cc == 31) break;
#pragma unroll
        for (int i = 0; i < 4; ++i) { const int c = tid + NTHR * i, row = c >> 5, c16 = c & 31; *(u32x4*)(ksm + row * KST + c16 * 16) = pk[i]; }
#pragma unroll
        for (int i = 0; i < 2; ++i) { const int c = tid + NTHR * i, row = c >> 4, c16 = c & 15; const float wv = WSV[cc * 64 + row]; const u32x4 w = pv[i];
            u32x4 o; o.x = cvt_pk(bflo(w.x) * wv, bfhi(w.x) * wv); o.y = cvt_pk(bflo(w.y) * wv, bfhi(w.y) * wv); o.z = cvt_pk(bflo(w.z) * wv, bfhi(w.z) * wv); o.w = cvt_pk(bflo(w.w) * wv, bfhi(w.w) * wv);
            *(u32x4*)(vsm + row * VST + c16 * 16) = o; }
        if (cc + 1 < 31) { const int t1 = t0 + 64;
#pragma unroll
            for (int i = 0; i < 4; ++i) { const int c = tid + NTHR * i, row = c >> 5, c16 = c & 31; pk[i] = *(const u32x4*)(KC + (size_t)(t1 + row) * 1024 + h * 256 + c16 * 8); }
#pragma unroll
            for (int i = 0; i < 2; ++i) { const int c = tid + NTHR * i, row = c >> 4, c16 = c & 15; pv[i] = *(const u32x4*)(Mv + (size_t)(t1 + row) * 1024 + h * 256 + eh * 128 + c16 * 8); } }
        lds_barrier();
        const float decay = SCL[64 + cc];
#pragma unroll
        for (int et = 0; et < 4; ++et)
#pragma unroll
            for (int i = 0; i < 16; ++i) acc[et][i] *= decay;
#pragma unroll
        for (int i = 0; i < 16; ++i) accn[i] *= decay;
#pragma unroll
        for (int ks = 0; ks < 4; ++ks) {
            const bf16x8 bfr = tr_frag(ksm + kb_off + ks * 16 * KST, 4 * KST);
            {
                const f32x4 w0 = *(const f32x4*)(WSV + cc * 64 + ks * 16 + hh * 8), w1 = *(const f32x4*)(WSV + cc * 64 + ks * 16 + hh * 8 + 4);
                u32x4 wb; wb.x = cvt_pk(w0[0], w0[1]); wb.y = cvt_pk(w0[2], w0[3]); wb.z = cvt_pk(w1[0], w1[1]); wb.w = cvt_pk(w1[2], w1[3]);
                if (r != 0) wb = (u32x4){0u, 0u, 0u, 0u};
                accn = __builtin_amdgcn_mfma_f32_32x32x16_bf16(bfr, __builtin_bit_cast(bf16x8, wb), accn, 0, 0, 0); }
#pragma unroll
            for (int et = 0; et < 4; ++et) { const bf16x8 afr = tr_frag(vsm + vb_off + ks * 16 * VST + et * 64, 4 * VST);
                acc[et] = __builtin_amdgcn_mfma_f32_32x32x16_bf16(bfr, afr, acc[et], 0, 0, 0); }
        }
    }
}

__device__ __forceinline__ void mlstm_passB(const Params& p, unsigned char* lds, int unit) {
    const int tid = get_tid(), lane = tid & 63, wave = tid >> 6, r = lane & 31, hh = lane >> 5, li = lane & 15;
    const int b = unit >> 7, h = (unit >> 5) & 3, cc = unit & 31;
    unsigned char* ws = p.ws;
    const bf16_t* QC = (const bf16_t*)(ws + WS_QC); const bf16_t* KC = (const bf16_t*)(ws + WS_KC);
    const bf16_t* Mv = (const bf16_t*)(ws + WS_P + 5 * SEG_B); const bf16_t* Mo = (const bf16_t*)(ws + WS_P + 6 * SEG_B);
    const float* gate = (const float*)(ws + WS_GATE);
    const bf16_t* Cst = (const bf16_t*)(ws + WS_CST); const float* nst = (const float*)(ws + WS_NST); const float* mst = (const float*)(ws + WS_MST);
    bf16_t* Oc = (bf16_t*)(ws + WS_H);
    constexpr int QST = 528, VST = 544, WST = 144, HST = 1040;
    unsigned char* qsm = lds;
    unsigned char* ksm = qsm + 64 * QST;
    unsigned char* vsm = ksm + 64 * QST;
    unsigned char* wsm = vsm + 64 * VST;
    float* sc = (float*)(wsm + 64 * WST);
    float* hsm = (float*)lds;
    const int bhc = (b * 4 + h) * 32 + cc, t0 = b * S_ + cc * 64;
    __syncthreads();
    if (wave == 0) {
        const float ipre = gate[(size_t)(t0 + lane) * 16 + 8 + h] + p.m_ib[h], fpre = gate[(size_t)(t0 + lane) * 16 + 12 + h] + p.m_fb[h];
        float bc = logsig(fpre);
#pragma unroll
        for (int o = 1; o < 64; o <<= 1) { const float u = __shfl_up(bc, o); if (lane >= o) bc += u; }
        const float a = ipre - bc; float pm = a;
#pragma unroll
        for (int o = 1; o < 64; o <<= 1) { const float u = __shfl_up(pm, o); if (lane >= o) pm = fmaxf(pm, u); }
        const float mc = mst[bhc]; const float mt = bc + fmaxf(mc, pm);
        sc[lane] = bc - mt; sc[64 + lane] = a; sc[128 + lane] = mt; sc[192 + lane] = expf(bc + mc - mt);
    }
    bf16x8 cfr[16];
#pragma unroll
    for (int ks = 0; ks < 16; ++ks) cfr[ks] = *(const bf16x8*)(Cst + ((size_t)bhc * 256 + wave * 32 + r) * 256 + ks * 16 + hh * 8);
#pragma unroll
    for (int i = 0; i < 4; ++i) { const int c = tid + NTHR * i, row = c >> 5, c16 = c & 31;
        *(u32x4*)(qsm + row * QST + c16 * 16) = *(const u32x4*)(QC + (size_t)(t0 + row) * 1024 + h * 256 + c16 * 8);
        *(u32x4*)(ksm + row * QST + c16 * 16) = *(const u32x4*)(KC + (size_t)(t0 + row) * 1024 + h * 256 + c16 * 8);
        *(u32x4*)(vsm + row * VST + c16 * 16) = *(const u32x4*)(Mv + (size_t)(t0 + row) * 1024 + h * 256 + c16 * 8); }
    __syncthreads();
    if (wave < 3) {
        const int sb = wave >> 1, lb = wave ? 1 : 0;
        f32x16 s;
#pragma unroll
        for (int i = 0; i < 16; ++i) s[i] = 0.f;
#pragma unroll
        for (int ks = 0; ks < 16; ++ks) { const bf16x8 a = *(const bf16x8*)(ksm + (sb * 32 + r) * QST + ks * 32 + hh * 16), q = *(const bf16x8*)(qsm + (lb * 32 + r) * QST + ks * 32 + hh * 16);
            s = __builtin_amdgcn_mfma_f32_32x32x16_bf16(a, q, s, 0, 0, 0); }
        const int l = lb * 32 + r; const float bl = sc[l]; float rs = 0.f;
#pragma unroll
        for (int g = 0; g < 4; ++g) { float w[4];
#pragma unroll
            for (int e = 0; e < 4; ++e) { const int sI = sb * 32 + 8 * g + 4 * hh + e; w[e] = (sI <= l) ? s[4 * g + e] * __expf(bl + sc[64 + sI]) : 0.f; rs += w[e]; }
            u32x2 o; o.x = cvt_pk(w[0], w[1]); o.y = cvt_pk(w[2], w[3]);
            *(u32x2*)(wsm + l * WST + (sb * 32 + 8 * g + 4 * hh) * 2) = o; }
        sc[256 + l * 4 + sb * 2 + hh] = rs;
    } else if (wave == 3) {
        const int l = r;
#pragma unroll
        for (int g = 0; g < 4; ++g) { u32x2 o; o.x = 0u; o.y = 0u; *(u32x2*)(wsm + l * WST + (32 + 8 * g + 4 * hh) * 2) = o; }
        sc[256 + l * 4 + 2 + hh] = 0.f;
    }
    {
        const int l = tid & 63, part = tid >> 6; const float* np = nst + (size_t)bhc * 256 + part * 32; float s = 0.f;
#pragma unroll
        for (int q = 0; q < 4; ++q) { const u32x4 w = *(const u32x4*)(qsm + l * QST + part * 64 + q * 16);
            s += bflo(w.x) * np[8 * q] + bfhi(w.x) * np[8 * q + 1] + bflo(w.y) * np[8 * q + 2] + bfhi(w.y) * np[8 * q + 3] + bflo(w.z) * np[8 * q + 4] + bfhi(w.z) * np[8 * q + 5] + bflo(w.w) * np[8 * q + 6] + bfhi(w.w) * np[8 * q + 7]; }
        sc[512 + l * 8 + part] = s;
    }
    f32x16 acc[2];
#pragma unroll
    for (int lb = 0; lb < 2; ++lb)
#pragma unroll
        for (int i = 0; i < 16; ++i) acc[lb][i] = 0.f;
#pragma unroll
    for (int ks = 0; ks < 16; ++ks)
#pragma unroll
        for (int lb = 0; lb < 2; ++lb) { const bf16x8 q = *(const bf16x8*)(qsm + (lb * 32 + r) * QST + ks * 32 + hh * 16);
            acc[lb] = __builtin_amdgcn_mfma_f32_32x32x16_bf16(cfr[ks], q, acc[lb], 0, 0, 0); }
    __syncthreads();
#pragma unroll
    for (int lb = 0; lb < 2; ++lb) { const float it = sc[192 + lb * 32 + r];
#pragma unroll
        for (int i = 0; i < 16; ++i) acc[lb][i] *= it; }
    const int vb_off = (8 * hh + (li >> 2)) * VST + (wave * 32 + 16 * (r >> 4) + 4 * (li & 3)) * 2;
#pragma unroll
    for (int ks = 0; ks < 4; ++ks) { const bf16x8 afr = tr_frag(vsm + vb_off + ks * 16 * VST, 4 * VST);
#pragma unroll
        for (int lb = 0; lb < 2; ++lb) { if (lb == 0 && ks >= 2) continue;
            const bf16x8 wf = *(const bf16x8*)(wsm + (lb * 32 + r) * WST + ks * 32 + hh * 16);
            acc[lb] = __builtin_amdgcn_mfma_f32_32x32x16_bf16(afr, wf, acc[lb], 0, 0, 0); } }
    float ssq[2];
#pragma unroll
    for (int lb = 0; lb < 2; ++lb) { const int l = lb * 32 + r;
        const f32x4 rsv = *(const f32x4*)(sc + 256 + l * 4); const f32x4 q0 = *(const f32x4*)(sc + 512 + l * 8), q1 = *(const f32x4*)(sc + 512 + l * 8 + 4);
        const float den = (rsv[0] + rsv[1] + rsv[2] + rsv[3]) + sc[192 + l] * ((q0[0] + q0[1] + q0[2] + q0[3]) + (q1[0] + q1[1] + q1[2] + q1[3]));
        const float inv = 1.f / fmaxf(fabsf(den), __expf(-sc[128 + l]));
        float s2 = 0.f;
#pragma unroll
        for (int i = 0; i < 16; ++i) { acc[lb][i] *= inv; s2 += acc[lb][i] * acc[lb][i]; }
        s2 += __shfl_xor(s2, 32); ssq[lb] = s2; }
    __syncthreads();
    if (hh == 0) { sc[1024 + r * 8 + wave] = ssq[0]; sc[1024 + (32 + r) * 8 + wave] = ssq[1]; }
#pragma unroll
    for (int lb = 0; lb < 2; ++lb)
#pragma unroll
        for (int g = 0; g < 4; ++g) { f32x4 v; v[0] = acc[lb][4 * g]; v[1] = acc[lb][4 * g + 1]; v[2] = acc[lb][4 * g + 2]; v[3] = acc[lb][4 * g + 3];
            *(f32x4*)((unsigned char*)hsm + (lb * 32 + r) * HST + (wave * 32 + 8 * g + 4 * hh) * 4) = v; }
    __syncthreads();
#pragma unroll
    for (int i = 0; i < 4; ++i) { const int c = tid + NTHR * i, l = c >> 5, e0 = (c & 31) * 8;
        const f32x4 s0 = *(const f32x4*)(sc + 1024 + l * 8), s1 = *(const f32x4*)(sc + 1024 + l * 8 + 4);
        const float rr = rsqrtf(((s0[0] + s0[1] + s0[2] + s0[3]) + (s1[0] + s1[1] + s1[2] + s1[3])) * (1.f / 256.f) + EPS_);
        const f32x4 h0 = *(const f32x4*)((unsigned char*)hsm + l * HST + e0 * 4), h1 = *(const f32x4*)((unsigned char*)hsm + l * HST + e0 * 4 + 16);
        const f32x4 g0 = *(const f32x4*)(p.m_hg + h * 256 + e0), g1 = *(const f32x4*)(p.m_hg + h * 256 + e0 + 4);
        const u32x4 mo = *(const u32x4*)(Mo + (size_t)(t0 + l) * 1024 + h * 256 + e0);
        u32x4 o;
        o.x = cvt_pk(h0[0] * rr * g0[0] * sigm(bflo(mo.x)), h0[1] * rr * g0[1] * sigm(bfhi(mo.x))); o.y = cvt_pk(h0[2] * rr * g0[2] * sigm(bflo(mo.y)), h0[3] * rr * g0[3] * sigm(bfhi(mo.y)));
        o.z = cvt_pk(h1[0] * rr * g1[0] * sigm(bflo(mo.z)), h1[1] * rr * g1[1] * sigm(bfhi(mo.z))); o.w = cvt_pk(h1[2] * rr * g1[2] * sigm(bflo(mo.w)), h1[3] * rr * g1[3] * sigm(bfhi(mo.w)));
        *(u32x4*)(Oc + (size_t)(t0 + l) * D_ + 1024 + h * 256 + e0) = o; }
}

__device__ __forceinline__ void ce_desc(float& a, float& b) { const float hi = fmaxf(a, b), lo = fminf(a, b); a = hi; b = lo; }
__device__ __forceinline__ void sort16_desc(float (&v)[16]) {
#pragma unroll
    for (int k = 2; k <= 16; k <<= 1)
#pragma unroll
        for (int j = k >> 1; j > 0; j >>= 1)
#pragma unroll
            for (int i = 0; i < 16; ++i) { const int l = i ^ j; if (l > i) { if ((i & k) == 0) ce_desc(v[i], v[l]); else ce_desc(v[l], v[i]); } }
}
__device__ __forceinline__ void bmerge16_desc(float (&v)[16]) {
#pragma unroll
    for (int j = 8; j > 0; j >>= 1)
#pragma unroll
        for (int i = 0; i < 16; ++i) { const int l = i ^ j; if (l > i) ce_desc(v[i], v[l]); }
}
__device__ __forceinline__ void merge_top16(float (&a)[16], const float (&b)[16]) {
#pragma unroll
    for (int i = 0; i < 16; ++i) a[i] = fmaxf(a[i], b[15 - i]);
    bmerge16_desc(a);
}
__device__ __forceinline__ float pack_idx(float v, unsigned mask, unsigned idx) { return __builtin_bit_cast(float, (__builtin_bit_cast(unsigned, v) & mask) | idx); }
__device__ __forceinline__ void top16_from_acc(const f32x16 (&acc)[4], int h, float (&out)[16]) {
    float g[4][16];
#pragma unroll
    for (int mt = 0; mt < 4; ++mt) {
#pragma unroll
        for (int i = 0; i < 16; ++i) g[mt][i] = pack_idx(acc[mt][i], 0xffffff80u, (unsigned)(32 * mt + (i & 3) + 8 * (i >> 2)) | ((unsigned)h << 2));
        sort16_desc(g[mt]);
    }
    merge_top16(g[0], g[1]); merge_top16(g[2], g[3]); merge_top16(g[0], g[2]);
    float o[16];
#pragma unroll
    for (int i = 0; i < 16; ++i) o[i] = __shfl_xor(g[0][i], 32);
    merge_top16(g[0], o);
#pragma unroll
    for (int i = 0; i < 16; ++i) out[i] = g[0][i];
}
__device__ __forceinline__ unsigned lut16(const unsigned (&P)[4], unsigned i) {
    const unsigned long long lo = (unsigned long long)P[0] | ((unsigned long long)P[1] << 32), hi = (unsigned long long)P[2] | ((unsigned long long)P[3] << 32);
    const unsigned long long s = (i & 8u) ? hi : lo;
    return (unsigned)(s >> ((i & 7u) * 8u)) & 0xffu;
}
struct CandTab { int i[50]; int j[50]; };
constexpr CandTab make_cand_tab() { CandTab t{}; int n = 0; for (int i = 0; i < 16; ++i) for (int j = 0; j < 16; ++j) if ((i + 1) * (j + 1) <= 16) { t.i[n] = i; t.j[n] = j; ++n; } return t; }
__device__ __forceinline__ void phase_topk(const Params& p, unsigned char* lds, int bid, int nb) {
    const int tid = get_tid(), lane = tid & 63, wave = tid >> 6, r = lane & 31, h = lane >> 5;
    unsigned char* ws = p.ws;
    const bf16_t* Q = (const bf16_t*)(ws + WS_Q); int* IDX = (int*)(ws + WS_IDX); float* GW = (float*)(ws + WS_GW);
    constexpr int KP = 136;
    bf16_t* KS = (bf16_t*)lds;
    for (int i = tid; i < 2 * 2048; i += NTHR) {
        const int which = i >> 11, n = (i >> 4) & 127, d0 = (i & 15) * 8; const float* sp = (which ? p.sk2 : p.sk1) + n * 128 + d0;
        const f32x4 a = *(const f32x4*)sp, b = *(const f32x4*)(sp + 4);
        u32x4 hi, lo;
        hi.x = cvt_pk(a[0], a[1]); hi.y = cvt_pk(a[2], a[3]); hi.z = cvt_pk(b[0], b[1]); hi.w = cvt_pk(b[2], b[3]);
        lo.x = cvt_pk(a[0] - bflo(hi.x), a[1] - bfhi(hi.x)); lo.y = cvt_pk(a[2] - bflo(hi.y), a[3] - bfhi(hi.y)); lo.z = cvt_pk(b[0] - bflo(hi.z), b[1] - bfhi(hi.z)); lo.w = cvt_pk(b[2] - bflo(hi.w), b[3] - bfhi(hi.w));
        *(u32x4*)(KS + ((which * 2 + 0) * 128 + n) * KP + d0) = hi; *(u32x4*)(KS + ((which * 2 + 1) * 128 + n) * KP + d0) = lo; }
    __syncthreads();
    for (int item = bid * 8 + wave; item < 512 * 8; item += nb * 8) {
        const int tt = item >> 3, hh = item & 7, t = tt * 32 + r;
        float top[2][16];
#pragma unroll
        for (int list = 0; list < 2; ++list) {
            bf16x8 qf[8];
#pragma unroll
            for (int ks = 0; ks < 8; ++ks) qf[ks] = *(const bf16x8*)(Q + (size_t)t * D_ + hh * 256 + list * 128 + ks * 16 + h * 8);
            float g[4][16];
#pragma unroll
            for (int mt = 0; mt < 4; ++mt) {
                f32x16 acc;
#pragma unroll
                for (int i = 0; i < 16; ++i) acc[i] = 0.f;
#pragma unroll
                for (int hl = 0; hl < 2; ++hl)
#pragma unroll
                    for (int ks = 0; ks < 8; ++ks) { const bf16x8 a = *(const bf16x8*)(KS + ((list * 2 + hl) * 128 + mt * 32 + r) * KP + ks * 16 + h * 8);
                        acc = __builtin_amdgcn_mfma_f32_32x32x16_bf16(a, qf[ks], acc, 0, 0, 0); }
#pragma unroll
                for (int i = 0; i < 16; ++i) g[mt][i] = pack_idx(acc[i], 0xffffff80u, (unsigned)(32 * mt + (i & 3) + 8 * (i >> 2)) | ((unsigned)h << 2));
                sort16_desc(g[mt]);
                __builtin_amdgcn_sched_barrier(0);
            }
            merge_top16(g[0], g[1]); merge_top16(g[2], g[3]); merge_top16(g[0], g[2]);
            {   float o[16];
#pragma unroll
                for (int i = 0; i < 16; ++i) o[i] = __shfl_xor(g[0][i], 32);
                merge_top16(g[0], o); }
#pragma unroll
            for (int i = 0; i < 16; ++i) top[list][i] = g[0][i];
            __builtin_amdgcn_sched_barrier(0);
        }
        unsigned P1[4], P2[4];
#pragma unroll
        for (int q = 0; q < 4; ++q) { P1[q] = 0u; P2[q] = 0u;
#pragma unroll
            for (int e = 0; e < 4; ++e) { P1[q] |= (__builtin_bit_cast(unsigned, top[0][4 * q + e]) & 127u) << (8 * e); P2[q] |= (__builtin_bit_cast(unsigned, top[1][4 * q + e]) & 127u) << (8 * e); } }
        float c[4][16];
#pragma unroll
        for (int n = 0; n < 64; ++n) {
            if (n < 50) { constexpr CandTab CT = make_cand_tab(); const int i = CT.i[n], j = CT.j[n];
                c[n >> 4][n & 15] = pack_idx(top[0][i] + top[1][j], 0xffffff00u, (unsigned)(i * 16 + j)); }
            else c[n >> 4][n & 15] = -INFINITY;
        }
        sort16_desc(c[0]); __builtin_amdgcn_sched_barrier(0); sort16_desc(c[1]); __builtin_amdgcn_sched_barrier(0); merge_top16(c[0], c[1]); __builtin_amdgcn_sched_barrier(0);
        sort16_desc(c[2]); __builtin_amdgcn_sched_barrier(0); sort16_desc(c[3]); __builtin_amdgcn_sched_barrier(0); merge_top16(c[2], c[3]); __builtin_amdgcn_sched_barrier(0); merge_top16(c[0], c[2]);
        float ex[16], sum = 0.f;
#pragma unroll
        for (int k = 0; k < 16; ++k) { ex[k] = __expf(c[0][k] - c[0][0]); sum += ex[k]; }
        const float inv = 1.f / sum;
        if (h == 0) {
            int* ip = IDX + (size_t)t * 128 + hh * 16; float* gp = GW + (size_t)t * 128 + hh * 16;
#pragma unroll
            for (int q = 0; q < 4; ++q) { u32x4 iv; f32x4 gv;
#pragma unroll
                for (int e = 0; e < 4; ++e) { const unsigned pos = __builtin_bit_cast(unsigned, c[0][4 * q + e]) & 255u;
                    iv[e] = lut16(P1, pos >> 4) * 128u + lut16(P2, pos & 15u); gv[e] = ex[4 * q + e] * inv; }
                *(u32x4*)(ip + 4 * q) = iv; *(f32x4*)(gp + 4 * q) = gv; }
        }
    }
}

typedef float f32x2 __attribute__((ext_vector_type(2)));
__device__ __forceinline__ float dot16_fp8(const u32x4 w, const float (&h)[32], int o) {
    float s = 0.f;
#pragma unroll
    for (int q = 0; q < 4; ++q) { const f32x2 lo = __builtin_amdgcn_cvt_pk_f32_fp8((int)w[q], false), hi = __builtin_amdgcn_cvt_pk_f32_fp8((int)w[q], true);
        fmac(s, lo[0], h[o + 4 * q]); fmac(s, lo[1], h[o + 4 * q + 1]); fmac(s, hi[0], h[o + 4 * q + 2]); fmac(s, hi[1], h[o + 4 * q + 3]); }
    return s;
}
template <int CTRL, int ROW_MASK, int BANK_MASK>
__device__ __forceinline__ int dpp_mov0i(int v) { return __builtin_amdgcn_update_dpp(0, v, CTRL, ROW_MASK, BANK_MASK, true); }
__device__ __forceinline__ void quant_row_i8(const bf16_t* hp, int c16, unsigned (&hq)[32], float& hsc) {
    float mx = 0.f;
#pragma unroll
    for (int i = 0; i < 16; ++i) { const u32x4 w = *(const u32x4*)(hp + 256 * (i >> 1) + 8 * (i & 1));
#pragma unroll
        for (int e = 0; e < 4; ++e) mx = fmaxf(mx, fmaxf(fabsf(bflo(w[e])), fabsf(bfhi(w[e])))); }
    mx = fmaxf(mx, __shfl_xor(mx, 1)); mx = fmaxf(mx, __shfl_xor(mx, 2)); mx = fmaxf(mx, __shfl_xor(mx, 4)); mx = fmaxf(mx, __shfl_xor(mx, 8));
    mx = fmaxf(mx, 1e-30f); const float inv = 127.f / mx; hsc = mx * (1.f / 127.f);
    asm volatile("" ::: "memory");
#pragma unroll
    for (int i = 0; i < 16; ++i) { const u32x4 w = *(const u32x4*)(hp + 256 * (i >> 1) + 8 * (i & 1));
#pragma unroll
        for (int hh = 0; hh < 2; ++hh) { const unsigned w0 = w[2 * hh], w1 = w[2 * hh + 1];
            hq[2 * i + hh] = ((unsigned)__float2int_rn(bflo(w0) * inv) & 0xffu) | (((unsigned)__float2int_rn(bfhi(w0) * inv) & 0xffu) << 8) | (((unsigned)__float2int_rn(bflo(w1) * inv) & 0xffu) << 16) | (((unsigned)__float2int_rn(bfhi(w1) * inv) & 0xffu) << 24); } }
}
__device__ __forceinline__ void phase_peer1(const Params& p, unsigned char* lds, int bid, int nb, int probe) {
    const int tid = get_tid(), lane = tid & 63, wave = tid >> 6, r = lane >> 4, c16 = lane & 15;
    unsigned char* ws = p.ws;
    const bf16_t* H2 = (const bf16_t*)(ws + WS_H2); const int* IDX = (const int*)(ws + WS_IDX); const float* GW = (const float*)(ws + WS_GW);
    unsigned* EWT = (unsigned*)(ws + WS_EWT); const float* DSC = (const float*)(ws + WS_DSC);
    const unsigned char* E8D = ws + WS_E8D + 16 * c16; const unsigned emask = probe ? 0x3ffu : 0x3fffu;
    LAS unsigned* seq = (LAS unsigned*)((LAS unsigned char*)lds + (wave * 4 + r) * 1024);
    LAS unsigned* hist = (LAS unsigned*)((LAS unsigned char*)lds + 32768 + (wave * 4 + r) * 128);
    for (int tile = bid; tile < 256; tile += nb) {
        const int tA = tile * 64 + wave * 4 + r, tB = tA + 32;
        unsigned hqA[32], hqB[32]; float hscA, hscB;
        quant_row_i8(H2 + (size_t)tA * D_ + 16 * c16, c16, hqA, hscA);
        quant_row_i8(H2 + (size_t)tB * D_ + 16 * c16, c16, hqB, hscB);
        unsigned ppA0, ppA1, ppB0, ppB1;
        {   int idx[16]; unsigned pos[16];
#pragma unroll
            for (int m = 0; m < 8; ++m) { idx[m] = IDX[(size_t)tA * 128 + c16 + 16 * m]; idx[8 + m] = IDX[(size_t)tB * 128 + c16 + 16 * m]; }
            hist[c16] = 0u;
#pragma unroll
            for (int m = 0; m < 16; ++m) pos[m] = __hip_atomic_fetch_add(&hist[idx[m] >> 10], 1u, __ATOMIC_RELAXED, __HIP_MEMORY_SCOPE_WORKGROUP);
            {   const unsigned c = hist[c16]; unsigned inc = c;
#pragma unroll
                for (int o = 1; o < 16; o <<= 1) { const unsigned u = __shfl_up(inc, o, 16); if (c16 >= o) inc += u; }
                hist[c16] = inc - c; }
#pragma unroll
            for (int m = 0; m < 16; ++m) { pos[m] += hist[idx[m] >> 10]; seq[pos[m]] = (unsigned)idx[m] | ((unsigned)(c16 + 16 * (m & 7)) << 14) | ((unsigned)(m >> 3) << 21); }
            ppA0 = pos[0] | (pos[1] << 8) | (pos[2] << 16) | (pos[3] << 24); ppA1 = pos[4] | (pos[5] << 8) | (pos[6] << 16) | (pos[7] << 24);
            ppB0 = pos[8] | (pos[9] << 8) | (pos[10] << 16) | (pos[11] << 24); ppB1 = pos[12] | (pos[13] << 8) | (pos[14] << 16) | (pos[15] << 24);
        }
        u32x4 cur[8], nxt[8]; unsigned ecur = seq[0], enxt = 0u;
        {   const unsigned char* rp = E8D + (size_t)(ecur & emask) * 2048;
#pragma unroll
            for (int q = 0; q < 8; ++q) cur[q] = *(const u32x4*)(rp + 256 * q); }
        for (int s = 0; s < 256; ++s) {
            if (s + 1 < 256) { enxt = seq[s + 1]; const unsigned char* rp = E8D + (size_t)(enxt & emask) * 2048;
#pragma unroll
                for (int q = 0; q < 8; ++q) nxt[q] = *(const u32x4*)(rp + 256 * q); }
            int a0 = 0, a1 = 0, b0 = 0, b1 = 0;
#pragma unroll
            for (int q = 0; q < 8; ++q) {
                a0 = __builtin_amdgcn_sdot4((int)cur[q][0], (int)hqA[4 * q], a0, false); a1 = __builtin_amdgcn_sdot4((int)cur[q][1], (int)hqA[4 * q + 1], a1, false);
                a0 = __builtin_amdgcn_sdot4((int)cur[q][2], (int)hqA[4 * q + 2], a0, false); a1 = __builtin_amdgcn_sdot4((int)cur[q][3], (int)hqA[4 * q + 3], a1, false);
                b0 = __builtin_amdgcn_sdot4((int)cur[q][0], (int)hqB[4 * q], b0, false); b1 = __builtin_amdgcn_sdot4((int)cur[q][1], (int)hqB[4 * q + 1], b1, false);
                b0 = __builtin_amdgcn_sdot4((int)cur[q][2], (int)hqB[4 * q + 2], b0, false); b1 = __builtin_amdgcn_sdot4((int)cur[q][3], (int)hqB[4 * q + 3], b1, false); }
            int d = ((ecur >> 21) & 1u) ? (b0 + b1) : (a0 + a1);
            d += dpp_mov0i<0x111, 0xf, 0xf>(d); d += dpp_mov0i<0x112, 0xf, 0xf>(d); d += dpp_mov0i<0x114, 0xf, 0xe>(d); d += dpp_mov0i<0x118, 0xf, 0xc>(d);
            if (c16 == 15) seq[s] = (unsigned)d;
#pragma unroll
            for (int q = 0; q < 8; ++q) cur[q] = nxt[q];
            ecur = enxt;
        }
        if (probe) continue;
#pragma unroll
        for (int tk = 0; tk < 2; ++tk) {
            const int t = tk ? tB : tA; const float hsc = tk ? hscB : hscA;
            unsigned* ep = EWT + (size_t)(t >> 6) * 8192 + (t & 63) * 4;
#pragma unroll
            for (int m = 0; m < 8; ++m) { const int j = c16 + 16 * m; const int ix = IDX[(size_t)t * 128 + j];
                const unsigned ps = ((tk ? (m < 4 ? ppB0 : ppB1) : (m < 4 ? ppA0 : ppA1)) >> (8 * (m & 3))) & 0xffu;
                const float a = (float)(int)seq[ps] * hsc * DSC[ix];
                const float w = GW[(size_t)t * 128 + j] * 0.5f * a * (1.f + erff(a * 0.7071067811865476f));
                ep[(j >> 2) * 256 + (j & 3)] = (cvt_pk(0.f, w) & 0xffff0000u) | (unsigned)ix; }
        }
    }
}
__device__ __forceinline__ void phase_peer2(const Params& p, unsigned char* lds, int bid, int nb) {
    const int tid = get_tid(), lane = tid & 63, wave = tid >> 6;
    unsigned char* ws = p.ws;
    const unsigned* EWT = (const unsigned*)(ws + WS_EWT); const bf16_t* Y = (const bf16_t*)(ws + WS_X1); const float* mod = (const float*)(ws + WS_MOD);
    for (int si = bid; si < 256; si += nb) {
        const int s = (si & 7) * 32 + (si >> 3);
        __syncthreads();
        {   const u32x4* sp = (const u32x4*)(ws + WS_E8U + (size_t)s * 131072);
#pragma unroll
            for (int i = 0; i < 16; ++i) ((u32x4*)lds)[tid + NTHR * i] = sp[tid + NTHR * i]; }
        __syncthreads();
        const int tb0 = ((si >> 5) * 32 + wave) & 255;
        unsigned cur[16], nxt[16];
        {   const u32x4* wp = (const u32x4*)(EWT + (size_t)tb0 * 8192) + lane;
#pragma unroll
            for (int u = 0; u < 4; ++u) { const u32x4 v = wp[u * 64]; cur[4 * u] = v.x; cur[4 * u + 1] = v.y; cur[4 * u + 2] = v.z; cur[4 * u + 3] = v.w; } }
        float acc[8];
#pragma unroll
        for (int c = 0; c < 8; ++c) acc[c] = 0.f;
        f32x4 xa = {0.f, 0.f, 0.f, 0.f}, xb = xa;
        for (int q = 0; q < 256; ++q) {
            const int tb = (tb0 + 8 * (q >> 3)) & 255, g = q & 7;
            if (q + 1 < 256) { const int tbn = (tb0 + 8 * ((q + 1) >> 3)) & 255; const u32x4* wp = (const u32x4*)(EWT + (size_t)tbn * 8192 + ((q + 1) & 7) * 1024) + lane;
#pragma unroll
                for (int u = 0; u < 4; ++u) { const u32x4 v = wp[u * 64]; nxt[4 * u] = v.x; nxt[4 * u + 1] = v.y; nxt[4 * u + 2] = v.z; nxt[4 * u + 3] = v.w; } }
            const int t = tb * 64 + lane;
            if (g == 0) { xa = *(const f32x4*)(p.x + (size_t)t * D_ + 8 * s); xb = *(const f32x4*)(p.x + (size_t)t * D_ + 8 * s + 4);
                const u32x4 yw = *(const u32x4*)(Y + (size_t)t * D_ + 8 * s); const float* g1 = mod + (size_t)(t >> 11) * NMOD + 2 * D_ + 8 * s; const f32x4 ha = *(const f32x4*)g1, hb = *(const f32x4*)(g1 + 4);
                xa[0] += ha[0] * bflo(yw.x); xa[1] += ha[1] * bfhi(yw.x); xa[2] += ha[2] * bflo(yw.y); xa[3] += ha[3] * bfhi(yw.y); xb[0] += hb[0] * bflo(yw.z); xb[1] += hb[1] * bfhi(yw.z); xb[2] += hb[2] * bflo(yw.w); xb[3] += hb[3] * bfhi(yw.w); }
            u32x2 row[16];
#pragma unroll
            for (int u = 0; u < 16; ++u) row[u] = *(const LAS u32x2*)(unsigned)((cur[u] << 3) & 0x1fff8u);
#pragma unroll
            for (int u = 0; u < 16; ++u) {
                const float w = __builtin_bit_cast(float, cur[u]);
                const f32x2 v0 = __builtin_amdgcn_cvt_pk_f32_fp8((int)row[u].x, false), v1 = __builtin_amdgcn_cvt_pk_f32_fp8((int)row[u].x, true), v2 = __builtin_amdgcn_cvt_pk_f32_fp8((int)row[u].y, false), v3 = __builtin_amdgcn_cvt_pk_f32_fp8((int)row[u].y, true);
                fmac(acc[0], w, v0[0]); fmac(acc[1], w, v0[1]); fmac(acc[2], w, v1[0]); fmac(acc[3], w, v1[1]); fmac(acc[4], w, v2[0]); fmac(acc[5], w, v2[1]); fmac(acc[6], w, v3[0]); fmac(acc[7], w, v3[1]);
            }
            if (g == 7) {
                const float* g2 = mod + (size_t)(t >> 11) * NMOD + 5 * D_ + 8 * s;
                const f32x4 ga = *(const f32x4*)g2, gb = *(const f32x4*)(g2 + 4);
                f32x4 oa, ob;
#pragma unroll
                for (int c = 0; c < 4; ++c) { oa[c] = xa[c] + ga[c] * acc[c] * (1.f / 32.f); ob[c] = xb[c] + gb[c] * acc[4 + c] * (1.f / 32.f); }
                *(f32x4*)(p.out + (size_t)t * D_ + 8 * s) = oa; *(f32x4*)(p.out + (size_t)t * D_ + 8 * s + 4) = ob;
#pragma unroll
                for (int c = 0; c < 8; ++c) acc[c] = 0.f;
            }
#pragma unroll
            for (int u = 0; u < 16; ++u) cur[u] = nxt[u];
        }
    }
}

typedef const __attribute__((address_space(4))) Params* KargPtr;
__device__ __forceinline__ Params load_params() {
#if defined(__HIP_DEVICE_COMPILE__)
    KargPtr kp = (KargPtr)__builtin_amdgcn_kernarg_segment_ptr(); asm volatile("" : "+s"(kp)); Params r; __builtin_memcpy(&r, kp, sizeof(Params)); return r;
#else
    return Params{};
#endif
}
constexpr int N_PHASES = 12;
constexpr int LDS_BYTES = 152 * 1024;
__global__ void __launch_bounds__(NTHR) fwd_kernel(Params p_arg) {
    extern __shared__ __attribute__((aligned(16))) unsigned char lds[];
    const int bid = blockIdx.x, nb = gridDim.x, tid = get_tid();
    unsigned char* ws = p_arg.ws;
    volatile LAS unsigned* xbst = (volatile LAS unsigned*)((LAS unsigned char*)lds + LDS_BYTES - 16);
    if (tid == 0) { xbst[0] = 0u; xbst[1] = 0u; xbst[2] = 0u; xbst[3] = 0u; }
    __syncthreads();
    if ((p_arg.ph_hi - p_arg.ph_lo) > 1) (void)xcd_barrier_post((unsigned*)(ws + WS_BAR), xbst);
#ifdef ONLY_PHASE
#define IN(k) ((k) == ONLY_PHASE && p.ph_lo <= (k) && (k) < p.ph_hi)
#else
#define IN(k) (p.ph_lo <= (k) && (k) < p.ph_hi)
#endif
#define SEAM(k) do { const Params p = load_params(); if (p.ph_lo <= (k) && (k) + 1 < p.ph_hi) { XcdBarrier bar; bar.bar = (unsigned*)(p.ws + WS_BAR); bar.x = xb_xcc_id(); bar.st = xbst; xcd_barrier(bar); } } while (0)
#ifndef REPEAT_MASK
#define REPEAT_MASK 0
#endif
#define REP(k) for (int rep_ = 0; rep_ < (((REPEAT_MASK) >> (k)) & 1) + 1; ++rep_)
    REP(0) { const Params p = load_params(); if (IN(0)) { unsigned char* ws = p.ws; const float* mod = (const float*)(ws + WS_MOD); (void)mod;
        phase_prep(p, lds, bid, nb);
    } }
    SEAM(0);
    REP(1) { const Params p = load_params(); if (IN(1)) { unsigned char* ws = p.ws; const float* mod = (const float*)(ws + WS_MOD); (void)mod;
        phase_norm<false>(p.x, nullptr, 0, p.g1, mod, 0, D_, (bf16_t*)(ws + WS_H), bid, nb);
    } }
    SEAM(1);
    REP(2) { const Params p = load_params(); if (IN(2)) { unsigned char* ws = p.ws; const float* mod = (const float*)(ws + WS_MOD); (void)mod;
        phase_gates(p, lds, bid, nb);
        { pg8::Gemm g{(const bf16_t*)(ws + WS_H), (const bf16_t*)(ws + WS_WINT), T_, 7168, D_}; pg8::StaticOrder S; S.init(T_, 7168, nb, bid);
        pg8::EpiSeg E{(bf16_t*)(ws + WS_P), p.fox_qg, p.fox_kg, (LAS float*)((LAS unsigned char*)lds + 131072)}; pg8::gemm_phase<pg8::EpiSeg, pg8::StaticOrder, true, true>((LAS unsigned char*)lds, g, S, E); }
    } }
    SEAM(2);
    REP(3) { const Params p = load_params(); if (IN(3)) { unsigned char* ws = p.ws; const float* mod = (const float*)(ws + WS_MOD); (void)mod;
        phase_post(p, bid, nb);
    } }
    SEAM(3);
    REP(4) { const Params p = load_params(); if (IN(4)) { unsigned char* ws = p.ws; const float* mod = (const float*)(ws + WS_MOD); (void)mod;
        { for (int u = bid; u < 64; u += nb) mlstm_passA(p, lds, u);
        unsigned* qctr = (unsigned*)(ws + WS_QCTR) + rep_; LAS int* slot = (LAS int*)((LAS unsigned char*)lds + LDS_BYTES - 32);
        for (;;) { __syncthreads(); if (tid == 0) *slot = (int)atomicAdd(qctr, 1u); __syncthreads(); const int u = *slot; if (u >= 512) break;
            const int bh = u & 63; fox_unit(p, lds, bh >> 3, bh & 7, 7 - (u >> 6)); } }
    } }
    SEAM(4);
    REP(5) { const Params p = load_params(); if (IN(5)) { unsigned char* ws = p.ws; const float* mod = (const float*)(ws + WS_MOD); (void)mod;
        { for (int u = bid; u < 1024; u += nb) mlstm_passB(p, lds, u); }
    } }
    SEAM(5);
    REP(6) { const Params p = load_params(); if (IN(6)) { unsigned char* ws = p.ws; const float* mod = (const float*)(ws + WS_MOD); (void)mod;
        { pg8::Gemm g{(const bf16_t*)(ws + WS_H), (const bf16_t*)(ws + WS_WOT), T_, D_, D_}; pg8::StaticOrder S; S.init(T_, D_, nb, bid);
        pg8::EpiBf E{(bf16_t*)(ws + WS_X1), D_}; pg8::gemm_phase<pg8::EpiBf, pg8::StaticOrder, true, true>((LAS unsigned char*)lds, g, S, E); }
    } }
    SEAM(6);
    REP(7) { const Params p = load_params(); if (IN(7)) { unsigned char* ws = p.ws; const float* mod = (const float*)(ws + WS_MOD); (void)mod;
        convert_experts(p, bid, nb);
    } }
    REP(7) { const Params p = load_params(); if (IN(7)) { unsigned char* ws = p.ws; const float* mod = (const float*)(ws + WS_MOD); (void)mod;
        phase_norm<true>(p.x, (const bf16_t*)(ws + WS_X1), 2 * D_, p.g2, mod, 3 * D_, 4 * D_, (bf16_t*)(ws + WS_H2), bid, nb);
    } }
    SEAM(7);
    REP(8) { const Params p = load_params(); if (IN(8)) { unsigned char* ws = p.ws; const float* mod = (const float*)(ws + WS_MOD); (void)mod;
        { pg8::Gemm g{(const bf16_t*)(ws + WS_H2), (const bf16_t*)(ws + WS_WQT), T_, D_, D_}; pg8::StaticOrder S; S.init(T_, D_, nb, bid);
        pg8::EpiBf E{(bf16_t*)(ws + WS_Q), D_}; pg8::gemm_phase<pg8::EpiBf, pg8::StaticOrder, true, true>((LAS unsigned char*)lds, g, S, E); }
    } }
    SEAM(8);
    REP(9) { const Params p = load_params(); if (IN(9)) { unsigned char* ws = p.ws; const float* mod = (const float*)(ws + WS_MOD); (void)mod;
        phase_topk(p, lds, bid, nb);
    } }
    SEAM(9);
    REP(10) { const Params p = load_params(); if (IN(10)) { unsigned char* ws = p.ws; const float* mod = (const float*)(ws + WS_MOD); (void)mod;
#ifdef PROBE_L2
        phase_peer1(p, lds, bid, nb, rep_);
#else
        phase_peer1(p, lds, bid, nb, 0);
#endif
    } }
    SEAM(10);
    REP(11) { const Params p = load_params(); if (IN(11)) { unsigned char* ws = p.ws; const float* mod = (const float*)(ws + WS_MOD); (void)mod;
        phase_peer2(p, lds, bid, nb);
    } }
#undef IN
#undef SEAM
}

#ifndef ONE_LAUNCH
#define ONE_LAUNCH 1
#endif
extern "C" void kernel_launch(void* const* d_in, const int* in_sizes, int n_in, void* d_out, int out_size, void* d_ws, size_t ws_size, hipStream_t stream) {
    static int grid = 0;
    if (grid == 0) {
        int dev = 0, cus = 0, per_cu = 0;
        if (n_in != 21 || ws_size < WS_END) { fprintf(stderr, "kernel_launch: unexpected n_in %d / ws_size %zu (need %zu)\n", n_in, ws_size, (size_t)WS_END); grid = -1; return; }
        hipGetDevice(&dev); hipDeviceGetAttribute(&cus, hipDeviceAttributeMultiprocessorCount, dev);
        if (hipFuncSetAttribute((const void*)fwd_kernel, hipFuncAttributeMaxDynamicSharedMemorySize, LDS_BYTES) != hipSuccess) { fprintf(stderr, "kernel_launch: hipFuncSetAttribute failed\n"); grid = -1; return; }
        if (hipOccupancyMaxActiveBlocksPerMultiprocessor(&per_cu, (const void*)fwd_kernel, NTHR, LDS_BYTES) != hipSuccess || per_cu < 1) { fprintf(stderr, "kernel_launch: occupancy query says %d\n", per_cu); (void)hipGetLastError(); }
        grid = cus > 0 ? cus : 256;
    }
    if (grid < 0) return;
    Params p{};
    const float** pp = (const float**)&p;
    for (int i = 0; i < 21; ++i) pp[i] = (const float*)d_in[i];
    p.out = (float*)d_out; p.ws = (unsigned char*)d_ws;
    hipMemsetAsync((char*)d_ws + WS_BAR, 0, 16384, stream);
#if ONE_LAUNCH
    p.ph_lo = 0; p.ph_hi = N_PHASES;
    void* args[] = {&p};
    hipError_t e = hipLaunchCooperativeKernel((const void*)fwd_kernel, dim3(grid), dim3(NTHR), args, LDS_BYTES, stream);
    if (e != hipSuccess) fprintf(stderr, "cooperative launch failed: %s (grid %d)\n", hipGetErrorString(e), grid);
#else
    for (int ph = 0; ph < N_PHASES; ++ph) { p.ph_lo = ph; p.ph_hi = ph + 1; hipLaunchKernelGGL(fwd_kernel, dim3(grid), dim3(NTHR), LDS_BYTES, stream, p); }
#endif
}
```

```cpp
#include <hip/hip_runtime.h>
#include <cstdio>
#include <cstdint>

#define GAS __attribute__((address_space(1)))
#define LAS __attribute__((address_space(3)))
typedef unsigned short bf16_t;
typedef short bf16x8 __attribute__((ext_vector_type(8)));
typedef float f32x4 __attribute__((ext_vector_type(4)));
typedef float f32x16 __attribute__((ext_vector_type(16)));
typedef unsigned u32x4 __attribute__((ext_vector_type(4)));
typedef unsigned u32x2 __attribute__((ext_vector_type(2)));

constexpr int T_ = 16384, D_ = 2048, B_ = 8, S_ = 2048, NTHR = 512;
constexpr float EPS_ = 1e-6f;
constexpr int NMOD = 6 * D_;
constexpr int INCOLS = 7184;

constexpr size_t WS_BAR   = 0;
constexpr size_t WS_MOD   = 16384;
constexpr size_t WS_WG    = WS_MOD + (size_t)B_ * NMOD * 4;
constexpr size_t WS_GATE  = WS_WG + 16 * 2048 * 4;
constexpr size_t WS_F     = WS_GATE + (size_t)T_ * 16 * 4;
constexpr size_t WS_NST   = WS_F + 64 * 2048 * 4;
constexpr size_t WS_MST   = WS_NST + 1024 * 256 * 4;
constexpr size_t WS_DSC   = WS_MST + 4096;
constexpr size_t WS_WINT  = WS_DSC + 16384 * 4;
constexpr size_t WS_WOT   = WS_WINT + (size_t)7168 * 2048 * 2;
constexpr size_t WS_WQT   = WS_WOT + (size_t)2048 * 2048 * 2;
constexpr size_t WS_H     = WS_WQT + (size_t)2048 * 2048 * 2;
constexpr size_t WS_P     = WS_H + (size_t)T_ * 2048 * 2;
constexpr size_t SEG_B    = (size_t)T_ * 1024 * 2;
constexpr size_t WS_CST   = WS_P + 7 * SEG_B;
constexpr size_t WS_E8D   = WS_CST + (size_t)1024 * 256 * 256 * 2;
constexpr size_t WS_E8U   = WS_E8D + (size_t)16384 * 2048;
constexpr size_t WS_END   = WS_E8U + (size_t)16384 * 2048;
constexpr size_t WS_QC    = WS_E8D;
constexpr size_t WS_KC    = WS_E8U;
constexpr size_t WS_H8    = WS_CST;
constexpr size_t WS_QCTR  = 15360;
constexpr size_t WS_H2    = WS_P;
constexpr size_t WS_Q     = WS_H2 + (size_t)T_ * 2048 * 2;
constexpr size_t WS_IDX   = WS_Q + (size_t)T_ * 2048 * 2;
constexpr size_t WS_GW    = WS_IDX + (size_t)T_ * 128 * 4;
static_assert(WS_GW + (size_t)T_ * 128 * 4 <= WS_CST, "alias overflow");
constexpr size_t WS_X1    = WS_CST;
constexpr size_t WS_EWT   = WS_GW + (size_t)T_ * 128 * 4;
static_assert(WS_EWT + (size_t)T_ * 128 * 4 <= WS_CST, "alias overflow 2");

struct Params {
    const float *x, *c, *w_ada, *b_ada, *g1, *g2, *w_in, *fox_fb, *fox_qg, *fox_kg, *conv_w, *conv_b, *m_ib, *m_fb, *m_hg, *w_out, *w_q, *sk1, *sk2, *e_down, *e_up;
    float* out; unsigned char* ws; int ph_lo, ph_hi; int swid;
};

__device__ __forceinline__ int get_tid(int swid) { int t; asm volatile("v_mbcnt_lo_u32_b32 %0, -1, 0\n\tv_mbcnt_hi_u32_b32 %0, -1, %0" : "=v"(t)); return swid * 64 + t; }
__device__ __forceinline__ void lds_barrier() { asm volatile("s_waitcnt lgkmcnt(0)\n\ts_barrier" ::: "memory"); }
__device__ __forceinline__ unsigned cvt_pk(float lo, float hi) { unsigned r; asm("v_cvt_pk_bf16_f32 %0, %1, %2" : "=v"(r) : "v"(lo), "v"(hi)); return r; }
__device__ __forceinline__ void fmac(float& acc, float a, float b) { asm("v_fmac_f32 %0, %1, %2" : "+v"(acc) : "v"(a), "v"(b)); }
__device__ __forceinline__ unsigned pack4_fp8(const f32x4 a) { int t = __builtin_amdgcn_cvt_pk_fp8_f32(a[0], a[1], 0, false); t = __builtin_amdgcn_cvt_pk_fp8_f32(a[2], a[3], t, true); return (unsigned)t; }
__device__ __forceinline__ float bf2f(unsigned short h) { return __builtin_bit_cast(float, ((unsigned)h) << 16); }
__device__ __forceinline__ float bflo(unsigned w) { return __builtin_bit_cast(float, w << 16); }
__device__ __forceinline__ float bfhi(unsigned w) { return __builtin_bit_cast(float, w & 0xffff0000u); }
__device__ __forceinline__ float wsum(float v) {
#pragma unroll
    for (int o = 32; o; o >>= 1) v += __shfl_xor(v, o);
    return v; }
__device__ __forceinline__ float wmax(float v) {
#pragma unroll
    for (int o = 32; o; o >>= 1) v = fmaxf(v, __shfl_xor(v, o));
    return v; }
__device__ __forceinline__ float logsig(float x) { return fminf(x, 0.f) - log1pf(expf(-fabsf(x))); }
__device__ __forceinline__ float sigm(float x) { return 1.f / (1.f + expf(-x)); }
__device__ __forceinline__ float silu_f(float x) { return x / (1.f + expf(-x)); }
namespace pg8 {
#define PG8_LAS __attribute__((address_space(3)))
typedef unsigned short bf16_t;
typedef short bf16x8 __attribute__((ext_vector_type(8)));
typedef float f32x4 __attribute__((ext_vector_type(4)));
typedef unsigned u32x4 __attribute__((ext_vector_type(4)));
constexpr int BM = 256, BK = 64, HALF = 128, HTB = HALF * BK * 2  , STAGE_BYTES = 8 * HTB, NXCD = 8, WGM = 8;

__host__ __device__ __forceinline__ int lds_byte(int r, int c) { const int st = (r >> 4) * 2 + (c >> 5), rr = r & 15, cc = c & 31, ob = rr * 64 + cc * 2; return st * 1024 + (ob ^ (((ob >> 9) & 1) << 5)); }
__host__ __device__ __forceinline__ void stage_rc(int b, int& R, int& C) { const int st = b / 1024, sb = b % 1024, swz = sb ^ (((sb >> 9) & 1) << 5); R = (st >> 1) * 16 + swz / 64; C = (st & 1) * 32 + (swz % 64) / 2; }
__host__ __device__ __forceinline__ int perm32(int rho) { const int n = rho >> 4, i = rho & 15; return 8 * (i >> 2) + 4 * n + (i & 3); }

struct Unit { int pm, pn; };
struct Gemm { const bf16_t* A; const bf16_t* Bt; int M, N, K; };

struct StaticOrder {
    int nM, nN, nwg, G, c;
    __host__ __device__ void init(int M, int N, int G_, int c_) { nM = M / BM; nN = N / BM; nwg = nM * nN; G = G_; c = c_; }
    __host__ __device__ bool next(int i, Unit& u) const {
        const long L = (long)i * G + c; if (L >= nwg) return false;
        int wgid = (int)L; { const int q = nwg / NXCD, r = nwg % NXCD, xcd = wgid % NXCD, off = wgid / NXCD; wgid = (xcd < r ? xcd * (q + 1) : r * (q + 1) + (xcd - r) * q) + off; }
        const int nig = WGM * nN, gid = wgid / nig, fm = gid * WGM, gsz = (nM - fm) < WGM ? (nM - fm) : WGM;
        u.pm = fm + ((wgid % nig) % gsz); u.pn = (wgid % nig) / gsz; return true;
    }
    __device__ __forceinline__ void a_ready(const Unit&) const {}
    __device__ __forceinline__ void done(const Unit&) const {}
};
struct EpiSeg {
    static constexpr bool PERM = true, AFTER_DRAIN = false;
    bf16_t* P; const float* qg; const float* kg; PG8_LAS float* X; float osc;
    __device__ __forceinline__ void operator()(const f32x4 (&acc)[2][2][4][2], const Unit& u, int wr, int wc, int fr, int fq) const {
        const int seg = u.pn >> 2; bf16_t* base = P + (size_t)seg * ((size_t)T_ * 1024);
        const int row0 = u.pm * BM + wr * 64 + fr, col0 = (u.pn & 3) * 256 + wc * 32 + 8 * fq;
        if (seg < 2) {
#pragma unroll
            for (int ai = 0; ai < 2; ++ai)
#pragma unroll
                for (int m = 0; m < 4; ++m)
#pragma unroll
                    for (int bj = 0; bj < 2; ++bj) { const f32x4 v0 = acc[ai][bj][m][0], v1 = acc[ai][bj][m][1];
                        float s = v0[0] * v0[0] + v0[1] * v0[1] + v0[2] * v0[2] + v0[3] * v0[3] + v1[0] * v1[0] + v1[1] * v1[1] + v1[2] * v1[2] + v1[3] * v1[3];
                        s += __int_as_float(__builtin_amdgcn_ds_bpermute(((fq ^ 1) * 16 + fr) * 4, __float_as_int(s))); s += __int_as_float(__builtin_amdgcn_ds_bpermute(((fq ^ 2) * 16 + fr) * 4, __float_as_int(s)));
                        if (fq == 0) X[((ai * HALF + wr * 64 + m * 16 + fr) * 2 + bj) * 4 + wc] = s * (osc * osc); }
            asm volatile("s_waitcnt lgkmcnt(0)\n\ts_barrier" ::: "memory");
            const float* gn = (seg ? kg : qg) + wc * 32 + 8 * fq;
            const f32x4 g0 = *(const f32x4*)gn, g1 = *(const f32x4*)(gn + 4);
            const float sc = seg ? 1.f : 0.08838834764831845f * 1.4426950408889634f;
#pragma unroll
            for (int ai = 0; ai < 2; ++ai)
#pragma unroll
                for (int m = 0; m < 4; ++m) { bf16_t* rowp = base + (size_t)(row0 + ai * HALF + m * 16) * 1024 + col0;
#pragma unroll
                    for (int bj = 0; bj < 2; ++bj) { const f32x4 pv = *(const PG8_LAS f32x4*)(X + ((ai * HALF + wr * 64 + m * 16 + fr) * 2 + bj) * 4);
                        const float rr = rsqrtf((pv[0] + pv[1] + pv[2] + pv[3]) * (1.f / 128.f) + EPS_) * sc * osc;
                        const f32x4 v0 = acc[ai][bj][m][0] * rr * g0, v1 = acc[ai][bj][m][1] * rr * g1;
                        u32x4 w; w.x = cvt_pk(v0[0], v0[1]); w.y = cvt_pk(v0[2], v0[3]); w.z = cvt_pk(v1[0], v1[1]); w.w = cvt_pk(v1[2], v1[3]);
                        *(u32x4*)(rowp + bj * HALF) = w; } }
            return;
        }
#pragma unroll
        for (int ai = 0; ai < 2; ++ai)
#pragma unroll
            for (int m = 0; m < 4; ++m) { bf16_t* rowp = base + (size_t)(row0 + ai * HALF + m * 16) * 1024 + col0;
#pragma unroll
                for (int bj = 0; bj < 2; ++bj) { const f32x4 v0 = acc[ai][bj][m][0] * osc, v1 = acc[ai][bj][m][1] * osc;
                    u32x4 w; w.x = cvt_pk(v0[0], v0[1]); w.y = cvt_pk(v0[2], v0[3]); w.z = cvt_pk(v1[0], v1[1]); w.w = cvt_pk(v1[2], v1[3]);
                    *(u32x4*)(rowp + bj * HALF) = w; } }
    }
};
struct EpiBf {
    static constexpr bool PERM = true, AFTER_DRAIN = false;
    bf16_t* O; int ldc;
    __device__ __forceinline__ void operator()(const f32x4 (&acc)[2][2][4][2], const Unit& u, int wr, int wc, int fr, int fq) const {
        const int row0 = u.pm * BM + wr * 64 + fr, col0 = u.pn * BM + wc * 32 + 8 * fq;
#pragma unroll
        for (int ai = 0; ai < 2; ++ai)
#pragma unroll
            for (int m = 0; m < 4; ++m) { bf16_t* rowp = O + (size_t)(row0 + ai * HALF + m * 16) * ldc + col0;
#pragma unroll
                for (int bj = 0; bj < 2; ++bj) { const f32x4 v0 = acc[ai][bj][m][0], v1 = acc[ai][bj][m][1];
                    u32x4 w; w.x = cvt_pk(v0[0], v0[1]); w.y = cvt_pk(v0[2], v0[3]); w.z = cvt_pk(v1[0], v1[1]); w.w = cvt_pk(v1[2], v1[3]);
                    *(u32x4*)(rowp + bj * HALF) = w; } }
    }
};
struct EpiRes {
    static constexpr bool PERM = false, AFTER_DRAIN = false;
    const float* X; float* O; const float* mod; int goff;
    __device__ __forceinline__ void operator()(const f32x4 (&acc)[2][2][4][2], const Unit& u, int wr, int wc, int fr, int fq) const {
        const int row0 = u.pm * BM + wr * 64 + fr, col0 = u.pn * BM + wc * 32 + 4 * fq;
        const float* gp = mod + (size_t)((u.pm * BM) >> 11) * NMOD + goff + col0;
        f32x4 gv[2][2];
#pragma unroll
        for (int bj = 0; bj < 2; ++bj)
#pragma unroll
            for (int n = 0; n < 2; ++n) gv[bj][n] = *(const f32x4*)(gp + bj * HALF + 16 * n);
#pragma unroll
        for (int ai = 0; ai < 2; ++ai)
#pragma unroll
            for (int m = 0; m < 4; ++m) { const size_t ro = (size_t)(row0 + ai * HALF + m * 16) * D_ + col0;
#pragma unroll
                for (int bj = 0; bj < 2; ++bj)
#pragma unroll
                    for (int n = 0; n < 2; ++n) { const f32x4 xv = *(const f32x4*)(X + ro + bj * HALF + 16 * n);
                        *(f32x4*)(O + ro + bj * HALF + 16 * n) = xv + gv[bj][n] * acc[ai][bj][m][n]; } }
    }
};
typedef int v8i_t __attribute__((ext_vector_type(8)));
typedef int v4i_t __attribute__((ext_vector_type(4)));
__device__ __forceinline__ v8i_t cat8(const bf16x8 a, const bf16x8 b) { const v4i_t x = __builtin_bit_cast(v4i_t, a), y = __builtin_bit_cast(v4i_t, b); v8i_t r; r[0] = x[0]; r[1] = x[1]; r[2] = x[2]; r[3] = x[3]; r[4] = y[0]; r[5] = y[1]; r[6] = y[2]; r[7] = y[3]; return r; }
template <class Epi, class Sched, bool ALIGN_EPI = false, bool SP2 = false, bool FP8 = false>
__device__ __forceinline__ void gemm_phase(PG8_LAS unsigned char* lds, const Gemm g, const Sched& S, const Epi& E, const int swid) {
    const int tid = get_tid(swid), wid = __builtin_amdgcn_readfirstlane(tid >> 6), lane = tid & 63, wr = wid >> 2, wc = wid & 3, fr = lane & 15, fq = lane >> 4;
    const int K = g.K, nt = FP8 ? K / (2 * BK) : K / BK, EB = FP8 ? 1 : 2;
    unsigned voffA[2], voffB[2];
#pragma unroll
    for (int i = 0; i < 2; ++i) { int R, C; stage_rc(tid * 16 + i * 8192, R, C); const int Rb = Epi::PERM ? ((R & ~31) + perm32(R & 31)) : R;
        voffA[i] = (unsigned)(R * K * EB + C * 2); voffB[i] = (unsigned)(Rb * K * EB + C * 2); }
    const size_t kstep = (size_t)(BK * 2);
    const size_t hstep = (size_t)HALF * K * EB;
    const size_t tstep = 2 * hstep;
    const unsigned ldsw = (unsigned)wid * 1024u;
    const int aoff = lds_byte(wr * 64 + fr, fq * 8), boff = lds_byte(wc * 32 + fr, fq * 8);
#define PG8_SA(b, h) (((b) * 2 + (h)) * HTB)
#define PG8_SB(b, h) ((4 + (b) * 2 + (h)) * HTB)
#define PG8_STAGE(bufoff, gbase, voff) do { _Pragma("unroll") for (int _i = 0; _i < 2; ++_i) { unsigned _vo = (voff)[_i]; asm volatile("" : "+v"(_vo));     \
        __builtin_amdgcn_global_load_lds((const unsigned*)((const char*)(gbase) + _vo), (PG8_LAS unsigned*)(lds + (bufoff) + ldsw + _i * 8192), 16, 0, 0); } } while (0)
#define PG8_LDA(dst, b, h) do { _Pragma("unroll") for (int m = 0; m < 4; ++m) { \
        if constexpr (FP8) { dst##8[m] = cat8(*(const PG8_LAS bf16x8*)(lds + PG8_SA(b, h) + aoff + m * 2048), *(const PG8_LAS bf16x8*)(lds + PG8_SA(b, h) + aoff + m * 2048 + 1024)); } \
        else { _Pragma("unroll") for (int k = 0; k < 2; ++k) dst[m][k] = *(const PG8_LAS bf16x8*)(lds + PG8_SA(b, h) + aoff + m * 2048 + k * 1024); } } } while (0)
#define PG8_LDB(dst, b, h) do { _Pragma("unroll") for (int n = 0; n < 2; ++n) { \
        if constexpr (FP8) { dst##8[n] = cat8(*(const PG8_LAS bf16x8*)(lds + PG8_SB(b, h) + boff + n * 2048), *(const PG8_LAS bf16x8*)(lds + PG8_SB(b, h) + boff + n * 2048 + 1024)); } \
        else { _Pragma("unroll") for (int k = 0; k < 2; ++k) dst[n][k] = *(const PG8_LAS bf16x8*)(lds + PG8_SB(b, h) + boff + n * 2048 + k * 1024); } } } while (0)
#define PG8_MMA(ai, bj, At, Bt) do { __builtin_amdgcn_s_setprio(1); _Pragma("unroll") for (int m = 0; m < 4; ++m) _Pragma("unroll") for (int n = 0; n < 2; ++n) { \
        if constexpr (FP8) { acc[ai][bj][m][n] = __builtin_amdgcn_mfma_scale_f32_16x16x128_f8f6f4(Bt##8[n], At##8[m], acc[ai][bj][m][n], 0, 0, 0, 0x7f7f7f7f, 0, 0x7f7f7f7f); } \
        else { _Pragma("unroll") for (int k = 0; k < 2; ++k) acc[ai][bj][m][n] = __builtin_amdgcn_mfma_f32_16x16x32_bf16(Bt[n][k], At[m][k], acc[ai][bj][m][n], 0, 0, 0); } } \
        __builtin_amdgcn_s_setprio(0); } while (0)
#define PG8_WAIT_V(n) asm volatile("s_waitcnt vmcnt(" #n ")" ::: "memory")
#define PG8_WAIT_L(n) asm volatile("s_waitcnt lgkmcnt(" #n ")" ::: "memory")
#define PG8_BAR __builtin_amdgcn_s_barrier()
#define PG8_SCHED __builtin_amdgcn_sched_barrier(0)
    Unit cur, nxt; int ui = 0;
    if (!S.next(0, cur)) return;
    f32x4 acc[2][2][4][2];
#pragma unroll
    for (int a = 0; a < 2; ++a)
#pragma unroll
        for (int b = 0; b < 2; ++b)
#pragma unroll
            for (int m = 0; m < 4; ++m)
#pragma unroll
                for (int n = 0; n < 2; ++n) acc[a][b][m][n] = (f32x4){0.f, 0.f, 0.f, 0.f};
    bf16x8 At[4][2], B0[2][2], B1[2][2];
    v8i_t At8[4], B08[2], B18[2];
    const char* cA = (const char*)g.A + (size_t)cur.pm * tstep; const char* cB = (const char*)g.Bt + (size_t)cur.pn * tstep;
    S.a_ready(cur);
    if constexpr (SP2) {
        PG8_STAGE(PG8_SB(0, 0), cB, voffB); PG8_STAGE(PG8_SB(0, 1), cB + hstep, voffB); PG8_STAGE(PG8_SA(0, 0), cA, voffA); PG8_STAGE(PG8_SA(0, 1), cA + hstep, voffA);
        if (wr == 1) PG8_BAR;
        PG8_WAIT_V(2); PG8_BAR;
        PG8_STAGE(PG8_SB(1, 0), cB + kstep, voffB); PG8_STAGE(PG8_SA(1, 0), cA + kstep, voffA); PG8_STAGE(PG8_SB(1, 1), cB + hstep + kstep, voffB);
        PG8_WAIT_V(6); PG8_BAR;
    } else {
        PG8_STAGE(PG8_SB(0, 0), cB, voffB); PG8_STAGE(PG8_SA(0, 0), cA, voffA); PG8_STAGE(PG8_SB(0, 1), cB + hstep, voffB); PG8_STAGE(PG8_SA(0, 1), cA + hstep, voffA);
        if (wr == 1) PG8_BAR;
        PG8_WAIT_V(4); PG8_BAR;
        PG8_STAGE(PG8_SB(1, 0), cB + kstep, voffB); PG8_STAGE(PG8_SA(1, 0), cA + kstep, voffA); PG8_STAGE(PG8_SB(1, 1), cB + hstep + kstep, voffB);
        PG8_WAIT_V(6); PG8_BAR;
    }
    for (;;) {
        const bool has_next = S.next(ui + 1, nxt);
        const char* nA = has_next ? (const char*)g.A + (size_t)nxt.pm * tstep : cA; const char* nB = has_next ? (const char*)g.Bt + (size_t)nxt.pn * tstep : cB;
        for (int t = 0; t < nt; t += 2) {
            const bool last = (t == nt - 2);
            const char* a1 = cA + (size_t)(t + 1) * kstep;
            const char* a2 = last ? nA : cA + (size_t)(t + 2) * kstep; const char* b2 = last ? nB : cB + (size_t)(t + 2) * kstep;
            const char* a3 = a2 + kstep; const char* b3 = b2 + kstep;
            if (last && has_next) S.a_ready(nxt);
            if constexpr (SP2) {
            PG8_LDB(B0, 0, 0); PG8_LDB(B1, 0, 1); PG8_SCHED; PG8_LDA(At, 0, 0); PG8_STAGE(PG8_SA(1, 1), a1 + hstep, voffA);
            PG8_WAIT_V(8); PG8_WAIT_L(0); PG8_BAR; PG8_MMA(0, 0, At, B0); PG8_MMA(0, 1, At, B1); PG8_BAR; PG8_SCHED;
            PG8_LDA(At, 0, 1); PG8_STAGE(PG8_SB(0, 0), b2, voffB); PG8_STAGE(PG8_SB(0, 1), b2 + hstep, voffB); PG8_STAGE(PG8_SA(0, 0), a2, voffA);
            PG8_WAIT_V(8); PG8_WAIT_L(0); PG8_BAR; PG8_MMA(1, 0, At, B0); PG8_MMA(1, 1, At, B1); PG8_BAR; PG8_SCHED;
            PG8_LDB(B0, 1, 0); PG8_LDB(B1, 1, 1); PG8_SCHED; PG8_LDA(At, 1, 0); PG8_STAGE(PG8_SA(0, 1), a2 + hstep, voffA);
            PG8_WAIT_V(8); PG8_WAIT_L(0); PG8_BAR; PG8_MMA(0, 0, At, B0); PG8_MMA(0, 1, At, B1); PG8_BAR; PG8_SCHED;
            PG8_LDA(At, 1, 1); PG8_STAGE(PG8_SB(1, 0), b3, voffB); PG8_STAGE(PG8_SB(1, 1), b3 + hstep, voffB); PG8_STAGE(PG8_SA(1, 0), a3, voffA);
            PG8_WAIT_V(8); PG8_WAIT_L(0); PG8_BAR; PG8_MMA(1, 0, At, B0); PG8_MMA(1, 1, At, B1); PG8_BAR; PG8_SCHED;
            } else {
            PG8_LDB(B0, 0, 0); PG8_SCHED; PG8_LDA(At, 0, 0); PG8_STAGE(PG8_SA(1, 1), a1 + hstep, voffA);
            PG8_WAIT_L(8); PG8_BAR; PG8_WAIT_L(0); PG8_MMA(0, 0, At, B0); PG8_BAR; PG8_SCHED;
            PG8_LDB(B1, 0, 1); PG8_STAGE(PG8_SB(0, 0), b2, voffB);
            PG8_BAR; PG8_WAIT_L(0); PG8_MMA(0, 1, At, B1); PG8_BAR;
            PG8_LDA(At, 0, 1); PG8_STAGE(PG8_SA(0, 0), a2, voffA);
            PG8_BAR; PG8_WAIT_L(0); PG8_MMA(1, 0, At, B0); PG8_BAR; PG8_SCHED;
            PG8_STAGE(PG8_SB(0, 1), b2 + hstep, voffB);
            PG8_WAIT_V(6); PG8_BAR; PG8_MMA(1, 1, At, B1); PG8_BAR;
            PG8_LDB(B0, 1, 0); PG8_SCHED; PG8_LDA(At, 1, 0); PG8_STAGE(PG8_SA(0, 1), a2 + hstep, voffA);
            PG8_WAIT_L(8); PG8_BAR; PG8_WAIT_L(0); PG8_MMA(0, 0, At, B0); PG8_BAR; PG8_SCHED;
            PG8_LDB(B1, 1, 1); PG8_STAGE(PG8_SB(1, 0), b3, voffB);
            PG8_BAR; PG8_WAIT_L(0); PG8_MMA(0, 1, At, B1); PG8_BAR;
            PG8_LDA(At, 1, 1); PG8_STAGE(PG8_SA(1, 0), a3, voffA);
            PG8_BAR; PG8_WAIT_L(0); PG8_MMA(1, 0, At, B0); PG8_BAR; PG8_SCHED;
            PG8_STAGE(PG8_SB(1, 1), b3 + hstep, voffB);
            PG8_WAIT_V(6); PG8_BAR; PG8_MMA(1, 1, At, B1); PG8_BAR;
            }
        }
        if constexpr (ALIGN_EPI) { if (wr == 0) PG8_BAR; }
        if constexpr (!Epi::AFTER_DRAIN) { int frl = fr, fql = fq; asm volatile("" : "+v"(frl), "+v"(fql));
            E(acc, cur, wr, wc, frl, fql); S.done(cur); }
        if (!has_next) break;
#pragma unroll
        for (int a = 0; a < 2; ++a)
#pragma unroll
            for (int b = 0; b < 2; ++b)
#pragma unroll
                for (int m = 0; m < 4; ++m)
#pragma unroll
                    for (int n = 0; n < 2; ++n) acc[a][b][m][n] = (f32x4){0.f, 0.f, 0.f, 0.f};
        cur = nxt; cA = nA; cB = nB; ++ui;
        if constexpr (ALIGN_EPI) { if (wr == 1) PG8_BAR; }
    }
    PG8_WAIT_V(0);
    if constexpr (!ALIGN_EPI) { if (wr == 0) PG8_BAR; }
    PG8_BAR;
    if constexpr (Epi::AFTER_DRAIN) { E.fused(acc, cur, wr, wc, fr, fq, lds, wid, lane); S.done(cur); }
#undef PG8_SA
#undef PG8_SB
#undef PG8_STAGE
#undef PG8_LDA
#undef PG8_LDB
#undef PG8_MMA
#undef PG8_WAIT_V
#undef PG8_WAIT_L
#undef PG8_BAR
#undef PG8_SCHED
}
}
#define XB_TMO      128
#define XB_XCNT(j)  (256  + 64 * (j))
#define XB_XSUB(j)  (1280 + 64 * (j))
#define XB_XGEN(j)  (2304 + 64 * (j))
#define XB_TOP      3328
#define XB_TOPGEN   3392
#define XCD_BAR_WORDS 3456
#define XB_SPIN_CAP (1u << 18)

__device__ __forceinline__ unsigned xb_ld(unsigned* p)              { return __hip_atomic_load(p, __ATOMIC_RELAXED, __HIP_MEMORY_SCOPE_AGENT); }
__device__ __forceinline__ unsigned xb_add(unsigned* p, unsigned v) { return __hip_atomic_fetch_add(p, v, __ATOMIC_RELAXED, __HIP_MEMORY_SCOPE_AGENT); }
__device__ __forceinline__ unsigned xb_xcc_id() { return (unsigned)__builtin_amdgcn_s_getreg((3 << 11) | 20) & 0xFu; }
#define XB_SPIN(cond, bar) do { unsigned _sp = 0; while (cond) { __builtin_amdgcn_s_sleep(1); \
    if ((++_sp & 255u) == 0u) { if (xb_ld(&(bar)[XB_TMO])) break; if (_sp > XB_SPIN_CAP) { atomicAdd(&(bar)[XB_TMO], 1u); break; } } } } while (0)

struct XcdBarrier {
    unsigned* bar; unsigned x;
    volatile LAS unsigned* st;
};

__device__ __forceinline__ XcdBarrier xcd_barrier_post(unsigned* bar, volatile LAS unsigned* st, int swid) {
    XcdBarrier b; b.bar = bar; b.x = xb_xcc_id(); b.st = st;
    if (get_tid(swid) == 0) (void)xb_add(&bar[XB_XCNT(b.x)], 1u);
    return b;
}
__device__ __forceinline__ void xcd_barrier_complete(unsigned* bar, unsigned x, unsigned& nloc, unsigned& nx) {
    const unsigned G = gridDim.x * gridDim.y * gridDim.z;
    unsigned sum, cnt, mine, sp = 0u;
    for (;;) {
        sum = 0u; cnt = 0u; mine = 0u;
#pragma unroll
        for (unsigned j = 0; j < 16; ++j) { const unsigned c = xb_ld(&bar[XB_XCNT(j)]); sum += c; cnt += (c > 0u) ? 1u : 0u; mine = (j == x) ? c : mine; }
        if (sum == G) break;
        __builtin_amdgcn_s_sleep(1);
        if ((++sp & 255u) == 0u) { if (xb_ld(&bar[XB_TMO])) break; if (sp > XB_SPIN_CAP) { atomicAdd(&bar[XB_TMO], 1u); break; } }
    }
    nloc = mine > 0u ? mine : 1u; nx = cnt > 0u ? cnt : 1u;
}

__device__ __forceinline__ void xcd_barrier(const XcdBarrier& b, int swid) {
    asm volatile("s_waitcnt vmcnt(0)" ::: "memory");
    __syncthreads();
    if (get_tid(swid) == 0) {
        unsigned* bar = b.bar;
        __builtin_amdgcn_s_waitcnt(0);
        unsigned nloc = b.st[0], nx = b.st[1];
        if (nloc == 0u) { xcd_barrier_complete(bar, b.x, nloc, nx); b.st[0] = nloc; b.st[1] = nx; }
        const unsigned old = xb_add(&bar[XB_XSUB(b.x)], 1u);
        const unsigned gen = old / nloc;
        if (old + 1u == (gen + 1u) * nloc) {
            __builtin_amdgcn_fence(__ATOMIC_RELEASE, "agent");
            asm volatile("s_waitcnt vmcnt(0)" ::: "memory");
            const unsigned og = xb_add(&bar[XB_TOP], 1u);
            const unsigned tg = og / nx;
            if (og + 1u == (tg + 1u) * nx) xb_add(&bar[XB_TOPGEN], 1u);
            else XB_SPIN(xb_ld(&bar[XB_TOPGEN]) == tg, bar);
            __builtin_amdgcn_fence(__ATOMIC_ACQUIRE, "agent");
            xb_add(&bar[XB_XGEN(b.x)], 1u);
            asm volatile("s_waitcnt vmcnt(0)" ::: "memory");
        } else {
            XB_SPIN(xb_ld(&bar[XB_XGEN(b.x)]) == gen, bar);
            __builtin_amdgcn_fence(__ATOMIC_ACQUIRE, "agent");
            asm volatile("s_waitcnt vmcnt(0)" ::: "memory");
        }
    }
    __syncthreads();
}
__device__ __forceinline__ void phase_prep(const Params& p, unsigned char* lds, int bid, int nb) {
    const int tid = get_tid(p.swid), lane = tid & 63, wave = tid >> 6;
    unsigned char* ws = p.ws;
    float* mod = (float*)(ws + WS_MOD);
    if (bid < 192) {
        float* sc = (float*)lds;
        float* red = sc + 8 * 2048;
        for (int i = tid; i < 8 * 2048; i += NTHR) sc[i] = silu_f(p.c[i]);
        __syncthreads();
        for (int it = bid; it < 192; it += nb) {
            const int col = it * 64 + lane;
            float acc[8];
#pragma unroll
            for (int b = 0; b < 8; ++b) acc[b] = 0.f;
            const float* w = p.w_ada + (size_t)(wave * 256) * NMOD + col;
            const float* s0 = sc + wave * 256;
#pragma unroll 16
            for (int k = 0; k < 256; ++k) {
                const float wv = __builtin_nontemporal_load(w + (size_t)k * NMOD);
#pragma unroll
                for (int b = 0; b < 8; ++b) acc[b] += s0[b * 2048 + k] * wv;
            }
#pragma unroll
            for (int b = 0; b < 8; ++b) red[(wave * 8 + b) * 64 + lane] = acc[b];
            __syncthreads();
            {   const int b = wave; float s = p.b_ada[col];
#pragma unroll
                for (int w2 = 0; w2 < 8; ++w2) s += red[(w2 * 8 + b) * 64 + lane];
                mod[b * NMOD + col] = s; }
            __syncthreads();
        }
    }
    __syncthreads();
    {
        float* tile = (float*)lds;
        bf16_t* WinT = (bf16_t*)(ws + WS_WINT); bf16_t* WoT = (bf16_t*)(ws + WS_WOT); bf16_t* WqT = (bf16_t*)(ws + WS_WQT);
        for (int item = bid; item < 5632; item += nb) {
            const float* src; int ld, scol; bf16_t* dst; int kt;
            if (item < 3584) { const int seg = item >> 9, rem = item & 511, ntile = rem >> 5; kt = rem & 31;
                src = p.w_in; ld = INCOLS; scol = (seg < 3 ? seg * 1024 : 3080 + (seg - 3) * 1024) + ntile * 64; dst = WinT + (size_t)(seg * 1024 + ntile * 64) * 1024; }
            else if (item < 4608) { const int rem = item - 3584, ntile = rem >> 5; kt = rem & 31; src = p.w_out; ld = 2048; scol = ntile * 64; dst = WoT + (size_t)(ntile * 64) * 2048; }
            else { const int rem = item - 4608, ntile = rem >> 5; kt = rem & 31; src = p.w_q; ld = 2048; scol = ntile * 64; dst = WqT + (size_t)(ntile * 64) * 2048; }
            const int k0 = kt * 64;
#pragma unroll
            for (int ii = 0; ii < 8; ++ii) { const int k = wave + 8 * ii; tile[k * 65 + lane] = src[(size_t)(k0 + k) * ld + scol + lane]; }
            __syncthreads();
            if (item < 3584) {
#pragma unroll
                for (int ii = 0; ii < 2; ++ii) { const int n = (tid >> 4) + 32 * ii, k4 = (tid & 15) * 4;
                    f32x4 v; v[0] = tile[k4 * 65 + n] * 64.f; v[1] = tile[(k4 + 1) * 65 + n] * 64.f; v[2] = tile[(k4 + 2) * 65 + n] * 64.f; v[3] = tile[(k4 + 3) * 65 + n] * 64.f;
                    *(unsigned*)((unsigned char*)dst + (size_t)n * 2048 + k0 + k4) = pack4_fp8(v); }
            } else {
#pragma unroll
            for (int ii = 0; ii < 8; ++ii) { const int n = wave + 8 * ii; dst[(size_t)n * 2048 + k0 + lane] = (bf16_t)(cvt_pk(tile[lane * 65 + n], 0.f) & 0xffffu); }
            }
            __syncthreads();
        }
    }
    {
        bf16_t* Wg = (bf16_t*)(ws + WS_WG);
        for (int i = bid * NTHR + tid; i < 16 * 2048; i += nb * NTHR) { const int g = i >> 11, k = i & 2047; const int col = g < 8 ? 3072 + g : 7176 + (g - 8);
            Wg[i] = (bf16_t)(cvt_pk(p.w_in[(size_t)k * INCOLS + col], 0.f) & 0xffffu); }
    }
}

__device__ __forceinline__ void convert_experts(const Params& p, int bid, int nb) {
    const int tid = get_tid(p.swid); unsigned char* ws = p.ws;
    unsigned char* E8D = ws + WS_E8D; unsigned char* E8US = ws + WS_E8U;
    {
        const int lane = tid & 63, wave = tid >> 6; float* DSC = (float*)(ws + WS_DSC);
        for (int e = bid * 8 + wave; e < 16384; e += nb * 8) {
            const float* rp = p.e_down + (size_t)e * 2048;
            f32x4 v[8]; float mx = 0.f;
#pragma unroll
            for (int hf = 0; hf < 2; ++hf)
#pragma unroll
                for (int q = 0; q < 4; ++q) { v[hf * 4 + q] = *(const f32x4*)(rp + hf * 1024 + 16 * lane + 4 * q);
#pragma unroll
                    for (int c = 0; c < 4; ++c) mx = fmaxf(mx, fabsf(v[hf * 4 + q][c])); }
            mx = fmaxf(wmax(mx), 1e-30f);
            const float inv = 127.f / mx;
            if (lane == 0) DSC[e] = mx * (1.f / 127.f);
#pragma unroll
            for (int hf = 0; hf < 2; ++hf) { u32x4 o;
#pragma unroll
                for (int q = 0; q < 4; ++q) { unsigned w = 0u;
#pragma unroll
                    for (int c = 0; c < 4; ++c) w |= ((unsigned)__float2int_rn(v[hf * 4 + q][c] * inv) & 0xffu) << (8 * c);
                    o[q] = w; }
                *(u32x4*)(E8D + (size_t)e * 2048 + hf * 1024 + 16 * lane) = o; }
        }
    }
    for (int i = bid * NTHR + tid; i < 524288; i += nb * NTHR) {
        const int s = i & 255, eg = i >> 8;
        const float* sp = p.e_up + (size_t)(eg * 8) * 2048 + 8 * s;
        unsigned w[16];
#pragma unroll
        for (int q = 0; q < 8; ++q) { const f32x4 a = *(const f32x4*)(sp + (size_t)q * 2048), b = *(const f32x4*)(sp + (size_t)q * 2048 + 4); w[2 * q] = pack4_fp8(a * 32.f); w[2 * q + 1] = pack4_fp8(b * 32.f); }
        u32x4* dp = (u32x4*)(E8US + ((size_t)s * 16384 + eg * 8) * 8);
#pragma unroll
        for (int q = 0; q < 4; ++q) { u32x4 o; o.x = w[4 * q]; o.y = w[4 * q + 1]; o.z = w[4 * q + 2]; o.w = w[4 * q + 3]; dp[q] = o; }
    }
}

template <bool RES>
__device__ __forceinline__ void phase_norm(const float* xin, const bf16_t* yin, int gate_off, const float* gain, const float* mod, int shift_off, int scale_off, bf16_t* hout, unsigned char* h8out, int bid, int nb, int swid) {
    const int tid = get_tid(swid), lane = tid & 63, wave = tid >> 6;
    for (int row = bid * 8 + wave; row < T_; row += nb * 8) {
        const f32x4* xr = (const f32x4*)(xin + (size_t)row * D_);
        f32x4 v[8]; float ss = 0.f;
        const float* mb = mod + (size_t)(row >> 11) * NMOD;
#pragma unroll
        for (int j = 0; j < 8; ++j) { v[j] = xr[lane + 64 * j];
            if (RES) { const int k = 4 * (lane + 64 * j); const u32x2 yw = *(const u32x2*)(yin + (size_t)row * D_ + k); const f32x4 gv = *(const f32x4*)(mb + gate_off + k);
                v[j][0] += gv[0] * bflo(yw.x); v[j][1] += gv[1] * bfhi(yw.x); v[j][2] += gv[2] * bflo(yw.y); v[j][3] += gv[3] * bfhi(yw.y); }
            ss += v[j][0] * v[j][0] + v[j][1] * v[j][1] + v[j][2] * v[j][2] + v[j][3] * v[j][3]; }
        ss = wsum(ss);
        const float r = rsqrtf(ss * (1.f / D_) + EPS_);
        f32x4 hv[8];
#pragma unroll
        for (int j = 0; j < 8; ++j) {
            const int k = 4 * (lane + 64 * j);
            const f32x4 gn = *(const f32x4*)(gain + k), sh = *(const f32x4*)(mb + shift_off + k), scl = *(const f32x4*)(mb + scale_off + k);
#pragma unroll
            for (int e = 0; e < 4; ++e) hv[j][e] = (v[j][e] * r) * gn[e] * (1.f + scl[e]) + sh[e];
            u32x2 w; w.x = cvt_pk(hv[j][0], hv[j][1]); w.y = cvt_pk(hv[j][2], hv[j][3]);
            *(u32x2*)(hout + (size_t)row * D_ + k) = w;
            if (h8out) *(unsigned*)(h8out + (size_t)row * D_ + k) = pack4_fp8(hv[j] * 8.f);
        }
    }
}

__device__ __forceinline__ void phase_gates(const Params& p, unsigned char* lds, int bid, int nb) {
    const int tid = get_tid(p.swid), lane = tid & 63, wave = tid >> 6, r = lane & 31, hh = lane >> 5;
    unsigned char* ws = p.ws;
    const bf16_t* H = (const bf16_t*)(ws + WS_H); const bf16_t* Wg = (const bf16_t*)(ws + WS_WG); float* gate = (float*)(ws + WS_GATE);
    constexpr int WST = 4096 + 16;
    for (int i = tid; i < 16 * 256; i += NTHR) { const int g = i >> 8, c = i & 255; *(u32x4*)(lds + g * WST + c * 16) = *(const u32x4*)(Wg + (size_t)g * 2048 + c * 8); }
    __syncthreads();
    float* part = (float*)(lds + 16 * WST);
    for (int pr = bid; pr < T_ / 64; pr += nb) {
        const int t = pr * 64 + (wave >> 2) * 32 + r, kq = wave & 3;
        f32x16 acc;
#pragma unroll
        for (int i = 0; i < 16; ++i) acc[i] = 0.f;
        const bf16_t* hp = H + (size_t)t * D_ + kq * 512 + hh * 8; const unsigned char* wp = lds + (r & 15) * WST + kq * 1024 + hh * 16;
#pragma unroll 1
        for (int k0 = 0; k0 < 32; k0 += 16) {
            bf16x8 bfr[16];
#pragma unroll
            for (int j = 0; j < 16; ++j) bfr[j] = *(const bf16x8*)(hp + (k0 + j) * 16);
#pragma unroll
            for (int j = 0; j < 16; ++j) { bf16x8 a = *(const bf16x8*)(wp + (k0 + j) * 32); if (r >= 16) a = (bf16x8){0, 0, 0, 0, 0, 0, 0, 0};
                acc = __builtin_amdgcn_mfma_f32_32x32x16_bf16(a, bfr[j], acc, 0, 0, 0); }
        }
        __syncthreads();
#pragma unroll
        for (int i = 0; i < 8; ++i) part[(wave * 8 + i) * 64 + lane] = acc[i];
        __syncthreads();
        if (kq == 0) {
            float s[8];
#pragma unroll
            for (int i = 0; i < 8; ++i) s[i] = part[(wave * 8 + i) * 64 + lane] + part[((wave + 1) * 8 + i) * 64 + lane] + part[((wave + 2) * 8 + i) * 64 + lane] + part[((wave + 3) * 8 + i) * 64 + lane];
            f32x4 g0, g1; g0[0] = s[0]; g0[1] = s[1]; g0[2] = s[2]; g0[3] = s[3]; g1[0] = s[4]; g1[1] = s[5]; g1[2] = s[6]; g1[3] = s[7];
            *(f32x4*)(gate + (size_t)t * 16 + 4 * hh) = g0; *(f32x4*)(gate + (size_t)t * 16 + 8 + 4 * hh) = g1;
        }
    }
    __syncthreads();
}

__device__ __forceinline__ void phase_post(const Params& p, int bid, int nb) {
    const int tid = get_tid(p.swid), lane = tid & 63, wave = tid >> 6;
    unsigned char* ws = p.ws;
    bf16_t* Pq = (bf16_t*)(ws + WS_P); bf16_t* Pk = (bf16_t*)(ws + WS_P + SEG_B);
    const float qscale = 0.08838834764831845f * 1.4426950408889634f;
    {
        const bf16_t* Mq = (const bf16_t*)(ws + WS_P + 3 * SEG_B); const bf16_t* Mk = (const bf16_t*)(ws + WS_P + 4 * SEG_B);
        bf16_t* QC = (bf16_t*)(ws + WS_QC); bf16_t* KC = (bf16_t*)(ws + WS_KC);
        for (int item = bid; item < 256; item += nb) {
            const int which = item >> 7, tb = item & 127, cg = tid & 127, run = tid >> 7, ch0 = cg * 8, ts = tb * 128 + run * 32, sp = ts & 2047;
            const bf16_t* src = (which ? Mk : Mq) + (size_t)ts * 1024 + ch0; bf16_t* dst = (which ? KC : QC) + (size_t)ts * 1024 + ch0;
            float w0[8], w1[8], w2[8], w3[8], cb[8], x0[8], x1[8], x2[8];
#pragma unroll
            for (int e = 0; e < 8; ++e) { const int ci = which * 1024 + ch0 + e; w0[e] = p.conv_w[ci]; w1[e] = p.conv_w[2048 + ci]; w2[e] = p.conv_w[4096 + ci]; w3[e] = p.conv_w[6144 + ci]; cb[e] = p.conv_b[ci]; }
            {   u32x4 a = {0u, 0u, 0u, 0u}, b = a, c = a;
                if (sp != 0) { a = *(const u32x4*)(src - 3 * 1024); b = *(const u32x4*)(src - 2 * 1024); c = *(const u32x4*)(src - 1024); }
#pragma unroll
                for (int e = 0; e < 4; ++e) { x0[2 * e] = bflo(a[e]); x0[2 * e + 1] = bfhi(a[e]); x1[2 * e] = bflo(b[e]); x1[2 * e + 1] = bfhi(b[e]); x2[2 * e] = bflo(c[e]); x2[2 * e + 1] = bfhi(c[e]); } }
            const float osc = which ? 0.0625f : 1.f;
            for (int s = 0; s < 32; ++s) {
                const u32x4 d = *(const u32x4*)(src + (size_t)s * 1024); float x3[8], y[8];
#pragma unroll
                for (int e = 0; e < 4; ++e) { x3[2 * e] = bflo(d[e]); x3[2 * e + 1] = bfhi(d[e]); }
#pragma unroll
                for (int e = 0; e < 8; ++e) { y[e] = silu_f(w0[e] * x0[e] + w1[e] * x1[e] + w2[e] * x2[e] + w3[e] * x3[e] + cb[e]) * osc; x0[e] = x1[e]; x1[e] = x2[e]; x2[e] = x3[e]; }
                u32x4 o; o.x = cvt_pk(y[0], y[1]); o.y = cvt_pk(y[2], y[3]); o.z = cvt_pk(y[4], y[5]); o.w = cvt_pk(y[6], y[7]);
                *(u32x4*)(dst + (size_t)s * 1024) = o;
            }
        }
    }
    const float* gate = (const float*)(ws + WS_GATE); float* F = (float*)(ws + WS_F);
    for (int sq = bid * 8 + wave; sq < 64; sq += nb * 8) {
        const int b = sq >> 3, h = sq & 7; const float fb = p.fox_fb[h];
        float v[32]; float run = 0.f;
#pragma unroll
        for (int i = 0; i < 32; ++i) { const int t = lane * 32 + i; run += logsig(gate[(size_t)(b * S_ + t) * 16 + h] + fb); v[i] = run; }
        float inc = run;
#pragma unroll
        for (int o = 1; o < 64; o <<= 1) { const float u = __shfl_up(inc, o); if (lane >= o) inc += u; }
        const float excl = inc - run;
#pragma unroll
        for (int i = 0; i < 32; ++i) F[(size_t)sq * S_ + lane * 32 + i] = (v[i] + excl) * 1.4426950408889634f;
    }
}
typedef short s16x4 __attribute__((ext_vector_type(4)));
__device__ __forceinline__ s16x4 lds_tr16(const unsigned char* p) { return __builtin_amdgcn_ds_read_tr16_b64_v4i16((LAS s16x4*)p); }
__device__ __forceinline__ bf16x8 tr_frag(const unsigned char* p0, int second_bytes) {
    const s16x4 a = lds_tr16(p0), b = lds_tr16(p0 + second_bytes);
    bf16x8 f; f[0] = a[0]; f[1] = a[1]; f[2] = a[2]; f[3] = a[3]; f[4] = b[0]; f[5] = b[1]; f[6] = b[2]; f[7] = b[3]; return f;
}
__device__ __forceinline__ unsigned split_bf16(float v, float& eff) { const unsigned hi = cvt_pk(v, 0.f) & 0xffffu; const float hf = bf2f((bf16_t)hi); const unsigned lo = cvt_pk(v - hf, 0.f) & 0xffffu; eff = hf + bf2f((bf16_t)lo); return hi | (lo << 16); }
__device__ __forceinline__ void fox_unit(const Params& p, unsigned char* lds, int b, int h, int qb) {
    const int tid = get_tid(p.swid), lane = tid & 63, wave = tid >> 6, r = lane & 31, hh = lane >> 5, li = lane & 15;
    unsigned char* ws = p.ws;
    const bf16_t* Pq = (const bf16_t*)(ws + WS_P); const bf16_t* Pk = (const bf16_t*)(ws + WS_P + SEG_B); const bf16_t* Pv = (const bf16_t*)(ws + WS_P + 2 * SEG_B);
    const float* F = (const float*)(ws + WS_F) + (size_t)(b * 8 + h) * S_;
    bf16_t* Oc = (bf16_t*)(ws + WS_H);
    constexpr int KST = 272, VST = 544, BUF = 64 * KST + 64 * VST;
    constexpr float THR = 8.f;
    const int q0w = qb * 256 + wave * 32, qs = q0w + r; const int q0s = __builtin_amdgcn_readfirstlane(q0w);
    const size_t trow = (size_t)(b * S_ + qs);
    bf16x8 qf[8];
#pragma unroll
    for (int ks = 0; ks < 8; ++ks) qf[ks] = *(const bf16x8*)(Pq + trow * 1024 + h * 128 + ks * 16 + hh * 8);
    float feff; const unsigned fq2 = split_bf16(F[qs], feff);
    float m = 0.f;
    u32x4 qa; qa.x = hh ? 0u : fq2; qa.y = 0u; qa.z = hh ? 0u : 0x3f803f80u; qa.w = 0u;
    f32x16 o[4];
#pragma unroll
    for (int d = 0; d < 4; ++d)
#pragma unroll
        for (int i = 0; i < 16; ++i) o[d][i] = 0.f;
    float l = 0.f;
    const int ntile = (qb * 256 + 256) / 64;
    const int srow0 = tid >> 4, scc = tid & 15;
    const bf16_t* kg = Pk + (size_t)(b * S_ + srow0) * 1024 + h * 128 + scc * 8; const bf16_t* vg = Pv + (size_t)(b * S_ + srow0) * 1024 + h * 128 + scc * 8;
    u32x4 kr[2], vr[2]; float fr = 0.f;
    const int vb_off = 64 * KST + (4 * hh + (li >> 2)) * VST + (16 * (r >> 4) + 4 * (li & 3)) * 2;
#define FOX_AUG(dst, fval) do { float e_; const unsigned s2_ = split_bf16(-(fval), e_); u32x4 w_; w_.x = 0x3f803f80u; w_.y = 0x3f803f80u; w_.z = s2_; w_.w = 0u; *(u32x4*)(dst) = w_; } while (0)
    __syncthreads();
#pragma unroll
    for (int i = 0; i < 2; ++i) { kr[i] = *(const u32x4*)(kg + (size_t)(32 * i) * 1024); vr[i] = *(const u32x4*)(vg + (size_t)(32 * i) * 1024); }
    if (tid < 64) fr = F[tid];
#pragma unroll
    for (int i = 0; i < 2; ++i) { *(u32x4*)(lds + (srow0 + 32 * i) * KST + scc * 16) = kr[i]; *(u32x4*)(lds + 64 * KST + (srow0 + 32 * i) * VST + scc * 16) = vr[i]; }
    if (tid < 64) FOX_AUG(lds + tid * KST + 256, fr);
    __syncthreads();
    for (int kt = 0; kt < ntile; ++kt) {
        const int k0 = kt * 64; unsigned char* cur = lds + (kt & 1) * BUF; unsigned char* nxt = lds + ((kt & 1) ^ 1) * BUF;
        const bool more = kt + 1 < ntile;
        if (more) {
#pragma unroll
            for (int i = 0; i < 2; ++i) { kr[i] = *(const u32x4*)(kg + (size_t)(k0 + 64 + 32 * i) * 1024); vr[i] = *(const u32x4*)(vg + (size_t)(k0 + 64 + 32 * i) * 1024); }
            if (tid < 64) fr = F[k0 + 64 + tid];
        }
        if (k0 <= q0s + 31) {
            f32x16 s[2];
            const bf16x8 qaf = __builtin_bit_cast(bf16x8, qa);
#pragma unroll
            for (int kb = 0; kb < 2; ++kb) {
#pragma unroll
                for (int i = 0; i < 16; ++i) s[kb][i] = 0.f;
#pragma unroll
                for (int ks = 0; ks < 8; ++ks) { const bf16x8 a = *(const bf16x8*)(cur + (kb * 32 + r) * KST + ks * 32 + hh * 16);
                    s[kb] = __builtin_amdgcn_mfma_f32_32x32x16_bf16(a, qf[ks], s[kb], 0, 0, 0); }
                {   const bf16x8 a = *(const bf16x8*)(cur + (kb * 32 + r) * KST + 256);
                    s[kb] = __builtin_amdgcn_mfma_f32_32x32x16_bf16(a, qaf, s[kb], 0, 0, 0); }
            }
            if (k0 + 63 > q0s) {
                const int lim = qs - k0;
#pragma unroll
                for (int kb = 0; kb < 2; ++kb)
#pragma unroll
                    for (int i = 0; i < 16; ++i) s[kb][i] = (kb * 32 + (i & 3) + 8 * (i >> 2) + 4 * hh > lim) ? -INFINITY : s[kb][i];
            }
            float mx = fmaxf(s[0][0], s[1][0]);
#pragma unroll
            for (int i = 1; i < 16; ++i) mx = fmaxf(mx, fmaxf(s[0][i], s[1][i]));
            mx = fmaxf(mx, __shfl_xor(mx, 32));
            if (__builtin_amdgcn_ballot_w64(mx > THR) != 0ull) {
                const float mnew_f = m + fmaxf(mx, 0.f); float meff; const unsigned m2 = split_bf16(-mnew_f, meff); meff = -meff;
                const float delta = meff - m, alpha = __builtin_amdgcn_exp2f(-delta);
                m = meff; if (!hh) qa.y = m2;
                l *= alpha;
#pragma unroll
                for (int d = 0; d < 4; ++d)
#pragma unroll
                    for (int i = 0; i < 16; ++i) o[d][i] *= alpha;
#pragma unroll
                for (int kb = 0; kb < 2; ++kb)
#pragma unroll
                    for (int i = 0; i < 16; ++i) s[kb][i] -= delta;
            }
            float ps = 0.f;
#pragma unroll
            for (int kb = 0; kb < 2; ++kb)
#pragma unroll
                for (int i = 0; i < 16; ++i) { const float pv = __builtin_amdgcn_exp2f(s[kb][i]); s[kb][i] = pv; ps += pv; }
            l += ps;
#pragma unroll
            for (int kb = 0; kb < 2; ++kb)
#pragma unroll
                for (int st = 0; st < 2; ++st) {
                    u32x4 pw; pw.x = cvt_pk(s[kb][8 * st + 0], s[kb][8 * st + 1]); pw.y = cvt_pk(s[kb][8 * st + 2], s[kb][8 * st + 3]);
                    pw.z = cvt_pk(s[kb][8 * st + 4], s[kb][8 * st + 5]); pw.w = cvt_pk(s[kb][8 * st + 6], s[kb][8 * st + 7]);
                    const bf16x8 pf = __builtin_bit_cast(bf16x8, pw);
#pragma unroll
                    for (int d = 0; d < 4; ++d) { const bf16x8 vf = tr_frag(cur + vb_off + (kb * 32 + st * 16) * VST + d * 64, 8 * VST);
                        o[d] = __builtin_amdgcn_mfma_f32_32x32x16_bf16(vf, pf, o[d], 0, 0, 0); }
                }
        }
        if (more) {
#pragma unroll
            for (int i = 0; i < 2; ++i) { *(u32x4*)(nxt + (srow0 + 32 * i) * KST + scc * 16) = kr[i]; *(u32x4*)(nxt + 64 * KST + (srow0 + 32 * i) * VST + scc * 16) = vr[i]; }
            if (tid < 64) FOX_AUG(nxt + tid * KST + 256, fr);
        }
        lds_barrier();
    }
#undef FOX_AUG
    l += __shfl_xor(l, 32);
    const float inv = 1.f / l;
#pragma unroll
    for (int d = 0; d < 4; ++d)
#pragma unroll
        for (int g = 0; g < 4; ++g) { u32x2 w; w.x = cvt_pk(o[d][4 * g] * inv, o[d][4 * g + 1] * inv); w.y = cvt_pk(o[d][4 * g + 2] * inv, o[d][4 * g + 3] * inv);
            *(u32x2*)(Oc + trow * D_ + h * 128 + d * 32 + 8 * g + 4 * hh) = w; }
}

__device__ __forceinline__ void mlstm_passA(const Params& p, unsigned char* lds, int unit) {
    const int tid = get_tid(p.swid), lane = tid & 63, wave = tid >> 6, r = lane & 31, hh = lane >> 5, li = lane & 15;
    const int b = unit >> 3, h = (unit >> 1) & 3, eh = unit & 1;
    unsigned char* ws = p.ws;
    const bf16_t* KC = (const bf16_t*)(ws + WS_KC); const bf16_t* Mv = (const bf16_t*)(ws + WS_P + 5 * SEG_B);
    const float* gate = (const float*)(ws + WS_GATE);
    bf16_t* Cst = (bf16_t*)(ws + WS_CST); float* nst = (float*)(ws + WS_NST); float* mst = (float*)(ws + WS_MST);
    constexpr int KST = 528, VST = 272;
    unsigned char* ksm = lds;
    unsigned char* vsm = ksm + 64 * KST;
    float* WSV = (float*)(vsm + 64 * VST);
    float* SCL = WSV + 2048;
    constexpr int STGS = 528;
    unsigned char* stg = (unsigned char*)(SCL + 128);
    __syncthreads();
    for (int cc = wave; cc < 32; cc += 8) {
        const int t = b * S_ + cc * 64 + lane;
        const float ipre = gate[(size_t)t * 16 + 8 + h] + p.m_ib[h], fpre = gate[(size_t)t * 16 + 12 + h] + p.m_fb[h];
        float bc = logsig(fpre);
#pragma unroll
        for (int o = 1; o < 64; o <<= 1) { const float u = __shfl_up(bc, o); if (lane >= o) bc += u; }
        const float a = ipre - bc; const float amax = wmax(a); const float bL = __shfl(bc, 63);
        WSV[cc * 64 + lane] = a; if (lane == 0) { SCL[cc] = bL; SCL[32 + cc] = amax; }
    }
    __syncthreads();
    if (tid == 0) { float m = 0.f; for (int cc = 0; cc < 32; ++cc) { const float mn = SCL[cc] + fmaxf(m, SCL[32 + cc]); SCL[64 + cc] = expf(SCL[cc] + m - mn); SCL[96 + cc] = mn; if (eh == 0) mst[(b * 4 + h) * 32 + cc] = m; m = mn; } }
    __syncthreads();
    for (int i = tid; i < 2048; i += NTHR) { const int cc = i >> 6; WSV[i] = expf(SCL[cc] + WSV[i] - SCL[96 + cc]); }
    f32x16 acc[4];
#pragma unroll
    for (int et = 0; et < 4; ++et)
#pragma unroll
        for (int i = 0; i < 16; ++i) acc[et][i] = 0.f;
    f32x16 accn;
#pragma unroll
    for (int i = 0; i < 16; ++i) accn[i] = 0.f;
    const int kb_off = (8 * hh + (li >> 2)) * KST + (wave * 32 + 16 * (r >> 4) + 4 * (li & 3)) * 2;
    const int vb_off = (8 * hh + (li >> 2)) * VST + (16 * (r >> 4) + 4 * (li & 3)) * 2;
    u32x4 pk[4], pv[2];
#pragma unroll
    for (int i = 0; i < 4; ++i) { const int c = tid + NTHR * i, row = c >> 5, c16 = c & 31; pk[i] = *(const u32x4*)(KC + (size_t)(b * S_ + row) * 1024 + h * 256 + c16 * 8); }
#pragma unroll
    for (int i = 0; i < 2; ++i) { const int c = tid + NTHR * i, row = c >> 4, c16 = c & 15; pv[i] = *(const u32x4*)(Mv + (size_t)(b * S_ + row) * 1024 + h * 256 + eh * 128 + c16 * 8); }
    for (int cc = 0; cc < 32; ++cc) {
        const int bhc = (b * 4 + h) * 32 + cc, t0 = b * S_ + cc * 64;
#pragma unroll
        for (int et = 0; et < 4; ++et)
#pragma unroll
            for (int g = 0; g < 4; ++g) { u32x2 o; o.x = cvt_pk(acc[et][4 * g], acc[et][4 * g + 1]); o.y = cvt_pk(acc[et][4 * g + 2], acc[et][4 * g + 3]);
                *(u32x2*)(stg + (et * 32 + r) * STGS + (wave * 32 + 8 * g + 4 * hh) * 2) = o; }
        if (eh == 0 && r == 0) {
#pragma unroll
            for (int g = 0; g < 4; ++g) { f32x4 o; o[0] = accn[4 * g]; o[1] = accn[4 * g + 1]; o[2] = accn[4 * g + 2]; o[3] = accn[4 * g + 3]; *(f32x4*)(nst + (size_t)bhc * 256 + wave * 32 + 8 * g + 4 * hh) = o; } }
        lds_barrier();
#pragma unroll
        for (int i = 0; i < 8; ++i) { const int c = tid + NTHR * i, row = c >> 5, c16 = c & 31;
            *(u32x4*)(Cst + ((size_t)bhc * 256 + eh * 128 + row) * 256 + c16 * 8) = *(const u32x4*)(stg + row * STGS + c16 * 16); }
        if (cc == 31) break;
#pragma unroll
        for (int i = 0; i < 4; ++i) { const int c = tid + NTHR * i, row = c >> 5, c16 = c & 31; *(u32x4*)(ksm + row * KST + c16 * 16) = pk[i]; }
#pragma unroll
        for (int i = 0; i < 2; ++i) { const int c = tid + NTHR * i, row = c >> 4, c16 = c & 15; const float wv = WSV[cc * 64 + row]; const u32x4 w = pv[i];
            u32x4 o; o.x = cvt_pk(bflo(w.x) * wv, bfhi(w.x) * wv); o.y = cvt_pk(bflo(w.y) * wv, bfhi(w.y) * wv); o.z = cvt_pk(bflo(w.z) * wv, bfhi(w.z) * wv); o.w = cvt_pk(bflo(w.w) * wv, bfhi(w.w) * wv);
            *(u32x4*)(vsm + row * VST + c16 * 16) = o; }
        if (cc + 1 < 31) { const int t1 = t0 + 64;
#pragma unroll
            for (int i = 0; i < 4; ++i) { const int c = tid + NTHR * i, row = c >> 5, c16 = c & 31; pk[i] = *(const u32x4*)(KC + (size_t)(t1 + row) * 1024 + h * 256 + c16 * 8); }
#pragma unroll
            for (int i = 0; i < 2; ++i) { const int c = tid + NTHR * i, row = c >> 4, c16 = c & 15; pv[i] = *(const u32x4*)(Mv + (size_t)(t1 + row) * 1024 + h * 256 + eh * 128 + c16 * 8); } }
        lds_barrier();
        const float decay = SCL[64 + cc];
#pragma unroll
        for (int et = 0; et < 4; ++et)
#pragma unroll
            for (int i = 0; i < 16; ++i) acc[et][i] *= decay;
#pragma unroll
        for (int i = 0; i < 16; ++i) accn[i] *= decay;
#pragma unroll
        for (int ks = 0; ks < 4; ++ks) {
            const bf16x8 bfr = tr_frag(ksm + kb_off + ks * 16 * KST, 4 * KST);
            {
                const f32x4 w0 = *(const f32x4*)(WSV + cc * 64 + ks * 16 + hh * 8), w1 = *(const f32x4*)(WSV + cc * 64 + ks * 16 + hh * 8 + 4);
                u32x4 wb; wb.x = cvt_pk(w0[0], w0[1]); wb.y = cvt_pk(w0[2], w0[3]); wb.z = cvt_pk(w1[0], w1[1]); wb.w = cvt_pk(w1[2], w1[3]);
                if (r != 0) wb = (u32x4){0u, 0u, 0u, 0u};
                accn = __builtin_amdgcn_mfma_f32_32x32x16_bf16(bfr, __builtin_bit_cast(bf16x8, wb), accn, 0, 0, 0); }
#pragma unroll
            for (int et = 0; et < 4; ++et) { const bf16x8 afr = tr_frag(vsm + vb_off + ks * 16 * VST + et * 64, 4 * VST);
                acc[et] = __builtin_amdgcn_mfma_f32_32x32x16_bf16(bfr, afr, acc[et], 0, 0, 0); }
        }
    }
}

__device__ __forceinline__ void mlstm_passB(const Params& p, unsigned char* lds, int unit) {
    const int tid = get_tid(p.swid), lane = tid & 63, wave = tid >> 6, r = lane & 31, hh = lane >> 5, li = lane & 15;
    const int b = unit >> 7, h = (unit >> 5) & 3, cc = unit & 31;
    unsigned char* ws = p.ws;
    const bf16_t* QC = (const bf16_t*)(ws + WS_QC); const bf16_t* KC = (const bf16_t*)(ws + WS_KC);
    const bf16_t* Mv = (const bf16_t*)(ws + WS_P + 5 * SEG_B); const bf16_t* Mo = (const bf16_t*)(ws + WS_P + 6 * SEG_B);
    const float* gate = (const float*)(ws + WS_GATE);
    const bf16_t* Cst = (const bf16_t*)(ws + WS_CST); const float* nst = (const float*)(ws + WS_NST); const float* mst = (const float*)(ws + WS_MST);
    bf16_t* Oc = (bf16_t*)(ws + WS_H);
    constexpr int QST = 528, VST = 544, WST = 144, HST = 1040;
    unsigned char* qsm = lds;
    unsigned char* ksm = qsm + 64 * QST;
    unsigned char* vsm = ksm + 64 * QST;
    unsigned char* wsm = vsm + 64 * VST;
    float* sc = (float*)(wsm + 64 * WST);
    float* hsm = (float*)lds;
    const int bhc = (b * 4 + h) * 32 + cc, t0 = b * S_ + cc * 64;
    __syncthreads();
    if (wave == 0) {
        const float ipre = gate[(size_t)(t0 + lane) * 16 + 8 + h] + p.m_ib[h], fpre = gate[(size_t)(t0 + lane) * 16 + 12 + h] + p.m_fb[h];
        float bc = logsig(fpre);
#pragma unroll
        for (int o = 1; o < 64; o <<= 1) { const float u = __shfl_up(bc, o); if (lane >= o) bc += u; }
        const float a = ipre - bc; float pm = a;
#pragma unroll
        for (int o = 1; o < 64; o <<= 1) { const float u = __shfl_up(pm, o); if (lane >= o) pm = fmaxf(pm, u); }
        const float mc = mst[bhc]; const float mt = bc + fmaxf(mc, pm);
        sc[lane] = bc - mt; sc[64 + lane] = a; sc[128 + lane] = mt; sc[192 + lane] = expf(bc + mc - mt);
    }
    bf16x8 cfr[16];
#pragma unroll
    for (int ks = 0; ks < 16; ++ks) cfr[ks] = *(const bf16x8*)(Cst + ((size_t)bhc * 256 + wave * 32 + r) * 256 + ks * 16 + hh * 8);
#pragma unroll
    for (int i = 0; i < 4; ++i) { const int c = tid + NTHR * i, row = c >> 5, c16 = c & 31;
        *(u32x4*)(qsm + row * QST + c16 * 16) = *(const u32x4*)(QC + (size_t)(t0 + row) * 1024 + h * 256 + c16 * 8);
        *(u32x4*)(ksm + row * QST + c16 * 16) = *(const u32x4*)(KC + (size_t)(t0 + row) * 1024 + h * 256 + c16 * 8);
        *(u32x4*)(vsm + row * VST + c16 * 16) = *(const u32x4*)(Mv + (size_t)(t0 + row) * 1024 + h * 256 + c16 * 8); }
    __syncthreads();
    if (wave < 3) {
        const int sb = wave >> 1, lb = wave ? 1 : 0;
        f32x16 s;
#pragma unroll
        for (int i = 0; i < 16; ++i) s[i] = 0.f;
#pragma unroll
        for (int ks = 0; ks < 16; ++ks) { const bf16x8 a = *(const bf16x8*)(ksm + (sb * 32 + r) * QST + ks * 32 + hh * 16), q = *(const bf16x8*)(qsm + (lb * 32 + r) * QST + ks * 32 + hh * 16);
            s = __builtin_amdgcn_mfma_f32_32x32x16_bf16(a, q, s, 0, 0, 0); }
        const int l = lb * 32 + r; const float bl = sc[l]; float rs = 0.f;
#pragma unroll
        for (int g = 0; g < 4; ++g) { float w[4];
#pragma unroll
            for (int e = 0; e < 4; ++e) { const int sI = sb * 32 + 8 * g + 4 * hh + e; w[e] = (sI <= l) ? s[4 * g + e] * __expf(bl + sc[64 + sI]) : 0.f; rs += w[e]; }
            u32x2 o; o.x = cvt_pk(w[0], w[1]); o.y = cvt_pk(w[2], w[3]);
            *(u32x2*)(wsm + l * WST + (sb * 32 + 8 * g + 4 * hh) * 2) = o; }
        sc[256 + l * 4 + sb * 2 + hh] = rs;
    } else if (wave == 3) {
        const int l = r;
#pragma unroll
        for (int g = 0; g < 4; ++g) { u32x2 o; o.x = 0u; o.y = 0u; *(u32x2*)(wsm + l * WST + (32 + 8 * g + 4 * hh) * 2) = o; }
        sc[256 + l * 4 + 2 + hh] = 0.f;
    }
    {
        const int l = tid & 63, part = tid >> 6; const float* np = nst + (size_t)bhc * 256 + part * 32; float s = 0.f;
#pragma unroll
        for (int q = 0; q < 4; ++q) { const u32x4 w = *(const u32x4*)(qsm + l * QST + part * 64 + q * 16);
            s += bflo(w.x) * np[8 * q] + bfhi(w.x) * np[8 * q + 1] + bflo(w.y) * np[8 * q + 2] + bfhi(w.y) * np[8 * q + 3] + bflo(w.z) * np[8 * q + 4] + bfhi(w.z) * np[8 * q + 5] + bflo(w.w) * np[8 * q + 6] + bfhi(w.w) * np[8 * q + 7]; }
        sc[512 + l * 8 + part] = s;
    }
    f32x16 acc[2];
#pragma unroll
    for (int lb = 0; lb < 2; ++lb)
#pragma unroll
        for (int i = 0; i < 16; ++i) acc[lb][i] = 0.f;
#pragma unroll
    for (int ks = 0; ks < 16; ++ks)
#pragma unroll
        for (int lb = 0; lb < 2; ++lb) { const bf16x8 q = *(const bf16x8*)(qsm + (lb * 32 + r) * QST + ks * 32 + hh * 16);
            acc[lb] = __builtin_amdgcn_mfma_f32_32x32x16_bf16(cfr[ks], q, acc[lb], 0, 0, 0); }
    __syncthreads();
#pragma unroll
    for (int lb = 0; lb < 2; ++lb) { const float it = sc[192 + lb * 32 + r];
#pragma unroll
        for (int i = 0; i < 16; ++i) acc[lb][i] *= it; }
    const int vb_off = (8 * hh + (li >> 2)) * VST + (wave * 32 + 16 * (r >> 4) + 4 * (li & 3)) * 2;
#pragma unroll
    for (int ks = 0; ks < 4; ++ks) { const bf16x8 afr = tr_frag(vsm + vb_off + ks * 16 * VST, 4 * VST);
#pragma unroll
        for (int lb = 0; lb < 2; ++lb) { if (lb == 0 && ks >= 2) continue;
            const bf16x8 wf = *(const bf16x8*)(wsm + (lb * 32 + r) * WST + ks * 32 + hh * 16);
            acc[lb] = __builtin_amdgcn_mfma_f32_32x32x16_bf16(afr, wf, acc[lb], 0, 0, 0); } }
    float ssq[2];
#pragma unroll
    for (int lb = 0; lb < 2; ++lb) { const int l = lb * 32 + r;
        const f32x4 rsv = *(const f32x4*)(sc + 256 + l * 4); const f32x4 q0 = *(const f32x4*)(sc + 512 + l * 8), q1 = *(const f32x4*)(sc + 512 + l * 8 + 4);
        const float den = (rsv[0] + rsv[1] + rsv[2] + rsv[3]) + sc[192 + l] * ((q0[0] + q0[1] + q0[2] + q0[3]) + (q1[0] + q1[1] + q1[2] + q1[3]));
        const float inv = 1.f / fmaxf(fabsf(den), __expf(-sc[128 + l]));
        float s2 = 0.f;
#pragma unroll
        for (int i = 0; i < 16; ++i) { acc[lb][i] *= inv; s2 += acc[lb][i] * acc[lb][i]; }
        s2 += __shfl_xor(s2, 32); ssq[lb] = s2; }
    __syncthreads();
    if (hh == 0) { sc[1024 + r * 8 + wave] = ssq[0]; sc[1024 + (32 + r) * 8 + wave] = ssq[1]; }
#pragma unroll
    for (int lb = 0; lb < 2; ++lb)
#pragma unroll
        for (int g = 0; g < 4; ++g) { f32x4 v; v[0] = acc[lb][4 * g]; v[1] = acc[lb][4 * g + 1]; v[2] = acc[lb][4 * g + 2]; v[3] = acc[lb][4 * g + 3];
            *(f32x4*)((unsigned char*)hsm + (lb * 32 + r) * HST + (wave * 32 + 8 * g + 4 * hh) * 4) = v; }
    __syncthreads();
#pragma unroll
    for (int i = 0; i < 4; ++i) { const int c = tid + NTHR * i, l = c >> 5, e0 = (c & 31) * 8;
        const f32x4 s0 = *(const f32x4*)(sc + 1024 + l * 8), s1 = *(const f32x4*)(sc + 1024 + l * 8 + 4);
        const float rr = rsqrtf(((s0[0] + s0[1] + s0[2] + s0[3]) + (s1[0] + s1[1] + s1[2] + s1[3])) * (1.f / 256.f) + EPS_);
        const f32x4 h0 = *(const f32x4*)((unsigned char*)hsm + l * HST + e0 * 4), h1 = *(const f32x4*)((unsigned char*)hsm + l * HST + e0 * 4 + 16);
        const f32x4 g0 = *(const f32x4*)(p.m_hg + h * 256 + e0), g1 = *(const f32x4*)(p.m_hg + h * 256 + e0 + 4);
        const u32x4 mo = *(const u32x4*)(Mo + (size_t)(t0 + l) * 1024 + h * 256 + e0);
        u32x4 o;
        o.x = cvt_pk(h0[0] * rr * g0[0] * sigm(bflo(mo.x)), h0[1] * rr * g0[1] * sigm(bfhi(mo.x))); o.y = cvt_pk(h0[2] * rr * g0[2] * sigm(bflo(mo.y)), h0[3] * rr * g0[3] * sigm(bfhi(mo.y)));
        o.z = cvt_pk(h1[0] * rr * g1[0] * sigm(bflo(mo.z)), h1[1] * rr * g1[1] * sigm(bfhi(mo.z))); o.w = cvt_pk(h1[2] * rr * g1[2] * sigm(bflo(mo.w)), h1[3] * rr * g1[3] * sigm(bfhi(mo.w)));
        *(u32x4*)(Oc + (size_t)(t0 + l) * D_ + 1024 + h * 256 + e0) = o; }
}

__device__ __forceinline__ void ce_desc(float& a, float& b) { const float hi = fmaxf(a, b), lo = fminf(a, b); a = hi; b = lo; }
__device__ __forceinline__ void sort16_desc(float (&v)[16]) {
#pragma unroll
    for (int k = 2; k <= 16; k <<= 1)
#pragma unroll
        for (int j = k >> 1; j > 0; j >>= 1)
#pragma unroll
            for (int i = 0; i < 16; ++i) { const int l = i ^ j; if (l > i) { if ((i & k) == 0) ce_desc(v[i], v[l]); else ce_desc(v[l], v[i]); } }
}
__device__ __forceinline__ void bmerge16_desc(float (&v)[16]) {
#pragma unroll
    for (int j = 8; j > 0; j >>= 1)
#pragma unroll
        for (int i = 0; i < 16; ++i) { const int l = i ^ j; if (l > i) ce_desc(v[i], v[l]); }
}
__device__ __forceinline__ void merge_top16(float (&a)[16], const float (&b)[16]) {
#pragma unroll
    for (int i = 0; i < 16; ++i) a[i] = fmaxf(a[i], b[15 - i]);
    bmerge16_desc(a);
}
__device__ __forceinline__ float pack_idx(float v, unsigned mask, unsigned idx) { return __builtin_bit_cast(float, (__builtin_bit_cast(unsigned, v) & mask) | idx); }
__device__ __forceinline__ void top16_from_acc(const f32x16 (&acc)[4], int h, float (&out)[16]) {
    float g[4][16];
#pragma unroll
    for (int mt = 0; mt < 4; ++mt) {
#pragma unroll
        for (int i = 0; i < 16; ++i) g[mt][i] = pack_idx(acc[mt][i], 0xffffff80u, (unsigned)(32 * mt + (i & 3) + 8 * (i >> 2)) | ((unsigned)h << 2));
        sort16_desc(g[mt]);
    }
    merge_top16(g[0], g[1]); merge_top16(g[2], g[3]); merge_top16(g[0], g[2]);
    float o[16];
#pragma unroll
    for (int i = 0; i < 16; ++i) o[i] = __shfl_xor(g[0][i], 32);
    merge_top16(g[0], o);
#pragma unroll
    for (int i = 0; i < 16; ++i) out[i] = g[0][i];
}
__device__ __forceinline__ unsigned lut16(const unsigned (&P)[4], unsigned i) {
    const unsigned long long lo = (unsigned long long)P[0] | ((unsigned long long)P[1] << 32), hi = (unsigned long long)P[2] | ((unsigned long long)P[3] << 32);
    const unsigned long long s = (i & 8u) ? hi : lo;
    return (unsigned)(s >> ((i & 7u) * 8u)) & 0xffu;
}
struct CandTab { int i[50]; int j[50]; };
constexpr CandTab make_cand_tab() { CandTab t{}; int n = 0; for (int i = 0; i < 16; ++i) for (int j = 0; j < 16; ++j) if ((i + 1) * (j + 1) <= 16) { t.i[n] = i; t.j[n] = j; ++n; } return t; }
__device__ __forceinline__ void phase_topk(const Params& p, unsigned char* lds, int bid, int nb) {
    const int tid = get_tid(p.swid), lane = tid & 63, wave = tid >> 6, r = lane & 31, h = lane >> 5;
    unsigned char* ws = p.ws;
    const bf16_t* Q = (const bf16_t*)(ws + WS_Q); int* IDX = (int*)(ws + WS_IDX); float* GW = (float*)(ws + WS_GW);
    constexpr int KP = 136;
    bf16_t* KS = (bf16_t*)lds;
    for (int i = tid; i < 2 * 2048; i += NTHR) {
        const int which = i >> 11, n = (i >> 4) & 127, d0 = (i & 15) * 8; const float* sp = (which ? p.sk2 : p.sk1) + n * 128 + d0;
        const f32x4 a = *(const f32x4*)sp, b = *(const f32x4*)(sp + 4);
        u32x4 hi, lo;
        hi.x = cvt_pk(a[0], a[1]); hi.y = cvt_pk(a[2], a[3]); hi.z = cvt_pk(b[0], b[1]); hi.w = cvt_pk(b[2], b[3]);
        lo.x = cvt_pk(a[0] - bflo(hi.x), a[1] - bfhi(hi.x)); lo.y = cvt_pk(a[2] - bflo(hi.y), a[3] - bfhi(hi.y)); lo.z = cvt_pk(b[0] - bflo(hi.z), b[1] - bfhi(hi.z)); lo.w = cvt_pk(b[2] - bflo(hi.w), b[3] - bfhi(hi.w));
        *(u32x4*)(KS + ((which * 2 + 0) * 128 + n) * KP + d0) = hi; *(u32x4*)(KS + ((which * 2 + 1) * 128 + n) * KP + d0) = lo; }
    __syncthreads();
    for (int item = bid * 8 + wave; item < 512 * 8; item += nb * 8) {
        const int tt = item >> 3, hh = item & 7, t = tt * 32 + r;
        float top[2][16];
#pragma unroll
        for (int list = 0; list < 2; ++list) {
            bf16x8 qf[8];
#pragma unroll
            for (int ks = 0; ks < 8; ++ks) qf[ks] = *(const bf16x8*)(Q + (size_t)t * D_ + hh * 256 + list * 128 + ks * 16 + h * 8);
            float g[4][16];
#pragma unroll
            for (int mt = 0; mt < 4; ++mt) {
                f32x16 acc;
#pragma unroll
                for (int i = 0; i < 16; ++i) acc[i] = 0.f;
#pragma unroll
                for (int hl = 0; hl < 2; ++hl)
#pragma unroll
                    for (int ks = 0; ks < 8; ++ks) { const bf16x8 a = *(const bf16x8*)(KS + ((list * 2 + hl) * 128 + mt * 32 + r) * KP + ks * 16 + h * 8);
                        acc = __builtin_amdgcn_mfma_f32_32x32x16_bf16(a, qf[ks], acc, 0, 0, 0); }
#pragma unroll
                for (int i = 0; i < 16; ++i) g[mt][i] = pack_idx(acc[i], 0xffffff80u, (unsigned)(32 * mt + (i & 3) + 8 * (i >> 2)) | ((unsigned)h << 2));
                sort16_desc(g[mt]);
                __builtin_amdgcn_sched_barrier(0);
            }
            merge_top16(g[0], g[1]); merge_top16(g[2], g[3]); merge_top16(g[0], g[2]);
            {   float o[16];
#pragma unroll
                for (int i = 0; i < 16; ++i) o[i] = __shfl_xor(g[0][i], 32);
                merge_top16(g[0], o); }
#pragma unroll
            for (int i = 0; i < 16; ++i) top[list][i] = g[0][i];
            __builtin_amdgcn_sched_barrier(0);
        }
        unsigned P1[4], P2[4];
#pragma unroll
        for (int q = 0; q < 4; ++q) { P1[q] = 0u; P2[q] = 0u;
#pragma unroll
            for (int e = 0; e < 4; ++e) { P1[q] |= (__builtin_bit_cast(unsigned, top[0][4 * q + e]) & 127u) << (8 * e); P2[q] |= (__builtin_bit_cast(unsigned, top[1][4 * q + e]) & 127u) << (8 * e); } }
        float c[4][16];
#pragma unroll
        for (int n = 0; n < 64; ++n) {
            if (n < 50) { constexpr CandTab CT = make_cand_tab(); const int i = CT.i[n], j = CT.j[n];
                c[n >> 4][n & 15] = pack_idx(top[0][i] + top[1][j], 0xffffff00u, (unsigned)(i * 16 + j)); }
            else c[n >> 4][n & 15] = -INFINITY;
        }
        sort16_desc(c[0]); __builtin_amdgcn_sched_barrier(0); sort16_desc(c[1]); __builtin_amdgcn_sched_barrier(0); merge_top16(c[0], c[1]); __builtin_amdgcn_sched_barrier(0);
        sort16_desc(c[2]); __builtin_amdgcn_sched_barrier(0); sort16_desc(c[3]); __builtin_amdgcn_sched_barrier(0); merge_top16(c[2], c[3]); __builtin_amdgcn_sched_barrier(0); merge_top16(c[0], c[2]);
        float ex[16], sum = 0.f;
#pragma unroll
        for (int k = 0; k < 16; ++k) { ex[k] = __expf(c[0][k] - c[0][0]); sum += ex[k]; }
        const float inv = 1.f / sum;
        if (h == 0) {
            int* ip = IDX + (size_t)t * 128 + hh * 16; float* gp = GW + (size_t)t * 128 + hh * 16;
#pragma unroll
            for (int q = 0; q < 4; ++q) { u32x4 iv; f32x4 gv;
#pragma unroll
                for (int e = 0; e < 4; ++e) { const unsigned pos = __builtin_bit_cast(unsigned, c[0][4 * q + e]) & 255u;
                    iv[e] = lut16(P1, pos >> 4) * 128u + lut16(P2, pos & 15u); gv[e] = ex[4 * q + e] * inv; }
                *(u32x4*)(ip + 4 * q) = iv; *(f32x4*)(gp + 4 * q) = gv; }
        }
    }
}

typedef float f32x2 __attribute__((ext_vector_type(2)));
__device__ __forceinline__ float dot16_fp8(const u32x4 w, const float (&h)[32], int o) {
    float s = 0.f;
#pragma unroll
    for (int q = 0; q < 4; ++q) { const f32x2 lo = __builtin_amdgcn_cvt_pk_f32_fp8((int)w[q], false), hi = __builtin_amdgcn_cvt_pk_f32_fp8((int)w[q], true);
        fmac(s, lo[0], h[o + 4 * q]); fmac(s, lo[1], h[o + 4 * q + 1]); fmac(s, hi[0], h[o + 4 * q + 2]); fmac(s, hi[1], h[o + 4 * q + 3]); }
    return s;
}
template <int CTRL, int ROW_MASK, int BANK_MASK>
__device__ __forceinline__ int dpp_mov0i(int v) { return __builtin_amdgcn_update_dpp(0, v, CTRL, ROW_MASK, BANK_MASK, true); }
__device__ __forceinline__ void quant_row_i8(const bf16_t* hp, int c16, unsigned (&hq)[32], float& hsc) {
    float mx = 0.f;
#pragma unroll
    for (int i = 0; i < 16; ++i) { const u32x4 w = *(const u32x4*)(hp + 256 * (i >> 1) + 8 * (i & 1));
#pragma unroll
        for (int e = 0; e < 4; ++e) mx = fmaxf(mx, fmaxf(fabsf(bflo(w[e])), fabsf(bfhi(w[e])))); }
    mx = fmaxf(mx, __shfl_xor(mx, 1)); mx = fmaxf(mx, __shfl_xor(mx, 2)); mx = fmaxf(mx, __shfl_xor(mx, 4)); mx = fmaxf(mx, __shfl_xor(mx, 8));
    mx = fmaxf(mx, 1e-30f); const float inv = 127.f / mx; hsc = mx * (1.f / 127.f);
    asm volatile("" ::: "memory");
#pragma unroll
    for (int i = 0; i < 16; ++i) { const u32x4 w = *(const u32x4*)(hp + 256 * (i >> 1) + 8 * (i & 1));
#pragma unroll
        for (int hh = 0; hh < 2; ++hh) { const unsigned w0 = w[2 * hh], w1 = w[2 * hh + 1];
            hq[2 * i + hh] = ((unsigned)__float2int_rn(bflo(w0) * inv) & 0xffu) | (((unsigned)__float2int_rn(bfhi(w0) * inv) & 0xffu) << 8) | (((unsigned)__float2int_rn(bflo(w1) * inv) & 0xffu) << 16) | (((unsigned)__float2int_rn(bfhi(w1) * inv) & 0xffu) << 24); } }
}
__device__ __forceinline__ void phase_peer1(const Params& p, unsigned char* lds, int bid, int nb, int probe) {
    const int tid = get_tid(p.swid), lane = tid & 63, wave = tid >> 6, r = lane >> 4, c16 = lane & 15;
    unsigned char* ws = p.ws;
    const bf16_t* H2 = (const bf16_t*)(ws + WS_H2); const int* IDX = (const int*)(ws + WS_IDX); const float* GW = (const float*)(ws + WS_GW);
    unsigned* EWT = (unsigned*)(ws + WS_EWT); const float* DSC = (const float*)(ws + WS_DSC);
    const unsigned char* E8D = ws + WS_E8D + 16 * c16; const unsigned emask = probe ? 0x3ffu : 0x3fffu;
    LAS unsigned* seq = (LAS unsigned*)((LAS unsigned char*)lds + (wave * 4 + r) * 1024);
    LAS unsigned* hist = (LAS unsigned*)((LAS unsigned char*)lds + 32768 + (wave * 4 + r) * 128);
    for (int tile = bid; tile < 256; tile += nb) {
        const int tA = tile * 64 + wave * 4 + r, tB = tA + 32;
        unsigned hqA[32], hqB[32]; float hscA, hscB;
        quant_row_i8(H2 + (size_t)tA * D_ + 16 * c16, c16, hqA, hscA);
        quant_row_i8(H2 + (size_t)tB * D_ + 16 * c16, c16, hqB, hscB);
        unsigned ppA0, ppA1, ppB0, ppB1;
        {   int idx[16]; unsigned pos[16];
#pragma unroll
            for (int m = 0; m < 8; ++m) { idx[m] = IDX[(size_t)tA * 128 + c16 + 16 * m]; idx[8 + m] = IDX[(size_t)tB * 128 + c16 + 16 * m]; }
            hist[c16] = 0u;
#pragma unroll
            for (int m = 0; m < 16; ++m) pos[m] = __hip_atomic_fetch_add(&hist[idx[m] >> 10], 1u, __ATOMIC_RELAXED, __HIP_MEMORY_SCOPE_WORKGROUP);
            {   const unsigned c = hist[c16]; unsigned inc = c;
#pragma unroll
                for (int o = 1; o < 16; o <<= 1) { const unsigned u = __shfl_up(inc, o, 16); if (c16 >= o) inc += u; }
                hist[c16] = inc - c; }
#pragma unroll
            for (int m = 0; m < 16; ++m) { pos[m] += hist[idx[m] >> 10]; seq[pos[m]] = (unsigned)idx[m] | ((unsigned)(c16 + 16 * (m & 7)) << 14) | ((unsigned)(m >> 3) << 21); }
            ppA0 = pos[0] | (pos[1] << 8) | (pos[2] << 16) | (pos[3] << 24); ppA1 = pos[4] | (pos[5] << 8) | (pos[6] << 16) | (pos[7] << 24);
            ppB0 = pos[8] | (pos[9] << 8) | (pos[10] << 16) | (pos[11] << 24); ppB1 = pos[12] | (pos[13] << 8) | (pos[14] << 16) | (pos[15] << 24);
        }
        u32x4 cur[8], nxt[8]; unsigned ecur = seq[0], enxt = 0u;
        {   const unsigned char* rp = E8D + (size_t)(ecur & emask) * 2048;
#pragma unroll
            for (int q = 0; q < 8; ++q) cur[q] = *(const u32x4*)(rp + 256 * q); }
        for (int s = 0; s < 256; ++s) {
            if (s + 1 < 256) { enxt = seq[s + 1]; const unsigned char* rp = E8D + (size_t)(enxt & emask) * 2048;
#pragma unroll
                for (int q = 0; q < 8; ++q) nxt[q] = *(const u32x4*)(rp + 256 * q); }
            int a0 = 0, a1 = 0, b0 = 0, b1 = 0;
#pragma unroll
            for (int q = 0; q < 8; ++q) {
                a0 = __builtin_amdgcn_sdot4((int)cur[q][0], (int)hqA[4 * q], a0, false); a1 = __builtin_amdgcn_sdot4((int)cur[q][1], (int)hqA[4 * q + 1], a1, false);
                a0 = __builtin_amdgcn_sdot4((int)cur[q][2], (int)hqA[4 * q + 2], a0, false); a1 = __builtin_amdgcn_sdot4((int)cur[q][3], (int)hqA[4 * q + 3], a1, false);
                b0 = __builtin_amdgcn_sdot4((int)cur[q][0], (int)hqB[4 * q], b0, false); b1 = __builtin_amdgcn_sdot4((int)cur[q][1], (int)hqB[4 * q + 1], b1, false);
                b0 = __builtin_amdgcn_sdot4((int)cur[q][2], (int)hqB[4 * q + 2], b0, false); b1 = __builtin_amdgcn_sdot4((int)cur[q][3], (int)hqB[4 * q + 3], b1, false); }
            int d = ((ecur >> 21) & 1u) ? (b0 + b1) : (a0 + a1);
            d += dpp_mov0i<0x111, 0xf, 0xf>(d); d += dpp_mov0i<0x112, 0xf, 0xf>(d); d += dpp_mov0i<0x114, 0xf, 0xe>(d); d += dpp_mov0i<0x118, 0xf, 0xc>(d);
            if (c16 == 15) seq[s] = (unsigned)d;
#pragma unroll
            for (int q = 0; q < 8; ++q) cur[q] = nxt[q];
            ecur = enxt;
        }
        if (probe) continue;
#pragma unroll
        for (int tk = 0; tk < 2; ++tk) {
            const int t = tk ? tB : tA; const float hsc = tk ? hscB : hscA;
            unsigned* ep = EWT + (size_t)(t >> 6) * 8192 + (t & 63) * 4;
#pragma unroll
            for (int m = 0; m < 8; ++m) { const int j = c16 + 16 * m; const int ix = IDX[(size_t)t * 128 + j];
                const unsigned ps = ((tk ? (m < 4 ? ppB0 : ppB1) : (m < 4 ? ppA0 : ppA1)) >> (8 * (m & 3))) & 0xffu;
                const float a = (float)(int)seq[ps] * hsc * DSC[ix];
                const float w = GW[(size_t)t * 128 + j] * 0.5f * a * (1.f + erff(a * 0.7071067811865476f));
                ep[(j >> 2) * 256 + (j & 3)] = (cvt_pk(0.f, w) & 0xffff0000u) | (unsigned)ix; }
        }
    }
}
__device__ __forceinline__ void phase_peer2(const Params& p, unsigned char* lds, int bid, int nb) {
    const int tid = get_tid(p.swid), lane = tid & 63, wave = tid >> 6;
    unsigned char* ws = p.ws;
    const unsigned* EWT = (const unsigned*)(ws + WS_EWT); const bf16_t* Y = (const bf16_t*)(ws + WS_X1); const float* mod = (const float*)(ws + WS_MOD);
    for (int si = bid; si < 256; si += nb) {
        const int s = (si & 7) * 32 + (si >> 3);
        __syncthreads();
        {   const u32x4* sp = (const u32x4*)(ws + WS_E8U + (size_t)s * 131072);
#pragma unroll
            for (int i = 0; i < 16; ++i) ((u32x4*)lds)[tid + NTHR * i] = sp[tid + NTHR * i]; }
        __syncthreads();
        const int tb0 = ((si >> 5) * 32 + wave) & 255;
        unsigned cur[16], nxt[16];
        {   const u32x4* wp = (const u32x4*)(EWT + (size_t)tb0 * 8192) + lane;
#pragma unroll
            for (int u = 0; u < 4; ++u) { const u32x4 v = wp[u * 64]; cur[4 * u] = v.x; cur[4 * u + 1] = v.y; cur[4 * u + 2] = v.z; cur[4 * u + 3] = v.w; } }
        float acc[8];
#pragma unroll
        for (int c = 0; c < 8; ++c) acc[c] = 0.f;
        f32x4 xa = {0.f, 0.f, 0.f, 0.f}, xb = xa;
        for (int q = 0; q < 256; ++q) {
            const int tb = (tb0 + 8 * (q >> 3)) & 255, g = q & 7;
            if (q + 1 < 256) { const int tbn = (tb0 + 8 * ((q + 1) >> 3)) & 255; const u32x4* wp = (const u32x4*)(EWT + (size_t)tbn * 8192 + ((q + 1) & 7) * 1024) + lane;
#pragma unroll
                for (int u = 0; u < 4; ++u) { const u32x4 v = wp[u * 64]; nxt[4 * u] = v.x; nxt[4 * u + 1] = v.y; nxt[4 * u + 2] = v.z; nxt[4 * u + 3] = v.w; } }
            const int t = tb * 64 + lane;
            if (g == 0) { xa = *(const f32x4*)(p.x + (size_t)t * D_ + 8 * s); xb = *(const f32x4*)(p.x + (size_t)t * D_ + 8 * s + 4);
                const u32x4 yw = *(const u32x4*)(Y + (size_t)t * D_ + 8 * s); const float* g1 = mod + (size_t)(t >> 11) * NMOD + 2 * D_ + 8 * s; const f32x4 ha = *(const f32x4*)g1, hb = *(const f32x4*)(g1 + 4);
                xa[0] += ha[0] * bflo(yw.x); xa[1] += ha[1] * bfhi(yw.x); xa[2] += ha[2] * bflo(yw.y); xa[3] += ha[3] * bfhi(yw.y); xb[0] += hb[0] * bflo(yw.z); xb[1] += hb[1] * bfhi(yw.z); xb[2] += hb[2] * bflo(yw.w); xb[3] += hb[3] * bfhi(yw.w); }
            u32x2 row[16];
#pragma unroll
            for (int u = 0; u < 16; ++u) row[u] = *(const LAS u32x2*)(unsigned)((cur[u] << 3) & 0x1fff8u);
#pragma unroll
            for (int u = 0; u < 16; ++u) {
                const float w = __builtin_bit_cast(float, cur[u]);
                const f32x2 v0 = __builtin_amdgcn_cvt_pk_f32_fp8((int)row[u].x, false), v1 = __builtin_amdgcn_cvt_pk_f32_fp8((int)row[u].x, true), v2 = __builtin_amdgcn_cvt_pk_f32_fp8((int)row[u].y, false), v3 = __builtin_amdgcn_cvt_pk_f32_fp8((int)row[u].y, true);
                fmac(acc[0], w, v0[0]); fmac(acc[1], w, v0[1]); fmac(acc[2], w, v1[0]); fmac(acc[3], w, v1[1]); fmac(acc[4], w, v2[0]); fmac(acc[5], w, v2[1]); fmac(acc[6], w, v3[0]); fmac(acc[7], w, v3[1]);
            }
            if (g == 7) {
                const float* g2 = mod + (size_t)(t >> 11) * NMOD + 5 * D_ + 8 * s;
                const f32x4 ga = *(const f32x4*)g2, gb = *(const f32x4*)(g2 + 4);
                f32x4 oa, ob;
#pragma unroll
                for (int c = 0; c < 4; ++c) { oa[c] = xa[c] + ga[c] * acc[c] * (1.f / 32.f); ob[c] = xb[c] + gb[c] * acc[4 + c] * (1.f / 32.f); }
                *(f32x4*)(p.out + (size_t)t * D_ + 8 * s) = oa; *(f32x4*)(p.out + (size_t)t * D_ + 8 * s + 4) = ob;
#pragma unroll
                for (int c = 0; c < 8; ++c) acc[c] = 0.f;
            }
#pragma unroll
            for (int u = 0; u < 16; ++u) cur[u] = nxt[u];
        }
    }
}

typedef const __attribute__((address_space(4))) Params* KargPtr;
__device__ __forceinline__ Params load_params(int swid = 0) {
#if defined(__HIP_DEVICE_COMPILE__)
    KargPtr kp = (KargPtr)__builtin_amdgcn_kernarg_segment_ptr(); asm volatile("" : "+s"(kp)); Params r; __builtin_memcpy(&r, kp, sizeof(Params)); r.swid = swid; return r;
#else
    return Params{};
#endif
}
constexpr int N_PHASES = 12;
constexpr int LDS_BYTES = 152 * 1024;
__global__ void __launch_bounds__(NTHR) fwd_kernel(Params p_arg) {
    extern __shared__ __attribute__((aligned(16))) unsigned char lds[];
    const int bid = blockIdx.x, nb = gridDim.x, swid = __builtin_amdgcn_readfirstlane((int)threadIdx.x >> 6);
    unsigned char* ws = p_arg.ws;
    volatile LAS unsigned* xbst = (volatile LAS unsigned*)((LAS unsigned char*)lds + LDS_BYTES - 16);
    if (get_tid(swid) == 0) { xbst[0] = 0u; xbst[1] = 0u; xbst[2] = 0u; xbst[3] = 0u; }
    __syncthreads();
    if ((p_arg.ph_hi - p_arg.ph_lo) > 1) (void)xcd_barrier_post((unsigned*)(ws + WS_BAR), xbst, swid);
#ifdef ONLY_PHASE
#define IN(k) ((k) == ONLY_PHASE && p.ph_lo <= (k) && (k) < p.ph_hi)
#else
#define IN(k) (p.ph_lo <= (k) && (k) < p.ph_hi)
#endif
#define SEAM(k) do { const Params p = load_params(); if (p.ph_lo <= (k) && (k) + 1 < p.ph_hi) { XcdBarrier bar; bar.bar = (unsigned*)(p.ws + WS_BAR); bar.x = xb_xcc_id(); bar.st = xbst; xcd_barrier(bar, swid); } } while (0)
#ifndef REPEAT_MASK
#define REPEAT_MASK 0
#endif
#define REP(k) for (int rep_ = 0; rep_ < (((REPEAT_MASK) >> (k)) & 1) + 1; ++rep_)
    REP(0) { const Params p = load_params(swid); if (IN(0)) { unsigned char* ws = p.ws; const float* mod = (const float*)(ws + WS_MOD); (void)mod;
        phase_prep(p, lds, bid, nb);
    } }
    SEAM(0);
    REP(1) { const Params p = load_params(swid); if (IN(1)) { unsigned char* ws = p.ws; const float* mod = (const float*)(ws + WS_MOD); (void)mod;
        phase_norm<false>(p.x, nullptr, 0, p.g1, mod, 0, D_, (bf16_t*)(ws + WS_H), ws + WS_H8, bid, nb, swid);
    } }
    SEAM(1);
    REP(2) { const Params p = load_params(swid); if (IN(2)) { unsigned char* ws = p.ws; const float* mod = (const float*)(ws + WS_MOD); (void)mod;
        phase_gates(p, lds, bid, nb);
        { pg8::Gemm g{(const bf16_t*)(ws + WS_H8), (const bf16_t*)(ws + WS_WINT), T_, 7168, D_}; pg8::StaticOrder S; S.init(T_, 7168, nb, bid);
        pg8::EpiSeg E{(bf16_t*)(ws + WS_P), p.fox_qg, p.fox_kg, (LAS float*)((LAS unsigned char*)lds + 131072), 1.f / 512.f}; pg8::gemm_phase<pg8::EpiSeg, pg8::StaticOrder, true, true, true>((LAS unsigned char*)lds, g, S, E, swid); }
    } }
    SEAM(2);
    REP(3) { const Params p = load_params(swid); if (IN(3)) { unsigned char* ws = p.ws; const float* mod = (const float*)(ws + WS_MOD); (void)mod;
        phase_post(p, bid, nb);
    } }
    SEAM(3);
    REP(4) { const Params p = load_params(swid); if (IN(4)) { unsigned char* ws = p.ws; const float* mod = (const float*)(ws + WS_MOD); (void)mod;
        { for (int u = bid; u < 64; u += nb) mlstm_passA(p, lds, u);
        unsigned* qctr = (unsigned*)(ws + WS_QCTR) + rep_; LAS int* slot = (LAS int*)((LAS unsigned char*)lds + LDS_BYTES - 32);
        const int tid = get_tid(swid);
        for (;;) { __syncthreads(); if (tid == 0) *slot = (int)atomicAdd(qctr, 1u); __syncthreads(); const int u = *slot; if (u >= 512) break;
            const int bh = u & 63; fox_unit(p, lds, bh >> 3, bh & 7, 7 - (u >> 6)); } }
    } }
    SEAM(4);
    REP(5) { const Params p = load_params(swid); if (IN(5)) { unsigned char* ws = p.ws; const float* mod = (const float*)(ws + WS_MOD); (void)mod;
        { for (int u = bid; u < 1024; u += nb) mlstm_passB(p, lds, u); }
    } }
    SEAM(5);
    REP(6) { const Params p = load_params(swid); if (IN(6)) { unsigned char* ws = p.ws; const float* mod = (const float*)(ws + WS_MOD); (void)mod;
        { pg8::Gemm g{(const bf16_t*)(ws + WS_H), (const bf16_t*)(ws + WS_WOT), T_, D_, D_}; pg8::StaticOrder S; S.init(T_, D_, nb, bid);
        pg8::EpiBf E{(bf16_t*)(ws + WS_X1), D_}; pg8::gemm_phase<pg8::EpiBf, pg8::StaticOrder, true, true>((LAS unsigned char*)lds, g, S, E, swid); }
    } }
    SEAM(6);
    REP(7) { const Params p = load_params(swid); if (IN(7)) { unsigned char* ws = p.ws; const float* mod = (const float*)(ws + WS_MOD); (void)mod;
        convert_experts(p, bid, nb);
    } }
    REP(7) { const Params p = load_params(swid); if (IN(7)) { unsigned char* ws = p.ws; const float* mod = (const float*)(ws + WS_MOD); (void)mod;
        phase_norm<true>(p.x, (const bf16_t*)(ws + WS_X1), 2 * D_, p.g2, mod, 3 * D_, 4 * D_, (bf16_t*)(ws + WS_H2), nullptr, bid, nb, swid);
    } }
    SEAM(7);
    REP(8) { const Params p = load_params(swid); if (IN(8)) { unsigned char* ws = p.ws; const float* mod = (const float*)(ws + WS_MOD); (void)mod;
        { pg8::Gemm g{(const bf16_t*)(ws + WS_H2), (const bf16_t*)(ws + WS_WQT), T_, D_, D_}; pg8::StaticOrder S; S.init(T_, D_, nb, bid);
        pg8::EpiBf E{(bf16_t*)(ws + WS_Q), D_}; pg8::gemm_phase<pg8::EpiBf, pg8::StaticOrder, true, true>((LAS unsigned char*)lds, g, S, E, swid); }
    } }
    SEAM(8);
    REP(9) { const Params p = load_params(swid); if (IN(9)) { unsigned char* ws = p.ws; const float* mod = (const float*)(ws + WS_MOD); (void)mod;
        phase_topk(p, lds, bid, nb);
    } }
    SEAM(9);
    REP(10) { const Params p = load_params(swid); if (IN(10)) { unsigned char* ws = p.ws; const float* mod = (const float*)(ws + WS_MOD); (void)mod;
#ifdef PROBE_L2
        phase_peer1(p, lds, bid, nb, rep_);
#else
        phase_peer1(p, lds, bid, nb, 0);
#endif
    } }
    SEAM(10);
    REP(11) { const Params p = load_params(swid); if (IN(11)) { unsigned char* ws = p.ws; const float* mod = (const float*)(ws + WS_MOD); (void)mod;
        phase_peer2(p, lds, bid, nb);
    } }
#undef IN
#undef SEAM
}

#ifndef ONE_LAUNCH
#define ONE_LAUNCH 1
#endif
extern "C" void kernel_launch(void* const* d_in, const int* in_sizes, int n_in, void* d_out, int out_size, void* d_ws, size_t ws_size, hipStream_t stream) {
    static int grid = 0;
    if (grid == 0) {
        int dev = 0, cus = 0, per_cu = 0;
        if (n_in != 21 || ws_size < WS_END) { fprintf(stderr, "kernel_launch: unexpected n_in %d / ws_size %zu (need %zu)\n", n_in, ws_size, (size_t)WS_END); grid = -1; return; }
        hipGetDevice(&dev); hipDeviceGetAttribute(&cus, hipDeviceAttributeMultiprocessorCount, dev);
        if (hipFuncSetAttribute((const void*)fwd_kernel, hipFuncAttributeMaxDynamicSharedMemorySize, LDS_BYTES) != hipSuccess) { fprintf(stderr, "kernel_launch: hipFuncSetAttribute failed\n"); grid = -1; return; }
        if (hipOccupancyMaxActiveBlocksPerMultiprocessor(&per_cu, (const void*)fwd_kernel, NTHR, LDS_BYTES) != hipSuccess || per_cu < 1) { fprintf(stderr, "kernel_launch: occupancy query says %d\n", per_cu); (void)hipGetLastError(); }
        grid = cus > 0 ? cus : 256;
    }
    if (grid < 0) return;
    Params p{};
    const float** pp = (const float**)&p;
    for (int i = 0; i < 21; ++i) pp[i] = (const float*)d_in[i];
    p.out = (float*)d_out; p.ws = (unsigned char*)d_ws;
    hipMemsetAsync((char*)d_ws + WS_BAR, 0, 16384, stream);
#if ONE_LAUNCH
    p.ph_lo = 0; p.ph_hi = N_PHASES;
    void* args[] = {&p};
    hipError_t e = hipLaunchCooperativeKernel((const void*)fwd_kernel, dim3(grid), dim3(NTHR), args, LDS_BYTES, stream);
    if (e != hipSuccess) fprintf(stderr, "cooperative launch failed: %s (grid %d)\n", hipGetErrorString(e), grid);
#else
    for (int ph = 0; ph < N_PHASES; ++ph) { p.ph_lo = ph; p.ph_hi = ph + 1; hipLaunchKernelGGL(fwd_kernel, dim3(grid), dim3(NTHR), LDS_BYTES, stream, p); }
#endif
}
```

```cpp
#include <hip/hip_runtime.h>
#include <cstdio>
#include <cstdint>

#define GAS __attribute__((address_space(1)))
#define LAS __attribute__((address_space(3)))
typedef unsigned short bf16_t;
typedef short bf16x8 __attribute__((ext_vector_type(8)));
typedef float f32x4 __attribute__((ext_vector_type(4)));
typedef float f32x16 __attribute__((ext_vector_type(16)));
typedef unsigned u32x4 __attribute__((ext_vector_type(4)));
typedef unsigned u32x2 __attribute__((ext_vector_type(2)));

constexpr int T_ = 16384, D_ = 2048, B_ = 8, S_ = 2048, NTHR = 512;
constexpr float EPS_ = 1e-6f;
constexpr int NMOD = 6 * D_;
constexpr int INCOLS = 7184;

constexpr size_t WS_BAR   = 0;
constexpr size_t WS_MOD   = 16384;
constexpr size_t WS_WG    = WS_MOD + (size_t)B_ * NMOD * 4;
constexpr size_t WS_GATE  = WS_WG + 16 * 2048 * 4;
constexpr size_t WS_F     = WS_GATE + (size_t)T_ * 16 * 4;
constexpr size_t WS_NST   = WS_F + 64 * 2048 * 4;
constexpr size_t WS_MST   = WS_NST + 1024 * 256 * 4;
constexpr size_t WS_DSC   = WS_MST + 4096;
constexpr size_t WS_WINT  = WS_DSC + 16384 * 4;
constexpr size_t WS_WOT   = WS_WINT + (size_t)7168 * 2048 * 2;
constexpr size_t WS_WQT   = WS_WOT + (size_t)2048 * 2048 * 2;
constexpr size_t WS_H     = WS_WQT + (size_t)2048 * 2048 * 2;
constexpr size_t WS_P     = WS_H + (size_t)T_ * 2048 * 2;
constexpr size_t SEG_B    = (size_t)T_ * 1024 * 2;
constexpr size_t WS_CST   = WS_P + 7 * SEG_B;
constexpr size_t WS_E8D   = WS_CST + (size_t)1024 * 256 * 256 * 2;
constexpr size_t WS_E8U   = WS_E8D + (size_t)16384 * 2048;
constexpr size_t WS_END   = WS_E8U + (size_t)16384 * 2048;
constexpr size_t WS_QC    = WS_E8D;
constexpr size_t WS_KC    = WS_E8U;
constexpr size_t WS_H8    = WS_CST;
constexpr size_t WS_QCTR  = 15360;
constexpr size_t WS_H2    = WS_P;
constexpr size_t WS_Q     = WS_H2 + (size_t)T_ * 2048 * 2;
constexpr size_t WS_IDX   = WS_Q + (size_t)T_ * 2048 * 2;
constexpr size_t WS_GW    = WS_IDX + (size_t)T_ * 128 * 4;
static_assert(WS_GW + (size_t)T_ * 128 * 4 <= WS_CST, "alias overflow");
constexpr size_t WS_X1    = WS_CST;
constexpr size_t WS_EWT   = WS_GW + (size_t)T_ * 128 * 4;
static_assert(WS_EWT + (size_t)T_ * 128 * 4 <= WS_CST, "alias overflow 2");

#ifndef G2_FP8
#define G2_FP8 1
#endif
struct Params {
    const float *x, *c, *w_ada, *b_ada, *g1, *g2, *w_in, *fox_fb, *fox_qg, *fox_kg, *conv_w, *conv_b, *m_ib, *m_fb, *m_hg, *w_out, *w_q, *sk1, *sk2, *e_down, *e_up;
    float* out; unsigned char* ws; int ph_lo, ph_hi; int swid;
};

__device__ __forceinline__ int get_tid(int swid) { int t; asm volatile("v_mbcnt_lo_u32_b32 %0, -1, 0\n\tv_mbcnt_hi_u32_b32 %0, -1, %0" : "=v"(t)); return swid * 64 + t; }
__device__ __forceinline__ void lds_barrier() { asm volatile("s_waitcnt lgkmcnt(0)\n\ts_barrier" ::: "memory"); }
__device__ __forceinline__ unsigned cvt_pk(float lo, float hi) { unsigned r; asm("v_cvt_pk_bf16_f32 %0, %1, %2" : "=v"(r) : "v"(lo), "v"(hi)); return r; }
__device__ __forceinline__ void fmac(float& acc, float a, float b) { asm("v_fmac_f32 %0, %1, %2" : "+v"(acc) : "v"(a), "v"(b)); }
__device__ __forceinline__ unsigned pack4_fp8(const f32x4 a) { int t = __builtin_amdgcn_cvt_pk_fp8_f32(a[0], a[1], 0, false); t = __builtin_amdgcn_cvt_pk_fp8_f32(a[2], a[3], t, true); return (unsigned)t; }
__device__ __forceinline__ float bf2f(unsigned short h) { return __builtin_bit_cast(float, ((unsigned)h) << 16); }
__device__ __forceinline__ float bflo(unsigned w) { return __builtin_bit_cast(float, w << 16); }
__device__ __forceinline__ float bfhi(unsigned w) { return __builtin_bit_cast(float, w & 0xffff0000u); }
__device__ __forceinline__ float wsum(float v) {
#pragma unroll
    for (int o = 32; o; o >>= 1) v += __shfl_xor(v, o);
    return v; }
__device__ __forceinline__ float wmax(float v) {
#pragma unroll
    for (int o = 32; o; o >>= 1) v = fmaxf(v, __shfl_xor(v, o));
    return v; }
__device__ __forceinline__ float logsig(float x) { return fminf(x, 0.f) - log1pf(expf(-fabsf(x))); }
__device__ __forceinline__ float sigm(float x) { return 1.f / (1.f + expf(-x)); }
__device__ __forceinline__ float silu_f(float x) { return x / (1.f + expf(-x)); }
namespace pg8 {
#define PG8_LAS __attribute__((address_space(3)))
typedef unsigned short bf16_t;
typedef short bf16x8 __attribute__((ext_vector_type(8)));
typedef float f32x4 __attribute__((ext_vector_type(4)));
typedef unsigned u32x4 __attribute__((ext_vector_type(4)));
constexpr int BM = 256, BK = 64, HALF = 128, HTB = HALF * BK * 2  , STAGE_BYTES = 8 * HTB, NXCD = 8, WGM = 8;

__host__ __device__ __forceinline__ int lds_byte(int r, int c) { const int st = (r >> 4) * 2 + (c >> 5), rr = r & 15, cc = c & 31, ob = rr * 64 + cc * 2; return st * 1024 + (ob ^ (((ob >> 9) & 1) << 5)); }
__host__ __device__ __forceinline__ void stage_rc(int b, int& R, int& C) { const int st = b / 1024, sb = b % 1024, swz = sb ^ (((sb >> 9) & 1) << 5); R = (st >> 1) * 16 + swz / 64; C = (st & 1) * 32 + (swz % 64) / 2; }
__host__ __device__ __forceinline__ int perm32(int rho) { const int n = rho >> 4, i = rho & 15; return 8 * (i >> 2) + 4 * n + (i & 3); }

struct Unit { int pm, pn; };
struct Gemm { const bf16_t* A; const bf16_t* Bt; int M, N, K; };

struct StaticOrder {
    int nM, nN, nwg, G, c;
    __host__ __device__ void init(int M, int N, int G_, int c_) { nM = M / BM; nN = N / BM; nwg = nM * nN; G = G_; c = c_; }
    __host__ __device__ bool next(int i, Unit& u) const {
        const long L = (long)i * G + c; if (L >= nwg) return false;
        int wgid = (int)L; { const int q = nwg / NXCD, r = nwg % NXCD, xcd = wgid % NXCD, off = wgid / NXCD; wgid = (xcd < r ? xcd * (q + 1) : r * (q + 1) + (xcd - r) * q) + off; }
        const int nig = WGM * nN, gid = wgid / nig, fm = gid * WGM, gsz = (nM - fm) < WGM ? (nM - fm) : WGM;
        u.pm = fm + ((wgid % nig) % gsz); u.pn = (wgid % nig) / gsz; return true;
    }
    __device__ __forceinline__ void a_ready(const Unit&) const {}
    __device__ __forceinline__ void done(const Unit&) const {}
};
struct EpiSeg {
    static constexpr bool PERM = true, AFTER_DRAIN = false;
    bf16_t* P; const float* qg; const float* kg; PG8_LAS float* X; float osc;
    __device__ __forceinline__ void operator()(const f32x4 (&acc)[2][2][4][2], const Unit& u, int wr, int wc, int fr, int fq) const {
        const int seg = u.pn >> 2; bf16_t* base = P + (size_t)seg * ((size_t)T_ * 1024);
        const int row0 = u.pm * BM + wr * 64 + fr, col0 = (u.pn & 3) * 256 + wc * 32 + 8 * fq;
        if (seg < 2) {
#pragma unroll
            for (int ai = 0; ai < 2; ++ai)
#pragma unroll
                for (int m = 0; m < 4; ++m)
#pragma unroll
                    for (int bj = 0; bj < 2; ++bj) { const f32x4 v0 = acc[ai][bj][m][0], v1 = acc[ai][bj][m][1];
                        float s = v0[0] * v0[0] + v0[1] * v0[1] + v0[2] * v0[2] + v0[3] * v0[3] + v1[0] * v1[0] + v1[1] * v1[1] + v1[2] * v1[2] + v1[3] * v1[3];
                        s += __int_as_float(__builtin_amdgcn_ds_bpermute(((fq ^ 1) * 16 + fr) * 4, __float_as_int(s))); s += __int_as_float(__builtin_amdgcn_ds_bpermute(((fq ^ 2) * 16 + fr) * 4, __float_as_int(s)));
                        if (fq == 0) X[((ai * HALF + wr * 64 + m * 16 + fr) * 2 + bj) * 4 + wc] = s * (osc * osc); }
            asm volatile("s_waitcnt lgkmcnt(0)\n\ts_barrier" ::: "memory");
            const float* gn = (seg ? kg : qg) + wc * 32 + 8 * fq;
            const f32x4 g0 = *(const f32x4*)gn, g1 = *(const f32x4*)(gn + 4);
            const float sc = seg ? 1.f : 0.08838834764831845f * 1.4426950408889634f;
#pragma unroll
            for (int ai = 0; ai < 2; ++ai)
#pragma unroll
                for (int m = 0; m < 4; ++m) { bf16_t* rowp = base + (size_t)(row0 + ai * HALF + m * 16) * 1024 + col0;
#pragma unroll
                    for (int bj = 0; bj < 2; ++bj) { const f32x4 pv = *(const PG8_LAS f32x4*)(X + ((ai * HALF + wr * 64 + m * 16 + fr) * 2 + bj) * 4);
                        const float rr = rsqrtf((pv[0] + pv[1] + pv[2] + pv[3]) * (1.f / 128.f) + EPS_) * sc * osc;
                        const f32x4 v0 = acc[ai][bj][m][0] * rr * g0, v1 = acc[ai][bj][m][1] * rr * g1;
                        u32x4 w; w.x = cvt_pk(v0[0], v0[1]); w.y = cvt_pk(v0[2], v0[3]); w.z = cvt_pk(v1[0], v1[1]); w.w = cvt_pk(v1[2], v1[3]);
                        *(u32x4*)(rowp + bj * HALF) = w; } }
            return;
        }
#pragma unroll
        for (int ai = 0; ai < 2; ++ai)
#pragma unroll
            for (int m = 0; m < 4; ++m) { bf16_t* rowp = base + (size_t)(row0 + ai * HALF + m * 16) * 1024 + col0;
#pragma unroll
                for (int bj = 0; bj < 2; ++bj) { const f32x4 v0 = acc[ai][bj][m][0] * osc, v1 = acc[ai][bj][m][1] * osc;
                    u32x4 w; w.x = cvt_pk(v0[0], v0[1]); w.y = cvt_pk(v0[2], v0[3]); w.z = cvt_pk(v1[0], v1[1]); w.w = cvt_pk(v1[2], v1[3]);
                    *(u32x4*)(rowp + bj * HALF) = w; } }
    }
};
struct EpiBf {
    static constexpr bool PERM = true, AFTER_DRAIN = false;
    bf16_t* O; int ldc; float osc;
    __device__ __forceinline__ void operator()(const f32x4 (&acc)[2][2][4][2], const Unit& u, int wr, int wc, int fr, int fq) const {
        const int row0 = u.pm * BM + wr * 64 + fr, col0 = u.pn * BM + wc * 32 + 8 * fq;
#pragma unroll
        for (int ai = 0; ai < 2; ++ai)
#pragma unroll
            for (int m = 0; m < 4; ++m) { bf16_t* rowp = O + (size_t)(row0 + ai * HALF + m * 16) * ldc + col0;
#pragma unroll
                for (int bj = 0; bj < 2; ++bj) { const f32x4 v0 = acc[ai][bj][m][0] * osc, v1 = acc[ai][bj][m][1] * osc;
                    u32x4 w; w.x = cvt_pk(v0[0], v0[1]); w.y = cvt_pk(v0[2], v0[3]); w.z = cvt_pk(v1[0], v1[1]); w.w = cvt_pk(v1[2], v1[3]);
                    *(u32x4*)(rowp + bj * HALF) = w; } }
    }
};
struct EpiRes {
    static constexpr bool PERM = false, AFTER_DRAIN = false;
    const float* X; float* O; const float* mod; int goff;
    __device__ __forceinline__ void operator()(const f32x4 (&acc)[2][2][4][2], const Unit& u, int wr, int wc, int fr, int fq) const {
        const int row0 = u.pm * BM + wr * 64 + fr, col0 = u.pn * BM + wc * 32 + 4 * fq;
        const float* gp = mod + (size_t)((u.pm * BM) >> 11) * NMOD + goff + col0;
        f32x4 gv[2][2];
#pragma unroll
        for (int bj = 0; bj < 2; ++bj)
#pragma unroll
            for (int n = 0; n < 2; ++n) gv[bj][n] = *(const f32x4*)(gp + bj * HALF + 16 * n);
#pragma unroll
        for (int ai = 0; ai < 2; ++ai)
#pragma unroll
            for (int m = 0; m < 4; ++m) { const size_t ro = (size_t)(row0 + ai * HALF + m * 16) * D_ + col0;
#pragma unroll
                for (int bj = 0; bj < 2; ++bj)
#pragma unroll
                    for (int n = 0; n < 2; ++n) { const f32x4 xv = *(const f32x4*)(X + ro + bj * HALF + 16 * n);
                        *(f32x4*)(O + ro + bj * HALF + 16 * n) = xv + gv[bj][n] * acc[ai][bj][m][n]; } }
    }
};
typedef int v8i_t __attribute__((ext_vector_type(8)));
typedef int v4i_t __attribute__((ext_vector_type(4)));
__device__ __forceinline__ v8i_t cat8(const bf16x8 a, const bf16x8 b) { const v4i_t x = __builtin_bit_cast(v4i_t, a), y = __builtin_bit_cast(v4i_t, b); v8i_t r; r[0] = x[0]; r[1] = x[1]; r[2] = x[2]; r[3] = x[3]; r[4] = y[0]; r[5] = y[1]; r[6] = y[2]; r[7] = y[3]; return r; }
template <class Epi, class Sched, bool ALIGN_EPI = false, bool SP2 = false, bool FP8 = false>
__device__ __forceinline__ void gemm_phase(PG8_LAS unsigned char* lds, const Gemm g, const Sched& S, const Epi& E, const int swid) {
    const int tid = get_tid(swid), wid = __builtin_amdgcn_readfirstlane(tid >> 6), lane = tid & 63, wr = wid >> 2, wc = wid & 3, fr = lane & 15, fq = lane >> 4;
    const int K = g.K, nt = FP8 ? K / (2 * BK) : K / BK, EB = FP8 ? 1 : 2;
    unsigned voffA[2], voffB[2];
#pragma unroll
    for (int i = 0; i < 2; ++i) { int R, C; stage_rc(tid * 16 + i * 8192, R, C); const int Rb = Epi::PERM ? ((R & ~31) + perm32(R & 31)) : R;
        voffA[i] = (unsigned)(R * K * EB + C * 2); voffB[i] = (unsigned)(Rb * K * EB + C * 2); }
    const size_t kstep = (size_t)(BK * 2);
    const size_t hstep = (size_t)HALF * K * EB;
    const size_t tstep = 2 * hstep;
    const unsigned ldsw = (unsigned)wid * 1024u;
    const int aoff = lds_byte(wr * 64 + fr, fq * 8), boff = lds_byte(wc * 32 + fr, fq * 8);
#define PG8_SA(b, h) (((b) * 2 + (h)) * HTB)
#define PG8_SB(b, h) ((4 + (b) * 2 + (h)) * HTB)
#define PG8_STAGE(bufoff, gbase, voff) do { _Pragma("unroll") for (int _i = 0; _i < 2; ++_i) { unsigned _vo = (voff)[_i]; asm volatile("" : "+v"(_vo));     \
        __builtin_amdgcn_global_load_lds((const unsigned*)((const char*)(gbase) + _vo), (PG8_LAS unsigned*)(lds + (bufoff) + ldsw + _i * 8192), 16, 0, 0); } } while (0)
#define PG8_LDA(dst, b, h) do { _Pragma("unroll") for (int m = 0; m < 4; ++m) { \
        if constexpr (FP8) { dst##8[m] = cat8(*(const PG8_LAS bf16x8*)(lds + PG8_SA(b, h) + aoff + m * 2048), *(const PG8_LAS bf16x8*)(lds + PG8_SA(b, h) + aoff + m * 2048 + 1024)); } \
        else { _Pragma("unroll") for (int k = 0; k < 2; ++k) dst[m][k] = *(const PG8_LAS bf16x8*)(lds + PG8_SA(b, h) + aoff + m * 2048 + k * 1024); } } } while (0)
#define PG8_LDB(dst, b, h) do { _Pragma("unroll") for (int n = 0; n < 2; ++n) { \
        if constexpr (FP8) { dst##8[n] = cat8(*(const PG8_LAS bf16x8*)(lds + PG8_SB(b, h) + boff + n * 2048), *(const PG8_LAS bf16x8*)(lds + PG8_SB(b, h) + boff + n * 2048 + 1024)); } \
        else { _Pragma("unroll") for (int k = 0; k < 2; ++k) dst[n][k] = *(const PG8_LAS bf16x8*)(lds + PG8_SB(b, h) + boff + n * 2048 + k * 1024); } } } while (0)
#define PG8_MMA(ai, bj, At, Bt) do { __builtin_amdgcn_s_setprio(1); _Pragma("unroll") for (int m = 0; m < 4; ++m) _Pragma("unroll") for (int n = 0; n < 2; ++n) { \
        if constexpr (FP8) { acc[ai][bj][m][n] = __builtin_amdgcn_mfma_scale_f32_16x16x128_f8f6f4(Bt##8[n], At##8[m], acc[ai][bj][m][n], 0, 0, 0, 0x7f7f7f7f, 0, 0x7f7f7f7f); } \
        else { _Pragma("unroll") for (int k = 0; k < 2; ++k) acc[ai][bj][m][n] = __builtin_amdgcn_mfma_f32_16x16x32_bf16(Bt[n][k], At[m][k], acc[ai][bj][m][n], 0, 0, 0); } } \
        __builtin_amdgcn_s_setprio(0); } while (0)
#define PG8_WAIT_V(n) asm volatile("s_waitcnt vmcnt(" #n ")" ::: "memory")
#define PG8_WAIT_L(n) asm volatile("s_waitcnt lgkmcnt(" #n ")" ::: "memory")
#define PG8_BAR __builtin_amdgcn_s_barrier()
#define PG8_SCHED __builtin_amdgcn_sched_barrier(0)
    Unit cur, nxt; int ui = 0;
    if (!S.next(0, cur)) return;
    f32x4 acc[2][2][4][2];
#pragma unroll
    for (int a = 0; a < 2; ++a)
#pragma unroll
        for (int b = 0; b < 2; ++b)
#pragma unroll
            for (int m = 0; m < 4; ++m)
#pragma unroll
                for (int n = 0; n < 2; ++n) acc[a][b][m][n] = (f32x4){0.f, 0.f, 0.f, 0.f};
    bf16x8 At[4][2], B0[2][2], B1[2][2];
    v8i_t At8[4], B08[2], B18[2];
    const char* cA = (const char*)g.A + (size_t)cur.pm * tstep; const char* cB = (const char*)g.Bt + (size_t)cur.pn * tstep;
    S.a_ready(cur);
    if constexpr (SP2) {
        PG8_STAGE(PG8_SB(0, 0), cB, voffB); PG8_STAGE(PG8_SB(0, 1), cB + hstep, voffB); PG8_STAGE(PG8_SA(0, 0), cA, voffA); PG8_STAGE(PG8_SA(0, 1), cA + hstep, voffA);
        if (wr == 1) PG8_BAR;
        PG8_WAIT_V(2); PG8_BAR;
        PG8_STAGE(PG8_SB(1, 0), cB + kstep, voffB); PG8_STAGE(PG8_SA(1, 0), cA + kstep, voffA); PG8_STAGE(PG8_SB(1, 1), cB + hstep + kstep, voffB);
        PG8_WAIT_V(6); PG8_BAR;
    } else {
        PG8_STAGE(PG8_SB(0, 0), cB, voffB); PG8_STAGE(PG8_SA(0, 0), cA, voffA); PG8_STAGE(PG8_SB(0, 1), cB + hstep, voffB); PG8_STAGE(PG8_SA(0, 1), cA + hstep, voffA);
        if (wr == 1) PG8_BAR;
        PG8_WAIT_V(4); PG8_BAR;
        PG8_STAGE(PG8_SB(1, 0), cB + kstep, voffB); PG8_STAGE(PG8_SA(1, 0), cA + kstep, voffA); PG8_STAGE(PG8_SB(1, 1), cB + hstep + kstep, voffB);
        PG8_WAIT_V(6); PG8_BAR;
    }
    for (;;) {
        const bool has_next = S.next(ui + 1, nxt);
        const char* nA = has_next ? (const char*)g.A + (size_t)nxt.pm * tstep : cA; const char* nB = has_next ? (const char*)g.Bt + (size_t)nxt.pn * tstep : cB;
        for (int t = 0; t < nt; t += 2) {
            const bool last = (t == nt - 2);
            const char* a1 = cA + (size_t)(t + 1) * kstep;
            const char* a2 = last ? nA : cA + (size_t)(t + 2) * kstep; const char* b2 = last ? nB : cB + (size_t)(t + 2) * kstep;
            const char* a3 = a2 + kstep; const char* b3 = b2 + kstep;
            if (last && has_next) S.a_ready(nxt);
            if constexpr (SP2) {
            PG8_LDB(B0, 0, 0); PG8_LDB(B1, 0, 1); PG8_SCHED; PG8_LDA(At, 0, 0); PG8_STAGE(PG8_SA(1, 1), a1 + hstep, voffA);
            PG8_WAIT_V(8); PG8_WAIT_L(0); PG8_BAR; PG8_MMA(0, 0, At, B0); PG8_MMA(0, 1, At, B1); PG8_BAR; PG8_SCHED;
            PG8_LDA(At, 0, 1); PG8_STAGE(PG8_SB(0, 0), b2, voffB); PG8_STAGE(PG8_SB(0, 1), b2 + hstep, voffB); PG8_STAGE(PG8_SA(0, 0), a2, voffA);
            PG8_WAIT_V(8); PG8_WAIT_L(0); PG8_BAR; PG8_MMA(1, 0, At, B0); PG8_MMA(1, 1, At, B1); PG8_BAR; PG8_SCHED;
            PG8_LDB(B0, 1, 0); PG8_LDB(B1, 1, 1); PG8_SCHED; PG8_LDA(At, 1, 0); PG8_STAGE(PG8_SA(0, 1), a2 + hstep, voffA);
            PG8_WAIT_V(8); PG8_WAIT_L(0); PG8_BAR; PG8_MMA(0, 0, At, B0); PG8_MMA(0, 1, At, B1); PG8_BAR; PG8_SCHED;
            PG8_LDA(At, 1, 1); PG8_STAGE(PG8_SB(1, 0), b3, voffB); PG8_STAGE(PG8_SB(1, 1), b3 + hstep, voffB); PG8_STAGE(PG8_SA(1, 0), a3, voffA);
            PG8_WAIT_V(8); PG8_WAIT_L(0); PG8_BAR; PG8_MMA(1, 0, At, B0); PG8_MMA(1, 1, At, B1); PG8_BAR; PG8_SCHED;
            } else {
            PG8_LDB(B0, 0, 0); PG8_SCHED; PG8_LDA(At, 0, 0); PG8_STAGE(PG8_SA(1, 1), a1 + hstep, voffA);
            PG8_WAIT_L(8); PG8_BAR; PG8_WAIT_L(0); PG8_MMA(0, 0, At, B0); PG8_BAR; PG8_SCHED;
            PG8_LDB(B1, 0, 1); PG8_STAGE(PG8_SB(0, 0), b2, voffB);
            PG8_BAR; PG8_WAIT_L(0); PG8_MMA(0, 1, At, B1); PG8_BAR;
            PG8_LDA(At, 0, 1); PG8_STAGE(PG8_SA(0, 0), a2, voffA);
            PG8_BAR; PG8_WAIT_L(0); PG8_MMA(1, 0, At, B0); PG8_BAR; PG8_SCHED;
            PG8_STAGE(PG8_SB(0, 1), b2 + hstep, voffB);
            PG8_WAIT_V(6); PG8_BAR; PG8_MMA(1, 1, At, B1); PG8_BAR;
            PG8_LDB(B0, 1, 0); PG8_SCHED; PG8_LDA(At, 1, 0); PG8_STAGE(PG8_SA(0, 1), a2 + hstep, voffA);
            PG8_WAIT_L(8); PG8_BAR; PG8_WAIT_L(0); PG8_MMA(0, 0, At, B0); PG8_BAR; PG8_SCHED;
            PG8_LDB(B1, 1, 1); PG8_STAGE(PG8_SB(1, 0), b3, voffB);
            PG8_BAR; PG8_WAIT_L(0); PG8_MMA(0, 1, At, B1); PG8_BAR;
            PG8_LDA(At, 1, 1); PG8_STAGE(PG8_SA(1, 0), a3, voffA);
            PG8_BAR; PG8_WAIT_L(0); PG8_MMA(1, 0, At, B0); PG8_BAR; PG8_SCHED;
            PG8_STAGE(PG8_SB(1, 1), b3 + hstep, voffB);
            PG8_WAIT_V(6); PG8_BAR; PG8_MMA(1, 1, At, B1); PG8_BAR;
            }
        }
        if constexpr (ALIGN_EPI) { if (wr == 0) PG8_BAR; }
        if constexpr (!Epi::AFTER_DRAIN) { int frl = fr, fql = fq; asm volatile("" : "+v"(frl), "+v"(fql));
            E(acc, cur, wr, wc, frl, fql); S.done(cur); }
        if (!has_next) break;
#pragma unroll
        for (int a = 0; a < 2; ++a)
#pragma unroll
            for (int b = 0; b < 2; ++b)
#pragma unroll
                for (int m = 0; m < 4; ++m)
#pragma unroll
                    for (int n = 0; n < 2; ++n) acc[a][b][m][n] = (f32x4){0.f, 0.f, 0.f, 0.f};
        cur = nxt; cA = nA; cB = nB; ++ui;
        if constexpr (ALIGN_EPI) { if (wr == 1) PG8_BAR; }
    }
    PG8_WAIT_V(0);
    if constexpr (!ALIGN_EPI) { if (wr == 0) PG8_BAR; }
    PG8_BAR;
    if constexpr (Epi::AFTER_DRAIN) { E.fused(acc, cur, wr, wc, fr, fq, lds, wid, lane); S.done(cur); }
#undef PG8_SA
#undef PG8_SB
#undef PG8_STAGE
#undef PG8_LDA
#undef PG8_LDB
#undef PG8_MMA
#undef PG8_WAIT_V
#undef PG8_WAIT_L
#undef PG8_BAR
#undef PG8_SCHED
}
}
#define XB_TMO      128
#define XB_XCNT(j)  (256  + 64 * (j))
#define XB_XSUB(j)  (1280 + 64 * (j))
#define XB_XGEN(j)  (2304 + 64 * (j))
#define XB_TOP      3328
#define XB_TOPGEN   3392
#define XCD_BAR_WORDS 3456
#define XB_SPIN_CAP (1u << 18)

__device__ __forceinline__ unsigned xb_ld(unsigned* p)              { return __hip_atomic_load(p, __ATOMIC_RELAXED, __HIP_MEMORY_SCOPE_AGENT); }
__device__ __forceinline__ unsigned xb_add(unsigned* p, unsigned v) { return __hip_atomic_fetch_add(p, v, __ATOMIC_RELAXED, __HIP_MEMORY_SCOPE_AGENT); }
__device__ __forceinline__ unsigned xb_xcc_id() { return (unsigned)__builtin_amdgcn_s_getreg((3 << 11) | 20) & 0xFu; }
#define XB_SPIN(cond, bar) do { unsigned _sp = 0; while (cond) { __builtin_amdgcn_s_sleep(1); \
    if ((++_sp & 255u) == 0u) { if (xb_ld(&(bar)[XB_TMO])) break; if (_sp > XB_SPIN_CAP) { atomicAdd(&(bar)[XB_TMO], 1u); break; } } } } while (0)

struct XcdBarrier {
    unsigned* bar; unsigned x;
    volatile LAS unsigned* st;
};

__device__ __forceinline__ XcdBarrier xcd_barrier_post(unsigned* bar, volatile LAS unsigned* st, int swid) {
    XcdBarrier b; b.bar = bar; b.x = xb_xcc_id(); b.st = st;
    if (get_tid(swid) == 0) (void)xb_add(&bar[XB_XCNT(b.x)], 1u);
    return b;
}
__device__ __forceinline__ void xcd_barrier_complete(unsigned* bar, unsigned x, unsigned& nloc, unsigned& nx) {
    const unsigned G = gridDim.x * gridDim.y * gridDim.z;
    unsigned sum, cnt, mine, sp = 0u;
    for (;;) {
        sum = 0u; cnt = 0u; mine = 0u;
#pragma unroll
        for (unsigned j = 0; j < 16; ++j) { const unsigned c = xb_ld(&bar[XB_XCNT(j)]); sum += c; cnt += (c > 0u) ? 1u : 0u; mine = (j == x) ? c : mine; }
        if (sum == G) break;
        __builtin_amdgcn_s_sleep(1);
        if ((++sp & 255u) == 0u) { if (xb_ld(&bar[XB_TMO])) break; if (sp > XB_SPIN_CAP) { atomicAdd(&bar[XB_TMO], 1u); break; } }
    }
    nloc = mine > 0u ? mine : 1u; nx = cnt > 0u ? cnt : 1u;
}

__device__ __forceinline__ void xcd_barrier(const XcdBarrier& b, int swid) {
    asm volatile("s_waitcnt vmcnt(0)" ::: "memory");
    __syncthreads();
    if (get_tid(swid) == 0) {
        unsigned* bar = b.bar;
        __builtin_amdgcn_s_waitcnt(0);
        unsigned nloc = b.st[0], nx = b.st[1];
        if (nloc == 0u) { xcd_barrier_complete(bar, b.x, nloc, nx); b.st[0] = nloc; b.st[1] = nx; }
        const unsigned old = xb_add(&bar[XB_XSUB(b.x)], 1u);
        const unsigned gen = old / nloc;
        if (old + 1u == (gen + 1u) * nloc) {
            __builtin_amdgcn_fence(__ATOMIC_RELEASE, "agent");
            asm volatile("s_waitcnt vmcnt(0)" ::: "memory");
            const unsigned og = xb_add(&bar[XB_TOP], 1u);
            const unsigned tg = og / nx;
            if (og + 1u == (tg + 1u) * nx) xb_add(&bar[XB_TOPGEN], 1u);
            else XB_SPIN(xb_ld(&bar[XB_TOPGEN]) == tg, bar);
            __builtin_amdgcn_fence(__ATOMIC_ACQUIRE, "agent");
            xb_add(&bar[XB_XGEN(b.x)], 1u);
            asm volatile("s_waitcnt vmcnt(0)" ::: "memory");
        } else {
            XB_SPIN(xb_ld(&bar[XB_XGEN(b.x)]) == gen, bar);
            __builtin_amdgcn_fence(__ATOMIC_ACQUIRE, "agent");
            asm volatile("s_waitcnt vmcnt(0)" ::: "memory");
        }
    }
    __syncthreads();
}
__device__ __forceinline__ void phase_prep(const Params& p, unsigned char* lds, int bid, int nb) {
    const int tid = get_tid(p.swid), lane = tid & 63, wave = tid >> 6;
    unsigned char* ws = p.ws;
    float* mod = (float*)(ws + WS_MOD);
    if (bid < 192) {
        float* sc = (float*)lds;
        float* red = sc + 8 * 2048;
        for (int i = tid; i < 8 * 2048; i += NTHR) sc[i] = silu_f(p.c[i]);
        __syncthreads();
        for (int it = bid; it < 192; it += nb) {
            const int col = it * 64 + lane;
            float acc[8];
#pragma unroll
            for (int b = 0; b < 8; ++b) acc[b] = 0.f;
            const float* w = p.w_ada + (size_t)(wave * 256) * NMOD + col;
            const float* s0 = sc + wave * 256;
#pragma unroll 16
            for (int k = 0; k < 256; ++k) {
                const float wv = __builtin_nontemporal_load(w + (size_t)k * NMOD);
#pragma unroll
                for (int b = 0; b < 8; ++b) acc[b] += s0[b * 2048 + k] * wv;
            }
#pragma unroll
            for (int b = 0; b < 8; ++b) red[(wave * 8 + b) * 64 + lane] = acc[b];
            __syncthreads();
            {   const int b = wave; float s = p.b_ada[col];
#pragma unroll
                for (int w2 = 0; w2 < 8; ++w2) s += red[(w2 * 8 + b) * 64 + lane];
                mod[b * NMOD + col] = s; }
            __syncthreads();
        }
    }
    __syncthreads();
    {
        float* tile = (float*)lds;
        bf16_t* WinT = (bf16_t*)(ws + WS_WINT); bf16_t* WoT = (bf16_t*)(ws + WS_WOT); bf16_t* WqT = (bf16_t*)(ws + WS_WQT);
        for (int item = bid; item < 5632; item += nb) {
            const float* src; int ld, scol; bf16_t* dst; int kt;
            if (item < 3584) { const int seg = item >> 9, rem = item & 511, ntile = rem >> 5; kt = rem & 31;
                src = p.w_in; ld = INCOLS; scol = (seg < 3 ? seg * 1024 : 3080 + (seg - 3) * 1024) + ntile * 64; dst = WinT + (size_t)(seg * 1024 + ntile * 64) * 1024; }
            else if (item < 4608) { const int rem = item - 3584, ntile = rem >> 5; kt = rem & 31; src = p.w_out; ld = 2048; scol = ntile * 64; dst = WoT + (size_t)(ntile * 64) * (G2_FP8 ? 1024 : 2048); }
            else { const int rem = item - 4608, ntile = rem >> 5; kt = rem & 31; src = p.w_q; ld = 2048; scol = ntile * 64; dst = WqT + (size_t)(ntile * 64) * 2048; }
            const int k0 = kt * 64;
#pragma unroll
            for (int ii = 0; ii < 8; ++ii) { const int k = wave + 8 * ii; tile[k * 65 + lane] = src[(size_t)(k0 + k) * ld + scol + lane]; }
            __syncthreads();
            if (item < (G2_FP8 ? 4608 : 3584)) {
#pragma unroll
                for (int ii = 0; ii < 2; ++ii) { const int n = (tid >> 4) + 32 * ii, k4 = (tid & 15) * 4;
                    f32x4 v; v[0] = tile[k4 * 65 + n] * 64.f; v[1] = tile[(k4 + 1) * 65 + n] * 64.f; v[2] = tile[(k4 + 2) * 65 + n] * 64.f; v[3] = tile[(k4 + 3) * 65 + n] * 64.f;
                    *(unsigned*)((unsigned char*)dst + (size_t)n * 2048 + k0 + k4) = pack4_fp8(v); }
            } else {
#pragma unroll
            for (int ii = 0; ii < 8; ++ii) { const int n = wave + 8 * ii; dst[(size_t)n * 2048 + k0 + lane] = (bf16_t)(cvt_pk(tile[lane * 65 + n], 0.f) & 0xffffu); }
            }
            __syncthreads();
        }
    }
    {
        bf16_t* Wg = (bf16_t*)(ws + WS_WG);
        for (int i = bid * NTHR + tid; i < 16 * 2048; i += nb * NTHR) { const int g = i >> 11, k = i & 2047; const int col = g < 8 ? 3072 + g : 7176 + (g - 8);
            Wg[i] = (bf16_t)(cvt_pk(p.w_in[(size_t)k * INCOLS + col], 0.f) & 0xffffu); }
    }
}

__device__ __forceinline__ void convert_experts(const Params& p, int bid, int nb) {
    const int tid = get_tid(p.swid); unsigned char* ws = p.ws;
    unsigned char* E8D = ws + WS_E8D; unsigned char* E8US = ws + WS_E8U;
    {
        const int lane = tid & 63, wave = tid >> 6; float* DSC = (float*)(ws + WS_DSC);
        for (int e = bid * 8 + wave; e < 16384; e += nb * 8) {
            const float* rp = p.e_down + (size_t)e * 2048;
            f32x4 v[8]; float mx = 0.f;
#pragma unroll
            for (int hf = 0; hf < 2; ++hf)
#pragma unroll
                for (int q = 0; q < 4; ++q) { v[hf * 4 + q] = *(const f32x4*)(rp + hf * 1024 + 16 * lane + 4 * q);
#pragma unroll
                    for (int c = 0; c < 4; ++c) mx = fmaxf(mx, fabsf(v[hf * 4 + q][c])); }
            mx = fmaxf(wmax(mx), 1e-30f);
            const float inv = 127.f / mx;
            if (lane == 0) DSC[e] = mx * (1.f / 127.f);
#pragma unroll
            for (int hf = 0; hf < 2; ++hf) { u32x4 o;
#pragma unroll
                for (int q = 0; q < 4; ++q) { unsigned w = 0u;
#pragma unroll
                    for (int c = 0; c < 4; ++c) w |= ((unsigned)__float2int_rn(v[hf * 4 + q][c] * inv) & 0xffu) << (8 * c);
                    o[q] = w; }
                *(u32x4*)(E8D + (size_t)e * 2048 + hf * 1024 + 16 * lane) = o; }
        }
    }
    for (int i = bid * NTHR + tid; i < 524288; i += nb * NTHR) {
        const int s = i & 255, eg = i >> 8;
        const float* sp = p.e_up + (size_t)(eg * 8) * 2048 + 8 * s;
        unsigned w[16];
#pragma unroll
        for (int q = 0; q < 8; ++q) { const f32x4 a = *(const f32x4*)(sp + (size_t)q * 2048), b = *(const f32x4*)(sp + (size_t)q * 2048 + 4); w[2 * q] = pack4_fp8(a * 32.f); w[2 * q + 1] = pack4_fp8(b * 32.f); }
        u32x4* dp = (u32x4*)(E8US + ((size_t)s * 16384 + eg * 8) * 8);
#pragma unroll
        for (int q = 0; q < 4; ++q) { u32x4 o; o.x = w[4 * q]; o.y = w[4 * q + 1]; o.z = w[4 * q + 2]; o.w = w[4 * q + 3]; dp[q] = o; }
    }
}

template <bool RES>
__device__ __forceinline__ void phase_norm(const float* xin, const bf16_t* yin, int gate_off, const float* gain, const float* mod, int shift_off, int scale_off, bf16_t* hout, unsigned char* h8out, int bid, int nb, int swid) {
    const int tid = get_tid(swid), lane = tid & 63, wave = tid >> 6;
    for (int row = bid * 8 + wave; row < T_; row += nb * 8) {
        const f32x4* xr = (const f32x4*)(xin + (size_t)row * D_);
        f32x4 v[8]; float ss = 0.f;
        const float* mb = mod + (size_t)(row >> 11) * NMOD;
#pragma unroll
        for (int j = 0; j < 8; ++j) { v[j] = xr[lane + 64 * j];
            if (RES) { const int k = 4 * (lane + 64 * j); const u32x2 yw = *(const u32x2*)(yin + (size_t)row * D_ + k); const f32x4 gv = *(const f32x4*)(mb + gate_off + k);
                v[j][0] += gv[0] * bflo(yw.x); v[j][1] += gv[1] * bfhi(yw.x); v[j][2] += gv[2] * bflo(yw.y); v[j][3] += gv[3] * bfhi(yw.y); }
            ss += v[j][0] * v[j][0] + v[j][1] * v[j][1] + v[j][2] * v[j][2] + v[j][3] * v[j][3]; }
        ss = wsum(ss);
        const float r = rsqrtf(ss * (1.f / D_) + EPS_);
        f32x4 hv[8];
#pragma unroll
        for (int j = 0; j < 8; ++j) {
            const int k = 4 * (lane + 64 * j);
            const f32x4 gn = *(const f32x4*)(gain + k), sh = *(const f32x4*)(mb + shift_off + k), scl = *(const f32x4*)(mb + scale_off + k);
#pragma unroll
            for (int e = 0; e < 4; ++e) hv[j][e] = (v[j][e] * r) * gn[e] * (1.f + scl[e]) + sh[e];
            u32x2 w; w.x = cvt_pk(hv[j][0], hv[j][1]); w.y = cvt_pk(hv[j][2], hv[j][3]);
            *(u32x2*)(hout + (size_t)row * D_ + k) = w;
            if (h8out) *(unsigned*)(h8out + (size_t)row * D_ + k) = pack4_fp8(hv[j] * 8.f);
        }
    }
}

__device__ __forceinline__ void phase_gates(const Params& p, unsigned char* lds, int bid, int nb) {
    const int tid = get_tid(p.swid), lane = tid & 63, wave = tid >> 6, r = lane & 31, hh = lane >> 5;
    unsigned char* ws = p.ws;
    const bf16_t* H = (const bf16_t*)(ws + WS_H); const bf16_t* Wg = (const bf16_t*)(ws + WS_WG); float* gate = (float*)(ws + WS_GATE);
    constexpr int WST = 4096 + 16;
    for (int i = tid; i < 16 * 256; i += NTHR) { const int g = i >> 8, c = i & 255; *(u32x4*)(lds + g * WST + c * 16) = *(const u32x4*)(Wg + (size_t)g * 2048 + c * 8); }
    __syncthreads();
    float* part = (float*)(lds + 16 * WST);
    for (int pr = bid; pr < T_ / 64; pr += nb) {
        const int t = pr * 64 + (wave >> 2) * 32 + r, kq = wave & 3;
        f32x16 acc;
#pragma unroll
        for (int i = 0; i < 16; ++i) acc[i] = 0.f;
        const bf16_t* hp = H + (size_t)t * D_ + kq * 512 + hh * 8; const unsigned char* wp = lds + (r & 15) * WST + kq * 1024 + hh * 16;
#pragma unroll 1
        for (int k0 = 0; k0 < 32; k0 += 16) {
            bf16x8 bfr[16];
#pragma unroll
            for (int j = 0; j < 16; ++j) bfr[j] = *(const bf16x8*)(hp + (k0 + j) * 16);
#pragma unroll
            for (int j = 0; j < 16; ++j) { bf16x8 a = *(const bf16x8*)(wp + (k0 + j) * 32); if (r >= 16) a = (bf16x8){0, 0, 0, 0, 0, 0, 0, 0};
                acc = __builtin_amdgcn_mfma_f32_32x32x16_bf16(a, bfr[j], acc, 0, 0, 0); }
        }
        __syncthreads();
#pragma unroll
        for (int i = 0; i < 8; ++i) part[(wave * 8 + i) * 64 + lane] = acc[i];
        __syncthreads();
        if (kq == 0) {
            float s[8];
#pragma unroll
            for (int i = 0; i < 8; ++i) s[i] = part[(wave * 8 + i) * 64 + lane] + part[((wave + 1) * 8 + i) * 64 + lane] + part[((wave + 2) * 8 + i) * 64 + lane] + part[((wave + 3) * 8 + i) * 64 + lane];
            f32x4 g0, g1; g0[0] = s[0]; g0[1] = s[1]; g0[2] = s[2]; g0[3] = s[3]; g1[0] = s[4]; g1[1] = s[5]; g1[2] = s[6]; g1[3] = s[7];
            *(f32x4*)(gate + (size_t)t * 16 + 4 * hh) = g0; *(f32x4*)(gate + (size_t)t * 16 + 8 + 4 * hh) = g1;
        }
    }
    __syncthreads();
}

__device__ __forceinline__ void phase_post(const Params& p, int bid, int nb) {
    const int tid = get_tid(p.swid), lane = tid & 63, wave = tid >> 6;
    unsigned char* ws = p.ws;
    bf16_t* Pq = (bf16_t*)(ws + WS_P); bf16_t* Pk = (bf16_t*)(ws + WS_P + SEG_B);
    const float qscale = 0.08838834764831845f * 1.4426950408889634f;
    {
        const bf16_t* Mq = (const bf16_t*)(ws + WS_P + 3 * SEG_B); const bf16_t* Mk = (const bf16_t*)(ws + WS_P + 4 * SEG_B);
        bf16_t* QC = (bf16_t*)(ws + WS_QC); bf16_t* KC = (bf16_t*)(ws + WS_KC);
        for (int item = bid; item < 256; item += nb) {
            const int which = item >> 7, tb = item & 127, cg = tid & 127, run = tid >> 7, ch0 = cg * 8, ts = tb * 128 + run * 32, sp = ts & 2047;
            const bf16_t* src = (which ? Mk : Mq) + (size_t)ts * 1024 + ch0; bf16_t* dst = (which ? KC : QC) + (size_t)ts * 1024 + ch0;
            float w0[8], w1[8], w2[8], w3[8], cb[8], x0[8], x1[8], x2[8];
#pragma unroll
            for (int e = 0; e < 8; ++e) { const int ci = which * 1024 + ch0 + e; w0[e] = p.conv_w[ci]; w1[e] = p.conv_w[2048 + ci]; w2[e] = p.conv_w[4096 + ci]; w3[e] = p.conv_w[6144 + ci]; cb[e] = p.conv_b[ci]; }
            {   u32x4 a = {0u, 0u, 0u, 0u}, b = a, c = a;
                if (sp != 0) { a = *(const u32x4*)(src - 3 * 1024); b = *(const u32x4*)(src - 2 * 1024); c = *(const u32x4*)(src - 1024); }
#pragma unroll
                for (int e = 0; e < 4; ++e) { x0[2 * e] = bflo(a[e]); x0[2 * e + 1] = bfhi(a[e]); x1[2 * e] = bflo(b[e]); x1[2 * e + 1] = bfhi(b[e]); x2[2 * e] = bflo(c[e]); x2[2 * e + 1] = bfhi(c[e]); } }
            const float osc = which ? 0.0625f : 1.f;
            for (int s = 0; s < 32; ++s) {
                const u32x4 d = *(const u32x4*)(src + (size_t)s * 1024); float x3[8], y[8];
#pragma unroll
                for (int e = 0; e < 4; ++e) { x3[2 * e] = bflo(d[e]); x3[2 * e + 1] = bfhi(d[e]); }
#pragma unroll
                for (int e = 0; e < 8; ++e) { y[e] = silu_f(w0[e] * x0[e] + w1[e] * x1[e] + w2[e] * x2[e] + w3[e] * x3[e] + cb[e]) * osc; x0[e] = x1[e]; x1[e] = x2[e]; x2[e] = x3[e]; }
                u32x4 o; o.x = cvt_pk(y[0], y[1]); o.y = cvt_pk(y[2], y[3]); o.z = cvt_pk(y[4], y[5]); o.w = cvt_pk(y[6], y[7]);
                *(u32x4*)(dst + (size_t)s * 1024) = o;
            }
        }
    }
    const float* gate = (const float*)(ws + WS_GATE); float* F = (float*)(ws + WS_F);
    for (int sq = bid * 8 + wave; sq < 64; sq += nb * 8) {
        const int b = sq >> 3, h = sq & 7; const float fb = p.fox_fb[h];
        float v[32]; float run = 0.f;
#pragma unroll
        for (int i = 0; i < 32; ++i) { const int t = lane * 32 + i; run += logsig(gate[(size_t)(b * S_ + t) * 16 + h] + fb); v[i] = run; }
        float inc = run;
#pragma unroll
        for (int o = 1; o < 64; o <<= 1) { const float u = __shfl_up(inc, o); if (lane >= o) inc += u; }
        const float excl = inc - run;
#pragma unroll
        for (int i = 0; i < 32; ++i) F[(size_t)sq * S_ + lane * 32 + i] = (v[i] + excl) * 1.4426950408889634f;
    }
}
typedef short s16x4 __attribute__((ext_vector_type(4)));
__device__ __forceinline__ s16x4 lds_tr16(const unsigned char* p) { return __builtin_amdgcn_ds_read_tr16_b64_v4i16((LAS s16x4*)p); }
__device__ __forceinline__ bf16x8 tr_frag(const unsigned char* p0, int second_bytes) {
    const s16x4 a = lds_tr16(p0), b = lds_tr16(p0 + second_bytes);
    bf16x8 f; f[0] = a[0]; f[1] = a[1]; f[2] = a[2]; f[3] = a[3]; f[4] = b[0]; f[5] = b[1]; f[6] = b[2]; f[7] = b[3]; return f;
}
__device__ __forceinline__ unsigned split_bf16(float v, float& eff) { const unsigned hi = cvt_pk(v, 0.f) & 0xffffu; const float hf = bf2f((bf16_t)hi); const unsigned lo = cvt_pk(v - hf, 0.f) & 0xffffu; eff = hf + bf2f((bf16_t)lo); return hi | (lo << 16); }
__device__ __forceinline__ void fox_unit(const Params& p, unsigned char* lds, int b, int h, int qb) {
    const int tid = get_tid(p.swid), lane = tid & 63, wave = tid >> 6, r = lane & 31, hh = lane >> 5, li = lane & 15;
    unsigned char* ws = p.ws;
    const bf16_t* Pq = (const bf16_t*)(ws + WS_P); const bf16_t* Pk = (const bf16_t*)(ws + WS_P + SEG_B); const bf16_t* Pv = (const bf16_t*)(ws + WS_P + 2 * SEG_B);
    const float* F = (const float*)(ws + WS_F) + (size_t)(b * 8 + h) * S_;
    bf16_t* Oc = (bf16_t*)(ws + WS_H);
    constexpr int KST = 272, VST = 544, BUF = 64 * KST + 64 * VST;
    constexpr float THR = 8.f;
    const int q0w = qb * 256 + wave * 32, qs = q0w + r; const int q0s = __builtin_amdgcn_readfirstlane(q0w);
    const size_t trow = (size_t)(b * S_ + qs);
    bf16x8 qf[8];
#pragma unroll
    for (int ks = 0; ks < 8; ++ks) qf[ks] = *(const bf16x8*)(Pq + trow * 1024 + h * 128 + ks * 16 + hh * 8);
    float feff; const unsigned fq2 = split_bf16(F[qs], feff);
    float m = 0.f;
    u32x4 qa; qa.x = hh ? 0u : fq2; qa.y = 0u; qa.z = hh ? 0u : 0x3f803f80u; qa.w = 0u;
    f32x16 o[4];
#pragma unroll
    for (int d = 0; d < 4; ++d)
#pragma unroll
        for (int i = 0; i < 16; ++i) o[d][i] = 0.f;
    float l = 0.f;
    const int ntile = (qb * 256 + 256) / 64;
    const int srow0 = tid >> 4, scc = tid & 15;
    const bf16_t* kg = Pk + (size_t)(b * S_ + srow0) * 1024 + h * 128 + scc * 8; const bf16_t* vg = Pv + (size_t)(b * S_ + srow0) * 1024 + h * 128 + scc * 8;
    u32x4 kr[2], vr[2]; float fr = 0.f;
    const int vb_off = 64 * KST + (4 * hh + (li >> 2)) * VST + (16 * (r >> 4) + 4 * (li & 3)) * 2;
#define FOX_AUG(dst, fval) do { float e_; const unsigned s2_ = split_bf16(-(fval), e_); u32x4 w_; w_.x = 0x3f803f80u; w_.y = 0x3f803f80u; w_.z = s2_; w_.w = 0u; *(u32x4*)(dst) = w_; } while (0)
    __syncthreads();
#pragma unroll
    for (int i = 0; i < 2; ++i) { kr[i] = *(const u32x4*)(kg + (size_t)(32 * i) * 1024); vr[i] = *(const u32x4*)(vg + (size_t)(32 * i) * 1024); }
    if (tid < 64) fr = F[tid];
#pragma unroll
    for (int i = 0; i < 2; ++i) { *(u32x4*)(lds + (srow0 + 32 * i) * KST + scc * 16) = kr[i]; *(u32x4*)(lds + 64 * KST + (srow0 + 32 * i) * VST + scc * 16) = vr[i]; }
    if (tid < 64) FOX_AUG(lds + tid * KST + 256, fr);
    __syncthreads();
    for (int kt = 0; kt < ntile; ++kt) {
        const int k0 = kt * 64; unsigned char* cur = lds + (kt & 1) * BUF; unsigned char* nxt = lds + ((kt & 1) ^ 1) * BUF;
        const bool more = kt + 1 < ntile;
        if (more) {
#pragma unroll
            for (int i = 0; i < 2; ++i) { kr[i] = *(const u32x4*)(kg + (size_t)(k0 + 64 + 32 * i) * 1024); vr[i] = *(const u32x4*)(vg + (size_t)(k0 + 64 + 32 * i) * 1024); }
            if (tid < 64) fr = F[k0 + 64 + tid];
        }
        if (k0 <= q0s + 31) {
            f32x16 s[2];
            const bf16x8 qaf = __builtin_bit_cast(bf16x8, qa);
#pragma unroll
            for (int kb = 0; kb < 2; ++kb) {
#pragma unroll
                for (int i = 0; i < 16; ++i) s[kb][i] = 0.f;
#pragma unroll
                for (int ks = 0; ks < 8; ++ks) { const bf16x8 a = *(const bf16x8*)(cur + (kb * 32 + r) * KST + ks * 32 + hh * 16);
                    s[kb] = __builtin_amdgcn_mfma_f32_32x32x16_bf16(a, qf[ks], s[kb], 0, 0, 0); }
                {   const bf16x8 a = *(const bf16x8*)(cur + (kb * 32 + r) * KST + 256);
                    s[kb] = __builtin_amdgcn_mfma_f32_32x32x16_bf16(a, qaf, s[kb], 0, 0, 0); }
            }
            if (k0 + 63 > q0s) {
                const int lim = qs - k0;
#pragma unroll
                for (int kb = 0; kb < 2; ++kb)
#pragma unroll
                    for (int i = 0; i < 16; ++i) s[kb][i] = (kb * 32 + (i & 3) + 8 * (i >> 2) + 4 * hh > lim) ? -INFINITY : s[kb][i];
            }
            float mx = fmaxf(s[0][0], s[1][0]);
#pragma unroll
            for (int i = 1; i < 16; ++i) mx = fmaxf(mx, fmaxf(s[0][i], s[1][i]));
            mx = fmaxf(mx, __shfl_xor(mx, 32));
            if (__builtin_amdgcn_ballot_w64(mx > THR) != 0ull) {
                const float mnew_f = m + fmaxf(mx, 0.f); float meff; const unsigned m2 = split_bf16(-mnew_f, meff); meff = -meff;
                const float delta = meff - m, alpha = __builtin_amdgcn_exp2f(-delta);
                m = meff; if (!hh) qa.y = m2;
                l *= alpha;
#pragma unroll
                for (int d = 0; d < 4; ++d)
#pragma unroll
                    for (int i = 0; i < 16; ++i) o[d][i] *= alpha;
#pragma unroll
                for (int kb = 0; kb < 2; ++kb)
#pragma unroll
                    for (int i = 0; i < 16; ++i) s[kb][i] -= delta;
            }
            float ps = 0.f;
#pragma unroll
            for (int kb = 0; kb < 2; ++kb)
#pragma unroll
                for (int i = 0; i < 16; ++i) { const float pv = __builtin_amdgcn_exp2f(s[kb][i]); s[kb][i] = pv; ps += pv; }
            l += ps;
#pragma unroll
            for (int kb = 0; kb < 2; ++kb)
#pragma unroll
                for (int st = 0; st < 2; ++st) {
                    u32x4 pw; pw.x = cvt_pk(s[kb][8 * st + 0], s[kb][8 * st + 1]); pw.y = cvt_pk(s[kb][8 * st + 2], s[kb][8 * st + 3]);
                    pw.z = cvt_pk(s[kb][8 * st + 4], s[kb][8 * st + 5]); pw.w = cvt_pk(s[kb][8 * st + 6], s[kb][8 * st + 7]);
                    const bf16x8 pf = __builtin_bit_cast(bf16x8, pw);
#pragma unroll
                    for (int d = 0; d < 4; ++d) { const bf16x8 vf = tr_frag(cur + vb_off + (kb * 32 + st * 16) * VST + d * 64, 8 * VST);
                        o[d] = __builtin_amdgcn_mfma_f32_32x32x16_bf16(vf, pf, o[d], 0, 0, 0); }
                }
        }
        if (more) {
#pragma unroll
            for (int i = 0; i < 2; ++i) { *(u32x4*)(nxt + (srow0 + 32 * i) * KST + scc * 16) = kr[i]; *(u32x4*)(nxt + 64 * KST + (srow0 + 32 * i) * VST + scc * 16) = vr[i]; }
            if (tid < 64) FOX_AUG(nxt + tid * KST + 256, fr);
        }
        lds_barrier();
    }
#undef FOX_AUG
    l += __shfl_xor(l, 32);
    const float inv = (G2_FP8 ? 8.f : 1.f) / l;
#pragma unroll
    for (int d = 0; d < 4; ++d)
#pragma unroll
        for (int g = 0; g < 4; ++g) {
#if G2_FP8
            f32x4 v; v[0] = o[d][4 * g] * inv; v[1] = o[d][4 * g + 1] * inv; v[2] = o[d][4 * g + 2] * inv; v[3] = o[d][4 * g + 3] * inv;
            *(unsigned*)((unsigned char*)Oc + trow * D_ + h * 128 + d * 32 + 8 * g + 4 * hh) = pack4_fp8(v);
#else
            u32x2 w; w.x = cvt_pk(o[d][4 * g] * inv, o[d][4 * g + 1] * inv); w.y = cvt_pk(o[d][4 * g + 2] * inv, o[d][4 * g + 3] * inv);
            *(u32x2*)(Oc + trow * D_ + h * 128 + d * 32 + 8 * g + 4 * hh) = w;
#endif
        }
}

__device__ __forceinline__ void mlstm_passA(const Params& p, unsigned char* lds, int unit) {
    const int tid = get_tid(p.swid), lane = tid & 63, wave = tid >> 6, r = lane & 31, hh = lane >> 5, li = lane & 15;
    const int b = unit >> 3, h = (unit >> 1) & 3, eh = unit & 1;
    unsigned char* ws = p.ws;
    const bf16_t* KC = (const bf16_t*)(ws + WS_KC); const bf16_t* Mv = (const bf16_t*)(ws + WS_P + 5 * SEG_B);
    const float* gate = (const float*)(ws + WS_GATE);
    bf16_t* Cst = (bf16_t*)(ws + WS_CST); float* nst = (float*)(ws + WS_NST); float* mst = (float*)(ws + WS_MST);
    constexpr int KST = 528, VST = 272;
    unsigned char* ksm = lds;
    unsigned char* vsm = ksm + 64 * KST;
    float* WSV = (float*)(vsm + 64 * VST);
    float* SCL = WSV + 2048;
    constexpr int STGS = 528;
    unsigned char* stg = (unsigned char*)(SCL + 128);
    __syncthreads();
    for (int cc = wave; cc < 32; cc += 8) {
        const int t = b * S_ + cc * 64 + lane;
        const float ipre = gate[(size_t)t * 16 + 8 + h] + p.m_ib[h], fpre = gate[(size_t)t * 16 + 12 + h] + p.m_fb[h];
        float bc = logsig(fpre);
#pragma unroll
        for (int o = 1; o < 64; o <<= 1) { const float u = __shfl_up(bc, o); if (lane >= o) bc += u; }
        const float a = ipre - bc; const float amax = wmax(a); const float bL = __shfl(bc, 63);
        WSV[cc * 64 + lane] = a; if (lane == 0) { SCL[cc] = bL; SCL[32 + cc] = amax; }
    }
    __syncthreads();
    if (tid == 0) { float m = 0.f; for (int cc = 0; cc < 32; ++cc) { const float mn = SCL[cc] + fmaxf(m, SCL[32 + cc]); SCL[64 + cc] = expf(SCL[cc] + m - mn); SCL[96 + cc] = mn; if (eh == 0) mst[(b * 4 + h) * 32 + cc] = m; m = mn; } }
    __syncthreads();
    for (int i = tid; i < 2048; i += NTHR) { const int cc = i >> 6; WSV[i] = expf(SCL[cc] + WSV[i] - SCL[96 + cc]); }
    f32x16 acc[4];
#pragma unroll
    for (int et = 0; et < 4; ++et)
#pragma unroll
        for (int i = 0; i < 16; ++i) acc[et][i] = 0.f;
    f32x16 accn;
#pragma unroll
    for (int i = 0; i < 16; ++i) accn[i] = 0.f;
    const int kb_off = (8 * hh + (li >> 2)) * KST + (wave * 32 + 16 * (r >> 4) + 4 * (li & 3)) * 2;
    const int vb_off = (8 * hh + (li >> 2)) * VST + (16 * (r >> 4) + 4 * (li & 3)) * 2;
    u32x4 pk[4], pv[2];
#pragma unroll
    for (int i = 0; i < 4; ++i) { const int c = tid + NTHR * i, row = c >> 5, c16 = c & 31; pk[i] = *(const u32x4*)(KC + (size_t)(b * S_ + row) * 1024 + h * 256 + c16 * 8); }
#pragma unroll
    for (int i = 0; i < 2; ++i) { const int c = tid + NTHR * i, row = c >> 4, c16 = c & 15; pv[i] = *(const u32x4*)(Mv + (size_t)(b * S_ + row) * 1024 + h * 256 + eh * 128 + c16 * 8); }
    for (int cc = 0; cc < 32; ++cc) {
        const int bhc = (b * 4 + h) * 32 + cc, t0 = b * S_ + cc * 64;
#pragma unroll
        for (int et = 0; et < 4; ++et)
#pragma unroll
            for (int g = 0; g < 4; ++g) { u32x2 o; o.x = cvt_pk(acc[et][4 * g], acc[et][4 * g + 1]); o.y = cvt_pk(acc[et][4 * g + 2], acc[et][4 * g + 3]);
                *(u32x2*)(stg + (et * 32 + r) * STGS + (wave * 32 + 8 * g + 4 * hh) * 2) = o; }
        if (eh == 0 && r == 0) {
#pragma unroll
            for (int g = 0; g < 4; ++g) { f32x4 o; o[0] = accn[4 * g]; o[1] = accn[4 * g + 1]; o[2] = accn[4 * g + 2]; o[3] = accn[4 * g + 3]; *(f32x4*)(nst + (size_t)bhc * 256 + wave * 32 + 8 * g + 4 * hh) = o; } }
        lds_barrier();
#pragma unroll
        for (int i = 0; i < 8; ++i) { const int c = tid + NTHR * i, row = c >> 5, c16 = c & 31;
            *(u32x4*)(Cst + ((size_t)bhc * 256 + eh * 128 + row) * 256 + c16 * 8) = *(const u32x4*)(stg + row * STGS + c16 * 16); }
        if (cc == 31) break;
#pragma unroll
        for (int i = 0; i < 4; ++i) { const int c = tid + NTHR * i, row = c >> 5, c16 = c & 31; *(u32x4*)(ksm + row * KST + c16 * 16) = pk[i]; }
#pragma unroll
        for (int i = 0; i < 2; ++i) { const int c = tid + NTHR * i, row = c >> 4, c16 = c & 15; const float wv = WSV[cc * 64 + row]; const u32x4 w = pv[i];
            u32x4 o; o.x = cvt_pk(bflo(w.x) * wv, bfhi(w.x) * wv); o.y = cvt_pk(bflo(w.y) * wv, bfhi(w.y) * wv); o.z = cvt_pk(bflo(w.z) * wv, bfhi(w.z) * wv); o.w = cvt_pk(bflo(w.w) * wv, bfhi(w.w) * wv);
            *(u32x4*)(vsm + row * VST + c16 * 16) = o; }
        if (cc + 1 < 31) { const int t1 = t0 + 64;
#pragma unroll
            for (int i = 0; i < 4; ++i) { const int c = tid + NTHR * i, row = c >> 5, c16 = c & 31; pk[i] = *(const u32x4*)(KC + (size_t)(t1 + row) * 1024 + h * 256 + c16 * 8); }
#pragma unroll
            for (int i = 0; i < 2; ++i) { const int c = tid + NTHR * i, row = c >> 4, c16 = c & 15; pv[i] = *(const u32x4*)(Mv + (size_t)(t1 + row) * 1024 + h * 256 + eh * 128 + c16 * 8); } }
        lds_barrier();
        const float decay = SCL[64 + cc];
#pragma unroll
        for (int et = 0; et < 4; ++et)
#pragma unroll
            for (int i = 0; i < 16; ++i) acc[et][i] *= decay;
#pragma unroll
        for (int i = 0; i < 16; ++i) accn[i] *= decay;
#pragma unroll
        for (int ks = 0; ks < 4; ++ks) {
            const bf16x8 bfr = tr_frag(ksm + kb_off + ks * 16 * KST, 4 * KST);
            {
                const f32x4 w0 = *(const f32x4*)(WSV + cc * 64 + ks * 16 + hh * 8), w1 = *(const f32x4*)(WSV + cc * 64 + ks * 16 + hh * 8 + 4);
                u32x4 wb; wb.x = cvt_pk(w0[0], w0[1]); wb.y = cvt_pk(w0[2], w0[3]); wb.z = cvt_pk(w1[0], w1[1]); wb.w = cvt_pk(w1[2], w1[3]);
                if (r != 0) wb = (u32x4){0u, 0u, 0u, 0u};
                accn = __builtin_amdgcn_mfma_f32_32x32x16_bf16(bfr, __builtin_bit_cast(bf16x8, wb), accn, 0, 0, 0); }
#pragma unroll
            for (int et = 0; et < 4; ++et) { const bf16x8 afr = tr_frag(vsm + vb_off + ks * 16 * VST + et * 64, 4 * VST);
                acc[et] = __builtin_amdgcn_mfma_f32_32x32x16_bf16(bfr, afr, acc[et], 0, 0, 0); }
        }
    }
}

__device__ __forceinline__ void mlstm_passB(const Params& p, unsigned char* lds, int unit) {
    const int tid = get_tid(p.swid), lane = tid & 63, wave = tid >> 6, r = lane & 31, hh = lane >> 5, li = lane & 15;
    const int b = unit >> 7, h = (unit >> 5) & 3, cc = unit & 31;
    unsigned char* ws = p.ws;
    const bf16_t* QC = (const bf16_t*)(ws + WS_QC); const bf16_t* KC = (const bf16_t*)(ws + WS_KC);
    const bf16_t* Mv = (const bf16_t*)(ws + WS_P + 5 * SEG_B); const bf16_t* Mo = (const bf16_t*)(ws + WS_P + 6 * SEG_B);
    const float* gate = (const float*)(ws + WS_GATE);
    const bf16_t* Cst = (const bf16_t*)(ws + WS_CST); const float* nst = (const float*)(ws + WS_NST); const float* mst = (const float*)(ws + WS_MST);
    bf16_t* Oc = (bf16_t*)(ws + WS_H);
    constexpr int QST = 528, VST = 544, WST = 144, HST = 1040;
    unsigned char* qsm = lds;
    unsigned char* ksm = qsm + 64 * QST;
    unsigned char* vsm = ksm + 64 * QST;
    unsigned char* wsm = vsm + 64 * VST;
    float* sc = (float*)(wsm + 64 * WST);
    float* hsm = (float*)lds;
    const int bhc = (b * 4 + h) * 32 + cc, t0 = b * S_ + cc * 64;
    __syncthreads();
    if (wave == 0) {
        const float ipre = gate[(size_t)(t0 + lane) * 16 + 8 + h] + p.m_ib[h], fpre = gate[(size_t)(t0 + lane) * 16 + 12 + h] + p.m_fb[h];
        float bc = logsig(fpre);
#pragma unroll
        for (int o = 1; o < 64; o <<= 1) { const float u = __shfl_up(bc, o); if (lane >= o) bc += u; }
        const float a = ipre - bc; float pm = a;
#pragma unroll
        for (int o = 1; o < 64; o <<= 1) { const float u = __shfl_up(pm, o); if (lane >= o) pm = fmaxf(pm, u); }
        const float mc = mst[bhc]; const float mt = bc + fmaxf(mc, pm);
        sc[lane] = bc - mt; sc[64 + lane] = a; sc[128 + lane] = mt; sc[192 + lane] = expf(bc + mc - mt);
    }
    bf16x8 cfr[16];
#pragma unroll
    for (int ks = 0; ks < 16; ++ks) cfr[ks] = *(const bf16x8*)(Cst + ((size_t)bhc * 256 + wave * 32 + r) * 256 + ks * 16 + hh * 8);
#pragma unroll
    for (int i = 0; i < 4; ++i) { const int c = tid + NTHR * i, row = c >> 5, c16 = c & 31;
        *(u32x4*)(qsm + row * QST + c16 * 16) = *(const u32x4*)(QC + (size_t)(t0 + row) * 1024 + h * 256 + c16 * 8);
        *(u32x4*)(ksm + row * QST + c16 * 16) = *(const u32x4*)(KC + (size_t)(t0 + row) * 1024 + h * 256 + c16 * 8);
        *(u32x4*)(vsm + row * VST + c16 * 16) = *(const u32x4*)(Mv + (size_t)(t0 + row) * 1024 + h * 256 + c16 * 8); }
    __syncthreads();
    if (wave < 3) {
        const int sb = wave >> 1, lb = wave ? 1 : 0;
        f32x16 s;
#pragma unroll
        for (int i = 0; i < 16; ++i) s[i] = 0.f;
#pragma unroll
        for (int ks = 0; ks < 16; ++ks) { const bf16x8 a = *(const bf16x8*)(ksm + (sb * 32 + r) * QST + ks * 32 + hh * 16), q = *(const bf16x8*)(qsm + (lb * 32 + r) * QST + ks * 32 + hh * 16);
            s = __builtin_amdgcn_mfma_f32_32x32x16_bf16(a, q, s, 0, 0, 0); }
        const int l = lb * 32 + r; const float bl = sc[l]; float rs = 0.f;
#pragma unroll
        for (int g = 0; g < 4; ++g) { float w[4];
#pragma unroll
            for (int e = 0; e < 4; ++e) { const int sI = sb * 32 + 8 * g + 4 * hh + e; w[e] = (sI <= l) ? s[4 * g + e] * __expf(bl + sc[64 + sI]) : 0.f; rs += w[e]; }
            u32x2 o; o.x = cvt_pk(w[0], w[1]); o.y = cvt_pk(w[2], w[3]);
            *(u32x2*)(wsm + l * WST + (sb * 32 + 8 * g + 4 * hh) * 2) = o; }
        sc[256 + l * 4 + sb * 2 + hh] = rs;
    } else if (wave == 3) {
        const int l = r;
#pragma unroll
        for (int g = 0; g < 4; ++g) { u32x2 o; o.x = 0u; o.y = 0u; *(u32x2*)(wsm + l * WST + (32 + 8 * g + 4 * hh) * 2) = o; }
        sc[256 + l * 4 + 2 + hh] = 0.f;
    }
    {
        const int l = tid & 63, part = tid >> 6; const float* np = nst + (size_t)bhc * 256 + part * 32; float s = 0.f;
#pragma unroll
        for (int q = 0; q < 4; ++q) { const u32x4 w = *(const u32x4*)(qsm + l * QST + part * 64 + q * 16);
            s += bflo(w.x) * np[8 * q] + bfhi(w.x) * np[8 * q + 1] + bflo(w.y) * np[8 * q + 2] + bfhi(w.y) * np[8 * q + 3] + bflo(w.z) * np[8 * q + 4] + bfhi(w.z) * np[8 * q + 5] + bflo(w.w) * np[8 * q + 6] + bfhi(w.w) * np[8 * q + 7]; }
        sc[512 + l * 8 + part] = s;
    }
    f32x16 acc[2];
#pragma unroll
    for (int lb = 0; lb < 2; ++lb)
#pragma unroll
        for (int i = 0; i < 16; ++i) acc[lb][i] = 0.f;
#pragma unroll
    for (int ks = 0; ks < 16; ++ks)
#pragma unroll
        for (int lb = 0; lb < 2; ++lb) { const bf16x8 q = *(const bf16x8*)(qsm + (lb * 32 + r) * QST + ks * 32 + hh * 16);
            acc[lb] = __builtin_amdgcn_mfma_f32_32x32x16_bf16(cfr[ks], q, acc[lb], 0, 0, 0); }
    __syncthreads();
#pragma unroll
    for (int lb = 0; lb < 2; ++lb) { const float it = sc[192 + lb * 32 + r];
#pragma unroll
        for (int i = 0; i < 16; ++i) acc[lb][i] *= it; }
    const int vb_off = (8 * hh + (li >> 2)) * VST + (wave * 32 + 16 * (r >> 4) + 4 * (li & 3)) * 2;
#pragma unroll
    for (int ks = 0; ks < 4; ++ks) { const bf16x8 afr = tr_frag(vsm + vb_off + ks * 16 * VST, 4 * VST);
#pragma unroll
        for (int lb = 0; lb < 2; ++lb) { if (lb == 0 && ks >= 2) continue;
            const bf16x8 wf = *(const bf16x8*)(wsm + (lb * 32 + r) * WST + ks * 32 + hh * 16);
            acc[lb] = __builtin_amdgcn_mfma_f32_32x32x16_bf16(afr, wf, acc[lb], 0, 0, 0); } }
    float ssq[2];
#pragma unroll
    for (int lb = 0; lb < 2; ++lb) { const int l = lb * 32 + r;
        const f32x4 rsv = *(const f32x4*)(sc + 256 + l * 4); const f32x4 q0 = *(const f32x4*)(sc + 512 + l * 8), q1 = *(const f32x4*)(sc + 512 + l * 8 + 4);
        const float den = (rsv[0] + rsv[1] + rsv[2] + rsv[3]) + sc[192 + l] * ((q0[0] + q0[1] + q0[2] + q0[3]) + (q1[0] + q1[1] + q1[2] + q1[3]));
        const float inv = 1.f / fmaxf(fabsf(den), __expf(-sc[128 + l]));
        float s2 = 0.f;
#pragma unroll
        for (int i = 0; i < 16; ++i) { acc[lb][i] *= inv; s2 += acc[lb][i] * acc[lb][i]; }
        s2 += __shfl_xor(s2, 32); ssq[lb] = s2; }
    __syncthreads();
    if (hh == 0) { sc[1024 + r * 8 + wave] = ssq[0]; sc[1024 + (32 + r) * 8 + wave] = ssq[1]; }
#pragma unroll
    for (int lb = 0; lb < 2; ++lb)
#pragma unroll
        for (int g = 0; g < 4; ++g) { f32x4 v; v[0] = acc[lb][4 * g]; v[1] = acc[lb][4 * g + 1]; v[2] = acc[lb][4 * g + 2]; v[3] = acc[lb][4 * g + 3];
            *(f32x4*)((unsigned char*)hsm + (lb * 32 + r) * HST + (wave * 32 + 8 * g + 4 * hh) * 4) = v; }
    __syncthreads();
#pragma unroll
    for (int i = 0; i < 4; ++i) { const int c = tid + NTHR * i, l = c >> 5, e0 = (c & 31) * 8;
        const f32x4 s0 = *(const f32x4*)(sc + 1024 + l * 8), s1 = *(const f32x4*)(sc + 1024 + l * 8 + 4);
        const float rr = rsqrtf(((s0[0] + s0[1] + s0[2] + s0[3]) + (s1[0] + s1[1] + s1[2] + s1[3])) * (1.f / 256.f) + EPS_);
        const f32x4 h0 = *(const f32x4*)((unsigned char*)hsm + l * HST + e0 * 4), h1 = *(const f32x4*)((unsigned char*)hsm + l * HST + e0 * 4 + 16);
        const f32x4 g0 = *(const f32x4*)(p.m_hg + h * 256 + e0), g1 = *(const f32x4*)(p.m_hg + h * 256 + e0 + 4);
        const u32x4 mo = *(const u32x4*)(Mo + (size_t)(t0 + l) * 1024 + h * 256 + e0);
#if G2_FP8
        const float r8 = rr * 8.f; f32x4 a, b;
        a[0] = h0[0] * r8 * g0[0] * sigm(bflo(mo.x)); a[1] = h0[1] * r8 * g0[1] * sigm(bfhi(mo.x)); a[2] = h0[2] * r8 * g0[2] * sigm(bflo(mo.y)); a[3] = h0[3] * r8 * g0[3] * sigm(bfhi(mo.y));
        b[0] = h1[0] * r8 * g1[0] * sigm(bflo(mo.z)); b[1] = h1[1] * r8 * g1[1] * sigm(bfhi(mo.z)); b[2] = h1[2] * r8 * g1[2] * sigm(bflo(mo.w)); b[3] = h1[3] * r8 * g1[3] * sigm(bfhi(mo.w));
        u32x2 o; o.x = pack4_fp8(a); o.y = pack4_fp8(b);
        *(u32x2*)((unsigned char*)Oc + (size_t)(t0 + l) * D_ + 1024 + h * 256 + e0) = o; }
#else
        u32x4 o;
        o.x = cvt_pk(h0[0] * rr * g0[0] * sigm(bflo(mo.x)), h0[1] * rr * g0[1] * sigm(bfhi(mo.x))); o.y = cvt_pk(h0[2] * rr * g0[2] * sigm(bflo(mo.y)), h0[3] * rr * g0[3] * sigm(bfhi(mo.y)));
        o.z = cvt_pk(h1[0] * rr * g1[0] * sigm(bflo(mo.z)), h1[1] * rr * g1[1] * sigm(bfhi(mo.z))); o.w = cvt_pk(h1[2] * rr * g1[2] * sigm(bflo(mo.w)), h1[3] * rr * g1[3] * sigm(bfhi(mo.w)));
        *(u32x4*)(Oc + (size_t)(t0 + l) * D_ + 1024 + h * 256 + e0) = o; }
#endif
}

__device__ __forceinline__ void ce_desc(float& a, float& b) { const float hi = fmaxf(a, b), lo = fminf(a, b); a = hi; b = lo; }
__device__ __forceinline__ void sort16_desc(float (&v)[16]) {
#pragma unroll
    for (int k = 2; k <= 16; k <<= 1)
#pragma unroll
        for (int j = k >> 1; j > 0; j >>= 1)
#pragma unroll
            for (int i = 0; i < 16; ++i) { const int l = i ^ j; if (l > i) { if ((i & k) == 0) ce_desc(v[i], v[l]); else ce_desc(v[l], v[i]); } }
}
__device__ __forceinline__ void bmerge16_desc(float (&v)[16]) {
#pragma unroll
    for (int j = 8; j > 0; j >>= 1)
#pragma unroll
        for (int i = 0; i < 16; ++i) { const int l = i ^ j; if (l > i) ce_desc(v[i], v[l]); }
}
__device__ __forceinline__ void merge_top16(float (&a)[16], const float (&b)[16]) {
#pragma unroll
    for (int i = 0; i < 16; ++i) a[i] = fmaxf(a[i], b[15 - i]);
    bmerge16_desc(a);
}
__device__ __forceinline__ float pack_idx(float v, unsigned mask, unsigned idx) { return __builtin_bit_cast(float, (__builtin_bit_cast(unsigned, v) & mask) | idx); }
__device__ __forceinline__ void top16_from_acc(const f32x16 (&acc)[4], int h, float (&out)[16]) {
    float g[4][16];
#pragma unroll
    for (int mt = 0; mt < 4; ++mt) {
#pragma unroll
        for (int i = 0; i < 16; ++i) g[mt][i] = pack_idx(acc[mt][i], 0xffffff80u, (unsigned)(32 * mt + (i & 3) + 8 * (i >> 2)) | ((unsigned)h << 2));
        sort16_desc(g[mt]);
    }
    merge_top16(g[0], g[1]); merge_top16(g[2], g[3]); merge_top16(g[0], g[2]);
    float o[16];
#pragma unroll
    for (int i = 0; i < 16; ++i) o[i] = __shfl_xor(g[0][i], 32);
    merge_top16(g[0], o);
#pragma unroll
    for (int i = 0; i < 16; ++i) out[i] = g[0][i];
}
__device__ __forceinline__ unsigned lut16(const unsigned (&P)[4], unsigned i) {
    const unsigned long long lo = (unsigned long long)P[0] | ((unsigned long long)P[1] << 32), hi = (unsigned long long)P[2] | ((unsigned long long)P[3] << 32);
    const unsigned long long s = (i & 8u) ? hi : lo;
    return (unsigned)(s >> ((i & 7u) * 8u)) & 0xffu;
}
struct CandTab { int i[50]; int j[50]; };
constexpr CandTab make_cand_tab() { CandTab t{}; int n = 0; for (int i = 0; i < 16; ++i) for (int j = 0; j < 16; ++j) if ((i + 1) * (j + 1) <= 16) { t.i[n] = i; t.j[n] = j; ++n; } return t; }
__device__ __forceinline__ void phase_topk(const Params& p, unsigned char* lds, int bid, int nb) {
    const int tid = get_tid(p.swid), lane = tid & 63, wave = tid >> 6, r = lane & 31, h = lane >> 5;
    unsigned char* ws = p.ws;
    const bf16_t* Q = (const bf16_t*)(ws + WS_Q); int* IDX = (int*)(ws + WS_IDX); float* GW = (float*)(ws + WS_GW);
    constexpr int KP = 136;
    bf16_t* KS = (bf16_t*)lds;
    for (int i = tid; i < 2 * 2048; i += NTHR) {
        const int which = i >> 11, n = (i >> 4) & 127, d0 = (i & 15) * 8; const float* sp = (which ? p.sk2 : p.sk1) + n * 128 + d0;
        const f32x4 a = *(const f32x4*)sp, b = *(const f32x4*)(sp + 4);
        u32x4 hi, lo;
        hi.x = cvt_pk(a[0], a[1]); hi.y = cvt_pk(a[2], a[3]); hi.z = cvt_pk(b[0], b[1]); hi.w = cvt_pk(b[2], b[3]);
        lo.x = cvt_pk(a[0] - bflo(hi.x), a[1] - bfhi(hi.x)); lo.y = cvt_pk(a[2] - bflo(hi.y), a[3] - bfhi(hi.y)); lo.z = cvt_pk(b[0] - bflo(hi.z), b[1] - bfhi(hi.z)); lo.w = cvt_pk(b[2] - bflo(hi.w), b[3] - bfhi(hi.w));
        *(u32x4*)(KS + ((which * 2 + 0) * 128 + n) * KP + d0) = hi; *(u32x4*)(KS + ((which * 2 + 1) * 128 + n) * KP + d0) = lo; }
    __syncthreads();
    for (int item = bid * 8 + wave; item < 512 * 8; item += nb * 8) {
        const int tt = item >> 3, hh = item & 7, t = tt * 32 + r;
        float top[2][16];
#pragma unroll
        for (int list = 0; list < 2; ++list) {
            bf16x8 qf[8];
#pragma unroll
            for (int ks = 0; ks < 8; ++ks) qf[ks] = *(const bf16x8*)(Q + (size_t)t * D_ + hh * 256 + list * 128 + ks * 16 + h * 8);
            float g[4][16];
#pragma unroll
            for (int mt = 0; mt < 4; ++mt) {
                f32x16 acc;
#pragma unroll
                for (int i = 0; i < 16; ++i) acc[i] = 0.f;
#pragma unroll
                for (int hl = 0; hl < 2; ++hl)
#pragma unroll
                    for (int ks = 0; ks < 8; ++ks) { const bf16x8 a = *(const bf16x8*)(KS + ((list * 2 + hl) * 128 + mt * 32 + r) * KP + ks * 16 + h * 8);
                        acc = __builtin_amdgcn_mfma_f32_32x32x16_bf16(a, qf[ks], acc, 0, 0, 0); }
#pragma unroll
                for (int i = 0; i < 16; ++i) g[mt][i] = pack_idx(acc[i], 0xffffff80u, (unsigned)(32 * mt + (i & 3) + 8 * (i >> 2)) | ((unsigned)h << 2));
                sort16_desc(g[mt]);
                __builtin_amdgcn_sched_barrier(0);
            }
            merge_top16(g[0], g[1]); merge_top16(g[2], g[3]); merge_top16(g[0], g[2]);
            {   float o[16];
#pragma unroll
                for (int i = 0; i < 16; ++i) o[i] = __shfl_xor(g[0][i], 32);
                merge_top16(g[0], o); }
#pragma unroll
            for (int i = 0; i < 16; ++i) top[list][i] = g[0][i];
            __builtin_amdgcn_sched_barrier(0);
        }
        unsigned P1[4], P2[4];
#pragma unroll
        for (int q = 0; q < 4; ++q) { P1[q] = 0u; P2[q] = 0u;
#pragma unroll
            for (int e = 0; e < 4; ++e) { P1[q] |= (__builtin_bit_cast(unsigned, top[0][4 * q + e]) & 127u) << (8 * e); P2[q] |= (__builtin_bit_cast(unsigned, top[1][4 * q + e]) & 127u) << (8 * e); } }
        float c[4][16];
#pragma unroll
        for (int n = 0; n < 64; ++n) {
            if (n < 50) { constexpr CandTab CT = make_cand_tab(); const int i = CT.i[n], j = CT.j[n];
                c[n >> 4][n & 15] = pack_idx(top[0][i] + top[1][j], 0xffffff00u, (unsigned)(i * 16 + j)); }
            else c[n >> 4][n & 15] = -INFINITY;
        }
        sort16_desc(c[0]); __builtin_amdgcn_sched_barrier(0); sort16_desc(c[1]); __builtin_amdgcn_sched_barrier(0); merge_top16(c[0], c[1]); __builtin_amdgcn_sched_barrier(0);
        sort16_desc(c[2]); __builtin_amdgcn_sched_barrier(0); sort16_desc(c[3]); __builtin_amdgcn_sched_barrier(0); merge_top16(c[2], c[3]); __builtin_amdgcn_sched_barrier(0); merge_top16(c[0], c[2]);
        float ex[16], sum = 0.f;
#pragma unroll
        for (int k = 0; k < 16; ++k) { ex[k] = __expf(c[0][k] - c[0][0]); sum += ex[k]; }
        const float inv = 1.f / sum;
        if (h == 0) {
            int* ip = IDX + (size_t)t * 128 + hh * 16; float* gp = GW + (size_t)t * 128 + hh * 16;
#pragma unroll
            for (int q = 0; q < 4; ++q) { u32x4 iv; f32x4 gv;
#pragma unroll
                for (int e = 0; e < 4; ++e) { const unsigned pos = __builtin_bit_cast(unsigned, c[0][4 * q + e]) & 255u;
                    iv[e] = lut16(P1, pos >> 4) * 128u + lut16(P2, pos & 15u); gv[e] = ex[4 * q + e] * inv; }
                *(u32x4*)(ip + 4 * q) = iv; *(f32x4*)(gp + 4 * q) = gv; }
        }
    }
}

typedef float f32x2 __attribute__((ext_vector_type(2)));
__device__ __forceinline__ float dot16_fp8(const u32x4 w, const float (&h)[32], int o) {
    float s = 0.f;
#pragma unroll
    for (int q = 0; q < 4; ++q) { const f32x2 lo = __builtin_amdgcn_cvt_pk_f32_fp8((int)w[q], false), hi = __builtin_amdgcn_cvt_pk_f32_fp8((int)w[q], true);
        fmac(s, lo[0], h[o + 4 * q]); fmac(s, lo[1], h[o + 4 * q + 1]); fmac(s, hi[0], h[o + 4 * q + 2]); fmac(s, hi[1], h[o + 4 * q + 3]); }
    return s;
}
template <int CTRL, int ROW_MASK, int BANK_MASK>
__device__ __forceinline__ int dpp_mov0i(int v) { return __builtin_amdgcn_update_dpp(0, v, CTRL, ROW_MASK, BANK_MASK, true); }
__device__ __forceinline__ void quant_row_i8(const bf16_t* hp, int c16, unsigned (&hq)[32], float& hsc) {
    float mx = 0.f;
#pragma unroll
    for (int i = 0; i < 16; ++i) { const u32x4 w = *(const u32x4*)(hp + 256 * (i >> 1) + 8 * (i & 1));
#pragma unroll
        for (int e = 0; e < 4; ++e) mx = fmaxf(mx, fmaxf(fabsf(bflo(w[e])), fabsf(bfhi(w[e])))); }
    mx = fmaxf(mx, __shfl_xor(mx, 1)); mx = fmaxf(mx, __shfl_xor(mx, 2)); mx = fmaxf(mx, __shfl_xor(mx, 4)); mx = fmaxf(mx, __shfl_xor(mx, 8));
    mx = fmaxf(mx, 1e-30f); const float inv = 127.f / mx; hsc = mx * (1.f / 127.f);
    asm volatile("" ::: "memory");
#pragma unroll
    for (int i = 0; i < 16; ++i) { const u32x4 w = *(const u32x4*)(hp + 256 * (i >> 1) + 8 * (i & 1));
#pragma unroll
        for (int hh = 0; hh < 2; ++hh) { const unsigned w0 = w[2 * hh], w1 = w[2 * hh + 1];
            hq[2 * i + hh] = ((unsigned)__float2int_rn(bflo(w0) * inv) & 0xffu) | (((unsigned)__float2int_rn(bfhi(w0) * inv) & 0xffu) << 8) | (((unsigned)__float2int_rn(bflo(w1) * inv) & 0xffu) << 16) | (((unsigned)__float2int_rn(bfhi(w1) * inv) & 0xffu) << 24); } }
}
__device__ __forceinline__ void phase_peer1(const Params& p, unsigned char* lds, int bid, int nb, int probe) {
    const int tid = get_tid(p.swid), lane = tid & 63, wave = tid >> 6, r = lane >> 4, c16 = lane & 15;
    unsigned char* ws = p.ws;
    const bf16_t* H2 = (const bf16_t*)(ws + WS_H2); const int* IDX = (const int*)(ws + WS_IDX); const float* GW = (const float*)(ws + WS_GW);
    unsigned* EWT = (unsigned*)(ws + WS_EWT); const float* DSC = (const float*)(ws + WS_DSC);
    const unsigned char* E8D = ws + WS_E8D + 16 * c16; const unsigned emask = probe ? 0x3ffu : 0x3fffu;
    LAS unsigned* seq = (LAS unsigned*)((LAS unsigned char*)lds + (wave * 4 + r) * 1024);
    LAS unsigned* hist = (LAS unsigned*)((LAS unsigned char*)lds + 32768 + (wave * 4 + r) * 128);
    for (int tile = bid; tile < 256; tile += nb) {
        const int tA = tile * 64 + wave * 4 + r, tB = tA + 32;
        unsigned hqA[32], hqB[32]; float hscA, hscB;
        quant_row_i8(H2 + (size_t)tA * D_ + 16 * c16, c16, hqA, hscA);
        quant_row_i8(H2 + (size_t)tB * D_ + 16 * c16, c16, hqB, hscB);
        unsigned ppA0, ppA1, ppB0, ppB1;
        {   int idx[16]; unsigned pos[16];
#pragma unroll
            for (int m = 0; m < 8; ++m) { idx[m] = IDX[(size_t)tA * 128 + c16 + 16 * m]; idx[8 + m] = IDX[(size_t)tB * 128 + c16 + 16 * m]; }
            hist[c16] = 0u;
#pragma unroll
            for (int m = 0; m < 16; ++m) pos[m] = __hip_atomic_fetch_add(&hist[idx[m] >> 10], 1u, __ATOMIC_RELAXED, __HIP_MEMORY_SCOPE_WORKGROUP);
            {   const unsigned c = hist[c16]; unsigned inc = c;
#pragma unroll
                for (int o = 1; o < 16; o <<= 1) { const unsigned u = __shfl_up(inc, o, 16); if (c16 >= o) inc += u; }
                hist[c16] = inc - c; }
#pragma unroll
            for (int m = 0; m < 16; ++m) { pos[m] += hist[idx[m] >> 10]; seq[pos[m]] = (unsigned)idx[m] | ((unsigned)(c16 + 16 * (m & 7)) << 14) | ((unsigned)(m >> 3) << 21); }
            ppA0 = pos[0] | (pos[1] << 8) | (pos[2] << 16) | (pos[3] << 24); ppA1 = pos[4] | (pos[5] << 8) | (pos[6] << 16) | (pos[7] << 24);
            ppB0 = pos[8] | (pos[9] << 8) | (pos[10] << 16) | (pos[11] << 24); ppB1 = pos[12] | (pos[13] << 8) | (pos[14] << 16) | (pos[15] << 24);
        }
        u32x4 cur[8], nxt[8]; unsigned ecur = seq[0], enxt = 0u;
        {   const unsigned char* rp = E8D + (size_t)(ecur & emask) * 2048;
#pragma unroll
            for (int q = 0; q < 8; ++q) cur[q] = *(const u32x4*)(rp + 256 * q); }
        for (int s = 0; s < 256; ++s) {
            if (s + 1 < 256) { enxt = seq[s + 1]; const unsigned char* rp = E8D + (size_t)(enxt & emask) * 2048;
#pragma unroll
                for (int q = 0; q < 8; ++q) nxt[q] = *(const u32x4*)(rp + 256 * q); }
            int a0 = 0, a1 = 0, b0 = 0, b1 = 0;
#pragma unroll
            for (int q = 0; q < 8; ++q) {
                a0 = __builtin_amdgcn_sdot4((int)cur[q][0], (int)hqA[4 * q], a0, false); a1 = __builtin_amdgcn_sdot4((int)cur[q][1], (int)hqA[4 * q + 1], a1, false);
                a0 = __builtin_amdgcn_sdot4((int)cur[q][2], (int)hqA[4 * q + 2], a0, false); a1 = __builtin_amdgcn_sdot4((int)cur[q][3], (int)hqA[4 * q + 3], a1, false);
                b0 = __builtin_amdgcn_sdot4((int)cur[q][0], (int)hqB[4 * q], b0, false); b1 = __builtin_amdgcn_sdot4((int)cur[q][1], (int)hqB[4 * q + 1], b1, false);
                b0 = __builtin_amdgcn_sdot4((int)cur[q][2], (int)hqB[4 * q + 2], b0, false); b1 = __builtin_amdgcn_sdot4((int)cur[q][3], (int)hqB[4 * q + 3], b1, false); }
            int d = ((ecur >> 21) & 1u) ? (b0 + b1) : (a0 + a1);
            d += dpp_mov0i<0x111, 0xf, 0xf>(d); d += dpp_mov0i<0x112, 0xf, 0xf>(d); d += dpp_mov0i<0x114, 0xf, 0xe>(d); d += dpp_mov0i<0x118, 0xf, 0xc>(d);
            if (c16 == 15) seq[s] = (unsigned)d;
#pragma unroll
            for (int q = 0; q < 8; ++q) cur[q] = nxt[q];
            ecur = enxt;
        }
        if (probe) continue;
#pragma unroll
        for (int tk = 0; tk < 2; ++tk) {
            const int t = tk ? tB : tA; const float hsc = tk ? hscB : hscA;
            unsigned* ep = EWT + (size_t)(t >> 6) * 8192 + (t & 63) * 4;
#pragma unroll
            for (int m = 0; m < 8; ++m) { const int j = c16 + 16 * m; const int ix = IDX[(size_t)t * 128 + j];
                const unsigned ps = ((tk ? (m < 4 ? ppB0 : ppB1) : (m < 4 ? ppA0 : ppA1)) >> (8 * (m & 3))) & 0xffu;
                const float a = (float)(int)seq[ps] * hsc * DSC[ix];
                const float w = GW[(size_t)t * 128 + j] * 0.5f * a * (1.f + erff(a * 0.7071067811865476f));
                ep[(j >> 2) * 256 + (j & 3)] = (cvt_pk(0.f, w) & 0xffff0000u) | (unsigned)ix; }
        }
    }
}
__device__ __forceinline__ void phase_peer2(const Params& p, unsigned char* lds, int bid, int nb) {
    const int tid = get_tid(p.swid), lane = tid & 63, wave = tid >> 6;
    unsigned char* ws = p.ws;
    const unsigned* EWT = (const unsigned*)(ws + WS_EWT); const bf16_t* Y = (const bf16_t*)(ws + WS_X1); const float* mod = (const float*)(ws + WS_MOD);
    for (int si = bid; si < 256; si += nb) {
        const int s = (si & 7) * 32 + (si >> 3);
        __syncthreads();
        {   const u32x4* sp = (const u32x4*)(ws + WS_E8U + (size_t)s * 131072);
#pragma unroll
            for (int i = 0; i < 16; ++i) ((u32x4*)lds)[tid + NTHR * i] = sp[tid + NTHR * i]; }
        __syncthreads();
        const int tb0 = ((si >> 5) * 32 + wave) & 255;
        unsigned cur[16], nxt[16];
        {   const u32x4* wp = (const u32x4*)(EWT + (size_t)tb0 * 8192) + lane;
#pragma unroll
            for (int u = 0; u < 4; ++u) { const u32x4 v = wp[u * 64]; cur[4 * u] = v.x; cur[4 * u + 1] = v.y; cur[4 * u + 2] = v.z; cur[4 * u + 3] = v.w; } }
        float acc[8];
#pragma unroll
        for (int c = 0; c < 8; ++c) acc[c] = 0.f;
        f32x4 xa = {0.f, 0.f, 0.f, 0.f}, xb = xa;
        for (int q = 0; q < 256; ++q) {
            const int tb = (tb0 + 8 * (q >> 3)) & 255, g = q & 7;
            if (q + 1 < 256) { const int tbn = (tb0 + 8 * ((q + 1) >> 3)) & 255; const u32x4* wp = (const u32x4*)(EWT + (size_t)tbn * 8192 + ((q + 1) & 7) * 1024) + lane;
#pragma unroll
                for (int u = 0; u < 4; ++u) { const u32x4 v = wp[u * 64]; nxt[4 * u] = v.x; nxt[4 * u + 1] = v.y; nxt[4 * u + 2] = v.z; nxt[4 * u + 3] = v.w; } }
            const int t = tb * 64 + lane;
            if (g == 0) { xa = *(const f32x4*)(p.x + (size_t)t * D_ + 8 * s); xb = *(const f32x4*)(p.x + (size_t)t * D_ + 8 * s + 4);
                const u32x4 yw = *(const u32x4*)(Y + (size_t)t * D_ + 8 * s); const float* g1 = mod + (size_t)(t >> 11) * NMOD + 2 * D_ + 8 * s; const f32x4 ha = *(const f32x4*)g1, hb = *(const f32x4*)(g1 + 4);
                xa[0] += ha[0] * bflo(yw.x); xa[1] += ha[1] * bfhi(yw.x); xa[2] += ha[2] * bflo(yw.y); xa[3] += ha[3] * bfhi(yw.y); xb[0] += hb[0] * bflo(yw.z); xb[1] += hb[1] * bfhi(yw.z); xb[2] += hb[2] * bflo(yw.w); xb[3] += hb[3] * bfhi(yw.w); }
            u32x2 row[16];
#pragma unroll
            for (int u = 0; u < 16; ++u) row[u] = *(const LAS u32x2*)(unsigned)((cur[u] << 3) & 0x1fff8u);
#pragma unroll
            for (int u = 0; u < 16; ++u) {
                const float w = __builtin_bit_cast(float, cur[u]);
                const f32x2 v0 = __builtin_amdgcn_cvt_pk_f32_fp8((int)row[u].x, false), v1 = __builtin_amdgcn_cvt_pk_f32_fp8((int)row[u].x, true), v2 = __builtin_amdgcn_cvt_pk_f32_fp8((int)row[u].y, false), v3 = __builtin_amdgcn_cvt_pk_f32_fp8((int)row[u].y, true);
                fmac(acc[0], w, v0[0]); fmac(acc[1], w, v0[1]); fmac(acc[2], w, v1[0]); fmac(acc[3], w, v1[1]); fmac(acc[4], w, v2[0]); fmac(acc[5], w, v2[1]); fmac(acc[6], w, v3[0]); fmac(acc[7], w, v3[1]);
            }
            if (g == 7) {
                const float* g2 = mod + (size_t)(t >> 11) * NMOD + 5 * D_ + 8 * s;
                const f32x4 ga = *(const f32x4*)g2, gb = *(const f32x4*)(g2 + 4);
                f32x4 oa, ob;
#pragma unroll
                for (int c = 0; c < 4; ++c) { oa[c] = xa[c] + ga[c] * acc[c] * (1.f / 32.f); ob[c] = xb[c] + gb[c] * acc[4 + c] * (1.f / 32.f); }
                *(f32x4*)(p.out + (size_t)t * D_ + 8 * s) = oa; *(f32x4*)(p.out + (size_t)t * D_ + 8 * s + 4) = ob;
#pragma unroll
                for (int c = 0; c < 8; ++c) acc[c] = 0.f;
            }
#pragma unroll
            for (int u = 0; u < 16; ++u) cur[u] = nxt[u];
        }
    }
}

typedef const __attribute__((address_space(4))) Params* KargPtr;
__device__ __forceinline__ Params load_params(int swid = 0) {
#if defined(__HIP_DEVICE_COMPILE__)
    KargPtr kp = (KargPtr)__builtin_amdgcn_kernarg_segment_ptr(); asm volatile("" : "+s"(kp)); Params r; __builtin_memcpy(&r, kp, sizeof(Params)); r.swid = swid; return r;
#else
    return Params{};
#endif
}
constexpr int N_PHASES = 12;
constexpr int LDS_BYTES = 152 * 1024;
__global__ void __launch_bounds__(NTHR) fwd_kernel(Params p_arg) {
    extern __shared__ __attribute__((aligned(16))) unsigned char lds[];
    const int bid = blockIdx.x, nb = gridDim.x, swid = __builtin_amdgcn_readfirstlane((int)threadIdx.x >> 6);
    unsigned char* ws = p_arg.ws;
    volatile LAS unsigned* xbst = (volatile LAS unsigned*)((LAS unsigned char*)lds + LDS_BYTES - 16);
    if (get_tid(swid) == 0) { xbst[0] = 0u; xbst[1] = 0u; xbst[2] = 0u; xbst[3] = 0u; }
    __syncthreads();
    if ((p_arg.ph_hi - p_arg.ph_lo) > 1) (void)xcd_barrier_post((unsigned*)(ws + WS_BAR), xbst, swid);
#ifdef ONLY_PHASE
#define IN(k) ((k) == ONLY_PHASE && p.ph_lo <= (k) && (k) < p.ph_hi)
#else
#define IN(k) (p.ph_lo <= (k) && (k) < p.ph_hi)
#endif
#define SEAM(k) do { const Params p = load_params(); if (p.ph_lo <= (k) && (k) + 1 < p.ph_hi) { XcdBarrier bar; bar.bar = (unsigned*)(p.ws + WS_BAR); bar.x = xb_xcc_id(); bar.st = xbst; xcd_barrier(bar, swid); } } while (0)
#ifndef REPEAT_MASK
#define REPEAT_MASK 0
#endif
#define REP(k) for (int rep_ = 0; rep_ < (((REPEAT_MASK) >> (k)) & 1) + 1; ++rep_)
    REP(0) { const Params p = load_params(swid); if (IN(0)) { unsigned char* ws = p.ws; const float* mod = (const float*)(ws + WS_MOD); (void)mod;
        phase_prep(p, lds, bid, nb);
    } }
    SEAM(0);
    REP(1) { const Params p = load_params(swid); if (IN(1)) { unsigned char* ws = p.ws; const float* mod = (const float*)(ws + WS_MOD); (void)mod;
        phase_norm<false>(p.x, nullptr, 0, p.g1, mod, 0, D_, (bf16_t*)(ws + WS_H), ws + WS_H8, bid, nb, swid);
    } }
    SEAM(1);
    REP(2) { const Params p = load_params(swid); if (IN(2)) { unsigned char* ws = p.ws; const float* mod = (const float*)(ws + WS_MOD); (void)mod;
        phase_gates(p, lds, bid, nb);
        { pg8::Gemm g{(const bf16_t*)(ws + WS_H8), (const bf16_t*)(ws + WS_WINT), T_, 7168, D_}; pg8::StaticOrder S; S.init(T_, 7168, nb, bid);
        pg8::EpiSeg E{(bf16_t*)(ws + WS_P), p.fox_qg, p.fox_kg, (LAS float*)((LAS unsigned char*)lds + 131072), 1.f / 512.f}; pg8::gemm_phase<pg8::EpiSeg, pg8::StaticOrder, true, true, true>((LAS unsigned char*)lds, g, S, E, swid); }
    } }
    SEAM(2);
    REP(3) { const Params p = load_params(swid); if (IN(3)) { unsigned char* ws = p.ws; const float* mod = (const float*)(ws + WS_MOD); (void)mod;
        phase_post(p, bid, nb);
    } }
    SEAM(3);
    REP(4) { const Params p = load_params(swid); if (IN(4)) { unsigned char* ws = p.ws; const float* mod = (const float*)(ws + WS_MOD); (void)mod;
        { for (int u = bid; u < 64; u += nb) mlstm_passA(p, lds, u);
        unsigned* qctr = (unsigned*)(ws + WS_QCTR) + rep_; LAS int* slot = (LAS int*)((LAS unsigned char*)lds + LDS_BYTES - 32);
        const int tid = get_tid(swid);
        for (;;) { __syncthreads(); if (tid == 0) *slot = (int)atomicAdd(qctr, 1u); __syncthreads(); const int u = *slot; if (u >= 512) break;
            const int bh = u & 63; fox_unit(p, lds, bh >> 3, bh & 7, 7 - (u >> 6)); } }
    } }
    SEAM(4);
    REP(5) { const Params p = load_params(swid); if (IN(5)) { unsigned char* ws = p.ws; const float* mod = (const float*)(ws + WS_MOD); (void)mod;
        { for (int u = bid; u < 1024; u += nb) mlstm_passB(p, lds, u); }
    } }
    SEAM(5);
    REP(6) { const Params p = load_params(swid); if (IN(6)) { unsigned char* ws = p.ws; const float* mod = (const float*)(ws + WS_MOD); (void)mod;
        { pg8::Gemm g{(const bf16_t*)(ws + WS_H), (const bf16_t*)(ws + WS_WOT), T_, D_, D_}; pg8::StaticOrder S; S.init(T_, D_, nb, bid);
        pg8::EpiBf E{(bf16_t*)(ws + WS_X1), D_, G2_FP8 ? 1.f / 512.f : 1.f}; pg8::gemm_phase<pg8::EpiBf, pg8::StaticOrder, true, true, G2_FP8 != 0>((LAS unsigned char*)lds, g, S, E, swid); }
    } }
    SEAM(6);
    REP(7) { const Params p = load_params(swid); if (IN(7)) { unsigned char* ws = p.ws; const float* mod = (const float*)(ws + WS_MOD); (void)mod;
        convert_experts(p, bid, nb);
    } }
    REP(7) { const Params p = load_params(swid); if (IN(7)) { unsigned char* ws = p.ws; const float* mod = (const float*)(ws + WS_MOD); (void)mod;
        phase_norm<true>(p.x, (const bf16_t*)(ws + WS_X1), 2 * D_, p.g2, mod, 3 * D_, 4 * D_, (bf16_t*)(ws + WS_H2), nullptr, bid, nb, swid);
    } }
    SEAM(7);
    REP(8) { const Params p = load_params(swid); if (IN(8)) { unsigned char* ws = p.ws; const float* mod = (const float*)(ws + WS_MOD); (void)mod;
        { pg8::Gemm g{(const bf16_t*)(ws + WS_H2), (const bf16_t*)(ws + WS_WQT), T_, D_, D_}; pg8::StaticOrder S; S.init(T_, D_, nb, bid);
        pg8::EpiBf E{(bf16_t*)(ws + WS_Q), D_, 1.f}; pg8::gemm_phase<pg8::EpiBf, pg8::StaticOrder, true, true>((LAS unsigned char*)lds, g, S, E, swid); }
    } }
    SEAM(8);
    REP(9) { const Params p = load_params(swid); if (IN(9)) { unsigned char* ws = p.ws; const float* mod = (const float*)(ws + WS_MOD); (void)mod;
        phase_topk(p, lds, bid, nb);
    } }
    SEAM(9);
    REP(10) { const Params p = load_params(swid); if (IN(10)) { unsigned char* ws = p.ws; const float* mod = (const float*)(ws + WS_MOD); (void)mod;
#ifdef PROBE_L2
        phase_peer1(p, lds, bid, nb, rep_);
#else
        phase_peer1(p, lds, bid, nb, 0);
#endif
    } }
    SEAM(10);
    REP(11) { const Params p = load_params(swid); if (IN(11)) { unsigned char* ws = p.ws; const float* mod = (const float*)(ws + WS_MOD); (void)mod;
        phase_peer2(p, lds, bid, nb);
    } }
#undef IN
#undef SEAM
}

#ifndef ONE_LAUNCH
#define ONE_LAUNCH 1
#endif
extern "C" void kernel_launch(void* const* d_in, const int* in_sizes, int n_in, void* d_out, int out_size, void* d_ws, size_t ws_size, hipStream_t stream) {
    static int grid = 0;
    if (grid == 0) {
        int dev = 0, cus = 0, per_cu = 0;
        if (n_in != 21 || ws_size < WS_END) { fprintf(stderr, "kernel_launch: unexpected n_in %d / ws_size %zu (need %zu)\n", n_in, ws_size, (size_t)WS_END); grid = -1; return; }
        hipGetDevice(&dev); hipDeviceGetAttribute(&cus, hipDeviceAttributeMultiprocessorCount, dev);
        if (hipFuncSetAttribute((const void*)fwd_kernel, hipFuncAttributeMaxDynamicSharedMemorySize, LDS_BYTES) != hipSuccess) { fprintf(stderr, "kernel_launch: hipFuncSetAttribute failed\n"); grid = -1; return; }
        if (hipOccupancyMaxActiveBlocksPerMultiprocessor(&per_cu, (const void*)fwd_kernel, NTHR, LDS_BYTES) != hipSuccess || per_cu < 1) { fprintf(stderr, "kernel_launch: occupancy query says %d\n", per_cu); (void)hipGetLastError(); }
        grid = cus > 0 ? cus : 256;
    }
    if (grid < 0) return;
    Params p{};
    const float** pp = (const float**)&p;
    for (int i = 0; i < 21; ++i) pp[i] = (const float*)d_in[i];
    p.out = (float*)d_out; p.ws = (unsigned char*)d_ws;
    hipMemsetAsync((char*)d_ws + WS_BAR, 0, 16384, stream);
#if ONE_LAUNCH
    p.ph_lo = 0; p.ph_hi = N_PHASES;
    void* args[] = {&p};
    hipError_t e = hipLaunchCooperativeKernel((const void*)fwd_kernel, dim3(grid), dim3(NTHR), args, LDS_BYTES, stream);
    if (e != hipSuccess) fprintf(stderr, "cooperative launch failed: %s (grid %d)\n", hipGetErrorString(e), grid);
#else
    for (int ph = 0; ph < N_PHASES; ++ph) { p.ph_lo = ph; p.ph_hi = ph + 1; hipLaunchKernelGGL(fwd_kernel, dim3(grid), dim3(NTHR), LDS_BYTES, stream, p); }
#endif
}
```

```cpp
#include <hip/hip_runtime.h>
#include <cstdio>
#include <cstdint>

#define GAS __attribute__((address_space(1)))
#define LAS __attribute__((address_space(3)))
typedef unsigned short bf16_t;
typedef short bf16x8 __attribute__((ext_vector_type(8)));
typedef float f32x4 __attribute__((ext_vector_type(4)));
typedef float f32x16 __attribute__((ext_vector_type(16)));
typedef unsigned u32x4 __attribute__((ext_vector_type(4)));
typedef unsigned u32x2 __attribute__((ext_vector_type(2)));

constexpr int T_ = 16384, D_ = 2048, B_ = 8, S_ = 2048, NTHR = 512;
constexpr float EPS_ = 1e-6f;
constexpr int NMOD = 6 * D_;
constexpr int INCOLS = 7184;

constexpr size_t WS_BAR   = 0;
constexpr size_t WS_MOD   = 16384;
constexpr size_t WS_WG    = WS_MOD + (size_t)B_ * NMOD * 4;
constexpr size_t WS_GATE  = WS_WG + 16 * 2048 * 4;
constexpr size_t WS_F     = WS_GATE + (size_t)T_ * 16 * 4;
constexpr size_t WS_NST   = WS_F + 64 * 2048 * 4;
constexpr size_t WS_MST   = WS_NST + 1024 * 256 * 4;
constexpr size_t WS_DSC   = WS_MST + 4096;
constexpr size_t WS_WINT  = WS_DSC + 16384 * 4;
constexpr size_t WS_WOT   = WS_WINT + (size_t)7168 * 2048 * 2;
constexpr size_t WS_WQT   = WS_WOT + (size_t)2048 * 2048 * 2;
constexpr size_t WS_H     = WS_WQT + (size_t)2048 * 2048 * 2;
constexpr size_t WS_P     = WS_H + (size_t)T_ * 2048 * 2;
constexpr size_t SEG_B    = (size_t)T_ * 1024 * 2;
constexpr size_t WS_CST   = WS_P + 7 * SEG_B;
constexpr size_t WS_E8D   = WS_CST + (size_t)1024 * 256 * 256 * 2;
constexpr size_t WS_E8U   = WS_E8D + (size_t)16384 * 2048;
constexpr size_t WS_END   = WS_E8U + (size_t)16384 * 2048;
constexpr size_t WS_QC    = WS_E8D;
constexpr size_t WS_KC    = WS_E8U;
constexpr size_t WS_H8    = WS_CST;
constexpr size_t WS_QCTR  = 15360;
constexpr size_t WS_H2    = WS_P;
constexpr size_t WS_Q     = WS_H2 + (size_t)T_ * 2048 * 2;
constexpr size_t WS_IDX   = WS_Q + (size_t)T_ * 2048 * 2;
constexpr size_t WS_GW    = WS_IDX + (size_t)T_ * 128 * 4;
static_assert(WS_GW + (size_t)T_ * 128 * 4 <= WS_CST, "alias overflow");
constexpr size_t WS_X1    = WS_CST;
constexpr size_t WS_EWT   = WS_GW + (size_t)T_ * 128 * 4;
static_assert(WS_EWT + (size_t)T_ * 128 * 4 <= WS_CST, "alias overflow 2");

#ifndef G2_FP8
#define G2_FP8 1
#endif
struct Params {
    const float *x, *c, *w_ada, *b_ada, *g1, *g2, *w_in, *fox_fb, *fox_qg, *fox_kg, *conv_w, *conv_b, *m_ib, *m_fb, *m_hg, *w_out, *w_q, *sk1, *sk2, *e_down, *e_up;
    float* out; unsigned char* ws; int ph_lo, ph_hi; int swid;
};

__device__ __forceinline__ int get_tid(int swid) { int t; asm volatile("v_mbcnt_lo_u32_b32 %0, -1, 0\n\tv_mbcnt_hi_u32_b32 %0, -1, %0" : "=v"(t)); return swid * 64 + t; }
__device__ __forceinline__ void lds_barrier() { asm volatile("s_waitcnt lgkmcnt(0)\n\ts_barrier" ::: "memory"); }
__device__ __forceinline__ unsigned cvt_pk(float lo, float hi) { unsigned r; asm("v_cvt_pk_bf16_f32 %0, %1, %2" : "=v"(r) : "v"(lo), "v"(hi)); return r; }
__device__ __forceinline__ void fmac(float& acc, float a, float b) { asm("v_fmac_f32 %0, %1, %2" : "+v"(acc) : "v"(a), "v"(b)); }
__device__ __forceinline__ unsigned pack4_fp8(const f32x4 a) { int t = __builtin_amdgcn_cvt_pk_fp8_f32(a[0], a[1], 0, false); t = __builtin_amdgcn_cvt_pk_fp8_f32(a[2], a[3], t, true); return (unsigned)t; }
__device__ __forceinline__ void pkfma_hi(unsigned& acc, unsigned w, unsigned v) { asm("v_pk_fma_f16 %0, %1, %2, %0 op_sel:[1,0,0] op_sel_hi:[1,1,1]" : "+v"(acc) : "v"(w), "v"(v)); }
__device__ __forceinline__ unsigned addr_lo16x8(unsigned w) { unsigned r; asm("v_lshlrev_b32_sdwa %0, 3, %1 dst_sel:DWORD dst_unused:UNUSED_PAD src0_sel:DWORD src1_sel:WORD_0" : "=v"(r) : "v"(w)); return r; }
__device__ __forceinline__ float h16(unsigned pk, int hi) { return (float)__builtin_bit_cast(_Float16, (unsigned short)(hi ? pk >> 16 : pk & 0xffffu)); }
__device__ __forceinline__ float bf2f(unsigned short h) { return __builtin_bit_cast(float, ((unsigned)h) << 16); }
__device__ __forceinline__ float bflo(unsigned w) { return __builtin_bit_cast(float, w << 16); }
__device__ __forceinline__ float bfhi(unsigned w) { return __builtin_bit_cast(float, w & 0xffff0000u); }
__device__ __forceinline__ float wsum(float v) {
#pragma unroll
    for (int o = 32; o; o >>= 1) v += __shfl_xor(v, o);
    return v; }
__device__ __forceinline__ float wmax(float v) {
#pragma unroll
    for (int o = 32; o; o >>= 1) v = fmaxf(v, __shfl_xor(v, o));
    return v; }
__device__ __forceinline__ float logsig(float x) { return fminf(x, 0.f) - log1pf(expf(-fabsf(x))); }
__device__ __forceinline__ float sigm(float x) { return 1.f / (1.f + expf(-x)); }
__device__ __forceinline__ float silu_f(float x) { return x / (1.f + expf(-x)); }
namespace pg8 {
#define PG8_LAS __attribute__((address_space(3)))
typedef unsigned short bf16_t;
typedef short bf16x8 __attribute__((ext_vector_type(8)));
typedef float f32x4 __attribute__((ext_vector_type(4)));
typedef unsigned u32x4 __attribute__((ext_vector_type(4)));
constexpr int BM = 256, BK = 64, HALF = 128, HTB = HALF * BK * 2  , STAGE_BYTES = 8 * HTB, NXCD = 8, WGM = 8;

__host__ __device__ __forceinline__ int lds_byte(int r, int c) { const int st = (r >> 4) * 2 + (c >> 5), rr = r & 15, cc = c & 31, ob = rr * 64 + cc * 2; return st * 1024 + (ob ^ (((ob >> 9) & 1) << 5)); }
__host__ __device__ __forceinline__ void stage_rc(int b, int& R, int& C) { const int st = b / 1024, sb = b % 1024, swz = sb ^ (((sb >> 9) & 1) << 5); R = (st >> 1) * 16 + swz / 64; C = (st & 1) * 32 + (swz % 64) / 2; }
__host__ __device__ __forceinline__ int perm32(int rho) { const int n = rho >> 4, i = rho & 15; return 8 * (i >> 2) + 4 * n + (i & 3); }

struct Unit { int pm, pn; };
struct Gemm { const bf16_t* A; const bf16_t* Bt; int M, N, K; };

struct StaticOrder {
    int nM, nN, nwg, G, c;
    __host__ __device__ void init(int M, int N, int G_, int c_) { nM = M / BM; nN = N / BM; nwg = nM * nN; G = G_; c = c_; }
    __host__ __device__ bool next(int i, Unit& u) const {
        const long L = (long)i * G + c; if (L >= nwg) return false;
        int wgid = (int)L; { const int q = nwg / NXCD, r = nwg % NXCD, xcd = wgid % NXCD, off = wgid / NXCD; wgid = (xcd < r ? xcd * (q + 1) : r * (q + 1) + (xcd - r) * q) + off; }
        const int nig = WGM * nN, gid = wgid / nig, fm = gid * WGM, gsz = (nM - fm) < WGM ? (nM - fm) : WGM;
        u.pm = fm + ((wgid % nig) % gsz); u.pn = (wgid % nig) / gsz; return true;
    }
    __device__ __forceinline__ void a_ready(const Unit&) const {}
    __device__ __forceinline__ void done(const Unit&) const {}
};
struct EpiSeg {
    static constexpr bool PERM = true, AFTER_DRAIN = false;
    bf16_t* P; const float* qg; const float* kg; PG8_LAS float* X; float osc;
    __device__ __forceinline__ void operator()(const f32x4 (&acc)[2][2][4][2], const Unit& u, int wr, int wc, int fr, int fq) const {
        const int seg = u.pn >> 2; bf16_t* base = P + (size_t)seg * ((size_t)T_ * 1024);
        const int row0 = u.pm * BM + wr * 64 + fr, col0 = (u.pn & 3) * 256 + wc * 32 + 8 * fq;
        if (seg < 2) {
#pragma unroll
            for (int ai = 0; ai < 2; ++ai)
#pragma unroll
                for (int m = 0; m < 4; ++m)
#pragma unroll
                    for (int bj = 0; bj < 2; ++bj) { const f32x4 v0 = acc[ai][bj][m][0], v1 = acc[ai][bj][m][1];
                        float s = v0[0] * v0[0] + v0[1] * v0[1] + v0[2] * v0[2] + v0[3] * v0[3] + v1[0] * v1[0] + v1[1] * v1[1] + v1[2] * v1[2] + v1[3] * v1[3];
                        s += __int_as_float(__builtin_amdgcn_ds_bpermute(((fq ^ 1) * 16 + fr) * 4, __float_as_int(s))); s += __int_as_float(__builtin_amdgcn_ds_bpermute(((fq ^ 2) * 16 + fr) * 4, __float_as_int(s)));
                        if (fq == 0) X[((ai * HALF + wr * 64 + m * 16 + fr) * 2 + bj) * 4 + wc] = s * (osc * osc); }
            asm volatile("s_waitcnt lgkmcnt(0)\n\ts_barrier" ::: "memory");
            const float* gn = (seg ? kg : qg) + wc * 32 + 8 * fq;
            const f32x4 g0 = *(const f32x4*)gn, g1 = *(const f32x4*)(gn + 4);
            const float sc = seg ? 1.f : 0.08838834764831845f * 1.4426950408889634f;
#pragma unroll
            for (int ai = 0; ai < 2; ++ai)
#pragma unroll
                for (int m = 0; m < 4; ++m) { bf16_t* rowp = base + (size_t)(row0 + ai * HALF + m * 16) * 1024 + col0;
#pragma unroll
                    for (int bj = 0; bj < 2; ++bj) { const f32x4 pv = *(const PG8_LAS f32x4*)(X + ((ai * HALF + wr * 64 + m * 16 + fr) * 2 + bj) * 4);
                        const float rr = rsqrtf((pv[0] + pv[1] + pv[2] + pv[3]) * (1.f / 128.f) + EPS_) * sc * osc;
                        const f32x4 v0 = acc[ai][bj][m][0] * rr * g0, v1 = acc[ai][bj][m][1] * rr * g1;
                        u32x4 w; w.x = cvt_pk(v0[0], v0[1]); w.y = cvt_pk(v0[2], v0[3]); w.z = cvt_pk(v1[0], v1[1]); w.w = cvt_pk(v1[2], v1[3]);
                        *(u32x4*)(rowp + bj * HALF) = w; } }
            return;
        }
#pragma unroll
        for (int ai = 0; ai < 2; ++ai)
#pragma unroll
            for (int m = 0; m < 4; ++m) { bf16_t* rowp = base + (size_t)(row0 + ai * HALF + m * 16) * 1024 + col0;
#pragma unroll
                for (int bj = 0; bj < 2; ++bj) { const f32x4 v0 = acc[ai][bj][m][0] * osc, v1 = acc[ai][bj][m][1] * osc;
                    u32x4 w; w.x = cvt_pk(v0[0], v0[1]); w.y = cvt_pk(v0[2], v0[3]); w.z = cvt_pk(v1[0], v1[1]); w.w = cvt_pk(v1[2], v1[3]);
                    *(u32x4*)(rowp + bj * HALF) = w; } }
    }
};
struct EpiBf {
    static constexpr bool PERM = true, AFTER_DRAIN = false;
    bf16_t* O; int ldc; float osc;
    __device__ __forceinline__ void operator()(const f32x4 (&acc)[2][2][4][2], const Unit& u, int wr, int wc, int fr, int fq) const {
        const int row0 = u.pm * BM + wr * 64 + fr, col0 = u.pn * BM + wc * 32 + 8 * fq;
#pragma unroll
        for (int ai = 0; ai < 2; ++ai)
#pragma unroll
            for (int m = 0; m < 4; ++m) { bf16_t* rowp = O + (size_t)(row0 + ai * HALF + m * 16) * ldc + col0;
#pragma unroll
                for (int bj = 0; bj < 2; ++bj) { const f32x4 v0 = acc[ai][bj][m][0] * osc, v1 = acc[ai][bj][m][1] * osc;
                    u32x4 w; w.x = cvt_pk(v0[0], v0[1]); w.y = cvt_pk(v0[2], v0[3]); w.z = cvt_pk(v1[0], v1[1]); w.w = cvt_pk(v1[2], v1[3]);
                    *(u32x4*)(rowp + bj * HALF) = w; } }
    }
};
struct EpiRes {
    static constexpr bool PERM = false, AFTER_DRAIN = false;
    const float* X; float* O; const float* mod; int goff;
    __device__ __forceinline__ void operator()(const f32x4 (&acc)[2][2][4][2], const Unit& u, int wr, int wc, int fr, int fq) const {
        const int row0 = u.pm * BM + wr * 64 + fr, col0 = u.pn * BM + wc * 32 + 4 * fq;
        const float* gp = mod + (size_t)((u.pm * BM) >> 11) * NMOD + goff + col0;
        f32x4 gv[2][2];
#pragma unroll
        for (int bj = 0; bj < 2; ++bj)
#pragma unroll
            for (int n = 0; n < 2; ++n) gv[bj][n] = *(const f32x4*)(gp + bj * HALF + 16 * n);
#pragma unroll
        for (int ai = 0; ai < 2; ++ai)
#pragma unroll
            for (int m = 0; m < 4; ++m) { const size_t ro = (size_t)(row0 + ai * HALF + m * 16) * D_ + col0;
#pragma unroll
                for (int bj = 0; bj < 2; ++bj)
#pragma unroll
                    for (int n = 0; n < 2; ++n) { const f32x4 xv = *(const f32x4*)(X + ro + bj * HALF + 16 * n);
                        *(f32x4*)(O + ro + bj * HALF + 16 * n) = xv + gv[bj][n] * acc[ai][bj][m][n]; } }
    }
};
typedef int v8i_t __attribute__((ext_vector_type(8)));
typedef int v4i_t __attribute__((ext_vector_type(4)));
__device__ __forceinline__ v8i_t cat8(const bf16x8 a, const bf16x8 b) { const v4i_t x = __builtin_bit_cast(v4i_t, a), y = __builtin_bit_cast(v4i_t, b); v8i_t r; r[0] = x[0]; r[1] = x[1]; r[2] = x[2]; r[3] = x[3]; r[4] = y[0]; r[5] = y[1]; r[6] = y[2]; r[7] = y[3]; return r; }
template <class Epi, class Sched, bool ALIGN_EPI = false, bool SP2 = false, bool FP8 = false>
__device__ __forceinline__ void gemm_phase(PG8_LAS unsigned char* lds, const Gemm g, const Sched& S, const Epi& E, const int swid) {
    const int tid = get_tid(swid), wid = __builtin_amdgcn_readfirstlane(tid >> 6), lane = tid & 63, wr = wid >> 2, wc = wid & 3, fr = lane & 15, fq = lane >> 4;
    const int K = g.K, nt = FP8 ? K / (2 * BK) : K / BK, EB = FP8 ? 1 : 2;
    unsigned voffA[2], voffB[2];
#pragma unroll
    for (int i = 0; i < 2; ++i) { int R, C; stage_rc(tid * 16 + i * 8192, R, C); const int Rb = Epi::PERM ? ((R & ~31) + perm32(R & 31)) : R;
        voffA[i] = (unsigned)(R * K * EB + C * 2); voffB[i] = (unsigned)(Rb * K * EB + C * 2); }
    const size_t kstep = (size_t)(BK * 2);
    const size_t hstep = (size_t)HALF * K * EB;
    const size_t tstep = 2 * hstep;
    const unsigned ldsw = (unsigned)wid * 1024u;
    const int aoff = lds_byte(wr * 64 + fr, fq * 8), boff = lds_byte(wc * 32 + fr, fq * 8);
#define PG8_SA(b, h) (((b) * 2 + (h)) * HTB)
#define PG8_SB(b, h) ((4 + (b) * 2 + (h)) * HTB)
#define PG8_STAGE(bufoff, gbase, voff) do { _Pragma("unroll") for (int _i = 0; _i < 2; ++_i) { unsigned _vo = (voff)[_i]; asm volatile("" : "+v"(_vo));     \
        __builtin_amdgcn_global_load_lds((const unsigned*)((const char*)(gbase) + _vo), (PG8_LAS unsigned*)(lds + (bufoff) + ldsw + _i * 8192), 16, 0, 0); } } while (0)
#define PG8_LDA(dst, b, h) do { _Pragma("unroll") for (int m = 0; m < 4; ++m) { \
        if constexpr (FP8) { dst##8[m] = cat8(*(const PG8_LAS bf16x8*)(lds + PG8_SA(b, h) + aoff + m * 2048), *(const PG8_LAS bf16x8*)(lds + PG8_SA(b, h) + aoff + m * 2048 + 1024)); } \
        else { _Pragma("unroll") for (int k = 0; k < 2; ++k) dst[m][k] = *(const PG8_LAS bf16x8*)(lds + PG8_SA(b, h) + aoff + m * 2048 + k * 1024); } } } while (0)
#define PG8_LDB(dst, b, h) do { _Pragma("unroll") for (int n = 0; n < 2; ++n) { \
        if constexpr (FP8) { dst##8[n] = cat8(*(const PG8_LAS bf16x8*)(lds + PG8_SB(b, h) + boff + n * 2048), *(const PG8_LAS bf16x8*)(lds + PG8_SB(b, h) + boff + n * 2048 + 1024)); } \
        else { _Pragma("unroll") for (int k = 0; k < 2; ++k) dst[n][k] = *(const PG8_LAS bf16x8*)(lds + PG8_SB(b, h) + boff + n * 2048 + k * 1024); } } } while (0)
#define PG8_MMA(ai, bj, At, Bt) do { __builtin_amdgcn_s_setprio(1); _Pragma("unroll") for (int m = 0; m < 4; ++m) _Pragma("unroll") for (int n = 0; n < 2; ++n) { \
        if constexpr (FP8) { acc[ai][bj][m][n] = __builtin_amdgcn_mfma_scale_f32_16x16x128_f8f6f4(Bt##8[n], At##8[m], acc[ai][bj][m][n], 0, 0, 0, 0x7f7f7f7f, 0, 0x7f7f7f7f); } \
        else { _Pragma("unroll") for (int k = 0; k < 2; ++k) acc[ai][bj][m][n] = __builtin_amdgcn_mfma_f32_16x16x32_bf16(Bt[n][k], At[m][k], acc[ai][bj][m][n], 0, 0, 0); } } \
        __builtin_amdgcn_s_setprio(0); } while (0)
#define PG8_WAIT_V(n) asm volatile("s_waitcnt vmcnt(" #n ")" ::: "memory")
#define PG8_WAIT_L(n) asm volatile("s_waitcnt lgkmcnt(" #n ")" ::: "memory")
#define PG8_BAR __builtin_amdgcn_s_barrier()
#define PG8_SCHED __builtin_amdgcn_sched_barrier(0)
    Unit cur, nxt; int ui = 0;
    if (!S.next(0, cur)) return;
    f32x4 acc[2][2][4][2];
#pragma unroll
    for (int a = 0; a < 2; ++a)
#pragma unroll
        for (int b = 0; b < 2; ++b)
#pragma unroll
            for (int m = 0; m < 4; ++m)
#pragma unroll
                for (int n = 0; n < 2; ++n) acc[a][b][m][n] = (f32x4){0.f, 0.f, 0.f, 0.f};
    bf16x8 At[4][2], B0[2][2], B1[2][2];
    v8i_t At8[4], B08[2], B18[2];
    const char* cA = (const char*)g.A + (size_t)cur.pm * tstep; const char* cB = (const char*)g.Bt + (size_t)cur.pn * tstep;
    S.a_ready(cur);
    if constexpr (SP2) {
        PG8_STAGE(PG8_SB(0, 0), cB, voffB); PG8_STAGE(PG8_SB(0, 1), cB + hstep, voffB); PG8_STAGE(PG8_SA(0, 0), cA, voffA); PG8_STAGE(PG8_SA(0, 1), cA + hstep, voffA);
        if (wr == 1) PG8_BAR;
        PG8_WAIT_V(2); PG8_BAR;
        PG8_STAGE(PG8_SB(1, 0), cB + kstep, voffB); PG8_STAGE(PG8_SA(1, 0), cA + kstep, voffA); PG8_STAGE(PG8_SB(1, 1), cB + hstep + kstep, voffB);
        PG8_WAIT_V(6); PG8_BAR;
    } else {
        PG8_STAGE(PG8_SB(0, 0), cB, voffB); PG8_STAGE(PG8_SA(0, 0), cA, voffA); PG8_STAGE(PG8_SB(0, 1), cB + hstep, voffB); PG8_STAGE(PG8_SA(0, 1), cA + hstep, voffA);
        if (wr == 1) PG8_BAR;
        PG8_WAIT_V(4); PG8_BAR;
        PG8_STAGE(PG8_SB(1, 0), cB + kstep, voffB); PG8_STAGE(PG8_SA(1, 0), cA + kstep, voffA); PG8_STAGE(PG8_SB(1, 1), cB + hstep + kstep, voffB);
        PG8_WAIT_V(6); PG8_BAR;
    }
    for (;;) {
        const bool has_next = S.next(ui + 1, nxt);
        const char* nA = has_next ? (const char*)g.A + (size_t)nxt.pm * tstep : cA; const char* nB = has_next ? (const char*)g.Bt + (size_t)nxt.pn * tstep : cB;
        for (int t = 0; t < nt; t += 2) {
            const bool last = (t == nt - 2);
            const char* a1 = cA + (size_t)(t + 1) * kstep;
            const char* a2 = last ? nA : cA + (size_t)(t + 2) * kstep; const char* b2 = last ? nB : cB + (size_t)(t + 2) * kstep;
            const char* a3 = a2 + kstep; const char* b3 = b2 + kstep;
            if (last && has_next) S.a_ready(nxt);
            if constexpr (SP2) {
            PG8_LDB(B0, 0, 0); PG8_LDB(B1, 0, 1); PG8_SCHED; PG8_LDA(At, 0, 0); PG8_STAGE(PG8_SA(1, 1), a1 + hstep, voffA);
            PG8_WAIT_V(8); PG8_WAIT_L(0); PG8_BAR; PG8_MMA(0, 0, At, B0); PG8_MMA(0, 1, At, B1); PG8_BAR; PG8_SCHED;
            PG8_LDA(At, 0, 1); PG8_STAGE(PG8_SB(0, 0), b2, voffB); PG8_STAGE(PG8_SB(0, 1), b2 + hstep, voffB); PG8_STAGE(PG8_SA(0, 0), a2, voffA);
            PG8_WAIT_V(8); PG8_WAIT_L(0); PG8_BAR; PG8_MMA(1, 0, At, B0); PG8_MMA(1, 1, At, B1); PG8_BAR; PG8_SCHED;
            PG8_LDB(B0, 1, 0); PG8_LDB(B1, 1, 1); PG8_SCHED; PG8_LDA(At, 1, 0); PG8_STAGE(PG8_SA(0, 1), a2 + hstep, voffA);
            PG8_WAIT_V(8); PG8_WAIT_L(0); PG8_BAR; PG8_MMA(0, 0, At, B0); PG8_MMA(0, 1, At, B1); PG8_BAR; PG8_SCHED;
            PG8_LDA(At, 1, 1); PG8_STAGE(PG8_SB(1, 0), b3, voffB); PG8_STAGE(PG8_SB(1, 1), b3 + hstep, voffB); PG8_STAGE(PG8_SA(1, 0), a3, voffA);
            PG8_WAIT_V(8); PG8_WAIT_L(0); PG8_BAR; PG8_MMA(1, 0, At, B0); PG8_MMA(1, 1, At, B1); PG8_BAR; PG8_SCHED;
            } else {
            PG8_LDB(B0, 0, 0); PG8_SCHED; PG8_LDA(At, 0, 0); PG8_STAGE(PG8_SA(1, 1), a1 + hstep, voffA);
            PG8_WAIT_L(8); PG8_BAR; PG8_WAIT_L(0); PG8_MMA(0, 0, At, B0); PG8_BAR; PG8_SCHED;
            PG8_LDB(B1, 0, 1); PG8_STAGE(PG8_SB(0, 0), b2, voffB);
            PG8_BAR; PG8_WAIT_L(0); PG8_MMA(0, 1, At, B1); PG8_BAR;
            PG8_LDA(At, 0, 1); PG8_STAGE(PG8_SA(0, 0), a2, voffA);
            PG8_BAR; PG8_WAIT_L(0); PG8_MMA(1, 0, At, B0); PG8_BAR; PG8_SCHED;
            PG8_STAGE(PG8_SB(0, 1), b2 + hstep, voffB);
            PG8_WAIT_V(6); PG8_BAR; PG8_MMA(1, 1, At, B1); PG8_BAR;
            PG8_LDB(B0, 1, 0); PG8_SCHED; PG8_LDA(At, 1, 0); PG8_STAGE(PG8_SA(0, 1), a2 + hstep, voffA);
            PG8_WAIT_L(8); PG8_BAR; PG8_WAIT_L(0); PG8_MMA(0, 0, At, B0); PG8_BAR; PG8_SCHED;
            PG8_LDB(B1, 1, 1); PG8_STAGE(PG8_SB(1, 0), b3, voffB);
            PG8_BAR; PG8_WAIT_L(0); PG8_MMA(0, 1, At, B1); PG8_BAR;
            PG8_LDA(At, 1, 1); PG8_STAGE(PG8_SA(1, 0), a3, voffA);
            PG8_BAR; PG8_WAIT_L(0); PG8_MMA(1, 0, At, B0); PG8_BAR; PG8_SCHED;
            PG8_STAGE(PG8_SB(1, 1), b3 + hstep, voffB);
            PG8_WAIT_V(6); PG8_BAR; PG8_MMA(1, 1, At, B1); PG8_BAR;
            }
        }
        if constexpr (ALIGN_EPI) { if (wr == 0) PG8_BAR; }
        if constexpr (!Epi::AFTER_DRAIN) { int frl = fr, fql = fq; asm volatile("" : "+v"(frl), "+v"(fql));
            E(acc, cur, wr, wc, frl, fql); S.done(cur); }
        if (!has_next) break;
#pragma unroll
        for (int a = 0; a < 2; ++a)
#pragma unroll
            for (int b = 0; b < 2; ++b)
#pragma unroll
                for (int m = 0; m < 4; ++m)
#pragma unroll
                    for (int n = 0; n < 2; ++n) acc[a][b][m][n] = (f32x4){0.f, 0.f, 0.f, 0.f};
        cur = nxt; cA = nA; cB = nB; ++ui;
        if constexpr (ALIGN_EPI) { if (wr == 1) PG8_BAR; }
    }
    PG8_WAIT_V(0);
    if constexpr (!ALIGN_EPI) { if (wr == 0) PG8_BAR; }
    PG8_BAR;
    if constexpr (Epi::AFTER_DRAIN) { E.fused(acc, cur, wr, wc, fr, fq, lds, wid, lane); S.done(cur); }
#undef PG8_SA
#undef PG8_SB
#undef PG8_STAGE
#undef PG8_LDA
#undef PG8_LDB
#undef PG8_MMA
#undef PG8_WAIT_V
#undef PG8_WAIT_L
#undef PG8_BAR
#undef PG8_SCHED
}
}
#define XB_TMO      128
#define XB_XCNT(j)  (256  + 64 * (j))
#define XB_XSUB(j)  (1280 + 64 * (j))
#define XB_XGEN(j)  (2304 + 64 * (j))
#define XB_TOP      3328
#define XB_TOPGEN   3392
#define XCD_BAR_WORDS 3456
#define XB_SPIN_CAP (1u << 18)

__device__ __forceinline__ unsigned xb_ld(unsigned* p)              { return __hip_atomic_load(p, __ATOMIC_RELAXED, __HIP_MEMORY_SCOPE_AGENT); }
__device__ __forceinline__ unsigned xb_add(unsigned* p, unsigned v) { return __hip_atomic_fetch_add(p, v, __ATOMIC_RELAXED, __HIP_MEMORY_SCOPE_AGENT); }
__device__ __forceinline__ unsigned xb_xcc_id() { return (unsigned)__builtin_amdgcn_s_getreg((3 << 11) | 20) & 0xFu; }
#define XB_SPIN(cond, bar) do { unsigned _sp = 0; while (cond) { __builtin_amdgcn_s_sleep(1); \
    if ((++_sp & 255u) == 0u) { if (xb_ld(&(bar)[XB_TMO])) break; if (_sp > XB_SPIN_CAP) { atomicAdd(&(bar)[XB_TMO], 1u); break; } } } } while (0)

struct XcdBarrier {
    unsigned* bar; unsigned x;
    volatile LAS unsigned* st;
};

__device__ __forceinline__ XcdBarrier xcd_barrier_post(unsigned* bar, volatile LAS unsigned* st, int swid) {
    XcdBarrier b; b.bar = bar; b.x = xb_xcc_id(); b.st = st;
    if (get_tid(swid) == 0) (void)xb_add(&bar[XB_XCNT(b.x)], 1u);
    return b;
}
__device__ __forceinline__ void xcd_barrier_complete(unsigned* bar, unsigned x, unsigned& nloc, unsigned& nx) {
    const unsigned G = gridDim.x * gridDim.y * gridDim.z;
    unsigned sum, cnt, mine, sp = 0u;
    for (;;) {
        sum = 0u; cnt = 0u; mine = 0u;
#pragma unroll
        for (unsigned j = 0; j < 16; ++j) { const unsigned c = xb_ld(&bar[XB_XCNT(j)]); sum += c; cnt += (c > 0u) ? 1u : 0u; mine = (j == x) ? c : mine; }
        if (sum == G) break;
        __builtin_amdgcn_s_sleep(1);
        if ((++sp & 255u) == 0u) { if (xb_ld(&bar[XB_TMO])) break; if (sp > XB_SPIN_CAP) { atomicAdd(&bar[XB_TMO], 1u); break; } }
    }
    nloc = mine > 0u ? mine : 1u; nx = cnt > 0u ? cnt : 1u;
}

__device__ __forceinline__ void xcd_barrier(const XcdBarrier& b, int swid) {
    asm volatile("s_waitcnt vmcnt(0)" ::: "memory");
    __syncthreads();
    if (get_tid(swid) == 0) {
        unsigned* bar = b.bar;
        __builtin_amdgcn_s_waitcnt(0);
        unsigned nloc = b.st[0], nx = b.st[1];
        if (nloc == 0u) { xcd_barrier_complete(bar, b.x, nloc, nx); b.st[0] = nloc; b.st[1] = nx; }
        const unsigned old = xb_add(&bar[XB_XSUB(b.x)], 1u);
        const unsigned gen = old / nloc;
        if (old + 1u == (gen + 1u) * nloc) {
            __builtin_amdgcn_fence(__ATOMIC_RELEASE, "agent");
            asm volatile("s_waitcnt vmcnt(0)" ::: "memory");
            const unsigned og = xb_add(&bar[XB_TOP], 1u);
            const unsigned tg = og / nx;
            if (og + 1u == (tg + 1u) * nx) xb_add(&bar[XB_TOPGEN], 1u);
            else XB_SPIN(xb_ld(&bar[XB_TOPGEN]) == tg, bar);
            __builtin_amdgcn_fence(__ATOMIC_ACQUIRE, "agent");
            xb_add(&bar[XB_XGEN(b.x)], 1u);
            asm volatile("s_waitcnt vmcnt(0)" ::: "memory");
        } else {
            XB_SPIN(xb_ld(&bar[XB_XGEN(b.x)]) == gen, bar);
            __builtin_amdgcn_fence(__ATOMIC_ACQUIRE, "agent");
            asm volatile("s_waitcnt vmcnt(0)" ::: "memory");
        }
    }
    __syncthreads();
}
__device__ __forceinline__ void phase_prep(const Params& p, unsigned char* lds, int bid, int nb) {
    const int tid = get_tid(p.swid), lane = tid & 63, wave = tid >> 6;
    unsigned char* ws = p.ws;
    float* mod = (float*)(ws + WS_MOD);
    if (bid < 192) {
        float* sc = (float*)lds;
        float* red = sc + 8 * 2048;
        for (int i = tid; i < 8 * 2048; i += NTHR) sc[i] = silu_f(p.c[i]);
        __syncthreads();
        for (int it = bid; it < 192; it += nb) {
            const int col = it * 64 + lane;
            float acc[8];
#pragma unroll
            for (int b = 0; b < 8; ++b) acc[b] = 0.f;
            const float* w = p.w_ada + (size_t)(wave * 256) * NMOD + col;
            const float* s0 = sc + wave * 256;
#pragma unroll 16
            for (int k = 0; k < 256; ++k) {
                const float wv = __builtin_nontemporal_load(w + (size_t)k * NMOD);
#pragma unroll
                for (int b = 0; b < 8; ++b) acc[b] += s0[b * 2048 + k] * wv;
            }
#pragma unroll
            for (int b = 0; b < 8; ++b) red[(wave * 8 + b) * 64 + lane] = acc[b];
            __syncthreads();
            {   const int b = wave; float s = p.b_ada[col];
#pragma unroll
                for (int w2 = 0; w2 < 8; ++w2) s += red[(w2 * 8 + b) * 64 + lane];
                mod[b * NMOD + col] = s; }
            __syncthreads();
        }
    }
    __syncthreads();
    {
        float* tile = (float*)lds;
        bf16_t* WinT = (bf16_t*)(ws + WS_WINT); bf16_t* WoT = (bf16_t*)(ws + WS_WOT); bf16_t* WqT = (bf16_t*)(ws + WS_WQT);
        for (int item = bid; item < 5632; item += nb) {
            const float* src; int ld, scol; bf16_t* dst; int kt;
            if (item < 3584) { const int seg = item >> 9, rem = item & 511, ntile = rem >> 5; kt = rem & 31;
                src = p.w_in; ld = INCOLS; scol = (seg < 3 ? seg * 1024 : 3080 + (seg - 3) * 1024) + ntile * 64; dst = WinT + (size_t)(seg * 1024 + ntile * 64) * 1024; }
            else if (item < 4608) { const int rem = item - 3584, ntile = rem >> 5; kt = rem & 31; src = p.w_out; ld = 2048; scol = ntile * 64; dst = WoT + (size_t)(ntile * 64) * (G2_FP8 ? 1024 : 2048); }
            else { const int rem = item - 4608, ntile = rem >> 5; kt = rem & 31; src = p.w_q; ld = 2048; scol = ntile * 64; dst = WqT + (size_t)(ntile * 64) * 2048; }
            const int k0 = kt * 64;
#pragma unroll
            for (int ii = 0; ii < 8; ++ii) { const int k = wave + 8 * ii; tile[k * 65 + lane] = src[(size_t)(k0 + k) * ld + scol + lane]; }
            __syncthreads();
            if (item < (G2_FP8 ? 4608 : 3584)) {
#pragma unroll
                for (int ii = 0; ii < 2; ++ii) { const int n = (tid >> 4) + 32 * ii, k4 = (tid & 15) * 4;
                    f32x4 v; v[0] = tile[k4 * 65 + n] * 64.f; v[1] = tile[(k4 + 1) * 65 + n] * 64.f; v[2] = tile[(k4 + 2) * 65 + n] * 64.f; v[3] = tile[(k4 + 3) * 65 + n] * 64.f;
                    *(unsigned*)((unsigned char*)dst + (size_t)n * 2048 + k0 + k4) = pack4_fp8(v); }
            } else {
#pragma unroll
            for (int ii = 0; ii < 8; ++ii) { const int n = wave + 8 * ii; dst[(size_t)n * 2048 + k0 + lane] = (bf16_t)(cvt_pk(tile[lane * 65 + n], 0.f) & 0xffffu); }
            }
            __syncthreads();
        }
    }
    {
        bf16_t* Wg = (bf16_t*)(ws + WS_WG);
        for (int i = bid * NTHR + tid; i < 16 * 2048; i += nb * NTHR) { const int g = i >> 11, k = i & 2047; const int col = g < 8 ? 3072 + g : 7176 + (g - 8);
            Wg[i] = (bf16_t)(cvt_pk(p.w_in[(size_t)k * INCOLS + col], 0.f) & 0xffffu); }
    }
}

__device__ __forceinline__ void convert_experts(const Params& p, int bid, int nb) {
    const int tid = get_tid(p.swid); unsigned char* ws = p.ws;
    unsigned char* E8D = ws + WS_E8D; unsigned char* E8US = ws + WS_E8U;
    {
        const int lane = tid & 63, wave = tid >> 6; float* DSC = (float*)(ws + WS_DSC);
        for (int e = bid * 8 + wave; e < 16384; e += nb * 8) {
            const float* rp = p.e_down + (size_t)e * 2048;
            f32x4 v[8]; float mx = 0.f;
#pragma unroll
            for (int hf = 0; hf < 2; ++hf)
#pragma unroll
                for (int q = 0; q < 4; ++q) { v[hf * 4 + q] = *(const f32x4*)(rp + hf * 1024 + 16 * lane + 4 * q);
#pragma unroll
                    for (int c = 0; c < 4; ++c) mx = fmaxf(mx, fabsf(v[hf * 4 + q][c])); }
            mx = fmaxf(wmax(mx), 1e-30f);
            const float inv = 127.f / mx;
            if (lane == 0) DSC[e] = mx * (1.f / 127.f);
#pragma unroll
            for (int hf = 0; hf < 2; ++hf) { u32x4 o;
#pragma unroll
                for (int q = 0; q < 4; ++q) { unsigned w = 0u;
#pragma unroll
                    for (int c = 0; c < 4; ++c) w |= ((unsigned)__float2int_rn(v[hf * 4 + q][c] * inv) & 0xffu) << (8 * c);
                    o[q] = w; }
                *(u32x4*)(E8D + (size_t)e * 2048 + hf * 1024 + 16 * lane) = o; }
        }
    }
    for (int i = bid * NTHR + tid; i < 524288; i += nb * NTHR) {
        const int s = i & 255, eg = i >> 8;
        const float* sp = p.e_up + (size_t)(eg * 8) * 2048 + 8 * s;
        unsigned w[16];
#pragma unroll
        for (int q = 0; q < 8; ++q) { const f32x4 a = *(const f32x4*)(sp + (size_t)q * 2048), b = *(const f32x4*)(sp + (size_t)q * 2048 + 4); w[2 * q] = pack4_fp8(a * 32.f); w[2 * q + 1] = pack4_fp8(b * 32.f); }
        u32x4* dp = (u32x4*)(E8US + ((size_t)s * 16384 + eg * 8) * 8);
#pragma unroll
        for (int q = 0; q < 4; ++q) { u32x4 o; o.x = w[4 * q]; o.y = w[4 * q + 1]; o.z = w[4 * q + 2]; o.w = w[4 * q + 3]; dp[q] = o; }
    }
}

template <bool RES>
__device__ __forceinline__ void phase_norm(const float* xin, const bf16_t* yin, int gate_off, const float* gain, const float* mod, int shift_off, int scale_off, bf16_t* hout, unsigned char* h8out, int bid, int nb, int swid) {
    const int tid = get_tid(swid), lane = tid & 63, wave = tid >> 6;
    for (int row = bid * 8 + wave; row < T_; row += nb * 8) {
        const f32x4* xr = (const f32x4*)(xin + (size_t)row * D_);
        f32x4 v[8]; float ss = 0.f;
        const float* mb = mod + (size_t)(row >> 11) * NMOD;
#pragma unroll
        for (int j = 0; j < 8; ++j) { v[j] = xr[lane + 64 * j];
            if (RES) { const int k = 4 * (lane + 64 * j); const u32x2 yw = *(const u32x2*)(yin + (size_t)row * D_ + k); const f32x4 gv = *(const f32x4*)(mb + gate_off + k);
                v[j][0] += gv[0] * bflo(yw.x); v[j][1] += gv[1] * bfhi(yw.x); v[j][2] += gv[2] * bflo(yw.y); v[j][3] += gv[3] * bfhi(yw.y); }
            ss += v[j][0] * v[j][0] + v[j][1] * v[j][1] + v[j][2] * v[j][2] + v[j][3] * v[j][3]; }
        ss = wsum(ss);
        const float r = rsqrtf(ss * (1.f / D_) + EPS_);
        f32x4 hv[8];
#pragma unroll
        for (int j = 0; j < 8; ++j) {
            const int k = 4 * (lane + 64 * j);
            const f32x4 gn = *(const f32x4*)(gain + k), sh = *(const f32x4*)(mb + shift_off + k), scl = *(const f32x4*)(mb + scale_off + k);
#pragma unroll
            for (int e = 0; e < 4; ++e) hv[j][e] = (v[j][e] * r) * gn[e] * (1.f + scl[e]) + sh[e];
            u32x2 w; w.x = cvt_pk(hv[j][0], hv[j][1]); w.y = cvt_pk(hv[j][2], hv[j][3]);
            *(u32x2*)(hout + (size_t)row * D_ + k) = w;
            if (h8out) *(unsigned*)(h8out + (size_t)row * D_ + k) = pack4_fp8(hv[j] * 8.f);
        }
    }
}

__device__ __forceinline__ void phase_gates(const Params& p, unsigned char* lds, int bid, int nb) {
    const int tid = get_tid(p.swid), lane = tid & 63, wave = tid >> 6, r = lane & 31, hh = lane >> 5;
    unsigned char* ws = p.ws;
    const bf16_t* H = (const bf16_t*)(ws + WS_H); const bf16_t* Wg = (const bf16_t*)(ws + WS_WG); float* gate = (float*)(ws + WS_GATE);
    constexpr int WST = 4096 + 16;
    for (int i = tid; i < 16 * 256; i += NTHR) { const int g = i >> 8, c = i & 255; *(u32x4*)(lds + g * WST + c * 16) = *(const u32x4*)(Wg + (size_t)g * 2048 + c * 8); }
    __syncthreads();
    float* part = (float*)(lds + 16 * WST);
    for (int pr = bid; pr < T_ / 64; pr += nb) {
        const int t = pr * 64 + (wave >> 2) * 32 + r, kq = wave & 3;
        f32x16 acc;
#pragma unroll
        for (int i = 0; i < 16; ++i) acc[i] = 0.f;
        const bf16_t* hp = H + (size_t)t * D_ + kq * 512 + hh * 8; const unsigned char* wp = lds + (r & 15) * WST + kq * 1024 + hh * 16;
#pragma unroll 1
        for (int k0 = 0; k0 < 32; k0 += 16) {
            bf16x8 bfr[16];
#pragma unroll
            for (int j = 0; j < 16; ++j) bfr[j] = *(const bf16x8*)(hp + (k0 + j) * 16);
#pragma unroll
            for (int j = 0; j < 16; ++j) { bf16x8 a = *(const bf16x8*)(wp + (k0 + j) * 32); if (r >= 16) a = (bf16x8){0, 0, 0, 0, 0, 0, 0, 0};
                acc = __builtin_amdgcn_mfma_f32_32x32x16_bf16(a, bfr[j], acc, 0, 0, 0); }
        }
        __syncthreads();
#pragma unroll
        for (int i = 0; i < 8; ++i) part[(wave * 8 + i) * 64 + lane] = acc[i];
        __syncthreads();
        if (kq == 0) {
            float s[8];
#pragma unroll
            for (int i = 0; i < 8; ++i) s[i] = part[(wave * 8 + i) * 64 + lane] + part[((wave + 1) * 8 + i) * 64 + lane] + part[((wave + 2) * 8 + i) * 64 + lane] + part[((wave + 3) * 8 + i) * 64 + lane];
            f32x4 g0, g1; g0[0] = s[0]; g0[1] = s[1]; g0[2] = s[2]; g0[3] = s[3]; g1[0] = s[4]; g1[1] = s[5]; g1[2] = s[6]; g1[3] = s[7];
            *(f32x4*)(gate + (size_t)t * 16 + 4 * hh) = g0; *(f32x4*)(gate + (size_t)t * 16 + 8 + 4 * hh) = g1;
        }
    }
    __syncthreads();
}

__device__ __forceinline__ void phase_post(const Params& p, int bid, int nb) {
    const int tid = get_tid(p.swid), lane = tid & 63, wave = tid >> 6;
    unsigned char* ws = p.ws;
    bf16_t* Pq = (bf16_t*)(ws + WS_P); bf16_t* Pk = (bf16_t*)(ws + WS_P + SEG_B);
    const float qscale = 0.08838834764831845f * 1.4426950408889634f;
    {
        const bf16_t* Mq = (const bf16_t*)(ws + WS_P + 3 * SEG_B); const bf16_t* Mk = (const bf16_t*)(ws + WS_P + 4 * SEG_B);
        bf16_t* QC = (bf16_t*)(ws + WS_QC); bf16_t* KC = (bf16_t*)(ws + WS_KC);
        for (int item = bid; item < 256; item += nb) {
            const int which = item >> 7, tb = item & 127, cg = tid & 127, run = tid >> 7, ch0 = cg * 8, ts = tb * 128 + run * 32, sp = ts & 2047;
            const bf16_t* src = (which ? Mk : Mq) + (size_t)ts * 1024 + ch0; bf16_t* dst = (which ? KC : QC) + (size_t)ts * 1024 + ch0;
            float w0[8], w1[8], w2[8], w3[8], cb[8], x0[8], x1[8], x2[8];
#pragma unroll
            for (int e = 0; e < 8; ++e) { const int ci = which * 1024 + ch0 + e; w0[e] = p.conv_w[ci]; w1[e] = p.conv_w[2048 + ci]; w2[e] = p.conv_w[4096 + ci]; w3[e] = p.conv_w[6144 + ci]; cb[e] = p.conv_b[ci]; }
            {   u32x4 a = {0u, 0u, 0u, 0u}, b = a, c = a;
                if (sp != 0) { a = *(const u32x4*)(src - 3 * 1024); b = *(const u32x4*)(src - 2 * 1024); c = *(const u32x4*)(src - 1024); }
#pragma unroll
                for (int e = 0; e < 4; ++e) { x0[2 * e] = bflo(a[e]); x0[2 * e + 1] = bfhi(a[e]); x1[2 * e] = bflo(b[e]); x1[2 * e + 1] = bfhi(b[e]); x2[2 * e] = bflo(c[e]); x2[2 * e + 1] = bfhi(c[e]); } }
            const float osc = which ? 0.0625f : 1.f;
            for (int s = 0; s < 32; ++s) {
                const u32x4 d = *(const u32x4*)(src + (size_t)s * 1024); float x3[8], y[8];
#pragma unroll
                for (int e = 0; e < 4; ++e) { x3[2 * e] = bflo(d[e]); x3[2 * e + 1] = bfhi(d[e]); }
#pragma unroll
                for (int e = 0; e < 8; ++e) { y[e] = silu_f(w0[e] * x0[e] + w1[e] * x1[e] + w2[e] * x2[e] + w3[e] * x3[e] + cb[e]) * osc; x0[e] = x1[e]; x1[e] = x2[e]; x2[e] = x3[e]; }
                u32x4 o; o.x = cvt_pk(y[0], y[1]); o.y = cvt_pk(y[2], y[3]); o.z = cvt_pk(y[4], y[5]); o.w = cvt_pk(y[6], y[7]);
                *(u32x4*)(dst + (size_t)s * 1024) = o;
            }
        }
    }
    const float* gate = (const float*)(ws + WS_GATE); float* F = (float*)(ws + WS_F);
    for (int sq = bid * 8 + wave; sq < 64; sq += nb * 8) {
        const int b = sq >> 3, h = sq & 7; const float fb = p.fox_fb[h];
        float v[32]; float run = 0.f;
#pragma unroll
        for (int i = 0; i < 32; ++i) { const int t = lane * 32 + i; run += logsig(gate[(size_t)(b * S_ + t) * 16 + h] + fb); v[i] = run; }
        float inc = run;
#pragma unroll
        for (int o = 1; o < 64; o <<= 1) { const float u = __shfl_up(inc, o); if (lane >= o) inc += u; }
        const float excl = inc - run;
#pragma unroll
        for (int i = 0; i < 32; ++i) F[(size_t)sq * S_ + lane * 32 + i] = (v[i] + excl) * 1.4426950408889634f;
    }
}
typedef short s16x4 __attribute__((ext_vector_type(4)));
__device__ __forceinline__ s16x4 lds_tr16(const unsigned char* p) { return __builtin_amdgcn_ds_read_tr16_b64_v4i16((LAS s16x4*)p); }
__device__ __forceinline__ bf16x8 tr_frag(const unsigned char* p0, int second_bytes) {
    const s16x4 a = lds_tr16(p0), b = lds_tr16(p0 + second_bytes);
    bf16x8 f; f[0] = a[0]; f[1] = a[1]; f[2] = a[2]; f[3] = a[3]; f[4] = b[0]; f[5] = b[1]; f[6] = b[2]; f[7] = b[3]; return f;
}
__device__ __forceinline__ unsigned split_bf16(float v, float& eff) { const unsigned hi = cvt_pk(v, 0.f) & 0xffffu; const float hf = bf2f((bf16_t)hi); const unsigned lo = cvt_pk(v - hf, 0.f) & 0xffffu; eff = hf + bf2f((bf16_t)lo); return hi | (lo << 16); }
__device__ __forceinline__ void fox_unit(const Params& p, unsigned char* lds, int b, int h, int qb) {
    const int tid = get_tid(p.swid), lane = tid & 63, wave = tid >> 6, r = lane & 31, hh = lane >> 5, li = lane & 15;
    unsigned char* ws = p.ws;
    const bf16_t* Pq = (const bf16_t*)(ws + WS_P); const bf16_t* Pk = (const bf16_t*)(ws + WS_P + SEG_B); const bf16_t* Pv = (const bf16_t*)(ws + WS_P + 2 * SEG_B);
    const float* F = (const float*)(ws + WS_F) + (size_t)(b * 8 + h) * S_;
    bf16_t* Oc = (bf16_t*)(ws + WS_H);
    constexpr int KST = 272, VST = 544, BUF = 64 * KST + 64 * VST;
    constexpr float THR = 8.f;
    const int q0w = qb * 256 + wave * 32, qs = q0w + r; const int q0s = __builtin_amdgcn_readfirstlane(q0w);
    const size_t trow = (size_t)(b * S_ + qs);
    bf16x8 qf[8];
#pragma unroll
    for (int ks = 0; ks < 8; ++ks) qf[ks] = *(const bf16x8*)(Pq + trow * 1024 + h * 128 + ks * 16 + hh * 8);
    float feff; const unsigned fq2 = split_bf16(F[qs], feff);
    float m = 0.f;
    u32x4 qa; qa.x = hh ? 0u : fq2; qa.y = 0u; qa.z = hh ? 0u : 0x3f803f80u; qa.w = 0u;
    f32x16 o[4];
#pragma unroll
    for (int d = 0; d < 4; ++d)
#pragma unroll
        for (int i = 0; i < 16; ++i) o[d][i] = 0.f;
    float l = 0.f;
    const int ntile = (qb * 256 + 256) / 64;
    const int srow0 = tid >> 4, scc = tid & 15;
    const bf16_t* kg = Pk + (size_t)(b * S_ + srow0) * 1024 + h * 128 + scc * 8; const bf16_t* vg = Pv + (size_t)(b * S_ + srow0) * 1024 + h * 128 + scc * 8;
    u32x4 kr[2], vr[2]; float fr = 0.f;
    const int vb_off = 64 * KST + (4 * hh + (li >> 2)) * VST + (16 * (r >> 4) + 4 * (li & 3)) * 2;
#define FOX_AUG(dst, fval) do { float e_; const unsigned s2_ = split_bf16(-(fval), e_); u32x4 w_; w_.x = 0x3f803f80u; w_.y = 0x3f803f80u; w_.z = s2_; w_.w = 0u; *(u32x4*)(dst) = w_; } while (0)
    __syncthreads();
#pragma unroll
    for (int i = 0; i < 2; ++i) { kr[i] = *(const u32x4*)(kg + (size_t)(32 * i) * 1024); vr[i] = *(const u32x4*)(vg + (size_t)(32 * i) * 1024); }
    if (tid < 64) fr = F[tid];
#pragma unroll
    for (int i = 0; i < 2; ++i) { *(u32x4*)(lds + (srow0 + 32 * i) * KST + scc * 16) = kr[i]; *(u32x4*)(lds + 64 * KST + (srow0 + 32 * i) * VST + scc * 16) = vr[i]; }
    if (tid < 64) FOX_AUG(lds + tid * KST + 256, fr);
    __syncthreads();
    for (int kt = 0; kt < ntile; ++kt) {
        const int k0 = kt * 64; unsigned char* cur = lds + (kt & 1) * BUF; unsigned char* nxt = lds + ((kt & 1) ^ 1) * BUF;
        const bool more = kt + 1 < ntile;
        if (more) {
#pragma unroll
            for (int i = 0; i < 2; ++i) { kr[i] = *(const u32x4*)(kg + (size_t)(k0 + 64 + 32 * i) * 1024); vr[i] = *(const u32x4*)(vg + (size_t)(k0 + 64 + 32 * i) * 1024); }
            if (tid < 64) fr = F[k0 + 64 + tid];
        }
        if (k0 <= q0s + 31) {
            f32x16 s[2];
            const bf16x8 qaf = __builtin_bit_cast(bf16x8, qa);
#pragma unroll
            for (int kb = 0; kb < 2; ++kb) {
#pragma unroll
                for (int i = 0; i < 16; ++i) s[kb][i] = 0.f;
#pragma unroll
                for (int ks = 0; ks < 8; ++ks) { const bf16x8 a = *(const bf16x8*)(cur + (kb * 32 + r) * KST + ks * 32 + hh * 16);
                    s[kb] = __builtin_amdgcn_mfma_f32_32x32x16_bf16(a, qf[ks], s[kb], 0, 0, 0); }
                {   const bf16x8 a = *(const bf16x8*)(cur + (kb * 32 + r) * KST + 256);
                    s[kb] = __builtin_amdgcn_mfma_f32_32x32x16_bf16(a, qaf, s[kb], 0, 0, 0); }
            }
            if (k0 + 63 > q0s) {
                const int lim = qs - k0;
#pragma unroll
                for (int kb = 0; kb < 2; ++kb)
#pragma unroll
                    for (int i = 0; i < 16; ++i) s[kb][i] = (kb * 32 + (i & 3) + 8 * (i >> 2) + 4 * hh > lim) ? -INFINITY : s[kb][i];
            }
            float mx = fmaxf(s[0][0], s[1][0]);
#pragma unroll
            for (int i = 1; i < 16; ++i) mx = fmaxf(mx, fmaxf(s[0][i], s[1][i]));
            mx = fmaxf(mx, __shfl_xor(mx, 32));
            if (__builtin_amdgcn_ballot_w64(mx > THR) != 0ull) {
                const float mnew_f = m + fmaxf(mx, 0.f); float meff; const unsigned m2 = split_bf16(-mnew_f, meff); meff = -meff;
                const float delta = meff - m, alpha = __builtin_amdgcn_exp2f(-delta);
                m = meff; if (!hh) qa.y = m2;
                l *= alpha;
#pragma unroll
                for (int d = 0; d < 4; ++d)
#pragma unroll
                    for (int i = 0; i < 16; ++i) o[d][i] *= alpha;
#pragma unroll
                for (int kb = 0; kb < 2; ++kb)
#pragma unroll
                    for (int i = 0; i < 16; ++i) s[kb][i] -= delta;
            }
            float ps = 0.f;
#pragma unroll
            for (int kb = 0; kb < 2; ++kb)
#pragma unroll
                for (int i = 0; i < 16; ++i) { const float pv = __builtin_amdgcn_exp2f(s[kb][i]); s[kb][i] = pv; ps += pv; }
            l += ps;
#pragma unroll
            for (int kb = 0; kb < 2; ++kb)
#pragma unroll
                for (int st = 0; st < 2; ++st) {
                    u32x4 pw; pw.x = cvt_pk(s[kb][8 * st + 0], s[kb][8 * st + 1]); pw.y = cvt_pk(s[kb][8 * st + 2], s[kb][8 * st + 3]);
                    pw.z = cvt_pk(s[kb][8 * st + 4], s[kb][8 * st + 5]); pw.w = cvt_pk(s[kb][8 * st + 6], s[kb][8 * st + 7]);
                    const bf16x8 pf = __builtin_bit_cast(bf16x8, pw);
#pragma unroll
                    for (int d = 0; d < 4; ++d) { const bf16x8 vf = tr_frag(cur + vb_off + (kb * 32 + st * 16) * VST + d * 64, 8 * VST);
                        o[d] = __builtin_amdgcn_mfma_f32_32x32x16_bf16(vf, pf, o[d], 0, 0, 0); }
                }
        }
        if (more) {
#pragma unroll
            for (int i = 0; i < 2; ++i) { *(u32x4*)(nxt + (srow0 + 32 * i) * KST + scc * 16) = kr[i]; *(u32x4*)(nxt + 64 * KST + (srow0 + 32 * i) * VST + scc * 16) = vr[i]; }
            if (tid < 64) FOX_AUG(nxt + tid * KST + 256, fr);
        }
        lds_barrier();
    }
#undef FOX_AUG
    l += __shfl_xor(l, 32);
    const float inv = (G2_FP8 ? 8.f : 1.f) / l;
#pragma unroll
    for (int d = 0; d < 4; ++d)
#pragma unroll
        for (int g = 0; g < 4; ++g) {
#if G2_FP8
            f32x4 v; v[0] = o[d][4 * g] * inv; v[1] = o[d][4 * g + 1] * inv; v[2] = o[d][4 * g + 2] * inv; v[3] = o[d][4 * g + 3] * inv;
            *(unsigned*)((unsigned char*)Oc + trow * D_ + h * 128 + d * 32 + 8 * g + 4 * hh) = pack4_fp8(v);
#else
            u32x2 w; w.x = cvt_pk(o[d][4 * g] * inv, o[d][4 * g + 1] * inv); w.y = cvt_pk(o[d][4 * g + 2] * inv, o[d][4 * g + 3] * inv);
            *(u32x2*)(Oc + trow * D_ + h * 128 + d * 32 + 8 * g + 4 * hh) = w;
#endif
        }
}

__device__ __forceinline__ void mlstm_passA(const Params& p, unsigned char* lds, int unit) {
    const int tid = get_tid(p.swid), lane = tid & 63, wave = tid >> 6, r = lane & 31, hh = lane >> 5, li = lane & 15;
    const int b = unit >> 3, h = (unit >> 1) & 3, eh = unit & 1;
    unsigned char* ws = p.ws;
    const bf16_t* KC = (const bf16_t*)(ws + WS_KC); const bf16_t* Mv = (const bf16_t*)(ws + WS_P + 5 * SEG_B);
    const float* gate = (const float*)(ws + WS_GATE);
    bf16_t* Cst = (bf16_t*)(ws + WS_CST); float* nst = (float*)(ws + WS_NST); float* mst = (float*)(ws + WS_MST);
    constexpr int KST = 528, VST = 272;
    unsigned char* ksm = lds;
    unsigned char* vsm = ksm + 64 * KST;
    float* WSV = (float*)(vsm + 64 * VST);
    float* SCL = WSV + 2048;
    constexpr int STGS = 528;
    unsigned char* stg = (unsigned char*)(SCL + 128);
    __syncthreads();
    for (int cc = wave; cc < 32; cc += 8) {
        const int t = b * S_ + cc * 64 + lane;
        const float ipre = gate[(size_t)t * 16 + 8 + h] + p.m_ib[h], fpre = gate[(size_t)t * 16 + 12 + h] + p.m_fb[h];
        float bc = logsig(fpre);
#pragma unroll
        for (int o = 1; o < 64; o <<= 1) { const float u = __shfl_up(bc, o); if (lane >= o) bc += u; }
        const float a = ipre - bc; const float amax = wmax(a); const float bL = __shfl(bc, 63);
        WSV[cc * 64 + lane] = a; if (lane == 0) { SCL[cc] = bL; SCL[32 + cc] = amax; }
    }
    __syncthreads();
    if (tid == 0) { float m = 0.f; for (int cc = 0; cc < 32; ++cc) { const float mn = SCL[cc] + fmaxf(m, SCL[32 + cc]); SCL[64 + cc] = expf(SCL[cc] + m - mn); SCL[96 + cc] = mn; if (eh == 0) mst[(b * 4 + h) * 32 + cc] = m; m = mn; } }
    __syncthreads();
    for (int i = tid; i < 2048; i += NTHR) { const int cc = i >> 6; WSV[i] = expf(SCL[cc] + WSV[i] - SCL[96 + cc]); }
    f32x16 acc[4];
#pragma unroll
    for (int et = 0; et < 4; ++et)
#pragma unroll
        for (int i = 0; i < 16; ++i) acc[et][i] = 0.f;
    f32x16 accn;
#pragma unroll
    for (int i = 0; i < 16; ++i) accn[i] = 0.f;
    const int kb_off = (8 * hh + (li >> 2)) * KST + (wave * 32 + 16 * (r >> 4) + 4 * (li & 3)) * 2;
    const int vb_off = (8 * hh + (li >> 2)) * VST + (16 * (r >> 4) + 4 * (li & 3)) * 2;
    u32x4 pk[4], pv[2];
#pragma unroll
    for (int i = 0; i < 4; ++i) { const int c = tid + NTHR * i, row = c >> 5, c16 = c & 31; pk[i] = *(const u32x4*)(KC + (size_t)(b * S_ + row) * 1024 + h * 256 + c16 * 8); }
#pragma unroll
    for (int i = 0; i < 2; ++i) { const int c = tid + NTHR * i, row = c >> 4, c16 = c & 15; pv[i] = *(const u32x4*)(Mv + (size_t)(b * S_ + row) * 1024 + h * 256 + eh * 128 + c16 * 8); }
    for (int cc = 0; cc < 32; ++cc) {
        const int bhc = (b * 4 + h) * 32 + cc, t0 = b * S_ + cc * 64;
#pragma unroll
        for (int et = 0; et < 4; ++et)
#pragma unroll
            for (int g = 0; g < 4; ++g) { u32x2 o; o.x = cvt_pk(acc[et][4 * g], acc[et][4 * g + 1]); o.y = cvt_pk(acc[et][4 * g + 2], acc[et][4 * g + 3]);
                *(u32x2*)(stg + (et * 32 + r) * STGS + (wave * 32 + 8 * g + 4 * hh) * 2) = o; }
        if (eh == 0 && r == 0) {
#pragma unroll
            for (int g = 0; g < 4; ++g) { f32x4 o; o[0] = accn[4 * g]; o[1] = accn[4 * g + 1]; o[2] = accn[4 * g + 2]; o[3] = accn[4 * g + 3]; *(f32x4*)(nst + (size_t)bhc * 256 + wave * 32 + 8 * g + 4 * hh) = o; } }
        lds_barrier();
#pragma unroll
        for (int i = 0; i < 8; ++i) { const int c = tid + NTHR * i, row = c >> 5, c16 = c & 31;
            *(u32x4*)(Cst + ((size_t)bhc * 256 + eh * 128 + row) * 256 + c16 * 8) = *(const u32x4*)(stg + row * STGS + c16 * 16); }
        if (cc == 31) break;
#pragma unroll
        for (int i = 0; i < 4; ++i) { const int c = tid + NTHR * i, row = c >> 5, c16 = c & 31; *(u32x4*)(ksm + row * KST + c16 * 16) = pk[i]; }
#pragma unroll
        for (int i = 0; i < 2; ++i) { const int c = tid + NTHR * i, row = c >> 4, c16 = c & 15; const float wv = WSV[cc * 64 + row]; const u32x4 w = pv[i];
            u32x4 o; o.x = cvt_pk(bflo(w.x) * wv, bfhi(w.x) * wv); o.y = cvt_pk(bflo(w.y) * wv, bfhi(w.y) * wv); o.z = cvt_pk(bflo(w.z) * wv, bfhi(w.z) * wv); o.w = cvt_pk(bflo(w.w) * wv, bfhi(w.w) * wv);
            *(u32x4*)(vsm + row * VST + c16 * 16) = o; }
        if (cc + 1 < 31) { const int t1 = t0 + 64;
#pragma unroll
            for (int i = 0; i < 4; ++i) { const int c = tid + NTHR * i, row = c >> 5, c16 = c & 31; pk[i] = *(const u32x4*)(KC + (size_t)(t1 + row) * 1024 + h * 256 + c16 * 8); }
#pragma unroll
            for (int i = 0; i < 2; ++i) { const int c = tid + NTHR * i, row = c >> 4, c16 = c & 15; pv[i] = *(const u32x4*)(Mv + (size_t)(t1 + row) * 1024 + h * 256 + eh * 128 + c16 * 8); } }
        lds_barrier();
        const float decay = SCL[64 + cc];
#pragma unroll
        for (int et = 0; et < 4; ++et)
#pragma unroll
            for (int i = 0; i < 16; ++i) acc[et][i] *= decay;
#pragma unroll
        for (int i = 0; i < 16; ++i) accn[i] *= decay;
#pragma unroll
        for (int ks = 0; ks < 4; ++ks) {
            const bf16x8 bfr = tr_frag(ksm + kb_off + ks * 16 * KST, 4 * KST);
            {
                const f32x4 w0 = *(const f32x4*)(WSV + cc * 64 + ks * 16 + hh * 8), w1 = *(const f32x4*)(WSV + cc * 64 + ks * 16 + hh * 8 + 4);
                u32x4 wb; wb.x = cvt_pk(w0[0], w0[1]); wb.y = cvt_pk(w0[2], w0[3]); wb.z = cvt_pk(w1[0], w1[1]); wb.w = cvt_pk(w1[2], w1[3]);
                if (r != 0) wb = (u32x4){0u, 0u, 0u, 0u};
                accn = __builtin_amdgcn_mfma_f32_32x32x16_bf16(bfr, __builtin_bit_cast(bf16x8, wb), accn, 0, 0, 0); }
#pragma unroll
            for (int et = 0; et < 4; ++et) { const bf16x8 afr = tr_frag(vsm + vb_off + ks * 16 * VST + et * 64, 4 * VST);
                acc[et] = __builtin_amdgcn_mfma_f32_32x32x16_bf16(bfr, afr, acc[et], 0, 0, 0); }
        }
    }
}

__device__ __forceinline__ void mlstm_passB(const Params& p, unsigned char* lds, int unit) {
    const int tid = get_tid(p.swid), lane = tid & 63, wave = tid >> 6, r = lane & 31, hh = lane >> 5, li = lane & 15;
    const int b = unit >> 7, h = (unit >> 5) & 3, cc = unit & 31;
    unsigned char* ws = p.ws;
    const bf16_t* QC = (const bf16_t*)(ws + WS_QC); const bf16_t* KC = (const bf16_t*)(ws + WS_KC);
    const bf16_t* Mv = (const bf16_t*)(ws + WS_P + 5 * SEG_B); const bf16_t* Mo = (const bf16_t*)(ws + WS_P + 6 * SEG_B);
    const float* gate = (const float*)(ws + WS_GATE);
    const bf16_t* Cst = (const bf16_t*)(ws + WS_CST); const float* nst = (const float*)(ws + WS_NST); const float* mst = (const float*)(ws + WS_MST);
    bf16_t* Oc = (bf16_t*)(ws + WS_H);
    constexpr int QST = 528, VST = 544, WST = 144, HST = 1040;
    unsigned char* qsm = lds;
    unsigned char* ksm = qsm + 64 * QST;
    unsigned char* vsm = ksm + 64 * QST;
    unsigned char* wsm = vsm + 64 * VST;
    float* sc = (float*)(wsm + 64 * WST);
    float* hsm = (float*)lds;
    const int bhc = (b * 4 + h) * 32 + cc, t0 = b * S_ + cc * 64;
    __syncthreads();
    if (wave == 0) {
        const float ipre = gate[(size_t)(t0 + lane) * 16 + 8 + h] + p.m_ib[h], fpre = gate[(size_t)(t0 + lane) * 16 + 12 + h] + p.m_fb[h];
        float bc = logsig(fpre);
#pragma unroll
        for (int o = 1; o < 64; o <<= 1) { const float u = __shfl_up(bc, o); if (lane >= o) bc += u; }
        const float a = ipre - bc; float pm = a;
#pragma unroll
        for (int o = 1; o < 64; o <<= 1) { const float u = __shfl_up(pm, o); if (lane >= o) pm = fmaxf(pm, u); }
        const float mc = mst[bhc]; const float mt = bc + fmaxf(mc, pm);
        sc[lane] = bc - mt; sc[64 + lane] = a; sc[128 + lane] = mt; sc[192 + lane] = expf(bc + mc - mt);
    }
    bf16x8 cfr[16];
#pragma unroll
    for (int ks = 0; ks < 16; ++ks) cfr[ks] = *(const bf16x8*)(Cst + ((size_t)bhc * 256 + wave * 32 + r) * 256 + ks * 16 + hh * 8);
#pragma unroll
    for (int i = 0; i < 4; ++i) { const int c = tid + NTHR * i, row = c >> 5, c16 = c & 31;
        *(u32x4*)(qsm + row * QST + c16 * 16) = *(const u32x4*)(QC + (size_t)(t0 + row) * 1024 + h * 256 + c16 * 8);
        *(u32x4*)(ksm + row * QST + c16 * 16) = *(const u32x4*)(KC + (size_t)(t0 + row) * 1024 + h * 256 + c16 * 8);
        *(u32x4*)(vsm + row * VST + c16 * 16) = *(const u32x4*)(Mv + (size_t)(t0 + row) * 1024 + h * 256 + c16 * 8); }
    __syncthreads();
    if (wave < 3) {
        const int sb = wave >> 1, lb = wave ? 1 : 0;
        f32x16 s;
#pragma unroll
        for (int i = 0; i < 16; ++i) s[i] = 0.f;
#pragma unroll
        for (int ks = 0; ks < 16; ++ks) { const bf16x8 a = *(const bf16x8*)(ksm + (sb * 32 + r) * QST + ks * 32 + hh * 16), q = *(const bf16x8*)(qsm + (lb * 32 + r) * QST + ks * 32 + hh * 16);
            s = __builtin_amdgcn_mfma_f32_32x32x16_bf16(a, q, s, 0, 0, 0); }
        const int l = lb * 32 + r; const float bl = sc[l]; float rs = 0.f;
#pragma unroll
        for (int g = 0; g < 4; ++g) { float w[4];
#pragma unroll
            for (int e = 0; e < 4; ++e) { const int sI = sb * 32 + 8 * g + 4 * hh + e; w[e] = (sI <= l) ? s[4 * g + e] * __expf(bl + sc[64 + sI]) : 0.f; rs += w[e]; }
            u32x2 o; o.x = cvt_pk(w[0], w[1]); o.y = cvt_pk(w[2], w[3]);
            *(u32x2*)(wsm + l * WST + (sb * 32 + 8 * g + 4 * hh) * 2) = o; }
        sc[256 + l * 4 + sb * 2 + hh] = rs;
    } else if (wave == 3) {
        const int l = r;
#pragma unroll
        for (int g = 0; g < 4; ++g) { u32x2 o; o.x = 0u; o.y = 0u; *(u32x2*)(wsm + l * WST + (32 + 8 * g + 4 * hh) * 2) = o; }
        sc[256 + l * 4 + 2 + hh] = 0.f;
    }
    {
        const int l = tid & 63, part = tid >> 6; const float* np = nst + (size_t)bhc * 256 + part * 32; float s = 0.f;
#pragma unroll
        for (int q = 0; q < 4; ++q) { const u32x4 w = *(const u32x4*)(qsm + l * QST + part * 64 + q * 16);
            s += bflo(w.x) * np[8 * q] + bfhi(w.x) * np[8 * q + 1] + bflo(w.y) * np[8 * q + 2] + bfhi(w.y) * np[8 * q + 3] + bflo(w.z) * np[8 * q + 4] + bfhi(w.z) * np[8 * q + 5] + bflo(w.w) * np[8 * q + 6] + bfhi(w.w) * np[8 * q + 7]; }
        sc[512 + l * 8 + part] = s;
    }
    f32x16 acc[2];
#pragma unroll
    for (int lb = 0; lb < 2; ++lb)
#pragma unroll
        for (int i = 0; i < 16; ++i) acc[lb][i] = 0.f;
#pragma unroll
    for (int ks = 0; ks < 16; ++ks)
#pragma unroll
        for (int lb = 0; lb < 2; ++lb) { const bf16x8 q = *(const bf16x8*)(qsm + (lb * 32 + r) * QST + ks * 32 + hh * 16);
            acc[lb] = __builtin_amdgcn_mfma_f32_32x32x16_bf16(cfr[ks], q, acc[lb], 0, 0, 0); }
    __syncthreads();
#pragma unroll
    for (int lb = 0; lb < 2; ++lb) { const float it = sc[192 + lb * 32 + r];
#pragma unroll
        for (int i = 0; i < 16; ++i) acc[lb][i] *= it; }
    const int vb_off = (8 * hh + (li >> 2)) * VST + (wave * 32 + 16 * (r >> 4) + 4 * (li & 3)) * 2;
#pragma unroll
    for (int ks = 0; ks < 4; ++ks) { const bf16x8 afr = tr_frag(vsm + vb_off + ks * 16 * VST, 4 * VST);
#pragma unroll
        for (int lb = 0; lb < 2; ++lb) { if (lb == 0 && ks >= 2) continue;
            const bf16x8 wf = *(const bf16x8*)(wsm + (lb * 32 + r) * WST + ks * 32 + hh * 16);
            acc[lb] = __builtin_amdgcn_mfma_f32_32x32x16_bf16(afr, wf, acc[lb], 0, 0, 0); } }
    float ssq[2];
#pragma unroll
    for (int lb = 0; lb < 2; ++lb) { const int l = lb * 32 + r;
        const f32x4 rsv = *(const f32x4*)(sc + 256 + l * 4); const f32x4 q0 = *(const f32x4*)(sc + 512 + l * 8), q1 = *(const f32x4*)(sc + 512 + l * 8 + 4);
        const float den = (rsv[0] + rsv[1] + rsv[2] + rsv[3]) + sc[192 + l] * ((q0[0] + q0[1] + q0[2] + q0[3]) + (q1[0] + q1[1] + q1[2] + q1[3]));
        const float inv = 1.f / fmaxf(fabsf(den), __expf(-sc[128 + l]));
        float s2 = 0.f;
#pragma unroll
        for (int i = 0; i < 16; ++i) { acc[lb][i] *= inv; s2 += acc[lb][i] * acc[lb][i]; }
        s2 += __shfl_xor(s2, 32); ssq[lb] = s2; }
    __syncthreads();
    if (hh == 0) { sc[1024 + r * 8 + wave] = ssq[0]; sc[1024 + (32 + r) * 8 + wave] = ssq[1]; }
#pragma unroll
    for (int lb = 0; lb < 2; ++lb)
#pragma unroll
        for (int g = 0; g < 4; ++g) { f32x4 v; v[0] = acc[lb][4 * g]; v[1] = acc[lb][4 * g + 1]; v[2] = acc[lb][4 * g + 2]; v[3] = acc[lb][4 * g + 3];
            *(f32x4*)((unsigned char*)hsm + (lb * 32 + r) * HST + (wave * 32 + 8 * g + 4 * hh) * 4) = v; }
    __syncthreads();
#pragma unroll
    for (int i = 0; i < 4; ++i) { const int c = tid + NTHR * i, l = c >> 5, e0 = (c & 31) * 8;
        const f32x4 s0 = *(const f32x4*)(sc + 1024 + l * 8), s1 = *(const f32x4*)(sc + 1024 + l * 8 + 4);
        const float rr = rsqrtf(((s0[0] + s0[1] + s0[2] + s0[3]) + (s1[0] + s1[1] + s1[2] + s1[3])) * (1.f / 256.f) + EPS_);
        const f32x4 h0 = *(const f32x4*)((unsigned char*)hsm + l * HST + e0 * 4), h1 = *(const f32x4*)((unsigned char*)hsm + l * HST + e0 * 4 + 16);
        const f32x4 g0 = *(const f32x4*)(p.m_hg + h * 256 + e0), g1 = *(const f32x4*)(p.m_hg + h * 256 + e0 + 4);
        const u32x4 mo = *(const u32x4*)(Mo + (size_t)(t0 + l) * 1024 + h * 256 + e0);
#if G2_FP8
        const float r8 = rr * 8.f; f32x4 a, b;
        a[0] = h0[0] * r8 * g0[0] * sigm(bflo(mo.x)); a[1] = h0[1] * r8 * g0[1] * sigm(bfhi(mo.x)); a[2] = h0[2] * r8 * g0[2] * sigm(bflo(mo.y)); a[3] = h0[3] * r8 * g0[3] * sigm(bfhi(mo.y));
        b[0] = h1[0] * r8 * g1[0] * sigm(bflo(mo.z)); b[1] = h1[1] * r8 * g1[1] * sigm(bfhi(mo.z)); b[2] = h1[2] * r8 * g1[2] * sigm(bflo(mo.w)); b[3] = h1[3] * r8 * g1[3] * sigm(bfhi(mo.w));
        u32x2 o; o.x = pack4_fp8(a); o.y = pack4_fp8(b);
        *(u32x2*)((unsigned char*)Oc + (size_t)(t0 + l) * D_ + 1024 + h * 256 + e0) = o; }
#else
        u32x4 o;
        o.x = cvt_pk(h0[0] * rr * g0[0] * sigm(bflo(mo.x)), h0[1] * rr * g0[1] * sigm(bfhi(mo.x))); o.y = cvt_pk(h0[2] * rr * g0[2] * sigm(bflo(mo.y)), h0[3] * rr * g0[3] * sigm(bfhi(mo.y)));
        o.z = cvt_pk(h1[0] * rr * g1[0] * sigm(bflo(mo.z)), h1[1] * rr * g1[1] * sigm(bfhi(mo.z))); o.w = cvt_pk(h1[2] * rr * g1[2] * sigm(bflo(mo.w)), h1[3] * rr * g1[3] * sigm(bfhi(mo.w)));
        *(u32x4*)(Oc + (size_t)(t0 + l) * D_ + 1024 + h * 256 + e0) = o; }
#endif
}

__device__ __forceinline__ void ce_desc(float& a, float& b) { const float hi = fmaxf(a, b), lo = fminf(a, b); a = hi; b = lo; }
__device__ __forceinline__ void sort16_desc(float (&v)[16]) {
#pragma unroll
    for (int k = 2; k <= 16; k <<= 1)
#pragma unroll
        for (int j = k >> 1; j > 0; j >>= 1)
#pragma unroll
            for (int i = 0; i < 16; ++i) { const int l = i ^ j; if (l > i) { if ((i & k) == 0) ce_desc(v[i], v[l]); else ce_desc(v[l], v[i]); } }
}
__device__ __forceinline__ void bmerge16_desc(float (&v)[16]) {
#pragma unroll
    for (int j = 8; j > 0; j >>= 1)
#pragma unroll
        for (int i = 0; i < 16; ++i) { const int l = i ^ j; if (l > i) ce_desc(v[i], v[l]); }
}
__device__ __forceinline__ void merge_top16(float (&a)[16], const float (&b)[16]) {
#pragma unroll
    for (int i = 0; i < 16; ++i) a[i] = fmaxf(a[i], b[15 - i]);
    bmerge16_desc(a);
}
__device__ __forceinline__ float pack_idx(float v, unsigned mask, unsigned idx) { return __builtin_bit_cast(float, (__builtin_bit_cast(unsigned, v) & mask) | idx); }
__device__ __forceinline__ void top16_from_acc(const f32x16 (&acc)[4], int h, float (&out)[16]) {
    float g[4][16];
#pragma unroll
    for (int mt = 0; mt < 4; ++mt) {
#pragma unroll
        for (int i = 0; i < 16; ++i) g[mt][i] = pack_idx(acc[mt][i], 0xffffff80u, (unsigned)(32 * mt + (i & 3) + 8 * (i >> 2)) | ((unsigned)h << 2));
        sort16_desc(g[mt]);
    }
    merge_top16(g[0], g[1]); merge_top16(g[2], g[3]); merge_top16(g[0], g[2]);
    float o[16];
#pragma unroll
    for (int i = 0; i < 16; ++i) o[i] = __shfl_xor(g[0][i], 32);
    merge_top16(g[0], o);
#pragma unroll
    for (int i = 0; i < 16; ++i) out[i] = g[0][i];
}
__device__ __forceinline__ unsigned lut16(const unsigned (&P)[4], unsigned i) {
    const unsigned long long lo = (unsigned long long)P[0] | ((unsigned long long)P[1] << 32), hi = (unsigned long long)P[2] | ((unsigned long long)P[3] << 32);
    const unsigned long long s = (i & 8u) ? hi : lo;
    return (unsigned)(s >> ((i & 7u) * 8u)) & 0xffu;
}
struct CandTab { int i[50]; int j[50]; };
constexpr CandTab make_cand_tab() { CandTab t{}; int n = 0; for (int i = 0; i < 16; ++i) for (int j = 0; j < 16; ++j) if ((i + 1) * (j + 1) <= 16) { t.i[n] = i; t.j[n] = j; ++n; } return t; }
__device__ __forceinline__ void phase_topk(const Params& p, unsigned char* lds, int bid, int nb) {
    const int tid = get_tid(p.swid), lane = tid & 63, wave = tid >> 6, r = lane & 31, h = lane >> 5;
    unsigned char* ws = p.ws;
    const bf16_t* Q = (const bf16_t*)(ws + WS_Q); int* IDX = (int*)(ws + WS_IDX); float* GW = (float*)(ws + WS_GW);
    constexpr int KP = 136;
    bf16_t* KS = (bf16_t*)lds;
    for (int i = tid; i < 2 * 2048; i += NTHR) {
        const int which = i >> 11, n = (i >> 4) & 127, d0 = (i & 15) * 8; const float* sp = (which ? p.sk2 : p.sk1) + n * 128 + d0;
        const f32x4 a = *(const f32x4*)sp, b = *(const f32x4*)(sp + 4);
        u32x4 hi, lo;
        hi.x = cvt_pk(a[0], a[1]); hi.y = cvt_pk(a[2], a[3]); hi.z = cvt_pk(b[0], b[1]); hi.w = cvt_pk(b[2], b[3]);
        lo.x = cvt_pk(a[0] - bflo(hi.x), a[1] - bfhi(hi.x)); lo.y = cvt_pk(a[2] - bflo(hi.y), a[3] - bfhi(hi.y)); lo.z = cvt_pk(b[0] - bflo(hi.z), b[1] - bfhi(hi.z)); lo.w = cvt_pk(b[2] - bflo(hi.w), b[3] - bfhi(hi.w));
        *(u32x4*)(KS + ((which * 2 + 0) * 128 + n) * KP + d0) = hi; *(u32x4*)(KS + ((which * 2 + 1) * 128 + n) * KP + d0) = lo; }
    __syncthreads();
    for (int item = bid * 8 + wave; item < 512 * 8; item += nb * 8) {
        const int tt = item >> 3, hh = item & 7, t = tt * 32 + r;
        float top[2][16];
#pragma unroll
        for (int list = 0; list < 2; ++list) {
            bf16x8 qf[8];
#pragma unroll
            for (int ks = 0; ks < 8; ++ks) qf[ks] = *(const bf16x8*)(Q + (size_t)t * D_ + hh * 256 + list * 128 + ks * 16 + h * 8);
            float g[4][16];
#pragma unroll
            for (int mt = 0; mt < 4; ++mt) {
                f32x16 acc;
#pragma unroll
                for (int i = 0; i < 16; ++i) acc[i] = 0.f;
#pragma unroll
                for (int hl = 0; hl < 2; ++hl)
#pragma unroll
                    for (int ks = 0; ks < 8; ++ks) { const bf16x8 a = *(const bf16x8*)(KS + ((list * 2 + hl) * 128 + mt * 32 + r) * KP + ks * 16 + h * 8);
                        acc = __builtin_amdgcn_mfma_f32_32x32x16_bf16(a, qf[ks], acc, 0, 0, 0); }
#pragma unroll
                for (int i = 0; i < 16; ++i) g[mt][i] = pack_idx(acc[i], 0xffffff80u, (unsigned)(32 * mt + (i & 3) + 8 * (i >> 2)) | ((unsigned)h << 2));
                sort16_desc(g[mt]);
                __builtin_amdgcn_sched_barrier(0);
            }
            merge_top16(g[0], g[1]); merge_top16(g[2], g[3]); merge_top16(g[0], g[2]);
            {   float o[16];
#pragma unroll
                for (int i = 0; i < 16; ++i) o[i] = __shfl_xor(g[0][i], 32);
                merge_top16(g[0], o); }
#pragma unroll
            for (int i = 0; i < 16; ++i) top[list][i] = g[0][i];
            __builtin_amdgcn_sched_barrier(0);
        }
        unsigned P1[4], P2[4];
#pragma unroll
        for (int q = 0; q < 4; ++q) { P1[q] = 0u; P2[q] = 0u;
#pragma unroll
            for (int e = 0; e < 4; ++e) { P1[q] |= (__builtin_bit_cast(unsigned, top[0][4 * q + e]) & 127u) << (8 * e); P2[q] |= (__builtin_bit_cast(unsigned, top[1][4 * q + e]) & 127u) << (8 * e); } }
        float c[4][16];
#pragma unroll
        for (int n = 0; n < 64; ++n) {
            if (n < 50) { constexpr CandTab CT = make_cand_tab(); const int i = CT.i[n], j = CT.j[n];
                c[n >> 4][n & 15] = pack_idx(top[0][i] + top[1][j], 0xffffff00u, (unsigned)(i * 16 + j)); }
            else c[n >> 4][n & 15] = -INFINITY;
        }
        sort16_desc(c[0]); __builtin_amdgcn_sched_barrier(0); sort16_desc(c[1]); __builtin_amdgcn_sched_barrier(0); merge_top16(c[0], c[1]); __builtin_amdgcn_sched_barrier(0);
        sort16_desc(c[2]); __builtin_amdgcn_sched_barrier(0); sort16_desc(c[3]); __builtin_amdgcn_sched_barrier(0); merge_top16(c[2], c[3]); __builtin_amdgcn_sched_barrier(0); merge_top16(c[0], c[2]);
        float ex[16], sum = 0.f;
#pragma unroll
        for (int k = 0; k < 16; ++k) { ex[k] = __expf(c[0][k] - c[0][0]); sum += ex[k]; }
        const float inv = 1.f / sum;
        if (h == 0) {
            int* ip = IDX + (size_t)t * 128 + hh * 16; float* gp = GW + (size_t)t * 128 + hh * 16;
#pragma unroll
            for (int q = 0; q < 4; ++q) { u32x4 iv; f32x4 gv;
#pragma unroll
                for (int e = 0; e < 4; ++e) { const unsigned pos = __builtin_bit_cast(unsigned, c[0][4 * q + e]) & 255u;
                    iv[e] = lut16(P1, pos >> 4) * 128u + lut16(P2, pos & 15u); gv[e] = ex[4 * q + e] * inv; }
                *(u32x4*)(ip + 4 * q) = iv; *(f32x4*)(gp + 4 * q) = gv; }
        }
    }
}

typedef float f32x2 __attribute__((ext_vector_type(2)));
__device__ __forceinline__ float dot16_fp8(const u32x4 w, const float (&h)[32], int o) {
    float s = 0.f;
#pragma unroll
    for (int q = 0; q < 4; ++q) { const f32x2 lo = __builtin_amdgcn_cvt_pk_f32_fp8((int)w[q], false), hi = __builtin_amdgcn_cvt_pk_f32_fp8((int)w[q], true);
        fmac(s, lo[0], h[o + 4 * q]); fmac(s, lo[1], h[o + 4 * q + 1]); fmac(s, hi[0], h[o + 4 * q + 2]); fmac(s, hi[1], h[o + 4 * q + 3]); }
    return s;
}
template <int CTRL, int ROW_MASK, int BANK_MASK>
__device__ __forceinline__ int dpp_mov0i(int v) { return __builtin_amdgcn_update_dpp(0, v, CTRL, ROW_MASK, BANK_MASK, true); }
__device__ __forceinline__ void quant_row_i8(const bf16_t* hp, int c16, unsigned (&hq)[32], float& hsc) {
    float mx = 0.f;
#pragma unroll
    for (int i = 0; i < 16; ++i) { const u32x4 w = *(const u32x4*)(hp + 256 * (i >> 1) + 8 * (i & 1));
#pragma unroll
        for (int e = 0; e < 4; ++e) mx = fmaxf(mx, fmaxf(fabsf(bflo(w[e])), fabsf(bfhi(w[e])))); }
    mx = fmaxf(mx, __shfl_xor(mx, 1)); mx = fmaxf(mx, __shfl_xor(mx, 2)); mx = fmaxf(mx, __shfl_xor(mx, 4)); mx = fmaxf(mx, __shfl_xor(mx, 8));
    mx = fmaxf(mx, 1e-30f); const float inv = 127.f / mx; hsc = mx * (1.f / 127.f);
    asm volatile("" ::: "memory");
#pragma unroll
    for (int i = 0; i < 16; ++i) { const u32x4 w = *(const u32x4*)(hp + 256 * (i >> 1) + 8 * (i & 1));
#pragma unroll
        for (int hh = 0; hh < 2; ++hh) { const unsigned w0 = w[2 * hh], w1 = w[2 * hh + 1];
            hq[2 * i + hh] = ((unsigned)__float2int_rn(bflo(w0) * inv) & 0xffu) | (((unsigned)__float2int_rn(bfhi(w0) * inv) & 0xffu) << 8) | (((unsigned)__float2int_rn(bflo(w1) * inv) & 0xffu) << 16) | (((unsigned)__float2int_rn(bfhi(w1) * inv) & 0xffu) << 24); } }
}
__device__ __forceinline__ void phase_peer1(const Params& p, unsigned char* lds, int bid, int nb, int probe) {
    const int tid = get_tid(p.swid), lane = tid & 63, wave = tid >> 6, r = lane >> 4, c16 = lane & 15;
    unsigned char* ws = p.ws;
    const bf16_t* H2 = (const bf16_t*)(ws + WS_H2); const int* IDX = (const int*)(ws + WS_IDX); const float* GW = (const float*)(ws + WS_GW);
    unsigned* EWT = (unsigned*)(ws + WS_EWT); const float* DSC = (const float*)(ws + WS_DSC);
    const unsigned char* E8D = ws + WS_E8D + 16 * c16; const unsigned emask = probe ? 0x3ffu : 0x3fffu;
    LAS unsigned* seq = (LAS unsigned*)((LAS unsigned char*)lds + (wave * 4 + r) * 1024);
    LAS unsigned* hist = (LAS unsigned*)((LAS unsigned char*)lds + 32768 + (wave * 4 + r) * 128);
    for (int tile = bid; tile < 256; tile += nb) {
        const int tA = tile * 64 + wave * 4 + r, tB = tA + 32;
        unsigned hqA[32], hqB[32]; float hscA, hscB;
        quant_row_i8(H2 + (size_t)tA * D_ + 16 * c16, c16, hqA, hscA);
        quant_row_i8(H2 + (size_t)tB * D_ + 16 * c16, c16, hqB, hscB);
        unsigned ppA0, ppA1, ppB0, ppB1;
        {   int idx[16]; unsigned pos[16];
#pragma unroll
            for (int m = 0; m < 8; ++m) { idx[m] = IDX[(size_t)tA * 128 + c16 + 16 * m]; idx[8 + m] = IDX[(size_t)tB * 128 + c16 + 16 * m]; }
            hist[c16] = 0u;
#pragma unroll
            for (int m = 0; m < 16; ++m) pos[m] = __hip_atomic_fetch_add(&hist[idx[m] >> 10], 1u, __ATOMIC_RELAXED, __HIP_MEMORY_SCOPE_WORKGROUP);
            {   const unsigned c = hist[c16]; unsigned inc = c;
#pragma unroll
                for (int o = 1; o < 16; o <<= 1) { const unsigned u = __shfl_up(inc, o, 16); if (c16 >= o) inc += u; }
                hist[c16] = inc - c; }
#pragma unroll
            for (int m = 0; m < 16; ++m) { pos[m] += hist[idx[m] >> 10]; seq[pos[m]] = (unsigned)idx[m] | ((unsigned)(c16 + 16 * (m & 7)) << 14) | ((unsigned)(m >> 3) << 21); }
            ppA0 = pos[0] | (pos[1] << 8) | (pos[2] << 16) | (pos[3] << 24); ppA1 = pos[4] | (pos[5] << 8) | (pos[6] << 16) | (pos[7] << 24);
            ppB0 = pos[8] | (pos[9] << 8) | (pos[10] << 16) | (pos[11] << 24); ppB1 = pos[12] | (pos[13] << 8) | (pos[14] << 16) | (pos[15] << 24);
        }
        u32x4 cur[8], nxt[8]; unsigned ecur = seq[0], enxt = 0u;
        {   const unsigned char* rp = E8D + (size_t)(ecur & emask) * 2048;
#pragma unroll
            for (int q = 0; q < 8; ++q) cur[q] = *(const u32x4*)(rp + 256 * q); }
        for (int s = 0; s < 256; ++s) {
            if (s + 1 < 256) { enxt = seq[s + 1]; const unsigned char* rp = E8D + (size_t)(enxt & emask) * 2048;
#pragma unroll
                for (int q = 0; q < 8; ++q) nxt[q] = *(const u32x4*)(rp + 256 * q); }
            int a0 = 0, a1 = 0, b0 = 0, b1 = 0;
#pragma unroll
            for (int q = 0; q < 8; ++q) {
                a0 = __builtin_amdgcn_sdot4((int)cur[q][0], (int)hqA[4 * q], a0, false); a1 = __builtin_amdgcn_sdot4((int)cur[q][1], (int)hqA[4 * q + 1], a1, false);
                a0 = __builtin_amdgcn_sdot4((int)cur[q][2], (int)hqA[4 * q + 2], a0, false); a1 = __builtin_amdgcn_sdot4((int)cur[q][3], (int)hqA[4 * q + 3], a1, false);
                b0 = __builtin_amdgcn_sdot4((int)cur[q][0], (int)hqB[4 * q], b0, false); b1 = __builtin_amdgcn_sdot4((int)cur[q][1], (int)hqB[4 * q + 1], b1, false);
                b0 = __builtin_amdgcn_sdot4((int)cur[q][2], (int)hqB[4 * q + 2], b0, false); b1 = __builtin_amdgcn_sdot4((int)cur[q][3], (int)hqB[4 * q + 3], b1, false); }
            int d = ((ecur >> 21) & 1u) ? (b0 + b1) : (a0 + a1);
            d += dpp_mov0i<0x111, 0xf, 0xf>(d); d += dpp_mov0i<0x112, 0xf, 0xf>(d); d += dpp_mov0i<0x114, 0xf, 0xe>(d); d += dpp_mov0i<0x118, 0xf, 0xc>(d);
            if (c16 == 15) seq[s] = (unsigned)d;
#pragma unroll
            for (int q = 0; q < 8; ++q) cur[q] = nxt[q];
            ecur = enxt;
        }
        if (probe) continue;
#pragma unroll
        for (int tk = 0; tk < 2; ++tk) {
            const int t = tk ? tB : tA; const float hsc = tk ? hscB : hscA;
            unsigned* ep = EWT + (size_t)(t >> 6) * 8192 + (t & 63) * 4;
            int ixm[8]; unsigned rk[8];
            hist[c16] = 0u; hist[16 + c16] = 0u;
#pragma unroll
            for (int m = 0; m < 8; ++m) ixm[m] = IDX[(size_t)t * 128 + c16 + 16 * m];
#pragma unroll
            for (int m = 0; m < 8; ++m) rk[m] = __hip_atomic_fetch_add(&hist[ixm[m] & 31], 1u, __ATOMIC_RELAXED, __HIP_MEMORY_SCOPE_WORKGROUP);
            {   const unsigned h0 = hist[2 * c16], h1 = hist[2 * c16 + 1], c = h0 + h1; unsigned inc = c;
#pragma unroll
                for (int o = 1; o < 16; o <<= 1) { const unsigned u = __shfl_up(inc, o, 16); if (c16 >= o) inc += u; }
                hist[2 * c16] = inc - c; hist[2 * c16 + 1] = inc - c + h0; }
#pragma unroll
            for (int m = 0; m < 8; ++m) { const int j = c16 + 16 * m; const int ix = ixm[m];
                const unsigned pz = (hist[ix & 31] + rk[m] - 4u * (unsigned)(t & 31)) & 127u;
                const unsigned ps = ((tk ? (m < 4 ? ppB0 : ppB1) : (m < 4 ? ppA0 : ppA1)) >> (8 * (m & 3))) & 0xffu;
                const float a = (float)(int)seq[ps] * hsc * DSC[ix];
                const float w = GW[(size_t)t * 128 + j] * 0.5f * a * (1.f + erff(a * 0.7071067811865476f));
                ep[(pz >> 2) * 256 + (pz & 3)] = ((unsigned)__builtin_bit_cast(unsigned short, (_Float16)w) << 16) | (unsigned)ix; }
        }
    }
}
__device__ __forceinline__ void phase_peer2(const Params& p, unsigned char* lds, int bid, int nb) {
    const int tid = get_tid(p.swid), lane = tid & 63, wave = tid >> 6;
    unsigned char* ws = p.ws;
    const unsigned* EWT = (const unsigned*)(ws + WS_EWT); const bf16_t* Y = (const bf16_t*)(ws + WS_X1); const float* mod = (const float*)(ws + WS_MOD);
    for (int si = bid; si < 256; si += nb) {
        const int s = (si & 7) * 32 + (si >> 3);
        __syncthreads();
        {   const u32x4* sp = (const u32x4*)(ws + WS_E8U + (size_t)s * 131072);
#pragma unroll
            for (int i = 0; i < 16; ++i) ((u32x4*)lds)[tid + NTHR * i] = sp[tid + NTHR * i]; }
        __syncthreads();
        const int tb0 = wave;
        unsigned b0[16], b1[16], b2[16], b3[16];
        auto ldw = [&](int q, unsigned (&d)[16]) { const int tbn = (tb0 + 8 * (q >> 3)) & 255; const u32x4* wp = (const u32x4*)(EWT + (size_t)tbn * 8192 + (q & 7) * 1024) + lane;
#pragma unroll
            for (int u = 0; u < 4; ++u) { const u32x4 v = wp[u * 64]; d[4 * u] = v.x; d[4 * u + 1] = v.y; d[4 * u + 2] = v.z; d[4 * u + 3] = v.w; } };
        ldw(0, b0); ldw(1, b1);
        unsigned acc[4] = {0u, 0u, 0u, 0u};
        f32x4 xa = {0.f, 0.f, 0.f, 0.f}, xb = xa; u32x4 yw = {0u, 0u, 0u, 0u};
        auto iter = [&](int q, unsigned (&cur)[16], unsigned (&pre)[16]) {
            const int tb = (tb0 + 8 * (q >> 3)) & 255, g = q & 7;
            if (q + 2 < 256) ldw(q + 2, pre);
            const int t = tb * 64 + lane;
            if (g == 0) { xa = *(const f32x4*)(p.x + (size_t)t * D_ + 8 * s); xb = *(const f32x4*)(p.x + (size_t)t * D_ + 8 * s + 4); yw = *(const u32x4*)(Y + (size_t)t * D_ + 8 * s); }
            u32x2 row[16];
#pragma unroll
            for (int u = 0; u < 16; ++u) row[u] = *(const LAS u32x2*)addr_lo16x8(cur[u]);
#pragma unroll
            for (int u = 0; u < 16; ++u) {
                pkfma_hi(acc[0], cur[u], __builtin_bit_cast(unsigned, __builtin_amdgcn_cvt_scalef32_pk_f16_fp8(row[u].x, 1.0f, false)));
                pkfma_hi(acc[1], cur[u], __builtin_bit_cast(unsigned, __builtin_amdgcn_cvt_scalef32_pk_f16_fp8(row[u].x, 1.0f, true)));
                pkfma_hi(acc[2], cur[u], __builtin_bit_cast(unsigned, __builtin_amdgcn_cvt_scalef32_pk_f16_fp8(row[u].y, 1.0f, false)));
                pkfma_hi(acc[3], cur[u], __builtin_bit_cast(unsigned, __builtin_amdgcn_cvt_scalef32_pk_f16_fp8(row[u].y, 1.0f, true)));
            }
            if (g == 7) {
                const float* g1 = mod + (size_t)(t >> 11) * NMOD + 2 * D_ + 8 * s; const f32x4 ha = *(const f32x4*)g1, hb = *(const f32x4*)(g1 + 4);
                xa[0] += ha[0] * bflo(yw.x); xa[1] += ha[1] * bfhi(yw.x); xa[2] += ha[2] * bflo(yw.y); xa[3] += ha[3] * bfhi(yw.y); xb[0] += hb[0] * bflo(yw.z); xb[1] += hb[1] * bfhi(yw.z); xb[2] += hb[2] * bflo(yw.w); xb[3] += hb[3] * bfhi(yw.w);
                const float* g2 = mod + (size_t)(t >> 11) * NMOD + 5 * D_ + 8 * s;
                const f32x4 ga = *(const f32x4*)g2, gb = *(const f32x4*)(g2 + 4);
                f32x4 oa, ob;
#pragma unroll
                for (int c = 0; c < 4; ++c) { oa[c] = xa[c] + ga[c] * h16(acc[c >> 1], c & 1) * (1.f / 32.f); ob[c] = xb[c] + gb[c] * h16(acc[2 + (c >> 1)], c & 1) * (1.f / 32.f); }
                *(f32x4*)(p.out + (size_t)t * D_ + 8 * s) = oa; *(f32x4*)(p.out + (size_t)t * D_ + 8 * s + 4) = ob;
#pragma unroll
                for (int c = 0; c < 4; ++c) acc[c] = 0u;
            }
        };
#pragma unroll 1
        for (int q = 0; q < 256; q += 4) { iter(q, b0, b2); iter(q + 1, b1, b3); iter(q + 2, b2, b0); iter(q + 3, b3, b1); }
    }
}

typedef const __attribute__((address_space(4))) Params* KargPtr;
__device__ __forceinline__ Params load_params(int swid = 0) {
#if defined(__HIP_DEVICE_COMPILE__)
    KargPtr kp = (KargPtr)__builtin_amdgcn_kernarg_segment_ptr(); asm volatile("" : "+s"(kp)); Params r; __builtin_memcpy(&r, kp, sizeof(Params)); r.swid = swid; return r;
#else
    return Params{};
#endif
}
constexpr int N_PHASES = 12;
constexpr int LDS_BYTES = 152 * 1024;
__global__ void __launch_bounds__(NTHR) fwd_kernel(Params p_arg) {
    extern __shared__ __attribute__((aligned(16))) unsigned char lds[];
    const int bid = blockIdx.x, nb = gridDim.x, swid = __builtin_amdgcn_readfirstlane((int)threadIdx.x >> 6);
    unsigned char* ws = p_arg.ws;
    volatile LAS unsigned* xbst = (volatile LAS unsigned*)((LAS unsigned char*)lds + LDS_BYTES - 16);
    if (get_tid(swid) == 0) { xbst[0] = 0u; xbst[1] = 0u; xbst[2] = 0u; xbst[3] = 0u; }
    __syncthreads();
    if ((p_arg.ph_hi - p_arg.ph_lo) > 1) (void)xcd_barrier_post((unsigned*)(ws + WS_BAR), xbst, swid);
#ifdef ONLY_PHASE
#define IN(k) ((k) == ONLY_PHASE && p.ph_lo <= (k) && (k) < p.ph_hi)
#else
#define IN(k) (p.ph_lo <= (k) && (k) < p.ph_hi)
#endif
#define SEAM(k) do { const Params p = load_params(); if (p.ph_lo <= (k) && (k) + 1 < p.ph_hi) { XcdBarrier bar; bar.bar = (unsigned*)(p.ws + WS_BAR); bar.x = xb_xcc_id(); bar.st = xbst; xcd_barrier(bar, swid); } } while (0)
#ifndef REPEAT_MASK
#define REPEAT_MASK 0
#endif
#define REP(k) for (int rep_ = 0; rep_ < (((REPEAT_MASK) >> (k)) & 1) + 1; ++rep_)
    REP(0) { const Params p = load_params(swid); if (IN(0)) { unsigned char* ws = p.ws; const float* mod = (const float*)(ws + WS_MOD); (void)mod;
        phase_prep(p, lds, bid, nb);
    } }
    SEAM(0);
    REP(1) { const Params p = load_params(swid); if (IN(1)) { unsigned char* ws = p.ws; const float* mod = (const float*)(ws + WS_MOD); (void)mod;
        phase_norm<false>(p.x, nullptr, 0, p.g1, mod, 0, D_, (bf16_t*)(ws + WS_H), ws + WS_H8, bid, nb, swid);
    } }
    SEAM(1);
    REP(2) { const Params p = load_params(swid); if (IN(2)) { unsigned char* ws = p.ws; const float* mod = (const float*)(ws + WS_MOD); (void)mod;
        phase_gates(p, lds, bid, nb);
        { pg8::Gemm g{(const bf16_t*)(ws + WS_H8), (const bf16_t*)(ws + WS_WINT), T_, 7168, D_}; pg8::StaticOrder S; S.init(T_, 7168, nb, bid);
        pg8::EpiSeg E{(bf16_t*)(ws + WS_P), p.fox_qg, p.fox_kg, (LAS float*)((LAS unsigned char*)lds + 131072), 1.f / 512.f}; pg8::gemm_phase<pg8::EpiSeg, pg8::StaticOrder, true, true, true>((LAS unsigned char*)lds, g, S, E, swid); }
    } }
    SEAM(2);
    REP(3) { const Params p = load_params(swid); if (IN(3)) { unsigned char* ws = p.ws; const float* mod = (const float*)(ws + WS_MOD); (void)mod;
        phase_post(p, bid, nb);
    } }
    SEAM(3);
    REP(4) { const Params p = load_params(swid); if (IN(4)) { unsigned char* ws = p.ws; const float* mod = (const float*)(ws + WS_MOD); (void)mod;
        { for (int u = bid; u < 64; u += nb) mlstm_passA(p, lds, u);
        unsigned* qctr = (unsigned*)(ws + WS_QCTR) + rep_; LAS int* slot = (LAS int*)((LAS unsigned char*)lds + LDS_BYTES - 32);
        const int tid = get_tid(swid);
        for (;;) { __syncthreads(); if (tid == 0) *slot = (int)atomicAdd(qctr, 1u); __syncthreads(); const int u = *slot; if (u >= 512) break;
            const int bh = u & 63; fox_unit(p, lds, bh >> 3, bh & 7, 7 - (u >> 6)); } }
    } }
    SEAM(4);
    REP(5) { const Params p = load_params(swid); if (IN(5)) { unsigned char* ws = p.ws; const float* mod = (const float*)(ws + WS_MOD); (void)mod;
        { for (int u = bid; u < 1024; u += nb) mlstm_passB(p, lds, u); }
    } }
    SEAM(5);
    REP(6) { const Params p = load_params(swid); if (IN(6)) { unsigned char* ws = p.ws; const float* mod = (const float*)(ws + WS_MOD); (void)mod;
        { pg8::Gemm g{(const bf16_t*)(ws + WS_H), (const bf16_t*)(ws + WS_WOT), T_, D_, D_}; pg8::StaticOrder S; S.init(T_, D_, nb, bid);
        pg8::EpiBf E{(bf16_t*)(ws + WS_X1), D_, G2_FP8 ? 1.f / 512.f : 1.f}; pg8::gemm_phase<pg8::EpiBf, pg8::StaticOrder, true, true, G2_FP8 != 0>((LAS unsigned char*)lds, g, S, E, swid); }
    } }
    SEAM(6);
    REP(7) { const Params p = load_params(swid); if (IN(7)) { unsigned char* ws = p.ws; const float* mod = (const float*)(ws + WS_MOD); (void)mod;
        convert_experts(p, bid, nb);
    } }
    REP(7) { const Params p = load_params(swid); if (IN(7)) { unsigned char* ws = p.ws; const float* mod = (const float*)(ws + WS_MOD); (void)mod;
        phase_norm<true>(p.x, (const bf16_t*)(ws + WS_X1), 2 * D_, p.g2, mod, 3 * D_, 4 * D_, (bf16_t*)(ws + WS_H2), nullptr, bid, nb, swid);
    } }
    SEAM(7);
    REP(8) { const Params p = load_params(swid); if (IN(8)) { unsigned char* ws = p.ws; const float* mod = (const float*)(ws + WS_MOD); (void)mod;
        { pg8::Gemm g{(const bf16_t*)(ws + WS_H2), (const bf16_t*)(ws + WS_WQT), T_, D_, D_}; pg8::StaticOrder S; S.init(T_, D_, nb, bid);
        pg8::EpiBf E{(bf16_t*)(ws + WS_Q), D_, 1.f}; pg8::gemm_phase<pg8::EpiBf, pg8::StaticOrder, true, true>((LAS unsigned char*)lds, g, S, E, swid); }
    } }
    SEAM(8);
    REP(9) { const Params p = load_params(swid); if (IN(9)) { unsigned char* ws = p.ws; const float* mod = (const float*)(ws + WS_MOD); (void)mod;
        phase_topk(p, lds, bid, nb);
    } }
    SEAM(9);
    REP(10) { const Params p = load_params(swid); if (IN(10)) { unsigned char* ws = p.ws; const float* mod = (const float*)(ws + WS_MOD); (void)mod;
#ifdef PROBE_L2
        phase_peer1(p, lds, bid, nb, rep_);
#else
        phase_peer1(p, lds, bid, nb, 0);
#endif
    } }
    SEAM(10);
    REP(11) { const Params p = load_params(swid); if (IN(11)) { unsigned char* ws = p.ws; const float* mod = (const float*)(ws + WS_MOD); (void)mod;
        phase_peer2(p, lds, bid, nb);
    } }
#undef IN
#undef SEAM
}

#ifndef ONE_LAUNCH
#define ONE_LAUNCH 1
#endif
extern "C" void kernel_launch(void* const* d_in, const int* in_sizes, int n_in, void* d_out, int out_size, void* d_ws, size_t ws_size, hipStream_t stream) {
    static int grid = 0;
    if (grid == 0) {
        int dev = 0, cus = 0, per_cu = 0;
        if (n_in != 21 || ws_size < WS_END) { fprintf(stderr, "kernel_launch: unexpected n_in %d / ws_size %zu (need %zu)\n", n_in, ws_size, (size_t)WS_END); grid = -1; return; }
        hipGetDevice(&dev); hipDeviceGetAttribute(&cus, hipDeviceAttributeMultiprocessorCount, dev);
        if (hipFuncSetAttribute((const void*)fwd_kernel, hipFuncAttributeMaxDynamicSharedMemorySize, LDS_BYTES) != hipSuccess) { fprintf(stderr, "kernel_launch: hipFuncSetAttribute failed\n"); grid = -1; return; }
        if (hipOccupancyMaxActiveBlocksPerMultiprocessor(&per_cu, (const void*)fwd_kernel, NTHR, LDS_BYTES) != hipSuccess || per_cu < 1) { fprintf(stderr, "kernel_launch: occupancy query says %d\n", per_cu); (void)hipGetLastError(); }
        grid = cus > 0 ? cus : 256;
    }
    if (grid < 0) return;
    Params p{};
    const float** pp = (const float**)&p;
    for (int i = 0; i < 21; ++i) pp[i] = (const float*)d_in[i];
    p.out = (float*)d_out; p.ws = (unsigned char*)d_ws;
    hipMemsetAsync((char*)d_ws + WS_BAR, 0, 16384, stream);
#if ONE_LAUNCH
    p.ph_lo = 0; p.ph_hi = N_PHASES;
    void* args[] = {&p};
    hipError_t e = hipLaunchCooperativeKernel((const void*)fwd_kernel, dim3(grid), dim3(NTHR), args, LDS_BYTES, stream);
    if (e != hipSuccess) fprintf(stderr, "cooperative launch failed: %s (grid %d)\n", hipGetErrorString(e), grid);
#else
    for (int ph = 0; ph < N_PHASES; ++ph) { p.ph_lo = ph; p.ph_hi = ph + 1; hipLaunchKernelGGL(fwd_kernel, dim3(grid), dim3(NTHR), LDS_BYTES, stream, p); }
#endif
}
```
